# Optimizing an MI355X kernel written in HIP

```python
import math
import jax, jax.numpy as jnp
from jax import lax
import numpy as np

D_MODEL = 1024
BATCH = 8
SEQ = 4096
DEPTH = 2

M_HEADS = 4
M_HEAD_DIM = 128
M_WIDTH = M_HEADS * M_HEAD_DIM
M_CONV = 4
M_CHUNK = 128
M_INIT = -1e30
ROPE_DIM = 64
ROPE_THETA = 10000.0
S_HEADS = 8
S_HEAD_DIM = ROPE_DIM
S_WIDTH = S_HEADS * S_HEAD_DIM
S_KV_RANK = 256
IDX_HEADS = 4
IDX_DIM = ROPE_DIM
IDX_TOPK_MAX = 256
S_QBLOCK = 64
DA_HEADS = 4
DA_HEAD_DIM = ROPE_DIM
DA_V_DIM = 2 * DA_HEAD_DIM
DA_WIDTH = DA_HEADS * DA_V_DIM
DA_QBLOCK = 128
N_BRANCH = 3
BRANCH_WIDTH = 512
FF_DIM = ((8 * D_MODEL + 3 * 256 - 1) // (3 * 256)) * 256
EPS = 1e-6

_SEG_SIZES = (
    2 * M_WIDTH,
    M_WIDTH,
    M_WIDTH,
    2 * M_HEADS,
    S_WIDTH,
    S_KV_RANK,
    IDX_HEADS * IDX_DIM,
    IDX_DIM,
    IDX_HEADS,
    2 * DA_HEADS * DA_HEAD_DIM,
    2 * DA_HEADS * DA_HEAD_DIM,
    DA_WIDTH,
    N_BRANCH * D_MODEL,
)
IN_COLS = sum(_SEG_SIZES)

kernel_name = 'hybrid_mlstm_dsa_diffattn_gated'


def _split_cols(z):
    offs = []
    acc = 0
    for s in _SEG_SIZES[:-1]:
        acc += s
        offs.append(acc)
    return jnp.split(z, offs, axis=-1)


def _rms(x, g):
    xf = x.astype(jnp.float32)
    y = xf * lax.rsqrt(jnp.mean(xf * xf, axis=-1, keepdims=True) + EPS)
    return (y * g.astype(jnp.float32)).astype(x.dtype)


def _rope_tables(seq, dim, dtype):
    inv = 1.0 / jnp.power(ROPE_THETA, jnp.arange(0, dim, 2, dtype=jnp.float32) / dim)
    ang = jnp.arange(seq, dtype=jnp.float32)[:, None] * inv[None, :]
    return jnp.cos(ang).astype(dtype), jnp.sin(ang).astype(dtype)


def _rope(x, cos, sin):
    half = x.shape[-1] // 2
    shape = (1, cos.shape[0]) + (1,) * (x.ndim - 3) + (half,)
    c = cos.reshape(shape)
    s = sin.reshape(shape)
    x1, x2 = x[..., :half], x[..., half:]
    return jnp.concatenate([x1 * c - x2 * s, x1 * s + x2 * c], axis=-1)


def _causal_conv(x, w, b):
    k, c = w.shape
    y = lax.conv_general_dilated(x, w[:, None, :], window_strides=(1,), padding=[(k - 1, 0)],
                                 dimension_numbers=('NWC', 'WIO', 'NWC'), feature_group_count=c)
    return y + b


def _mlstm(q, k, v, i_pre, f_pre):
    B, T, H, dh = q.shape
    L = M_CHUNK
    N = T // L
    f32 = jnp.float32

    def chunk(a):
        a = a.astype(f32).reshape((B, N, L, H) + a.shape[3:])
        return jnp.moveaxis(a, 3, 1)

    qc = chunk(q)
    kc = chunk(k) * (dh ** -0.5)
    vc = chunk(v)
    ic = chunk(i_pre)
    lf = jax.nn.log_sigmoid(chunk(f_pre))
    b = jnp.cumsum(lf, axis=-1)
    g = b[..., -1]

    a = g[..., None] - b + ic
    m_loc = a.max(axis=-1)
    w_loc = jnp.exp(a - m_loc[..., None])
    c_loc = jnp.einsum('bhnlv,bhnlk->bhnvk', vc * w_loc[..., None], kc)
    n_loc = jnp.einsum('bhnl,bhnlk->bhnk', w_loc, kc)

    def step(state, xs):
        c_st, n_st, m_st = state
        g_n, c_n, nn_n, m_n = xs
        m_new = jnp.maximum(g_n + m_st, m_n)
        s_old = jnp.exp(g_n + m_st - m_new)
        s_loc = jnp.exp(m_n - m_new)
        c_new = s_old[..., None, None] * c_st + s_loc[..., None, None] * c_n
        n_new = s_old[..., None] * n_st + s_loc[..., None] * nn_n
        return (c_new, n_new, m_new), (c_st, n_st, m_st)

    init = (jnp.zeros((B, H, dh, dh), f32), jnp.zeros((B, H, dh), f32), jnp.full((B, H), M_INIT, f32))
    xs = (jnp.moveaxis(g, 2, 0), jnp.moveaxis(c_loc, 2, 0), jnp.moveaxis(n_loc, 2, 0), jnp.moveaxis(m_loc, 2, 0))
    _, (c_prev, n_prev, m_prev) = lax.scan(step, init, xs)
    c_prev = jnp.moveaxis(c_prev, 0, 2)
    n_prev = jnp.moveaxis(n_prev, 0, 2)
    m_prev = jnp.moveaxis(m_prev, 0, 2)

    t_idx = jnp.arange(L)
    causal = t_idx[:, None] >= t_idx[None, :]
    dmat = b[..., :, None] - b[..., None, :] + ic[..., None, :]
    dmat = jnp.where(causal, dmat, -jnp.inf)
    inter = b + m_prev[..., None]
    m_t = jnp.maximum(inter, dmat.max(axis=-1))
    sw = jnp.exp(dmat - m_t[..., None]) * jnp.einsum('bhntk,bhnsk->bhnts', qc, kc)
    s_inter = jnp.exp(inter - m_t)
    num = jnp.einsum('bhnts,bhnsv->bhntv', sw, vc) + s_inter[..., None] * jnp.einsum('bhntk,bhnvk->bhntv', qc, c_prev)
    den = sw.sum(axis=-1) + s_inter * jnp.einsum('bhntk,bhnk->bhnt', qc, n_prev)
    h = num / jnp.maximum(jnp.abs(den), jnp.exp(-m_t))[..., None]
    return jnp.moveaxis(h, 1, 3).reshape(B, T, H, dh)


def _dsa(q, k, v, qi, ki, wi):
    B, T, H, dh = q.shape
    topk = min(IDX_TOPK_MAX, T // 4)
    nb = T // S_QBLOCK
    f32 = jnp.float32
    bidx = jnp.arange(B)[:, None, None]
    ki32 = ki.astype(f32)
    key_pos = jnp.arange(T)
    idx_scale = (IDX_HEADS * IDX_DIM) ** -0.5

    def blocks(a):
        return jnp.moveaxis(a.reshape((B, nb, S_QBLOCK) + a.shape[2:]), 1, 0)

    def blk(args):
        qb, qib, wib, start = args
        tq = start + jnp.arange(S_QBLOCK)
        causal = key_pos[None, :] <= tq[:, None]
        rel = jax.nn.relu(jnp.einsum('bqhd,bsd->bqhs', qib.astype(f32), ki32))
        score = jnp.einsum('bqh,bqhs->bqs', wib.astype(f32) * idx_scale, rel)
        score = jnp.where(causal[None], score, -jnp.inf)
        _, idx = lax.top_k(score, topk)
        valid = idx <= tq[None, :, None]
        k_sel = k[bidx, idx]
        v_sel = v[bidx, idx]
        s = jnp.einsum('bqhd,bqkhd->bhqk', qb, k_sel).astype(f32) * (dh ** -0.5)
        s = jnp.where(valid[:, None], s, -jnp.inf)
        p = jax.nn.softmax(s, axis=-1).astype(v.dtype)
        return jnp.einsum('bhqk,bqkhd->bqhd', p, v_sel)

    starts = jnp.arange(nb, dtype=jnp.int32) * S_QBLOCK
    out = lax.map(blk, (blocks(q), blocks(qi), blocks(wi), starts))
    return jnp.moveaxis(out, 0, 1).reshape(B, T, H, dh)


def _diff_attn(q, k, v, lam):
    B, T, H, _, d = q.shape
    nb = T // DA_QBLOCK
    f32 = jnp.float32
    key_pos = jnp.arange(T)

    def blk(args):
        qb, start = args
        tq = start + jnp.arange(DA_QBLOCK)
        causal = key_pos[None, :] <= tq[:, None]
        s = jnp.einsum('bqhcd,bshcd->bhcqs', qb, k).astype(f32) * (d ** -0.5)
        s = jnp.where(causal, s, -jnp.inf)
        p = jax.nn.softmax(s, axis=-1)
        a = p[:, :, 0] - lam * p[:, :, 1]
        return jnp.einsum('bhqs,bshv->bqhv', a.astype(v.dtype), v)

    qblk = jnp.moveaxis(q.reshape((B, nb, DA_QBLOCK) + q.shape[2:]), 1, 0)
    starts = jnp.arange(nb, dtype=jnp.int32) * DA_QBLOCK
    out = lax.map(blk, (qblk, starts))
    return jnp.moveaxis(out, 0, 1).reshape(B, T, H, v.shape[-1])


def _layer(x, li, cos, sin, norm_mix_g, w_in, b_gate, conv_w, conv_b, gate_b, m_norm_g,
           kv_norm_g, w_kv_up, sq_g, sk_g, dq_g, dk_g, lam, d_out_g, w_branch, w_out,
           norm_ffn_g, w_gate_up, w_down):
    B, T, _ = x.shape
    f32 = jnp.float32
    xn = _rms(x, norm_mix_g)
    z = jnp.einsum('btd,dc->btc', xn, w_in)
    (m_qk, m_v, m_o, m_if, s_q, s_ckv, i_q, i_k, i_w, d_q, d_k, d_v, g_pre) = _split_cols(z)

    m_qk = jax.nn.silu(_causal_conv(m_qk, conv_w, conv_b))
    mq, mk = jnp.split(m_qk, 2, axis=-1)
    m_if = m_if + gate_b
    h = _mlstm(mq.reshape(B, T, M_HEADS, M_HEAD_DIM), mk.reshape(B, T, M_HEADS, M_HEAD_DIM),
               m_v.reshape(B, T, M_HEADS, M_HEAD_DIM), m_if[..., :M_HEADS], m_if[..., M_HEADS:])
    h = _rms(h, m_norm_g).reshape(B, T, M_WIDTH)
    y_a = (jax.nn.sigmoid(m_o.astype(f32)) * h).astype(x.dtype)

    sq = _rope(_rms(s_q.reshape(B, T, S_HEADS, S_HEAD_DIM), sq_g), cos, sin)
    ckv = _rms(s_ckv, kv_norm_g)
    kv = jnp.einsum('btr,rc->btc', ckv, w_kv_up).reshape(B, T, 2, S_HEADS, S_HEAD_DIM)
    sk = _rope(_rms(kv[:, :, 0], sk_g), cos, sin)
    sv = kv[:, :, 1]
    iq = _rope(i_q.reshape(B, T, IDX_HEADS, IDX_DIM), cos, sin)
    ik = _rope(i_k, cos, sin)
    y_b = _dsa(sq, sk, sv, iq, ik, i_w).reshape(B, T, S_WIDTH)

    dq = _rope(_rms(d_q.reshape(B, T, DA_HEADS, 2, DA_HEAD_DIM), dq_g), cos, sin)
    dk = _rope(_rms(d_k.reshape(B, T, DA_HEADS, 2, DA_HEAD_DIM), dk_g), cos, sin)
    dv = d_v.reshape(B, T, DA_HEADS, DA_V_DIM)
    lamf = lam.astype(f32)
    lam_init = 0.8 - 0.6 * math.exp(-0.3 * li)
    lam_val = jnp.exp(jnp.sum(lamf[0] * lamf[1])) - jnp.exp(jnp.sum(lamf[2] * lamf[3])) + lam_init
    o = _diff_attn(dq, dk, dv, lam_val)
    y_c = (_rms(o, d_out_g) * (1.0 - lam_init)).reshape(B, T, DA_WIDTH)

    gates = jax.nn.sigmoid((g_pre + b_gate).astype(f32)).astype(x.dtype).reshape(B, T, N_BRANCH, D_MODEL)
    merged = (gates[:, :, 0] * jnp.einsum('btc,cd->btd', y_a, w_branch[0])
              + gates[:, :, 1] * jnp.einsum('btc,cd->btd', y_b, w_branch[1])
              + gates[:, :, 2] * jnp.einsum('btc,cd->btd', y_c, w_branch[2]))
    x = x + jnp.einsum('btd,de->bte', merged, w_out)

    xn = _rms(x, norm_ffn_g)
    gu = jnp.einsum('btd,df->btf', xn, w_gate_up)
    g, u = jnp.split(gu, 2, axis=-1)
    return x + jnp.einsum('btf,fd->btd', jax.nn.silu(g) * u, w_down)


def setup_inputs(seed: int = 0) -> dict:
    key = jax.random.key(seed)
    ks = jax.random.split(key, 24)
    nrm = jax.random.normal
    f32 = jnp.float32

    def gain(k, shape):
        return 1.0 + 0.02 * nrm(k, shape, f32)

    i_bias = 0.1 * nrm(ks[6], (DEPTH, M_HEADS), f32)
    f_bias = jnp.linspace(3.0, 6.0, M_HEADS, dtype=f32)[None, :] + 0.1 * nrm(ks[7], (DEPTH, M_HEADS), f32)
    return {
        'x': nrm(ks[0], (BATCH, SEQ, D_MODEL), f32),
        'norm_mix_g': gain(ks[1], (DEPTH, D_MODEL)),
        'w_in': nrm(ks[2], (DEPTH, D_MODEL, IN_COLS), f32) * D_MODEL ** -0.5,
        'b_gate': 0.02 * nrm(ks[3], (DEPTH, N_BRANCH * D_MODEL), f32),
        'mlstm_conv_w': nrm(ks[4], (DEPTH, M_CONV, 2 * M_WIDTH), f32) * M_CONV ** -0.5,
        'mlstm_conv_b': 0.02 * nrm(ks[5], (DEPTH, 2 * M_WIDTH), f32),
        'mlstm_gate_b': jnp.concatenate([i_bias, f_bias], axis=-1),
        'mlstm_norm_g': gain(ks[8], (DEPTH, M_HEADS, M_HEAD_DIM)),
        'dsa_kv_norm_g': gain(ks[9], (DEPTH, S_KV_RANK)),
        'dsa_w_kv_up': nrm(ks[10], (DEPTH, S_KV_RANK, 2 * S_WIDTH), f32) * S_KV_RANK ** -0.5,
        'dsa_q_norm_g': gain(ks[11], (DEPTH, S_HEAD_DIM)),
        'dsa_k_norm_g': gain(ks[12], (DEPTH, S_HEAD_DIM)),
        'diff_q_norm_g': gain(ks[13], (DEPTH, DA_HEAD_DIM)),
        'diff_k_norm_g': gain(ks[14], (DEPTH, DA_HEAD_DIM)),
        'diff_lambda': 0.1 * nrm(ks[15], (DEPTH, 4, DA_HEAD_DIM), f32),
        'diff_out_norm_g': gain(ks[16], (DEPTH, DA_V_DIM)),
        'w_branch': nrm(ks[17], (DEPTH, N_BRANCH, BRANCH_WIDTH, D_MODEL), f32) * BRANCH_WIDTH ** -0.5,
        'w_out': nrm(ks[18], (DEPTH, D_MODEL, D_MODEL), f32) * D_MODEL ** -0.5,
        'norm_ffn_g': gain(ks[19], (DEPTH, D_MODEL)),
        'w_gate_up': nrm(ks[20], (DEPTH, D_MODEL, 2 * FF_DIM), f32) * D_MODEL ** -0.5,
        'w_down': nrm(ks[21], (DEPTH, FF_DIM, D_MODEL), f32) * FF_DIM ** -0.5,
    }


def reference(x, norm_mix_g, w_in, b_gate, mlstm_conv_w, mlstm_conv_b, mlstm_gate_b, mlstm_norm_g,
              dsa_kv_norm_g, dsa_w_kv_up, dsa_q_norm_g, dsa_k_norm_g, diff_q_norm_g, diff_k_norm_g,
              diff_lambda, diff_out_norm_g, w_branch, w_out, norm_ffn_g, w_gate_up, w_down):
    cos, sin = _rope_tables(x.shape[1], ROPE_DIM, x.dtype)
    for li in range(DEPTH):
        x = _layer(x, li, cos, sin, norm_mix_g[li], w_in[li], b_gate[li], mlstm_conv_w[li],
                   mlstm_conv_b[li], mlstm_gate_b[li], mlstm_norm_g[li], dsa_kv_norm_g[li],
                   dsa_w_kv_up[li], dsa_q_norm_g[li], dsa_k_norm_g[li], diff_q_norm_g[li],
                   diff_k_norm_g[li], diff_lambda[li], diff_out_norm_g[li], w_branch[li], w_out[li],
                   norm_ffn_g[li], w_gate_up[li], w_down[li])
    return x
```

```cpp
#include <hip/hip_runtime.h>
#include <cstdio>
#include <cstdint>

#define DI __device__ __forceinline__
#define LAS __attribute__((address_space(3)))
#define GAS __attribute__((address_space(1)))

typedef unsigned short bf16_t;
typedef short bf16x8 __attribute__((ext_vector_type(8)));
typedef float f32x4 __attribute__((ext_vector_type(4)));
typedef float f32x2 __attribute__((ext_vector_type(2)));
typedef unsigned u32x4 __attribute__((ext_vector_type(4)));
typedef unsigned u32x2 __attribute__((ext_vector_type(2)));

constexpr int BATCH = 8, SEQ = 4096, DM = 1024, DEPTH = 2;
constexpr int CB = 4;
constexpr int MC = CB * SEQ;
constexpr int NCHUNK = BATCH / CB;
constexpr int IN_COLS = 7756;
constexpr int FF = 2816;
constexpr float EPS = 1e-6f;
constexpr float LOG2E = 1.4426950408889634f;
constexpr float C2 = 0.125f * LOG2E;
constexpr int Z_MQK = 0, Z_MV = 1024, Z_MO = 1536, Z_MIF = 2048, Z_SQ = 2056, Z_CKV = 2568, Z_IQ = 2824, Z_IK = 3080, Z_IW = 3144, Z_DQ = 3148, Z_DK = 3660, Z_DV = 4172, Z_G = 4684;
constexpr int NT_IN = 19;

constexpr size_t MiB = 1u << 20;
constexpr size_t WS_CTL = 0, CTL_ZERO_BYTES = 128 * 1024;
constexpr size_t WS_COS = 1 * MiB, WS_SIN = 1 * MiB + 512 * 1024;
constexpr size_t WS_W = 2 * MiB, W_LAYER = 38 * MiB;
constexpr size_t WO_IN = 0;
constexpr size_t WO_G = WO_IN + (size_t)NT_IN * 256 * 1024 * 2;
constexpr size_t WO_KV = WO_G + (size_t)3072 * 1024 * 2;
constexpr size_t WO_BR = WO_KV + (size_t)1024 * 256 * 2;
constexpr size_t WO_OUT = WO_BR + (size_t)1024 * 1536 * 2;
constexpr size_t WO_GU = WO_OUT + (size_t)1024 * 1024 * 2;
constexpr size_t WO_D = WO_GU + (size_t)5632 * 1024 * 2;
static_assert(WO_D + (size_t)1024 * 2816 * 2 <= W_LAYER, "weights per layer");
constexpr size_t WS_ACT = WS_W + 2 * W_LAYER;
constexpr size_t WS_XN = WS_ACT;
constexpr size_t WS_QKRAW = WS_XN + 32 * MiB;
constexpr size_t WS_CKV = WS_QKRAW + 32 * MiB;
constexpr size_t WS_IQ = WS_CKV + 8 * MiB;
constexpr size_t WS_Y = WS_QKRAW;
constexpr size_t WS_QK = WS_IQ + 8 * MiB;
constexpr size_t WS_MG = WS_QK;
constexpr size_t WS_VM = WS_QK + 32 * MiB;
constexpr size_t WS_OM = WS_VM + 16 * MiB;
constexpr size_t WS_SQ = WS_OM + 16 * MiB;
constexpr size_t WS_DQ = WS_SQ + 16 * MiB;
constexpr size_t WS_DK = WS_DQ + 16 * MiB;
constexpr size_t WS_DV = WS_DK + 16 * MiB;
constexpr size_t WS_SK = WS_DV + 16 * MiB;
constexpr size_t WS_SV = WS_SK + 16 * MiB;
constexpr size_t WS_IK = WS_SV + 16 * MiB;
constexpr size_t WS_IF = WS_IK + 2 * MiB;
constexpr size_t WS_IW = WS_IF + 512 * 1024;
constexpr size_t WS_RT = WS_IW + 256 * 1024;
constexpr size_t WS_AK = WS_RT + 256 * 1024;
constexpr size_t WS_MQ = WS_AK + 256 * 1024;
constexpr size_t WS_EM = WS_MQ + 256 * 1024;
constexpr size_t WS_MASK = WS_IK + 4 * MiB;
constexpr size_t WS_HREG = WS_MASK + 8 * MiB;
constexpr size_t WS_MD = WS_HREG + 136 * MiB;
constexpr size_t WS_MC = WS_MD + 16 * MiB;
constexpr size_t WS_MN = WS_MC + 8 * MiB;
constexpr size_t WS_END = WS_MN + 1 * MiB;
static_assert(WS_EM + 256 * 1024 <= WS_MASK, "small buffers");
static_assert(WS_END <= 512 * MiB, "workspace");
constexpr int CW_BAR = 4096;
constexpr size_t WS_GAIN = 512 * 1024;

constexpr int RING_BYTES = 131072;
constexpr int LDSCTL_OFF = RING_BYTES, MISC_OFF = LDSCTL_OFF + 320;
constexpr int LDS_BYTES = 147456;
constexpr int NWAVES = 8;

DI float bf2f(unsigned v) { return __uint_as_float(v << 16); }
DI unsigned f2bf(float f) { unsigned u = __float_as_uint(f); return (u + 0x7fffu + ((u >> 16) & 1u)) >> 16; }
DI unsigned pk2(float lo, float hi) { return f2bf(lo) | (f2bf(hi) << 16); }
DI float bflo(unsigned w) { return __uint_as_float(w << 16); }
DI float bfhi(unsigned w) { return __uint_as_float(w & 0xffff0000u); }
typedef unsigned u32x2v __attribute__((ext_vector_type(2)));
DI float xor1(float v)  { return __uint_as_float((unsigned)__builtin_amdgcn_mov_dpp((int)__float_as_uint(v), 0xB1, 0xF, 0xF, true)); }
DI float xor2(float v)  { return __uint_as_float((unsigned)__builtin_amdgcn_mov_dpp((int)__float_as_uint(v), 0x4E, 0xF, 0xF, true)); }
DI float ror4(float v)  { return __uint_as_float((unsigned)__builtin_amdgcn_mov_dpp((int)__float_as_uint(v), 0x124, 0xF, 0xF, true)); }
DI float ror8(float v)  { return __uint_as_float((unsigned)__builtin_amdgcn_mov_dpp((int)__float_as_uint(v), 0x128, 0xF, 0xF, true)); }
DI float sum16x(float v) { const unsigned u = __float_as_uint(v); const auto r = __builtin_amdgcn_permlane16_swap(u, u, false, false); return __uint_as_float(r[0]) + __uint_as_float(r[1]); }
DI float sum32x(float v) { const unsigned u = __float_as_uint(v); const auto r = __builtin_amdgcn_permlane32_swap(u, u, false, false); return __uint_as_float(r[0]) + __uint_as_float(r[1]); }
DI float max16x(float v) { const unsigned u = __float_as_uint(v); const auto r = __builtin_amdgcn_permlane16_swap(u, u, false, false); return fmaxf(__uint_as_float(r[0]), __uint_as_float(r[1])); }
DI float max32x(float v) { const unsigned u = __float_as_uint(v); const auto r = __builtin_amdgcn_permlane32_swap(u, u, false, false); return fmaxf(__uint_as_float(r[0]), __uint_as_float(r[1])); }
DI float wave_sum(float v) { v += xor1(v); v += xor2(v); v += ror4(v); v += ror8(v); v = sum16x(v); return sum32x(v); }
DI float wave_max(float v) { v = fmaxf(v, xor1(v)); v = fmaxf(v, xor2(v)); v = fmaxf(v, ror4(v)); v = fmaxf(v, ror8(v)); v = max16x(v); return max32x(v); }
typedef __bf16 bf16x2e_t __attribute__((ext_vector_type(2)));
DI unsigned cvtpk_(float lo, float hi) { f32x2 v = {lo, hi}; bf16x2e_t b = __builtin_convertvector(v, bf16x2e_t); return __builtin_bit_cast(unsigned, b); }
DI float fexp2(float x) { return __builtin_amdgcn_exp2f(x); }
DI float fexp(float x) { return __builtin_amdgcn_exp2f(x * LOG2E); }
DI float frcp(float x) { return __builtin_amdgcn_rcpf(x); }
DI float sigmoidf_(float x) { return frcp(1.0f + fexp(-x)); }
#define WSYNC() do { asm volatile("s_waitcnt lgkmcnt(0)" ::: "memory"); __builtin_amdgcn_wave_barrier(); } while (0)

namespace pg8 {
constexpr int BM = 256, BK = 64, HALF = 128, HTB = HALF * BK * 2, STAGE_BYTES = 8 * HTB, NXCD = 8, WGM = 8;
__host__ __device__ __forceinline__ int lds_byte(int r, int c) { const int st = (r >> 4) * 2 + (c >> 5), rr = r & 15, cc = c & 31, ob = rr * 64 + cc * 2; return st * 1024 + (ob ^ (((ob >> 9) & 1) << 5)); }
__host__ __device__ __forceinline__ void stage_rc(int b, int& R, int& C) { const int st = b / 1024, sb = b % 1024, swz = sb ^ (((sb >> 9) & 1) << 5); R = (st >> 1) * 16 + swz / 64; C = (st & 1) * 32 + (swz % 64) / 2; }
__host__ __device__ __forceinline__ int perm32(int rho) { const int n = rho >> 4, i = rho & 15; return 8 * (i >> 2) + 4 * n + (i & 3); }
struct Unit { int pm, pn; };
struct Gemm { const bf16_t* A; const bf16_t* Bt; int M, N, K; };
struct StaticOrder {
    int nM, nN, nwg, G, c;
    __host__ __device__ void init(int M, int N, int G_, int c_) { nM = M / BM; nN = N / BM; nwg = nM * nN; G = G_; c = c_; }
    __host__ __device__ bool next(int i, Unit& u) const {
        const long L = (long)i * G + c; if (L >= nwg) return false;
        int wgid = (int)L; { const int q = nwg / NXCD, r = nwg % NXCD, xcd = wgid % NXCD, off = wgid / NXCD; wgid = (xcd < r ? xcd * (q + 1) : r * (q + 1) + (xcd - r) * q) + off; }
        const int nig = WGM * nN, gid = wgid / nig, fm = gid * WGM, gsz = (nM - fm) < WGM ? (nM - fm) : WGM;
        u.pm = fm + ((wgid % nig) % gsz); u.pn = (wgid % nig) / gsz; return true;
    }
};
template <class Epi, bool ALIGN_EPI>
__device__ __forceinline__ void gemm_phase(LAS unsigned char* lds, const Gemm g, const StaticOrder& S, const Epi& E, int tid_in) {
    int tid_ = tid_in; asm volatile("" : "+v"(tid_));
    int K_ = g.K; asm volatile("" : "+s"(K_));
    const int tid = tid_, wid = __builtin_amdgcn_readfirstlane(tid >> 6), lane = tid & 63, wr = wid >> 2, wc = wid & 3, fr = lane & 15, fq = lane >> 4;
    const int K = K_, nt = K / BK;
    unsigned voffA[2], voffB[2];
#pragma unroll
    for (int i = 0; i < 2; ++i) { int R, C; stage_rc(tid * 16 + i * 8192, R, C); const int Rb = Epi::PERM ? ((R & ~31) + perm32(R & 31)) : R;
        voffA[i] = (unsigned)(R * K + C) * 2u; voffB[i] = (unsigned)(Rb * K + C) * 2u; }
    const size_t kstep = (size_t)(BK * 2);
    const size_t hstep = (size_t)HALF * K * 2;
    const size_t tstep = 2 * hstep;
    const unsigned ldsw = (unsigned)wid * 1024u;
    const int aoff = lds_byte(wr * 64 + fr, fq * 8), boff = lds_byte(wc * 32 + fr, fq * 8);
#define PG8_SA(b, h) (((b) * 2 + (h)) * HTB)
#define PG8_SB(b, h) ((4 + (b) * 2 + (h)) * HTB)
#define PG8_STAGE(bufoff, gbase, voff) do { _Pragma("unroll") for (int _i = 0; _i < 2; ++_i) \
        __builtin_amdgcn_global_load_lds((const unsigned*)((const char*)(gbase) + (voff)[_i]), (LAS unsigned*)(lds + (bufoff) + ldsw + _i * 8192), 16, 0, 0); } while (0)
#define PG8_LDA(dst, b, h) do { _Pragma("unroll") for (int m = 0; m < 4; ++m) _Pragma("unroll") for (int k = 0; k < 2; ++k) dst[m][k] = *(const LAS bf16x8*)(lds + PG8_SA(b, h) + aoff + m * 2048 + k * 1024); } while (0)
#define PG8_LDB(dst, b, h) do { _Pragma("unroll") for (int n = 0; n < 2; ++n) _Pragma("unroll") for (int k = 0; k < 2; ++k) dst[n][k] = *(const LAS bf16x8*)(lds + PG8_SB(b, h) + boff + n * 2048 + k * 1024); } while (0)
#define PG8_MMA(ai, bj, At, Bt) do { __builtin_amdgcn_s_setprio(1); _Pragma("unroll") for (int m = 0; m < 4; ++m) _Pragma("unroll") for (int n = 0; n < 2; ++n) _Pragma("unroll") for (int k = 0; k < 2; ++k) \
        acc[ai][bj][m][n] = __builtin_amdgcn_mfma_f32_16x16x32_bf16(Bt[n][k], At[m][k], acc[ai][bj][m][n], 0, 0, 0); __builtin_amdgcn_s_setprio(0); } while (0)
#define PG8_WAIT_V(n) asm volatile("s_waitcnt vmcnt(" #n ")" ::: "memory")
#define PG8_WAIT_L(n) asm volatile("s_waitcnt lgkmcnt(" #n ")" ::: "memory")
#define PG8_BAR __builtin_amdgcn_s_barrier()
#define PG8_SCHED __builtin_amdgcn_sched_barrier(0)
    Unit cur, nxt; int ui = 0;
    if (!S.next(0, cur)) return;
    f32x4 acc[2][2][4][2];
    if constexpr (Epi::INIT) { int fr_ = fr, fq_ = fq, wr_ = wr, wc_ = wc; asm volatile("" : "+v"(fr_), "+v"(fq_), "+s"(wr_), "+s"(wc_)); E.init(acc, cur, wr_, wc_, fr_, fq_); }
    else {
#pragma unroll
    for (int a = 0; a < 2; ++a)
#pragma unroll
        for (int b = 0; b < 2; ++b)
#pragma unroll
            for (int m = 0; m < 4; ++m)
#pragma unroll
                for (int n = 0; n < 2; ++n) acc[a][b][m][n] = (f32x4){0.f, 0.f, 0.f, 0.f};
    }
    bf16x8 At[4][2], B0[2][2], B1[2][2];
    const char* cA = (const char*)g.A + (size_t)cur.pm * tstep; const char* cB = (const char*)g.Bt + (size_t)cur.pn * tstep;
    PG8_STAGE(PG8_SB(0, 0), cB, voffB); PG8_STAGE(PG8_SB(0, 1), cB + hstep, voffB); PG8_STAGE(PG8_SA(0, 0), cA, voffA); PG8_STAGE(PG8_SA(0, 1), cA + hstep, voffA);
    if (wr == 1) PG8_BAR;
    PG8_WAIT_V(2); PG8_BAR;
    PG8_STAGE(PG8_SB(1, 0), cB + kstep, voffB); PG8_STAGE(PG8_SA(1, 0), cA + kstep, voffA); PG8_STAGE(PG8_SB(1, 1), cB + hstep + kstep, voffB);
    PG8_WAIT_V(6); PG8_BAR;
    for (;;) {
        const bool has_next = S.next(ui + 1, nxt);
        const char* nA = has_next ? (const char*)g.A + (size_t)nxt.pm * tstep : cA; const char* nB = has_next ? (const char*)g.Bt + (size_t)nxt.pn * tstep : cB;
        for (int t = 0; t < nt; t += 2) {
            const bool last = (t == nt - 2);
            const char* a1 = cA + (size_t)(t + 1) * kstep;
            const char* a2 = last ? nA : cA + (size_t)(t + 2) * kstep; const char* b2 = last ? nB : cB + (size_t)(t + 2) * kstep;
            const char* a3 = a2 + kstep; const char* b3 = b2 + kstep;
            if constexpr (Epi::MIDK) { if (t == 8 || t == 16) { int fr_ = fr, fq_ = fq, wr_ = wr, wc_ = wc; asm volatile("" : "+v"(fr_), "+v"(fq_), "+s"(wr_), "+s"(wc_)); E.mid(acc, cur, t, wr_, wc_, fr_, fq_); } }
            PG8_LDB(B0, 0, 0); PG8_LDB(B1, 0, 1); PG8_SCHED; PG8_LDA(At, 0, 0); PG8_STAGE(PG8_SA(1, 1), a1 + hstep, voffA);
            PG8_WAIT_V(8); PG8_WAIT_L(0); PG8_BAR; PG8_MMA(0, 0, At, B0); PG8_MMA(0, 1, At, B1); PG8_BAR; PG8_SCHED;
            PG8_LDA(At, 0, 1); PG8_STAGE(PG8_SB(0, 0), b2, voffB); PG8_STAGE(PG8_SB(0, 1), b2 + hstep, voffB); PG8_STAGE(PG8_SA(0, 0), a2, voffA);
            PG8_WAIT_V(8); PG8_WAIT_L(0); PG8_BAR; PG8_MMA(1, 0, At, B0); PG8_MMA(1, 1, At, B1); PG8_BAR; PG8_SCHED;
            PG8_LDB(B0, 1, 0); PG8_LDB(B1, 1, 1); PG8_SCHED; PG8_LDA(At, 1, 0); PG8_STAGE(PG8_SA(0, 1), a2 + hstep, voffA);
            PG8_WAIT_V(8); PG8_WAIT_L(0); PG8_BAR; PG8_MMA(0, 0, At, B0); PG8_MMA(0, 1, At, B1); PG8_BAR; PG8_SCHED;
            PG8_LDA(At, 1, 1); PG8_STAGE(PG8_SB(1, 0), b3, voffB); PG8_STAGE(PG8_SB(1, 1), b3 + hstep, voffB); PG8_STAGE(PG8_SA(1, 0), a3, voffA);
            PG8_WAIT_V(8); PG8_WAIT_L(0); PG8_BAR; PG8_MMA(1, 0, At, B0); PG8_MMA(1, 1, At, B1); PG8_BAR; PG8_SCHED;
        }
        if constexpr (ALIGN_EPI) { if (wr == 0) PG8_BAR; }
        { int fr_ = fr, fq_ = fq, wr_ = wr, wc_ = wc; asm volatile("" : "+v"(fr_), "+v"(fq_), "+s"(wr_), "+s"(wc_)); E(acc, cur, wr_, wc_, fr_, fq_); }
        if (!has_next) break;
        if constexpr (Epi::INIT) { int fr_ = fr, fq_ = fq, wr_ = wr, wc_ = wc; asm volatile("" : "+v"(fr_), "+v"(fq_), "+s"(wr_), "+s"(wc_)); E.init(acc, nxt, wr_, wc_, fr_, fq_); }
        else {
#pragma unroll
        for (int a = 0; a < 2; ++a)
#pragma unroll
            for (int b = 0; b < 2; ++b)
#pragma unroll
                for (int m = 0; m < 4; ++m)
#pragma unroll
                    for (int n = 0; n < 2; ++n) acc[a][b][m][n] = (f32x4){0.f, 0.f, 0.f, 0.f};
        }
        cur = nxt; cA = nA; cB = nB; ++ui;
        if constexpr (ALIGN_EPI) { if (wr == 1) PG8_BAR; }
    }
    PG8_WAIT_V(0);
    if constexpr (!ALIGN_EPI) { if (wr == 0) PG8_BAR; }
    PG8_BAR;
#undef PG8_SA
#undef PG8_SB
#undef PG8_STAGE
#undef PG8_LDA
#undef PG8_LDB
#undef PG8_MMA
#undef PG8_WAIT_V
#undef PG8_WAIT_L
#undef PG8_BAR
#undef PG8_SCHED
}
}

#define XB_TMO      128
#define XB_XCNT(j)  (256  + 64 * (j))
#define XB_XSUB(j)  (1280 + 64 * (j))
#define XB_XGEN(j)  (2304 + 64 * (j))
#define XB_TOP      3328
#define XB_TOPGEN   3392
#define XCD_BAR_WORDS 3456
#define XB_SPIN_CAP (1u << 24)
DI unsigned xb_ld(unsigned* p)              { return __hip_atomic_load(p, __ATOMIC_RELAXED, __HIP_MEMORY_SCOPE_AGENT); }
DI unsigned xb_add(unsigned* p, unsigned v) { return __hip_atomic_fetch_add(p, v, __ATOMIC_RELAXED, __HIP_MEMORY_SCOPE_AGENT); }
DI unsigned xb_xcc_id() { return (unsigned)__builtin_amdgcn_s_getreg((3 << 11) | 20) & 0xFu; }
#define XB_SPIN(cond, bar) do { unsigned _sp = 0; while (cond) { __builtin_amdgcn_s_sleep(1); \
    if ((++_sp & 255u) == 0u) { if (xb_ld(&(bar)[XB_TMO])) break; if (_sp > XB_SPIN_CAP) { atomicAdd(&(bar)[XB_TMO], 1u); break; } } } } while (0)
struct XcdBarrier { unsigned* bar; unsigned x; volatile LAS unsigned* st; };
DI XcdBarrier xcd_barrier_post(unsigned* bar, volatile LAS unsigned* st) {
    XcdBarrier b; b.bar = bar; b.x = xb_xcc_id(); b.st = st;
    if (threadIdx.x == 0) (void)xb_add(&bar[XB_XCNT(b.x)], 1u);
    return b;
}
DI void xcd_barrier_complete(unsigned* bar, unsigned x, unsigned& nloc, unsigned& nx) {
    const unsigned G = gridDim.x * gridDim.y * gridDim.z;
    unsigned sum, cnt, mine, sp = 0u;
    for (;;) {
        sum = 0u; cnt = 0u; mine = 0u;
#pragma unroll
        for (unsigned j = 0; j < 16; ++j) { const unsigned c = xb_ld(&bar[XB_XCNT(j)]); sum += c; cnt += (c > 0u) ? 1u : 0u; mine = (j == x) ? c : mine; }
        if (sum == G) break;
        __builtin_amdgcn_s_sleep(1);
        if ((++sp & 255u) == 0u) { if (xb_ld(&bar[XB_TMO])) break; if (sp > XB_SPIN_CAP) { atomicAdd(&bar[XB_TMO], 1u); break; } }
    }
    nloc = mine > 0u ? mine : 1u; nx = cnt > 0u ? cnt : 1u;
}
DI void xcd_barrier(const XcdBarrier& b_in) {
    XcdBarrier b = b_in; { unsigned x_ = b.x; asm volatile("" : "+s"(x_)); b.x = x_; }
    asm volatile("s_waitcnt vmcnt(0)" ::: "memory");
    __syncthreads();
    if (threadIdx.x == 0) {
        unsigned* bar = b.bar;
        __builtin_amdgcn_s_waitcnt(0);
        unsigned nloc = b.st[0], nx = b.st[1];
        if (nloc == 0u) { xcd_barrier_complete(bar, b.x, nloc, nx); b.st[0] = nloc; b.st[1] = nx; }
        const unsigned old = xb_add(&bar[XB_XSUB(b.x)], 1u);
        const unsigned gen = old / nloc;
        if (old + 1u == (gen + 1u) * nloc) {
            __builtin_amdgcn_fence(__ATOMIC_RELEASE, "agent");
            asm volatile("s_waitcnt vmcnt(0)" ::: "memory");
            const unsigned og = xb_add(&bar[XB_TOP], 1u);
            const unsigned tg = og / nx;
            if (og + 1u == (tg + 1u) * nx) xb_add(&bar[XB_TOPGEN], 1u);
            else XB_SPIN(xb_ld(&bar[XB_TOPGEN]) == tg, bar);
            __builtin_amdgcn_fence(__ATOMIC_ACQUIRE, "agent");
            xb_add(&bar[XB_XGEN(b.x)], 1u);
            asm volatile("s_waitcnt vmcnt(0)" ::: "memory");
        } else {
            XB_SPIN(xb_ld(&bar[XB_XGEN(b.x)]) == gen, bar);
            __builtin_amdgcn_fence(__ATOMIC_ACQUIRE, "agent");
            asm volatile("s_waitcnt vmcnt(0)" ::: "memory");
        }
    }
    __syncthreads();
}

struct Args { const float* in[21]; float* out; unsigned char* ws; int it_lo, it_hi, ph_lo, ph_hi; };
enum { I_X = 0, I_NMG, I_WIN, I_BG, I_CW, I_CB, I_GB, I_MNG, I_KVNG, I_WKV, I_SQG, I_SKG, I_DQG, I_DKG, I_LAM, I_DOG, I_WBR, I_WOUT, I_NFG, I_WGU, I_WD };

struct Frame {
    LAS unsigned char* lds;
    unsigned char* ws;
    int tid, lane, wave, G, bid;
    int wave0;
    DI void refresh() {
        int l_; asm volatile("v_mbcnt_lo_u32_b32 %0, -1, 0\n\tv_mbcnt_hi_u32_b32 %0, -1, %0" : "=v"(l_));
        unsigned char* w_ = ws; int g_ = G, b_ = bid, wv_ = wave0; asm volatile("" : "+s"(w_), "+s"(g_), "+s"(b_), "+s"(wv_));
        ws = w_; G = g_; bid = b_; lane = l_; wave = wv_; tid = wv_ * 64 + l_; }
};

DI int map_in(int n) {
    const int pn = n >> 8, p = n & 255, bj = p >> 7, wcq = p & 127, wc = wcq >> 5, q = wcq & 31;
    const int hd = 32 * bj + q;
    switch (pn) {
        case 0: case 1: case 2: case 3: return Z_MQK + n;
        case 4: case 5: return Z_MV + (n - 4 * 256);
        case 6: case 7: return Z_MO + (n - 6 * 256);
        case 8: case 9: return Z_SQ + (4 * (pn - 8) + wc) * 64 + hd;
        case 10: return Z_CKV + p;
        case 11: return Z_IQ + wc * 64 + hd;
        case 12: case 13: return Z_DQ + (4 * (pn - 12) + wc) * 64 + hd;
        case 14: case 15: return Z_DK + (4 * (pn - 14) + wc) * 64 + hd;
        case 16: case 17: return Z_DV + (n - 16 * 256);
        default:
            if (wc == 0) return Z_IK + hd;
            if (wc == 1 && bj == 0) { if (q < 8) return Z_MIF + q; if (q < 12) return Z_IW + (q - 8); }
            return -1;
    }
}
DI int map_kv(int n) {
    const int pn = n >> 8, p = n & 255, bj = p >> 7, wcq = p & 127, wc = wcq >> 5, q = wcq & 31;
    if (pn < 2) return (4 * pn + wc) * 64 + 32 * bj + q;
    return n;
}
DI int map_gu(int n) {
    const int pn = n >> 8, p = n & 255;
    return (p >> 7) * FF + 128 * pn + (p & 127);
}
template <int MAP>
DI void transpose_item(const float* W, int ldw, int cbase, const float* kscale, bf16_t* WT, int ldo, int koff, int nblk, LAS float* scr, int item, int lane) {
    const int kb = item / nblk, nb = item % nblk, k0 = 64 * kb, n0 = 32 * nb;
    const int n = n0 + (lane & 31);
    int src;
    if (MAP == 0) src = n; else if (MAP == 1) src = map_in(n); else if (MAP == 2) src = map_kv(n); else src = map_gu(n);
    float tv_[32];
    const int srcc = src >= 0 ? src : 0;
#pragma unroll
    for (int i = 0; i < 32; ++i) tv_[i] = W[(size_t)(k0 + 2 * i + (lane >> 5)) * ldw + cbase + srcc];
#pragma unroll
    for (int i = 0; i < 32; ++i) { const int kk = 2 * i + (lane >> 5);
        float v = src >= 0 ? tv_[i] : 0.f;
        if (kscale) v *= kscale[k0 + kk];
        scr[kk * 33 + (lane & 31)] = v; }
    WSYNC();
    const int c = lane & 7;
#pragma unroll
    for (int j = 0; j < 4; ++j) { const int nn = (lane >> 3) + 8 * j; const LAS float* s = scr + (8 * c) * 33 + nn;
        u32x4 o; o.x = pk2(s[0 * 33], s[1 * 33]); o.y = pk2(s[2 * 33], s[3 * 33]); o.z = pk2(s[4 * 33], s[5 * 33]); o.w = pk2(s[6 * 33], s[7 * 33]);
        *(u32x4*)(WT + (size_t)(n0 + nn) * ldo + koff + k0 + 8 * c) = o; }
    WSYNC();
}
__device__ const float INVF[32] = {1.000000000e+00f, 7.498942018e-01f, 5.623413324e-01f, 4.216965139e-01f, 3.162277639e-01f, 2.371373922e-01f, 1.778279394e-01f, 1.333521456e-01f,
    1.000000015e-01f, 7.498941571e-02f, 5.623412877e-02f, 4.216964915e-02f, 3.162277862e-02f, 2.371373586e-02f, 1.778279431e-02f, 1.333521493e-02f,
    9.999999776e-03f, 7.498942316e-03f, 5.623413250e-03f, 4.216964822e-03f, 3.162277862e-03f, 2.371373819e-03f, 1.778279431e-03f, 1.333521446e-03f,
    1.000000047e-03f, 7.498941850e-04f, 5.623413017e-04f, 4.216965463e-04f, 3.162277862e-04f, 2.371373848e-04f, 1.778279402e-04f, 1.333521504e-04f};
DI void sincos_acc(float angf, float& c, float& s) {
    const double x = (double)angf;
    const double kd = __builtin_rint(x * 0.63661977236758134308);
    const double r = (x - kd * 1.5707963267948965580) - kd * 6.1232339957367658860e-17;
    const double r2 = r * r;
    double sp = -1.0 / 39916800.0; sp = sp * r2 + 1.0 / 362880.0; sp = sp * r2 - 1.0 / 5040.0; sp = sp * r2 + 1.0 / 120.0; sp = sp * r2 - 1.0 / 6.0; sp = sp * r2 + 1.0; sp *= r;
    double cp = 1.0 / 479001600.0; cp = cp * r2 - 1.0 / 3628800.0; cp = cp * r2 + 1.0 / 40320.0; cp = cp * r2 - 1.0 / 720.0; cp = cp * r2 + 1.0 / 24.0; cp = cp * r2 - 0.5; cp = cp * r2 + 1.0;
    const int k = (int)kd & 3;
    double cc, ss;
    if (k == 0) { cc = cp; ss = sp; } else if (k == 1) { cc = -sp; ss = cp; } else if (k == 2) { cc = -cp; ss = -sp; } else { cc = sp; ss = -cp; }
    c = (float)cc; s = (float)ss;
}
DI void phase_prologue(Frame& F, const Args& a) {
    F.refresh();
    LAS float* scr = (LAS float*)(F.lds + F.wave * 16384);
    const int gw = F.bid * NWAVES + F.wave, NGW = F.G * NWAVES;
    float* COS = (float*)(F.ws + WS_COS); float* SIN = (float*)(F.ws + WS_SIN);
    for (int i = gw * 64 + F.lane; i < SEQ * 32; i += NGW * 64) { const int t = i >> 5, f = i & 31; float c, s; sincos_acc((float)t * INVF[f], c, s); COS[i] = c; SIN[i] = s; }
    if (gw == 0) { float* GN = (float*)(F.ws + WS_GAIN);
        for (int l = 0; l < DEPTH; ++l) { GN[(l * 4 + 0) * 64 + F.lane] = a.in[I_SQG][l * 64 + F.lane]; GN[(l * 4 + 1) * 64 + F.lane] = a.in[I_DQG][l * 64 + F.lane];
            GN[(l * 4 + 2) * 64 + F.lane] = a.in[I_DKG][l * 64 + F.lane]; GN[(l * 4 + 3) * 64 + F.lane] = a.in[I_SKG][l * 64 + F.lane]; } }
    for (int l = 0; l < DEPTH; ++l) {
        unsigned char* wl = F.ws + WS_W + (size_t)l * W_LAYER;
        const float* w_in = a.in[I_WIN] + (size_t)l * DM * IN_COLS;
        { const int nblk = NT_IN * 256 / 32, nit = (DM / 64) * nblk;
          for (int it = gw; it < nit; it += NGW) transpose_item<1>(w_in, IN_COLS, 0, nullptr, (bf16_t*)(wl + WO_IN), DM, 0, nblk, scr, it, F.lane); }
        { const int nblk = 3072 / 32, nit = (DM / 64) * nblk;
          for (int it = gw; it < nit; it += NGW) transpose_item<0>(w_in, IN_COLS, Z_G, nullptr, (bf16_t*)(wl + WO_G), DM, 0, nblk, scr, it, F.lane); }
        { const int nblk = 1024 / 32, nit = (256 / 64) * nblk;
          for (int it = gw; it < nit; it += NGW) transpose_item<2>(a.in[I_WKV] + (size_t)l * 256 * 1024, 1024, 0, a.in[I_KVNG] + l * 256, (bf16_t*)(wl + WO_KV), 256, 0, nblk, scr, it, F.lane); }
        for (int b = 0; b < 3; ++b) { const int nblk = 1024 / 32, nit = (512 / 64) * nblk;
          for (int it = gw; it < nit; it += NGW) transpose_item<0>(a.in[I_WBR] + ((size_t)l * 3 + b) * 512 * 1024, 1024, 0, nullptr, (bf16_t*)(wl + WO_BR), 1536, b * 512, nblk, scr, it, F.lane); }
        { const int nblk = 1024 / 32, nit = (1024 / 64) * nblk;
          for (int it = gw; it < nit; it += NGW) transpose_item<0>(a.in[I_WOUT] + (size_t)l * 1024 * 1024, 1024, 0, nullptr, (bf16_t*)(wl + WO_OUT), 1024, 0, nblk, scr, it, F.lane); }
        { const int nblk = 5632 / 32, nit = (1024 / 64) * nblk;
          for (int it = gw; it < nit; it += NGW) transpose_item<3>(a.in[I_WGU] + (size_t)l * 1024 * 5632, 5632, 0, nullptr, (bf16_t*)(wl + WO_GU), 1024, 0, nblk, scr, it, F.lane); }
        { const int nblk = 1024 / 32, nit = (2816 / 64) * nblk;
          for (int it = gw; it < nit; it += NGW) transpose_item<0>(a.in[I_WD] + (size_t)l * 2816 * 1024, 1024, 0, nullptr, (bf16_t*)(wl + WO_D), 2816, 0, nblk, scr, it, F.lane); }
    }
}

DI void phase_rmsnorm(Frame& F, const float* x, const float* gain, bf16_t* out) {
    F.refresh();
    const int gw = F.bid * NWAVES + F.wave, NGW = F.G * NWAVES;
    f32x4 gv[4];
#pragma unroll
    for (int j = 0; j < 4; ++j) gv[j] = *(const f32x4*)(gain + 4 * F.lane + 256 * j);
    for (int m = gw; m < MC; m += NGW) {
        const f32x4* xr = (const f32x4*)(x + (size_t)m * DM) + F.lane;
        f32x4 v[4]; float s = 0.f;
#pragma unroll
        for (int j = 0; j < 4; ++j) { v[j] = xr[64 * j]; s += (v[j].x * v[j].x + v[j].y * v[j].y) + (v[j].z * v[j].z + v[j].w * v[j].w); }
        const float r = 1.0f / sqrtf(wave_sum(s) * (1.f / DM) + EPS);
        u32x2* o8 = (u32x2*)(out + (size_t)m * DM) + F.lane;
#pragma unroll
        for (int j = 0; j < 4; ++j) { u32x2 w; w.x = pk2(v[j].x * r * gv[j].x, v[j].y * r * gv[j].y); w.y = pk2(v[j].z * r * gv[j].z, v[j].w * r * gv[j].w); o8[64 * j] = w; }
    }
}
DI float log_sigmoid(float x) {
    const float ax = fabsf(x), y = fexp(-ax);
    float l1p;
    if (y < 0.06f) l1p = y * (1.f - y * (0.5f - y * (0.33333333f - y * (0.25f - y * 0.2f))));
    else l1p = __builtin_amdgcn_logf(1.f + y) * 0.69314718056f;
    return fminf(x, 0.f) - l1p;
}
DI void phase_token(Frame& F, const Args& a, int l, const int probe) {
    F.refresh();
    const int gw0 = F.bid * NWAVES + F.wave, NGW = F.G * NWAVES, NSC = CB * 4, NCV = NGW - NSC;
    const bool scanw = (F.wave == NWAVES - 1) && (F.bid < NSC);
    const int gw = scanw ? NCV : gw0 - ((gw0 >> 3) < NSC ? (gw0 >> 3) : NSC);
    if (!scanw) { if (probe != 2) {
    const bf16_t* QKRAW = (const bf16_t*)(F.ws + WS_QKRAW); bf16_t* QK = (bf16_t*)(F.ws + WS_QK);
    const bf16_t* CKV = (const bf16_t*)(F.ws + WS_CKV); float* RT = (float*)(F.ws + WS_RT);
    const float* cw = a.in[I_CW] + (size_t)l * 4 * 1024; const float* cb = a.in[I_CB] + (size_t)l * 1024;
    const int c0 = F.lane * 16;
    float w[4][16], bs[16];
#pragma unroll
    for (int j = 0; j < 4; ++j)
#pragma unroll
        for (int i = 0; i < 16; ++i) w[j][i] = cw[j * 1024 + c0 + i];
#pragma unroll
    for (int i = 0; i < 16; ++i) bs[i] = cb[c0 + i];
    const float ksc = (c0 >= 512) ? 0.08838834764831845f : 1.0f;
    for (int m = gw; m < MC; m += NCV) {
        const int t = m & (SEQ - 1);
        float accv[16];
#pragma unroll
        for (int i = 0; i < 16; ++i) accv[i] = bs[i];
        u32x4 tv[4][2];
#pragma unroll
        for (int j = 0; j < 4; ++j) { const int tt = t - 3 + j; const u32x4* p = (const u32x4*)(QKRAW + (size_t)(tt >= 0 ? m - 3 + j : m) * 1024 + c0); tv[j][0] = p[0]; tv[j][1] = p[1]; }
        const u32x2 ckv4 = *(const u32x2*)(CKV + (size_t)m * 256 + 4 * F.lane);
#pragma unroll
        for (int j = 0; j < 4; ++j) { const float on = (t - 3 + j >= 0) ? 1.f : 0.f;
            const unsigned ww[8] = {tv[j][0].x, tv[j][0].y, tv[j][0].z, tv[j][0].w, tv[j][1].x, tv[j][1].y, tv[j][1].z, tv[j][1].w};
#pragma unroll
            for (int i = 0; i < 8; ++i) { accv[2 * i] += on * w[j][2 * i] * bflo(ww[i]); accv[2 * i + 1] += on * w[j][2 * i + 1] * bfhi(ww[i]); } }
        unsigned o[8];
#pragma unroll
        for (int i = 0; i < 8; ++i) { const float x0 = accv[2 * i], x1 = accv[2 * i + 1]; o[i] = pk2(x0 * sigmoidf_(x0) * ksc, x1 * sigmoidf_(x1) * ksc); }
        u32x4* q = (u32x4*)(QK + (size_t)m * 1024 + c0); q[0] = (u32x4){o[0], o[1], o[2], o[3]}; q[1] = (u32x4){o[4], o[5], o[6], o[7]};
        { const u32x2 v = ckv4; const float a0 = bflo(v.x), a1 = bfhi(v.x), a2 = bflo(v.y), a3 = bfhi(v.y);
          const float ss = wave_sum((a0 * a0 + a1 * a1) + (a2 * a2 + a3 * a3)); if (F.lane == 0) RT[m] = 1.0f / sqrtf(ss * (1.f / 256.f) + EPS); }
    }
    } } else if (probe != 1) {
        const int sq = F.bid, b = sq >> 2, h = sq & 3, lane = F.lane; const float* IFb = (const float*)(F.ws + WS_IF) + (size_t)b * SEQ * 8;
        float* AK = (float*)(F.ws + WS_AK) + (size_t)sq * SEQ; float* MQ = (float*)(F.ws + WS_MQ) + (size_t)sq * SEQ; float* EM = (float*)(F.ws + WS_EM) + (size_t)sq * SEQ;
        LAS float* X0 = (LAS float*)F.lds; LAS float* X1 = X0 + 4160; LAS float* X2 = X1 + 4160;
#pragma unroll 1
        for (int c = 0; c < 4; ++c) { float fv[16], iv[16];
#pragma unroll
            for (int kk = 0; kk < 16; ++kk) { const size_t t = (size_t)64 * (16 * c + kk) + lane; fv[kk] = *(const GAS float*)(IFb + t * 8 + 4 + h); iv[kk] = *(const GAS float*)(IFb + t * 8 + h); }
#pragma unroll
            for (int kk = 0; kk < 16; ++kk) { const int t = 64 * (16 * c + kk) + lane; X0[t + (t >> 6)] = fv[kk]; X1[t + (t >> 6)] = iv[kk]; } }
        WSYNC();
        const int tb = 65 * lane;
        double sum = 0.0;
#pragma unroll 8
        for (int j = 0; j < 64; ++j) { const float lf = log_sigmoid(X0[tb + j]); X0[tb + j] = lf; sum += (double)lf; }
        double inc = sum;
#pragma unroll
        for (int o = 1; o < 64; o <<= 1) { const double y = __shfl_up(inc, o); if (lane >= o) inc += y; }
        double bb = inc - sum; float mx = -INFINITY;
#pragma unroll 8
        for (int j = 0; j < 64; ++j) { bb += (double)X0[tb + j]; const float av = (float)((double)X1[tb + j] - bb); X1[tb + j] = av; X0[tb + j] = (float)bb; mx = fmaxf(mx, av); }
        float minc = mx;
#pragma unroll
        for (int o = 1; o < 64; o <<= 1) { const float y = __shfl_up(minc, o); if (lane >= o) minc = fmaxf(minc, y); }
        float mrun = __shfl_up(minc, 1); if (lane == 0) mrun = -INFINITY;
#pragma unroll 8
        for (int j = 0; j < 64; ++j) { mrun = fmaxf(mrun, X1[tb + j]); X2[tb + j] = mrun; X0[tb + j] = fexp(-(X0[tb + j] + mrun)); }
        WSYNC();
#pragma unroll 8
        for (int k = 0; k < 64; ++k) { const int t = 64 * k + lane, ix = t + k; AK[t] = X1[ix]; MQ[t] = X2[ix]; EM[t] = X0[ix]; }
    }
}

DI void store8(bf16_t* p, f32x4 v0, f32x4 v1) { u32x4 w; w.x = cvtpk_(v0[0], v0[1]); w.y = cvtpk_(v0[2], v0[3]); w.z = cvtpk_(v1[0], v1[1]); w.w = cvtpk_(v1[2], v1[3]); *(u32x4*)p = w; }
DI void head_norm_rope(f32x4 (&x)[2][2], bool norm, const f32x4 (&gn)[2][2], const float* cosr, const float* sinr, int fq, float scale) {
    if (norm) {
        float ss = 0.f;
#pragma unroll
        for (int bj = 0; bj < 2; ++bj)
#pragma unroll
            for (int n = 0; n < 2; ++n) ss += (x[bj][n][0] * x[bj][n][0] + x[bj][n][1] * x[bj][n][1]) + (x[bj][n][2] * x[bj][n][2] + x[bj][n][3] * x[bj][n][3]);
        ss = sum16x(ss); ss = sum32x(ss);
        const float r = 1.0f / sqrtf(ss * (1.f / 64.f) + EPS);
#pragma unroll
        for (int bj = 0; bj < 2; ++bj)
#pragma unroll
            for (int n = 0; n < 2; ++n) x[bj][n] = x[bj][n] * r * gn[bj][n];
    }
#pragma unroll
    for (int n = 0; n < 2; ++n) { const f32x4 c = *(const f32x4*)(cosr + 8 * fq + 4 * n), s = *(const f32x4*)(sinr + 8 * fq + 4 * n);
        const f32x4 x1 = x[0][n], x2 = x[1][n]; x[0][n] = (x1 * c - x2 * s) * scale; x[1][n] = (x1 * s + x2 * c) * scale; }
}
DI void head_norm_rope_cs(f32x4 (&x)[2][2], bool norm, const f32x4 (&gn)[2][2], const f32x4 (&c)[2], const f32x4 (&sn)[2], float scale) {
    if (norm) {
        float ss = 0.f;
#pragma unroll
        for (int bj = 0; bj < 2; ++bj)
#pragma unroll
            for (int n = 0; n < 2; ++n) ss += (x[bj][n][0] * x[bj][n][0] + x[bj][n][1] * x[bj][n][1]) + (x[bj][n][2] * x[bj][n][2] + x[bj][n][3] * x[bj][n][3]);
        ss = sum16x(ss); ss = sum32x(ss);
        const float r = 1.0f / sqrtf(ss * (1.f / 64.f) + EPS);
#pragma unroll
        for (int bj = 0; bj < 2; ++bj)
#pragma unroll
            for (int n = 0; n < 2; ++n) x[bj][n] = x[bj][n] * r * gn[bj][n];
    }
#pragma unroll
    for (int n = 0; n < 2; ++n) { const f32x4 x1 = x[0][n], x2 = x[1][n]; x[0][n] = (x1 * c[n] - x2 * sn[n]) * scale; x[1][n] = (x1 * sn[n] + x2 * c[n]) * scale; }
}
struct EpiInProj {
    static constexpr bool PERM = true, MIDK = false, INIT = false;
    unsigned char* ws; const float* gate_b; int layer;
    DI void operator()(const f32x4 (&acc)[2][2][4][2], const pg8::Unit& u, int wr, int wc, int fr, int fq) const {
        const int pn = u.pn; const int rowb = u.pm * 256 + wr * 64 + fr;
        if (pn < 8 || pn == 10 || pn == 16 || pn == 17) {
            size_t doff; int ldc, cb; bool sg = false;
            if (pn < 4) { doff = WS_QKRAW; ldc = 1024; cb = pn * 256; }
            else if (pn < 6) { doff = WS_VM; ldc = 512; cb = (pn - 4) * 256; }
            else if (pn < 8) { doff = WS_OM; ldc = 512; cb = (pn - 6) * 256; sg = true; }
            else if (pn == 10) { doff = WS_CKV; ldc = 256; cb = 0; }
            else { doff = WS_DV; ldc = 512; cb = (pn - 16) * 256; }
            bf16_t* dst = (bf16_t*)(ws + doff);
#pragma unroll
            for (int ai = 0; ai < 2; ++ai)
#pragma unroll
                for (int m = 0; m < 4; ++m) { bf16_t* rowp = dst + (size_t)(rowb + ai * 128 + m * 16) * ldc + cb + wc * 32 + 8 * fq;
#pragma unroll
                    for (int bj = 0; bj < 2; ++bj) { f32x4 v0 = acc[ai][bj][m][0], v1 = acc[ai][bj][m][1];
                        if (sg) {
#pragma unroll
                            for (int j = 0; j < 4; ++j) { v0[j] = sigmoidf_(v0[j]); v1[j] = sigmoidf_(v1[j]); } }
                        store8(rowp + bj * 128, v0, v1); } }
        } else if (pn == 18) {
            const float* COS = (const float*)(ws + WS_COS); const float* SIN = (const float*)(ws + WS_SIN);
            if (wc == 0) {
                bf16_t* dst = (bf16_t*)(ws + WS_IK); f32x4 gn[2][2];
#pragma unroll
                for (int bj = 0; bj < 2; ++bj)
#pragma unroll
                    for (int n = 0; n < 2; ++n) gn[bj][n] = (f32x4){1.f, 1.f, 1.f, 1.f};
#pragma unroll
                for (int ai = 0; ai < 2; ++ai)
#pragma unroll
                    for (int m = 0; m < 4; ++m) { const int row = rowb + ai * 128 + m * 16, t = row & (SEQ - 1);
                        f32x4 x[2][2] = {{acc[ai][0][m][0], acc[ai][0][m][1]}, {acc[ai][1][m][0], acc[ai][1][m][1]}};
                        head_norm_rope(x, false, gn, COS + t * 32, SIN + t * 32, fq, 1.0f);
#pragma unroll
                        for (int bj = 0; bj < 2; ++bj) store8(dst + (size_t)row * 64 + 32 * bj + 8 * fq, x[bj][0], x[bj][1]);
                        asm volatile("" ::: "memory"); }
            } else if (wc == 1) {
                float* IFp = (float*)(ws + WS_IF); float* IWp = (float*)(ws + WS_IW);
#pragma unroll
                for (int ai = 0; ai < 2; ++ai)
#pragma unroll
                    for (int m = 0; m < 4; ++m) { const int row = rowb + ai * 128 + m * 16;
                        if (fq == 0) { *(f32x4*)(IFp + (size_t)row * 8) = acc[ai][0][m][0] + *(const f32x4*)gate_b; *(f32x4*)(IFp + (size_t)row * 8 + 4) = acc[ai][0][m][1] + *(const f32x4*)(gate_b + 4); }
                        else if (fq == 1) { *(f32x4*)(IWp + (size_t)row * 4) = acc[ai][0][m][0] * 0.0625f; } }
            }
        } else {
            const float* COS = (const float*)(ws + WS_COS); const float* SIN = (const float*)(ws + WS_SIN);
            size_t doff; int gi, pn0; float scale; bool norm = true; int ldc = 512;
            if (pn < 10) { doff = WS_SQ; gi = 0; pn0 = 8; scale = C2; }
            else if (pn == 11) { doff = WS_IQ; gi = 0; pn0 = 11; scale = 1.f; norm = false; ldc = 256; }
            else if (pn < 14) { doff = WS_DQ; gi = 1; pn0 = 12; scale = C2; }
            else { doff = WS_DK; gi = 2; pn0 = 14; scale = 1.f; }
            bf16_t* dst = (bf16_t*)(ws + doff); const float* g = (const float*)(ws + WS_GAIN) + (layer * 4 + gi) * 64;
            f32x4 gn[2][2];
#pragma unroll
            for (int bj = 0; bj < 2; ++bj)
#pragma unroll
                for (int n = 0; n < 2; ++n) gn[bj][n] = *(const f32x4*)(g + 32 * bj + 8 * fq + 4 * n);
            const int head = 4 * (pn - pn0) + wc;
#pragma unroll
            for (int ai = 0; ai < 2; ++ai)
#pragma unroll
              for (int mp = 0; mp < 4; mp += 2) {
                f32x4 cc[2][2], sn[2][2];
#pragma unroll
                for (int m = 0; m < 2; ++m) { const int t = (rowb + ai * 128 + (mp + m) * 16) & (SEQ - 1);
#pragma unroll
                    for (int n = 0; n < 2; ++n) { cc[m][n] = *(const GAS f32x4*)(COS + t * 32 + 8 * fq + 4 * n); sn[m][n] = *(const GAS f32x4*)(SIN + t * 32 + 8 * fq + 4 * n); } }
#pragma unroll
                for (int m = 0; m < 2; ++m) { const int row = rowb + ai * 128 + (mp + m) * 16;
                    f32x4 x[2][2] = {{acc[ai][0][mp + m][0], acc[ai][0][mp + m][1]}, {acc[ai][1][mp + m][0], acc[ai][1][mp + m][1]}};
                    head_norm_rope_cs(x, norm, gn, cc[m], sn[m], scale);
#pragma unroll
                    for (int bj = 0; bj < 2; ++bj) store8(dst + (size_t)row * ldc + head * 64 + 32 * bj + 8 * fq, x[bj][0], x[bj][1]); }
                asm volatile("" ::: "memory");
              }
        }
    }
};
struct EpiKV {
    static constexpr bool PERM = true, MIDK = false, INIT = false;
    unsigned char* ws; int layer;
    DI void operator()(const f32x4 (&acc)[2][2][4][2], const pg8::Unit& u, int wr, int wc, int fr, int fq) const {
        const int pn = u.pn; const int rowb = u.pm * 256 + wr * 64 + fr; const float* RT = (const float*)(ws + WS_RT);
        if (pn >= 2) {
            bf16_t* dst = (bf16_t*)(ws + WS_SV);
#pragma unroll
            for (int ai = 0; ai < 2; ++ai)
#pragma unroll
                for (int m = 0; m < 4; ++m) { const int row = rowb + ai * 128 + m * 16; const float r = RT[row]; bf16_t* rowp = dst + (size_t)row * 512 + (pn - 2) * 256 + wc * 32 + 8 * fq;
#pragma unroll
                    for (int bj = 0; bj < 2; ++bj) store8(rowp + bj * 128, acc[ai][bj][m][0] * r, acc[ai][bj][m][1] * r); }
        } else {
            const float* COS = (const float*)(ws + WS_COS); const float* SIN = (const float*)(ws + WS_SIN);
            bf16_t* dst = (bf16_t*)(ws + WS_SK); f32x4 gn[2][2];
#pragma unroll
            for (int bj = 0; bj < 2; ++bj)
#pragma unroll
                for (int n = 0; n < 2; ++n) gn[bj][n] = *(const f32x4*)((const float*)(ws + WS_GAIN) + (layer * 4 + 3) * 64 + 32 * bj + 8 * fq + 4 * n);
            const int head = 4 * pn + wc;
#pragma unroll
            for (int ai = 0; ai < 2; ++ai)
#pragma unroll
              for (int mp = 0; mp < 4; mp += 2) {
                f32x4 cc[2][2], sn[2][2]; float rr[2];
#pragma unroll
                for (int m = 0; m < 2; ++m) { const int row = rowb + ai * 128 + (mp + m) * 16, t = row & (SEQ - 1); rr[m] = *(const GAS float*)(RT + row);
#pragma unroll
                    for (int n = 0; n < 2; ++n) { cc[m][n] = *(const GAS f32x4*)(COS + t * 32 + 8 * fq + 4 * n); sn[m][n] = *(const GAS f32x4*)(SIN + t * 32 + 8 * fq + 4 * n); } }
#pragma unroll
                for (int m = 0; m < 2; ++m) { const int row = rowb + ai * 128 + (mp + m) * 16; const float r = rr[m];
                    f32x4 x[2][2] = {{acc[ai][0][mp + m][0] * r, acc[ai][0][mp + m][1] * r}, {acc[ai][1][mp + m][0] * r, acc[ai][1][mp + m][1] * r}};
                    head_norm_rope_cs(x, true, gn, cc[m], sn[m], 1.0f);
#pragma unroll
                    for (int bj = 0; bj < 2; ++bj) store8(dst + (size_t)row * 512 + head * 64 + 32 * bj + 8 * fq, x[bj][0], x[bj][1]); }
                asm volatile("" ::: "memory");
              }
        }
    }
};
struct EpiGate {
    static constexpr bool PERM = true, MIDK = false, INIT = false;
    bf16_t* G; const float* bias;
    DI void operator()(const f32x4 (&acc)[2][2][4][2], const pg8::Unit& u, int wr, int wc, int fr, int fq) const {
        const int rowb = u.pm * 256 + wr * 64 + fr, col0 = u.pn * 256 + wc * 32 + 8 * fq;
        f32x4 bv[2][2];
#pragma unroll
        for (int bj = 0; bj < 2; ++bj)
#pragma unroll
            for (int n = 0; n < 2; ++n) bv[bj][n] = *(const f32x4*)(bias + col0 + bj * 128 + 4 * n);
#pragma unroll
        for (int ai = 0; ai < 2; ++ai)
#pragma unroll
            for (int m = 0; m < 4; ++m) { bf16_t* rowp = G + (size_t)(rowb + ai * 128 + m * 16) * 3072 + col0;
#pragma unroll
                for (int bj = 0; bj < 2; ++bj) { f32x4 v0 = acc[ai][bj][m][0] + bv[bj][0], v1 = acc[ai][bj][m][1] + bv[bj][1];
#pragma unroll
                    for (int j = 0; j < 4; ++j) { v0[j] = sigmoidf_(v0[j]); v1[j] = sigmoidf_(v1[j]); }
                    store8(rowp + bj * 128, v0, v1); } }
    }
};
struct EpiMerge {
    static constexpr bool PERM = true, MIDK = true, INIT = false;
    const bf16_t* G; bf16_t* MG;
    DI static void ld8(const bf16_t* p, float (&g)[8]) { const u32x4 w = *(const u32x4*)p; g[0] = bflo(w.x); g[1] = bfhi(w.x); g[2] = bflo(w.y); g[3] = bfhi(w.y); g[4] = bflo(w.z); g[5] = bfhi(w.z); g[6] = bflo(w.w); g[7] = bfhi(w.w); }
    DI void mid(f32x4 (&acc)[2][2][4][2], const pg8::Unit& u, int t, int wr, int wc, int fr, int fq) const {
        const int seg = (t >> 3) - 1; const int rowb = u.pm * 256 + wr * 64 + fr, col0 = u.pn * 256 + wc * 32 + 8 * fq;
#pragma unroll
        for (int ai = 0; ai < 2; ++ai) {
            u32x4 ga[4][2], gb[4][2];
#pragma unroll
            for (int m = 0; m < 4; ++m) { const bf16_t* gp = G + (size_t)(rowb + ai * 128 + m * 16) * 3072 + seg * 1024 + col0;
#pragma unroll
                for (int bj = 0; bj < 2; ++bj) { ga[m][bj] = *(const GAS u32x4*)(gp + bj * 128); gb[m][bj] = *(const GAS u32x4*)(gp + 1024 + bj * 128); } }
#pragma unroll
            for (int m = 0; m < 4; ++m)
#pragma unroll
                for (int bj = 0; bj < 2; ++bj) { const unsigned aw[4] = {ga[m][bj].x, ga[m][bj].y, ga[m][bj].z, ga[m][bj].w}, bw[4] = {gb[m][bj].x, gb[m][bj].y, gb[m][bj].z, gb[m][bj].w};
#pragma unroll
                    for (int q = 0; q < 4; ++q) { const int n = q >> 1, j0 = 2 * (q & 1);
                        acc[ai][bj][m][n][j0] *= fmaxf(bflo(aw[q]), 1e-20f) * frcp(fmaxf(bflo(bw[q]), 1e-20f));
                        acc[ai][bj][m][n][j0 + 1] *= fmaxf(bfhi(aw[q]), 1e-20f) * frcp(fmaxf(bfhi(bw[q]), 1e-20f)); } }
            asm volatile("" ::: "memory");
        }
    }
    DI void operator()(const f32x4 (&acc)[2][2][4][2], const pg8::Unit& u, int wr, int wc, int fr, int fq) const {
        const int rowb = u.pm * 256 + wr * 64 + fr, col0 = u.pn * 256 + wc * 32 + 8 * fq;
#pragma unroll
        for (int ai = 0; ai < 2; ++ai) {
            u32x4 gc[4][2];
#pragma unroll
            for (int m = 0; m < 4; ++m)
#pragma unroll
                for (int bj = 0; bj < 2; ++bj) gc[m][bj] = *(const GAS u32x4*)(G + (size_t)(rowb + ai * 128 + m * 16) * 3072 + 2048 + col0 + bj * 128);
#pragma unroll
            for (int m = 0; m < 4; ++m)
#pragma unroll
                for (int bj = 0; bj < 2; ++bj) { const unsigned cw[4] = {gc[m][bj].x, gc[m][bj].y, gc[m][bj].z, gc[m][bj].w}; f32x4 v0 = acc[ai][bj][m][0], v1 = acc[ai][bj][m][1];
                    v0[0] *= fmaxf(bflo(cw[0]), 1e-20f); v0[1] *= fmaxf(bfhi(cw[0]), 1e-20f); v0[2] *= fmaxf(bflo(cw[1]), 1e-20f); v0[3] *= fmaxf(bfhi(cw[1]), 1e-20f);
                    v1[0] *= fmaxf(bflo(cw[2]), 1e-20f); v1[1] *= fmaxf(bfhi(cw[2]), 1e-20f); v1[2] *= fmaxf(bflo(cw[3]), 1e-20f); v1[3] *= fmaxf(bfhi(cw[3]), 1e-20f);
                    store8(MG + (size_t)(rowb + ai * 128 + m * 16) * 1024 + col0 + bj * 128, v0, v1); }
            asm volatile("" ::: "memory");
        }
    }
};
struct EpiResid {
    static constexpr bool PERM = false, MIDK = false, INIT = true;
    const float* base; float* out;
    DI void init(f32x4 (&acc)[2][2][4][2], const pg8::Unit& u, int wr, int wc, int fr, int fq) const {
        const int rowb = u.pm * 256 + wr * 64 + fr, col0 = u.pn * 256 + wc * 32 + 4 * fq;
#pragma unroll
        for (int ai = 0; ai < 2; ++ai)
#pragma unroll
            for (int m = 0; m < 4; ++m) { const size_t off = (size_t)(rowb + ai * 128 + m * 16) * DM + col0;
#pragma unroll
                for (int bj = 0; bj < 2; ++bj)
#pragma unroll
                    for (int n = 0; n < 2; ++n) acc[ai][bj][m][n] = *(const GAS f32x4*)(base + off + bj * 128 + n * 16); }
    }
    DI void operator()(const f32x4 (&acc)[2][2][4][2], const pg8::Unit& u, int wr, int wc, int fr, int fq) const {
        const int rowb = u.pm * 256 + wr * 64 + fr, col0 = u.pn * 256 + wc * 32 + 4 * fq;
#pragma unroll
        for (int ai = 0; ai < 2; ++ai)
#pragma unroll
            for (int m = 0; m < 4; ++m) { const size_t off = (size_t)(rowb + ai * 128 + m * 16) * DM + col0;
#pragma unroll
                for (int bj = 0; bj < 2; ++bj)
#pragma unroll
                    for (int n = 0; n < 2; ++n) *(f32x4*)(out + off + bj * 128 + n * 16) = acc[ai][bj][m][n]; }
    }
};
struct EpiSwiGLU {
    static constexpr bool PERM = true, MIDK = false, INIT = false;
    bf16_t* H;
    DI void operator()(const f32x4 (&acc)[2][2][4][2], const pg8::Unit& u, int wr, int wc, int fr, int fq) const {
        const int rowb = u.pm * 256 + wr * 64 + fr, col0 = u.pn * 128 + wc * 32 + 8 * fq;
#pragma unroll
        for (int ai = 0; ai < 2; ++ai)
#pragma unroll
            for (int m = 0; m < 4; ++m) { f32x4 v0, v1;
#pragma unroll
                for (int j = 0; j < 4; ++j) { const float g0 = acc[ai][0][m][0][j], g1 = acc[ai][0][m][1][j]; v0[j] = g0 * sigmoidf_(g0) * acc[ai][1][m][0][j]; v1[j] = g1 * sigmoidf_(g1) * acc[ai][1][m][1][j]; }
                store8(H + (size_t)(rowb + ai * 128 + m * 16) * FF + col0, v0, v1); }
    }
};

DI unsigned mono_key(float f) { const unsigned u = __float_as_uint(f + 0.0f); return u ^ ((unsigned)((int)u >> 31) | 0x80000000u); }
DI unsigned pack_mask(unsigned long long bm, int h) {
    unsigned r = 0;
#pragma unroll
    for (int p = 0; p < 2; ++p)
#pragma unroll
        for (int g = 0; g < 4; ++g) r |= (unsigned)((bm >> (32 * p + 8 * g + 4 * h)) & 0xFull) << (16 * p + 4 * g);
    return r;
}
DI unsigned long long unpack_mask(unsigned w0, unsigned w1) {
    unsigned long long bm = 0;
#pragma unroll
    for (int p = 0; p < 2; ++p)
#pragma unroll
        for (int g = 0; g < 4; ++g) { bm |= (unsigned long long)((w0 >> (16 * p + 4 * g)) & 0xFu) << (32 * p + 8 * g); bm |= (unsigned long long)((w1 >> (16 * p + 4 * g)) & 0xFu) << (32 * p + 8 * g + 4); }
    return bm;
}
DI void ld8f(const bf16_t* p, float (&g)[8]) { const u32x4 w = *(const u32x4*)p; g[0] = bflo(w.x); g[1] = bfhi(w.x); g[2] = bflo(w.y); g[3] = bfhi(w.y); g[4] = bflo(w.z); g[5] = bfhi(w.z); g[6] = bflo(w.w); g[7] = bfhi(w.w); }

DI void naive_select(Frame& F) {
    F.refresh();
    if (F.wave >= 4) return;
    const int gw = F.bid * 4 + F.wave, NGW = F.G * 4;
    LAS unsigned char* wl = F.lds + F.wave * 20480;
    LAS float* sc = (LAS float*)wl; LAS float* iqf = (LAS float*)(wl + 16384); LAS unsigned* hist = (LAS unsigned*)(wl + 16384 + 1024);
    const bf16_t* IQ = (const bf16_t*)(F.ws + WS_IQ); const bf16_t* IK = (const bf16_t*)(F.ws + WS_IK); const float* IW = (const float*)(F.ws + WS_IW);
    unsigned* MASK = (unsigned*)(F.ws + WS_MASK);
    const int lane = F.lane;
    for (int row = gw; row < MC; row += NGW) {
        const int b = row >> 12, t = row & (SEQ - 1), n = t + 1;
        { const u32x2 v = *(const u32x2*)(IQ + (size_t)row * 256 + 4 * lane); iqf[4 * lane] = bflo(v.x); iqf[4 * lane + 1] = bfhi(v.x); iqf[4 * lane + 2] = bflo(v.y); iqf[4 * lane + 3] = bfhi(v.y); }
        const f32x4 wv = *(const f32x4*)(IW + (size_t)row * 4);
        WSYNC();
        for (int s = lane; s < n; s += 64) {
            const bf16_t* kr = IK + ((size_t)b * SEQ + s) * 64;
            float d0 = 0.f, d1 = 0.f, d2 = 0.f, d3 = 0.f;
#pragma unroll
            for (int c = 0; c < 8; ++c) { float kv[8]; ld8f(kr + 8 * c, kv);
#pragma unroll
                for (int j = 0; j < 8; ++j) { const float k = kv[j]; d0 += iqf[8 * c + j] * k; d1 += iqf[64 + 8 * c + j] * k; d2 += iqf[128 + 8 * c + j] * k; d3 += iqf[192 + 8 * c + j] * k; } }
            sc[s] = wv[0] * fmaxf(d0, 0.f) + wv[1] * fmaxf(d1, 0.f) + wv[2] * fmaxf(d2, 0.f) + wv[3] * fmaxf(d3, 0.f);
        }
        WSYNC();
        unsigned thr = 0u; int need = 256;
        if (n > 256) {
            unsigned prefix = 0u, pmask = 0u;
            for (int pass = 0; pass < 4; ++pass) {
                const int shift = 24 - 8 * pass;
                { unsigned z_ = 0u; asm volatile("" : "+v"(z_)); hist[lane] = z_; hist[lane + 64] = z_; hist[lane + 128] = z_; hist[lane + 192] = z_; }
                WSYNC();
                for (int s = lane; s < n; s += 64) { const unsigned key = mono_key(sc[s]); if ((key & pmask) == prefix) __hip_atomic_fetch_add(&hist[(key >> shift) & 255u], 1u, __ATOMIC_RELAXED, __HIP_MEMORY_SCOPE_WORKGROUP); }
                WSYNC();
                const unsigned c0 = hist[4 * lane], c1 = hist[4 * lane + 1], c2 = hist[4 * lane + 2], c3 = hist[4 * lane + 3];
                const unsigned ls = c0 + c1 + c2 + c3; unsigned inc = ls;
#pragma unroll
                for (int o = 1; o < 64; o <<= 1) { const unsigned y = __shfl_up(inc, o); if (lane >= o) inc += y; }
                const unsigned total = __shfl(inc, 63);
                unsigned cum = total - inc;
                int fbin = -1; unsigned fneed = 0u;
                const unsigned cc[4] = {c0, c1, c2, c3};
#pragma unroll
                for (int bq = 3; bq >= 0; --bq) { if (fbin < 0 && cum < (unsigned)need && cum + cc[bq] >= (unsigned)need) { fbin = 4 * lane + bq; fneed = (unsigned)need - cum; } cum += cc[bq]; }
                const unsigned long long fm = __ballot(fbin >= 0);
                const int src = __ffsll((long long)fm) - 1;
                const int bin = __shfl(fbin, src); need = (int)__shfl(fneed, src);
                prefix |= (unsigned)bin << shift; pmask |= 0xFFu << shift;
                WSYNC();
            }
            thr = prefix;
        }
        int eqc = 0;
        for (int i = 0; i < 64; ++i) {
            const int s = 64 * i + lane; bool sel = false;
            if (64 * i < n) {
                const bool valid = s < n;
                if (n <= 256) sel = valid;
                else { const unsigned key = valid ? mono_key(sc[s]) : 0u; const bool eq = valid && key == thr; const unsigned long long em = __ballot(eq);
                    const int rank = eqc + __popcll(em & ((1ull << lane) - 1ull)); sel = valid && (key > thr || (eq && rank < need)); eqc += __popcll(em); }
            }
            const unsigned long long bm = __ballot(sel);
            if (lane == 0) { MASK[((size_t)row * 2 + 0) * 64 + i] = pack_mask(bm, 0); MASK[((size_t)row * 2 + 1) * 64 + i] = pack_mask(bm, 1); }
        }
        WSYNC();
    }
}
DI void naive_dsa(Frame& F) {
    F.refresh();
    if (F.wave >= 4) return;
    const int gw = F.bid * 4 + F.wave, NGW = F.G * 4;
    LAS unsigned char* wl = F.lds + F.wave * 20480;
    LAS float* sc = (LAS float*)wl;
    LAS float* sqf = (LAS float*)(wl + 8192);
    LAS unsigned* list = (LAS unsigned*)(wl + 8192 + 2048);
    LAS float* invs = (LAS float*)(wl + 8192 + 2048 + 2048);
    const bf16_t* SQ = (const bf16_t*)(F.ws + WS_SQ); const bf16_t* SK = (const bf16_t*)(F.ws + WS_SK); const bf16_t* SV = (const bf16_t*)(F.ws + WS_SV);
    const unsigned* MASK = (const unsigned*)(F.ws + WS_MASK); bf16_t* Y = (bf16_t*)(F.ws + WS_Y);
    const int lane = F.lane;
    for (int row = gw; row < MC; row += NGW) {
        const int b = row >> 12, t = row & (SEQ - 1);
        { float q[8]; ld8f(SQ + (size_t)row * 512 + 8 * lane, q);
#pragma unroll
          for (int j = 0; j < 8; ++j) sqf[8 * lane + j] = q[j]; }
        int nsel = 0;
        for (int i = 0; i <= (t >> 6); ++i) {
            const unsigned w0 = MASK[((size_t)row * 2 + 0) * 64 + i], w1 = MASK[((size_t)row * 2 + 1) * 64 + i];
            const unsigned long long bm = unpack_mask(w0, w1);
            const bool sel = (bm >> lane) & 1ull;
            const int pos = nsel + __popcll(bm & ((1ull << lane) - 1ull));
            if (sel && pos < 256) list[pos] = (unsigned)(64 * i + lane);
            nsel += __popcll(bm);
        }
        if (nsel > 256) nsel = 256;
        WSYNC();
        for (int k = lane; k < nsel; k += 64) {
            const bf16_t* kr = SK + ((size_t)b * SEQ + list[k]) * 512;
#pragma unroll 1
            for (int h = 0; h < 8; ++h) { float d = 0.f;
#pragma unroll
                for (int c = 0; c < 8; ++c) { float kv[8]; ld8f(kr + h * 64 + 8 * c, kv);
#pragma unroll
                    for (int j = 0; j < 8; ++j) d += sqf[h * 64 + 8 * c + j] * kv[j]; }
                sc[h * 256 + k] = d; }
        }
        WSYNC();
#pragma unroll 1
        for (int h = 0; h < 8; ++h) {
            float mx = -INFINITY; for (int k = lane; k < nsel; k += 64) mx = fmaxf(mx, sc[h * 256 + k]);
            mx = wave_max(mx); float sum = 0.f;
            for (int k = lane; k < nsel; k += 64) { const float p = fexp2(sc[h * 256 + k] - mx); sc[h * 256 + k] = p; sum += p; }
            sum = wave_sum(sum); if (lane == 0) invs[h] = 1.0f / sum;
        }
        WSYNC();
        { const int h = lane >> 3, d0 = (lane & 7) * 8; float accv[8] = {0.f, 0.f, 0.f, 0.f, 0.f, 0.f, 0.f, 0.f};
          for (int k = 0; k < nsel; ++k) { const float p = sc[h * 256 + k]; float v[8]; ld8f(SV + ((size_t)b * SEQ + list[k]) * 512 + h * 64 + d0, v);
#pragma unroll
              for (int j = 0; j < 8; ++j) accv[j] += p * v[j]; }
          const float inv = invs[h];
          u32x4 o; o.x = pk2(accv[0] * inv, accv[1] * inv); o.y = pk2(accv[2] * inv, accv[3] * inv); o.z = pk2(accv[4] * inv, accv[5] * inv); o.w = pk2(accv[6] * inv, accv[7] * inv);
          *(u32x4*)(Y + (size_t)row * 1536 + 512 + h * 64 + d0) = o; }
        WSYNC();
    }
}
DI void naive_mlstm(Frame& F, const Args& a, int l) {
    F.refresh();
    const int gw = F.bid * NWAVES + F.wave, NGW = F.G * NWAVES;
    LAS unsigned char* wl = F.lds + F.wave * 16384;
    LAS float* pl = (LAS float*)wl;
    const bf16_t* QK = (const bf16_t*)(F.ws + WS_QK); const bf16_t* VM = (const bf16_t*)(F.ws + WS_VM); const bf16_t* OM = (const bf16_t*)(F.ws + WS_OM);
    const float* AK = (const float*)(F.ws + WS_AK); const float* MQ = (const float*)(F.ws + WS_MQ); const float* EM = (const float*)(F.ws + WS_EM);
    bf16_t* Y = (bf16_t*)(F.ws + WS_Y); const float* mng = a.in[I_MNG] + (size_t)l * 512;
    const int lane = F.lane;
    for (int qi = gw; qi < MC * 4; qi += NGW) {
        const int row = qi >> 2, h = qi & 3, b = row >> 12, t = row & (SEQ - 1), seq = b * 4 + h;
        const unsigned qw = *(const unsigned*)(QK + (size_t)row * 1024 + h * 128 + 2 * lane);
        const float q0 = bflo(qw), q1 = bfhi(qw);
        const float Mt = MQ[(size_t)seq * SEQ + t];
        float denp = 0.f;
        for (int s0 = 0; s0 <= t; s0 += 64) {
            const int s = s0 + lane; const bool valid = s <= t; const int sr = valid ? s : t;
            const bf16_t* kr = QK + ((size_t)b * SEQ + sr) * 1024 + 512 + h * 128;
            float d = 0.f;
#pragma unroll 4
            for (int c = 0; c < 16; ++c) { float kv[8]; ld8f(kr + 8 * c, kv);
#pragma unroll
                for (int j = 0; j < 4; ++j) { d += __shfl(q0, 4 * c + j) * kv[2 * j] + __shfl(q1, 4 * c + j) * kv[2 * j + 1]; } }
            const float p = valid ? d * fexp(AK[(size_t)seq * SEQ + sr] - Mt) : 0.f;
            pl[s] = p;
            denp += p;
        }
        const float den = wave_sum(denp);
        WSYNC();
        float a0 = 0.f, a1 = 0.f;
        for (int s = 0; s <= t; ++s) { const float p = pl[s]; const unsigned vw = *(const unsigned*)(VM + ((size_t)b * SEQ + s) * 512 + h * 128 + 2 * lane); a0 += p * bflo(vw); a1 += p * bfhi(vw); }
        const float hd = fmaxf(fabsf(den), EM[(size_t)seq * SEQ + t]);
        a0 /= hd; a1 /= hd;
        const float ss = wave_sum(a0 * a0 + a1 * a1); const float r = 1.0f / sqrtf(ss * (1.f / 128.f) + EPS);
        const unsigned ow = *(const unsigned*)(OM + (size_t)row * 512 + h * 128 + 2 * lane);
        const float y0 = a0 * r * mng[h * 128 + 2 * lane] * bflo(ow), y1 = a1 * r * mng[h * 128 + 2 * lane + 1] * bfhi(ow);
        *(unsigned*)(Y + (size_t)row * 1536 + h * 128 + 2 * lane) = pk2(y0, y1);
        WSYNC();
    }
}
DI void naive_diff(Frame& F, const Args& a, int l) {
    F.refresh();
    if (F.wave >= 4) return;
    const int gw = F.bid * 4 + F.wave, NGW = F.G * 4;
    LAS unsigned char* wl = F.lds + F.wave * 32768;
    LAS float* p0 = (LAS float*)wl; LAS float* p1 = (LAS float*)(wl + 16384);
    const bf16_t* DQ = (const bf16_t*)(F.ws + WS_DQ); const bf16_t* DK = (const bf16_t*)(F.ws + WS_DK); const bf16_t* DV = (const bf16_t*)(F.ws + WS_DV);
    bf16_t* Y = (bf16_t*)(F.ws + WS_Y); const float* dog = a.in[I_DOG] + (size_t)l * 128; const float* lam = a.in[I_LAM] + (size_t)l * 256;
    const int lane = F.lane;
    const float lam_init = (l == 0) ? 0.2f : 0.35550906759096934f;
    const float s01 = wave_sum(lam[lane] * lam[64 + lane]), s23 = wave_sum(lam[128 + lane] * lam[192 + lane]);
    const float lam_val = fexp(s01) - fexp(s23) + lam_init;
    for (int qi = gw; qi < MC * 4; qi += NGW) {
        const int row = qi >> 2, h = qi & 3, b = row >> 12, t = row & (SEQ - 1);
        const float qa = bf2f(DQ[(size_t)row * 512 + (2 * h) * 64 + lane]), qb = bf2f(DQ[(size_t)row * 512 + (2 * h + 1) * 64 + lane]);
        float mx0 = -INFINITY, mx1 = -INFINITY;
        for (int s0 = 0; s0 <= t; s0 += 64) {
            const int s = s0 + lane; const bool valid = s <= t; const int sr = valid ? s : t;
            const bf16_t* kr = DK + ((size_t)b * SEQ + sr) * 512 + (2 * h) * 64;
            float d0 = 0.f, d1 = 0.f;
#pragma unroll 4
            for (int c = 0; c < 8; ++c) { float ka[8], kb[8]; ld8f(kr + 8 * c, ka); ld8f(kr + 64 + 8 * c, kb);
#pragma unroll
                for (int j = 0; j < 8; ++j) { d0 += __shfl(qa, 8 * c + j) * ka[j]; d1 += __shfl(qb, 8 * c + j) * kb[j]; } }
            if (valid) { p0[s] = d0; p1[s] = d1; mx0 = fmaxf(mx0, d0); mx1 = fmaxf(mx1, d1); }
        }
        mx0 = wave_max(mx0); mx1 = wave_max(mx1);
        WSYNC();
        float sm0 = 0.f, sm1 = 0.f;
        for (int s = lane; s <= t; s += 64) { const float e0 = fexp2(p0[s] - mx0), e1 = fexp2(p1[s] - mx1); p0[s] = e0; p1[s] = e1; sm0 += e0; sm1 += e1; }
        const float i0 = 1.0f / wave_sum(sm0), i1 = lam_val / wave_sum(sm1);
        WSYNC();
        float a0 = 0.f, a1 = 0.f;
        for (int s = 0; s <= t; ++s) { const float av = p0[s] * i0 - p1[s] * i1; const unsigned vw = *(const unsigned*)(DV + ((size_t)b * SEQ + s) * 512 + h * 128 + 2 * lane); a0 += av * bflo(vw); a1 += av * bfhi(vw); }
        const float ss = wave_sum(a0 * a0 + a1 * a1); const float r = 1.0f / sqrtf(ss * (1.f / 128.f) + EPS) * (1.0f - lam_init);
        *(unsigned*)(Y + (size_t)row * 1536 + 1024 + h * 128 + 2 * lane) = pk2(a0 * r * dog[2 * lane], a1 * r * dog[2 * lane + 1]);
        WSYNC();
    }
}

typedef float f32x16 __attribute__((ext_vector_type(16)));
typedef short s16x4 __attribute__((ext_vector_type(4)));
typedef __bf16 bf16x2_t __attribute__((ext_vector_type(2)));
DI unsigned cvtpk(float lo, float hi) { f32x2 v = {lo, hi}; bf16x2_t b = __builtin_convertvector(v, bf16x2_t); return __builtin_bit_cast(unsigned, b); }
#define MFMA32(a, b, c) __builtin_amdgcn_mfma_f32_32x32x16_bf16((a), (b), (c), 0, 0, 0)
DI s16x4 trread(LAS const unsigned char* p) { return __builtin_bit_cast(s16x4, __builtin_amdgcn_ds_read_tr16_b64_v4i16((LAS s16x4*)p)); }
#ifndef MIXMODES
#define MIXMODES 7
#endif
constexpr int CW_QUEUE = 8192;
constexpr int ATT_WSF_OFF = RING_BYTES + 1024;
constexpr float NEGBIG = -1.0e30f;
constexpr float RESC_THR = 16.0f;

DI float max3f(float a, float b, float c) { float r_; asm("v_max3_f32 %0, %1, %2, %3" : "=v"(r_) : "v"(a), "v"(b), "v"(c)); return r_; }
template <int MODE>
DI void attn_tile(f32x16 (&o)[MODE == 0 ? 2 : 4], float& lsum, float& mref, const bf16x8 (&qf)[MODE == 2 ? 8 : 4], LAS const unsigned char* kb, int koff, int voff,
                  int j, int q0w, int r, int h, unsigned mw, float M2, LAS float* wsf, const bool DIAG, const int probe) {
    constexpr int KW = MODE == 0 ? 64 : 128, DQK = MODE == 2 ? 128 : 64, DV = MODE == 0 ? 64 : 128, KROWB = KW * 2 + 16, VROWB = MODE == 0 ? 192 : 320, KBYTES = 64 * KROWB, VBYTES = 64 * VROWB;
    constexpr int NKS = DQK / 16, NVB = DV / 32;
    LAS const unsigned char* vb = kb + KBYTES; LAS const unsigned char* ab = vb + VBYTES;
    f32x16 s0, s1;
    if (MODE == 0) {
        const unsigned nmw = ~mw;
#pragma unroll
        for (int i = 0; i < 16; ++i) { s0[i] = __uint_as_float((unsigned)((int)(nmw << (31 - i)) >> 31) & 0xF149F2CAu); s1[i] = __uint_as_float((unsigned)((int)(nmw << (15 - i)) >> 31) & 0xF149F2CAu); }
    } else if (MODE == 1 && DIAG) {
        const int qd = q0w + r - 64 * j;
#pragma unroll
        for (int i = 0; i < 16; ++i) { const int kk = (i & 3) + 8 * (i >> 2) + 4 * h; s0[i] = kk > qd ? NEGBIG : 0.f; s1[i] = kk + 32 > qd ? NEGBIG : 0.f; }
    } else {
#pragma unroll
        for (int i = 0; i < 16; ++i) { s0[i] = 0.f; s1[i] = 0.f; }
    }
#pragma unroll
    for (int s = 0; s < NKS; ++s) {
        const bf16x8 k0 = *(LAS const bf16x8*)(kb + koff + 32 * s);
        const bf16x8 k1 = *(LAS const bf16x8*)(kb + koff + 32 * KROWB + 32 * s);
        s0 = MFMA32(k0, qf[s], s0); s1 = MFMA32(k1, qf[s], s1);
    }
    if (MODE == 2) {
        float part = 0.f;
        if (DIAG) {
            const int qd = q0w + r - 64 * j;
#pragma unroll
            for (int g = 0; g < 4; ++g) {
                const f32x4 a0 = *(LAS const f32x4*)(ab + (8 * g + 4 * h) * 4), a1 = *(LAS const f32x4*)(ab + (32 + 8 * g + 4 * h) * 4);
#pragma unroll
                for (int e = 0; e < 4; ++e) { const int i = 4 * g + e, kk = 8 * g + 4 * h + e;
                    float w0 = fexp2(a0[e] - M2), w1 = fexp2(a1[e] - M2);
                    if (kk > qd) w0 = 0.f; if (kk + 32 > qd) w1 = 0.f;
                    s0[i] *= w0; s1[i] *= w1; part += s0[i] + s1[i]; }
            }
        } else {
#pragma unroll
            for (int g = 0; g < 4; ++g) {
                const f32x4 a0 = *(LAS const f32x4*)(ab + (8 * g + 4 * h) * 4), a1 = *(LAS const f32x4*)(ab + (32 + 8 * g + 4 * h) * 4);
#pragma unroll
                for (int e = 0; e < 4; ++e) { const int i = 4 * g + e;
                    s0[i] *= fexp2(a0[e] - M2); s1[i] *= fexp2(a1[e] - M2); part += s0[i] + s1[i]; }
            }
        }
        lsum += part;
    } else {
        if (probe != 2) {
        asm volatile("s_nop 15\n\ts_nop 7" : "+v"(s0), "+v"(s1));
        float ta = max3f(s0[0], s0[1], s1[0]), tb = max3f(s0[2], s0[3], s1[1]); ta = max3f(ta, s1[2], s1[3]);
#pragma unroll
        for (int i = 4; i < 16; i += 4) { ta = max3f(ta, s0[i], s0[i + 1]); tb = max3f(tb, s0[i + 2], s0[i + 3]); ta = max3f(ta, s1[i], s1[i + 1]); tb = max3f(tb, s1[i + 2], s1[i + 3]); }
        float tm = max3f(ta, tb, tb); tm = max32x(tm);
        if (__any(tm > mref + RESC_THR)) {
            const float nm = tm > mref + RESC_THR ? tm : mref, al = fexp2(mref - nm);
            mref = nm; lsum *= al;
            if (h == 0) wsf[r] = al;
            WSYNC();
#pragma unroll
            for (int g = 0; g < 4; ++g) { const f32x4 av = *(LAS const f32x4*)(wsf + 8 * g + 4 * h);
#pragma unroll
                for (int v = 0; v < NVB; ++v)
#pragma unroll
                    for (int e = 0; e < 4; ++e) o[v][4 * g + e] *= av[e]; }
            WSYNC();
        }
        if (__any(mref != 0.f)) {
#pragma unroll
            for (int i = 0; i < 16; ++i) { s0[i] -= mref; s1[i] -= mref; }
        }
        float part = 0.f;
#pragma unroll
        for (int i = 0; i < 16; ++i) { s0[i] = fexp2(s0[i]); s1[i] = fexp2(s1[i]); part += s0[i] + s1[i]; }
        lsum += part;
        }
    }
    bf16x8 pf[2][2];
#pragma unroll
    for (int s2 = 0; s2 < 2; ++s2) {
        u32x4 t0, t1;
        t0.x = cvtpk(s0[8 * s2 + 0], s0[8 * s2 + 1]); t0.y = cvtpk(s0[8 * s2 + 2], s0[8 * s2 + 3]); t0.z = cvtpk(s0[8 * s2 + 4], s0[8 * s2 + 5]); t0.w = cvtpk(s0[8 * s2 + 6], s0[8 * s2 + 7]);
        t1.x = cvtpk(s1[8 * s2 + 0], s1[8 * s2 + 1]); t1.y = cvtpk(s1[8 * s2 + 2], s1[8 * s2 + 3]); t1.z = cvtpk(s1[8 * s2 + 4], s1[8 * s2 + 5]); t1.w = cvtpk(s1[8 * s2 + 6], s1[8 * s2 + 7]);
        pf[0][s2] = __builtin_bit_cast(bf16x8, t0); pf[1][s2] = __builtin_bit_cast(bf16x8, t1);
    }
    if (probe != 3)
#pragma unroll
    for (int v = 0; v < NVB; ++v)
#pragma unroll
        for (int p = 0; p < 2; ++p)
#pragma unroll
            for (int s2 = 0; s2 < 2; ++s2) {
                const s16x4 lo = trread(vb + voff + (32 * p + 16 * s2) * VROWB + 64 * v), hi = trread(vb + voff + (32 * p + 16 * s2 + 8) * VROWB + 64 * v);
                const bf16x8 vf = (bf16x8){lo[0], lo[1], lo[2], lo[3], hi[0], hi[1], hi[2], hi[3]};
                o[v] = MFMA32(pf[p][s2], vf, o[v]);
            }
}

template <int MODE>
DI void attn_unit(Frame& F, const Args& a, int l, int b, int head, int qb, float lam_val, float lam_init) {
    constexpr int KW = MODE == 0 ? 64 : 128, DQK = MODE == 2 ? 128 : 64, NCOMP = 1, NPASS = 1, DV = MODE == 0 ? 64 : 128;
    constexpr int KROWB = KW * 2 + 16, VROWB = MODE == 0 ? 192 : 320;
    constexpr int KBYTES = 64 * KROWB, VBYTES = 64 * VROWB, STAGE = KBYTES + VBYTES + 256;
    constexpr int NKS = DQK / 16, NVB = DV / 32, KCH = KW / 64, VCH = DV / 64;
    static_assert(2 * STAGE <= 98304, "tile buffers");
    F.refresh();
    const int probe = ((volatile LAS int*)(F.lds + MISC_OFF + 96))[2];
    const int tid = F.tid, lane = F.lane, w = F.wave, r = lane & 31, h = lane >> 5;
    const bf16_t* Qp; const bf16_t* Kp; const bf16_t* Vp; int ldq, ldk;
    if (MODE == 0) { Qp = (const bf16_t*)(F.ws + WS_SQ) + head * 64; Kp = (const bf16_t*)(F.ws + WS_SK) + head * 64; Vp = (const bf16_t*)(F.ws + WS_SV) + head * 64; ldq = 512; ldk = 512; }
    else if (MODE == 1) { Qp = (const bf16_t*)(F.ws + WS_DQ) + head * 128; Kp = (const bf16_t*)(F.ws + WS_DK) + head * 128; Vp = (const bf16_t*)(F.ws + WS_DV) + head * 128; ldq = 512; ldk = 512; }
    else { Qp = (const bf16_t*)(F.ws + WS_QK) + head * 128; Kp = (const bf16_t*)(F.ws + WS_QK) + 512 + head * 128; Vp = (const bf16_t*)(F.ws + WS_VM) + head * 128; ldq = 1024; ldk = 1024; }
    const size_t rowb = (size_t)b * SEQ;
    const int comp = MODE == 1 ? (w >> 2) : 0;
    const int q0w = MODE == 1 ? qb * 128 + (w & 3) * 32 : qb * 256 + w * 32;
    const int seq = b * 4 + head;
    LAS float* wsf = (LAS float*)(F.lds + ATT_WSF_OFF + w * 256);
    f32x16 o[NCOMP][NVB];
    float lsum[NCOMP], mref[NCOMP];
    const int i16 = lane & 15, vq = i16 >> 2, vp = i16 & 3, vcs = (lane >> 4) & 1;
    const int voff = (4 * h + vq) * VROWB + (16 * vcs + 4 * vp) * 2;
    const int koff = r * KROWB + 16 * h;
    const int NT = MODE == 2 ? 4 : (MODE == 1 ? 2 * (qb + 1) : 4 * (qb + 1)), JB = MODE == 2 ? 4 * qb : 0;
#pragma unroll 1
    for (int pass = 0; pass < NPASS; ++pass) {
    bf16x8 qf[NCOMP][NKS];
#pragma unroll
    for (int c = 0; c < NCOMP; ++c)
#pragma unroll
        for (int s = 0; s < NKS; ++s) qf[c][s] = *(const GAS bf16x8*)(Qp + (rowb + q0w + r) * ldq + comp * 64 + 16 * s + 8 * h);
#pragma unroll
    for (int c = 0; c < NCOMP; ++c)
#pragma unroll
        for (int v = 0; v < NVB; ++v)
#pragma unroll
            for (int i = 0; i < 16; ++i) o[c][v][i] = 0.f;
#pragma unroll
    for (int c = 0; c < NCOMP; ++c) { lsum[c] = 0.f; mref[c] = 0.f; }
    float M2 = 0.f;
    if (MODE == 2) M2 = ((const float*)(F.ws + WS_MQ))[(size_t)seq * SEQ + q0w + r] * LOG2E;
    const unsigned* mrow = (const unsigned*)(F.ws + WS_MASK) + ((rowb + q0w + r) * 2 + h) * 64;
    const int srow = tid >> 3, sch = tid & 7;
    const bf16_t* kg = Kp + (rowb + srow) * ldk + sch * 8; const bf16_t* vg = Vp + (rowb + srow) * 512 + sch * 8;
    const float* ag = (const float*)(F.ws + WS_AK) + (size_t)seq * SEQ;
    u32x4 kreg[KCH], vreg[VCH]; float areg = 0.f; unsigned mw = 0u; u32x4 mw4 = (u32x4){0u, 0u, 0u, 0u}, mw4n = (u32x4){0u, 0u, 0u, 0u};
#define ST_LOAD(j) do { _Pragma("unroll") for (int c_ = 0; c_ < KCH; ++c_) kreg[c_] = *(const GAS u32x4*)(kg + (size_t)(j) * 64 * ldk + c_ * 64); \
        _Pragma("unroll") for (int c_ = 0; c_ < VCH; ++c_) vreg[c_] = *(const GAS u32x4*)(vg + (size_t)(j) * 64 * 512 + c_ * 64); \
        if (MODE == 2) { if (tid < 64) areg = *(const GAS float*)(ag + (j) * 64 + tid); } \
        asm volatile("" ::: "memory"); } while (0)
#define ST_WRITE(buf) do { LAS unsigned char* sb_ = F.lds + (buf) * STAGE; \
        _Pragma("unroll") for (int c_ = 0; c_ < KCH; ++c_) *(LAS u32x4*)(sb_ + srow * KROWB + (sch + 8 * c_) * 16) = kreg[c_]; \
        _Pragma("unroll") for (int c_ = 0; c_ < VCH; ++c_) *(LAS u32x4*)(sb_ + KBYTES + srow * VROWB + (sch + 8 * c_) * 16) = vreg[c_]; \
        if (MODE == 2) { if (tid < 64) *(LAS float*)(sb_ + KBYTES + VBYTES + tid * 4) = areg * LOG2E; } } while (0)
    if (MODE == 0) mw4n = *(const GAS u32x4*)(mrow + JB);
    ST_LOAD(JB); ST_WRITE(0);
    __syncthreads();
    for (int j = JB; j < JB + NT; ++j) {
        const int cur = j & 1;
        if (MODE == 0) {
            if ((j & 3) == 0) { mw4 = mw4n; if (j + 4 < JB + NT) mw4n = *(const GAS u32x4*)(mrow + j + 4); }
            mw = (j & 3) == 0 ? mw4.x : ((j & 3) == 1 ? mw4.y : ((j & 3) == 2 ? mw4.z : mw4.w));
        }
        if (j + 1 < JB + NT && (probe == 0 || probe == 2 || probe == 3)) ST_LOAD(j + 1);
        if (64 * j <= q0w + 31) {
            LAS const unsigned char* kb = F.lds + cur * STAGE;
            attn_tile<MODE>(o[0], lsum[0], mref[0], qf[0], kb, koff + comp * 128, voff, j, q0w, r, h, mw, M2, wsf, 64 * j + 63 > q0w, probe);
        }
        if (probe != 4) { if (j + 1 < JB + NT) ST_WRITE(cur ^ 1);
        __syncthreads(); }
    }
#undef ST_LOAD
#undef ST_WRITE
    }
    if (MODE == 2) { if (qb > 0) {
        const float Mp2 = ((const float*)(F.ws + WS_MQ))[(size_t)seq * SEQ + 256 * qb - 1] * LOG2E;
        const float M2s = ((const float*)(F.ws + WS_MQ))[(size_t)seq * SEQ + q0w + r] * LOG2E;
        const float g = fexp2(Mp2 - M2s);
        const float* NSn = (const float*)(F.ws + WS_MN + 128 * 1024) + ((size_t)seq * 16 + qb) * 128;
        const bf16_t* Cn = (const bf16_t*)(F.ws + WS_MC) + ((size_t)seq * 16 + qb) * 16384;
        bf16x8 qs[8]; float dpart = 0.f;
#pragma unroll
        for (int s = 0; s < 8; ++s) {
            const bf16x8 qv = *(const GAS bf16x8*)(Qp + (rowb + q0w + r) * ldq + 16 * s + 8 * h);
            const u32x4 qw = __builtin_bit_cast(u32x4, qv);
            const f32x4 n0 = *(const GAS f32x4*)(NSn + 16 * s + 8 * h), n1 = *(const GAS f32x4*)(NSn + 16 * s + 8 * h + 4);
            const float q0 = bflo(qw.x), q1 = bfhi(qw.x), q2 = bflo(qw.y), q3 = bfhi(qw.y), q4 = bflo(qw.z), q5 = bfhi(qw.z), q6 = bflo(qw.w), q7 = bfhi(qw.w);
            dpart += (q0 * n0[0] + q1 * n0[1]) + (q2 * n0[2] + q3 * n0[3]) + (q4 * n1[0] + q5 * n1[1]) + (q6 * n1[2] + q7 * n1[3]);
            u32x4 t; t.x = cvtpk(q0 * g, q1 * g); t.y = cvtpk(q2 * g, q3 * g); t.z = cvtpk(q4 * g, q5 * g); t.w = cvtpk(q6 * g, q7 * g);
            qs[s] = __builtin_bit_cast(bf16x8, t);
        }
        lsum[0] += g * dpart;
#pragma unroll
        for (int v = 0; v < NVB; ++v) {
            bf16x8 cf[8];
#pragma unroll
            for (int s = 0; s < 8; ++s) cf[s] = *(const GAS bf16x8*)(Cn + (size_t)(32 * v + r) * 128 + 16 * s + 8 * h);
#pragma unroll
            for (int s = 0; s < 8; ++s) o[0][v] = MFMA32(qs[s], cf[s], o[0][v]);
        }
    } }
    float sc0; const float sc1 = 0.f;
    if (MODE == 1) { lam_val = ((volatile LAS float*)(F.lds + MISC_OFF + 96))[0]; lam_init = ((volatile LAS float*)(F.lds + MISC_OFF + 96))[1]; }
    { float lt = sum32x(lsum[0]);
      if (MODE == 2) sc0 = frcp(fmaxf(fabsf(lt), ((const float*)(F.ws + WS_EM))[(size_t)seq * SEQ + q0w + r]));
      else if (MODE == 1) sc0 = (comp ? lam_val : 1.0f) * frcp(lt);
      else sc0 = frcp(lt); }
    if (h == 0) { wsf[r] = sc0; wsf[32 + r] = sc1; }
    WSYNC();
    LAS float* stg = (LAS float*)(F.lds + w * 16384);
#pragma unroll
    for (int g = 0; g < 4; ++g) {
        const f32x4 av = *(LAS const f32x4*)(wsf + 8 * g + 4 * h);
#pragma unroll
        for (int e = 0; e < 4; ++e) { const int i = 4 * g + e, row = 8 * g + 4 * h + e;
#pragma unroll
            for (int v = 0; v < NVB; ++v) { float val = o[0][v][i] * av[e]; stg[row * DV + 32 * v + r] = val; } }
    }
    WSYNC();
    if (MODE == 1) __syncthreads();
    if (MODE != 1 || comp == 0) {
        const int q = lane >> 1, hf = lane & 1; constexpr int HC = DV / 2;
        LAS float* srow_ = stg + q * DV + hf * HC;
        if (MODE == 1) {
            LAS const float* prow_ = (LAS const float*)(F.lds + (w + 4) * 16384) + q * DV + hf * HC;
#pragma unroll
            for (int c4 = 0; c4 < HC / 4; ++c4) *(LAS f32x4*)(srow_ + 4 * c4) = *(LAS const f32x4*)(srow_ + 4 * c4) - *(LAS const f32x4*)(prow_ + 4 * c4);
        }
        size_t grow = rowb + q0w + q;
        bf16_t* Y = (bf16_t*)(F.ws + (probe ? WS_MD : WS_Y)); if (probe) grow &= 4095;
        if (MODE == 0) {
            bf16_t* yp = Y + grow * 1536 + 512 + head * 64 + hf * HC;
#pragma unroll
            for (int c8 = 0; c8 < HC / 8; ++c8) { const f32x4 x0 = *(LAS const f32x4*)(srow_ + 8 * c8), x1 = *(LAS const f32x4*)(srow_ + 8 * c8 + 4);
                u32x4 ov; ov.x = cvtpk(x0[0], x0[1]); ov.y = cvtpk(x0[2], x0[3]); ov.z = cvtpk(x1[0], x1[1]); ov.w = cvtpk(x1[2], x1[3]); *(u32x4*)(yp + 8 * c8) = ov; }
        } else {
            float ss = 0.f;
#pragma unroll
            for (int c4 = 0; c4 < HC / 4; ++c4) { const f32x4 x = *(LAS const f32x4*)(srow_ + 4 * c4); ss += (x[0] * x[0] + x[1] * x[1]) + (x[2] * x[2] + x[3] * x[3]); }
            ss += xor1(ss);
            float rs = 1.0f / sqrtf(ss * (1.f / 128.f) + EPS);
            const float* gain; bf16_t* yp; const bf16_t* gatep = nullptr;
            if (MODE == 1) { rs *= (1.0f - lam_init); gain = a.in[I_DOG] + (size_t)l * 128 + hf * HC; yp = Y + grow * 1536 + 1024 + head * 128 + hf * HC; }
            else { gain = a.in[I_MNG] + (size_t)l * 512 + head * 128 + hf * HC; yp = Y + grow * 1536 + head * 128 + hf * HC; gatep = (const bf16_t*)(F.ws + WS_OM) + grow * 512 + head * 128 + hf * HC; }
#pragma unroll
            for (int c8 = 0; c8 < HC / 8; ++c8) {
                f32x4 x0 = *(LAS const f32x4*)(srow_ + 8 * c8), x1 = *(LAS const f32x4*)(srow_ + 8 * c8 + 4);
                const f32x4 g0 = *(const f32x4*)(gain + 8 * c8), g1 = *(const f32x4*)(gain + 8 * c8 + 4);
                x0 = x0 * rs * g0; x1 = x1 * rs * g1;
                if (MODE == 2) { float gt[8]; ld8f(gatep + 8 * c8, gt);
#pragma unroll
                    for (int e = 0; e < 4; ++e) { x0[e] *= gt[e]; x1[e] *= gt[4 + e]; } }
                u32x4 ov; ov.x = cvtpk(x0[0], x0[1]); ov.y = cvtpk(x0[2], x0[3]); ov.z = cvtpk(x1[0], x1[1]); ov.w = cvtpk(x1[2], x1[3]); *(u32x4*)(yp + 8 * c8) = ov;
            }
        }
    }
    __syncthreads();
}
DI void phase_mixers(Frame& F, const Args& a, int l, int it, int modes, int probe) {
    F.refresh();
    const float* lam = a.in[I_LAM] + (size_t)l * 256;
    const float lam_init = (l == 0) ? 0.2f : 0.35550906759096934f;
    const float s01 = wave_sum(lam[F.lane] * lam[64 + F.lane]), s23 = wave_sum(lam[128 + F.lane] * lam[192 + F.lane]);
    { const float lv = fexp(s01) - fexp(s23) + lam_init; if (F.tid == 0) { ((volatile LAS int*)(F.lds + MISC_OFF + 96))[2] = probe; ((volatile LAS float*)(F.lds + MISC_OFF + 96))[0] = lv; ((volatile LAS float*)(F.lds + MISC_OFF + 96))[1] = lam_init; } }
    const float lam_val = 0.f;
    unsigned* qhead = (unsigned*)(F.ws + WS_CTL) + CW_QUEUE + it * 64;
    volatile LAS unsigned* slot = (volatile LAS unsigned*)(F.lds + MISC_OFF + 64);
    for (;;) {
        if (F.tid == 0) *slot = __hip_atomic_fetch_add(qhead, 1u, __ATOMIC_RELAXED, __HIP_MEMORY_SCOPE_AGENT);
        __syncthreads();
        const int u = __builtin_amdgcn_readfirstlane((int)*slot);
        __syncthreads();
        if (u >= 1280) break;
        if (u < 1024) { const int p_ = u >> 6, k = u & 63;
            if (k < 16) { if (modes & MIXMODES & 2) attn_unit<1>(F, a, l, k >> 2, k & 3, 31 - 2 * p_, lam_val, lam_init); }
            else if (k < 48) { if (modes & MIXMODES & 1) attn_unit<0>(F, a, l, (k - 16) >> 3, (k - 16) & 7, 15 - p_, lam_val, lam_init); }
            else { if (modes & MIXMODES & 2) attn_unit<1>(F, a, l, (k - 48) >> 2, (k - 48) & 3, 30 - 2 * p_, lam_val, lam_init); }
        } else { const int m_ = u - 1024; if (modes & MIXMODES & 4) attn_unit<2>(F, a, l, (m_ >> 2) & 3, m_ & 3, 15 - (m_ >> 4), lam_val, lam_init); }
    }
}

DI void mlstm_state_unit(Frame& F, int sq, int n) {
    F.refresh();
    constexpr int KROWB = 272, VROWB = 320, KBYTES = 64 * KROWB, VBYTES = 64 * VROWB;
    const int tid = F.tid, lane = F.lane, w = F.wave, r = lane & 31, h = lane >> 5, b = sq >> 2, head = sq & 3;
    const size_t rowb = (size_t)b * SEQ;
    const bf16_t* Kp = (const bf16_t*)(F.ws + WS_QK) + 512 + head * 128; const bf16_t* Vp = (const bf16_t*)(F.ws + WS_VM) + head * 128;
    const float* ag = (const float*)(F.ws + WS_AK) + (size_t)sq * SEQ;
    const float Mend = ((const float*)(F.ws + WS_MQ))[(size_t)sq * SEQ + 256 * n + 255];
    f32x16 acc[2];
#pragma unroll
    for (int c = 0; c < 2; ++c)
#pragma unroll
        for (int i = 0; i < 16; ++i) acc[c][i] = 0.f;
    const int dvb = w >> 1, dkb0 = 2 * (w & 1);
    const int srow = tid >> 3, sch = tid & 7;
    const int i16 = lane & 15, vq = i16 >> 2, vp = i16 & 3, vcs = (lane >> 4) & 1;
    const int toffV = (4 * h + vq) * VROWB + (16 * vcs + 4 * vp) * 2, toffK = (4 * h + vq) * KROWB + (16 * vcs + 4 * vp) * 2;
    LAS unsigned char* kb = F.lds; LAS unsigned char* vb = kb + KBYTES; LAS float* wts = (LAS float*)(vb + VBYTES);
    float nacc = 0.f; const int ndk = tid & 127, npart = tid >> 7;
    for (int jt = 0; jt < 4; ++jt) {
        const int j = 4 * n + jt;
        const float wr_ = fexp(*(const GAS float*)(ag + 64 * j + srow) - Mend);
        u32x4 kreg[2], vreg[2];
#pragma unroll
        for (int c = 0; c < 2; ++c) { kreg[c] = *(const GAS u32x4*)(Kp + (rowb + 64 * j + srow) * 1024 + (sch + 8 * c) * 8); vreg[c] = *(const GAS u32x4*)(Vp + (rowb + 64 * j + srow) * 512 + (sch + 8 * c) * 8); }
#pragma unroll
        for (int c = 0; c < 2; ++c) { u32x4 t = vreg[c];
            t.x = cvtpk(bflo(t.x) * wr_, bfhi(t.x) * wr_); t.y = cvtpk(bflo(t.y) * wr_, bfhi(t.y) * wr_); t.z = cvtpk(bflo(t.z) * wr_, bfhi(t.z) * wr_); t.w = cvtpk(bflo(t.w) * wr_, bfhi(t.w) * wr_); vreg[c] = t; }
        __syncthreads();
#pragma unroll
        for (int c = 0; c < 2; ++c) { *(LAS u32x4*)(kb + srow * KROWB + (sch + 8 * c) * 16) = kreg[c]; *(LAS u32x4*)(vb + srow * VROWB + (sch + 8 * c) * 16) = vreg[c]; }
        if (sch == 0) wts[srow] = wr_;
        __syncthreads();
#pragma unroll
        for (int sg = 0; sg < 4; ++sg) {
            const s16x4 alo = trread(vb + toffV + (16 * sg) * VROWB + 64 * dvb), ahi = trread(vb + toffV + (16 * sg + 8) * VROWB + 64 * dvb);
            const bf16x8 af = (bf16x8){alo[0], alo[1], alo[2], alo[3], ahi[0], ahi[1], ahi[2], ahi[3]};
#pragma unroll
            for (int c = 0; c < 2; ++c) {
                const s16x4 blo = trread(kb + toffK + (16 * sg) * KROWB + 64 * (dkb0 + c)), bhi = trread(kb + toffK + (16 * sg + 8) * KROWB + 64 * (dkb0 + c));
                const bf16x8 bfr = (bf16x8){blo[0], blo[1], blo[2], blo[3], bhi[0], bhi[1], bhi[2], bhi[3]};
                acc[c] = MFMA32(af, bfr, acc[c]);
            }
        }
#pragma unroll 4
        for (int s_ = 0; s_ < 16; ++s_) { const int ks = 16 * npart + s_; nacc += wts[ks] * bf2f(*(LAS const bf16_t*)(kb + ks * KROWB + ndk * 2)); }
    }
    float* D = (float*)(F.ws + WS_MD) + ((size_t)sq * 16 + n) * 16384;
#pragma unroll
    for (int c = 0; c < 2; ++c)
#pragma unroll
        for (int i = 0; i < 16; ++i) D[(32 * dvb + (i & 3) + 8 * (i >> 2) + 4 * h) * 128 + 32 * (dkb0 + c) + r] = acc[c][i];
    __syncthreads();
    LAS float* red = (LAS float*)F.lds;
    red[npart * 128 + ndk] = nacc;
    __syncthreads();
    if (tid < 128) ((float*)(F.ws + WS_MN))[((size_t)sq * 16 + n) * 128 + tid] = (red[tid] + red[128 + tid]) + (red[256 + tid] + red[384 + tid]);
    __syncthreads();
}
DI void mlstm_state_scan(Frame& F) {
    const int gid = (F.bid * NWAVES + F.wave) * 64 + F.lane, NG_ = F.G * NWAVES * 64;
    const float* D = (const float*)(F.ws + WS_MD); bf16_t* C = (bf16_t*)(F.ws + WS_MC); const float* MQ = (const float*)(F.ws + WS_MQ);
    for (int e = gid; e < CB * 4 * 16384; e += NG_) {
        const int sq = e >> 14, idx = e & 16383;
        float d[15], me[15];
#pragma unroll
        for (int n = 0; n < 15; ++n) { d[n] = D[((size_t)sq * 16 + n) * 16384 + idx]; me[n] = MQ[(size_t)sq * SEQ + 256 * n + 255]; }
        float c = 0.f;
#pragma unroll
        for (int n = 0; n < 15; ++n) { const float f = n == 0 ? 0.f : fexp(me[n - 1] - me[n]); c = f * c + d[n]; C[((size_t)sq * 16 + n + 1) * 16384 + idx] = (bf16_t)f2bf(c); }
    }
    const float* Nv = (const float*)(F.ws + WS_MN); float* NS = (float*)(F.ws + WS_MN + 128 * 1024);
    for (int e = gid; e < CB * 4 * 128; e += NG_) {
        const int sq = e >> 7, idx = e & 127; float c = 0.f;
#pragma unroll
        for (int n = 0; n < 15; ++n) { const float me = MQ[(size_t)sq * SEQ + 256 * n + 255]; const float f = n == 0 ? 0.f : fexp(MQ[(size_t)sq * SEQ + 256 * (n - 1) + 255] - me);
            c = f * c + Nv[((size_t)sq * 16 + n) * 128 + idx]; NS[((size_t)sq * 16 + n + 1) * 128 + idx] = c; }
    }
}

constexpr size_t SC_BSTRIDE = (size_t)4096 * (64 * 65 / 2);
DI size_t sc_off(int b, int t) { const int qb = t >> 6; return (size_t)b * SC_BSTRIDE + (size_t)4096 * (qb * (qb + 1) / 2) + (size_t)(t & 63) * 64 * (qb + 1); }
constexpr int CW_QUEUE2 = 12288;
DI void phase_scores(Frame& F, int it) {
    F.refresh();
    unsigned* qhead = (unsigned*)(F.ws + WS_CTL) + CW_QUEUE2 + it * 64;
    volatile LAS unsigned* slot = (volatile LAS unsigned*)(F.lds + MISC_OFF + 64);
    const bf16_t* IQ = (const bf16_t*)(F.ws + WS_IQ); const bf16_t* IK = (const bf16_t*)(F.ws + WS_IK); const float* IW = (const float*)(F.ws + WS_IW);
    float* SC = (float*)(F.ws + WS_HREG);
    for (;;) {
        if (F.tid == 0) *slot = __hip_atomic_fetch_add(qhead, 1u, __ATOMIC_RELAXED, __HIP_MEMORY_SCOPE_AGENT);
        __syncthreads();
        const int u = __builtin_amdgcn_readfirstlane((int)*slot);
        __syncthreads();
        if (u >= CB * 160 + 240) break;
        if (u >= CB * 160) { const int m_ = u - CB * 160; mlstm_state_unit(F, m_ & 15, m_ >> 4); continue; }
        int b = u / 160, k = u % 160, qb, seg;
        {
          int cls = 3, base = 0;
          for (;; --cls) { const int cnt = 16 * (cls + 1); if (k < base + cnt) break; base += cnt; }
          const int kk = k - base; qb = 16 * cls + (kk % 16); seg = kk / 16; }
        F.refresh();
        const int lane = F.lane, w = F.wave, r = lane & 31, h = lane >> 5, qh = w & 1;
        const int t0 = 64 * qb + 32 * qh;
        const size_t rowq = (size_t)b * SEQ + t0 + r;
        const f32x4 wv = *(const GAS f32x4*)(IW + rowq * 4);
        bf16x8 qf[4][4];
#pragma unroll
        for (int hd = 0; hd < 4; ++hd)
#pragma unroll
            for (int s = 0; s < 4; ++s) qf[hd][s] = *(const GAS bf16x8*)(IQ + rowq * 256 + hd * 64 + 16 * s + 8 * h);
        LAS unsigned* T = (LAS unsigned*)(F.lds + w * 8448);
        const int jplast = ((16 * seg + 15 < qb) ? 16 * seg + 15 : qb) >> 1;
        unsigned short* scb = (unsigned short*)(F.ws + WS_HREG) + sc_off(b, t0);
        const int rstride = 64 * (qb + 1);
        for (int jp = 8 * seg + (w >> 1); jp <= jplast; jp += 4) {
            const int nt2 = (2 * jp + 1 <= qb) ? 2 : 1;
            bf16x8 kfa[4][4];
#pragma unroll
            for (int q4 = 0; q4 < 4; ++q4) { const int jq = 2 * jp + ((q4 >> 1) < nt2 ? (q4 >> 1) : 0);
#pragma unroll
                for (int s = 0; s < 4; ++s) kfa[q4][s] = *(const GAS bf16x8*)(IK + ((size_t)b * SEQ + 64 * jq + 32 * (q4 & 1) + r) * 64 + 8 * h + 16 * s); }
#pragma unroll
            for (int ts = 0; ts < 2; ++ts) { if (ts < nt2) {
#pragma unroll
                for (int p = 0; p < 2; ++p) {
                    float sc[16];
#pragma unroll
                    for (int i = 0; i < 16; ++i) sc[i] = 0.f;
#pragma unroll
                    for (int hd = 0; hd < 4; ++hd) {
                        f32x16 acc;
#pragma unroll
                        for (int i = 0; i < 16; ++i) acc[i] = 0.f;
#pragma unroll
                        for (int s = 0; s < 4; ++s) acc = MFMA32(kfa[2 * ts + p][s], qf[hd][s], acc);
#pragma unroll
                        for (int i = 0; i < 16; ++i) sc[i] += wv[hd] * fmaxf(acc[i], 0.f);
                    }
#pragma unroll
                    for (int i = 0; i < 16; i += 2) {
                        const unsigned lo = __builtin_bit_cast(unsigned short, (_Float16)(sc[i] + 0.0f)), hi = __builtin_bit_cast(unsigned short, (_Float16)(sc[i + 1] + 0.0f));
                        T[r * 65 + ((64 * ts + 32 * p + (i & 3) + 8 * (i >> 2) + 4 * h) >> 1)] = lo | (hi << 16); }
                }
            } }
            WSYNC();
            if (lane < 32 * nt2) {
#pragma unroll 8
                for (int q = 0; q < 32; ++q) *(unsigned*)(scb + (size_t)q * rstride + 128 * jp + 2 * lane) = T[q * 65 + lane];
            }
            WSYNC();
        }
    }
}
DI unsigned long long spread32(unsigned x) {
    unsigned long long v = x;
    v = (v | (v << 16)) & 0x0000FFFF0000FFFFull; v = (v | (v << 8)) & 0x00FF00FF00FF00FFull; v = (v | (v << 4)) & 0x0F0F0F0F0F0F0F0Full;
    v = (v | (v << 2)) & 0x3333333333333333ull; v = (v | (v << 1)) & 0x5555555555555555ull; return v;
}
DI unsigned pack_nib(unsigned long long bm, int hh) {
    unsigned long long x = (bm >> (4 * hh)) & 0x0F0F0F0F0F0F0F0Full;
    x = (x | (x >> 4)) & 0x00FF00FF00FF00FFull; x = (x | (x >> 8)) & 0x0000FFFF0000FFFFull; x = (x | (x >> 16)) & 0x00000000FFFFFFFFull; return (unsigned)x;
}
DI void radix_find(LAS unsigned* hist, int lane, int& need, unsigned& digit, unsigned& cnt) {
    const u32x4 c = *(LAS const u32x4*)(hist + 4 * lane);
    const unsigned ls = (c.x + c.y) + (c.z + c.w); unsigned inc = ls;
#pragma unroll
    for (int o = 1; o < 64; o <<= 1) { const unsigned y = __shfl_up(inc, o); if (lane >= o) inc += y; }
    const unsigned total = __shfl(inc, 63);
    unsigned cum = total - inc; int fbin = -1; unsigned fneed = 0u, fcnt = 0u;
    if (cum < (unsigned)need && cum + c.w >= (unsigned)need) { fbin = 4 * lane + 3; fneed = (unsigned)need - cum; fcnt = c.w; } cum += c.w;
    if (fbin < 0 && cum < (unsigned)need && cum + c.z >= (unsigned)need) { fbin = 4 * lane + 2; fneed = (unsigned)need - cum; fcnt = c.z; } cum += c.z;
    if (fbin < 0 && cum < (unsigned)need && cum + c.y >= (unsigned)need) { fbin = 4 * lane + 1; fneed = (unsigned)need - cum; fcnt = c.y; } cum += c.y;
    if (fbin < 0 && cum < (unsigned)need && cum + c.x >= (unsigned)need) { fbin = 4 * lane; fneed = (unsigned)need - cum; fcnt = c.x; }
    const int src = __ffsll((long long)__ballot(fbin >= 0)) - 1;
    digit = (unsigned)__shfl(fbin, src); need = (int)__shfl(fneed, src); cnt = __shfl(fcnt, src);
}
template <int NGP>
DI void select_row(int row, int lane, LAS unsigned* hist, const unsigned (&raw)[32], unsigned* MASK, const int probe) {
        const int b = row >> 12, t = row & (SEQ - 1), n = t + 1, ngp = (t >> 7) + 1;
        unsigned key[NGP];
        (void)b;
#pragma unroll
        for (int i = 0; i < NGP; ++i) key[i] = raw[i];
#pragma unroll
        for (int i = 0; i < NGP; ++i) { const int e2 = 64 * i + lane; unsigned w_ = key[i];
            { const unsigned sg_ = (w_ >> 15) & 0x00010001u; w_ ^= ((sg_ << 15) - sg_) + 0x80008000u; }
            if (2 * e2 >= n) w_ &= 0xFFFF0000u; if (2 * e2 + 1 >= n) w_ &= 0x0000FFFFu; key[i] = w_; }
        unsigned thr = 0u; int need = 256; bool ties = false;
        if (n > 256 && probe != 1 && probe != 3) {
            unsigned dA = 0u, dB = 0u, cnt = 0u;
            { unsigned z_ = 0u; asm volatile("" : "+v"(z_)); *(LAS u32x4*)(hist + 4 * lane) = (u32x4){z_, z_, z_, z_}; }
            WSYNC();
#pragma unroll
            for (int i = 0; i < NGP; ++i) if (i < ngp) { const unsigned kx = key[i];
                __hip_atomic_fetch_add(&hist[(kx >> 8) & 255u], 1u, __ATOMIC_RELAXED, __HIP_MEMORY_SCOPE_WORKGROUP); __hip_atomic_fetch_add(&hist[kx >> 24], 1u, __ATOMIC_RELAXED, __HIP_MEMORY_SCOPE_WORKGROUP); }
            WSYNC();
            radix_find(hist, lane, need, dA, cnt);
            WSYNC();
            if ((unsigned)need != cnt) {
                { unsigned z_ = 0u; asm volatile("" : "+v"(z_)); *(LAS u32x4*)(hist + 4 * lane) = (u32x4){z_, z_, z_, z_}; }
                WSYNC();
#pragma unroll
                for (int i = 0; i < NGP; ++i) if (i < ngp) { const unsigned kx = key[i];
                    if (((kx >> 8) & 255u) == dA) __hip_atomic_fetch_add(&hist[kx & 255u], 1u, __ATOMIC_RELAXED, __HIP_MEMORY_SCOPE_WORKGROUP);
                    if ((kx >> 24) == dA) __hip_atomic_fetch_add(&hist[(kx >> 16) & 255u], 1u, __ATOMIC_RELAXED, __HIP_MEMORY_SCOPE_WORKGROUP); }
                WSYNC();
                radix_find(hist, lane, need, dB, cnt);
                WSYNC();
                thr = (dA << 8) | dB; ties = (unsigned)need != cnt;
            } else { thr = dA << 8; ties = false; }
        }
        unsigned elo = 0u, ehi = 0u, olo = 0u, ohi = 0u; int eqc = 0;
        if (probe == 1 || probe == 3) thr = 0x9000u;
        if (probe < 2)
        {
#define SEL_STEP(i) if constexpr ((i) < NGP) if ((i) < ngp) { const unsigned kx = key[(i) < NGP ? (i) : 0], kl = kx & 0xFFFFu, kh = kx >> 16; bool sl, sh; \
            if (n <= 256) { sl = kl != 0u; sh = kh != 0u; } \
            else if (!ties) { sl = kl >= thr; sh = kh >= thr; } \
            else { const bool ql = kl == thr, qh = kh == thr; const unsigned long long ml = __ballot(ql), mh = __ballot(qh), lt = (1ull << lane) - 1ull; \
                const int rl = eqc + __popcll(ml & lt) + __popcll(mh & lt), rh = rl + (ql ? 1 : 0); \
                sl = kl > thr || (ql && rl < need); sh = kh > thr || (qh && rh < need); eqc += __popcll(ml) + __popcll(mh); } \
            const unsigned long long be = __ballot(sl), bo = __ballot(sh); const unsigned e0 = (unsigned)be, e1 = (unsigned)(be >> 32), o0 = (unsigned)bo, o1 = (unsigned)(bo >> 32); \
            asm volatile("s_nop 4\n\tv_writelane_b32 %0, %4, " #i "\n\tv_writelane_b32 %1, %5, " #i "\n\tv_writelane_b32 %2, %6, " #i "\n\tv_writelane_b32 %3, %7, " #i \
                         : "+v"(elo), "+v"(ehi), "+v"(olo), "+v"(ohi) : "s"(e0), "s"(e1), "s"(o0), "s"(o1)); }
#define SEL8(b) SEL_STEP(b) SEL_STEP(b + 1) SEL_STEP(b + 2) SEL_STEP(b + 3) SEL_STEP(b + 4) SEL_STEP(b + 5) SEL_STEP(b + 6) SEL_STEP(b + 7)
        SEL8(0) SEL8(8) SEL8(16) SEL8(24)
#undef SEL8
#undef SEL_STEP
        }
        if (lane < 32) {
            const unsigned long long ta = spread32(elo) | (spread32(olo) << 1), tb = spread32(ehi) | (spread32(ohi) << 1);
            *(u32x2*)(MASK + ((size_t)row * 2 + 0) * 64 + 2 * lane) = (u32x2){pack_nib(ta, 0), pack_nib(tb, 0)};
            *(u32x2*)(MASK + ((size_t)row * 2 + 1) * 64 + 2 * lane) = (u32x2){pack_nib(ta, 1), pack_nib(tb, 1)};
        }
}
DI void phase_select(Frame& F, const int probe) {
    F.refresh();
    const int gw = F.bid * NWAVES + F.wave, NGW = F.G * NWAVES, lane = F.lane;
    LAS unsigned* hist = (LAS unsigned*)(F.lds + F.wave * 1024);
    const unsigned short* SC = (const unsigned short*)(F.ws + WS_HREG); unsigned* MASK = (unsigned*)(F.ws + WS_MASK);
    if (!probe) mlstm_state_scan(F);
    unsigned cur[32];
#define LOAD_ROW(dst, rw) do { const int t_ = (rw) & (SEQ - 1), em_ = t_ >> 1; const unsigned* sr_ = (const unsigned*)(SC + sc_off((rw) >> 12, t_)); \
        _Pragma("unroll") for (int i_ = 0; i_ < 32; ++i_) { const int e_ = 64 * i_ + lane; dst[i_] = *(const GAS unsigned*)(sr_ + (e_ < em_ ? e_ : em_)); } } while (0)
    const int nstep = (MC + NGW - 1) / NGW;
#define ROW_OF(k) ((NGW == 2048) ? (((k) >> 1) * SEQ + (((k) & 1) ? (SEQ - 1 - gw) : gw)) : (gw + (k) * NGW))
    if (gw < MC) LOAD_ROW(cur, ROW_OF(0));
    for (int k = 0; k < nstep; ++k) {
        const int row = ROW_OF(k); if (row >= MC) break;
        unsigned nxt[32]; const int nrow = (k + 1 < nstep && ROW_OF(k + 1) < MC) ? ROW_OF(k + 1) : row;
        LOAD_ROW(nxt, nrow);
        asm volatile("" ::: "memory");
        const int cls = (row & (SEQ - 1)) >> 10;
        unsigned* mk = probe ? (unsigned*)(F.ws + WS_QKRAW) : MASK;
        if (cls == 0) select_row<8>(row, lane, hist, cur, mk, probe);
        else if (cls == 1) select_row<16>(row, lane, hist, cur, mk, probe);
        else if (cls == 2) select_row<24>(row, lane, hist, cur, mk, probe);
        else select_row<32>(row, lane, hist, cur, mk, probe);
#pragma unroll
        for (int i = 0; i < 32; ++i) cur[i] = nxt[i];
    }
#undef ROW_OF
#undef LOAD_ROW
}

#ifndef MK_ONE_LAUNCH
#define MK_ONE_LAUNCH 1
#endif
constexpr int NPHASE = 13;
__global__ void __launch_bounds__(NWAVES * 64, 2) fwd(Args args) {
    extern __shared__ __attribute__((aligned(16))) unsigned char lds[];
    Frame F;
    F.lds = (LAS unsigned char*)lds; F.ws = args.ws;
    F.tid = threadIdx.x; F.lane = F.tid & 63; F.wave = __builtin_amdgcn_readfirstlane(F.tid >> 6); F.wave0 = F.wave;
    F.G = gridDim.x; F.bid = blockIdx.x;
    volatile LAS unsigned* MISC = (volatile LAS unsigned*)(F.lds + MISC_OFF);
    for (int u = F.tid; u < (LDS_BYTES - LDSCTL_OFF) / 4; u += NWAVES * 64) ((LAS unsigned*)(F.lds + LDSCTL_OFF))[u] = 0u;
    __syncthreads();
    const bool multi = MK_ONE_LAUNCH ? true : !(args.it_hi - args.it_lo == 1 && args.ph_hi - args.ph_lo == 1);
    XcdBarrier bar; bar.bar = (unsigned*)(F.ws + WS_CTL) + CW_BAR; bar.x = 0; bar.st = nullptr;
    if (multi) bar = xcd_barrier_post((unsigned*)(F.ws + WS_CTL) + CW_BAR, MISC + 8);
#define GRID_BAR() do { if (multi) { xcd_barrier(bar); if ((REPMASK >> 15) & 1) xcd_barrier(bar); } } while (0)
    const int lo = args.ph_lo, hi = args.ph_hi; (void)lo; (void)hi;
#ifndef PHMASK
#define PHMASK 0xFFFF
#endif
#if MK_ONE_LAUNCH
#define IN(k) ((PHMASK >> (k)) & 1)
#else
#define IN(k) (((PHMASK >> (k)) & 1) && lo <= (k) && (k) < hi)
#endif
#ifndef REPMASK
#define REPMASK 0
#endif
#define PROBE_MODES 7
#define PROBE_NOLOAD 0
#define REPS(k) (1 + ((REPMASK >> (k)) & 1))
    if (IN(0) && args.it_lo == 0) for (int rp = 0; rp < REPS(0); ++rp) { phase_prologue(F, args); GRID_BAR(); }
    for (int it = args.it_lo; it < args.it_hi; ++it) {
        const int chunk = it >> 1, l = it & 1;
        unsigned char* wl = F.ws + WS_W + (size_t)l * W_LAYER;
        const size_t xoff = (size_t)chunk * MC * DM;
        const float* xsrc = (l == 0 ? args.in[I_X] : args.out) + xoff;
        float* X = args.out + xoff;
        bf16_t* XN = (bf16_t*)(F.ws + WS_XN);
        if (IN(1)) for (int rp = 0; rp < REPS(1); ++rp) { phase_rmsnorm(F, xsrc, args.in[I_NMG] + (size_t)l * DM, XN); GRID_BAR(); }
        if (IN(2)) for (int rp = 0; rp < REPS(2); ++rp) {
            pg8::Gemm g{XN, (const bf16_t*)(wl + WO_IN), MC, NT_IN * 256, DM}; F.refresh(); pg8::StaticOrder S; S.init(MC, NT_IN * 256, F.G, F.bid);
            EpiInProj E{F.ws, args.in[I_GB] + l * 8, l};
            pg8::gemm_phase<EpiInProj, true>(F.lds, g, S, E, F.tid);
            GRID_BAR();
        }
        if (IN(3)) for (int rp = 0; rp < REPS(3); ++rp) { phase_token(F, args, l, rp == 0 ? 0 : PROBE_NOLOAD); GRID_BAR(); }
        if (IN(4)) for (int rp = 0; rp < REPS(4); ++rp) {
            pg8::Gemm g{(const bf16_t*)(F.ws + WS_CKV), (const bf16_t*)(wl + WO_KV), MC, 1024, 256}; F.refresh(); pg8::StaticOrder S; S.init(MC, 1024, F.G, F.bid);
            EpiKV E{F.ws, l};
            pg8::gemm_phase<EpiKV, true>(F.lds, g, S, E, F.tid);
            if (rp + 1 < REPS(4)) GRID_BAR();
        }
#ifdef NAIVE_SEL
        if (IN(5)) { naive_select(F); GRID_BAR(); }
#else
        if (IN(5)) { for (int rp = 0; rp < REPS(5); ++rp) { phase_scores(F, it + 8 * rp); GRID_BAR(); } for (int rp = 0; rp < REPS(13); ++rp) { phase_select(F, rp == 0 ? 0 : PROBE_NOLOAD); GRID_BAR(); } }
#endif
        #ifdef NAIVE_MIX
        if (IN(6)) { naive_dsa(F); __syncthreads(); naive_mlstm(F, args, l); __syncthreads(); naive_diff(F, args, l); GRID_BAR(); }
#else
        if (IN(6)) for (int rp = 0; rp < REPS(6); ++rp) { phase_mixers(F, args, l, it + 8 * rp, rp == 0 ? 7 : PROBE_MODES, rp == 0 ? 0 : PROBE_NOLOAD); if (rp + 1 < REPS(6)) GRID_BAR(); }
#endif
        if (IN(7)) for (int rp = 0; rp < REPS(7); ++rp) {
            pg8::Gemm g{XN, (const bf16_t*)(wl + WO_G), MC, 3072, DM}; F.refresh(); pg8::StaticOrder S; S.init(MC, 3072, F.G, F.bid);
            EpiGate E{(bf16_t*)(F.ws + WS_HREG), args.in[I_BG] + (size_t)l * 3072};
            pg8::gemm_phase<EpiGate, true>(F.lds, g, S, E, F.tid);
            GRID_BAR();
        }
        if (IN(8)) for (int rp = 0; rp < REPS(8); ++rp) {
            pg8::Gemm g{(const bf16_t*)(F.ws + WS_Y), (const bf16_t*)(wl + WO_BR), MC, 1024, 1536}; F.refresh(); pg8::StaticOrder S; S.init(MC, 1024, F.G, F.bid);
            EpiMerge E{(const bf16_t*)(F.ws + WS_HREG), (bf16_t*)(F.ws + WS_MG)};
            pg8::gemm_phase<EpiMerge, false>(F.lds, g, S, E, F.tid);
            GRID_BAR();
        }
        if (IN(9)) for (int rp = 0; rp < REPS(9); ++rp) {
            pg8::Gemm g{(const bf16_t*)(F.ws + WS_MG), (const bf16_t*)(wl + WO_OUT), MC, 1024, 1024}; F.refresh(); pg8::StaticOrder S; S.init(MC, 1024, F.G, F.bid);
            EpiResid E{xsrc, rp == 0 ? X : (float*)(F.ws + WS_XN)};
            pg8::gemm_phase<EpiResid, false>(F.lds, g, S, E, F.tid);
            GRID_BAR();
        }
        if (IN(10)) for (int rp = 0; rp < REPS(10); ++rp) { phase_rmsnorm(F, X, args.in[I_NFG] + (size_t)l * DM, XN); GRID_BAR(); }
        if (IN(11)) for (int rp = 0; rp < REPS(11); ++rp) {
            pg8::Gemm g{XN, (const bf16_t*)(wl + WO_GU), MC, 5632, DM}; F.refresh(); pg8::StaticOrder S; S.init(MC, 5632, F.G, F.bid);
            EpiSwiGLU E{(bf16_t*)(F.ws + WS_HREG)};
            pg8::gemm_phase<EpiSwiGLU, true>(F.lds, g, S, E, F.tid);
            GRID_BAR();
        }
        if (IN(12)) for (int rp = 0; rp < REPS(12); ++rp) {
            pg8::Gemm g{(const bf16_t*)(F.ws + WS_HREG), (const bf16_t*)(wl + WO_D), MC, 1024, FF}; F.refresh(); pg8::StaticOrder S; S.init(MC, 1024, F.G, F.bid);
            EpiResid E{X, rp == REPS(12) - 1 ? X : (float*)(F.ws + WS_XN)};
            pg8::gemm_phase<EpiResid, false>(F.lds, g, S, E, F.tid);
            GRID_BAR();
        }
    }
#undef IN
#undef GRID_BAR
}

extern "C" void kernel_launch(void* const* d_in, const int* in_sizes, int n_in, void* d_out, int out_size, void* d_ws, size_t ws_size, hipStream_t stream) {
    static int grid = 0;
    if (grid == 0) {
        if (n_in != 21 || ws_size < WS_END) { fprintf(stderr, "kernel_launch: unexpected inputs (n_in %d, ws %zu)\n", n_in, ws_size); grid = -1; return; }
        int dev = 0, cus = 0;
        if (hipGetDevice(&dev) != hipSuccess || hipDeviceGetAttribute(&cus, hipDeviceAttributeMultiprocessorCount, dev) != hipSuccess) { grid = -1; return; }
        if (hipFuncSetAttribute((const void*)fwd, hipFuncAttributeMaxDynamicSharedMemorySize, LDS_BYTES) != hipSuccess) { grid = -1; return; }
        int per_cu = 0;
        if (hipOccupancyMaxActiveBlocksPerMultiprocessor(&per_cu, (const void*)fwd, NWAVES * 64, LDS_BYTES) != hipSuccess || per_cu < 1) fprintf(stderr, "kernel_launch: occupancy query says %d\n", per_cu);
        (void)hipGetLastError();
        grid = cus;
    }
    if (grid < 0) return;
    (void)hipMemsetAsync((char*)d_ws + WS_CTL, 0, CTL_ZERO_BYTES, stream);
    Args a{};
    for (int i = 0; i < 21; ++i) a.in[i] = (const float*)d_in[i];
    a.out = (float*)d_out; a.ws = (unsigned char*)d_ws;
#if MK_ONE_LAUNCH
    a.it_lo = 0; a.it_hi = NCHUNK * DEPTH; a.ph_lo = 0; a.ph_hi = NPHASE;
    hipLaunchKernelGGL(fwd, dim3(grid), dim3(NWAVES * 64), LDS_BYTES, stream, a);
#else
    a.it_lo = 0; a.it_hi = 1; a.ph_lo = 0; a.ph_hi = 1;
    hipLaunchKernelGGL(fwd, dim3(grid), dim3(NWAVES * 64), LDS_BYTES, stream, a);
    for (int it = 0; it < NCHUNK * DEPTH; ++it)
        for (int ph = 1; ph < NPHASE; ++ph) { a.it_lo = it; a.it_hi = it + 1; a.ph_lo = ph; a.ph_hi = ph + 1; hipLaunchKernelGGL(fwd, dim3(grid), dim3(NWAVES * 64), LDS_BYTES, stream, a); }
#endif
}
```

```cpp
#include <hip/hip_runtime.h>
#include <cstdio>
#include <cstdint>

#define DI __device__ __forceinline__
#define LAS __attribute__((address_space(3)))
#define GAS __attribute__((address_space(1)))

typedef unsigned short bf16_t;
typedef short bf16x8 __attribute__((ext_vector_type(8)));
typedef float f32x4 __attribute__((ext_vector_type(4)));
typedef float f32x2 __attribute__((ext_vector_type(2)));
typedef unsigned u32x4 __attribute__((ext_vector_type(4)));
typedef unsigned u32x2 __attribute__((ext_vector_type(2)));

constexpr int BATCH = 8, SEQ = 4096, DM = 1024, DEPTH = 2;
constexpr int CB = 4;
constexpr int MC = CB * SEQ;
constexpr int NCHUNK = BATCH / CB;
constexpr int IN_COLS = 7756;
constexpr int FF = 2816;
constexpr float EPS = 1e-6f;
constexpr float LOG2E = 1.4426950408889634f;
constexpr float C2 = 0.125f * LOG2E;
constexpr int Z_MQK = 0, Z_MV = 1024, Z_MO = 1536, Z_MIF = 2048, Z_SQ = 2056, Z_CKV = 2568, Z_IQ = 2824, Z_IK = 3080, Z_IW = 3144, Z_DQ = 3148, Z_DK = 3660, Z_DV = 4172, Z_G = 4684;
constexpr int NT_IN = 19;

constexpr size_t MiB = 1u << 20;
constexpr size_t WS_CTL = 0, CTL_ZERO_BYTES = 128 * 1024;
constexpr size_t WS_COS = 1 * MiB, WS_SIN = 1 * MiB + 512 * 1024;
constexpr size_t WS_W = 2 * MiB, W_LAYER = 38 * MiB;
constexpr size_t WO_IN = 0;
constexpr size_t WO_G = WO_IN + (size_t)NT_IN * 256 * 1024 * 2;
constexpr size_t WO_KV = WO_G + (size_t)3072 * 1024 * 2;
constexpr size_t WO_BR = WO_KV + (size_t)1024 * 256 * 2;
constexpr size_t WO_OUT = WO_BR + (size_t)1024 * 1536 * 2;
constexpr size_t WO_GU = WO_OUT + (size_t)1024 * 1024 * 2;
constexpr size_t WO_D = WO_GU + (size_t)5632 * 1024 * 2;
static_assert(WO_D + (size_t)1024 * 2816 * 2 <= W_LAYER, "weights per layer");
constexpr size_t WS_ACT = WS_W + 2 * W_LAYER;
constexpr size_t WS_XN = WS_ACT;
constexpr size_t WS_QKRAW = WS_XN + 32 * MiB;
constexpr size_t WS_CKV = WS_QKRAW + 32 * MiB;
constexpr size_t WS_IQ = WS_CKV + 8 * MiB;
constexpr size_t WS_Y = WS_QKRAW;
constexpr size_t WS_QK = WS_IQ + 8 * MiB;
constexpr size_t WS_MG = WS_QK;
constexpr size_t WS_VM = WS_QK + 32 * MiB;
constexpr size_t WS_OM = WS_VM + 16 * MiB;
constexpr size_t WS_SQ = WS_OM + 16 * MiB;
constexpr size_t WS_DQ = WS_SQ + 16 * MiB;
constexpr size_t WS_DK = WS_DQ + 16 * MiB;
constexpr size_t WS_DV = WS_DK + 16 * MiB;
constexpr size_t WS_SK = WS_DV + 16 * MiB;
constexpr size_t WS_SV = WS_SK + 16 * MiB;
constexpr size_t WS_IK = WS_SV + 16 * MiB;
constexpr size_t WS_IF = WS_IK + 2 * MiB;
constexpr size_t WS_IW = WS_IF + 512 * 1024;
constexpr size_t WS_RT = WS_IW + 256 * 1024;
constexpr size_t WS_AK = WS_RT + 256 * 1024;
constexpr size_t WS_MQ = WS_AK + 256 * 1024;
constexpr size_t WS_EM = WS_MQ + 256 * 1024;
constexpr size_t WS_MASK = WS_IK + 4 * MiB;
constexpr size_t WS_HREG = WS_MASK + 8 * MiB;
constexpr size_t WS_X16 = WS_HREG + 96 * MiB;
constexpr size_t WS_MD = WS_X16 + 32 * MiB;
constexpr size_t WS_MC = WS_MD + 16 * MiB;
constexpr size_t WS_MN = WS_MC + 8 * MiB;
constexpr size_t WS_END = WS_MN + 1 * MiB;
static_assert(WS_EM + 256 * 1024 <= WS_MASK, "small buffers");
static_assert(WS_END <= 512 * MiB, "workspace");
constexpr int CW_BAR = 4096;
constexpr size_t WS_GAIN = 512 * 1024;

constexpr int RING_BYTES = 131072;
constexpr int LDSCTL_OFF = RING_BYTES, MISC_OFF = LDSCTL_OFF + 320;
constexpr int LDS_BYTES = 147456;
constexpr int NWAVES = 8;

DI float bf2f(unsigned v) { return __uint_as_float(v << 16); }
DI unsigned f2bf(float f) { unsigned u = __float_as_uint(f); return (u + 0x7fffu + ((u >> 16) & 1u)) >> 16; }
DI unsigned pk2(float lo, float hi) { return f2bf(lo) | (f2bf(hi) << 16); }
DI float bflo(unsigned w) { return __uint_as_float(w << 16); }
DI float bfhi(unsigned w) { return __uint_as_float(w & 0xffff0000u); }
typedef unsigned u32x2v __attribute__((ext_vector_type(2)));
DI float xor1(float v)  { return __uint_as_float((unsigned)__builtin_amdgcn_mov_dpp((int)__float_as_uint(v), 0xB1, 0xF, 0xF, true)); }
DI float xor2(float v)  { return __uint_as_float((unsigned)__builtin_amdgcn_mov_dpp((int)__float_as_uint(v), 0x4E, 0xF, 0xF, true)); }
DI float ror4(float v)  { return __uint_as_float((unsigned)__builtin_amdgcn_mov_dpp((int)__float_as_uint(v), 0x124, 0xF, 0xF, true)); }
DI float ror8(float v)  { return __uint_as_float((unsigned)__builtin_amdgcn_mov_dpp((int)__float_as_uint(v), 0x128, 0xF, 0xF, true)); }
DI float sum16x(float v) { const unsigned u = __float_as_uint(v); const auto r = __builtin_amdgcn_permlane16_swap(u, u, false, false); return __uint_as_float(r[0]) + __uint_as_float(r[1]); }
DI float sum32x(float v) { const unsigned u = __float_as_uint(v); const auto r = __builtin_amdgcn_permlane32_swap(u, u, false, false); return __uint_as_float(r[0]) + __uint_as_float(r[1]); }
DI float max16x(float v) { const unsigned u = __float_as_uint(v); const auto r = __builtin_amdgcn_permlane16_swap(u, u, false, false); return fmaxf(__uint_as_float(r[0]), __uint_as_float(r[1])); }
DI float max32x(float v) { const unsigned u = __float_as_uint(v); const auto r = __builtin_amdgcn_permlane32_swap(u, u, false, false); return fmaxf(__uint_as_float(r[0]), __uint_as_float(r[1])); }
DI unsigned shup_u(unsigned v, int o, int lane) { return (unsigned)__builtin_amdgcn_ds_bpermute(((lane - o) & 63) << 2, (int)v); }
DI float shup_f(float v, int o, int lane) { return __uint_as_float(shup_u(__float_as_uint(v), o, lane)); }
DI double shup_d(double v, int o, int lane) { const unsigned long long u = __builtin_bit_cast(unsigned long long, v); const unsigned lo = shup_u((unsigned)u, o, lane), hi = shup_u((unsigned)(u >> 32), o, lane); return __builtin_bit_cast(double, ((unsigned long long)hi << 32) | lo); }
DI unsigned rdl_u(unsigned v, int src) { return (unsigned)__builtin_amdgcn_readlane((int)v, src); }
DI float wave_sum(float v) { v += xor1(v); v += xor2(v); v += ror4(v); v += ror8(v); v = sum16x(v); return sum32x(v); }
DI float wave_max(float v) { v = fmaxf(v, xor1(v)); v = fmaxf(v, xor2(v)); v = fmaxf(v, ror4(v)); v = fmaxf(v, ror8(v)); v = max16x(v); return max32x(v); }
typedef __bf16 bf16x2e_t __attribute__((ext_vector_type(2)));
DI unsigned cvtpk_(float lo, float hi) { f32x2 v = {lo, hi}; bf16x2e_t b = __builtin_convertvector(v, bf16x2e_t); return __builtin_bit_cast(unsigned, b); }
DI float fexp2(float x) { return __builtin_amdgcn_exp2f(x); }
DI float fexp(float x) { return __builtin_amdgcn_exp2f(x * LOG2E); }
DI float frcp(float x) { return __builtin_amdgcn_rcpf(x); }
DI float sigmoidf_(float x) { return frcp(1.0f + fexp(-x)); }
#define WSYNC() do { asm volatile("s_waitcnt lgkmcnt(0)" ::: "memory"); __builtin_amdgcn_wave_barrier(); } while (0)

namespace pg8 {
constexpr int BM = 256, BK = 64, HALF = 128, HTB = HALF * BK * 2, STAGE_BYTES = 8 * HTB, NXCD = 8, WGM = 8;
__host__ __device__ __forceinline__ int lds_byte(int r, int c) { const int st = (r >> 4) * 2 + (c >> 5), rr = r & 15, cc = c & 31, ob = rr * 64 + cc * 2; return st * 1024 + (ob ^ (((ob >> 9) & 1) << 5)); }
__host__ __device__ __forceinline__ void stage_rc(int b, int& R, int& C) { const int st = b / 1024, sb = b % 1024, swz = sb ^ (((sb >> 9) & 1) << 5); R = (st >> 1) * 16 + swz / 64; C = (st & 1) * 32 + (swz % 64) / 2; }
__host__ __device__ __forceinline__ int perm32(int rho) { const int n = rho >> 4, i = rho & 15; return 8 * (i >> 2) + 4 * n + (i & 3); }
struct Unit { int pm, pn; };
struct Gemm { const bf16_t* A; const bf16_t* Bt; int M, N, K; };
struct StaticOrder {
    int nM, nN, nwg, G, c;
    __host__ __device__ void init(int M, int N, int G_, int c_) { nM = M / BM; nN = N / BM; nwg = nM * nN; G = G_; c = c_; }
    __host__ __device__ bool next(int i, Unit& u) const {
        const long L = (long)i * G + c; if (L >= nwg) return false;
        int wgid = (int)L; { const int q = nwg / NXCD, r = nwg % NXCD, xcd = wgid % NXCD, off = wgid / NXCD; wgid = (xcd < r ? xcd * (q + 1) : r * (q + 1) + (xcd - r) * q) + off; }
        const int nig = WGM * nN, gid = wgid / nig, fm = gid * WGM, gsz = (nM - fm) < WGM ? (nM - fm) : WGM;
        u.pm = fm + ((wgid % nig) % gsz); u.pn = (wgid % nig) / gsz; return true;
    }
};
template <class Epi, bool ALIGN_EPI>
__device__ __forceinline__ void gemm_phase(LAS unsigned char* lds, const Gemm g, const StaticOrder& S, const Epi& E, int tid_in) {
    int tid_ = tid_in; asm volatile("" : "+v"(tid_));
    int K_ = g.K; asm volatile("" : "+s"(K_));
    const int tid = tid_, wid = __builtin_amdgcn_readfirstlane(tid >> 6), lane = tid & 63, wr = wid >> 2, wc = wid & 3, fr = lane & 15, fq = lane >> 4;
    const int K = K_, nt = K / BK;
    unsigned voffA[2], voffB[2];
#pragma unroll
    for (int i = 0; i < 2; ++i) { int R, C; stage_rc(tid * 16 + i * 8192, R, C); const int Rb = Epi::PERM ? ((R & ~31) + perm32(R & 31)) : R;
        voffA[i] = (unsigned)(R * K + C) * 2u; voffB[i] = (unsigned)(Rb * K + C) * 2u; }
    const size_t kstep = (size_t)(BK * 2);
    const size_t hstep = (size_t)HALF * K * 2;
    const size_t tstep = 2 * hstep;
    const unsigned ldsw = (unsigned)wid * 1024u;
    const int aoff = lds_byte(wr * 64 + fr, fq * 8), boff = lds_byte(wc * 32 + fr, fq * 8);
#define PG8_SA(b, h) (((b) * 2 + (h)) * HTB)
#define PG8_SB(b, h) ((4 + (b) * 2 + (h)) * HTB)
#define PG8_STAGE(bufoff, gbase, voff) do { _Pragma("unroll") for (int _i = 0; _i < 2; ++_i) \
        __builtin_amdgcn_global_load_lds((const unsigned*)((const char*)(gbase) + (voff)[_i]), (LAS unsigned*)(lds + (bufoff) + ldsw + _i * 8192), 16, 0, 0); } while (0)
#define PG8_LDA(dst, b, h) do { _Pragma("unroll") for (int m = 0; m < 4; ++m) _Pragma("unroll") for (int k = 0; k < 2; ++k) dst[m][k] = *(const LAS bf16x8*)(lds + PG8_SA(b, h) + aoff + m * 2048 + k * 1024); } while (0)
#define PG8_LDB(dst, b, h) do { _Pragma("unroll") for (int n = 0; n < 2; ++n) _Pragma("unroll") for (int k = 0; k < 2; ++k) dst[n][k] = *(const LAS bf16x8*)(lds + PG8_SB(b, h) + boff + n * 2048 + k * 1024); } while (0)
#define PG8_MMA(ai, bj, At, Bt) do { __builtin_amdgcn_s_setprio(1); _Pragma("unroll") for (int m = 0; m < 4; ++m) _Pragma("unroll") for (int n = 0; n < 2; ++n) _Pragma("unroll") for (int k = 0; k < 2; ++k) \
        acc[ai][bj][m][n] = __builtin_amdgcn_mfma_f32_16x16x32_bf16(Bt[n][k], At[m][k], acc[ai][bj][m][n], 0, 0, 0); __builtin_amdgcn_s_setprio(0); } while (0)
#define PG8_WAIT_V(n) asm volatile("s_waitcnt vmcnt(" #n ")" ::: "memory")
#define PG8_WAIT_L(n) asm volatile("s_waitcnt lgkmcnt(" #n ")" ::: "memory")
#define PG8_BAR __builtin_amdgcn_s_barrier()
#define PG8_SCHED __builtin_amdgcn_sched_barrier(0)
    Unit cur, nxt; int ui = 0;
    if (!S.next(0, cur)) return;
    f32x4 acc[2][2][4][2];
    if constexpr (Epi::INIT) { int fr_ = fr, fq_ = fq, wr_ = wr, wc_ = wc; asm volatile("" : "+v"(fr_), "+v"(fq_), "+s"(wr_), "+s"(wc_)); E.init(acc, cur, wr_, wc_, fr_, fq_); }
    else {
#pragma unroll
    for (int a = 0; a < 2; ++a)
#pragma unroll
        for (int b = 0; b < 2; ++b)
#pragma unroll
            for (int m = 0; m < 4; ++m)
#pragma unroll
                for (int n = 0; n < 2; ++n) acc[a][b][m][n] = (f32x4){0.f, 0.f, 0.f, 0.f};
    }
    bf16x8 At[4][2], B0[2][2], B1[2][2];
    const char* cA = (const char*)g.A + (size_t)cur.pm * tstep; const char* cB = (const char*)g.Bt + (size_t)cur.pn * tstep;
    PG8_STAGE(PG8_SB(0, 0), cB, voffB); PG8_STAGE(PG8_SB(0, 1), cB + hstep, voffB); PG8_STAGE(PG8_SA(0, 0), cA, voffA); PG8_STAGE(PG8_SA(0, 1), cA + hstep, voffA);
    if (wr == 1) PG8_BAR;
    PG8_WAIT_V(2); PG8_BAR;
    PG8_STAGE(PG8_SB(1, 0), cB + kstep, voffB); PG8_STAGE(PG8_SA(1, 0), cA + kstep, voffA); PG8_STAGE(PG8_SB(1, 1), cB + hstep + kstep, voffB);
    PG8_WAIT_V(6); PG8_BAR;
    for (;;) {
        const bool has_next = S.next(ui + 1, nxt);
        const char* nA = has_next ? (const char*)g.A + (size_t)nxt.pm * tstep : cA; const char* nB = has_next ? (const char*)g.Bt + (size_t)nxt.pn * tstep : cB;
        for (int t = 0; t < nt; t += 2) {
            const bool last = (t == nt - 2);
            const char* a1 = cA + (size_t)(t + 1) * kstep;
            const char* a2 = last ? nA : cA + (size_t)(t + 2) * kstep; const char* b2 = last ? nB : cB + (size_t)(t + 2) * kstep;
            const char* a3 = a2 + kstep; const char* b3 = b2 + kstep;
            if constexpr (Epi::MIDK) { if (t == 8 || t == 16) { int fr_ = fr, fq_ = fq, wr_ = wr, wc_ = wc; asm volatile("" : "+v"(fr_), "+v"(fq_), "+s"(wr_), "+s"(wc_)); E.mid(acc, cur, t, wr_, wc_, fr_, fq_); } }
            PG8_LDB(B0, 0, 0); PG8_LDB(B1, 0, 1); PG8_SCHED; PG8_LDA(At, 0, 0); PG8_STAGE(PG8_SA(1, 1), a1 + hstep, voffA);
            PG8_WAIT_V(8); PG8_WAIT_L(0); PG8_BAR; PG8_MMA(0, 0, At, B0); PG8_MMA(0, 1, At, B1); PG8_BAR; PG8_SCHED;
            PG8_LDA(At, 0, 1); PG8_STAGE(PG8_SB(0, 0), b2, voffB); PG8_STAGE(PG8_SB(0, 1), b2 + hstep, voffB); PG8_STAGE(PG8_SA(0, 0), a2, voffA);
            PG8_WAIT_V(8); PG8_WAIT_L(0); PG8_BAR; PG8_MMA(1, 0, At, B0); PG8_MMA(1, 1, At, B1); PG8_BAR; PG8_SCHED;
            PG8_LDB(B0, 1, 0); PG8_LDB(B1, 1, 1); PG8_SCHED; PG8_LDA(At, 1, 0); PG8_STAGE(PG8_SA(0, 1), a2 + hstep, voffA);
            PG8_WAIT_V(8); PG8_WAIT_L(0); PG8_BAR; PG8_MMA(0, 0, At, B0); PG8_MMA(0, 1, At, B1); PG8_BAR; PG8_SCHED;
            PG8_LDA(At, 1, 1); PG8_STAGE(PG8_SB(1, 0), b3, voffB); PG8_STAGE(PG8_SB(1, 1), b3 + hstep, voffB); PG8_STAGE(PG8_SA(1, 0), a3, voffA);
            PG8_WAIT_V(8); PG8_WAIT_L(0); PG8_BAR; PG8_MMA(1, 0, At, B0); PG8_MMA(1, 1, At, B1); PG8_BAR; PG8_SCHED;
        }
        if constexpr (ALIGN_EPI) { if (wr == 0) PG8_BAR; }
        { int fr_ = fr, fq_ = fq, wr_ = wr, wc_ = wc; asm volatile("" : "+v"(fr_), "+v"(fq_), "+s"(wr_), "+s"(wc_)); E(acc, cur, wr_, wc_, fr_, fq_); }
        if (!has_next) break;
        if constexpr (Epi::INIT) { int fr_ = fr, fq_ = fq, wr_ = wr, wc_ = wc; asm volatile("" : "+v"(fr_), "+v"(fq_), "+s"(wr_), "+s"(wc_)); E.init(acc, nxt, wr_, wc_, fr_, fq_); }
        else {
#pragma unroll
        for (int a = 0; a < 2; ++a)
#pragma unroll
            for (int b = 0; b < 2; ++b)
#pragma unroll
                for (int m = 0; m < 4; ++m)
#pragma unroll
                    for (int n = 0; n < 2; ++n) acc[a][b][m][n] = (f32x4){0.f, 0.f, 0.f, 0.f};
        }
        cur = nxt; cA = nA; cB = nB; ++ui;
        if constexpr (ALIGN_EPI) { if (wr == 1) PG8_BAR; }
    }
    PG8_WAIT_V(0);
    if constexpr (!ALIGN_EPI) { if (wr == 0) PG8_BAR; }
    PG8_BAR;
#undef PG8_SA
#undef PG8_SB
#undef PG8_STAGE
#undef PG8_LDA
#undef PG8_LDB
#undef PG8_MMA
#undef PG8_WAIT_V
#undef PG8_WAIT_L
#undef PG8_BAR
#undef PG8_SCHED
}
}

#define XB_TMO      128
#define XB_XCNT(j)  (256  + 64 * (j))
#define XB_XSUB(j)  (1280 + 64 * (j))
#define XB_XGEN(j)  (2304 + 64 * (j))
#define XB_TOP      3328
#define XB_TOPGEN   3392
#define XCD_BAR_WORDS 3456
#define XB_SPIN_CAP (1u << 24)
DI unsigned xb_ld(unsigned* p)              { return __hip_atomic_load(p, __ATOMIC_RELAXED, __HIP_MEMORY_SCOPE_AGENT); }
DI unsigned xb_add(unsigned* p, unsigned v) { return __hip_atomic_fetch_add(p, v, __ATOMIC_RELAXED, __HIP_MEMORY_SCOPE_AGENT); }
DI unsigned xb_xcc_id() { return (unsigned)__builtin_amdgcn_s_getreg((3 << 11) | 20) & 0xFu; }
#define XB_SPIN(cond, bar) do { unsigned _sp = 0; while (cond) { __builtin_amdgcn_s_sleep(1); \
    if ((++_sp & 255u) == 0u) { if (xb_ld(&(bar)[XB_TMO])) break; if (_sp > XB_SPIN_CAP) { atomicAdd(&(bar)[XB_TMO], 1u); break; } } } } while (0)
struct XcdBarrier { unsigned* bar; unsigned x; volatile LAS unsigned* st; };
DI XcdBarrier xcd_barrier_post(unsigned* bar, volatile LAS unsigned* st) {
    XcdBarrier b; b.bar = bar; b.x = xb_xcc_id(); b.st = st;
    if (threadIdx.x == 0) (void)xb_add(&bar[XB_XCNT(b.x)], 1u);
    return b;
}
DI void xcd_barrier_complete(unsigned* bar, unsigned x, unsigned& nloc, unsigned& nx) {
    const unsigned G = gridDim.x * gridDim.y * gridDim.z;
    unsigned sum, cnt, mine, sp = 0u;
    for (;;) {
        sum = 0u; cnt = 0u; mine = 0u;
#pragma unroll
        for (unsigned j = 0; j < 16; ++j) { const unsigned c = xb_ld(&bar[XB_XCNT(j)]); sum += c; cnt += (c > 0u) ? 1u : 0u; mine = (j == x) ? c : mine; }
        if (sum == G) break;
        __builtin_amdgcn_s_sleep(1);
        if ((++sp & 255u) == 0u) { if (xb_ld(&bar[XB_TMO])) break; if (sp > XB_SPIN_CAP) { atomicAdd(&bar[XB_TMO], 1u); break; } }
    }
    nloc = mine > 0u ? mine : 1u; nx = cnt > 0u ? cnt : 1u;
}
DI void xcd_barrier(const XcdBarrier& b_in) {
    XcdBarrier b = b_in; { unsigned x_ = b.x; asm volatile("" : "+s"(x_)); b.x = x_; }
    asm volatile("s_waitcnt vmcnt(0)" ::: "memory");
    __syncthreads();
    if (threadIdx.x == 0) {
        unsigned* bar = b.bar;
        __builtin_amdgcn_s_waitcnt(0);
        unsigned nloc = b.st[0], nx = b.st[1];
        if (nloc == 0u) { xcd_barrier_complete(bar, b.x, nloc, nx); b.st[0] = nloc; b.st[1] = nx; }
        const unsigned old = xb_add(&bar[XB_XSUB(b.x)], 1u);
        const unsigned gen = old / nloc;
        if (old + 1u == (gen + 1u) * nloc) {
            __builtin_amdgcn_fence(__ATOMIC_RELEASE, "agent");
            asm volatile("s_waitcnt vmcnt(0)" ::: "memory");
            const unsigned og = xb_add(&bar[XB_TOP], 1u);
            const unsigned tg = og / nx;
            if (og + 1u == (tg + 1u) * nx) xb_add(&bar[XB_TOPGEN], 1u);
            else XB_SPIN(xb_ld(&bar[XB_TOPGEN]) == tg, bar);
            __builtin_amdgcn_fence(__ATOMIC_ACQUIRE, "agent");
            xb_add(&bar[XB_XGEN(b.x)], 1u);
            asm volatile("s_waitcnt vmcnt(0)" ::: "memory");
        } else {
            XB_SPIN(xb_ld(&bar[XB_XGEN(b.x)]) == gen, bar);
            __builtin_amdgcn_fence(__ATOMIC_ACQUIRE, "agent");
            asm volatile("s_waitcnt vmcnt(0)" ::: "memory");
        }
    }
    __syncthreads();
}

struct Args { const float* in[21]; float* out; unsigned char* ws; int it_lo, it_hi, ph_lo, ph_hi; };
enum { I_X = 0, I_NMG, I_WIN, I_BG, I_CW, I_CB, I_GB, I_MNG, I_KVNG, I_WKV, I_SQG, I_SKG, I_DQG, I_DKG, I_LAM, I_DOG, I_WBR, I_WOUT, I_NFG, I_WGU, I_WD };

struct Frame {
    LAS unsigned char* lds;
    unsigned char* ws;
    int tid, lane, wave, G, bid;
    int wave0;
    DI void refresh() {
        int l_; asm volatile("v_mbcnt_lo_u32_b32 %0, -1, 0\n\tv_mbcnt_hi_u32_b32 %0, -1, %0" : "=v"(l_));
        unsigned char* w_ = ws; int g_ = G, b_ = bid, wv_ = wave0; asm volatile("" : "+s"(w_), "+s"(g_), "+s"(b_), "+s"(wv_));
        ws = w_; G = g_; bid = b_; lane = l_; wave = wv_; tid = wv_ * 64 + l_; }
};

DI int map_in(int n) {
    const int pn = n >> 8, p = n & 255, bj = p >> 7, wcq = p & 127, wc = wcq >> 5, q = wcq & 31;
    const int hd = 32 * bj + q;
    switch (pn) {
        case 0: case 1: case 2: case 3: return Z_MQK + n;
        case 4: case 5: return Z_MV + (n - 4 * 256);
        case 6: case 7: return Z_MO + (n - 6 * 256);
        case 8: case 9: return Z_SQ + (4 * (pn - 8) + wc) * 64 + hd;
        case 10: return Z_CKV + p;
        case 11: return Z_IQ + wc * 64 + hd;
        case 12: case 13: return Z_DQ + (4 * (pn - 12) + wc) * 64 + hd;
        case 14: case 15: return Z_DK + (4 * (pn - 14) + wc) * 64 + hd;
        case 16: case 17: return Z_DV + (n - 16 * 256);
        default:
            if (wc == 0) return Z_IK + hd;
            if (wc == 1 && bj == 0) { if (q < 8) return Z_MIF + q; if (q < 12) return Z_IW + (q - 8); }
            return -1;
    }
}
DI int map_kv(int n) {
    const int pn = n >> 8, p = n & 255, bj = p >> 7, wcq = p & 127, wc = wcq >> 5, q = wcq & 31;
    if (pn < 2) return (4 * pn + wc) * 64 + 32 * bj + q;
    return n;
}
DI int map_gu(int n) {
    const int pn = n >> 8, p = n & 255;
    return (p >> 7) * FF + 128 * pn + (p & 127);
}
template <int MAP>
DI void transpose_item(const float* W, int ldw, int cbase, const float* kscale, bf16_t* WT, int ldo, int koff, int nblk, LAS float* scr, int item, int lane) {
    const int kb = item / nblk, nb = item % nblk, k0 = 64 * kb, n0 = 32 * nb;
    const int n = n0 + (lane & 31);
    int src;
    if (MAP == 0) src = n; else if (MAP == 1) src = map_in(n); else if (MAP == 2) src = map_kv(n); else src = map_gu(n);
    float tv_[32];
    const int srcc = src >= 0 ? src : 0;
#pragma unroll
    for (int i = 0; i < 32; ++i) tv_[i] = W[(size_t)(k0 + 2 * i + (lane >> 5)) * ldw + cbase + srcc];
#pragma unroll
    for (int i = 0; i < 32; ++i) { const int kk = 2 * i + (lane >> 5);
        float v = src >= 0 ? tv_[i] : 0.f;
        if (kscale) v *= kscale[k0 + kk];
        scr[kk * 33 + (lane & 31)] = v; }
    WSYNC();
    const int c = lane & 7;
#pragma unroll
    for (int j = 0; j < 4; ++j) { const int nn = (lane >> 3) + 8 * j; const LAS float* s = scr + (8 * c) * 33 + nn;
        u32x4 o; o.x = pk2(s[0 * 33], s[1 * 33]); o.y = pk2(s[2 * 33], s[3 * 33]); o.z = pk2(s[4 * 33], s[5 * 33]); o.w = pk2(s[6 * 33], s[7 * 33]);
        *(u32x4*)(WT + (size_t)(n0 + nn) * ldo + koff + k0 + 8 * c) = o; }
    WSYNC();
}
__device__ const float INVF[32] = {1.000000000e+00f, 7.498942018e-01f, 5.623413324e-01f, 4.216965139e-01f, 3.162277639e-01f, 2.371373922e-01f, 1.778279394e-01f, 1.333521456e-01f,
    1.000000015e-01f, 7.498941571e-02f, 5.623412877e-02f, 4.216964915e-02f, 3.162277862e-02f, 2.371373586e-02f, 1.778279431e-02f, 1.333521493e-02f,
    9.999999776e-03f, 7.498942316e-03f, 5.623413250e-03f, 4.216964822e-03f, 3.162277862e-03f, 2.371373819e-03f, 1.778279431e-03f, 1.333521446e-03f,
    1.000000047e-03f, 7.498941850e-04f, 5.623413017e-04f, 4.216965463e-04f, 3.162277862e-04f, 2.371373848e-04f, 1.778279402e-04f, 1.333521504e-04f};
DI void sincos_acc(float angf, float& c, float& s) {
    const double x = (double)angf;
    const double kd = __builtin_rint(x * 0.63661977236758134308);
    const double r = (x - kd * 1.5707963267948965580) - kd * 6.1232339957367658860e-17;
    const double r2 = r * r;
    double sp = -1.0 / 39916800.0; sp = sp * r2 + 1.0 / 362880.0; sp = sp * r2 - 1.0 / 5040.0; sp = sp * r2 + 1.0 / 120.0; sp = sp * r2 - 1.0 / 6.0; sp = sp * r2 + 1.0; sp *= r;
    double cp = 1.0 / 479001600.0; cp = cp * r2 - 1.0 / 3628800.0; cp = cp * r2 + 1.0 / 40320.0; cp = cp * r2 - 1.0 / 720.0; cp = cp * r2 + 1.0 / 24.0; cp = cp * r2 - 0.5; cp = cp * r2 + 1.0;
    const int k = (int)kd & 3;
    double cc, ss;
    if (k == 0) { cc = cp; ss = sp; } else if (k == 1) { cc = -sp; ss = cp; } else if (k == 2) { cc = -cp; ss = -sp; } else { cc = sp; ss = -cp; }
    c = (float)cc; s = (float)ss;
}
DI void phase_prologue(Frame& F, const Args& a) {
    F.refresh();
    LAS float* scr = (LAS float*)(F.lds + F.wave * 16384);
    const int gw = F.bid * NWAVES + F.wave, NGW = F.G * NWAVES;
    float* COS = (float*)(F.ws + WS_COS); float* SIN = (float*)(F.ws + WS_SIN);
    for (int i = gw * 64 + F.lane; i < SEQ * 32; i += NGW * 64) { const int t = i >> 5, f = i & 31; float c, s; sincos_acc((float)t * INVF[f], c, s); COS[i] = c; SIN[i] = s; }
    if (gw == 0) { float* GN = (float*)(F.ws + WS_GAIN);
        for (int l = 0; l < DEPTH; ++l) { GN[(l * 4 + 0) * 64 + F.lane] = a.in[I_SQG][l * 64 + F.lane]; GN[(l * 4 + 1) * 64 + F.lane] = a.in[I_DQG][l * 64 + F.lane];
            GN[(l * 4 + 2) * 64 + F.lane] = a.in[I_DKG][l * 64 + F.lane]; GN[(l * 4 + 3) * 64 + F.lane] = a.in[I_SKG][l * 64 + F.lane]; } }
    for (int l = 0; l < DEPTH; ++l) {
        unsigned char* wl = F.ws + WS_W + (size_t)l * W_LAYER;
        const float* w_in = a.in[I_WIN] + (size_t)l * DM * IN_COLS;
        { const int nblk = NT_IN * 256 / 32, nit = (DM / 64) * nblk;
          for (int it = gw; it < nit; it += NGW) transpose_item<1>(w_in, IN_COLS, 0, nullptr, (bf16_t*)(wl + WO_IN), DM, 0, nblk, scr, it, F.lane); }
        { const int nblk = 3072 / 32, nit = (DM / 64) * nblk;
          for (int it = gw; it < nit; it += NGW) transpose_item<0>(w_in, IN_COLS, Z_G, nullptr, (bf16_t*)(wl + WO_G), DM, 0, nblk, scr, it, F.lane); }
        { const int nblk = 1024 / 32, nit = (256 / 64) * nblk;
          for (int it = gw; it < nit; it += NGW) transpose_item<2>(a.in[I_WKV] + (size_t)l * 256 * 1024, 1024, 0, a.in[I_KVNG] + l * 256, (bf16_t*)(wl + WO_KV), 256, 0, nblk, scr, it, F.lane); }
        for (int b = 0; b < 3; ++b) { const int nblk = 1024 / 32, nit = (512 / 64) * nblk;
          for (int it = gw; it < nit; it += NGW) transpose_item<0>(a.in[I_WBR] + ((size_t)l * 3 + b) * 512 * 1024, 1024, 0, nullptr, (bf16_t*)(wl + WO_BR), 1536, b * 512, nblk, scr, it, F.lane); }
        { const int nblk = 1024 / 32, nit = (1024 / 64) * nblk;
          for (int it = gw; it < nit; it += NGW) transpose_item<0>(a.in[I_WOUT] + (size_t)l * 1024 * 1024, 1024, 0, nullptr, (bf16_t*)(wl + WO_OUT), 1024, 0, nblk, scr, it, F.lane); }
        { const int nblk = 5632 / 32, nit = (1024 / 64) * nblk;
          for (int it = gw; it < nit; it += NGW) transpose_item<3>(a.in[I_WGU] + (size_t)l * 1024 * 5632, 5632, 0, nullptr, (bf16_t*)(wl + WO_GU), 1024, 0, nblk, scr, it, F.lane); }
        { const int nblk = 1024 / 32, nit = (2816 / 64) * nblk;
          for (int it = gw; it < nit; it += NGW) transpose_item<0>(a.in[I_WD] + (size_t)l * 2816 * 1024, 1024, 0, nullptr, (bf16_t*)(wl + WO_D), 2816, 0, nblk, scr, it, F.lane); }
    }
}

DI void phase_rmsnorm(Frame& F, const void* xv, const bool src16, const float* gain, bf16_t* out) {
    F.refresh();
    const int gw = F.bid * NWAVES + F.wave, NGW = F.G * NWAVES;
    f32x4 gv[4];
#pragma unroll
    for (int j = 0; j < 4; ++j) gv[j] = *(const f32x4*)(gain + 4 * F.lane + 256 * j);
    for (int m = gw; m < MC; m += NGW) {
        f32x4 v[4]; float s = 0.f;
        if (src16) { const GAS u32x2* xr = (const GAS u32x2*)((const bf16_t*)xv + (size_t)m * DM) + F.lane;
#pragma unroll
            for (int j = 0; j < 4; ++j) { const u32x2 w = xr[64 * j]; v[j] = (f32x4){bflo(w.x), bfhi(w.x), bflo(w.y), bfhi(w.y)}; }
        } else { const GAS f32x4* xr = (const GAS f32x4*)((const float*)xv + (size_t)m * DM) + F.lane;
#pragma unroll
            for (int j = 0; j < 4; ++j) v[j] = xr[64 * j]; }
#pragma unroll
        for (int j = 0; j < 4; ++j) s += (v[j].x * v[j].x + v[j].y * v[j].y) + (v[j].z * v[j].z + v[j].w * v[j].w);
        const float r = 1.0f / sqrtf(wave_sum(s) * (1.f / DM) + EPS);
        u32x2* o8 = (u32x2*)(out + (size_t)m * DM) + F.lane;
#pragma unroll
        for (int j = 0; j < 4; ++j) { u32x2 w; w.x = cvtpk_(v[j].x * r * gv[j].x, v[j].y * r * gv[j].y); w.y = cvtpk_(v[j].z * r * gv[j].z, v[j].w * r * gv[j].w); o8[64 * j] = w; }
    }
}
DI float log_sigmoid(float x) {
    const float ax = fabsf(x), y = fexp(-ax);
    float l1p;
    if (y < 0.06f) l1p = y * (1.f - y * (0.5f - y * (0.33333333f - y * (0.25f - y * 0.2f))));
    else l1p = __builtin_amdgcn_logf(1.f + y) * 0.69314718056f;
    return fminf(x, 0.f) - l1p;
}
DI void phase_token(Frame& F, const Args& a, int l, const int probe) {
    F.refresh();
    const int gw0 = F.bid * NWAVES + F.wave, NGW = F.G * NWAVES, NSC = CB * 4, NCV = NGW - NSC;
    const bool scanw = (F.wave == NWAVES - 1) && (F.bid < NSC);
    const int gw = scanw ? NCV : gw0 - ((gw0 >> 3) < NSC ? (gw0 >> 3) : NSC);
    if (!scanw) { if (probe != 2) {
    const bf16_t* QKRAW = (const bf16_t*)(F.ws + WS_QKRAW); bf16_t* QK = (bf16_t*)(F.ws + WS_QK);
    const bf16_t* CKV = (const bf16_t*)(F.ws + WS_CKV); float* RT = (float*)(F.ws + WS_RT);
    const float* cw = a.in[I_CW] + (size_t)l * 4 * 1024; const float* cb = a.in[I_CB] + (size_t)l * 1024;
    const int c0 = F.lane * 16;
    float w[4][16], bs[16];
#pragma unroll
    for (int j = 0; j < 4; ++j)
#pragma unroll
        for (int i = 0; i < 16; ++i) w[j][i] = cw[j * 1024 + c0 + i];
#pragma unroll
    for (int i = 0; i < 16; ++i) bs[i] = cb[c0 + i];
    const float ksc = (c0 >= 512) ? 0.08838834764831845f : 1.0f;
    for (int m = gw; m < MC; m += NCV) {
        const int t = m & (SEQ - 1);
        float accv[16];
#pragma unroll
        for (int i = 0; i < 16; ++i) accv[i] = bs[i];
        u32x4 tv[4][2];
#pragma unroll
        for (int j = 0; j < 4; ++j) { const int tt = t - 3 + j; const u32x4* p = (const u32x4*)(QKRAW + (size_t)(tt >= 0 ? m - 3 + j : m) * 1024 + c0); tv[j][0] = p[0]; tv[j][1] = p[1]; }
        const u32x2 ckv4 = *(const u32x2*)(CKV + (size_t)m * 256 + 4 * F.lane);
#pragma unroll
        for (int j = 0; j < 4; ++j) { const float on = (t - 3 + j >= 0) ? 1.f : 0.f;
            const unsigned ww[8] = {tv[j][0].x, tv[j][0].y, tv[j][0].z, tv[j][0].w, tv[j][1].x, tv[j][1].y, tv[j][1].z, tv[j][1].w};
#pragma unroll
            for (int i = 0; i < 8; ++i) { accv[2 * i] += on * w[j][2 * i] * bflo(ww[i]); accv[2 * i + 1] += on * w[j][2 * i + 1] * bfhi(ww[i]); } }
        unsigned o[8];
#pragma unroll
        for (int i = 0; i < 8; ++i) { const float x0 = accv[2 * i], x1 = accv[2 * i + 1]; o[i] = pk2(x0 * sigmoidf_(x0) * ksc, x1 * sigmoidf_(x1) * ksc); }
        u32x4* q = (u32x4*)(QK + (size_t)m * 1024 + c0); q[0] = (u32x4){o[0], o[1], o[2], o[3]}; q[1] = (u32x4){o[4], o[5], o[6], o[7]};
        { const u32x2 v = ckv4; const float a0 = bflo(v.x), a1 = bfhi(v.x), a2 = bflo(v.y), a3 = bfhi(v.y);
          const float ss = wave_sum((a0 * a0 + a1 * a1) + (a2 * a2 + a3 * a3)); if (F.lane == 0) RT[m] = 1.0f / sqrtf(ss * (1.f / 256.f) + EPS); }
    }
    } } else if (probe != 1) {
        const int sq = F.bid, b = sq >> 2, h = sq & 3, lane = F.lane; const float* IFb = (const float*)(F.ws + WS_IF) + (size_t)b * SEQ * 8;
        float* AK = (float*)(F.ws + WS_AK) + (size_t)sq * SEQ; float* MQ = (float*)(F.ws + WS_MQ) + (size_t)sq * SEQ; float* EM = (float*)(F.ws + WS_EM) + (size_t)sq * SEQ;
        LAS float* X0 = (LAS float*)F.lds; LAS float* X1 = X0 + 4160; LAS float* X2 = X1 + 4160;
#pragma unroll 1
        for (int c = 0; c < 4; ++c) { float fv[16], iv[16];
#pragma unroll
            for (int kk = 0; kk < 16; ++kk) { const size_t t = (size_t)64 * (16 * c + kk) + lane; fv[kk] = *(const GAS float*)(IFb + t * 8 + 4 + h); iv[kk] = *(const GAS float*)(IFb + t * 8 + h); }
#pragma unroll
            for (int kk = 0; kk < 16; ++kk) { const int t = 64 * (16 * c + kk) + lane; X0[t + (t >> 6)] = fv[kk]; X1[t + (t >> 6)] = iv[kk]; } }
        WSYNC();
        const int tb = 65 * lane;
        double sum = 0.0;
#pragma unroll 8
        for (int j = 0; j < 64; ++j) { const float lf = log_sigmoid(X0[tb + j]); X0[tb + j] = lf; sum += (double)lf; }
        double inc = sum;
#pragma unroll
        for (int o = 1; o < 64; o <<= 1) { const double y = shup_d(inc, o, lane); if (lane >= o) inc += y; }
        double bb = inc - sum; float mx = -INFINITY;
#pragma unroll 8
        for (int j = 0; j < 64; ++j) { bb += (double)X0[tb + j]; const float av = (float)((double)X1[tb + j] - bb); X1[tb + j] = av; X0[tb + j] = (float)bb; mx = fmaxf(mx, av); }
        float minc = mx;
#pragma unroll
        for (int o = 1; o < 64; o <<= 1) { const float y = shup_f(minc, o, lane); if (lane >= o) minc = fmaxf(minc, y); }
        float mrun = shup_f(minc, 1, lane); if (lane == 0) mrun = -INFINITY;
#pragma unroll 8
        for (int j = 0; j < 64; ++j) { mrun = fmaxf(mrun, X1[tb + j]); X2[tb + j] = mrun; X0[tb + j] = fexp(-(X0[tb + j] + mrun)); }
        WSYNC();
#pragma unroll 8
        for (int k = 0; k < 64; ++k) { const int t = 64 * k + lane, ix = t + k; AK[t] = X1[ix]; MQ[t] = X2[ix]; EM[t] = X0[ix]; }
    }
}

DI void store8(bf16_t* p, f32x4 v0, f32x4 v1) { u32x4 w; w.x = cvtpk_(v0[0], v0[1]); w.y = cvtpk_(v0[2], v0[3]); w.z = cvtpk_(v1[0], v1[1]); w.w = cvtpk_(v1[2], v1[3]); *(u32x4*)p = w; }
DI void head_norm_rope(f32x4 (&x)[2][2], bool norm, const f32x4 (&gn)[2][2], const float* cosr, const float* sinr, int fq, float scale) {
    if (norm) {
        float ss = 0.f;
#pragma unroll
        for (int bj = 0; bj < 2; ++bj)
#pragma unroll
            for (int n = 0; n < 2; ++n) ss += (x[bj][n][0] * x[bj][n][0] + x[bj][n][1] * x[bj][n][1]) + (x[bj][n][2] * x[bj][n][2] + x[bj][n][3] * x[bj][n][3]);
        ss = sum16x(ss); ss = sum32x(ss);
        const float r = 1.0f / sqrtf(ss * (1.f / 64.f) + EPS);
#pragma unroll
        for (int bj = 0; bj < 2; ++bj)
#pragma unroll
            for (int n = 0; n < 2; ++n) x[bj][n] = x[bj][n] * r * gn[bj][n];
    }
#pragma unroll
    for (int n = 0; n < 2; ++n) { const f32x4 c = *(const f32x4*)(cosr + 8 * fq + 4 * n), s = *(const f32x4*)(sinr + 8 * fq + 4 * n);
        const f32x4 x1 = x[0][n], x2 = x[1][n]; x[0][n] = (x1 * c - x2 * s) * scale; x[1][n] = (x1 * s + x2 * c) * scale; }
}
DI void head_norm_rope_cs(f32x4 (&x)[2][2], bool norm, const f32x4 (&gn)[2][2], const f32x4 (&c)[2], const f32x4 (&sn)[2], float scale) {
    if (norm) {
        float ss = 0.f;
#pragma unroll
        for (int bj = 0; bj < 2; ++bj)
#pragma unroll
            for (int n = 0; n < 2; ++n) ss += (x[bj][n][0] * x[bj][n][0] + x[bj][n][1] * x[bj][n][1]) + (x[bj][n][2] * x[bj][n][2] + x[bj][n][3] * x[bj][n][3]);
        ss = sum16x(ss); ss = sum32x(ss);
        const float r = 1.0f / sqrtf(ss * (1.f / 64.f) + EPS);
#pragma unroll
        for (int bj = 0; bj < 2; ++bj)
#pragma unroll
            for (int n = 0; n < 2; ++n) x[bj][n] = x[bj][n] * r * gn[bj][n];
    }
#pragma unroll
    for (int n = 0; n < 2; ++n) { const f32x4 x1 = x[0][n], x2 = x[1][n]; x[0][n] = (x1 * c[n] - x2 * sn[n]) * scale; x[1][n] = (x1 * sn[n] + x2 * c[n]) * scale; }
}
struct EpiInProj {
    static constexpr bool PERM = true, MIDK = false, INIT = false;
    unsigned char* ws; const float* gate_b; int layer;
    DI void operator()(const f32x4 (&acc)[2][2][4][2], const pg8::Unit& u, int wr, int wc, int fr, int fq) const {
        const int pn = u.pn; const int rowb = u.pm * 256 + wr * 64 + fr;
        if (pn < 8 || pn == 10 || pn == 16 || pn == 17) {
            size_t doff; int ldc, cb; bool sg = false;
            if (pn < 4) { doff = WS_QKRAW; ldc = 1024; cb = pn * 256; }
            else if (pn < 6) { doff = WS_VM; ldc = 512; cb = (pn - 4) * 256; }
            else if (pn < 8) { doff = WS_OM; ldc = 512; cb = (pn - 6) * 256; sg = true; }
            else if (pn == 10) { doff = WS_CKV; ldc = 256; cb = 0; }
            else { doff = WS_DV; ldc = 512; cb = (pn - 16) * 256; }
            bf16_t* dst = (bf16_t*)(ws + doff);
#pragma unroll
            for (int ai = 0; ai < 2; ++ai)
#pragma unroll
                for (int m = 0; m < 4; ++m) { bf16_t* rowp = dst + (size_t)(rowb + ai * 128 + m * 16) * ldc + cb + wc * 32 + 8 * fq;
#pragma unroll
                    for (int bj = 0; bj < 2; ++bj) { f32x4 v0 = acc[ai][bj][m][0], v1 = acc[ai][bj][m][1];
                        if (sg) {
#pragma unroll
                            for (int j = 0; j < 4; ++j) { v0[j] = sigmoidf_(v0[j]); v1[j] = sigmoidf_(v1[j]); } }
                        store8(rowp + bj * 128, v0, v1); } }
        } else if (pn == 18) {
            const float* COS = (const float*)(ws + WS_COS); const float* SIN = (const float*)(ws + WS_SIN);
            if (wc == 0) {
                bf16_t* dst = (bf16_t*)(ws + WS_IK); f32x4 gn[2][2];
#pragma unroll
                for (int bj = 0; bj < 2; ++bj)
#pragma unroll
                    for (int n = 0; n < 2; ++n) gn[bj][n] = (f32x4){1.f, 1.f, 1.f, 1.f};
#pragma unroll
                for (int ai = 0; ai < 2; ++ai)
#pragma unroll
                    for (int m = 0; m < 4; ++m) { const int row = rowb + ai * 128 + m * 16, t = row & (SEQ - 1);
                        f32x4 x[2][2] = {{acc[ai][0][m][0], acc[ai][0][m][1]}, {acc[ai][1][m][0], acc[ai][1][m][1]}};
                        head_norm_rope(x, false, gn, COS + t * 32, SIN + t * 32, fq, 1.0f);
#pragma unroll
                        for (int bj = 0; bj < 2; ++bj) store8(dst + (size_t)row * 64 + 32 * bj + 8 * fq, x[bj][0], x[bj][1]);
                        asm volatile("" ::: "memory"); }
            } else if (wc == 1) {
                float* IFp = (float*)(ws + WS_IF); float* IWp = (float*)(ws + WS_IW);
#pragma unroll
                for (int ai = 0; ai < 2; ++ai)
#pragma unroll
                    for (int m = 0; m < 4; ++m) { const int row = rowb + ai * 128 + m * 16;
                        if (fq == 0) { *(f32x4*)(IFp + (size_t)row * 8) = acc[ai][0][m][0] + *(const f32x4*)gate_b; *(f32x4*)(IFp + (size_t)row * 8 + 4) = acc[ai][0][m][1] + *(const f32x4*)(gate_b + 4); }
                        else if (fq == 1) { *(f32x4*)(IWp + (size_t)row * 4) = acc[ai][0][m][0] * 0.0625f; } }
            }
        } else {
            const float* COS = (const float*)(ws + WS_COS); const float* SIN = (const float*)(ws + WS_SIN);
            size_t doff; int gi, pn0; float scale; bool norm = true; int ldc = 512;
            if (pn < 10) { doff = WS_SQ; gi = 0; pn0 = 8; scale = C2; }
            else if (pn == 11) { doff = WS_IQ; gi = 0; pn0 = 11; scale = 1.f; norm = false; ldc = 256; }
            else if (pn < 14) { doff = WS_DQ; gi = 1; pn0 = 12; scale = C2; }
            else { doff = WS_DK; gi = 2; pn0 = 14; scale = 1.f; }
            bf16_t* dst = (bf16_t*)(ws + doff); const float* g = (const float*)(ws + WS_GAIN) + (layer * 4 + gi) * 64;
            f32x4 gn[2][2];
#pragma unroll
            for (int bj = 0; bj < 2; ++bj)
#pragma unroll
                for (int n = 0; n < 2; ++n) gn[bj][n] = *(const f32x4*)(g + 32 * bj + 8 * fq + 4 * n);
            const int head = 4 * (pn - pn0) + wc;
#pragma unroll
            for (int ai = 0; ai < 2; ++ai)
#pragma unroll
              for (int mp = 0; mp < 4; mp += 2) {
                f32x4 cc[2][2], sn[2][2];
#pragma unroll
                for (int m = 0; m < 2; ++m) { const int t = (rowb + ai * 128 + (mp + m) * 16) & (SEQ - 1);
#pragma unroll
                    for (int n = 0; n < 2; ++n) { cc[m][n] = *(const GAS f32x4*)(COS + t * 32 + 8 * fq + 4 * n); sn[m][n] = *(const GAS f32x4*)(SIN + t * 32 + 8 * fq + 4 * n); } }
#pragma unroll
                for (int m = 0; m < 2; ++m) { const int row = rowb + ai * 128 + (mp + m) * 16;
                    f32x4 x[2][2] = {{acc[ai][0][mp + m][0], acc[ai][0][mp + m][1]}, {acc[ai][1][mp + m][0], acc[ai][1][mp + m][1]}};
                    head_norm_rope_cs(x, norm, gn, cc[m], sn[m], scale);
#pragma unroll
                    for (int bj = 0; bj < 2; ++bj) store8(dst + (size_t)row * ldc + head * 64 + 32 * bj + 8 * fq, x[bj][0], x[bj][1]); }
                asm volatile("" ::: "memory");
              }
        }
    }
};
struct EpiKV {
    static constexpr bool PERM = true, MIDK = false, INIT = false;
    unsigned char* ws; int layer;
    DI void operator()(const f32x4 (&acc)[2][2][4][2], const pg8::Unit& u, int wr, int wc, int fr, int fq) const {
        const int pn = u.pn; const int rowb = u.pm * 256 + wr * 64 + fr; const float* RT = (const float*)(ws + WS_RT);
        if (pn >= 2) {
            bf16_t* dst = (bf16_t*)(ws + WS_SV);
#pragma unroll
            for (int ai = 0; ai < 2; ++ai)
#pragma unroll
                for (int m = 0; m < 4; ++m) { const int row = rowb + ai * 128 + m * 16; const float r = RT[row]; bf16_t* rowp = dst + (size_t)row * 512 + (pn - 2) * 256 + wc * 32 + 8 * fq;
#pragma unroll
                    for (int bj = 0; bj < 2; ++bj) store8(rowp + bj * 128, acc[ai][bj][m][0] * r, acc[ai][bj][m][1] * r); }
        } else {
            const float* COS = (const float*)(ws + WS_COS); const float* SIN = (const float*)(ws + WS_SIN);
            bf16_t* dst = (bf16_t*)(ws + WS_SK); f32x4 gn[2][2];
#pragma unroll
            for (int bj = 0; bj < 2; ++bj)
#pragma unroll
                for (int n = 0; n < 2; ++n) gn[bj][n] = *(const f32x4*)((const float*)(ws + WS_GAIN) + (layer * 4 + 3) * 64 + 32 * bj + 8 * fq + 4 * n);
            const int head = 4 * pn + wc;
#pragma unroll
            for (int ai = 0; ai < 2; ++ai)
#pragma unroll
              for (int mp = 0; mp < 4; mp += 2) {
                f32x4 cc[2][2], sn[2][2]; float rr[2];
#pragma unroll
                for (int m = 0; m < 2; ++m) { const int row = rowb + ai * 128 + (mp + m) * 16, t = row & (SEQ - 1); rr[m] = *(const GAS float*)(RT + row);
#pragma unroll
                    for (int n = 0; n < 2; ++n) { cc[m][n] = *(const GAS f32x4*)(COS + t * 32 + 8 * fq + 4 * n); sn[m][n] = *(const GAS f32x4*)(SIN + t * 32 + 8 * fq + 4 * n); } }
#pragma unroll
                for (int m = 0; m < 2; ++m) { const int row = rowb + ai * 128 + (mp + m) * 16; const float r = rr[m];
                    f32x4 x[2][2] = {{acc[ai][0][mp + m][0] * r, acc[ai][0][mp + m][1] * r}, {acc[ai][1][mp + m][0] * r, acc[ai][1][mp + m][1] * r}};
                    head_norm_rope_cs(x, true, gn, cc[m], sn[m], 1.0f);
#pragma unroll
                    for (int bj = 0; bj < 2; ++bj) store8(dst + (size_t)row * 512 + head * 64 + 32 * bj + 8 * fq, x[bj][0], x[bj][1]); }
                asm volatile("" ::: "memory");
              }
        }
    }
};
struct EpiGate {
    static constexpr bool PERM = true, MIDK = false, INIT = false;
    bf16_t* G; const float* bias;
    DI void operator()(const f32x4 (&acc)[2][2][4][2], const pg8::Unit& u, int wr, int wc, int fr, int fq) const {
        const int rowb = u.pm * 256 + wr * 64 + fr, col0 = u.pn * 256 + wc * 32 + 8 * fq;
        f32x4 bv[2][2];
#pragma unroll
        for (int bj = 0; bj < 2; ++bj)
#pragma unroll
            for (int n = 0; n < 2; ++n) bv[bj][n] = *(const f32x4*)(bias + col0 + bj * 128 + 4 * n);
#pragma unroll
        for (int ai = 0; ai < 2; ++ai)
#pragma unroll
            for (int m = 0; m < 4; ++m) { bf16_t* rowp = G + (size_t)(rowb + ai * 128 + m * 16) * 3072 + col0;
#pragma unroll
                for (int bj = 0; bj < 2; ++bj) { f32x4 v0 = acc[ai][bj][m][0] + bv[bj][0], v1 = acc[ai][bj][m][1] + bv[bj][1];
#pragma unroll
                    for (int j = 0; j < 4; ++j) { v0[j] = sigmoidf_(v0[j]); v1[j] = sigmoidf_(v1[j]); }
                    store8(rowp + bj * 128, v0, v1); } }
    }
};
struct EpiMerge {
    static constexpr bool PERM = true, MIDK = true, INIT = false;
    const bf16_t* G; bf16_t* MG;
    DI static void ld8(const bf16_t* p, float (&g)[8]) { const u32x4 w = *(const u32x4*)p; g[0] = bflo(w.x); g[1] = bfhi(w.x); g[2] = bflo(w.y); g[3] = bfhi(w.y); g[4] = bflo(w.z); g[5] = bfhi(w.z); g[6] = bflo(w.w); g[7] = bfhi(w.w); }
    DI void mid(f32x4 (&acc)[2][2][4][2], const pg8::Unit& u, int t, int wr, int wc, int fr, int fq) const {
        const int seg = (t >> 3) - 1; const int rowb = u.pm * 256 + wr * 64 + fr, col0 = u.pn * 256 + wc * 32 + 8 * fq;
#pragma unroll
        for (int ai = 0; ai < 2; ++ai) {
            u32x4 ga[4][2], gb[4][2];
#pragma unroll
            for (int m = 0; m < 4; ++m) { const bf16_t* gp = G + (size_t)(rowb + ai * 128 + m * 16) * 3072 + seg * 1024 + col0;
#pragma unroll
                for (int bj = 0; bj < 2; ++bj) { ga[m][bj] = *(const GAS u32x4*)(gp + bj * 128); gb[m][bj] = *(const GAS u32x4*)(gp + 1024 + bj * 128); } }
#pragma unroll
            for (int m = 0; m < 4; ++m)
#pragma unroll
                for (int bj = 0; bj < 2; ++bj) { const unsigned aw[4] = {ga[m][bj].x, ga[m][bj].y, ga[m][bj].z, ga[m][bj].w}, bw[4] = {gb[m][bj].x, gb[m][bj].y, gb[m][bj].z, gb[m][bj].w};
#pragma unroll
                    for (int q = 0; q < 4; ++q) { const int n = q >> 1, j0 = 2 * (q & 1);
                        acc[ai][bj][m][n][j0] *= fmaxf(bflo(aw[q]), 1e-20f) * frcp(fmaxf(bflo(bw[q]), 1e-20f));
                        acc[ai][bj][m][n][j0 + 1] *= fmaxf(bfhi(aw[q]), 1e-20f) * frcp(fmaxf(bfhi(bw[q]), 1e-20f)); } }
            asm volatile("" ::: "memory");
        }
    }
    DI void operator()(const f32x4 (&acc)[2][2][4][2], const pg8::Unit& u, int wr, int wc, int fr, int fq) const {
        const int rowb = u.pm * 256 + wr * 64 + fr, col0 = u.pn * 256 + wc * 32 + 8 * fq;
#pragma unroll
        for (int ai = 0; ai < 2; ++ai) {
            u32x4 gc[4][2];
#pragma unroll
            for (int m = 0; m < 4; ++m)
#pragma unroll
                for (int bj = 0; bj < 2; ++bj) gc[m][bj] = *(const GAS u32x4*)(G + (size_t)(rowb + ai * 128 + m * 16) * 3072 + 2048 + col0 + bj * 128);
#pragma unroll
            for (int m = 0; m < 4; ++m)
#pragma unroll
                for (int bj = 0; bj < 2; ++bj) { const unsigned cw[4] = {gc[m][bj].x, gc[m][bj].y, gc[m][bj].z, gc[m][bj].w}; f32x4 v0 = acc[ai][bj][m][0], v1 = acc[ai][bj][m][1];
                    v0[0] *= fmaxf(bflo(cw[0]), 1e-20f); v0[1] *= fmaxf(bfhi(cw[0]), 1e-20f); v0[2] *= fmaxf(bflo(cw[1]), 1e-20f); v0[3] *= fmaxf(bfhi(cw[1]), 1e-20f);
                    v1[0] *= fmaxf(bflo(cw[2]), 1e-20f); v1[1] *= fmaxf(bfhi(cw[2]), 1e-20f); v1[2] *= fmaxf(bflo(cw[3]), 1e-20f); v1[3] *= fmaxf(bfhi(cw[3]), 1e-20f);
                    store8(MG + (size_t)(rowb + ai * 128 + m * 16) * 1024 + col0 + bj * 128, v0, v1); }
            asm volatile("" ::: "memory");
        }
    }
};
struct EpiResid {
    static constexpr bool PERM = true, MIDK = false, INIT = true;
    const void* base; void* out; bool in16, out16;
    DI void init(f32x4 (&acc)[2][2][4][2], const pg8::Unit& u, int wr, int wc, int fr, int fq) const {
        const int rowb = u.pm * 256 + wr * 64 + fr, col0 = u.pn * 256 + wc * 32 + 8 * fq;
#pragma unroll
        for (int ai = 0; ai < 2; ++ai)
#pragma unroll
            for (int m = 0; m < 4; ++m) { const size_t off = (size_t)(rowb + ai * 128 + m * 16) * DM + col0;
#pragma unroll
                for (int bj = 0; bj < 2; ++bj) {
                    if (in16) { const u32x4 w = *(const GAS u32x4*)((const bf16_t*)base + off + bj * 128);
                        acc[ai][bj][m][0] = (f32x4){bflo(w.x), bfhi(w.x), bflo(w.y), bfhi(w.y)}; acc[ai][bj][m][1] = (f32x4){bflo(w.z), bfhi(w.z), bflo(w.w), bfhi(w.w)}; }
                    else { acc[ai][bj][m][0] = *(const GAS f32x4*)((const float*)base + off + bj * 128); acc[ai][bj][m][1] = *(const GAS f32x4*)((const float*)base + off + bj * 128 + 4); } } }
    }
    DI void operator()(const f32x4 (&acc)[2][2][4][2], const pg8::Unit& u, int wr, int wc, int fr, int fq) const {
        const int rowb = u.pm * 256 + wr * 64 + fr, col0 = u.pn * 256 + wc * 32 + 8 * fq;
#pragma unroll
        for (int ai = 0; ai < 2; ++ai)
#pragma unroll
            for (int m = 0; m < 4; ++m) { const size_t off = (size_t)(rowb + ai * 128 + m * 16) * DM + col0;
#pragma unroll
                for (int bj = 0; bj < 2; ++bj) {
                    if (out16) store8((bf16_t*)out + off + bj * 128, acc[ai][bj][m][0], acc[ai][bj][m][1]);
                    else { *(f32x4*)((float*)out + off + bj * 128) = acc[ai][bj][m][0]; *(f32x4*)((float*)out + off + bj * 128 + 4) = acc[ai][bj][m][1]; } } }
    }
};
struct EpiSwiGLU {
    static constexpr bool PERM = true, MIDK = false, INIT = false;
    bf16_t* H;
    DI void operator()(const f32x4 (&acc)[2][2][4][2], const pg8::Unit& u, int wr, int wc, int fr, int fq) const {
        const int rowb = u.pm * 256 + wr * 64 + fr, col0 = u.pn * 128 + wc * 32 + 8 * fq;
#pragma unroll
        for (int ai = 0; ai < 2; ++ai)
#pragma unroll
            for (int m = 0; m < 4; ++m) { f32x4 v0, v1;
#pragma unroll
                for (int j = 0; j < 4; ++j) { const float g0 = acc[ai][0][m][0][j], g1 = acc[ai][0][m][1][j]; v0[j] = g0 * sigmoidf_(g0) * acc[ai][1][m][0][j]; v1[j] = g1 * sigmoidf_(g1) * acc[ai][1][m][1][j]; }
                store8(H + (size_t)(rowb + ai * 128 + m * 16) * FF + col0, v0, v1); }
    }
};

DI unsigned mono_key(float f) { const unsigned u = __float_as_uint(f + 0.0f); return u ^ ((unsigned)((int)u >> 31) | 0x80000000u); }
DI unsigned pack_mask(unsigned long long bm, int h) {
    unsigned r = 0;
#pragma unroll
    for (int p = 0; p < 2; ++p)
#pragma unroll
        for (int g = 0; g < 4; ++g) r |= (unsigned)((bm >> (32 * p + 8 * g + 4 * h)) & 0xFull) << (16 * p + 4 * g);
    return r;
}
DI unsigned long long unpack_mask(unsigned w0, unsigned w1) {
    unsigned long long bm = 0;
#pragma unroll
    for (int p = 0; p < 2; ++p)
#pragma unroll
        for (int g = 0; g < 4; ++g) { bm |= (unsigned long long)((w0 >> (16 * p + 4 * g)) & 0xFu) << (32 * p + 8 * g); bm |= (unsigned long long)((w1 >> (16 * p + 4 * g)) & 0xFu) << (32 * p + 8 * g + 4); }
    return bm;
}
DI void ld8f(const bf16_t* p, float (&g)[8]) { const u32x4 w = *(const u32x4*)p; g[0] = bflo(w.x); g[1] = bfhi(w.x); g[2] = bflo(w.y); g[3] = bfhi(w.y); g[4] = bflo(w.z); g[5] = bfhi(w.z); g[6] = bflo(w.w); g[7] = bfhi(w.w); }

DI void naive_select(Frame& F) {
    F.refresh();
    if (F.wave >= 4) return;
    const int gw = F.bid * 4 + F.wave, NGW = F.G * 4;
    LAS unsigned char* wl = F.lds + F.wave * 20480;
    LAS float* sc = (LAS float*)wl; LAS float* iqf = (LAS float*)(wl + 16384); LAS unsigned* hist = (LAS unsigned*)(wl + 16384 + 1024);
    const bf16_t* IQ = (const bf16_t*)(F.ws + WS_IQ); const bf16_t* IK = (const bf16_t*)(F.ws + WS_IK); const float* IW = (const float*)(F.ws + WS_IW);
    unsigned* MASK = (unsigned*)(F.ws + WS_MASK);
    const int lane = F.lane;
    for (int row = gw; row < MC; row += NGW) {
        const int b = row >> 12, t = row & (SEQ - 1), n = t + 1;
        { const u32x2 v = *(const u32x2*)(IQ + (size_t)row * 256 + 4 * lane); iqf[4 * lane] = bflo(v.x); iqf[4 * lane + 1] = bfhi(v.x); iqf[4 * lane + 2] = bflo(v.y); iqf[4 * lane + 3] = bfhi(v.y); }
        const f32x4 wv = *(const f32x4*)(IW + (size_t)row * 4);
        WSYNC();
        for (int s = lane; s < n; s += 64) {
            const bf16_t* kr = IK + ((size_t)b * SEQ + s) * 64;
            float d0 = 0.f, d1 = 0.f, d2 = 0.f, d3 = 0.f;
#pragma unroll
            for (int c = 0; c < 8; ++c) { float kv[8]; ld8f(kr + 8 * c, kv);
#pragma unroll
                for (int j = 0; j < 8; ++j) { const float k = kv[j]; d0 += iqf[8 * c + j] * k; d1 += iqf[64 + 8 * c + j] * k; d2 += iqf[128 + 8 * c + j] * k; d3 += iqf[192 + 8 * c + j] * k; } }
            sc[s] = wv[0] * fmaxf(d0, 0.f) + wv[1] * fmaxf(d1, 0.f) + wv[2] * fmaxf(d2, 0.f) + wv[3] * fmaxf(d3, 0.f);
        }
        WSYNC();
        unsigned thr = 0u; int need = 256;
        if (n > 256) {
            unsigned prefix = 0u, pmask = 0u;
            for (int pass = 0; pass < 4; ++pass) {
                const int shift = 24 - 8 * pass;
                { unsigned z_ = 0u; asm volatile("" : "+v"(z_)); hist[lane] = z_; hist[lane + 64] = z_; hist[lane + 128] = z_; hist[lane + 192] = z_; }
                WSYNC();
                for (int s = lane; s < n; s += 64) { const unsigned key = mono_key(sc[s]); if ((key & pmask) == prefix) __hip_atomic_fetch_add(&hist[(key >> shift) & 255u], 1u, __ATOMIC_RELAXED, __HIP_MEMORY_SCOPE_WORKGROUP); }
                WSYNC();
                const unsigned c0 = hist[4 * lane], c1 = hist[4 * lane + 1], c2 = hist[4 * lane + 2], c3 = hist[4 * lane + 3];
                const unsigned ls = c0 + c1 + c2 + c3; unsigned inc = ls;
#pragma unroll
                for (int o = 1; o < 64; o <<= 1) { const unsigned y = __shfl_up(inc, o); if (lane >= o) inc += y; }
                const unsigned total = __shfl(inc, 63);
                unsigned cum = total - inc;
                int fbin = -1; unsigned fneed = 0u;
                const unsigned cc[4] = {c0, c1, c2, c3};
#pragma unroll
                for (int bq = 3; bq >= 0; --bq) { if (fbin < 0 && cum < (unsigned)need && cum + cc[bq] >= (unsigned)need) { fbin = 4 * lane + bq; fneed = (unsigned)need - cum; } cum += cc[bq]; }
                const unsigned long long fm = __ballot(fbin >= 0);
                const int src = __ffsll((long long)fm) - 1;
                const int bin = __shfl(fbin, src); need = (int)__shfl(fneed, src);
                prefix |= (unsigned)bin << shift; pmask |= 0xFFu << shift;
                WSYNC();
            }
            thr = prefix;
        }
        int eqc = 0;
        for (int i = 0; i < 64; ++i) {
            const int s = 64 * i + lane; bool sel = false;
            if (64 * i < n) {
                const bool valid = s < n;
                if (n <= 256) sel = valid;
                else { const unsigned key = valid ? mono_key(sc[s]) : 0u; const bool eq = valid && key == thr; const unsigned long long em = __ballot(eq);
                    const int rank = eqc + __popcll(em & ((1ull << lane) - 1ull)); sel = valid && (key > thr || (eq && rank < need)); eqc += __popcll(em); }
            }
            const unsigned long long bm = __ballot(sel);
            if (lane == 0) { MASK[((size_t)row * 2 + 0) * 64 + i] = pack_mask(bm, 0); MASK[((size_t)row * 2 + 1) * 64 + i] = pack_mask(bm, 1); }
        }
        WSYNC();
    }
}
DI void naive_dsa(Frame& F) {
    F.refresh();
    if (F.wave >= 4) return;
    const int gw = F.bid * 4 + F.wave, NGW = F.G * 4;
    LAS unsigned char* wl = F.lds + F.wave * 20480;
    LAS float* sc = (LAS float*)wl;
    LAS float* sqf = (LAS float*)(wl + 8192);
    LAS unsigned* list = (LAS unsigned*)(wl + 8192 + 2048);
    LAS float* invs = (LAS float*)(wl + 8192 + 2048 + 2048);
    const bf16_t* SQ = (const bf16_t*)(F.ws + WS_SQ); const bf16_t* SK = (const bf16_t*)(F.ws + WS_SK); const bf16_t* SV = (const bf16_t*)(F.ws + WS_SV);
    const unsigned* MASK = (const unsigned*)(F.ws + WS_MASK); bf16_t* Y = (bf16_t*)(F.ws + WS_Y);
    const int lane = F.lane;
    for (int row = gw; row < MC; row += NGW) {
        const int b = row >> 12, t = row & (SEQ - 1);
        { float q[8]; ld8f(SQ + (size_t)row * 512 + 8 * lane, q);
#pragma unroll
          for (int j = 0; j < 8; ++j) sqf[8 * lane + j] = q[j]; }
        int nsel = 0;
        for (int i = 0; i <= (t >> 6); ++i) {
            const unsigned w0 = MASK[((size_t)row * 2 + 0) * 64 + i], w1 = MASK[((size_t)row * 2 + 1) * 64 + i];
            const unsigned long long bm = unpack_mask(w0, w1);
            const bool sel = (bm >> lane) & 1ull;
            const int pos = nsel + __popcll(bm & ((1ull << lane) - 1ull));
            if (sel && pos < 256) list[pos] = (unsigned)(64 * i + lane);
            nsel += __popcll(bm);
        }
        if (nsel > 256) nsel = 256;
        WSYNC();
        for (int k = lane; k < nsel; k += 64) {
            const bf16_t* kr = SK + ((size_t)b * SEQ + list[k]) * 512;
#pragma unroll 1
            for (int h = 0; h < 8; ++h) { float d = 0.f;
#pragma unroll
                for (int c = 0; c < 8; ++c) { float kv[8]; ld8f(kr + h * 64 + 8 * c, kv);
#pragma unroll
                    for (int j = 0; j < 8; ++j) d += sqf[h * 64 + 8 * c + j] * kv[j]; }
                sc[h * 256 + k] = d; }
        }
        WSYNC();
#pragma unroll 1
        for (int h = 0; h < 8; ++h) {
            float mx = -INFINITY; for (int k = lane; k < nsel; k += 64) mx = fmaxf(mx, sc[h * 256 + k]);
            mx = wave_max(mx); float sum = 0.f;
            for (int k = lane; k < nsel; k += 64) { const float p = fexp2(sc[h * 256 + k] - mx); sc[h * 256 + k] = p; sum += p; }
            sum = wave_sum(sum); if (lane == 0) invs[h] = 1.0f / sum;
        }
        WSYNC();
        { const int h = lane >> 3, d0 = (lane & 7) * 8; float accv[8] = {0.f, 0.f, 0.f, 0.f, 0.f, 0.f, 0.f, 0.f};
          for (int k = 0; k < nsel; ++k) { const float p = sc[h * 256 + k]; float v[8]; ld8f(SV + ((size_t)b * SEQ + list[k]) * 512 + h * 64 + d0, v);
#pragma unroll
              for (int j = 0; j < 8; ++j) accv[j] += p * v[j]; }
          const float inv = invs[h];
          u32x4 o; o.x = pk2(accv[0] * inv, accv[1] * inv); o.y = pk2(accv[2] * inv, accv[3] * inv); o.z = pk2(accv[4] * inv, accv[5] * inv); o.w = pk2(accv[6] * inv, accv[7] * inv);
          *(u32x4*)(Y + (size_t)row * 1536 + 512 + h * 64 + d0) = o; }
        WSYNC();
    }
}
DI void naive_mlstm(Frame& F, const Args& a, int l) {
    F.refresh();
    const int gw = F.bid * NWAVES + F.wave, NGW = F.G * NWAVES;
    LAS unsigned char* wl = F.lds + F.wave * 16384;
    LAS float* pl = (LAS float*)wl;
    const bf16_t* QK = (const bf16_t*)(F.ws + WS_QK); const bf16_t* VM = (const bf16_t*)(F.ws + WS_VM); const bf16_t* OM = (const bf16_t*)(F.ws + WS_OM);
    const float* AK = (const float*)(F.ws + WS_AK); const float* MQ = (const float*)(F.ws + WS_MQ); const float* EM = (const float*)(F.ws + WS_EM);
    bf16_t* Y = (bf16_t*)(F.ws + WS_Y); const float* mng = a.in[I_MNG] + (size_t)l * 512;
    const int lane = F.lane;
    for (int qi = gw; qi < MC * 4; qi += NGW) {
        const int row = qi >> 2, h = qi & 3, b = row >> 12, t = row & (SEQ - 1), seq = b * 4 + h;
        const unsigned qw = *(const unsigned*)(QK + (size_t)row * 1024 + h * 128 + 2 * lane);
        const float q0 = bflo(qw), q1 = bfhi(qw);
        const float Mt = MQ[(size_t)seq * SEQ + t];
        float denp = 0.f;
        for (int s0 = 0; s0 <= t; s0 += 64) {
            const int s = s0 + lane; const bool valid = s <= t; const int sr = valid ? s : t;
            const bf16_t* kr = QK + ((size_t)b * SEQ + sr) * 1024 + 512 + h * 128;
            float d = 0.f;
#pragma unroll 4
            for (int c = 0; c < 16; ++c) { float kv[8]; ld8f(kr + 8 * c, kv);
#pragma unroll
                for (int j = 0; j < 4; ++j) { d += __shfl(q0, 4 * c + j) * kv[2 * j] + __shfl(q1, 4 * c + j) * kv[2 * j + 1]; } }
            const float p = valid ? d * fexp(AK[(size_t)seq * SEQ + sr] - Mt) : 0.f;
            pl[s] = p;
            denp += p;
        }
        const float den = wave_sum(denp);
        WSYNC();
        float a0 = 0.f, a1 = 0.f;
        for (int s = 0; s <= t; ++s) { const float p = pl[s]; const unsigned vw = *(const unsigned*)(VM + ((size_t)b * SEQ + s) * 512 + h * 128 + 2 * lane); a0 += p * bflo(vw); a1 += p * bfhi(vw); }
        const float hd = fmaxf(fabsf(den), EM[(size_t)seq * SEQ + t]);
        a0 /= hd; a1 /= hd;
        const float ss = wave_sum(a0 * a0 + a1 * a1); const float r = 1.0f / sqrtf(ss * (1.f / 128.f) + EPS);
        const unsigned ow = *(const unsigned*)(OM + (size_t)row * 512 + h * 128 + 2 * lane);
        const float y0 = a0 * r * mng[h * 128 + 2 * lane] * bflo(ow), y1 = a1 * r * mng[h * 128 + 2 * lane + 1] * bfhi(ow);
        *(unsigned*)(Y + (size_t)row * 1536 + h * 128 + 2 * lane) = pk2(y0, y1);
        WSYNC();
    }
}
DI void naive_diff(Frame& F, const Args& a, int l) {
    F.refresh();
    if (F.wave >= 4) return;
    const int gw = F.bid * 4 + F.wave, NGW = F.G * 4;
    LAS unsigned char* wl = F.lds + F.wave * 32768;
    LAS float* p0 = (LAS float*)wl; LAS float* p1 = (LAS float*)(wl + 16384);
    const bf16_t* DQ = (const bf16_t*)(F.ws + WS_DQ); const bf16_t* DK = (const bf16_t*)(F.ws + WS_DK); const bf16_t* DV = (const bf16_t*)(F.ws + WS_DV);
    bf16_t* Y = (bf16_t*)(F.ws + WS_Y); const float* dog = a.in[I_DOG] + (size_t)l * 128; const float* lam = a.in[I_LAM] + (size_t)l * 256;
    const int lane = F.lane;
    const float lam_init = (l == 0) ? 0.2f : 0.35550906759096934f;
    const float s01 = wave_sum(lam[lane] * lam[64 + lane]), s23 = wave_sum(lam[128 + lane] * lam[192 + lane]);
    const float lam_val = fexp(s01) - fexp(s23) + lam_init;
    for (int qi = gw; qi < MC * 4; qi += NGW) {
        const int row = qi >> 2, h = qi & 3, b = row >> 12, t = row & (SEQ - 1);
        const float qa = bf2f(DQ[(size_t)row * 512 + (2 * h) * 64 + lane]), qb = bf2f(DQ[(size_t)row * 512 + (2 * h + 1) * 64 + lane]);
        float mx0 = -INFINITY, mx1 = -INFINITY;
        for (int s0 = 0; s0 <= t; s0 += 64) {
            const int s = s0 + lane; const bool valid = s <= t; const int sr = valid ? s : t;
            const bf16_t* kr = DK + ((size_t)b * SEQ + sr) * 512 + (2 * h) * 64;
            float d0 = 0.f, d1 = 0.f;
#pragma unroll 4
            for (int c = 0; c < 8; ++c) { float ka[8], kb[8]; ld8f(kr + 8 * c, ka); ld8f(kr + 64 + 8 * c, kb);
#pragma unroll
                for (int j = 0; j < 8; ++j) { d0 += __shfl(qa, 8 * c + j) * ka[j]; d1 += __shfl(qb, 8 * c + j) * kb[j]; } }
            if (valid) { p0[s] = d0; p1[s] = d1; mx0 = fmaxf(mx0, d0); mx1 = fmaxf(mx1, d1); }
        }
        mx0 = wave_max(mx0); mx1 = wave_max(mx1);
        WSYNC();
        float sm0 = 0.f, sm1 = 0.f;
        for (int s = lane; s <= t; s += 64) { const float e0 = fexp2(p0[s] - mx0), e1 = fexp2(p1[s] - mx1); p0[s] = e0; p1[s] = e1; sm0 += e0; sm1 += e1; }
        const float i0 = 1.0f / wave_sum(sm0), i1 = lam_val / wave_sum(sm1);
        WSYNC();
        float a0 = 0.f, a1 = 0.f;
        for (int s = 0; s <= t; ++s) { const float av = p0[s] * i0 - p1[s] * i1; const unsigned vw = *(const unsigned*)(DV + ((size_t)b * SEQ + s) * 512 + h * 128 + 2 * lane); a0 += av * bflo(vw); a1 += av * bfhi(vw); }
        const float ss = wave_sum(a0 * a0 + a1 * a1); const float r = 1.0f / sqrtf(ss * (1.f / 128.f) + EPS) * (1.0f - lam_init);
        *(unsigned*)(Y + (size_t)row * 1536 + 1024 + h * 128 + 2 * lane) = pk2(a0 * r * dog[2 * lane], a1 * r * dog[2 * lane + 1]);
        WSYNC();
    }
}

typedef float f32x16 __attribute__((ext_vector_type(16)));
typedef short s16x4 __attribute__((ext_vector_type(4)));
typedef __bf16 bf16x2_t __attribute__((ext_vector_type(2)));
DI unsigned cvtpk(float lo, float hi) { f32x2 v = {lo, hi}; bf16x2_t b = __builtin_convertvector(v, bf16x2_t); return __builtin_bit_cast(unsigned, b); }
#define MFMA32(a, b, c) __builtin_amdgcn_mfma_f32_32x32x16_bf16((a), (b), (c), 0, 0, 0)
DI s16x4 trread(LAS const unsigned char* p) { return __builtin_bit_cast(s16x4, __builtin_amdgcn_ds_read_tr16_b64_v4i16((LAS s16x4*)p)); }
#ifndef MIXMODES
#define MIXMODES 7
#endif
constexpr int CW_QUEUE = 8192;
constexpr int ATT_WSF_OFF = RING_BYTES + 1024;
constexpr float NEGBIG = -1.0e30f;
constexpr float RESC_THR = 16.0f;

DI float max3f(float a, float b, float c) { float r_; asm("v_max3_f32 %0, %1, %2, %3" : "=v"(r_) : "v"(a), "v"(b), "v"(c)); return r_; }
template <int MODE>
DI void attn_qk(f32x16& s0, f32x16& s1, const bf16x8 (&qf)[MODE == 2 ? 8 : 4], LAS const unsigned char* kb, int koff, int j, int q0w, int r, int h, unsigned mw, const bool DIAG) {
    constexpr int KW = MODE == 0 ? 64 : 128, DQK = MODE == 2 ? 128 : 64, DV = MODE == 0 ? 64 : 128, KROWB = KW * 2 + 16, VROWB = MODE == 0 ? 192 : 320, KBYTES = 64 * KROWB, VBYTES = 64 * VROWB;
    constexpr int NKS = DQK / 16, NVB = DV / 32;
    (void)KBYTES; (void)VBYTES; (void)NVB;
    if (MODE == 0) {
        const unsigned nmw = ~mw;
#pragma unroll
        for (int i = 0; i < 16; ++i) { s0[i] = __uint_as_float((unsigned)((int)(nmw << (31 - i)) >> 31) & 0xF149F2CAu); s1[i] = __uint_as_float((unsigned)((int)(nmw << (15 - i)) >> 31) & 0xF149F2CAu); }
    } else if (MODE == 1 && DIAG) {
        const int qd = q0w + r - 64 * j;
#pragma unroll
        for (int i = 0; i < 16; ++i) { const int kk = (i & 3) + 8 * (i >> 2) + 4 * h; s0[i] = kk > qd ? NEGBIG : 0.f; s1[i] = kk + 32 > qd ? NEGBIG : 0.f; }
    } else {
#pragma unroll
        for (int i = 0; i < 16; ++i) { s0[i] = 0.f; s1[i] = 0.f; }
    }
#pragma unroll
    for (int s = 0; s < NKS; ++s) {
        const bf16x8 k0 = *(LAS const bf16x8*)(kb + koff + 32 * s);
        const bf16x8 k1 = *(LAS const bf16x8*)(kb + koff + 32 * KROWB + 32 * s);
        s0 = MFMA32(k0, qf[s], s0); s1 = MFMA32(k1, qf[s], s1);
    }
}
template <int MODE>
DI void attn_pv(f32x16 (&o)[MODE == 0 ? 2 : 4], float& lsum, float& mref, f32x16& s0, f32x16& s1, LAS const unsigned char* vb, int voff,
                int j, int q0w, int r, int h, float M2, LAS float* wsf, const bool DIAG, const int probe) {
    constexpr int DV = MODE == 0 ? 64 : 128, VROWB = MODE == 0 ? 192 : 320, VBYTES = 64 * VROWB;
    constexpr int NVB = DV / 32;
    LAS const unsigned char* ab = vb + VBYTES;
    if (MODE == 2) {
        float part = 0.f;
        if (DIAG) {
            const int qd = q0w + r - 64 * j;
#pragma unroll
            for (int g = 0; g < 4; ++g) {
                const f32x4 a0 = *(LAS const f32x4*)(ab + (8 * g + 4 * h) * 4), a1 = *(LAS const f32x4*)(ab + (32 + 8 * g + 4 * h) * 4);
#pragma unroll
                for (int e = 0; e < 4; ++e) { const int i = 4 * g + e, kk = 8 * g + 4 * h + e;
                    float w0 = fexp2(a0[e] - M2), w1 = fexp2(a1[e] - M2);
                    if (kk > qd) w0 = 0.f; if (kk + 32 > qd) w1 = 0.f;
                    s0[i] *= w0; s1[i] *= w1; part += s0[i] + s1[i]; }
            }
        } else {
#pragma unroll
            for (int g = 0; g < 4; ++g) {
                const f32x4 a0 = *(LAS const f32x4*)(ab + (8 * g + 4 * h) * 4), a1 = *(LAS const f32x4*)(ab + (32 + 8 * g + 4 * h) * 4);
#pragma unroll
                for (int e = 0; e < 4; ++e) { const int i = 4 * g + e;
                    s0[i] *= fexp2(a0[e] - M2); s1[i] *= fexp2(a1[e] - M2); part += s0[i] + s1[i]; }
            }
        }
        lsum += part;
    } else {
        if (probe != 2) {
        asm volatile("s_nop 15\n\ts_nop 7" : "+v"(s0), "+v"(s1));
        float ta = max3f(s0[0], s0[1], s1[0]), tb = max3f(s0[2], s0[3], s1[1]); ta = max3f(ta, s1[2], s1[3]);
#pragma unroll
        for (int i = 4; i < 16; i += 4) { ta = max3f(ta, s0[i], s0[i + 1]); tb = max3f(tb, s0[i + 2], s0[i + 3]); ta = max3f(ta, s1[i], s1[i + 1]); tb = max3f(tb, s1[i + 2], s1[i + 3]); }
        float tm = max3f(ta, tb, tb); tm = max32x(tm);
        if (__any(tm > mref + RESC_THR)) {
            const float nm = tm > mref + RESC_THR ? tm : mref, al = fexp2(mref - nm);
            mref = nm; lsum *= al;
            if (h == 0) wsf[r] = al;
            WSYNC();
#pragma unroll
            for (int g = 0; g < 4; ++g) { const f32x4 av = *(LAS const f32x4*)(wsf + 8 * g + 4 * h);
#pragma unroll
                for (int v = 0; v < NVB; ++v)
#pragma unroll
                    for (int e = 0; e < 4; ++e) o[v][4 * g + e] *= av[e]; }
            WSYNC();
        }
        if (__any(mref != 0.f)) {
#pragma unroll
            for (int i = 0; i < 16; ++i) { s0[i] -= mref; s1[i] -= mref; }
        }
        float part = 0.f;
#pragma unroll
        for (int i = 0; i < 16; ++i) { s0[i] = fexp2(s0[i]); s1[i] = fexp2(s1[i]); part += s0[i] + s1[i]; }
        lsum += part;
        }
    }
    bf16x8 pf[2][2];
#pragma unroll
    for (int s2 = 0; s2 < 2; ++s2) {
        u32x4 t0, t1;
        t0.x = cvtpk(s0[8 * s2 + 0], s0[8 * s2 + 1]); t0.y = cvtpk(s0[8 * s2 + 2], s0[8 * s2 + 3]); t0.z = cvtpk(s0[8 * s2 + 4], s0[8 * s2 + 5]); t0.w = cvtpk(s0[8 * s2 + 6], s0[8 * s2 + 7]);
        t1.x = cvtpk(s1[8 * s2 + 0], s1[8 * s2 + 1]); t1.y = cvtpk(s1[8 * s2 + 2], s1[8 * s2 + 3]); t1.z = cvtpk(s1[8 * s2 + 4], s1[8 * s2 + 5]); t1.w = cvtpk(s1[8 * s2 + 6], s1[8 * s2 + 7]);
        pf[0][s2] = __builtin_bit_cast(bf16x8, t0); pf[1][s2] = __builtin_bit_cast(bf16x8, t1);
    }
    if (probe != 3)
#pragma unroll
    for (int v = 0; v < NVB; ++v)
#pragma unroll
        for (int p = 0; p < 2; ++p)
#pragma unroll
            for (int s2 = 0; s2 < 2; ++s2) {
                const s16x4 lo = trread(vb + voff + (32 * p + 16 * s2) * VROWB + 64 * v), hi = trread(vb + voff + (32 * p + 16 * s2 + 8) * VROWB + 64 * v);
                const bf16x8 vf = (bf16x8){lo[0], lo[1], lo[2], lo[3], hi[0], hi[1], hi[2], hi[3]};
                o[v] = MFMA32(pf[p][s2], vf, o[v]);
            }
}

template <int MODE>
DI void attn_tile(f32x16 (&o)[MODE == 0 ? 2 : 4], float& lsum, float& mref, const bf16x8 (&qf)[MODE == 2 ? 8 : 4], LAS const unsigned char* kb, int koff, int voff,
                  int j, int q0w, int r, int h, unsigned mw, float M2, LAS float* wsf, const bool DIAG, const int probe) {
    constexpr int KW = MODE == 0 ? 64 : 128, KROWB = KW * 2 + 16, KBYTES = 64 * KROWB;
    f32x16 s0, s1;
    attn_qk<MODE>(s0, s1, qf, kb, koff, j, q0w, r, h, mw, DIAG);
    attn_pv<MODE>(o, lsum, mref, s0, s1, kb + KBYTES, voff, j, q0w, r, h, M2, wsf, DIAG, probe);
}
template <int MODE>
DI void attn_unit(Frame& F, const Args& a, int l, int b, int head, int qb, float lam_val, float lam_init) {
    constexpr int KW = MODE == 0 ? 64 : 128, DQK = MODE == 2 ? 128 : 64, NCOMP = 1, NPASS = 1, DV = MODE == 0 ? 64 : 128;
    constexpr int KROWB = KW * 2 + 16, VROWB = MODE == 0 ? 192 : 320;
    constexpr int KBYTES = 64 * KROWB, VBYTES = 64 * VROWB, STAGE = KBYTES + VBYTES + 256;
    constexpr int NKS = DQK / 16, NVB = DV / 32, KCH = KW / 64, VCH = DV / 64;
    static_assert(2 * STAGE <= 98304, "tile buffers");
    F.refresh();
    const int probe = ((volatile LAS int*)(F.lds + MISC_OFF + 96))[2];
    const int tid = F.tid, lane = F.lane, w = F.wave, r = lane & 31, h = lane >> 5;
    const bf16_t* Qp; const bf16_t* Kp; const bf16_t* Vp; int ldq, ldk;
    if (MODE == 0) { Qp = (const bf16_t*)(F.ws + WS_SQ) + head * 64; Kp = (const bf16_t*)(F.ws + WS_SK) + head * 64; Vp = (const bf16_t*)(F.ws + WS_SV) + head * 64; ldq = 512; ldk = 512; }
    else if (MODE == 1) { Qp = (const bf16_t*)(F.ws + WS_DQ) + head * 128; Kp = (const bf16_t*)(F.ws + WS_DK) + head * 128; Vp = (const bf16_t*)(F.ws + WS_DV) + head * 128; ldq = 512; ldk = 512; }
    else { Qp = (const bf16_t*)(F.ws + WS_QK) + head * 128; Kp = (const bf16_t*)(F.ws + WS_QK) + 512 + head * 128; Vp = (const bf16_t*)(F.ws + WS_VM) + head * 128; ldq = 1024; ldk = 1024; }
    const size_t rowb = (size_t)b * SEQ;
    const int comp = MODE == 1 ? (w >> 2) : 0;
    const int q0w = MODE == 1 ? qb * 128 + (w & 3) * 32 : qb * 256 + w * 32;
    const int seq = b * 4 + head;
    LAS float* wsf = (LAS float*)(F.lds + ATT_WSF_OFF + w * 256);
    f32x16 o[NCOMP][NVB];
    float lsum[NCOMP], mref[NCOMP];
    const int i16 = lane & 15, vq = i16 >> 2, vp = i16 & 3, vcs = (lane >> 4) & 1;
    const int voff = (4 * h + vq) * VROWB + (16 * vcs + 4 * vp) * 2;
    const int koff = r * KROWB + 16 * h;
    const int NT = MODE == 2 ? 4 : (MODE == 1 ? 2 * (qb + 1) : 4 * (qb + 1)), JB = MODE == 2 ? 4 * qb : 0;
#pragma unroll 1
    for (int pass = 0; pass < NPASS; ++pass) {
    bf16x8 qf[NCOMP][NKS];
#pragma unroll
    for (int c = 0; c < NCOMP; ++c)
#pragma unroll
        for (int s = 0; s < NKS; ++s) qf[c][s] = *(const GAS bf16x8*)(Qp + (rowb + q0w + r) * ldq + comp * 64 + 16 * s + 8 * h);
#pragma unroll
    for (int c = 0; c < NCOMP; ++c)
#pragma unroll
        for (int v = 0; v < NVB; ++v)
#pragma unroll
            for (int i = 0; i < 16; ++i) o[c][v][i] = 0.f;
#pragma unroll
    for (int c = 0; c < NCOMP; ++c) { lsum[c] = 0.f; mref[c] = 0.f; }
    float M2 = 0.f;
    if (MODE == 2) M2 = ((const float*)(F.ws + WS_MQ))[(size_t)seq * SEQ + q0w + r] * LOG2E;
    const unsigned* mrow = (const unsigned*)(F.ws + WS_MASK) + ((rowb + q0w + r) * 2 + h) * 64;
    const int srow = tid >> 3, sch = tid & 7;
    const bf16_t* kg = Kp + (rowb + srow) * ldk + sch * 8; const bf16_t* vg = Vp + (rowb + srow) * 512 + sch * 8;
    const float* ag = (const float*)(F.ws + WS_AK) + (size_t)seq * SEQ;
    u32x4 kreg[KCH], vreg[VCH]; float areg = 0.f; unsigned mw = 0u; u32x4 mw4 = (u32x4){0u, 0u, 0u, 0u}, mw4n = (u32x4){0u, 0u, 0u, 0u};
#define ST_LOAD(j) do { _Pragma("unroll") for (int c_ = 0; c_ < KCH; ++c_) kreg[c_] = *(const GAS u32x4*)(kg + (size_t)(j) * 64 * ldk + c_ * 64); \
        _Pragma("unroll") for (int c_ = 0; c_ < VCH; ++c_) vreg[c_] = *(const GAS u32x4*)(vg + (size_t)(j) * 64 * 512 + c_ * 64); \
        if (MODE == 2) { if (tid < 64) areg = *(const GAS float*)(ag + (j) * 64 + tid); } \
        asm volatile("" ::: "memory"); } while (0)
#define ST_WRITE(buf) do { LAS unsigned char* sb_ = F.lds + (buf) * STAGE; \
        _Pragma("unroll") for (int c_ = 0; c_ < KCH; ++c_) *(LAS u32x4*)(sb_ + srow * KROWB + (sch + 8 * c_) * 16) = kreg[c_]; \
        _Pragma("unroll") for (int c_ = 0; c_ < VCH; ++c_) *(LAS u32x4*)(sb_ + KBYTES + srow * VROWB + (sch + 8 * c_) * 16) = vreg[c_]; \
        if (MODE == 2) { if (tid < 64) *(LAS float*)(sb_ + KBYTES + VBYTES + tid * 4) = areg * LOG2E; } } while (0)
    if (MODE == 0) mw4n = *(const GAS u32x4*)(mrow + JB);
    ST_LOAD(JB); ST_WRITE(0);
    __syncthreads();
    for (int j = JB; j < JB + NT; ++j) {
        const int cur = j & 1;
        if (MODE == 0) {
            if ((j & 3) == 0) { mw4 = mw4n; if (j + 4 < JB + NT) mw4n = *(const GAS u32x4*)(mrow + j + 4); }
            mw = (j & 3) == 0 ? mw4.x : ((j & 3) == 1 ? mw4.y : ((j & 3) == 2 ? mw4.z : mw4.w));
        }
        if (j + 1 < JB + NT && (probe == 0 || probe == 2 || probe == 3)) ST_LOAD(j + 1);
        if (64 * j <= q0w + 31) {
            LAS const unsigned char* kb = F.lds + cur * STAGE;
            attn_tile<MODE>(o[0], lsum[0], mref[0], qf[0], kb, koff + comp * 128, voff, j, q0w, r, h, mw, M2, wsf, 64 * j + 63 > q0w, probe);
        }
        if (probe != 4) { if (j + 1 < JB + NT) ST_WRITE(cur ^ 1);
        __syncthreads(); }
    }
#undef ST_LOAD
#undef ST_WRITE
    }
    if (MODE == 2) { if (qb > 0) {
        const float Mp2 = ((const float*)(F.ws + WS_MQ))[(size_t)seq * SEQ + 256 * qb - 1] * LOG2E;
        const float M2s = ((const float*)(F.ws + WS_MQ))[(size_t)seq * SEQ + q0w + r] * LOG2E;
        const float g = fexp2(Mp2 - M2s);
        const float* NSn = (const float*)(F.ws + WS_MN + 128 * 1024) + ((size_t)seq * 16 + qb) * 128;
        const bf16_t* Cn = (const bf16_t*)(F.ws + WS_MC) + ((size_t)seq * 16 + qb) * 16384;
        bf16x8 qs[8]; float dpart = 0.f;
#pragma unroll
        for (int s = 0; s < 8; ++s) {
            const bf16x8 qv = *(const GAS bf16x8*)(Qp + (rowb + q0w + r) * ldq + 16 * s + 8 * h);
            const u32x4 qw = __builtin_bit_cast(u32x4, qv);
            const f32x4 n0 = *(const GAS f32x4*)(NSn + 16 * s + 8 * h), n1 = *(const GAS f32x4*)(NSn + 16 * s + 8 * h + 4);
            const float q0 = bflo(qw.x), q1 = bfhi(qw.x), q2 = bflo(qw.y), q3 = bfhi(qw.y), q4 = bflo(qw.z), q5 = bfhi(qw.z), q6 = bflo(qw.w), q7 = bfhi(qw.w);
            dpart += (q0 * n0[0] + q1 * n0[1]) + (q2 * n0[2] + q3 * n0[3]) + (q4 * n1[0] + q5 * n1[1]) + (q6 * n1[2] + q7 * n1[3]);
            u32x4 t; t.x = cvtpk(q0 * g, q1 * g); t.y = cvtpk(q2 * g, q3 * g); t.z = cvtpk(q4 * g, q5 * g); t.w = cvtpk(q6 * g, q7 * g);
            qs[s] = __builtin_bit_cast(bf16x8, t);
        }
        lsum[0] += g * dpart;
#pragma unroll
        for (int v = 0; v < NVB; ++v) {
            bf16x8 cf[8];
#pragma unroll
            for (int s = 0; s < 8; ++s) cf[s] = *(const GAS bf16x8*)(Cn + (size_t)(32 * v + r) * 128 + 16 * s + 8 * h);
#pragma unroll
            for (int s = 0; s < 8; ++s) o[0][v] = MFMA32(qs[s], cf[s], o[0][v]);
        }
    } }
    float sc0; const float sc1 = 0.f;
    if (MODE == 1) { lam_val = ((volatile LAS float*)(F.lds + MISC_OFF + 96))[0]; lam_init = ((volatile LAS float*)(F.lds + MISC_OFF + 96))[1]; }
    { float lt = sum32x(lsum[0]);
      if (MODE == 2) sc0 = frcp(fmaxf(fabsf(lt), ((const float*)(F.ws + WS_EM))[(size_t)seq * SEQ + q0w + r]));
      else if (MODE == 1) sc0 = (comp ? lam_val : 1.0f) * frcp(lt);
      else sc0 = frcp(lt); }
    if (h == 0) { wsf[r] = sc0; wsf[32 + r] = sc1; }
    WSYNC();
    LAS float* stg = (LAS float*)(F.lds + w * 16384);
#pragma unroll
    for (int g = 0; g < 4; ++g) {
        const f32x4 av = *(LAS const f32x4*)(wsf + 8 * g + 4 * h);
#pragma unroll
        for (int e = 0; e < 4; ++e) { const int i = 4 * g + e, row = 8 * g + 4 * h + e;
#pragma unroll
            for (int v = 0; v < NVB; ++v) { float val = o[0][v][i] * av[e]; stg[row * DV + 32 * v + r] = val; } }
    }
    WSYNC();
    if (MODE == 1) __syncthreads();
    if (MODE != 1 || comp == 0) {
        const int q = lane >> 1, hf = lane & 1; constexpr int HC = DV / 2;
        LAS float* srow_ = stg + q * DV + hf * HC;
        if (MODE == 1) {
            LAS const float* prow_ = (LAS const float*)(F.lds + (w + 4) * 16384) + q * DV + hf * HC;
#pragma unroll
            for (int c4 = 0; c4 < HC / 4; ++c4) *(LAS f32x4*)(srow_ + 4 * c4) = *(LAS const f32x4*)(srow_ + 4 * c4) - *(LAS const f32x4*)(prow_ + 4 * c4);
        }
        size_t grow = rowb + q0w + q;
        bf16_t* Y = (bf16_t*)(F.ws + (probe ? WS_MD : WS_Y)); if (probe) grow &= 4095;
        if (MODE == 0) {
            bf16_t* yp = Y + grow * 1536 + 512 + head * 64 + hf * HC;
#pragma unroll
            for (int c8 = 0; c8 < HC / 8; ++c8) { const f32x4 x0 = *(LAS const f32x4*)(srow_ + 8 * c8), x1 = *(LAS const f32x4*)(srow_ + 8 * c8 + 4);
                u32x4 ov; ov.x = cvtpk(x0[0], x0[1]); ov.y = cvtpk(x0[2], x0[3]); ov.z = cvtpk(x1[0], x1[1]); ov.w = cvtpk(x1[2], x1[3]); *(u32x4*)(yp + 8 * c8) = ov; }
        } else {
            float ss = 0.f;
#pragma unroll
            for (int c4 = 0; c4 < HC / 4; ++c4) { const f32x4 x = *(LAS const f32x4*)(srow_ + 4 * c4); ss += (x[0] * x[0] + x[1] * x[1]) + (x[2] * x[2] + x[3] * x[3]); }
            ss += xor1(ss);
            float rs = 1.0f / sqrtf(ss * (1.f / 128.f) + EPS);
            const float* gain; bf16_t* yp; const bf16_t* gatep = nullptr;
            if (MODE == 1) { rs *= (1.0f - lam_init); gain = a.in[I_DOG] + (size_t)l * 128 + hf * HC; yp = Y + grow * 1536 + 1024 + head * 128 + hf * HC; }
            else { gain = a.in[I_MNG] + (size_t)l * 512 + head * 128 + hf * HC; yp = Y + grow * 1536 + head * 128 + hf * HC; gatep = (const bf16_t*)(F.ws + WS_OM) + grow * 512 + head * 128 + hf * HC; }
#pragma unroll
            for (int c8 = 0; c8 < HC / 8; ++c8) {
                f32x4 x0 = *(LAS const f32x4*)(srow_ + 8 * c8), x1 = *(LAS const f32x4*)(srow_ + 8 * c8 + 4);
                const f32x4 g0 = *(const f32x4*)(gain + 8 * c8), g1 = *(const f32x4*)(gain + 8 * c8 + 4);
                x0 = x0 * rs * g0; x1 = x1 * rs * g1;
                if (MODE == 2) { float gt[8]; ld8f(gatep + 8 * c8, gt);
#pragma unroll
                    for (int e = 0; e < 4; ++e) { x0[e] *= gt[e]; x1[e] *= gt[4 + e]; } }
                u32x4 ov; ov.x = cvtpk(x0[0], x0[1]); ov.y = cvtpk(x0[2], x0[3]); ov.z = cvtpk(x1[0], x1[1]); ov.w = cvtpk(x1[2], x1[3]); *(u32x4*)(yp + 8 * c8) = ov;
            }
        }
    }
    __syncthreads();
}
DI void phase_mixers(Frame& F, const Args& a, int l, int it, int modes, int probe) {
    F.refresh();
    const float* lam = a.in[I_LAM] + (size_t)l * 256;
    const float lam_init = (l == 0) ? 0.2f : 0.35550906759096934f;
    const float s01 = wave_sum(lam[F.lane] * lam[64 + F.lane]), s23 = wave_sum(lam[128 + F.lane] * lam[192 + F.lane]);
    { const float lv = fexp(s01) - fexp(s23) + lam_init; if (F.tid == 0) { ((volatile LAS int*)(F.lds + MISC_OFF + 96))[2] = probe; ((volatile LAS float*)(F.lds + MISC_OFF + 96))[0] = lv; ((volatile LAS float*)(F.lds + MISC_OFF + 96))[1] = lam_init; } }
    const float lam_val = 0.f;
    unsigned* qhead = (unsigned*)(F.ws + WS_CTL) + CW_QUEUE + it * 64;
    volatile LAS unsigned* slot = (volatile LAS unsigned*)(F.lds + MISC_OFF + 64);
    for (;;) {
        if (F.tid == 0) *slot = __hip_atomic_fetch_add(qhead, 1u, __ATOMIC_RELAXED, __HIP_MEMORY_SCOPE_AGENT);
        __syncthreads();
        const int u = __builtin_amdgcn_readfirstlane((int)*slot);
        __syncthreads();
        if (u >= 1280) break;
        if (u < 1024) { const int p_ = u >> 6, k = u & 63;
            if (k < 16) { if (modes & MIXMODES & 2) attn_unit<1>(F, a, l, k >> 2, k & 3, 31 - 2 * p_, lam_val, lam_init); }
            else if (k < 48) { if (modes & MIXMODES & 1) attn_unit<0>(F, a, l, (k - 16) >> 3, (k - 16) & 7, 15 - p_, lam_val, lam_init); }
            else { if (modes & MIXMODES & 2) attn_unit<1>(F, a, l, (k - 48) >> 2, (k - 48) & 3, 30 - 2 * p_, lam_val, lam_init); }
        } else { const int m_ = u - 1024; if (modes & MIXMODES & 4) attn_unit<2>(F, a, l, (m_ >> 2) & 3, m_ & 3, 15 - (m_ >> 4), lam_val, lam_init); }
    }
}

DI void mlstm_state_unit(Frame& F, int sq, int n) {
    F.refresh();
    constexpr int KROWB = 272, VROWB = 320, KBYTES = 64 * KROWB, VBYTES = 64 * VROWB;
    const int tid = F.tid, lane = F.lane, w = F.wave, r = lane & 31, h = lane >> 5, b = sq >> 2, head = sq & 3;
    const size_t rowb = (size_t)b * SEQ;
    const bf16_t* Kp = (const bf16_t*)(F.ws + WS_QK) + 512 + head * 128; const bf16_t* Vp = (const bf16_t*)(F.ws + WS_VM) + head * 128;
    const float* ag = (const float*)(F.ws + WS_AK) + (size_t)sq * SEQ;
    const float Mend = ((const float*)(F.ws + WS_MQ))[(size_t)sq * SEQ + 256 * n + 255];
    f32x16 acc[2];
#pragma unroll
    for (int c = 0; c < 2; ++c)
#pragma unroll
        for (int i = 0; i < 16; ++i) acc[c][i] = 0.f;
    const int dvb = w >> 1, dkb0 = 2 * (w & 1);
    const int srow = tid >> 3, sch = tid & 7;
    const int i16 = lane & 15, vq = i16 >> 2, vp = i16 & 3, vcs = (lane >> 4) & 1;
    const int toffV = (4 * h + vq) * VROWB + (16 * vcs + 4 * vp) * 2, toffK = (4 * h + vq) * KROWB + (16 * vcs + 4 * vp) * 2;
    LAS unsigned char* kb = F.lds; LAS unsigned char* vb = kb + KBYTES; LAS float* wts = (LAS float*)(vb + VBYTES);
    float nacc = 0.f; const int ndk = tid & 127, npart = tid >> 7;
    for (int jt = 0; jt < 4; ++jt) {
        const int j = 4 * n + jt;
        const float wr_ = fexp(*(const GAS float*)(ag + 64 * j + srow) - Mend);
        u32x4 kreg[2], vreg[2];
#pragma unroll
        for (int c = 0; c < 2; ++c) { kreg[c] = *(const GAS u32x4*)(Kp + (rowb + 64 * j + srow) * 1024 + (sch + 8 * c) * 8); vreg[c] = *(const GAS u32x4*)(Vp + (rowb + 64 * j + srow) * 512 + (sch + 8 * c) * 8); }
#pragma unroll
        for (int c = 0; c < 2; ++c) { u32x4 t = vreg[c];
            t.x = cvtpk(bflo(t.x) * wr_, bfhi(t.x) * wr_); t.y = cvtpk(bflo(t.y) * wr_, bfhi(t.y) * wr_); t.z = cvtpk(bflo(t.z) * wr_, bfhi(t.z) * wr_); t.w = cvtpk(bflo(t.w) * wr_, bfhi(t.w) * wr_); vreg[c] = t; }
        __syncthreads();
#pragma unroll
        for (int c = 0; c < 2; ++c) { *(LAS u32x4*)(kb + srow * KROWB + (sch + 8 * c) * 16) = kreg[c]; *(LAS u32x4*)(vb + srow * VROWB + (sch + 8 * c) * 16) = vreg[c]; }
        if (sch == 0) wts[srow] = wr_;
        __syncthreads();
#pragma unroll
        for (int sg = 0; sg < 4; ++sg) {
            const s16x4 alo = trread(vb + toffV + (16 * sg) * VROWB + 64 * dvb), ahi = trread(vb + toffV + (16 * sg + 8) * VROWB + 64 * dvb);
            const bf16x8 af = (bf16x8){alo[0], alo[1], alo[2], alo[3], ahi[0], ahi[1], ahi[2], ahi[3]};
#pragma unroll
            for (int c = 0; c < 2; ++c) {
                const s16x4 blo = trread(kb + toffK + (16 * sg) * KROWB + 64 * (dkb0 + c)), bhi = trread(kb + toffK + (16 * sg + 8) * KROWB + 64 * (dkb0 + c));
                const bf16x8 bfr = (bf16x8){blo[0], blo[1], blo[2], blo[3], bhi[0], bhi[1], bhi[2], bhi[3]};
                acc[c] = MFMA32(af, bfr, acc[c]);
            }
        }
#pragma unroll 4
        for (int s_ = 0; s_ < 16; ++s_) { const int ks = 16 * npart + s_; nacc += wts[ks] * bf2f(*(LAS const bf16_t*)(kb + ks * KROWB + ndk * 2)); }
    }
    float* D = (float*)(F.ws + WS_MD) + ((size_t)sq * 16 + n) * 16384;
#pragma unroll
    for (int c = 0; c < 2; ++c)
#pragma unroll
        for (int i = 0; i < 16; ++i) D[(32 * dvb + (i & 3) + 8 * (i >> 2) + 4 * h) * 128 + 32 * (dkb0 + c) + r] = acc[c][i];
    __syncthreads();
    LAS float* red = (LAS float*)F.lds;
    red[npart * 128 + ndk] = nacc;
    __syncthreads();
    if (tid < 128) ((float*)(F.ws + WS_MN))[((size_t)sq * 16 + n) * 128 + tid] = (red[tid] + red[128 + tid]) + (red[256 + tid] + red[384 + tid]);
    __syncthreads();
}
DI void mlstm_state_scan(Frame& F) {
    const int gid = (F.bid * NWAVES + F.wave) * 64 + F.lane, NG_ = F.G * NWAVES * 64;
    const float* D = (const float*)(F.ws + WS_MD); bf16_t* C = (bf16_t*)(F.ws + WS_MC); const float* MQ = (const float*)(F.ws + WS_MQ);
    for (int e = gid; e < CB * 4 * 16384; e += NG_) {
        const int sq = e >> 14, idx = e & 16383;
        float d[15], me[15];
#pragma unroll
        for (int n = 0; n < 15; ++n) { d[n] = D[((size_t)sq * 16 + n) * 16384 + idx]; me[n] = MQ[(size_t)sq * SEQ + 256 * n + 255]; }
        float c = 0.f;
#pragma unroll
        for (int n = 0; n < 15; ++n) { const float f = n == 0 ? 0.f : fexp(me[n - 1] - me[n]); c = f * c + d[n]; C[((size_t)sq * 16 + n + 1) * 16384 + idx] = (bf16_t)f2bf(c); }
    }
    const float* Nv = (const float*)(F.ws + WS_MN); float* NS = (float*)(F.ws + WS_MN + 128 * 1024);
    for (int e = gid; e < CB * 4 * 128; e += NG_) {
        const int sq = e >> 7, idx = e & 127; float c = 0.f;
#pragma unroll
        for (int n = 0; n < 15; ++n) { const float me = MQ[(size_t)sq * SEQ + 256 * n + 255]; const float f = n == 0 ? 0.f : fexp(MQ[(size_t)sq * SEQ + 256 * (n - 1) + 255] - me);
            c = f * c + Nv[((size_t)sq * 16 + n) * 128 + idx]; NS[((size_t)sq * 16 + n + 1) * 128 + idx] = c; }
    }
}

constexpr size_t SC_BSTRIDE = (size_t)4096 * (64 * 65 / 2);
DI size_t sc_off(int b, int t) { const int qb = t >> 6; return (size_t)b * SC_BSTRIDE + (size_t)4096 * (qb * (qb + 1) / 2) + (size_t)(t & 63) * 64 * (qb + 1); }
constexpr int CW_QUEUE2 = 12288;
DI void phase_scores(Frame& F, int it) {
    F.refresh();
    unsigned* qhead = (unsigned*)(F.ws + WS_CTL) + CW_QUEUE2 + it * 64;
    volatile LAS unsigned* slot = (volatile LAS unsigned*)(F.lds + MISC_OFF + 64);
    const bf16_t* IQ = (const bf16_t*)(F.ws + WS_IQ); const bf16_t* IK = (const bf16_t*)(F.ws + WS_IK); const float* IW = (const float*)(F.ws + WS_IW);
    float* SC = (float*)(F.ws + WS_HREG);
    for (;;) {
        if (F.tid == 0) *slot = __hip_atomic_fetch_add(qhead, 1u, __ATOMIC_RELAXED, __HIP_MEMORY_SCOPE_AGENT);
        __syncthreads();
        const int u = __builtin_amdgcn_readfirstlane((int)*slot);
        __syncthreads();
        if (u >= CB * 160 + 240) break;
        if (u >= CB * 160) { const int m_ = u - CB * 160; mlstm_state_unit(F, m_ & 15, m_ >> 4); continue; }
        int b = u / 160, k = u % 160, qb, seg;
        {
          int cls = 3, base = 0;
          for (;; --cls) { const int cnt = 16 * (cls + 1); if (k < base + cnt) break; base += cnt; }
          const int kk = k - base; qb = 16 * cls + (kk % 16); seg = kk / 16; }
        F.refresh();
        const int lane = F.lane, w = F.wave, r = lane & 31, h = lane >> 5, qh = w & 1;
        const int t0 = 64 * qb + 32 * qh;
        const size_t rowq = (size_t)b * SEQ + t0 + r;
        const f32x4 wv = *(const GAS f32x4*)(IW + rowq * 4);
        bf16x8 qf[4][4];
#pragma unroll
        for (int hd = 0; hd < 4; ++hd)
#pragma unroll
            for (int s = 0; s < 4; ++s) qf[hd][s] = *(const GAS bf16x8*)(IQ + rowq * 256 + hd * 64 + 16 * s + 8 * h);
        LAS unsigned* T = (LAS unsigned*)(F.lds + w * 8448);
        const int jplast = ((16 * seg + 15 < qb) ? 16 * seg + 15 : qb) >> 1;
        unsigned short* scb = (unsigned short*)(F.ws + WS_HREG) + sc_off(b, t0);
        const int rstride = 64 * (qb + 1);
        for (int jp = 8 * seg + (w >> 1); jp <= jplast; jp += 4) {
            const int nt2 = (2 * jp + 1 <= qb) ? 2 : 1;
            bf16x8 kfa[4][4];
#pragma unroll
            for (int q4 = 0; q4 < 4; ++q4) { const int jq = 2 * jp + ((q4 >> 1) < nt2 ? (q4 >> 1) : 0);
#pragma unroll
                for (int s = 0; s < 4; ++s) kfa[q4][s] = *(const GAS bf16x8*)(IK + ((size_t)b * SEQ + 64 * jq + 32 * (q4 & 1) + r) * 64 + 8 * h + 16 * s); }
#pragma unroll
            for (int ts = 0; ts < 2; ++ts) { if (ts < nt2) {
#pragma unroll
                for (int p = 0; p < 2; ++p) {
                    float sc[16];
#pragma unroll
                    for (int i = 0; i < 16; ++i) sc[i] = 0.f;
#pragma unroll
                    for (int hd = 0; hd < 4; ++hd) {
                        f32x16 acc;
#pragma unroll
                        for (int i = 0; i < 16; ++i) acc[i] = 0.f;
#pragma unroll
                        for (int s = 0; s < 4; ++s) acc = MFMA32(kfa[2 * ts + p][s], qf[hd][s], acc);
#pragma unroll
                        for (int i = 0; i < 16; ++i) sc[i] += wv[hd] * fmaxf(acc[i], 0.f);
                    }
#pragma unroll
                    for (int i = 0; i < 16; i += 2) {
                        const unsigned lo = __builtin_bit_cast(unsigned short, (_Float16)(sc[i] + 0.0f)), hi = __builtin_bit_cast(unsigned short, (_Float16)(sc[i + 1] + 0.0f));
                        T[r * 65 + ((64 * ts + 32 * p + (i & 3) + 8 * (i >> 2) + 4 * h) >> 1)] = lo | (hi << 16); }
                }
            } }
            WSYNC();
            if (lane < 32 * nt2) {
#pragma unroll 8
                for (int q = 0; q < 32; ++q) *(unsigned*)(scb + (size_t)q * rstride + 128 * jp + 2 * lane) = T[q * 65 + lane];
            }
            WSYNC();
        }
    }
}
DI unsigned long long spread32(unsigned x) {
    unsigned long long v = x;
    v = (v | (v << 16)) & 0x0000FFFF0000FFFFull; v = (v | (v << 8)) & 0x00FF00FF00FF00FFull; v = (v | (v << 4)) & 0x0F0F0F0F0F0F0F0Full;
    v = (v | (v << 2)) & 0x3333333333333333ull; v = (v | (v << 1)) & 0x5555555555555555ull; return v;
}
DI unsigned pack_nib(unsigned long long bm, int hh) {
    unsigned long long x = (bm >> (4 * hh)) & 0x0F0F0F0F0F0F0F0Full;
    x = (x | (x >> 4)) & 0x00FF00FF00FF00FFull; x = (x | (x >> 8)) & 0x0000FFFF0000FFFFull; x = (x | (x >> 16)) & 0x00000000FFFFFFFFull; return (unsigned)x;
}
DI void radix_find(LAS unsigned* hist, int lane, int& need, unsigned& digit, unsigned& cnt) {
    const u32x4 c = *(LAS const u32x4*)(hist + 4 * lane);
    const unsigned ls = (c.x + c.y) + (c.z + c.w); unsigned inc = ls;
#pragma unroll
    for (int o = 1; o < 64; o <<= 1) { const unsigned y = shup_u(inc, o, lane); if (lane >= o) inc += y; }
    const unsigned total = rdl_u(inc, 63);
    unsigned cum = total - inc; int fbin = -1; unsigned fneed = 0u, fcnt = 0u;
    if (cum < (unsigned)need && cum + c.w >= (unsigned)need) { fbin = 4 * lane + 3; fneed = (unsigned)need - cum; fcnt = c.w; } cum += c.w;
    if (fbin < 0 && cum < (unsigned)need && cum + c.z >= (unsigned)need) { fbin = 4 * lane + 2; fneed = (unsigned)need - cum; fcnt = c.z; } cum += c.z;
    if (fbin < 0 && cum < (unsigned)need && cum + c.y >= (unsigned)need) { fbin = 4 * lane + 1; fneed = (unsigned)need - cum; fcnt = c.y; } cum += c.y;
    if (fbin < 0 && cum < (unsigned)need && cum + c.x >= (unsigned)need) { fbin = 4 * lane; fneed = (unsigned)need - cum; fcnt = c.x; }
    const int src = __ffsll((long long)__ballot(fbin >= 0)) - 1;
    digit = rdl_u((unsigned)fbin, src); need = (int)rdl_u(fneed, src); cnt = rdl_u(fcnt, src);
}
template <int NGP>
DI void select_row(int row, int lane, LAS unsigned* hist, const unsigned (&raw)[32], unsigned* MASK, const int probe) {
        const int b = row >> 12, t = row & (SEQ - 1), n = t + 1, ngp = (t >> 7) + 1;
        unsigned key[NGP];
        (void)b;
#pragma unroll
        for (int i = 0; i < NGP; ++i) key[i] = raw[i];
#pragma unroll
        for (int i = 0; i < NGP; ++i) { const int e2 = 64 * i + lane; unsigned w_ = key[i];
            { const unsigned sg_ = (w_ >> 15) & 0x00010001u; w_ ^= ((sg_ << 15) - sg_) + 0x80008000u; }
            if (2 * e2 >= n) w_ &= 0xFFFF0000u; if (2 * e2 + 1 >= n) w_ &= 0x0000FFFFu; key[i] = w_; }
        unsigned thr = 0u; int need = 256; bool ties = false;
        if (n > 256 && probe != 1 && probe != 3) {
            unsigned dA = 0u, dB = 0u, cnt = 0u;
            { unsigned z_ = 0u; asm volatile("" : "+v"(z_)); *(LAS u32x4*)(hist + 4 * lane) = (u32x4){z_, z_, z_, z_}; }
            WSYNC();
#pragma unroll
            for (int i = 0; i < NGP; ++i) if (i < ngp) { const unsigned kx = key[i];
                __hip_atomic_fetch_add(&hist[(kx >> 8) & 255u], 1u, __ATOMIC_RELAXED, __HIP_MEMORY_SCOPE_WORKGROUP); __hip_atomic_fetch_add(&hist[kx >> 24], 1u, __ATOMIC_RELAXED, __HIP_MEMORY_SCOPE_WORKGROUP); }
            WSYNC();
            radix_find(hist, lane, need, dA, cnt);
            WSYNC();
            if ((unsigned)need != cnt) {
                { unsigned z_ = 0u; asm volatile("" : "+v"(z_)); *(LAS u32x4*)(hist + 4 * lane) = (u32x4){z_, z_, z_, z_}; }
                WSYNC();
#pragma unroll
                for (int i = 0; i < NGP; ++i) if (i < ngp) { const unsigned kx = key[i];
                    if (((kx >> 8) & 255u) == dA) __hip_atomic_fetch_add(&hist[kx & 255u], 1u, __ATOMIC_RELAXED, __HIP_MEMORY_SCOPE_WORKGROUP);
                    if ((kx >> 24) == dA) __hip_atomic_fetch_add(&hist[(kx >> 16) & 255u], 1u, __ATOMIC_RELAXED, __HIP_MEMORY_SCOPE_WORKGROUP); }
                WSYNC();
                radix_find(hist, lane, need, dB, cnt);
                WSYNC();
                thr = (dA << 8) | dB; ties = (unsigned)need != cnt;
            } else { thr = dA << 8; ties = false; }
        }
        unsigned elo = 0u, ehi = 0u, olo = 0u, ohi = 0u; int eqc = 0;
        if (probe == 1 || probe == 3) thr = 0x9000u;
        if (probe < 2)
        {
#define SEL_STEP(i) if constexpr ((i) < NGP) if ((i) < ngp) { const unsigned kx = key[(i) < NGP ? (i) : 0], kl = kx & 0xFFFFu, kh = kx >> 16; bool sl, sh; \
            if (n <= 256) { sl = kl != 0u; sh = kh != 0u; } \
            else if (!ties) { sl = kl >= thr; sh = kh >= thr; } \
            else { const bool ql = kl == thr, qh = kh == thr; const unsigned long long ml = __ballot(ql), mh = __ballot(qh), lt = (1ull << lane) - 1ull; \
                const int rl = eqc + __popcll(ml & lt) + __popcll(mh & lt), rh = rl + (ql ? 1 : 0); \
                sl = kl > thr || (ql && rl < need); sh = kh > thr || (qh && rh < need); eqc += __popcll(ml) + __popcll(mh); } \
            const unsigned long long be = __ballot(sl), bo = __ballot(sh); const unsigned e0 = (unsigned)be, e1 = (unsigned)(be >> 32), o0 = (unsigned)bo, o1 = (unsigned)(bo >> 32); \
            asm volatile("s_nop 4\n\tv_writelane_b32 %0, %4, " #i "\n\tv_writelane_b32 %1, %5, " #i "\n\tv_writelane_b32 %2, %6, " #i "\n\tv_writelane_b32 %3, %7, " #i \
                         : "+v"(elo), "+v"(ehi), "+v"(olo), "+v"(ohi) : "s"(e0), "s"(e1), "s"(o0), "s"(o1)); }
#define SEL8(b) SEL_STEP(b) SEL_STEP(b + 1) SEL_STEP(b + 2) SEL_STEP(b + 3) SEL_STEP(b + 4) SEL_STEP(b + 5) SEL_STEP(b + 6) SEL_STEP(b + 7)
        SEL8(0) SEL8(8) SEL8(16) SEL8(24)
#undef SEL8
#undef SEL_STEP
        }
        if (lane < 32) {
            const unsigned long long ta = spread32(elo) | (spread32(olo) << 1), tb = spread32(ehi) | (spread32(ohi) << 1);
            *(u32x2*)(MASK + ((size_t)row * 2 + 0) * 64 + 2 * lane) = (u32x2){pack_nib(ta, 0), pack_nib(tb, 0)};
            *(u32x2*)(MASK + ((size_t)row * 2 + 1) * 64 + 2 * lane) = (u32x2){pack_nib(ta, 1), pack_nib(tb, 1)};
        }
}
DI void phase_select(Frame& F, const int probe) {
    F.refresh();
    const int gw = F.bid * NWAVES + F.wave, NGW = F.G * NWAVES, lane = F.lane;
    LAS unsigned* hist = (LAS unsigned*)(F.lds + F.wave * 1024);
    const unsigned short* SC = (const unsigned short*)(F.ws + WS_HREG); unsigned* MASK = (unsigned*)(F.ws + WS_MASK);
    if (!probe) mlstm_state_scan(F);
    unsigned cur[32];
#define LOAD_ROW(dst, rw) do { const int t_ = (rw) & (SEQ - 1), em_ = t_ >> 1; const unsigned* sr_ = (const unsigned*)(SC + sc_off((rw) >> 12, t_)); \
        _Pragma("unroll") for (int i_ = 0; i_ < 32; ++i_) { const int e_ = 64 * i_ + lane; dst[i_] = *(const GAS unsigned*)(sr_ + (e_ < em_ ? e_ : em_)); } } while (0)
    const int nstep = (MC + NGW - 1) / NGW;
#define ROW_OF(k) ((NGW == 2048) ? (((k) >> 1) * SEQ + (((k) & 1) ? (SEQ - 1 - gw) : gw)) : (gw + (k) * NGW))
    if (gw < MC) LOAD_ROW(cur, ROW_OF(0));
    for (int k = 0; k < nstep; ++k) {
        const int row = ROW_OF(k); if (row >= MC) break;
        unsigned nxt[32]; const int nrow = (k + 1 < nstep && ROW_OF(k + 1) < MC) ? ROW_OF(k + 1) : row;
        LOAD_ROW(nxt, nrow);
        asm volatile("" ::: "memory");
        const int cls = (row & (SEQ - 1)) >> 10;
        unsigned* mk = probe ? (unsigned*)(F.ws + WS_QKRAW) : MASK;
        if (cls == 0) select_row<8>(row, lane, hist, cur, mk, probe);
        else if (cls == 1) select_row<16>(row, lane, hist, cur, mk, probe);
        else if (cls == 2) select_row<24>(row, lane, hist, cur, mk, probe);
        else select_row<32>(row, lane, hist, cur, mk, probe);
#pragma unroll
        for (int i = 0; i < 32; ++i) cur[i] = nxt[i];
    }
#undef ROW_OF
#undef LOAD_ROW
}

#ifndef MK_ONE_LAUNCH
#define MK_ONE_LAUNCH 1
#endif
constexpr int NPHASE = 13;
__global__ void __launch_bounds__(NWAVES * 64, 2) fwd(Args args) {
    extern __shared__ __attribute__((aligned(16))) unsigned char lds[];
    Frame F;
    F.lds = (LAS unsigned char*)lds; F.ws = args.ws;
    F.tid = threadIdx.x; F.lane = F.tid & 63; F.wave = __builtin_amdgcn_readfirstlane(F.tid >> 6); F.wave0 = F.wave;
    F.G = gridDim.x; F.bid = blockIdx.x;
    volatile LAS unsigned* MISC = (volatile LAS unsigned*)(F.lds + MISC_OFF);
    for (int u = F.tid; u < (LDS_BYTES - LDSCTL_OFF) / 4; u += NWAVES * 64) ((LAS unsigned*)(F.lds + LDSCTL_OFF))[u] = 0u;
    __syncthreads();
    const bool multi = MK_ONE_LAUNCH ? true : !(args.it_hi - args.it_lo == 1 && args.ph_hi - args.ph_lo == 1);
    XcdBarrier bar; bar.bar = (unsigned*)(F.ws + WS_CTL) + CW_BAR; bar.x = 0; bar.st = nullptr;
    if (multi) bar = xcd_barrier_post((unsigned*)(F.ws + WS_CTL) + CW_BAR, MISC + 8);
#define GRID_BAR() do { if (multi) { xcd_barrier(bar); if ((REPMASK >> 15) & 1) xcd_barrier(bar); } } while (0)
    const int lo = args.ph_lo, hi = args.ph_hi; (void)lo; (void)hi;
#ifndef PHMASK
#define PHMASK 0xFFFF
#endif
#if MK_ONE_LAUNCH
#define IN(k) ((PHMASK >> (k)) & 1)
#else
#define IN(k) (((PHMASK >> (k)) & 1) && lo <= (k) && (k) < hi)
#endif
#ifndef REPMASK
#define REPMASK 0
#endif
#define PROBE_MODES 7
#define PROBE_NOLOAD 0
#define REPS(k) (1 + ((REPMASK >> (k)) & 1))
    if (IN(0) && args.it_lo == 0) for (int rp = 0; rp < REPS(0); ++rp) { phase_prologue(F, args); GRID_BAR(); }
    for (int it = args.it_lo; it < args.it_hi; ++it) {
        const int chunk = it >> 1, l = it & 1;
        unsigned char* wl = F.ws + WS_W + (size_t)l * W_LAYER;
        const size_t xoff = (size_t)chunk * MC * DM;
        const float* xin = args.in[I_X] + xoff;
        float* Xout = args.out + xoff;
        bf16_t* X16 = (bf16_t*)(F.ws + WS_X16);
        bf16_t* XN = (bf16_t*)(F.ws + WS_XN);
        if (IN(1)) for (int rp = 0; rp < REPS(1); ++rp) { phase_rmsnorm(F, l == 0 ? (const void*)xin : (const void*)X16, l != 0, args.in[I_NMG] + (size_t)l * DM, XN); GRID_BAR(); }
        if (IN(2)) for (int rp = 0; rp < REPS(2); ++rp) {
            pg8::Gemm g{XN, (const bf16_t*)(wl + WO_IN), MC, NT_IN * 256, DM}; F.refresh(); pg8::StaticOrder S; S.init(MC, NT_IN * 256, F.G, F.bid);
            EpiInProj E{F.ws, args.in[I_GB] + l * 8, l};
            pg8::gemm_phase<EpiInProj, true>(F.lds, g, S, E, F.tid);
            GRID_BAR();
        }
        if (IN(3)) for (int rp = 0; rp < REPS(3); ++rp) { phase_token(F, args, l, rp == 0 ? 0 : PROBE_NOLOAD); GRID_BAR(); }
        if (IN(4)) for (int rp = 0; rp < REPS(4); ++rp) {
            pg8::Gemm g{(const bf16_t*)(F.ws + WS_CKV), (const bf16_t*)(wl + WO_KV), MC, 1024, 256}; F.refresh(); pg8::StaticOrder S; S.init(MC, 1024, F.G, F.bid);
            EpiKV E{F.ws, l};
            pg8::gemm_phase<EpiKV, true>(F.lds, g, S, E, F.tid);
            if (rp + 1 < REPS(4)) GRID_BAR();
        }
#ifdef NAIVE_SEL
        if (IN(5)) { naive_select(F); GRID_BAR(); }
#else
        if (IN(5)) { for (int rp = 0; rp < REPS(5); ++rp) { phase_scores(F, it + 8 * rp); GRID_BAR(); } for (int rp = 0; rp < REPS(13); ++rp) { phase_select(F, rp == 0 ? 0 : PROBE_NOLOAD); GRID_BAR(); } }
#endif
        #ifdef NAIVE_MIX
        if (IN(6)) { naive_dsa(F); __syncthreads(); naive_mlstm(F, args, l); __syncthreads(); naive_diff(F, args, l); GRID_BAR(); }
#else
        if (IN(6)) for (int rp = 0; rp < REPS(6); ++rp) { phase_mixers(F, args, l, it + 8 * rp, rp == 0 ? 7 : PROBE_MODES, rp == 0 ? 0 : PROBE_NOLOAD); if (rp + 1 < REPS(6)) GRID_BAR(); }
#endif
        if (IN(7)) for (int rp = 0; rp < REPS(7); ++rp) {
            pg8::Gemm g{XN, (const bf16_t*)(wl + WO_G), MC, 3072, DM}; F.refresh(); pg8::StaticOrder S; S.init(MC, 3072, F.G, F.bid);
            EpiGate E{(bf16_t*)(F.ws + WS_HREG), args.in[I_BG] + (size_t)l * 3072};
            pg8::gemm_phase<EpiGate, true>(F.lds, g, S, E, F.tid);
            GRID_BAR();
        }
        if (IN(8)) for (int rp = 0; rp < REPS(8); ++rp) {
            pg8::Gemm g{(const bf16_t*)(F.ws + WS_Y), (const bf16_t*)(wl + WO_BR), MC, 1024, 1536}; F.refresh(); pg8::StaticOrder S; S.init(MC, 1024, F.G, F.bid);
            EpiMerge E{(const bf16_t*)(F.ws + WS_HREG), (bf16_t*)(F.ws + WS_MG)};
            pg8::gemm_phase<EpiMerge, false>(F.lds, g, S, E, F.tid);
            GRID_BAR();
        }
        if (IN(9)) for (int rp = 0; rp < REPS(9); ++rp) {
            pg8::Gemm g{(const bf16_t*)(F.ws + WS_MG), (const bf16_t*)(wl + WO_OUT), MC, 1024, 1024}; F.refresh(); pg8::StaticOrder S; S.init(MC, 1024, F.G, F.bid);
            EpiResid E{l == 0 ? (const void*)xin : (const void*)X16, (void*)X16, l != 0, true};
            pg8::gemm_phase<EpiResid, false>(F.lds, g, S, E, F.tid);
            GRID_BAR();
        }
        if (IN(10)) for (int rp = 0; rp < REPS(10); ++rp) { phase_rmsnorm(F, X16, true, args.in[I_NFG] + (size_t)l * DM, XN); GRID_BAR(); }
        if (IN(11)) for (int rp = 0; rp < REPS(11); ++rp) {
            pg8::Gemm g{XN, (const bf16_t*)(wl + WO_GU), MC, 5632, DM}; F.refresh(); pg8::StaticOrder S; S.init(MC, 5632, F.G, F.bid);
            EpiSwiGLU E{(bf16_t*)(F.ws + WS_HREG)};
            pg8::gemm_phase<EpiSwiGLU, true>(F.lds, g, S, E, F.tid);
            GRID_BAR();
        }
        if (IN(12)) for (int rp = 0; rp < REPS(12); ++rp) {
            pg8::Gemm g{(const bf16_t*)(F.ws + WS_HREG), (const bf16_t*)(wl + WO_D), MC, 1024, FF}; F.refresh(); pg8::StaticOrder S; S.init(MC, 1024, F.G, F.bid);
            EpiResid E{(const void*)X16, l == DEPTH - 1 ? (void*)Xout : (void*)X16, true, l != DEPTH - 1};
            pg8::gemm_phase<EpiResid, false>(F.lds, g, S, E, F.tid);
            GRID_BAR();
        }
    }
#undef IN
#undef GRID_BAR
}

extern "C" void kernel_launch(void* const* d_in, const int* in_sizes, int n_in, void* d_out, int out_size, void* d_ws, size_t ws_size, hipStream_t stream) {
    static int grid = 0;
    if (grid == 0) {
        if (n_in != 21 || ws_size < WS_END) { fprintf(stderr, "kernel_launch: unexpected inputs (n_in %d, ws %zu)\n", n_in, ws_size); grid = -1; return; }
        int dev = 0, cus = 0;
        if (hipGetDevice(&dev) != hipSuccess || hipDeviceGetAttribute(&cus, hipDeviceAttributeMultiprocessorCount, dev) != hipSuccess) { grid = -1; return; }
        if (hipFuncSetAttribute((const void*)fwd, hipFuncAttributeMaxDynamicSharedMemorySize, LDS_BYTES) != hipSuccess) { grid = -1; return; }
        int per_cu = 0;
        if (hipOccupancyMaxActiveBlocksPerMultiprocessor(&per_cu, (const void*)fwd, NWAVES * 64, LDS_BYTES) != hipSuccess || per_cu < 1) fprintf(stderr, "kernel_launch: occupancy query says %d\n", per_cu);
        (void)hipGetLastError();
        grid = cus;
    }
    if (grid < 0) return;
    (void)hipMemsetAsync((char*)d_ws + WS_CTL, 0, CTL_ZERO_BYTES, stream);
    Args a{};
    for (int i = 0; i < 21; ++i) a.in[i] = (const float*)d_in[i];
    a.out = (float*)d_out; a.ws = (unsigned char*)d_ws;
#if MK_ONE_LAUNCH
    a.it_lo = 0; a.it_hi = NCHUNK * DEPTH; a.ph_lo = 0; a.ph_hi = NPHASE;
    hipLaunchKernelGGL(fwd, dim3(grid), dim3(NWAVES * 64), LDS_BYTES, stream, a);
#else
    a.it_lo = 0; a.it_hi = 1; a.ph_lo = 0; a.ph_hi = 1;
    hipLaunchKernelGGL(fwd, dim3(grid), dim3(NWAVES * 64), LDS_BYTES, stream, a);
    for (int it = 0; it < NCHUNK * DEPTH; ++it)
        for (int ph = 1; ph < NPHASE; ++ph) { a.it_lo = it; a.it_hi = it + 1; a.ph_lo = ph; a.ph_hi = ph + 1; hipLaunchKernelGGL(fwd, dim3(grid), dim3(NWAVES * 64), LDS_BYTES, stream, a); }
#endif
}
```

```cpp
#include <hip/hip_runtime.h>
#include <cstdio>
#include <cstdint>

#define DI __device__ __forceinline__
#define LAS __attribute__((address_space(3)))
#define GAS __attribute__((address_space(1)))

typedef unsigned short bf16_t;
typedef short bf16x8 __attribute__((ext_vector_type(8)));
typedef float f32x4 __attribute__((ext_vector_type(4)));
typedef float f32x2 __attribute__((ext_vector_type(2)));
typedef unsigned u32x4 __attribute__((ext_vector_type(4)));
typedef unsigned u32x2 __attribute__((ext_vector_type(2)));

constexpr int BATCH = 8, SEQ = 4096, DM = 1024, DEPTH = 2;
constexpr int CB = 4;
constexpr int MC = CB * SEQ;
constexpr int NCHUNK = BATCH / CB;
constexpr int IN_COLS = 7756;
constexpr int FF = 2816;
constexpr float EPS = 1e-6f;
constexpr float LOG2E = 1.4426950408889634f;
constexpr float C2 = 0.125f * LOG2E;
constexpr int Z_MQK = 0, Z_MV = 1024, Z_MO = 1536, Z_MIF = 2048, Z_SQ = 2056, Z_CKV = 2568, Z_IQ = 2824, Z_IK = 3080, Z_IW = 3144, Z_DQ = 3148, Z_DK = 3660, Z_DV = 4172, Z_G = 4684;
constexpr int NT_IN = 19;

constexpr size_t MiB = 1u << 20;
constexpr size_t WS_CTL = 0, CTL_ZERO_BYTES = 128 * 1024;
constexpr size_t WS_COS = 1 * MiB, WS_SIN = 1 * MiB + 512 * 1024;
constexpr size_t WS_W = 2 * MiB, W_LAYER = 38 * MiB;
constexpr size_t WO_IN = 0;
constexpr size_t WO_G = WO_IN + (size_t)NT_IN * 256 * 1024 * 2;
constexpr size_t WO_KV = WO_G + (size_t)3072 * 1024 * 2;
constexpr size_t WO_BR = WO_KV + (size_t)1024 * 256 * 2;
constexpr size_t WO_OUT = WO_BR + (size_t)1024 * 1536 * 2;
constexpr size_t WO_GU = WO_OUT + (size_t)1024 * 1024 * 2;
constexpr size_t WO_D = WO_GU + (size_t)5632 * 1024 * 2;
static_assert(WO_D + (size_t)1024 * 2816 * 2 <= W_LAYER, "weights per layer");
constexpr size_t WS_ACT = WS_W + 2 * W_LAYER;
constexpr size_t WS_XN = WS_ACT;
constexpr size_t WS_QKRAW = WS_XN + 32 * MiB;
constexpr size_t WS_CKV = WS_QKRAW + 32 * MiB;
constexpr size_t WS_IQ = WS_CKV + 8 * MiB;
constexpr size_t WS_Y = WS_QKRAW;
constexpr size_t WS_QK = WS_IQ + 8 * MiB;
constexpr size_t WS_MG = WS_QK;
constexpr size_t WS_VM = WS_QK + 32 * MiB;
constexpr size_t WS_OM = WS_VM + 16 * MiB;
constexpr size_t WS_SQ = WS_OM + 16 * MiB;
constexpr size_t WS_DQ = WS_SQ + 16 * MiB;
constexpr size_t WS_DK = WS_DQ + 16 * MiB;
constexpr size_t WS_DV = WS_DK + 16 * MiB;
constexpr size_t WS_SK = WS_DV + 16 * MiB;
constexpr size_t WS_SV = WS_SK + 16 * MiB;
constexpr size_t WS_IK = WS_SV + 16 * MiB;
constexpr size_t WS_IF = WS_IK + 2 * MiB;
constexpr size_t WS_IW = WS_IF + 512 * 1024;
constexpr size_t WS_RT = WS_IW + 256 * 1024;
constexpr size_t WS_AK = WS_RT + 256 * 1024;
constexpr size_t WS_MQ = WS_AK + 256 * 1024;
constexpr size_t WS_EM = WS_MQ + 256 * 1024;
constexpr size_t WS_MASK = WS_IK + 4 * MiB;
constexpr size_t WS_HREG = WS_MASK + 8 * MiB;
constexpr size_t WS_X16 = WS_HREG + 96 * MiB;
constexpr size_t WS_MD = WS_X16 + 32 * MiB;
constexpr size_t WS_MC = WS_MD + 16 * MiB;
constexpr size_t WS_MN = WS_MC + 8 * MiB;
constexpr size_t WS_END = WS_MN + 1 * MiB;
static_assert(WS_EM + 256 * 1024 <= WS_MASK, "small buffers");
static_assert(WS_END <= 512 * MiB, "workspace");
constexpr int CW_BAR = 4096;
constexpr size_t WS_GAIN = 512 * 1024;

constexpr int RING_BYTES = 131072;
constexpr int LDSCTL_OFF = RING_BYTES, MISC_OFF = LDSCTL_OFF + 320;
constexpr int LDS_BYTES = 147456;
constexpr int NWAVES = 8;

DI float bf2f(unsigned v) { return __uint_as_float(v << 16); }
DI unsigned f2bf(float f) { unsigned u = __float_as_uint(f); return (u + 0x7fffu + ((u >> 16) & 1u)) >> 16; }
DI unsigned pk2(float lo, float hi) { return f2bf(lo) | (f2bf(hi) << 16); }
DI float bflo(unsigned w) { return __uint_as_float(w << 16); }
DI float bfhi(unsigned w) { return __uint_as_float(w & 0xffff0000u); }
typedef unsigned u32x2v __attribute__((ext_vector_type(2)));
DI float xor1(float v)  { return __uint_as_float((unsigned)__builtin_amdgcn_mov_dpp((int)__float_as_uint(v), 0xB1, 0xF, 0xF, true)); }
DI float xor2(float v)  { return __uint_as_float((unsigned)__builtin_amdgcn_mov_dpp((int)__float_as_uint(v), 0x4E, 0xF, 0xF, true)); }
DI float ror4(float v)  { return __uint_as_float((unsigned)__builtin_amdgcn_mov_dpp((int)__float_as_uint(v), 0x124, 0xF, 0xF, true)); }
DI float ror8(float v)  { return __uint_as_float((unsigned)__builtin_amdgcn_mov_dpp((int)__float_as_uint(v), 0x128, 0xF, 0xF, true)); }
DI float sum16x(float v) { const unsigned u = __float_as_uint(v); const auto r = __builtin_amdgcn_permlane16_swap(u, u, false, false); return __uint_as_float(r[0]) + __uint_as_float(r[1]); }
DI float sum32x(float v) { const unsigned u = __float_as_uint(v); const auto r = __builtin_amdgcn_permlane32_swap(u, u, false, false); return __uint_as_float(r[0]) + __uint_as_float(r[1]); }
DI float max16x(float v) { const unsigned u = __float_as_uint(v); const auto r = __builtin_amdgcn_permlane16_swap(u, u, false, false); return fmaxf(__uint_as_float(r[0]), __uint_as_float(r[1])); }
DI float max32x(float v) { const unsigned u = __float_as_uint(v); const auto r = __builtin_amdgcn_permlane32_swap(u, u, false, false); return fmaxf(__uint_as_float(r[0]), __uint_as_float(r[1])); }
DI unsigned shup_u(unsigned v, int o, int lane) { return (unsigned)__builtin_amdgcn_ds_bpermute(((lane - o) & 63) << 2, (int)v); }
DI float shup_f(float v, int o, int lane) { return __uint_as_float(shup_u(__float_as_uint(v), o, lane)); }
DI double shup_d(double v, int o, int lane) { const unsigned long long u = __builtin_bit_cast(unsigned long long, v); const unsigned lo = shup_u((unsigned)u, o, lane), hi = shup_u((unsigned)(u >> 32), o, lane); return __builtin_bit_cast(double, ((unsigned long long)hi << 32) | lo); }
DI unsigned rdl_u(unsigned v, int src) { return (unsigned)__builtin_amdgcn_readlane((int)v, src); }
DI float wave_sum(float v) { v += xor1(v); v += xor2(v); v += ror4(v); v += ror8(v); v = sum16x(v); return sum32x(v); }
DI float wave_max(float v) { v = fmaxf(v, xor1(v)); v = fmaxf(v, xor2(v)); v = fmaxf(v, ror4(v)); v = fmaxf(v, ror8(v)); v = max16x(v); return max32x(v); }
typedef __bf16 bf16x2e_t __attribute__((ext_vector_type(2)));
DI unsigned cvtpk_(float lo, float hi) { f32x2 v = {lo, hi}; bf16x2e_t b = __builtin_convertvector(v, bf16x2e_t); return __builtin_bit_cast(unsigned, b); }
DI float fexp2(float x) { return __builtin_amdgcn_exp2f(x); }
DI float fexp(float x) { return __builtin_amdgcn_exp2f(x * LOG2E); }
DI float frcp(float x) { return __builtin_amdgcn_rcpf(x); }
DI float sigmoidf_(float x) { return frcp(1.0f + fexp(-x)); }
#define WSYNC() do { asm volatile("s_waitcnt lgkmcnt(0)" ::: "memory"); __builtin_amdgcn_wave_barrier(); } while (0)

namespace pg8 {
constexpr int BM = 256, BK = 64, HALF = 128, HTB = HALF * BK * 2, STAGE_BYTES = 8 * HTB, NXCD = 8, WGM = 8;
__host__ __device__ __forceinline__ int lds_byte(int r, int c) { const int st = (r >> 4) * 2 + (c >> 5), rr = r & 15, cc = c & 31, ob = rr * 64 + cc * 2; return st * 1024 + (ob ^ (((ob >> 9) & 1) << 5)); }
__host__ __device__ __forceinline__ void stage_rc(int b, int& R, int& C) { const int st = b / 1024, sb = b % 1024, swz = sb ^ (((sb >> 9) & 1) << 5); R = (st >> 1) * 16 + swz / 64; C = (st & 1) * 32 + (swz % 64) / 2; }
__host__ __device__ __forceinline__ int perm32(int rho) { const int n = rho >> 4, i = rho & 15; return 8 * (i >> 2) + 4 * n + (i & 3); }
struct Unit { int pm, pn; };
struct Gemm { const bf16_t* A; const bf16_t* Bt; int M, N, K; };
struct StaticOrder {
    int nM, nN, nwg, G, c;
    __host__ __device__ void init(int M, int N, int G_, int c_) { nM = M / BM; nN = N / BM; nwg = nM * nN; G = G_; c = c_; }
    __host__ __device__ bool next(int i, Unit& u) const {
        const long L = (long)i * G + c; if (L >= nwg) return false;
        int wgid = (int)L; { const int q = nwg / NXCD, r = nwg % NXCD, xcd = wgid % NXCD, off = wgid / NXCD; wgid = (xcd < r ? xcd * (q + 1) : r * (q + 1) + (xcd - r) * q) + off; }
        const int nig = WGM * nN, gid = wgid / nig, fm = gid * WGM, gsz = (nM - fm) < WGM ? (nM - fm) : WGM;
        u.pm = fm + ((wgid % nig) % gsz); u.pn = (wgid % nig) / gsz; return true;
    }
};
template <class Epi, bool ALIGN_EPI>
__device__ __forceinline__ void gemm_phase(LAS unsigned char* lds, const Gemm g, const StaticOrder& S, const Epi& E, int tid_in) {
    int tid_ = tid_in; asm volatile("" : "+v"(tid_));
    int K_ = g.K; asm volatile("" : "+s"(K_));
    const int tid = tid_, wid = __builtin_amdgcn_readfirstlane(tid >> 6), lane = tid & 63, wr = wid >> 2, wc = wid & 3, fr = lane & 15, fq = lane >> 4;
    const int K = K_, nt = K / BK;
    unsigned voffA[2], voffB[2];
#pragma unroll
    for (int i = 0; i < 2; ++i) { int R, C; stage_rc(tid * 16 + i * 8192, R, C); const int Rb = Epi::PERM ? ((R & ~31) + perm32(R & 31)) : R;
        voffA[i] = (unsigned)(R * K + C) * 2u; voffB[i] = (unsigned)(Rb * K + C) * 2u; }
    const size_t kstep = (size_t)(BK * 2);
    const size_t hstep = (size_t)HALF * K * 2;
    const size_t tstep = 2 * hstep;
    const unsigned ldsw = (unsigned)wid * 1024u;
    const int aoff = lds_byte(wr * 64 + fr, fq * 8), boff = lds_byte(wc * 32 + fr, fq * 8);
#define PG8_SA(b, h) (((b) * 2 + (h)) * HTB)
#define PG8_SB(b, h) ((4 + (b) * 2 + (h)) * HTB)
#define PG8_STAGE(bufoff, gbase, voff) do { _Pragma("unroll") for (int _i = 0; _i < 2; ++_i) \
        __builtin_amdgcn_global_load_lds((const unsigned*)((const char*)(gbase) + (voff)[_i]), (LAS unsigned*)(lds + (bufoff) + ldsw + _i * 8192), 16, 0, 0); } while (0)
#define PG8_LDA(dst, b, h) do { _Pragma("unroll") for (int m = 0; m < 4; ++m) _Pragma("unroll") for (int k = 0; k < 2; ++k) dst[m][k] = *(const LAS bf16x8*)(lds + PG8_SA(b, h) + aoff + m * 2048 + k * 1024); } while (0)
#define PG8_LDB(dst, b, h) do { _Pragma("unroll") for (int n = 0; n < 2; ++n) _Pragma("unroll") for (int k = 0; k < 2; ++k) dst[n][k] = *(const LAS bf16x8*)(lds + PG8_SB(b, h) + boff + n * 2048 + k * 1024); } while (0)
#define PG8_MMA(ai, bj, At, Bt) do { __builtin_amdgcn_s_setprio(1); _Pragma("unroll") for (int m = 0; m < 4; ++m) _Pragma("unroll") for (int n = 0; n < 2; ++n) _Pragma("unroll") for (int k = 0; k < 2; ++k) \
        acc[ai][bj][m][n] = __builtin_amdgcn_mfma_f32_16x16x32_bf16(Bt[n][k], At[m][k], acc[ai][bj][m][n], 0, 0, 0); __builtin_amdgcn_s_setprio(0); } while (0)
#define PG8_WAIT_V(n) asm volatile("s_waitcnt vmcnt(" #n ")" ::: "memory")
#define PG8_WAIT_L(n) asm volatile("s_waitcnt lgkmcnt(" #n ")" ::: "memory")
#define PG8_BAR __builtin_amdgcn_s_barrier()
#define PG8_SCHED __builtin_amdgcn_sched_barrier(0)
    Unit cur, nxt; int ui = 0;
    if (!S.next(0, cur)) return;
    f32x4 acc[2][2][4][2];
    if constexpr (Epi::INIT) { int fr_ = fr, fq_ = fq, wr_ = wr, wc_ = wc; asm volatile("" : "+v"(fr_), "+v"(fq_), "+s"(wr_), "+s"(wc_)); E.init(acc, cur, wr_, wc_, fr_, fq_); }
    else {
#pragma unroll
    for (int a = 0; a < 2; ++a)
#pragma unroll
        for (int b = 0; b < 2; ++b)
#pragma unroll
            for (int m = 0; m < 4; ++m)
#pragma unroll
                for (int n = 0; n < 2; ++n) acc[a][b][m][n] = (f32x4){0.f, 0.f, 0.f, 0.f};
    }
    bf16x8 At[4][2], B0[2][2], B1[2][2];
    const char* cA = (const char*)g.A + (size_t)cur.pm * tstep; const char* cB = (const char*)g.Bt + (size_t)cur.pn * tstep;
    PG8_STAGE(PG8_SB(0, 0), cB, voffB); PG8_STAGE(PG8_SB(0, 1), cB + hstep, voffB); PG8_STAGE(PG8_SA(0, 0), cA, voffA); PG8_STAGE(PG8_SA(0, 1), cA + hstep, voffA);
    if (wr == 1) PG8_BAR;
    PG8_WAIT_V(2); PG8_BAR;
    PG8_STAGE(PG8_SB(1, 0), cB + kstep, voffB); PG8_STAGE(PG8_SA(1, 0), cA + kstep, voffA); PG8_STAGE(PG8_SB(1, 1), cB + hstep + kstep, voffB);
    PG8_WAIT_V(6); PG8_BAR;
    for (;;) {
        const bool has_next = S.next(ui + 1, nxt);
        const char* nA = has_next ? (const char*)g.A + (size_t)nxt.pm * tstep : cA; const char* nB = has_next ? (const char*)g.Bt + (size_t)nxt.pn * tstep : cB;
        for (int t = 0; t < nt; t += 2) {
            const bool last = (t == nt - 2);
            const char* a1 = cA + (size_t)(t + 1) * kstep;
            const char* a2 = last ? nA : cA + (size_t)(t + 2) * kstep; const char* b2 = last ? nB : cB + (size_t)(t + 2) * kstep;
            const char* a3 = a2 + kstep; const char* b3 = b2 + kstep;
            if constexpr (Epi::MIDK) { if (t == 8 || t == 16) { int fr_ = fr, fq_ = fq, wr_ = wr, wc_ = wc; asm volatile("" : "+v"(fr_), "+v"(fq_), "+s"(wr_), "+s"(wc_)); E.mid(acc, cur, t, wr_, wc_, fr_, fq_); } }
            PG8_LDB(B0, 0, 0); PG8_LDB(B1, 0, 1); PG8_SCHED; PG8_LDA(At, 0, 0); PG8_STAGE(PG8_SA(1, 1), a1 + hstep, voffA);
            PG8_WAIT_V(8); PG8_WAIT_L(0); PG8_BAR; PG8_MMA(0, 0, At, B0); PG8_MMA(0, 1, At, B1); PG8_BAR; PG8_SCHED;
            PG8_LDA(At, 0, 1); PG8_STAGE(PG8_SB(0, 0), b2, voffB); PG8_STAGE(PG8_SB(0, 1), b2 + hstep, voffB); PG8_STAGE(PG8_SA(0, 0), a2, voffA);
            PG8_WAIT_V(8); PG8_WAIT_L(0); PG8_BAR; PG8_MMA(1, 0, At, B0); PG8_MMA(1, 1, At, B1); PG8_BAR; PG8_SCHED;
            PG8_LDB(B0, 1, 0); PG8_LDB(B1, 1, 1); PG8_SCHED; PG8_LDA(At, 1, 0); PG8_STAGE(PG8_SA(0, 1), a2 + hstep, voffA);
            PG8_WAIT_V(8); PG8_WAIT_L(0); PG8_BAR; PG8_MMA(0, 0, At, B0); PG8_MMA(0, 1, At, B1); PG8_BAR; PG8_SCHED;
            PG8_LDA(At, 1, 1); PG8_STAGE(PG8_SB(1, 0), b3, voffB); PG8_STAGE(PG8_SB(1, 1), b3 + hstep, voffB); PG8_STAGE(PG8_SA(1, 0), a3, voffA);
            PG8_WAIT_V(8); PG8_WAIT_L(0); PG8_BAR; PG8_MMA(1, 0, At, B0); PG8_MMA(1, 1, At, B1); PG8_BAR; PG8_SCHED;
        }
        if constexpr (ALIGN_EPI) { if (wr == 0) PG8_BAR; }
        { int fr_ = fr, fq_ = fq, wr_ = wr, wc_ = wc; asm volatile("" : "+v"(fr_), "+v"(fq_), "+s"(wr_), "+s"(wc_)); E(acc, cur, wr_, wc_, fr_, fq_); }
        if (!has_next) break;
        if constexpr (Epi::INIT) { int fr_ = fr, fq_ = fq, wr_ = wr, wc_ = wc; asm volatile("" : "+v"(fr_), "+v"(fq_), "+s"(wr_), "+s"(wc_)); E.init(acc, nxt, wr_, wc_, fr_, fq_); }
        else {
#pragma unroll
        for (int a = 0; a < 2; ++a)
#pragma unroll
            for (int b = 0; b < 2; ++b)
#pragma unroll
                for (int m = 0; m < 4; ++m)
#pragma unroll
                    for (int n = 0; n < 2; ++n) acc[a][b][m][n] = (f32x4){0.f, 0.f, 0.f, 0.f};
        }
        cur = nxt; cA = nA; cB = nB; ++ui;
        if constexpr (ALIGN_EPI) { if (wr == 1) PG8_BAR; }
    }
    PG8_WAIT_V(0);
    if constexpr (!ALIGN_EPI) { if (wr == 0) PG8_BAR; }
    PG8_BAR;
#undef PG8_SA
#undef PG8_SB
#undef PG8_STAGE
#undef PG8_LDA
#undef PG8_LDB
#undef PG8_MMA
#undef PG8_WAIT_V
#undef PG8_WAIT_L
#undef PG8_BAR
#undef PG8_SCHED
}
}

#define XB_TMO      128
#define XB_XCNT(j)  (256  + 64 * (j))
#define XB_XSUB(j)  (1280 + 64 * (j))
#define XB_XGEN(j)  (2304 + 64 * (j))
#define XB_TOP      3328
#define XB_TOPGEN   3392
#define XCD_BAR_WORDS 3456
#define XB_SPIN_CAP (1u << 24)
DI unsigned xb_ld(unsigned* p)              { return __hip_atomic_load(p, __ATOMIC_RELAXED, __HIP_MEMORY_SCOPE_AGENT); }
DI unsigned xb_add(unsigned* p, unsigned v) { return __hip_atomic_fetch_add(p, v, __ATOMIC_RELAXED, __HIP_MEMORY_SCOPE_AGENT); }
DI unsigned xb_xcc_id() { return (unsigned)__builtin_amdgcn_s_getreg((3 << 11) | 20) & 0xFu; }
#define XB_SPIN(cond, bar) do { unsigned _sp = 0; while (cond) { __builtin_amdgcn_s_sleep(1); \
    if ((++_sp & 255u) == 0u) { if (xb_ld(&(bar)[XB_TMO])) break; if (_sp > XB_SPIN_CAP) { atomicAdd(&(bar)[XB_TMO], 1u); break; } } } } while (0)
struct XcdBarrier { unsigned* bar; unsigned x; volatile LAS unsigned* st; };
DI XcdBarrier xcd_barrier_post(unsigned* bar, volatile LAS unsigned* st) {
    XcdBarrier b; b.bar = bar; b.x = xb_xcc_id(); b.st = st;
    if (threadIdx.x == 0) (void)xb_add(&bar[XB_XCNT(b.x)], 1u);
    return b;
}
DI void xcd_barrier_complete(unsigned* bar, unsigned x, unsigned& nloc, unsigned& nx) {
    const unsigned G = gridDim.x * gridDim.y * gridDim.z;
    unsigned sum, cnt, mine, sp = 0u;
    for (;;) {
        sum = 0u; cnt = 0u; mine = 0u;
#pragma unroll
        for (unsigned j = 0; j < 16; ++j) { const unsigned c = xb_ld(&bar[XB_XCNT(j)]); sum += c; cnt += (c > 0u) ? 1u : 0u; mine = (j == x) ? c : mine; }
        if (sum == G) break;
        __builtin_amdgcn_s_sleep(1);
        if ((++sp & 255u) == 0u) { if (xb_ld(&bar[XB_TMO])) break; if (sp > XB_SPIN_CAP) { atomicAdd(&bar[XB_TMO], 1u); break; } }
    }
    nloc = mine > 0u ? mine : 1u; nx = cnt > 0u ? cnt : 1u;
}
DI void xcd_barrier(const XcdBarrier& b_in) {
    XcdBarrier b = b_in; { unsigned x_ = b.x; asm volatile("" : "+s"(x_)); b.x = x_; }
    asm volatile("s_waitcnt vmcnt(0)" ::: "memory");
    __syncthreads();
    if (threadIdx.x == 0) {
        unsigned* bar = b.bar;
        __builtin_amdgcn_s_waitcnt(0);
        unsigned nloc = b.st[0], nx = b.st[1];
        if (nloc == 0u) { xcd_barrier_complete(bar, b.x, nloc, nx); b.st[0] = nloc; b.st[1] = nx; }
        const unsigned old = xb_add(&bar[XB_XSUB(b.x)], 1u);
        const unsigned gen = old / nloc;
        if (old + 1u == (gen + 1u) * nloc) {
            __builtin_amdgcn_fence(__ATOMIC_RELEASE, "agent");
            asm volatile("s_waitcnt vmcnt(0)" ::: "memory");
            const unsigned og = xb_add(&bar[XB_TOP], 1u);
            const unsigned tg = og / nx;
            if (og + 1u == (tg + 1u) * nx) xb_add(&bar[XB_TOPGEN], 1u);
            else XB_SPIN(xb_ld(&bar[XB_TOPGEN]) == tg, bar);
            __builtin_amdgcn_fence(__ATOMIC_ACQUIRE, "agent");
            xb_add(&bar[XB_XGEN(b.x)], 1u);
            asm volatile("s_waitcnt vmcnt(0)" ::: "memory");
        } else {
            XB_SPIN(xb_ld(&bar[XB_XGEN(b.x)]) == gen, bar);
            __builtin_amdgcn_fence(__ATOMIC_ACQUIRE, "agent");
            asm volatile("s_waitcnt vmcnt(0)" ::: "memory");
        }
    }
    __syncthreads();
}

struct Args { const float* in[21]; float* out; unsigned char* ws; int it_lo, it_hi, ph_lo, ph_hi; };
enum { I_X = 0, I_NMG, I_WIN, I_BG, I_CW, I_CB, I_GB, I_MNG, I_KVNG, I_WKV, I_SQG, I_SKG, I_DQG, I_DKG, I_LAM, I_DOG, I_WBR, I_WOUT, I_NFG, I_WGU, I_WD };

struct Frame {
    LAS unsigned char* lds;
    unsigned char* ws;
    int tid, lane, wave, G, bid;
    int wave0;
    DI void refresh() {
        int l_; asm volatile("v_mbcnt_lo_u32_b32 %0, -1, 0\n\tv_mbcnt_hi_u32_b32 %0, -1, %0" : "=v"(l_));
        unsigned char* w_ = ws; int g_ = G, b_ = bid, wv_ = wave0; asm volatile("" : "+s"(w_), "+s"(g_), "+s"(b_), "+s"(wv_));
        ws = w_; G = g_; bid = b_; lane = l_; wave = wv_; tid = wv_ * 64 + l_; }
};

DI int map_in(int n) {
    const int pn = n >> 8, p = n & 255, bj = p >> 7, wcq = p & 127, wc = wcq >> 5, q = wcq & 31;
    const int hd = 32 * bj + q;
    switch (pn) {
        case 0: case 1: case 2: case 3: return Z_MQK + n;
        case 4: case 5: return Z_MV + (n - 4 * 256);
        case 6: case 7: return Z_MO + (n - 6 * 256);
        case 8: case 9: return Z_SQ + (4 * (pn - 8) + wc) * 64 + hd;
        case 10: return Z_CKV + p;
        case 11: return Z_IQ + wc * 64 + hd;
        case 12: case 13: return Z_DQ + (4 * (pn - 12) + wc) * 64 + hd;
        case 14: case 15: return Z_DK + (4 * (pn - 14) + wc) * 64 + hd;
        case 16: case 17: return Z_DV + (n - 16 * 256);
        default:
            if (wc == 0) return Z_IK + hd;
            if (wc == 1 && bj == 0) { if (q < 8) return Z_MIF + q; if (q < 12) return Z_IW + (q - 8); }
            return -1;
    }
}
DI int map_kv(int n) {
    const int pn = n >> 8, p = n & 255, bj = p >> 7, wcq = p & 127, wc = wcq >> 5, q = wcq & 31;
    if (pn < 2) return (4 * pn + wc) * 64 + 32 * bj + q;
    return n;
}
DI int map_gu(int n) {
    const int pn = n >> 8, p = n & 255;
    return (p >> 7) * FF + 128 * pn + (p & 127);
}
template <int MAP>
DI void transpose_item(const float* W, int ldw, int cbase, const float* kscale, bf16_t* WT, int ldo, int koff, int nblk, LAS float* scr, int item, int lane) {
    const int kb = item / nblk, nb = item % nblk, k0 = 64 * kb, n0 = 32 * nb;
    const int n = n0 + (lane & 31);
    int src;
    if (MAP == 0) src = n; else if (MAP == 1) src = map_in(n); else if (MAP == 2) src = map_kv(n); else src = map_gu(n);
    float tv_[32];
    const int srcc = src >= 0 ? src : 0;
#pragma unroll
    for (int i = 0; i < 32; ++i) tv_[i] = W[(size_t)(k0 + 2 * i + (lane >> 5)) * ldw + cbase + srcc];
#pragma unroll
    for (int i = 0; i < 32; ++i) { const int kk = 2 * i + (lane >> 5);
        float v = src >= 0 ? tv_[i] : 0.f;
        if (kscale) v *= kscale[k0 + kk];
        scr[kk * 33 + (lane & 31)] = v; }
    WSYNC();
    const int c = lane & 7;
#pragma unroll
    for (int j = 0; j < 4; ++j) { const int nn = (lane >> 3) + 8 * j; const LAS float* s = scr + (8 * c) * 33 + nn;
        u32x4 o; o.x = pk2(s[0 * 33], s[1 * 33]); o.y = pk2(s[2 * 33], s[3 * 33]); o.z = pk2(s[4 * 33], s[5 * 33]); o.w = pk2(s[6 * 33], s[7 * 33]);
        *(u32x4*)(WT + (size_t)(n0 + nn) * ldo + koff + k0 + 8 * c) = o; }
    WSYNC();
}
__device__ const float INVF[32] = {1.000000000e+00f, 7.498942018e-01f, 5.623413324e-01f, 4.216965139e-01f, 3.162277639e-01f, 2.371373922e-01f, 1.778279394e-01f, 1.333521456e-01f,
    1.000000015e-01f, 7.498941571e-02f, 5.623412877e-02f, 4.216964915e-02f, 3.162277862e-02f, 2.371373586e-02f, 1.778279431e-02f, 1.333521493e-02f,
    9.999999776e-03f, 7.498942316e-03f, 5.623413250e-03f, 4.216964822e-03f, 3.162277862e-03f, 2.371373819e-03f, 1.778279431e-03f, 1.333521446e-03f,
    1.000000047e-03f, 7.498941850e-04f, 5.623413017e-04f, 4.216965463e-04f, 3.162277862e-04f, 2.371373848e-04f, 1.778279402e-04f, 1.333521504e-04f};
DI void sincos_acc(float angf, float& c, float& s) {
    const double x = (double)angf;
    const double kd = __builtin_rint(x * 0.63661977236758134308);
    const double r = (x - kd * 1.5707963267948965580) - kd * 6.1232339957367658860e-17;
    const double r2 = r * r;
    double sp = -1.0 / 39916800.0; sp = sp * r2 + 1.0 / 362880.0; sp = sp * r2 - 1.0 / 5040.0; sp = sp * r2 + 1.0 / 120.0; sp = sp * r2 - 1.0 / 6.0; sp = sp * r2 + 1.0; sp *= r;
    double cp = 1.0 / 479001600.0; cp = cp * r2 - 1.0 / 3628800.0; cp = cp * r2 + 1.0 / 40320.0; cp = cp * r2 - 1.0 / 720.0; cp = cp * r2 + 1.0 / 24.0; cp = cp * r2 - 0.5; cp = cp * r2 + 1.0;
    const int k = (int)kd & 3;
    double cc, ss;
    if (k == 0) { cc = cp; ss = sp; } else if (k == 1) { cc = -sp; ss = cp; } else if (k == 2) { cc = -cp; ss = -sp; } else { cc = sp; ss = -cp; }
    c = (float)cc; s = (float)ss;
}
DI void phase_prologue(Frame& F, const Args& a) {
    F.refresh();
    LAS float* scr = (LAS float*)(F.lds + F.wave * 16384);
    const int gw = F.bid * NWAVES + F.wave, NGW = F.G * NWAVES;
    float* COS = (float*)(F.ws + WS_COS); float* SIN = (float*)(F.ws + WS_SIN);
    for (int i = gw * 64 + F.lane; i < SEQ * 32; i += NGW * 64) { const int t = i >> 5, f = i & 31; float c, s; sincos_acc((float)t * INVF[f], c, s); COS[i] = c; SIN[i] = s; }
    if (gw == 0) { float* GN = (float*)(F.ws + WS_GAIN);
        for (int l = 0; l < DEPTH; ++l) { GN[(l * 4 + 0) * 64 + F.lane] = a.in[I_SQG][l * 64 + F.lane]; GN[(l * 4 + 1) * 64 + F.lane] = a.in[I_DQG][l * 64 + F.lane];
            GN[(l * 4 + 2) * 64 + F.lane] = a.in[I_DKG][l * 64 + F.lane]; GN[(l * 4 + 3) * 64 + F.lane] = a.in[I_SKG][l * 64 + F.lane]; } }
    for (int l = 0; l < DEPTH; ++l) {
        unsigned char* wl = F.ws + WS_W + (size_t)l * W_LAYER;
        const float* w_in = a.in[I_WIN] + (size_t)l * DM * IN_COLS;
        { const int nblk = NT_IN * 256 / 32, nit = (DM / 64) * nblk;
          for (int it = gw; it < nit; it += NGW) transpose_item<1>(w_in, IN_COLS, 0, nullptr, (bf16_t*)(wl + WO_IN), DM, 0, nblk, scr, it, F.lane); }
        { const int nblk = 3072 / 32, nit = (DM / 64) * nblk;
          for (int it = gw; it < nit; it += NGW) transpose_item<0>(w_in, IN_COLS, Z_G, nullptr, (bf16_t*)(wl + WO_G), DM, 0, nblk, scr, it, F.lane); }
        { const int nblk = 1024 / 32, nit = (256 / 64) * nblk;
          for (int it = gw; it < nit; it += NGW) transpose_item<2>(a.in[I_WKV] + (size_t)l * 256 * 1024, 1024, 0, a.in[I_KVNG] + l * 256, (bf16_t*)(wl + WO_KV), 256, 0, nblk, scr, it, F.lane); }
        for (int b = 0; b < 3; ++b) { const int nblk = 1024 / 32, nit = (512 / 64) * nblk;
          for (int it = gw; it < nit; it += NGW) transpose_item<0>(a.in[I_WBR] + ((size_t)l * 3 + b) * 512 * 1024, 1024, 0, nullptr, (bf16_t*)(wl + WO_BR), 1536, b * 512, nblk, scr, it, F.lane); }
        { const int nblk = 1024 / 32, nit = (1024 / 64) * nblk;
          for (int it = gw; it < nit; it += NGW) transpose_item<0>(a.in[I_WOUT] + (size_t)l * 1024 * 1024, 1024, 0, nullptr, (bf16_t*)(wl + WO_OUT), 1024, 0, nblk, scr, it, F.lane); }
        { const int nblk = 5632 / 32, nit = (1024 / 64) * nblk;
          for (int it = gw; it < nit; it += NGW) transpose_item<3>(a.in[I_WGU] + (size_t)l * 1024 * 5632, 5632, 0, nullptr, (bf16_t*)(wl + WO_GU), 1024, 0, nblk, scr, it, F.lane); }
        { const int nblk = 1024 / 32, nit = (2816 / 64) * nblk;
          for (int it = gw; it < nit; it += NGW) transpose_item<0>(a.in[I_WD] + (size_t)l * 2816 * 1024, 1024, 0, nullptr, (bf16_t*)(wl + WO_D), 2816, 0, nblk, scr, it, F.lane); }
    }
}

DI void phase_rmsnorm(Frame& F, const void* xv, const bool src16, const float* gain, bf16_t* out) {
    F.refresh();
    const int gw = F.bid * NWAVES + F.wave, NGW = F.G * NWAVES;
    f32x4 gv[4];
#pragma unroll
    for (int j = 0; j < 4; ++j) gv[j] = *(const f32x4*)(gain + 4 * F.lane + 256 * j);
    for (int m = gw; m < MC; m += NGW) {
        f32x4 v[4]; float s = 0.f;
        if (src16) { const GAS u32x2* xr = (const GAS u32x2*)((const bf16_t*)xv + (size_t)m * DM) + F.lane;
#pragma unroll
            for (int j = 0; j < 4; ++j) { const u32x2 w = xr[64 * j]; v[j] = (f32x4){bflo(w.x), bfhi(w.x), bflo(w.y), bfhi(w.y)}; }
        } else { const GAS f32x4* xr = (const GAS f32x4*)((const float*)xv + (size_t)m * DM) + F.lane;
#pragma unroll
            for (int j = 0; j < 4; ++j) v[j] = xr[64 * j]; }
#pragma unroll
        for (int j = 0; j < 4; ++j) s += (v[j].x * v[j].x + v[j].y * v[j].y) + (v[j].z * v[j].z + v[j].w * v[j].w);
        const float r = 1.0f / sqrtf(wave_sum(s) * (1.f / DM) + EPS);
        u32x2* o8 = (u32x2*)(out + (size_t)m * DM) + F.lane;
#pragma unroll
        for (int j = 0; j < 4; ++j) { u32x2 w; w.x = cvtpk_(v[j].x * r * gv[j].x, v[j].y * r * gv[j].y); w.y = cvtpk_(v[j].z * r * gv[j].z, v[j].w * r * gv[j].w); o8[64 * j] = w; }
    }
}
DI float log_sigmoid(float x) {
    const float ax = fabsf(x), y = fexp(-ax);
    float l1p;
    if (y < 0.06f) l1p = y * (1.f - y * (0.5f - y * (0.33333333f - y * (0.25f - y * 0.2f))));
    else l1p = __builtin_amdgcn_logf(1.f + y) * 0.69314718056f;
    return fminf(x, 0.f) - l1p;
}
DI void phase_token(Frame& F, const Args& a, int l, const int probe) {
    F.refresh();
    const int gw0 = F.bid * NWAVES + F.wave, NGW = F.G * NWAVES, NSC = CB * 4, NCV = NGW - NSC;
    const bool scanw = (F.wave == NWAVES - 1) && (F.bid < NSC);
    const int gw = scanw ? NCV : gw0 - ((gw0 >> 3) < NSC ? (gw0 >> 3) : NSC);
    if (!scanw) { if (probe != 2) {
    const bf16_t* QKRAW = (const bf16_t*)(F.ws + WS_QKRAW); bf16_t* QK = (bf16_t*)(F.ws + WS_QK);
    const bf16_t* CKV = (const bf16_t*)(F.ws + WS_CKV); float* RT = (float*)(F.ws + WS_RT);
    const float* cw = a.in[I_CW] + (size_t)l * 4 * 1024; const float* cb = a.in[I_CB] + (size_t)l * 1024;
    const int c0 = F.lane * 16;
    float w[4][16], bs[16];
#pragma unroll
    for (int j = 0; j < 4; ++j)
#pragma unroll
        for (int i = 0; i < 16; ++i) w[j][i] = cw[j * 1024 + c0 + i];
#pragma unroll
    for (int i = 0; i < 16; ++i) bs[i] = cb[c0 + i];
    const float ksc = (c0 >= 512) ? 0.08838834764831845f : 1.0f;
    for (int m = gw; m < MC; m += NCV) {
        const int t = m & (SEQ - 1);
        float accv[16];
#pragma unroll
        for (int i = 0; i < 16; ++i) accv[i] = bs[i];
        u32x4 tv[4][2];
#pragma unroll
        for (int j = 0; j < 4; ++j) { const int tt = t - 3 + j; const u32x4* p = (const u32x4*)(QKRAW + (size_t)(tt >= 0 ? m - 3 + j : m) * 1024 + c0); tv[j][0] = p[0]; tv[j][1] = p[1]; }
        const u32x2 ckv4 = *(const u32x2*)(CKV + (size_t)m * 256 + 4 * F.lane);
#pragma unroll
        for (int j = 0; j < 4; ++j) { const float on = (t - 3 + j >= 0) ? 1.f : 0.f;
            const unsigned ww[8] = {tv[j][0].x, tv[j][0].y, tv[j][0].z, tv[j][0].w, tv[j][1].x, tv[j][1].y, tv[j][1].z, tv[j][1].w};
#pragma unroll
            for (int i = 0; i < 8; ++i) { accv[2 * i] += on * w[j][2 * i] * bflo(ww[i]); accv[2 * i + 1] += on * w[j][2 * i + 1] * bfhi(ww[i]); } }
        unsigned o[8];
#pragma unroll
        for (int i = 0; i < 8; ++i) { const float x0 = accv[2 * i], x1 = accv[2 * i + 1]; o[i] = pk2(x0 * sigmoidf_(x0) * ksc, x1 * sigmoidf_(x1) * ksc); }
        u32x4* q = (u32x4*)(QK + (size_t)m * 1024 + c0); q[0] = (u32x4){o[0], o[1], o[2], o[3]}; q[1] = (u32x4){o[4], o[5], o[6], o[7]};
        { const u32x2 v = ckv4; const float a0 = bflo(v.x), a1 = bfhi(v.x), a2 = bflo(v.y), a3 = bfhi(v.y);
          const float ss = wave_sum((a0 * a0 + a1 * a1) + (a2 * a2 + a3 * a3)); if (F.lane == 0) RT[m] = 1.0f / sqrtf(ss * (1.f / 256.f) + EPS); }
    }
    } } else if (probe != 1) {
        const int sq = F.bid, b = sq >> 2, h = sq & 3, lane = F.lane; const float* IFb = (const float*)(F.ws + WS_IF) + (size_t)b * SEQ * 8;
        float* AK = (float*)(F.ws + WS_AK) + (size_t)sq * SEQ; float* MQ = (float*)(F.ws + WS_MQ) + (size_t)sq * SEQ; float* EM = (float*)(F.ws + WS_EM) + (size_t)sq * SEQ;
        LAS float* X0 = (LAS float*)F.lds; LAS float* X1 = X0 + 4160; LAS float* X2 = X1 + 4160;
#pragma unroll 1
        for (int c = 0; c < 4; ++c) { float fv[16], iv[16];
#pragma unroll
            for (int kk = 0; kk < 16; ++kk) { const size_t t = (size_t)64 * (16 * c + kk) + lane; fv[kk] = *(const GAS float*)(IFb + t * 8 + 4 + h); iv[kk] = *(const GAS float*)(IFb + t * 8 + h); }
#pragma unroll
            for (int kk = 0; kk < 16; ++kk) { const int t = 64 * (16 * c + kk) + lane; X0[t + (t >> 6)] = fv[kk]; X1[t + (t >> 6)] = iv[kk]; } }
        WSYNC();
        const int tb = 65 * lane;
        double sum = 0.0;
#pragma unroll 8
        for (int j = 0; j < 64; ++j) { const float lf = log_sigmoid(X0[tb + j]); X0[tb + j] = lf; sum += (double)lf; }
        double inc = sum;
#pragma unroll
        for (int o = 1; o < 64; o <<= 1) { const double y = shup_d(inc, o, lane); if (lane >= o) inc += y; }
        double bb = inc - sum; float mx = -INFINITY;
#pragma unroll 8
        for (int j = 0; j < 64; ++j) { bb += (double)X0[tb + j]; const float av = (float)((double)X1[tb + j] - bb); X1[tb + j] = av; X0[tb + j] = (float)bb; mx = fmaxf(mx, av); }
        float minc = mx;
#pragma unroll
        for (int o = 1; o < 64; o <<= 1) { const float y = shup_f(minc, o, lane); if (lane >= o) minc = fmaxf(minc, y); }
        float mrun = shup_f(minc, 1, lane); if (lane == 0) mrun = -INFINITY;
#pragma unroll 8
        for (int j = 0; j < 64; ++j) { mrun = fmaxf(mrun, X1[tb + j]); X2[tb + j] = mrun; X0[tb + j] = fexp(-(X0[tb + j] + mrun)); }
        WSYNC();
#pragma unroll 8
        for (int k = 0; k < 64; ++k) { const int t = 64 * k + lane, ix = t + k; AK[t] = X1[ix]; MQ[t] = X2[ix]; EM[t] = X0[ix]; }
    }
}

DI void store8(bf16_t* p, f32x4 v0, f32x4 v1) { u32x4 w; w.x = cvtpk_(v0[0], v0[1]); w.y = cvtpk_(v0[2], v0[3]); w.z = cvtpk_(v1[0], v1[1]); w.w = cvtpk_(v1[2], v1[3]); *(u32x4*)p = w; }
DI void head_norm_rope(f32x4 (&x)[2][2], bool norm, const f32x4 (&gn)[2][2], const float* cosr, const float* sinr, int fq, float scale) {
    if (norm) {
        float ss = 0.f;
#pragma unroll
        for (int bj = 0; bj < 2; ++bj)
#pragma unroll
            for (int n = 0; n < 2; ++n) ss += (x[bj][n][0] * x[bj][n][0] + x[bj][n][1] * x[bj][n][1]) + (x[bj][n][2] * x[bj][n][2] + x[bj][n][3] * x[bj][n][3]);
        ss = sum16x(ss); ss = sum32x(ss);
        const float r = 1.0f / sqrtf(ss * (1.f / 64.f) + EPS);
#pragma unroll
        for (int bj = 0; bj < 2; ++bj)
#pragma unroll
            for (int n = 0; n < 2; ++n) x[bj][n] = x[bj][n] * r * gn[bj][n];
    }
#pragma unroll
    for (int n = 0; n < 2; ++n) { const f32x4 c = *(const f32x4*)(cosr + 8 * fq + 4 * n), s = *(const f32x4*)(sinr + 8 * fq + 4 * n);
        const f32x4 x1 = x[0][n], x2 = x[1][n]; x[0][n] = (x1 * c - x2 * s) * scale; x[1][n] = (x1 * s + x2 * c) * scale; }
}
DI void head_norm_rope_cs(f32x4 (&x)[2][2], bool norm, const f32x4 (&gn)[2][2], const f32x4 (&c)[2], const f32x4 (&sn)[2], float scale) {
    if (norm) {
        float ss = 0.f;
#pragma unroll
        for (int bj = 0; bj < 2; ++bj)
#pragma unroll
            for (int n = 0; n < 2; ++n) ss += (x[bj][n][0] * x[bj][n][0] + x[bj][n][1] * x[bj][n][1]) + (x[bj][n][2] * x[bj][n][2] + x[bj][n][3] * x[bj][n][3]);
        ss = sum16x(ss); ss = sum32x(ss);
        const float r = 1.0f / sqrtf(ss * (1.f / 64.f) + EPS);
#pragma unroll
        for (int bj = 0; bj < 2; ++bj)
#pragma unroll
            for (int n = 0; n < 2; ++n) x[bj][n] = x[bj][n] * r * gn[bj][n];
    }
#pragma unroll
    for (int n = 0; n < 2; ++n) { const f32x4 x1 = x[0][n], x2 = x[1][n]; x[0][n] = (x1 * c[n] - x2 * sn[n]) * scale; x[1][n] = (x1 * sn[n] + x2 * c[n]) * scale; }
}
struct EpiInProj {
    static constexpr bool PERM = true, MIDK = false, INIT = false;
    unsigned char* ws; const float* gate_b; int layer;
    DI void operator()(const f32x4 (&acc)[2][2][4][2], const pg8::Unit& u, int wr, int wc, int fr, int fq) const {
        const int pn = u.pn; const int rowb = u.pm * 256 + wr * 64 + fr;
        if (pn < 8 || pn == 10 || pn == 16 || pn == 17) {
            size_t doff; int ldc, cb; bool sg = false;
            if (pn < 4) { doff = WS_QKRAW; ldc = 1024; cb = pn * 256; }
            else if (pn < 6) { doff = WS_VM; ldc = 512; cb = (pn - 4) * 256; }
            else if (pn < 8) { doff = WS_OM; ldc = 512; cb = (pn - 6) * 256; sg = true; }
            else if (pn == 10) { doff = WS_CKV; ldc = 256; cb = 0; }
            else { doff = WS_DV; ldc = 512; cb = (pn - 16) * 256; }
            bf16_t* dst = (bf16_t*)(ws + doff);
#pragma unroll
            for (int ai = 0; ai < 2; ++ai)
#pragma unroll
                for (int m = 0; m < 4; ++m) { bf16_t* rowp = dst + (size_t)(rowb + ai * 128 + m * 16) * ldc + cb + wc * 32 + 8 * fq;
#pragma unroll
                    for (int bj = 0; bj < 2; ++bj) { f32x4 v0 = acc[ai][bj][m][0], v1 = acc[ai][bj][m][1];
                        if (sg) {
#pragma unroll
                            for (int j = 0; j < 4; ++j) { v0[j] = sigmoidf_(v0[j]); v1[j] = sigmoidf_(v1[j]); } }
                        store8(rowp + bj * 128, v0, v1); } }
        } else if (pn == 18) {
            const float* COS = (const float*)(ws + WS_COS); const float* SIN = (const float*)(ws + WS_SIN);
            if (wc == 0) {
                bf16_t* dst = (bf16_t*)(ws + WS_IK); f32x4 gn[2][2];
#pragma unroll
                for (int bj = 0; bj < 2; ++bj)
#pragma unroll
                    for (int n = 0; n < 2; ++n) gn[bj][n] = (f32x4){1.f, 1.f, 1.f, 1.f};
#pragma unroll
                for (int ai = 0; ai < 2; ++ai)
#pragma unroll
                    for (int m = 0; m < 4; ++m) { const int row = rowb + ai * 128 + m * 16, t = row & (SEQ - 1);
                        f32x4 x[2][2] = {{acc[ai][0][m][0], acc[ai][0][m][1]}, {acc[ai][1][m][0], acc[ai][1][m][1]}};
                        head_norm_rope(x, false, gn, COS + t * 32, SIN + t * 32, fq, 1.0f);
#pragma unroll
                        for (int bj = 0; bj < 2; ++bj) store8(dst + (size_t)row * 64 + 32 * bj + 8 * fq, x[bj][0], x[bj][1]);
                        asm volatile("" ::: "memory"); }
            } else if (wc == 1) {
                float* IFp = (float*)(ws + WS_IF); float* IWp = (float*)(ws + WS_IW);
#pragma unroll
                for (int ai = 0; ai < 2; ++ai)
#pragma unroll
                    for (int m = 0; m < 4; ++m) { const int row = rowb + ai * 128 + m * 16;
                        if (fq == 0) { *(f32x4*)(IFp + (size_t)row * 8) = acc[ai][0][m][0] + *(const f32x4*)gate_b; *(f32x4*)(IFp + (size_t)row * 8 + 4) = acc[ai][0][m][1] + *(const f32x4*)(gate_b + 4); }
                        else if (fq == 1) { *(f32x4*)(IWp + (size_t)row * 4) = acc[ai][0][m][0] * 0.0625f; } }
            }
        } else {
            const float* COS = (const float*)(ws + WS_COS); const float* SIN = (const float*)(ws + WS_SIN);
            size_t doff; int gi, pn0; float scale; bool norm = true; int ldc = 512;
            if (pn < 10) { doff = WS_SQ; gi = 0; pn0 = 8; scale = C2; }
            else if (pn == 11) { doff = WS_IQ; gi = 0; pn0 = 11; scale = 1.f; norm = false; ldc = 256; }
            else if (pn < 14) { doff = WS_DQ; gi = 1; pn0 = 12; scale = C2; }
            else { doff = WS_DK; gi = 2; pn0 = 14; scale = 1.f; }
            bf16_t* dst = (bf16_t*)(ws + doff); const float* g = (const float*)(ws + WS_GAIN) + (layer * 4 + gi) * 64;
            f32x4 gn[2][2];
#pragma unroll
            for (int bj = 0; bj < 2; ++bj)
#pragma unroll
                for (int n = 0; n < 2; ++n) gn[bj][n] = *(const f32x4*)(g + 32 * bj + 8 * fq + 4 * n);
            const int head = 4 * (pn - pn0) + wc;
#pragma unroll
            for (int ai = 0; ai < 2; ++ai)
#pragma unroll
              for (int mp = 0; mp < 4; mp += 2) {
                f32x4 cc[2][2], sn[2][2];
#pragma unroll
                for (int m = 0; m < 2; ++m) { const int t = (rowb + ai * 128 + (mp + m) * 16) & (SEQ - 1);
#pragma unroll
                    for (int n = 0; n < 2; ++n) { cc[m][n] = *(const GAS f32x4*)(COS + t * 32 + 8 * fq + 4 * n); sn[m][n] = *(const GAS f32x4*)(SIN + t * 32 + 8 * fq + 4 * n); } }
#pragma unroll
                for (int m = 0; m < 2; ++m) { const int row = rowb + ai * 128 + (mp + m) * 16;
                    f32x4 x[2][2] = {{acc[ai][0][mp + m][0], acc[ai][0][mp + m][1]}, {acc[ai][1][mp + m][0], acc[ai][1][mp + m][1]}};
                    head_norm_rope_cs(x, norm, gn, cc[m], sn[m], scale);
#pragma unroll
                    for (int bj = 0; bj < 2; ++bj) store8(dst + (size_t)row * ldc + head * 64 + 32 * bj + 8 * fq, x[bj][0], x[bj][1]); }
                asm volatile("" ::: "memory");
              }
        }
    }
};
struct EpiKV {
    static constexpr bool PERM = true, MIDK = false, INIT = false;
    unsigned char* ws; int layer;
    DI void operator()(const f32x4 (&acc)[2][2][4][2], const pg8::Unit& u, int wr, int wc, int fr, int fq) const {
        const int pn = u.pn; const int rowb = u.pm * 256 + wr * 64 + fr; const float* RT = (const float*)(ws + WS_RT);
        if (pn >= 2) {
            bf16_t* dst = (bf16_t*)(ws + WS_SV);
#pragma unroll
            for (int ai = 0; ai < 2; ++ai)
#pragma unroll
                for (int m = 0; m < 4; ++m) { const int row = rowb + ai * 128 + m * 16; const float r = RT[row]; bf16_t* rowp = dst + (size_t)row * 512 + (pn - 2) * 256 + wc * 32 + 8 * fq;
#pragma unroll
                    for (int bj = 0; bj < 2; ++bj) store8(rowp + bj * 128, acc[ai][bj][m][0] * r, acc[ai][bj][m][1] * r); }
        } else {
            const float* COS = (const float*)(ws + WS_COS); const float* SIN = (const float*)(ws + WS_SIN);
            bf16_t* dst = (bf16_t*)(ws + WS_SK); f32x4 gn[2][2];
#pragma unroll
            for (int bj = 0; bj < 2; ++bj)
#pragma unroll
                for (int n = 0; n < 2; ++n) gn[bj][n] = *(const f32x4*)((const float*)(ws + WS_GAIN) + (layer * 4 + 3) * 64 + 32 * bj + 8 * fq + 4 * n);
            const int head = 4 * pn + wc;
#pragma unroll
            for (int ai = 0; ai < 2; ++ai)
#pragma unroll
              for (int mp = 0; mp < 4; mp += 2) {
                f32x4 cc[2][2], sn[2][2]; float rr[2];
#pragma unroll
                for (int m = 0; m < 2; ++m) { const int row = rowb + ai * 128 + (mp + m) * 16, t = row & (SEQ - 1); rr[m] = *(const GAS float*)(RT + row);
#pragma unroll
                    for (int n = 0; n < 2; ++n) { cc[m][n] = *(const GAS f32x4*)(COS + t * 32 + 8 * fq + 4 * n); sn[m][n] = *(const GAS f32x4*)(SIN + t * 32 + 8 * fq + 4 * n); } }
#pragma unroll
                for (int m = 0; m < 2; ++m) { const int row = rowb + ai * 128 + (mp + m) * 16; const float r = rr[m];
                    f32x4 x[2][2] = {{acc[ai][0][mp + m][0] * r, acc[ai][0][mp + m][1] * r}, {acc[ai][1][mp + m][0] * r, acc[ai][1][mp + m][1] * r}};
                    head_norm_rope_cs(x, true, gn, cc[m], sn[m], 1.0f);
#pragma unroll
                    for (int bj = 0; bj < 2; ++bj) store8(dst + (size_t)row * 512 + head * 64 + 32 * bj + 8 * fq, x[bj][0], x[bj][1]); }
                asm volatile("" ::: "memory");
              }
        }
    }
};
DI size_t gq_off(int pm, int png, int wave, int am, int lane) { return ((((size_t)pm * 12 + png) * 8 + wave) * 8 + am) * 1024 + (size_t)lane * 16; }
struct EpiGate {
    static constexpr bool PERM = true, MIDK = false, INIT = false;
    unsigned char* G; const float* bias;
    DI void operator()(const f32x4 (&acc)[2][2][4][2], const pg8::Unit& u, int wr, int wc, int fr, int fq) const {
        const int col0 = u.pn * 256 + wc * 32 + 8 * fq, wave = wr * 4 + wc, lane = fq * 16 + fr;
        f32x4 bv[2][2];
#pragma unroll
        for (int bj = 0; bj < 2; ++bj)
#pragma unroll
            for (int n = 0; n < 2; ++n) bv[bj][n] = *(const f32x4*)(bias + col0 + bj * 128 + 4 * n);
#pragma unroll
        for (int ai = 0; ai < 2; ++ai)
#pragma unroll
            for (int m = 0; m < 4; ++m) { unsigned w[4];
#pragma unroll
                for (int bj = 0; bj < 2; ++bj)
#pragma unroll
                    for (int n = 0; n < 2; ++n) { const f32x4 v = acc[ai][bj][m][n] + bv[bj][n]; unsigned q = 0u;
#pragma unroll
                        for (int j = 0; j < 4; ++j) q = __builtin_amdgcn_cvt_pk_u8_f32(sigmoidf_(v[j]) * 255.0f, j, q);
                        w[2 * bj + n] = q; }
                *(u32x4*)(G + gq_off(u.pm, u.pn, wave, ai * 4 + m, lane)) = (u32x4){w[0], w[1], w[2], w[3]}; }
    }
};
struct EpiMerge {
    static constexpr bool PERM = true, MIDK = true, INIT = false;
    const unsigned char* G; bf16_t* MG;
    DI static float ub(unsigned w, int k) { return (float)((w >> (8 * k)) & 0xFFu); }
    DI void mid(f32x4 (&acc)[2][2][4][2], const pg8::Unit& u, int t, int wr, int wc, int fr, int fq) const {
        const int seg = (t >> 3) - 1, wave = wr * 4 + wc, lane = fq * 16 + fr;
#pragma unroll
        for (int ai = 0; ai < 2; ++ai) {
            u32x4 ga[4], gb[4];
#pragma unroll
            for (int m = 0; m < 4; ++m) { ga[m] = *(const GAS u32x4*)(G + gq_off(u.pm, seg * 4 + u.pn, wave, ai * 4 + m, lane)); gb[m] = *(const GAS u32x4*)(G + gq_off(u.pm, (seg + 1) * 4 + u.pn, wave, ai * 4 + m, lane)); }
#pragma unroll
            for (int m = 0; m < 4; ++m) { const unsigned aw[4] = {ga[m].x, ga[m].y, ga[m].z, ga[m].w}, bw[4] = {gb[m].x, gb[m].y, gb[m].z, gb[m].w};
#pragma unroll
                for (int bj = 0; bj < 2; ++bj)
#pragma unroll
                    for (int n = 0; n < 2; ++n)
#pragma unroll
                        for (int j = 0; j < 4; ++j) acc[ai][bj][m][n][j] *= fmaxf(ub(aw[2 * bj + n], j), 1e-6f) * frcp(fmaxf(ub(bw[2 * bj + n], j), 1e-6f)); }
            asm volatile("" ::: "memory");
        }
    }
    DI void operator()(const f32x4 (&acc)[2][2][4][2], const pg8::Unit& u, int wr, int wc, int fr, int fq) const {
        const int rowb = u.pm * 256 + wr * 64 + fr, col0 = u.pn * 256 + wc * 32 + 8 * fq, wave = wr * 4 + wc, lane = fq * 16 + fr;
#pragma unroll
        for (int ai = 0; ai < 2; ++ai) {
            u32x4 gc[4];
#pragma unroll
            for (int m = 0; m < 4; ++m) gc[m] = *(const GAS u32x4*)(G + gq_off(u.pm, 8 + u.pn, wave, ai * 4 + m, lane));
#pragma unroll
            for (int m = 0; m < 4; ++m) { const unsigned cw[4] = {gc[m].x, gc[m].y, gc[m].z, gc[m].w};
#pragma unroll
                for (int bj = 0; bj < 2; ++bj) { f32x4 v0 = acc[ai][bj][m][0], v1 = acc[ai][bj][m][1];
#pragma unroll
                    for (int j = 0; j < 4; ++j) { v0[j] *= fmaxf(ub(cw[2 * bj], j), 1e-6f) * (1.0f / 255.0f); v1[j] *= fmaxf(ub(cw[2 * bj + 1], j), 1e-6f) * (1.0f / 255.0f); }
                    store8(MG + (size_t)(rowb + ai * 128 + m * 16) * 1024 + col0 + bj * 128, v0, v1); } }
            asm volatile("" ::: "memory");
        }
    }
};
struct EpiResid {
    static constexpr bool PERM = true, MIDK = false, INIT = true;
    const void* base; void* out; bool in16, out16;
    DI void init(f32x4 (&acc)[2][2][4][2], const pg8::Unit& u, int wr, int wc, int fr, int fq) const {
        const int rowb = u.pm * 256 + wr * 64 + fr, col0 = u.pn * 256 + wc * 32 + 8 * fq;
#pragma unroll
        for (int ai = 0; ai < 2; ++ai)
#pragma unroll
            for (int m = 0; m < 4; ++m) { const size_t off = (size_t)(rowb + ai * 128 + m * 16) * DM + col0;
#pragma unroll
                for (int bj = 0; bj < 2; ++bj) {
                    if (in16) { const u32x4 w = *(const GAS u32x4*)((const bf16_t*)base + off + bj * 128);
                        acc[ai][bj][m][0] = (f32x4){bflo(w.x), bfhi(w.x), bflo(w.y), bfhi(w.y)}; acc[ai][bj][m][1] = (f32x4){bflo(w.z), bfhi(w.z), bflo(w.w), bfhi(w.w)}; }
                    else { acc[ai][bj][m][0] = *(const GAS f32x4*)((const float*)base + off + bj * 128); acc[ai][bj][m][1] = *(const GAS f32x4*)((const float*)base + off + bj * 128 + 4); } } }
    }
    DI void operator()(const f32x4 (&acc)[2][2][4][2], const pg8::Unit& u, int wr, int wc, int fr, int fq) const {
        const int rowb = u.pm * 256 + wr * 64 + fr, col0 = u.pn * 256 + wc * 32 + 8 * fq;
#pragma unroll
        for (int ai = 0; ai < 2; ++ai)
#pragma unroll
            for (int m = 0; m < 4; ++m) { const size_t off = (size_t)(rowb + ai * 128 + m * 16) * DM + col0;
#pragma unroll
                for (int bj = 0; bj < 2; ++bj) {
                    if (out16) store8((bf16_t*)out + off + bj * 128, acc[ai][bj][m][0], acc[ai][bj][m][1]);
                    else { *(f32x4*)((float*)out + off + bj * 128) = acc[ai][bj][m][0]; *(f32x4*)((float*)out + off + bj * 128 + 4) = acc[ai][bj][m][1]; } } }
    }
};
struct EpiSwiGLU {
    static constexpr bool PERM = true, MIDK = false, INIT = false;
    bf16_t* H;
    DI void operator()(const f32x4 (&acc)[2][2][4][2], const pg8::Unit& u, int wr, int wc, int fr, int fq) const {
        const int rowb = u.pm * 256 + wr * 64 + fr, col0 = u.pn * 128 + wc * 32 + 8 * fq;
#pragma unroll
        for (int ai = 0; ai < 2; ++ai)
#pragma unroll
            for (int m = 0; m < 4; ++m) { f32x4 v0, v1;
#pragma unroll
                for (int j = 0; j < 4; ++j) { const float g0 = acc[ai][0][m][0][j], g1 = acc[ai][0][m][1][j]; v0[j] = g0 * sigmoidf_(g0) * acc[ai][1][m][0][j]; v1[j] = g1 * sigmoidf_(g1) * acc[ai][1][m][1][j]; }
                store8(H + (size_t)(rowb + ai * 128 + m * 16) * FF + col0, v0, v1); }
    }
};

DI unsigned mono_key(float f) { const unsigned u = __float_as_uint(f + 0.0f); return u ^ ((unsigned)((int)u >> 31) | 0x80000000u); }
DI unsigned pack_mask(unsigned long long bm, int h) {
    unsigned r = 0;
#pragma unroll
    for (int p = 0; p < 2; ++p)
#pragma unroll
        for (int g = 0; g < 4; ++g) r |= (unsigned)((bm >> (32 * p + 8 * g + 4 * h)) & 0xFull) << (16 * p + 4 * g);
    return r;
}
DI unsigned long long unpack_mask(unsigned w0, unsigned w1) {
    unsigned long long bm = 0;
#pragma unroll
    for (int p = 0; p < 2; ++p)
#pragma unroll
        for (int g = 0; g < 4; ++g) { bm |= (unsigned long long)((w0 >> (16 * p + 4 * g)) & 0xFu) << (32 * p + 8 * g); bm |= (unsigned long long)((w1 >> (16 * p + 4 * g)) & 0xFu) << (32 * p + 8 * g + 4); }
    return bm;
}
DI void ld8f(const bf16_t* p, float (&g)[8]) { const u32x4 w = *(const u32x4*)p; g[0] = bflo(w.x); g[1] = bfhi(w.x); g[2] = bflo(w.y); g[3] = bfhi(w.y); g[4] = bflo(w.z); g[5] = bfhi(w.z); g[6] = bflo(w.w); g[7] = bfhi(w.w); }

DI void naive_select(Frame& F) {
    F.refresh();
    if (F.wave >= 4) return;
    const int gw = F.bid * 4 + F.wave, NGW = F.G * 4;
    LAS unsigned char* wl = F.lds + F.wave * 20480;
    LAS float* sc = (LAS float*)wl; LAS float* iqf = (LAS float*)(wl + 16384); LAS unsigned* hist = (LAS unsigned*)(wl + 16384 + 1024);
    const bf16_t* IQ = (const bf16_t*)(F.ws + WS_IQ); const bf16_t* IK = (const bf16_t*)(F.ws + WS_IK); const float* IW = (const float*)(F.ws + WS_IW);
    unsigned* MASK = (unsigned*)(F.ws + WS_MASK);
    const int lane = F.lane;
    for (int row = gw; row < MC; row += NGW) {
        const int b = row >> 12, t = row & (SEQ - 1), n = t + 1;
        { const u32x2 v = *(const u32x2*)(IQ + (size_t)row * 256 + 4 * lane); iqf[4 * lane] = bflo(v.x); iqf[4 * lane + 1] = bfhi(v.x); iqf[4 * lane + 2] = bflo(v.y); iqf[4 * lane + 3] = bfhi(v.y); }
        const f32x4 wv = *(const f32x4*)(IW + (size_t)row * 4);
        WSYNC();
        for (int s = lane; s < n; s += 64) {
            const bf16_t* kr = IK + ((size_t)b * SEQ + s) * 64;
            float d0 = 0.f, d1 = 0.f, d2 = 0.f, d3 = 0.f;
#pragma unroll
            for (int c = 0; c < 8; ++c) { float kv[8]; ld8f(kr + 8 * c, kv);
#pragma unroll
                for (int j = 0; j < 8; ++j) { const float k = kv[j]; d0 += iqf[8 * c + j] * k; d1 += iqf[64 + 8 * c + j] * k; d2 += iqf[128 + 8 * c + j] * k; d3 += iqf[192 + 8 * c + j] * k; } }
            sc[s] = wv[0] * fmaxf(d0, 0.f) + wv[1] * fmaxf(d1, 0.f) + wv[2] * fmaxf(d2, 0.f) + wv[3] * fmaxf(d3, 0.f);
        }
        WSYNC();
        unsigned thr = 0u; int need = 256;
        if (n > 256) {
            unsigned prefix = 0u, pmask = 0u;
            for (int pass = 0; pass < 4; ++pass) {
                const int shift = 24 - 8 * pass;
                { unsigned z_ = 0u; asm volatile("" : "+v"(z_)); hist[lane] = z_; hist[lane + 64] = z_; hist[lane + 128] = z_; hist[lane + 192] = z_; }
                WSYNC();
                for (int s = lane; s < n; s += 64) { const unsigned key = mono_key(sc[s]); if ((key & pmask) == prefix) __hip_atomic_fetch_add(&hist[(key >> shift) & 255u], 1u, __ATOMIC_RELAXED, __HIP_MEMORY_SCOPE_WORKGROUP); }
                WSYNC();
                const unsigned c0 = hist[4 * lane], c1 = hist[4 * lane + 1], c2 = hist[4 * lane + 2], c3 = hist[4 * lane + 3];
                const unsigned ls = c0 + c1 + c2 + c3; unsigned inc = ls;
#pragma unroll
                for (int o = 1; o < 64; o <<= 1) { const unsigned y = __shfl_up(inc, o); if (lane >= o) inc += y; }
                const unsigned total = __shfl(inc, 63);
                unsigned cum = total - inc;
                int fbin = -1; unsigned fneed = 0u;
                const unsigned cc[4] = {c0, c1, c2, c3};
#pragma unroll
                for (int bq = 3; bq >= 0; --bq) { if (fbin < 0 && cum < (unsigned)need && cum + cc[bq] >= (unsigned)need) { fbin = 4 * lane + bq; fneed = (unsigned)need - cum; } cum += cc[bq]; }
                const unsigned long long fm = __ballot(fbin >= 0);
                const int src = __ffsll((long long)fm) - 1;
                const int bin = __shfl(fbin, src); need = (int)__shfl(fneed, src);
                prefix |= (unsigned)bin << shift; pmask |= 0xFFu << shift;
                WSYNC();
            }
            thr = prefix;
        }
        int eqc = 0;
        for (int i = 0; i < 64; ++i) {
            const int s = 64 * i + lane; bool sel = false;
            if (64 * i < n) {
                const bool valid = s < n;
                if (n <= 256) sel = valid;
                else { const unsigned key = valid ? mono_key(sc[s]) : 0u; const bool eq = valid && key == thr; const unsigned long long em = __ballot(eq);
                    const int rank = eqc + __popcll(em & ((1ull << lane) - 1ull)); sel = valid && (key > thr || (eq && rank < need)); eqc += __popcll(em); }
            }
            const unsigned long long bm = __ballot(sel);
            if (lane == 0) { MASK[((size_t)row * 2 + 0) * 64 + i] = pack_mask(bm, 0); MASK[((size_t)row * 2 + 1) * 64 + i] = pack_mask(bm, 1); }
        }
        WSYNC();
    }
}
DI void naive_dsa(Frame& F) {
    F.refresh();
    if (F.wave >= 4) return;
    const int gw = F.bid * 4 + F.wave, NGW = F.G * 4;
    LAS unsigned char* wl = F.lds + F.wave * 20480;
    LAS float* sc = (LAS float*)wl;
    LAS float* sqf = (LAS float*)(wl + 8192);
    LAS unsigned* list = (LAS unsigned*)(wl + 8192 + 2048);
    LAS float* invs = (LAS float*)(wl + 8192 + 2048 + 2048);
    const bf16_t* SQ = (const bf16_t*)(F.ws + WS_SQ); const bf16_t* SK = (const bf16_t*)(F.ws + WS_SK); const bf16_t* SV = (const bf16_t*)(F.ws + WS_SV);
    const unsigned* MASK = (const unsigned*)(F.ws + WS_MASK); bf16_t* Y = (bf16_t*)(F.ws + WS_Y);
    const int lane = F.lane;
    for (int row = gw; row < MC; row += NGW) {
        const int b = row >> 12, t = row & (SEQ - 1);
        { float q[8]; ld8f(SQ + (size_t)row * 512 + 8 * lane, q);
#pragma unroll
          for (int j = 0; j < 8; ++j) sqf[8 * lane + j] = q[j]; }
        int nsel = 0;
        for (int i = 0; i <= (t >> 6); ++i) {
            const unsigned w0 = MASK[((size_t)row * 2 + 0) * 64 + i], w1 = MASK[((size_t)row * 2 + 1) * 64 + i];
            const unsigned long long bm = unpack_mask(w0, w1);
            const bool sel = (bm >> lane) & 1ull;
            const int pos = nsel + __popcll(bm & ((1ull << lane) - 1ull));
            if (sel && pos < 256) list[pos] = (unsigned)(64 * i + lane);
            nsel += __popcll(bm);
        }
        if (nsel > 256) nsel = 256;
        WSYNC();
        for (int k = lane; k < nsel; k += 64) {
            const bf16_t* kr = SK + ((size_t)b * SEQ + list[k]) * 512;
#pragma unroll 1
            for (int h = 0; h < 8; ++h) { float d = 0.f;
#pragma unroll
                for (int c = 0; c < 8; ++c) { float kv[8]; ld8f(kr + h * 64 + 8 * c, kv);
#pragma unroll
                    for (int j = 0; j < 8; ++j) d += sqf[h * 64 + 8 * c + j] * kv[j]; }
                sc[h * 256 + k] = d; }
        }
        WSYNC();
#pragma unroll 1
        for (int h = 0; h < 8; ++h) {
            float mx = -INFINITY; for (int k = lane; k < nsel; k += 64) mx = fmaxf(mx, sc[h * 256 + k]);
            mx = wave_max(mx); float sum = 0.f;
            for (int k = lane; k < nsel; k += 64) { const float p = fexp2(sc[h * 256 + k] - mx); sc[h * 256 + k] = p; sum += p; }
            sum = wave_sum(sum); if (lane == 0) invs[h] = 1.0f / sum;
        }
        WSYNC();
        { const int h = lane >> 3, d0 = (lane & 7) * 8; float accv[8] = {0.f, 0.f, 0.f, 0.f, 0.f, 0.f, 0.f, 0.f};
          for (int k = 0; k < nsel; ++k) { const float p = sc[h * 256 + k]; float v[8]; ld8f(SV + ((size_t)b * SEQ + list[k]) * 512 + h * 64 + d0, v);
#pragma unroll
              for (int j = 0; j < 8; ++j) accv[j] += p * v[j]; }
          const float inv = invs[h];
          u32x4 o; o.x = pk2(accv[0] * inv, accv[1] * inv); o.y = pk2(accv[2] * inv, accv[3] * inv); o.z = pk2(accv[4] * inv, accv[5] * inv); o.w = pk2(accv[6] * inv, accv[7] * inv);
          *(u32x4*)(Y + (size_t)row * 1536 + 512 + h * 64 + d0) = o; }
        WSYNC();
    }
}
DI void naive_mlstm(Frame& F, const Args& a, int l) {
    F.refresh();
    const int gw = F.bid * NWAVES + F.wave, NGW = F.G * NWAVES;
    LAS unsigned char* wl = F.lds + F.wave * 16384;
    LAS float* pl = (LAS float*)wl;
    const bf16_t* QK = (const bf16_t*)(F.ws + WS_QK); const bf16_t* VM = (const bf16_t*)(F.ws + WS_VM); const bf16_t* OM = (const bf16_t*)(F.ws + WS_OM);
    const float* AK = (const float*)(F.ws + WS_AK); const float* MQ = (const float*)(F.ws + WS_MQ); const float* EM = (const float*)(F.ws + WS_EM);
    bf16_t* Y = (bf16_t*)(F.ws + WS_Y); const float* mng = a.in[I_MNG] + (size_t)l * 512;
    const int lane = F.lane;
    for (int qi = gw; qi < MC * 4; qi += NGW) {
        const int row = qi >> 2, h = qi & 3, b = row >> 12, t = row & (SEQ - 1), seq = b * 4 + h;
        const unsigned qw = *(const unsigned*)(QK + (size_t)row * 1024 + h * 128 + 2 * lane);
        const float q0 = bflo(qw), q1 = bfhi(qw);
        const float Mt = MQ[(size_t)seq * SEQ + t];
        float denp = 0.f;
        for (int s0 = 0; s0 <= t; s0 += 64) {
            const int s = s0 + lane; const bool valid = s <= t; const int sr = valid ? s : t;
            const bf16_t* kr = QK + ((size_t)b * SEQ + sr) * 1024 + 512 + h * 128;
            float d = 0.f;
#pragma unroll 4
            for (int c = 0; c < 16; ++c) { float kv[8]; ld8f(kr + 8 * c, kv);
#pragma unroll
                for (int j = 0; j < 4; ++j) { d += __shfl(q0, 4 * c + j) * kv[2 * j] + __shfl(q1, 4 * c + j) * kv[2 * j + 1]; } }
            const float p = valid ? d * fexp(AK[(size_t)seq * SEQ + sr] - Mt) : 0.f;
            pl[s] = p;
            denp += p;
        }
        const float den = wave_sum(denp);
        WSYNC();
        float a0 = 0.f, a1 = 0.f;
        for (int s = 0; s <= t; ++s) { const float p = pl[s]; const unsigned vw = *(const unsigned*)(VM + ((size_t)b * SEQ + s) * 512 + h * 128 + 2 * lane); a0 += p * bflo(vw); a1 += p * bfhi(vw); }
        const float hd = fmaxf(fabsf(den), EM[(size_t)seq * SEQ + t]);
        a0 /= hd; a1 /= hd;
        const float ss = wave_sum(a0 * a0 + a1 * a1); const float r = 1.0f / sqrtf(ss * (1.f / 128.f) + EPS);
        const unsigned ow = *(const unsigned*)(OM + (size_t)row * 512 + h * 128 + 2 * lane);
        const float y0 = a0 * r * mng[h * 128 + 2 * lane] * bflo(ow), y1 = a1 * r * mng[h * 128 + 2 * lane + 1] * bfhi(ow);
        *(unsigned*)(Y + (size_t)row * 1536 + h * 128 + 2 * lane) = pk2(y0, y1);
        WSYNC();
    }
}
DI void naive_diff(Frame& F, const Args& a, int l) {
    F.refresh();
    if (F.wave >= 4) return;
    const int gw = F.bid * 4 + F.wave, NGW = F.G * 4;
    LAS unsigned char* wl = F.lds + F.wave * 32768;
    LAS float* p0 = (LAS float*)wl; LAS float* p1 = (LAS float*)(wl + 16384);
    const bf16_t* DQ = (const bf16_t*)(F.ws + WS_DQ); const bf16_t* DK = (const bf16_t*)(F.ws + WS_DK); const bf16_t* DV = (const bf16_t*)(F.ws + WS_DV);
    bf16_t* Y = (bf16_t*)(F.ws + WS_Y); const float* dog = a.in[I_DOG] + (size_t)l * 128; const float* lam = a.in[I_LAM] + (size_t)l * 256;
    const int lane = F.lane;
    const float lam_init = (l == 0) ? 0.2f : 0.35550906759096934f;
    const float s01 = wave_sum(lam[lane] * lam[64 + lane]), s23 = wave_sum(lam[128 + lane] * lam[192 + lane]);
    const float lam_val = fexp(s01) - fexp(s23) + lam_init;
    for (int qi = gw; qi < MC * 4; qi += NGW) {
        const int row = qi >> 2, h = qi & 3, b = row >> 12, t = row & (SEQ - 1);
        const float qa = bf2f(DQ[(size_t)row * 512 + (2 * h) * 64 + lane]), qb = bf2f(DQ[(size_t)row * 512 + (2 * h + 1) * 64 + lane]);
        float mx0 = -INFINITY, mx1 = -INFINITY;
        for (int s0 = 0; s0 <= t; s0 += 64) {
            const int s = s0 + lane; const bool valid = s <= t; const int sr = valid ? s : t;
            const bf16_t* kr = DK + ((size_t)b * SEQ + sr) * 512 + (2 * h) * 64;
            float d0 = 0.f, d1 = 0.f;
#pragma unroll 4
            for (int c = 0; c < 8; ++c) { float ka[8], kb[8]; ld8f(kr + 8 * c, ka); ld8f(kr + 64 + 8 * c, kb);
#pragma unroll
                for (int j = 0; j < 8; ++j) { d0 += __shfl(qa, 8 * c + j) * ka[j]; d1 += __shfl(qb, 8 * c + j) * kb[j]; } }
            if (valid) { p0[s] = d0; p1[s] = d1; mx0 = fmaxf(mx0, d0); mx1 = fmaxf(mx1, d1); }
        }
        mx0 = wave_max(mx0); mx1 = wave_max(mx1);
        WSYNC();
        float sm0 = 0.f, sm1 = 0.f;
        for (int s = lane; s <= t; s += 64) { const float e0 = fexp2(p0[s] - mx0), e1 = fexp2(p1[s] - mx1); p0[s] = e0; p1[s] = e1; sm0 += e0; sm1 += e1; }
        const float i0 = 1.0f / wave_sum(sm0), i1 = lam_val / wave_sum(sm1);
        WSYNC();
        float a0 = 0.f, a1 = 0.f;
        for (int s = 0; s <= t; ++s) { const float av = p0[s] * i0 - p1[s] * i1; const unsigned vw = *(const unsigned*)(DV + ((size_t)b * SEQ + s) * 512 + h * 128 + 2 * lane); a0 += av * bflo(vw); a1 += av * bfhi(vw); }
        const float ss = wave_sum(a0 * a0 + a1 * a1); const float r = 1.0f / sqrtf(ss * (1.f / 128.f) + EPS) * (1.0f - lam_init);
        *(unsigned*)(Y + (size_t)row * 1536 + 1024 + h * 128 + 2 * lane) = pk2(a0 * r * dog[2 * lane], a1 * r * dog[2 * lane + 1]);
        WSYNC();
    }
}

typedef float f32x16 __attribute__((ext_vector_type(16)));
typedef short s16x4 __attribute__((ext_vector_type(4)));
typedef __bf16 bf16x2_t __attribute__((ext_vector_type(2)));
DI unsigned cvtpk(float lo, float hi) { f32x2 v = {lo, hi}; bf16x2_t b = __builtin_convertvector(v, bf16x2_t); return __builtin_bit_cast(unsigned, b); }
#define MFMA32(a, b, c) __builtin_amdgcn_mfma_f32_32x32x16_bf16((a), (b), (c), 0, 0, 0)
DI s16x4 trread(LAS const unsigned char* p) { return __builtin_bit_cast(s16x4, __builtin_amdgcn_ds_read_tr16_b64_v4i16((LAS s16x4*)p)); }
#ifndef MIXMODES
#define MIXMODES 7
#endif
constexpr int CW_QUEUE = 8192;
constexpr int ATT_WSF_OFF = RING_BYTES + 1024;
constexpr float NEGBIG = -1.0e30f;
constexpr float RESC_THR = 16.0f;

DI float max3f(float a, float b, float c) { float r_; asm("v_max3_f32 %0, %1, %2, %3" : "=v"(r_) : "v"(a), "v"(b), "v"(c)); return r_; }
template <int MODE>
DI void attn_qk(f32x16& s0, f32x16& s1, const bf16x8 (&qf)[MODE == 2 ? 8 : 4], LAS const unsigned char* kb, int koff, int j, int q0w, int r, int h, unsigned mw, const bool DIAG) {
    constexpr int KW = MODE == 0 ? 64 : 128, DQK = MODE == 2 ? 128 : 64, DV = MODE == 0 ? 64 : 128, KROWB = KW * 2 + 16, VROWB = MODE == 0 ? 192 : 320, KBYTES = 64 * KROWB, VBYTES = 64 * VROWB;
    constexpr int NKS = DQK / 16, NVB = DV / 32;
    (void)KBYTES; (void)VBYTES; (void)NVB;
    if (MODE == 0) {
        const unsigned nmw = ~mw;
#pragma unroll
        for (int i = 0; i < 16; ++i) { s0[i] = __uint_as_float((unsigned)((int)(nmw << (31 - i)) >> 31) & 0xF149F2CAu); s1[i] = __uint_as_float((unsigned)((int)(nmw << (15 - i)) >> 31) & 0xF149F2CAu); }
    } else if (MODE == 1 && DIAG) {
        const int qd = q0w + r - 64 * j;
#pragma unroll
        for (int i = 0; i < 16; ++i) { const int kk = (i & 3) + 8 * (i >> 2) + 4 * h; s0[i] = kk > qd ? NEGBIG : 0.f; s1[i] = kk + 32 > qd ? NEGBIG : 0.f; }
    } else {
#pragma unroll
        for (int i = 0; i < 16; ++i) { s0[i] = 0.f; s1[i] = 0.f; }
    }
#pragma unroll
    for (int s = 0; s < NKS; ++s) {
        const bf16x8 k0 = *(LAS const bf16x8*)(kb + koff + 32 * s);
        const bf16x8 k1 = *(LAS const bf16x8*)(kb + koff + 32 * KROWB + 32 * s);
        s0 = MFMA32(k0, qf[s], s0); s1 = MFMA32(k1, qf[s], s1);
    }
}
template <int MODE>
DI void attn_pv(f32x16 (&o)[MODE == 0 ? 2 : 4], float& lsum, float& mref, f32x16& s0, f32x16& s1, LAS const unsigned char* vb, int voff,
                int j, int q0w, int r, int h, float M2, LAS float* wsf, const bool DIAG, const int probe) {
    constexpr int DV = MODE == 0 ? 64 : 128, VROWB = MODE == 0 ? 192 : 320, VBYTES = 64 * VROWB;
    constexpr int NVB = DV / 32;
    LAS const unsigned char* ab = vb + VBYTES;
    if (MODE == 2) {
        float part = 0.f;
        if (DIAG) {
            const int qd = q0w + r - 64 * j;
#pragma unroll
            for (int g = 0; g < 4; ++g) {
                const f32x4 a0 = *(LAS const f32x4*)(ab + (8 * g + 4 * h) * 4), a1 = *(LAS const f32x4*)(ab + (32 + 8 * g + 4 * h) * 4);
#pragma unroll
                for (int e = 0; e < 4; ++e) { const int i = 4 * g + e, kk = 8 * g + 4 * h + e;
                    float w0 = fexp2(a0[e] - M2), w1 = fexp2(a1[e] - M2);
                    if (kk > qd) w0 = 0.f; if (kk + 32 > qd) w1 = 0.f;
                    s0[i] *= w0; s1[i] *= w1; part += s0[i] + s1[i]; }
            }
        } else {
#pragma unroll
            for (int g = 0; g < 4; ++g) {
                const f32x4 a0 = *(LAS const f32x4*)(ab + (8 * g + 4 * h) * 4), a1 = *(LAS const f32x4*)(ab + (32 + 8 * g + 4 * h) * 4);
#pragma unroll
                for (int e = 0; e < 4; ++e) { const int i = 4 * g + e;
                    s0[i] *= fexp2(a0[e] - M2); s1[i] *= fexp2(a1[e] - M2); part += s0[i] + s1[i]; }
            }
        }
        lsum += part;
    } else {
        if (probe != 2) {
        asm volatile("s_nop 15\n\ts_nop 7" : "+v"(s0), "+v"(s1));
        float ta = max3f(s0[0], s0[1], s1[0]), tb = max3f(s0[2], s0[3], s1[1]); ta = max3f(ta, s1[2], s1[3]);
#pragma unroll
        for (int i = 4; i < 16; i += 4) { ta = max3f(ta, s0[i], s0[i + 1]); tb = max3f(tb, s0[i + 2], s0[i + 3]); ta = max3f(ta, s1[i], s1[i + 1]); tb = max3f(tb, s1[i + 2], s1[i + 3]); }
        float tm = max3f(ta, tb, tb); tm = max32x(tm);
        if (__any(tm > mref + RESC_THR)) {
            const float nm = tm > mref + RESC_THR ? tm : mref, al = fexp2(mref - nm);
            mref = nm; lsum *= al;
            if (h == 0) wsf[r] = al;
            WSYNC();
#pragma unroll
            for (int g = 0; g < 4; ++g) { const f32x4 av = *(LAS const f32x4*)(wsf + 8 * g + 4 * h);
#pragma unroll
                for (int v = 0; v < NVB; ++v)
#pragma unroll
                    for (int e = 0; e < 4; ++e) o[v][4 * g + e] *= av[e]; }
            WSYNC();
        }
        if (__any(mref != 0.f)) {
#pragma unroll
            for (int i = 0; i < 16; ++i) { s0[i] -= mref; s1[i] -= mref; }
        }
        float part = 0.f;
#pragma unroll
        for (int i = 0; i < 16; ++i) { s0[i] = fexp2(s0[i]); s1[i] = fexp2(s1[i]); part += s0[i] + s1[i]; }
        lsum += part;
        }
    }
    bf16x8 pf[2][2];
#pragma unroll
    for (int s2 = 0; s2 < 2; ++s2) {
        u32x4 t0, t1;
        t0.x = cvtpk(s0[8 * s2 + 0], s0[8 * s2 + 1]); t0.y = cvtpk(s0[8 * s2 + 2], s0[8 * s2 + 3]); t0.z = cvtpk(s0[8 * s2 + 4], s0[8 * s2 + 5]); t0.w = cvtpk(s0[8 * s2 + 6], s0[8 * s2 + 7]);
        t1.x = cvtpk(s1[8 * s2 + 0], s1[8 * s2 + 1]); t1.y = cvtpk(s1[8 * s2 + 2], s1[8 * s2 + 3]); t1.z = cvtpk(s1[8 * s2 + 4], s1[8 * s2 + 5]); t1.w = cvtpk(s1[8 * s2 + 6], s1[8 * s2 + 7]);
        pf[0][s2] = __builtin_bit_cast(bf16x8, t0); pf[1][s2] = __builtin_bit_cast(bf16x8, t1);
    }
    if (probe != 3)
#pragma unroll
    for (int v = 0; v < NVB; ++v)
#pragma unroll
        for (int p = 0; p < 2; ++p)
#pragma unroll
            for (int s2 = 0; s2 < 2; ++s2) {
                const s16x4 lo = trread(vb + voff + (32 * p + 16 * s2) * VROWB + 64 * v), hi = trread(vb + voff + (32 * p + 16 * s2 + 8) * VROWB + 64 * v);
                const bf16x8 vf = (bf16x8){lo[0], lo[1], lo[2], lo[3], hi[0], hi[1], hi[2], hi[3]};
                o[v] = MFMA32(pf[p][s2], vf, o[v]);
            }
}

template <int MODE>
DI void attn_tile(f32x16 (&o)[MODE == 0 ? 2 : 4], float& lsum, float& mref, const bf16x8 (&qf)[MODE == 2 ? 8 : 4], LAS const unsigned char* kb, int koff, int voff,
                  int j, int q0w, int r, int h, unsigned mw, float M2, LAS float* wsf, const bool DIAG, const int probe) {
    constexpr int KW = MODE == 0 ? 64 : 128, KROWB = KW * 2 + 16, KBYTES = 64 * KROWB;
    f32x16 s0, s1;
    attn_qk<MODE>(s0, s1, qf, kb, koff, j, q0w, r, h, mw, DIAG);
    attn_pv<MODE>(o, lsum, mref, s0, s1, kb + KBYTES, voff, j, q0w, r, h, M2, wsf, DIAG, probe);
}
template <int MODE>
DI void attn_unit(Frame& F, const Args& a, int l, int b, int head, int qb, float lam_val, float lam_init) {
    constexpr int KW = MODE == 0 ? 64 : 128, DQK = MODE == 2 ? 128 : 64, NCOMP = 1, NPASS = 1, DV = MODE == 0 ? 64 : 128;
    constexpr int KROWB = KW * 2 + 16, VROWB = MODE == 0 ? 192 : 320;
    constexpr int KBYTES = 64 * KROWB, VBYTES = 64 * VROWB, STAGE = KBYTES + VBYTES + 256;
    constexpr int NKS = DQK / 16, NVB = DV / 32, KCH = KW / 64, VCH = DV / 64;
    static_assert(2 * STAGE <= 98304, "tile buffers");
    F.refresh();
    const int probe = ((volatile LAS int*)(F.lds + MISC_OFF + 96))[2];
    const int tid = F.tid, lane = F.lane, w = F.wave, r = lane & 31, h = lane >> 5;
    const bf16_t* Qp; const bf16_t* Kp; const bf16_t* Vp; int ldq, ldk;
    if (MODE == 0) { Qp = (const bf16_t*)(F.ws + WS_SQ) + head * 64; Kp = (const bf16_t*)(F.ws + WS_SK) + head * 64; Vp = (const bf16_t*)(F.ws + WS_SV) + head * 64; ldq = 512; ldk = 512; }
    else if (MODE == 1) { Qp = (const bf16_t*)(F.ws + WS_DQ) + head * 128; Kp = (const bf16_t*)(F.ws + WS_DK) + head * 128; Vp = (const bf16_t*)(F.ws + WS_DV) + head * 128; ldq = 512; ldk = 512; }
    else { Qp = (const bf16_t*)(F.ws + WS_QK) + head * 128; Kp = (const bf16_t*)(F.ws + WS_QK) + 512 + head * 128; Vp = (const bf16_t*)(F.ws + WS_VM) + head * 128; ldq = 1024; ldk = 1024; }
    const size_t rowb = (size_t)b * SEQ;
    const int comp = MODE == 1 ? (w >> 2) : 0;
    const int q0w = MODE == 1 ? qb * 128 + (w & 3) * 32 : qb * 256 + w * 32;
    const int seq = b * 4 + head;
    LAS float* wsf = (LAS float*)(F.lds + ATT_WSF_OFF + w * 256);
    f32x16 o[NCOMP][NVB];
    float lsum[NCOMP], mref[NCOMP];
    const int i16 = lane & 15, vq = i16 >> 2, vp = i16 & 3, vcs = (lane >> 4) & 1;
    const int voff = (4 * h + vq) * VROWB + (16 * vcs + 4 * vp) * 2;
    const int koff = r * KROWB + 16 * h;
    const int NT = MODE == 2 ? 4 : (MODE == 1 ? 2 * (qb + 1) : 4 * (qb + 1)), JB = MODE == 2 ? 4 * qb : 0;
#pragma unroll 1
    for (int pass = 0; pass < NPASS; ++pass) {
    bf16x8 qf[NCOMP][NKS];
#pragma unroll
    for (int c = 0; c < NCOMP; ++c)
#pragma unroll
        for (int s = 0; s < NKS; ++s) qf[c][s] = *(const GAS bf16x8*)(Qp + (rowb + q0w + r) * ldq + comp * 64 + 16 * s + 8 * h);
#pragma unroll
    for (int c = 0; c < NCOMP; ++c)
#pragma unroll
        for (int v = 0; v < NVB; ++v)
#pragma unroll
            for (int i = 0; i < 16; ++i) o[c][v][i] = 0.f;
#pragma unroll
    for (int c = 0; c < NCOMP; ++c) { lsum[c] = 0.f; mref[c] = 0.f; }
    float M2 = 0.f;
    if (MODE == 2) M2 = ((const float*)(F.ws + WS_MQ))[(size_t)seq * SEQ + q0w + r] * LOG2E;
    const unsigned* mrow = (const unsigned*)(F.ws + WS_MASK) + ((rowb + q0w + r) * 2 + h) * 64;
    const int srow = tid >> 3, sch = tid & 7;
    const bf16_t* kg = Kp + (rowb + srow) * ldk + sch * 8; const bf16_t* vg = Vp + (rowb + srow) * 512 + sch * 8;
    const float* ag = (const float*)(F.ws + WS_AK) + (size_t)seq * SEQ;
    u32x4 kreg[KCH], vreg[VCH]; float areg = 0.f; unsigned mw = 0u; u32x4 mw4 = (u32x4){0u, 0u, 0u, 0u}, mw4n = (u32x4){0u, 0u, 0u, 0u};
#define ST_LOAD(j) do { _Pragma("unroll") for (int c_ = 0; c_ < KCH; ++c_) kreg[c_] = *(const GAS u32x4*)(kg + (size_t)(j) * 64 * ldk + c_ * 64); \
        _Pragma("unroll") for (int c_ = 0; c_ < VCH; ++c_) vreg[c_] = *(const GAS u32x4*)(vg + (size_t)(j) * 64 * 512 + c_ * 64); \
        if (MODE == 2) { if (tid < 64) areg = *(const GAS float*)(ag + (j) * 64 + tid); } \
        asm volatile("" ::: "memory"); } while (0)
#define ST_WRITE(buf) do { LAS unsigned char* sb_ = F.lds + (buf) * STAGE; \
        _Pragma("unroll") for (int c_ = 0; c_ < KCH; ++c_) *(LAS u32x4*)(sb_ + srow * KROWB + (sch + 8 * c_) * 16) = kreg[c_]; \
        _Pragma("unroll") for (int c_ = 0; c_ < VCH; ++c_) *(LAS u32x4*)(sb_ + KBYTES + srow * VROWB + (sch + 8 * c_) * 16) = vreg[c_]; \
        if (MODE == 2) { if (tid < 64) *(LAS float*)(sb_ + KBYTES + VBYTES + tid * 4) = areg * LOG2E; } } while (0)
    if (MODE == 0) mw4n = *(const GAS u32x4*)(mrow + JB);
    ST_LOAD(JB); ST_WRITE(0);
    __syncthreads();
    for (int j = JB; j < JB + NT; ++j) {
        const int cur = j & 1;
        if (MODE == 0) {
            if ((j & 3) == 0) { mw4 = mw4n; if (j + 4 < JB + NT) mw4n = *(const GAS u32x4*)(mrow + j + 4); }
            mw = (j & 3) == 0 ? mw4.x : ((j & 3) == 1 ? mw4.y : ((j & 3) == 2 ? mw4.z : mw4.w));
        }
        if (j + 1 < JB + NT && (probe == 0 || probe == 2 || probe == 3)) ST_LOAD(j + 1);
        if (64 * j <= q0w + 31) {
            LAS const unsigned char* kb = F.lds + cur * STAGE;
            attn_tile<MODE>(o[0], lsum[0], mref[0], qf[0], kb, koff + comp * 128, voff, j, q0w, r, h, mw, M2, wsf, 64 * j + 63 > q0w, probe);
        }
        if (probe != 4) { if (j + 1 < JB + NT) ST_WRITE(cur ^ 1);
        __syncthreads(); }
    }
#undef ST_LOAD
#undef ST_WRITE
    }
    if (MODE == 2) { if (qb > 0) {
        const float Mp2 = ((const float*)(F.ws + WS_MQ))[(size_t)seq * SEQ + 256 * qb - 1] * LOG2E;
        const float M2s = ((const float*)(F.ws + WS_MQ))[(size_t)seq * SEQ + q0w + r] * LOG2E;
        const float g = fexp2(Mp2 - M2s);
        const float* NSn = (const float*)(F.ws + WS_MN + 128 * 1024) + ((size_t)seq * 16 + qb) * 128;
        const bf16_t* Cn = (const bf16_t*)(F.ws + WS_MC) + ((size_t)seq * 16 + qb) * 16384;
        bf16x8 qs[8]; float dpart = 0.f;
#pragma unroll
        for (int s = 0; s < 8; ++s) {
            const bf16x8 qv = *(const GAS bf16x8*)(Qp + (rowb + q0w + r) * ldq + 16 * s + 8 * h);
            const u32x4 qw = __builtin_bit_cast(u32x4, qv);
            const f32x4 n0 = *(const GAS f32x4*)(NSn + 16 * s + 8 * h), n1 = *(const GAS f32x4*)(NSn + 16 * s + 8 * h + 4);
            const float q0 = bflo(qw.x), q1 = bfhi(qw.x), q2 = bflo(qw.y), q3 = bfhi(qw.y), q4 = bflo(qw.z), q5 = bfhi(qw.z), q6 = bflo(qw.w), q7 = bfhi(qw.w);
            dpart += (q0 * n0[0] + q1 * n0[1]) + (q2 * n0[2] + q3 * n0[3]) + (q4 * n1[0] + q5 * n1[1]) + (q6 * n1[2] + q7 * n1[3]);
            u32x4 t; t.x = cvtpk(q0 * g, q1 * g); t.y = cvtpk(q2 * g, q3 * g); t.z = cvtpk(q4 * g, q5 * g); t.w = cvtpk(q6 * g, q7 * g);
            qs[s] = __builtin_bit_cast(bf16x8, t);
        }
        lsum[0] += g * dpart;
#pragma unroll
        for (int v = 0; v < NVB; ++v) {
            bf16x8 cf[8];
#pragma unroll
            for (int s = 0; s < 8; ++s) cf[s] = *(const GAS bf16x8*)(Cn + (size_t)(32 * v + r) * 128 + 16 * s + 8 * h);
#pragma unroll
            for (int s = 0; s < 8; ++s) o[0][v] = MFMA32(qs[s], cf[s], o[0][v]);
        }
    } }
    float sc0; const float sc1 = 0.f;
    if (MODE == 1) { lam_val = ((volatile LAS float*)(F.lds + MISC_OFF + 96))[0]; lam_init = ((volatile LAS float*)(F.lds + MISC_OFF + 96))[1]; }
    { float lt = sum32x(lsum[0]);
      if (MODE == 2) sc0 = frcp(fmaxf(fabsf(lt), ((const float*)(F.ws + WS_EM))[(size_t)seq * SEQ + q0w + r]));
      else if (MODE == 1) sc0 = (comp ? lam_val : 1.0f) * frcp(lt);
      else sc0 = frcp(lt); }
    if (h == 0) { wsf[r] = sc0; wsf[32 + r] = sc1; }
    WSYNC();
    LAS float* stg = (LAS float*)(F.lds + w * 16384);
#pragma unroll
    for (int g = 0; g < 4; ++g) {
        const f32x4 av = *(LAS const f32x4*)(wsf + 8 * g + 4 * h);
#pragma unroll
        for (int e = 0; e < 4; ++e) { const int i = 4 * g + e, row = 8 * g + 4 * h + e;
#pragma unroll
            for (int v = 0; v < NVB; ++v) { float val = o[0][v][i] * av[e]; stg[row * DV + 32 * v + r] = val; } }
    }
    WSYNC();
    if (MODE == 1) __syncthreads();
    if (MODE != 1 || comp == 0) {
        const int q = lane >> 1, hf = lane & 1; constexpr int HC = DV / 2;
        LAS float* srow_ = stg + q * DV + hf * HC;
        if (MODE == 1) {
            LAS const float* prow_ = (LAS const float*)(F.lds + (w + 4) * 16384) + q * DV + hf * HC;
#pragma unroll
            for (int c4 = 0; c4 < HC / 4; ++c4) *(LAS f32x4*)(srow_ + 4 * c4) = *(LAS const f32x4*)(srow_ + 4 * c4) - *(LAS const f32x4*)(prow_ + 4 * c4);
        }
        size_t grow = rowb + q0w + q;
        bf16_t* Y = (bf16_t*)(F.ws + (probe ? WS_MD : WS_Y)); if (probe) grow &= 4095;
        if (MODE == 0) {
            bf16_t* yp = Y + grow * 1536 + 512 + head * 64 + hf * HC;
#pragma unroll
            for (int c8 = 0; c8 < HC / 8; ++c8) { const f32x4 x0 = *(LAS const f32x4*)(srow_ + 8 * c8), x1 = *(LAS const f32x4*)(srow_ + 8 * c8 + 4);
                u32x4 ov; ov.x = cvtpk(x0[0], x0[1]); ov.y = cvtpk(x0[2], x0[3]); ov.z = cvtpk(x1[0], x1[1]); ov.w = cvtpk(x1[2], x1[3]); *(u32x4*)(yp + 8 * c8) = ov; }
        } else {
            float ss = 0.f;
#pragma unroll
            for (int c4 = 0; c4 < HC / 4; ++c4) { const f32x4 x = *(LAS const f32x4*)(srow_ + 4 * c4); ss += (x[0] * x[0] + x[1] * x[1]) + (x[2] * x[2] + x[3] * x[3]); }
            ss += xor1(ss);
            float rs = 1.0f / sqrtf(ss * (1.f / 128.f) + EPS);
            const float* gain; bf16_t* yp; const bf16_t* gatep = nullptr;
            if (MODE == 1) { rs *= (1.0f - lam_init); gain = a.in[I_DOG] + (size_t)l * 128 + hf * HC; yp = Y + grow * 1536 + 1024 + head * 128 + hf * HC; }
            else { gain = a.in[I_MNG] + (size_t)l * 512 + head * 128 + hf * HC; yp = Y + grow * 1536 + head * 128 + hf * HC; gatep = (const bf16_t*)(F.ws + WS_OM) + grow * 512 + head * 128 + hf * HC; }
#pragma unroll
            for (int c8 = 0; c8 < HC / 8; ++c8) {
                f32x4 x0 = *(LAS const f32x4*)(srow_ + 8 * c8), x1 = *(LAS const f32x4*)(srow_ + 8 * c8 + 4);
                const f32x4 g0 = *(const f32x4*)(gain + 8 * c8), g1 = *(const f32x4*)(gain + 8 * c8 + 4);
                x0 = x0 * rs * g0; x1 = x1 * rs * g1;
                if (MODE == 2) { float gt[8]; ld8f(gatep + 8 * c8, gt);
#pragma unroll
                    for (int e = 0; e < 4; ++e) { x0[e] *= gt[e]; x1[e] *= gt[4 + e]; } }
                u32x4 ov; ov.x = cvtpk(x0[0], x0[1]); ov.y = cvtpk(x0[2], x0[3]); ov.z = cvtpk(x1[0], x1[1]); ov.w = cvtpk(x1[2], x1[3]); *(u32x4*)(yp + 8 * c8) = ov;
            }
        }
    }
    __syncthreads();
}
DI void phase_mixers(Frame& F, const Args& a, int l, int it, int modes, int probe) {
    F.refresh();
    const float* lam = a.in[I_LAM] + (size_t)l * 256;
    const float lam_init = (l == 0) ? 0.2f : 0.35550906759096934f;
    const float s01 = wave_sum(lam[F.lane] * lam[64 + F.lane]), s23 = wave_sum(lam[128 + F.lane] * lam[192 + F.lane]);
    { const float lv = fexp(s01) - fexp(s23) + lam_init; if (F.tid == 0) { ((volatile LAS int*)(F.lds + MISC_OFF + 96))[2] = probe; ((volatile LAS float*)(F.lds + MISC_OFF + 96))[0] = lv; ((volatile LAS float*)(F.lds + MISC_OFF + 96))[1] = lam_init; } }
    const float lam_val = 0.f;
    unsigned* qhead = (unsigned*)(F.ws + WS_CTL) + CW_QUEUE + it * 64;
    volatile LAS unsigned* slot = (volatile LAS unsigned*)(F.lds + MISC_OFF + 64);
    for (;;) {
        if (F.tid == 0) *slot = __hip_atomic_fetch_add(qhead, 1u, __ATOMIC_RELAXED, __HIP_MEMORY_SCOPE_AGENT);
        __syncthreads();
        const int u = __builtin_amdgcn_readfirstlane((int)*slot);
        __syncthreads();
        if (u >= 1280) break;
        if (u < 1024) { const int p_ = u >> 6, k = u & 63;
            if (k < 16) { if (modes & MIXMODES & 2) attn_unit<1>(F, a, l, k >> 2, k & 3, 31 - 2 * p_, lam_val, lam_init); }
            else if (k < 48) { if (modes & MIXMODES & 1) attn_unit<0>(F, a, l, (k - 16) >> 3, (k - 16) & 7, 15 - p_, lam_val, lam_init); }
            else { if (modes & MIXMODES & 2) attn_unit<1>(F, a, l, (k - 48) >> 2, (k - 48) & 3, 30 - 2 * p_, lam_val, lam_init); }
        } else { const int m_ = u - 1024; if (modes & MIXMODES & 4) attn_unit<2>(F, a, l, (m_ >> 2) & 3, m_ & 3, 15 - (m_ >> 4), lam_val, lam_init); }
    }
}

DI void mlstm_state_unit(Frame& F, int sq, int n) {
    F.refresh();
    constexpr int KROWB = 272, VROWB = 320, KBYTES = 64 * KROWB, VBYTES = 64 * VROWB;
    const int tid = F.tid, lane = F.lane, w = F.wave, r = lane & 31, h = lane >> 5, b = sq >> 2, head = sq & 3;
    const size_t rowb = (size_t)b * SEQ;
    const bf16_t* Kp = (const bf16_t*)(F.ws + WS_QK) + 512 + head * 128; const bf16_t* Vp = (const bf16_t*)(F.ws + WS_VM) + head * 128;
    const float* ag = (const float*)(F.ws + WS_AK) + (size_t)sq * SEQ;
    const float Mend = ((const float*)(F.ws + WS_MQ))[(size_t)sq * SEQ + 256 * n + 255];
    f32x16 acc[2];
#pragma unroll
    for (int c = 0; c < 2; ++c)
#pragma unroll
        for (int i = 0; i < 16; ++i) acc[c][i] = 0.f;
    const int dvb = w >> 1, dkb0 = 2 * (w & 1);
    const int srow = tid >> 3, sch = tid & 7;
    const int i16 = lane & 15, vq = i16 >> 2, vp = i16 & 3, vcs = (lane >> 4) & 1;
    const int toffV = (4 * h + vq) * VROWB + (16 * vcs + 4 * vp) * 2, toffK = (4 * h + vq) * KROWB + (16 * vcs + 4 * vp) * 2;
    LAS unsigned char* kb = F.lds; LAS unsigned char* vb = kb + KBYTES; LAS float* wts = (LAS float*)(vb + VBYTES);
    float nacc = 0.f; const int ndk = tid & 127, npart = tid >> 7;
    for (int jt = 0; jt < 4; ++jt) {
        const int j = 4 * n + jt;
        const float wr_ = fexp(*(const GAS float*)(ag + 64 * j + srow) - Mend);
        u32x4 kreg[2], vreg[2];
#pragma unroll
        for (int c = 0; c < 2; ++c) { kreg[c] = *(const GAS u32x4*)(Kp + (rowb + 64 * j + srow) * 1024 + (sch + 8 * c) * 8); vreg[c] = *(const GAS u32x4*)(Vp + (rowb + 64 * j + srow) * 512 + (sch + 8 * c) * 8); }
#pragma unroll
        for (int c = 0; c < 2; ++c) { u32x4 t = vreg[c];
            t.x = cvtpk(bflo(t.x) * wr_, bfhi(t.x) * wr_); t.y = cvtpk(bflo(t.y) * wr_, bfhi(t.y) * wr_); t.z = cvtpk(bflo(t.z) * wr_, bfhi(t.z) * wr_); t.w = cvtpk(bflo(t.w) * wr_, bfhi(t.w) * wr_); vreg[c] = t; }
        __syncthreads();
#pragma unroll
        for (int c = 0; c < 2; ++c) { *(LAS u32x4*)(kb + srow * KROWB + (sch + 8 * c) * 16) = kreg[c]; *(LAS u32x4*)(vb + srow * VROWB + (sch + 8 * c) * 16) = vreg[c]; }
        if (sch == 0) wts[srow] = wr_;
        __syncthreads();
#pragma unroll
        for (int sg = 0; sg < 4; ++sg) {
            const s16x4 alo = trread(vb + toffV + (16 * sg) * VROWB + 64 * dvb), ahi = trread(vb + toffV + (16 * sg + 8) * VROWB + 64 * dvb);
            const bf16x8 af = (bf16x8){alo[0], alo[1], alo[2], alo[3], ahi[0], ahi[1], ahi[2], ahi[3]};
#pragma unroll
            for (int c = 0; c < 2; ++c) {
                const s16x4 blo = trread(kb + toffK + (16 * sg) * KROWB + 64 * (dkb0 + c)), bhi = trread(kb + toffK + (16 * sg + 8) * KROWB + 64 * (dkb0 + c));
                const bf16x8 bfr = (bf16x8){blo[0], blo[1], blo[2], blo[3], bhi[0], bhi[1], bhi[2], bhi[3]};
                acc[c] = MFMA32(af, bfr, acc[c]);
            }
        }
#pragma unroll 4
        for (int s_ = 0; s_ < 16; ++s_) { const int ks = 16 * npart + s_; nacc += wts[ks] * bf2f(*(LAS const bf16_t*)(kb + ks * KROWB + ndk * 2)); }
    }
    float* D = (float*)(F.ws + WS_MD) + ((size_t)sq * 16 + n) * 16384;
#pragma unroll
    for (int c = 0; c < 2; ++c)
#pragma unroll
        for (int i = 0; i < 16; ++i) D[(32 * dvb + (i & 3) + 8 * (i >> 2) + 4 * h) * 128 + 32 * (dkb0 + c) + r] = acc[c][i];
    __syncthreads();
    LAS float* red = (LAS float*)F.lds;
    red[npart * 128 + ndk] = nacc;
    __syncthreads();
    if (tid < 128) ((float*)(F.ws + WS_MN))[((size_t)sq * 16 + n) * 128 + tid] = (red[tid] + red[128 + tid]) + (red[256 + tid] + red[384 + tid]);
    __syncthreads();
}
DI void mlstm_state_scan(Frame& F) {
    const int gid = (F.bid * NWAVES + F.wave) * 64 + F.lane, NG_ = F.G * NWAVES * 64;
    const float* D = (const float*)(F.ws + WS_MD); bf16_t* C = (bf16_t*)(F.ws + WS_MC); const float* MQ = (const float*)(F.ws + WS_MQ);
    for (int e = gid; e < CB * 4 * 16384; e += NG_) {
        const int sq = e >> 14, idx = e & 16383;
        float d[15], me[15];
#pragma unroll
        for (int n = 0; n < 15; ++n) { d[n] = D[((size_t)sq * 16 + n) * 16384 + idx]; me[n] = MQ[(size_t)sq * SEQ + 256 * n + 255]; }
        float c = 0.f;
#pragma unroll
        for (int n = 0; n < 15; ++n) { const float f = n == 0 ? 0.f : fexp(me[n - 1] - me[n]); c = f * c + d[n]; C[((size_t)sq * 16 + n + 1) * 16384 + idx] = (bf16_t)f2bf(c); }
    }
    const float* Nv = (const float*)(F.ws + WS_MN); float* NS = (float*)(F.ws + WS_MN + 128 * 1024);
    for (int e = gid; e < CB * 4 * 128; e += NG_) {
        const int sq = e >> 7, idx = e & 127; float c = 0.f;
#pragma unroll
        for (int n = 0; n < 15; ++n) { const float me = MQ[(size_t)sq * SEQ + 256 * n + 255]; const float f = n == 0 ? 0.f : fexp(MQ[(size_t)sq * SEQ + 256 * (n - 1) + 255] - me);
            c = f * c + Nv[((size_t)sq * 16 + n) * 128 + idx]; NS[((size_t)sq * 16 + n + 1) * 128 + idx] = c; }
    }
}

constexpr size_t SC_BSTRIDE = (size_t)4096 * (64 * 65 / 2);
DI size_t sc_off(int b, int t) { const int qb = t >> 6; return (size_t)b * SC_BSTRIDE + (size_t)4096 * (qb * (qb + 1) / 2) + (size_t)(t & 63) * 64 * (qb + 1); }
constexpr int CW_QUEUE2 = 12288;
DI void phase_scores(Frame& F, int it) {
    F.refresh();
    unsigned* qhead = (unsigned*)(F.ws + WS_CTL) + CW_QUEUE2 + it * 64;
    volatile LAS unsigned* slot = (volatile LAS unsigned*)(F.lds + MISC_OFF + 64);
    const bf16_t* IQ = (const bf16_t*)(F.ws + WS_IQ); const bf16_t* IK = (const bf16_t*)(F.ws + WS_IK); const float* IW = (const float*)(F.ws + WS_IW);
    float* SC = (float*)(F.ws + WS_HREG);
    for (;;) {
        if (F.tid == 0) *slot = __hip_atomic_fetch_add(qhead, 1u, __ATOMIC_RELAXED, __HIP_MEMORY_SCOPE_AGENT);
        __syncthreads();
        const int u = __builtin_amdgcn_readfirstlane((int)*slot);
        __syncthreads();
        if (u >= CB * 160 + 240) break;
        if (u >= CB * 160) { const int m_ = u - CB * 160; mlstm_state_unit(F, m_ & 15, m_ >> 4); continue; }
        int b = u / 160, k = u % 160, qb, seg;
        {
          int cls = 3, base = 0;
          for (;; --cls) { const int cnt = 16 * (cls + 1); if (k < base + cnt) break; base += cnt; }
          const int kk = k - base; qb = 16 * cls + (kk % 16); seg = kk / 16; }
        F.refresh();
        const int lane = F.lane, w = F.wave, r = lane & 31, h = lane >> 5, qh = w & 1;
        const int t0 = 64 * qb + 32 * qh;
        const size_t rowq = (size_t)b * SEQ + t0 + r;
        const f32x4 wv = *(const GAS f32x4*)(IW + rowq * 4);
        bf16x8 qf[4][4];
#pragma unroll
        for (int hd = 0; hd < 4; ++hd)
#pragma unroll
            for (int s = 0; s < 4; ++s) qf[hd][s] = *(const GAS bf16x8*)(IQ + rowq * 256 + hd * 64 + 16 * s + 8 * h);
        LAS unsigned* T = (LAS unsigned*)(F.lds + w * 8448);
        const int jplast = ((16 * seg + 15 < qb) ? 16 * seg + 15 : qb) >> 1;
        unsigned short* scb = (unsigned short*)(F.ws + WS_HREG) + sc_off(b, t0);
        const int rstride = 64 * (qb + 1);
        for (int jp = 8 * seg + (w >> 1); jp <= jplast; jp += 4) {
            const int nt2 = (2 * jp + 1 <= qb) ? 2 : 1;
            bf16x8 kfa[4][4];
#pragma unroll
            for (int q4 = 0; q4 < 4; ++q4) { const int jq = 2 * jp + ((q4 >> 1) < nt2 ? (q4 >> 1) : 0);
#pragma unroll
                for (int s = 0; s < 4; ++s) kfa[q4][s] = *(const GAS bf16x8*)(IK + ((size_t)b * SEQ + 64 * jq + 32 * (q4 & 1) + r) * 64 + 8 * h + 16 * s); }
#pragma unroll
            for (int ts = 0; ts < 2; ++ts) { if (ts < nt2) {
#pragma unroll
                for (int p = 0; p < 2; ++p) {
                    float sc[16];
#pragma unroll
                    for (int i = 0; i < 16; ++i) sc[i] = 0.f;
#pragma unroll
                    for (int hd = 0; hd < 4; ++hd) {
                        f32x16 acc;
#pragma unroll
                        for (int i = 0; i < 16; ++i) acc[i] = 0.f;
#pragma unroll
                        for (int s = 0; s < 4; ++s) acc = MFMA32(kfa[2 * ts + p][s], qf[hd][s], acc);
#pragma unroll
                        for (int i = 0; i < 16; ++i) sc[i] += wv[hd] * fmaxf(acc[i], 0.f);
                    }
#pragma unroll
                    for (int i = 0; i < 16; i += 2) {
                        const unsigned lo = __builtin_bit_cast(unsigned short, (_Float16)(sc[i] + 0.0f)), hi = __builtin_bit_cast(unsigned short, (_Float16)(sc[i + 1] + 0.0f));
                        T[r * 65 + ((64 * ts + 32 * p + (i & 3) + 8 * (i >> 2) + 4 * h) >> 1)] = lo | (hi << 16); }
                }
            } }
            WSYNC();
            if (lane < 32 * nt2) {
#pragma unroll 8
                for (int q = 0; q < 32; ++q) *(unsigned*)(scb + (size_t)q * rstride + 128 * jp + 2 * lane) = T[q * 65 + lane];
            }
            WSYNC();
        }
    }
}
DI unsigned long long spread32(unsigned x) {
    unsigned long long v = x;
    v = (v | (v << 16)) & 0x0000FFFF0000FFFFull; v = (v | (v << 8)) & 0x00FF00FF00FF00FFull; v = (v | (v << 4)) & 0x0F0F0F0F0F0F0F0Full;
    v = (v | (v << 2)) & 0x3333333333333333ull; v = (v | (v << 1)) & 0x5555555555555555ull; return v;
}
DI unsigned pack_nib(unsigned long long bm, int hh) {
    unsigned long long x = (bm >> (4 * hh)) & 0x0F0F0F0F0F0F0F0Full;
    x = (x | (x >> 4)) & 0x00FF00FF00FF00FFull; x = (x | (x >> 8)) & 0x0000FFFF0000FFFFull; x = (x | (x >> 16)) & 0x00000000FFFFFFFFull; return (unsigned)x;
}
DI void radix_find(LAS unsigned* hist, int lane, int& need, unsigned& digit, unsigned& cnt) {
    const u32x4 c = *(LAS const u32x4*)(hist + 4 * lane);
    const unsigned ls = (c.x + c.y) + (c.z + c.w); unsigned inc = ls;
#pragma unroll
    for (int o = 1; o < 64; o <<= 1) { const unsigned y = shup_u(inc, o, lane); if (lane >= o) inc += y; }
    const unsigned total = rdl_u(inc, 63);
    unsigned cum = total - inc; int fbin = -1; unsigned fneed = 0u, fcnt = 0u;
    if (cum < (unsigned)need && cum + c.w >= (unsigned)need) { fbin = 4 * lane + 3; fneed = (unsigned)need - cum; fcnt = c.w; } cum += c.w;
    if (fbin < 0 && cum < (unsigned)need && cum + c.z >= (unsigned)need) { fbin = 4 * lane + 2; fneed = (unsigned)need - cum; fcnt = c.z; } cum += c.z;
    if (fbin < 0 && cum < (unsigned)need && cum + c.y >= (unsigned)need) { fbin = 4 * lane + 1; fneed = (unsigned)need - cum; fcnt = c.y; } cum += c.y;
    if (fbin < 0 && cum < (unsigned)need && cum + c.x >= (unsigned)need) { fbin = 4 * lane; fneed = (unsigned)need - cum; fcnt = c.x; }
    const int src = __ffsll((long long)__ballot(fbin >= 0)) - 1;
    digit = rdl_u((unsigned)fbin, src); need = (int)rdl_u(fneed, src); cnt = rdl_u(fcnt, src);
}
template <int NGP>
DI void select_row(int row, int lane, LAS unsigned* hist, const unsigned (&raw)[32], unsigned* MASK, const int probe) {
        const int b = row >> 12, t = row & (SEQ - 1), n = t + 1, ngp = (t >> 7) + 1;
        unsigned key[NGP];
        (void)b;
#pragma unroll
        for (int i = 0; i < NGP; ++i) key[i] = raw[i];
#pragma unroll
        for (int i = 0; i < NGP; ++i) { const int e2 = 64 * i + lane; unsigned w_ = key[i];
            { const unsigned sg_ = (w_ >> 15) & 0x00010001u; w_ ^= ((sg_ << 15) - sg_) + 0x80008000u; }
            if (2 * e2 >= n) w_ &= 0xFFFF0000u; if (2 * e2 + 1 >= n) w_ &= 0x0000FFFFu; key[i] = w_; }
        unsigned thr = 0u; int need = 256; bool ties = false;
        if (n > 256 && probe != 1 && probe != 3) {
            unsigned dA = 0u, dB = 0u, cnt = 0u;
            { unsigned z_ = 0u; asm volatile("" : "+v"(z_)); *(LAS u32x4*)(hist + 4 * lane) = (u32x4){z_, z_, z_, z_}; }
            WSYNC();
#pragma unroll
            for (int i = 0; i < NGP; ++i) if (i < ngp) { const unsigned kx = key[i];
                __hip_atomic_fetch_add(&hist[(kx >> 8) & 255u], 1u, __ATOMIC_RELAXED, __HIP_MEMORY_SCOPE_WORKGROUP); __hip_atomic_fetch_add(&hist[kx >> 24], 1u, __ATOMIC_RELAXED, __HIP_MEMORY_SCOPE_WORKGROUP); }
            WSYNC();
            radix_find(hist, lane, need, dA, cnt);
            WSYNC();
            if ((unsigned)need != cnt) {
                { unsigned z_ = 0u; asm volatile("" : "+v"(z_)); *(LAS u32x4*)(hist + 4 * lane) = (u32x4){z_, z_, z_, z_}; }
                WSYNC();
#pragma unroll
                for (int i = 0; i < NGP; ++i) if (i < ngp) { const unsigned kx = key[i];
                    if (((kx >> 8) & 255u) == dA) __hip_atomic_fetch_add(&hist[kx & 255u], 1u, __ATOMIC_RELAXED, __HIP_MEMORY_SCOPE_WORKGROUP);
                    if ((kx >> 24) == dA) __hip_atomic_fetch_add(&hist[(kx >> 16) & 255u], 1u, __ATOMIC_RELAXED, __HIP_MEMORY_SCOPE_WORKGROUP); }
                WSYNC();
                radix_find(hist, lane, need, dB, cnt);
                WSYNC();
                thr = (dA << 8) | dB; ties = (unsigned)need != cnt;
            } else { thr = dA << 8; ties = false; }
        }
        unsigned elo = 0u, ehi = 0u, olo = 0u, ohi = 0u; int eqc = 0;
        if (probe == 1 || probe == 3) thr = 0x9000u;
        if (probe < 2)
        {
#define SEL_STEP(i) if constexpr ((i) < NGP) if ((i) < ngp) { const unsigned kx = key[(i) < NGP ? (i) : 0], kl = kx & 0xFFFFu, kh = kx >> 16; bool sl, sh; \
            if (n <= 256) { sl = kl != 0u; sh = kh != 0u; } \
            else if (!ties) { sl = kl >= thr; sh = kh >= thr; } \
            else { const bool ql = kl == thr, qh = kh == thr; const unsigned long long ml = __ballot(ql), mh = __ballot(qh), lt = (1ull << lane) - 1ull; \
                const int rl = eqc + __popcll(ml & lt) + __popcll(mh & lt), rh = rl + (ql ? 1 : 0); \
                sl = kl > thr || (ql && rl < need); sh = kh > thr || (qh && rh < need); eqc += __popcll(ml) + __popcll(mh); } \
            const unsigned long long be = __ballot(sl), bo = __ballot(sh); const unsigned e0 = (unsigned)be, e1 = (unsigned)(be >> 32), o0 = (unsigned)bo, o1 = (unsigned)(bo >> 32); \
            asm volatile("s_nop 4\n\tv_writelane_b32 %0, %4, " #i "\n\tv_writelane_b32 %1, %5, " #i "\n\tv_writelane_b32 %2, %6, " #i "\n\tv_writelane_b32 %3, %7, " #i \
                         : "+v"(elo), "+v"(ehi), "+v"(olo), "+v"(ohi) : "s"(e0), "s"(e1), "s"(o0), "s"(o1)); }
#define SEL8(b) SEL_STEP(b) SEL_STEP(b + 1) SEL_STEP(b + 2) SEL_STEP(b + 3) SEL_STEP(b + 4) SEL_STEP(b + 5) SEL_STEP(b + 6) SEL_STEP(b + 7)
        SEL8(0) SEL8(8) SEL8(16) SEL8(24)
#undef SEL8
#undef SEL_STEP
        }
        if (lane < 32) {
            const unsigned long long ta = spread32(elo) | (spread32(olo) << 1), tb = spread32(ehi) | (spread32(ohi) << 1);
            *(u32x2*)(MASK + ((size_t)row * 2 + 0) * 64 + 2 * lane) = (u32x2){pack_nib(ta, 0), pack_nib(tb, 0)};
            *(u32x2*)(MASK + ((size_t)row * 2 + 1) * 64 + 2 * lane) = (u32x2){pack_nib(ta, 1), pack_nib(tb, 1)};
        }
}
DI void phase_select(Frame& F, const int probe) {
    F.refresh();
    const int gw = F.bid * NWAVES + F.wave, NGW = F.G * NWAVES, lane = F.lane;
    LAS unsigned* hist = (LAS unsigned*)(F.lds + F.wave * 1024);
    const unsigned short* SC = (const unsigned short*)(F.ws + WS_HREG); unsigned* MASK = (unsigned*)(F.ws + WS_MASK);
    if (!probe) mlstm_state_scan(F);
    unsigned cur[32];
#define LOAD_ROW(dst, rw) do { const int t_ = (rw) & (SEQ - 1), em_ = t_ >> 1; const unsigned* sr_ = (const unsigned*)(SC + sc_off((rw) >> 12, t_)); \
        _Pragma("unroll") for (int i_ = 0; i_ < 32; ++i_) { const int e_ = 64 * i_ + lane; dst[i_] = *(const GAS unsigned*)(sr_ + (e_ < em_ ? e_ : em_)); } } while (0)
    const int nstep = (MC + NGW - 1) / NGW;
#define ROW_OF(k) ((NGW == 2048) ? (((k) >> 1) * SEQ + (((k) & 1) ? (SEQ - 1 - gw) : gw)) : (gw + (k) * NGW))
    if (gw < MC) LOAD_ROW(cur, ROW_OF(0));
    for (int k = 0; k < nstep; ++k) {
        const int row = ROW_OF(k); if (row >= MC) break;
        unsigned nxt[32]; const int nrow = (k + 1 < nstep && ROW_OF(k + 1) < MC) ? ROW_OF(k + 1) : row;
        LOAD_ROW(nxt, nrow);
        asm volatile("" ::: "memory");
        const int cls = (row & (SEQ - 1)) >> 10;
        unsigned* mk = probe ? (unsigned*)(F.ws + WS_QKRAW) : MASK;
        if (cls == 0) select_row<8>(row, lane, hist, cur, mk, probe);
        else if (cls == 1) select_row<16>(row, lane, hist, cur, mk, probe);
        else if (cls == 2) select_row<24>(row, lane, hist, cur, mk, probe);
        else select_row<32>(row, lane, hist, cur, mk, probe);
#pragma unroll
        for (int i = 0; i < 32; ++i) cur[i] = nxt[i];
    }
#undef ROW_OF
#undef LOAD_ROW
}

#ifndef MK_ONE_LAUNCH
#define MK_ONE_LAUNCH 1
#endif
constexpr int NPHASE = 13;
__global__ void __launch_bounds__(NWAVES * 64, 2) fwd(Args args) {
    extern __shared__ __attribute__((aligned(16))) unsigned char lds[];
    Frame F;
    F.lds = (LAS unsigned char*)lds; F.ws = args.ws;
    F.tid = threadIdx.x; F.lane = F.tid & 63; F.wave = __builtin_amdgcn_readfirstlane(F.tid >> 6); F.wave0 = F.wave;
    F.G = gridDim.x; F.bid = blockIdx.x;
    volatile LAS unsigned* MISC = (volatile LAS unsigned*)(F.lds + MISC_OFF);
    for (int u = F.tid; u < (LDS_BYTES - LDSCTL_OFF) / 4; u += NWAVES * 64) ((LAS unsigned*)(F.lds + LDSCTL_OFF))[u] = 0u;
    __syncthreads();
    const bool multi = MK_ONE_LAUNCH ? true : !(args.it_hi - args.it_lo == 1 && args.ph_hi - args.ph_lo == 1);
    XcdBarrier bar; bar.bar = (unsigned*)(F.ws + WS_CTL) + CW_BAR; bar.x = 0; bar.st = nullptr;
    if (multi) bar = xcd_barrier_post((unsigned*)(F.ws + WS_CTL) + CW_BAR, MISC + 8);
#define GRID_BAR() do { if (multi) { xcd_barrier(bar); if ((REPMASK >> 15) & 1) xcd_barrier(bar); } } while (0)
    const int lo = args.ph_lo, hi = args.ph_hi; (void)lo; (void)hi;
#ifndef PHMASK
#define PHMASK 0xFFFF
#endif
#if MK_ONE_LAUNCH
#define IN(k) ((PHMASK >> (k)) & 1)
#else
#define IN(k) (((PHMASK >> (k)) & 1) && lo <= (k) && (k) < hi)
#endif
#ifndef REPMASK
#define REPMASK 0
#endif
#define PROBE_MODES 7
#define PROBE_NOLOAD 0
#define REPS(k) (1 + ((REPMASK >> (k)) & 1))
    if (IN(0) && args.it_lo == 0) for (int rp = 0; rp < REPS(0); ++rp) { phase_prologue(F, args); GRID_BAR(); }
    for (int it = args.it_lo; it < args.it_hi; ++it) {
        const int chunk = it >> 1, l = it & 1;
        unsigned char* wl = F.ws + WS_W + (size_t)l * W_LAYER;
        const size_t xoff = (size_t)chunk * MC * DM;
        const float* xin = args.in[I_X] + xoff;
        float* Xout = args.out + xoff;
        bf16_t* X16 = (bf16_t*)(F.ws + WS_X16);
        bf16_t* XN = (bf16_t*)(F.ws + WS_XN);
        if (IN(1)) for (int rp = 0; rp < REPS(1); ++rp) { phase_rmsnorm(F, l == 0 ? (const void*)xin : (const void*)X16, l != 0, args.in[I_NMG] + (size_t)l * DM, XN); GRID_BAR(); }
        if (IN(2)) for (int rp = 0; rp < REPS(2); ++rp) {
            pg8::Gemm g{XN, (const bf16_t*)(wl + WO_IN), MC, NT_IN * 256, DM}; F.refresh(); pg8::StaticOrder S; S.init(MC, NT_IN * 256, F.G, F.bid);
            EpiInProj E{F.ws, args.in[I_GB] + l * 8, l};
            pg8::gemm_phase<EpiInProj, true>(F.lds, g, S, E, F.tid);
            GRID_BAR();
        }
        if (IN(3)) for (int rp = 0; rp < REPS(3); ++rp) { phase_token(F, args, l, rp == 0 ? 0 : PROBE_NOLOAD); GRID_BAR(); }
        if (IN(4)) for (int rp = 0; rp < REPS(4); ++rp) {
            pg8::Gemm g{(const bf16_t*)(F.ws + WS_CKV), (const bf16_t*)(wl + WO_KV), MC, 1024, 256}; F.refresh(); pg8::StaticOrder S; S.init(MC, 1024, F.G, F.bid);
            EpiKV E{F.ws, l};
            pg8::gemm_phase<EpiKV, true>(F.lds, g, S, E, F.tid);
            if (rp + 1 < REPS(4)) GRID_BAR();
        }
#ifdef NAIVE_SEL
        if (IN(5)) { naive_select(F); GRID_BAR(); }
#else
        if (IN(5)) { for (int rp = 0; rp < REPS(5); ++rp) { phase_scores(F, it + 8 * rp); GRID_BAR(); } for (int rp = 0; rp < REPS(13); ++rp) { phase_select(F, rp == 0 ? 0 : PROBE_NOLOAD); GRID_BAR(); } }
#endif
        #ifdef NAIVE_MIX
        if (IN(6)) { naive_dsa(F); __syncthreads(); naive_mlstm(F, args, l); __syncthreads(); naive_diff(F, args, l); GRID_BAR(); }
#else
        if (IN(6)) for (int rp = 0; rp < REPS(6); ++rp) { phase_mixers(F, args, l, it + 8 * rp, rp == 0 ? 7 : PROBE_MODES, rp == 0 ? 0 : PROBE_NOLOAD); if (rp + 1 < REPS(6)) GRID_BAR(); }
#endif
        if (IN(7)) for (int rp = 0; rp < REPS(7); ++rp) {
            pg8::Gemm g{XN, (const bf16_t*)(wl + WO_G), MC, 3072, DM}; F.refresh(); pg8::StaticOrder S; S.init(MC, 3072, F.G, F.bid);
            EpiGate E{F.ws + WS_HREG, args.in[I_BG] + (size_t)l * 3072};
            pg8::gemm_phase<EpiGate, true>(F.lds, g, S, E, F.tid);
            GRID_BAR();
        }
        if (IN(8)) for (int rp = 0; rp < REPS(8); ++rp) {
            pg8::Gemm g{(const bf16_t*)(F.ws + WS_Y), (const bf16_t*)(wl + WO_BR), MC, 1024, 1536}; F.refresh(); pg8::StaticOrder S; S.init(MC, 1024, F.G, F.bid);
            EpiMerge E{F.ws + WS_HREG, (bf16_t*)(F.ws + WS_MG)};
            pg8::gemm_phase<EpiMerge, false>(F.lds, g, S, E, F.tid);
            GRID_BAR();
        }
        if (IN(9)) for (int rp = 0; rp < REPS(9); ++rp) {
            pg8::Gemm g{(const bf16_t*)(F.ws + WS_MG), (const bf16_t*)(wl + WO_OUT), MC, 1024, 1024}; F.refresh(); pg8::StaticOrder S; S.init(MC, 1024, F.G, F.bid);
            EpiResid E{l == 0 ? (const void*)xin : (const void*)X16, (void*)X16, l != 0, true};
            pg8::gemm_phase<EpiResid, false>(F.lds, g, S, E, F.tid);
            GRID_BAR();
        }
        if (IN(10)) for (int rp = 0; rp < REPS(10); ++rp) { phase_rmsnorm(F, X16, true, args.in[I_NFG] + (size_t)l * DM, XN); GRID_BAR(); }
        if (IN(11)) for (int rp = 0; rp < REPS(11); ++rp) {
            pg8::Gemm g{XN, (const bf16_t*)(wl + WO_GU), MC, 5632, DM}; F.refresh(); pg8::StaticOrder S; S.init(MC, 5632, F.G, F.bid);
            EpiSwiGLU E{(bf16_t*)(F.ws + WS_HREG)};
            pg8::gemm_phase<EpiSwiGLU, true>(F.lds, g, S, E, F.tid);
            GRID_BAR();
        }
        if (IN(12)) for (int rp = 0; rp < REPS(12); ++rp) {
            pg8::Gemm g{(const bf16_t*)(F.ws + WS_HREG), (const bf16_t*)(wl + WO_D), MC, 1024, FF}; F.refresh(); pg8::StaticOrder S; S.init(MC, 1024, F.G, F.bid);
            EpiResid E{(const void*)X16, l == DEPTH - 1 ? (void*)Xout : (void*)X16, true, l != DEPTH - 1};
            pg8::gemm_phase<EpiResid, false>(F.lds, g, S, E, F.tid);
            GRID_BAR();
        }
    }
#undef IN
#undef GRID_BAR
}

extern "C" void kernel_launch(void* const* d_in, const int* in_sizes, int n_in, void* d_out, int out_size, void* d_ws, size_t ws_size, hipStream_t stream) {
    static int grid = 0;
    if (grid == 0) {
        if (n_in != 21 || ws_size < WS_END) { fprintf(stderr, "kernel_launch: unexpected inputs (n_in %d, ws %zu)\n", n_in, ws_size); grid = -1; return; }
        int dev = 0, cus = 0;
        if (hipGetDevice(&dev) != hipSuccess || hipDeviceGetAttribute(&cus, hipDeviceAttributeMultiprocessorCount, dev) != hipSuccess) { grid = -1; return; }
        if (hipFuncSetAttribute((const void*)fwd, hipFuncAttributeMaxDynamicSharedMemorySize, LDS_BYTES) != hipSuccess) { grid = -1; return; }
        int per_cu = 0;
        if (hipOccupancyMaxActiveBlocksPerMultiprocessor(&per_cu, (const void*)fwd, NWAVES * 64, LDS_BYTES) != hipSuccess || per_cu < 1) fprintf(stderr, "kernel_launch: occupancy query says %d\n", per_cu);
        (void)hipGetLastError();
        grid = cus;
    }
    if (grid < 0) return;
    (void)hipMemsetAsync((char*)d_ws + WS_CTL, 0, CTL_ZERO_BYTES, stream);
    Args a{};
    for (int i = 0; i < 21; ++i) a.in[i] = (const float*)d_in[i];
    a.out = (float*)d_out; a.ws = (unsigned char*)d_ws;
#if MK_ONE_LAUNCH
    a.it_lo = 0; a.it_hi = NCHUNK * DEPTH; a.ph_lo = 0; a.ph_hi = NPHASE;
    hipLaunchKernelGGL(fwd, dim3(grid), dim3(NWAVES * 64), LDS_BYTES, stream, a);
#else
    a.it_lo = 0; a.it_hi = 1; a.ph_lo = 0; a.ph_hi = 1;
    hipLaunchKernelGGL(fwd, dim3(grid), dim3(NWAVES * 64), LDS_BYTES, stream, a);
    for (int it = 0; it < NCHUNK * DEPTH; ++it)
        for (int ph = 1; ph < NPHASE; ++ph) { a.it_lo = it; a.it_hi = it + 1; a.ph_lo = ph; a.ph_hi = ph + 1; hipLaunchKernelGGL(fwd, dim3(grid), dim3(NWAVES * 64), LDS_BYTES, stream, a); }
#endif
}
```

```cpp
#include <hip/hip_runtime.h>
#include <cstdio>
#include <cstdint>

#ifndef REPMASK
#define REPMASK 0
#endif
#define PROBE_MODES 7
#define PROBE_NOLOAD 0
#define DI __device__ __forceinline__
#define LAS __attribute__((address_space(3)))
#define GAS __attribute__((address_space(1)))

typedef unsigned short bf16_t;
typedef short bf16x8 __attribute__((ext_vector_type(8)));
typedef float f32x4 __attribute__((ext_vector_type(4)));
typedef float f32x2 __attribute__((ext_vector_type(2)));
typedef unsigned u32x4 __attribute__((ext_vector_type(4)));
typedef unsigned u32x2 __attribute__((ext_vector_type(2)));

constexpr int BATCH = 8, SEQ = 4096, DM = 1024, DEPTH = 2;
constexpr int CB = 4;
constexpr int MC = CB * SEQ;
constexpr int NCHUNK = BATCH / CB;
constexpr int IN_COLS = 7756;
constexpr int FF = 2816;
constexpr float EPS = 1e-6f;
constexpr float LOG2E = 1.4426950408889634f;
constexpr float C2 = 0.125f * LOG2E;
constexpr int Z_MQK = 0, Z_MV = 1024, Z_MO = 1536, Z_MIF = 2048, Z_SQ = 2056, Z_CKV = 2568, Z_IQ = 2824, Z_IK = 3080, Z_IW = 3144, Z_DQ = 3148, Z_DK = 3660, Z_DV = 4172, Z_G = 4684;
constexpr int NT_IN = 19;

constexpr size_t MiB = 1u << 20;
constexpr size_t WS_CTL = 0, CTL_ZERO_BYTES = 128 * 1024;
constexpr size_t WS_COS = 1 * MiB, WS_SIN = 1 * MiB + 512 * 1024;
constexpr size_t WS_W = 2 * MiB, W_LAYER = 38 * MiB;
constexpr size_t WO_IN = 0;
constexpr size_t WO_G = WO_IN + (size_t)NT_IN * 256 * 1024 * 2;
constexpr size_t WO_KV = WO_G + (size_t)3072 * 1024 * 2;
constexpr size_t WO_BR = WO_KV + (size_t)1024 * 256 * 2;
constexpr size_t WO_OUT = WO_BR + (size_t)1024 * 1536 * 2;
constexpr size_t WO_GU = WO_OUT + (size_t)1024 * 1024 * 2;
constexpr size_t WO_D = WO_GU + (size_t)5632 * 1024 * 2;
static_assert(WO_D + (size_t)1024 * 2816 * 2 <= W_LAYER, "weights per layer");
constexpr size_t WS_ACT = WS_W + 2 * W_LAYER;
constexpr size_t WS_XN = WS_ACT;
constexpr size_t WS_QKRAW = WS_XN + 32 * MiB;
constexpr size_t WS_CKV = WS_QKRAW + 32 * MiB;
constexpr size_t WS_IQ = WS_CKV + 8 * MiB;
constexpr size_t WS_Y = WS_QKRAW;
constexpr size_t WS_QK = WS_IQ + 8 * MiB;
constexpr size_t WS_MG = WS_QK;
constexpr size_t WS_VM = WS_QK + 32 * MiB;
constexpr size_t WS_OM = WS_VM + 16 * MiB;
constexpr size_t WS_SQ = WS_OM + 16 * MiB;
constexpr size_t WS_DQ = WS_SQ + 16 * MiB;
constexpr size_t WS_DK = WS_DQ + 16 * MiB;
constexpr size_t WS_DV = WS_DK + 16 * MiB;
constexpr size_t WS_SK = WS_DV + 16 * MiB;
constexpr size_t WS_SV = WS_SK + 16 * MiB;
constexpr size_t WS_IK = WS_SV + 16 * MiB;
constexpr size_t WS_IF = WS_IK + 2 * MiB;
constexpr size_t WS_IW = WS_IF + 512 * 1024;
constexpr size_t WS_RT = WS_IW + 256 * 1024;
constexpr size_t WS_AK = WS_RT + 256 * 1024;
constexpr size_t WS_MQ = WS_AK + 256 * 1024;
constexpr size_t WS_EM = WS_MQ + 256 * 1024;
constexpr size_t WS_MASK = WS_IK + 4 * MiB;
constexpr size_t WS_HREG = WS_MASK + 8 * MiB;
constexpr size_t WS_X16 = WS_HREG + 96 * MiB;
constexpr size_t WS_MD = WS_X16 + 32 * MiB;
constexpr size_t WS_MC = WS_MD + 16 * MiB;
constexpr size_t WS_MN = WS_MC + 8 * MiB;
constexpr size_t WS_END = WS_MN + 1 * MiB;
static_assert(WS_EM + 256 * 1024 <= WS_MASK, "small buffers");
static_assert(WS_END <= 512 * MiB, "workspace");
constexpr int CW_BAR = 4096;
constexpr size_t WS_GAIN = 512 * 1024;

constexpr int RING_BYTES = 131072;
constexpr int LDSCTL_OFF = RING_BYTES, MISC_OFF = LDSCTL_OFF + 320;
constexpr int LDS_BYTES = 147456;
constexpr int NWAVES = 8;

DI float bf2f(unsigned v) { return __uint_as_float(v << 16); }
DI unsigned f2bf(float f) { unsigned u = __float_as_uint(f); return (u + 0x7fffu + ((u >> 16) & 1u)) >> 16; }
DI unsigned pk2(float lo, float hi) { return f2bf(lo) | (f2bf(hi) << 16); }
DI float bflo(unsigned w) { return __uint_as_float(w << 16); }
DI float bfhi(unsigned w) { return __uint_as_float(w & 0xffff0000u); }
typedef unsigned u32x2v __attribute__((ext_vector_type(2)));
DI float xor1(float v)  { return __uint_as_float((unsigned)__builtin_amdgcn_mov_dpp((int)__float_as_uint(v), 0xB1, 0xF, 0xF, true)); }
DI float xor2(float v)  { return __uint_as_float((unsigned)__builtin_amdgcn_mov_dpp((int)__float_as_uint(v), 0x4E, 0xF, 0xF, true)); }
DI float ror4(float v)  { return __uint_as_float((unsigned)__builtin_amdgcn_mov_dpp((int)__float_as_uint(v), 0x124, 0xF, 0xF, true)); }
DI float ror8(float v)  { return __uint_as_float((unsigned)__builtin_amdgcn_mov_dpp((int)__float_as_uint(v), 0x128, 0xF, 0xF, true)); }
DI float sum16x(float v) { const unsigned u = __float_as_uint(v); const auto r = __builtin_amdgcn_permlane16_swap(u, u, false, false); return __uint_as_float(r[0]) + __uint_as_float(r[1]); }
DI float sum32x(float v) { const unsigned u = __float_as_uint(v); const auto r = __builtin_amdgcn_permlane32_swap(u, u, false, false); return __uint_as_float(r[0]) + __uint_as_float(r[1]); }
DI float max16x(float v) { const unsigned u = __float_as_uint(v); const auto r = __builtin_amdgcn_permlane16_swap(u, u, false, false); return fmaxf(__uint_as_float(r[0]), __uint_as_float(r[1])); }
DI float max32x(float v) { const unsigned u = __float_as_uint(v); const auto r = __builtin_amdgcn_permlane32_swap(u, u, false, false); return fmaxf(__uint_as_float(r[0]), __uint_as_float(r[1])); }
DI unsigned shup_u(unsigned v, int o, int lane) { return (unsigned)__builtin_amdgcn_ds_bpermute(((lane - o) & 63) << 2, (int)v); }
DI float shup_f(float v, int o, int lane) { return __uint_as_float(shup_u(__float_as_uint(v), o, lane)); }
DI double shup_d(double v, int o, int lane) { const unsigned long long u = __builtin_bit_cast(unsigned long long, v); const unsigned lo = shup_u((unsigned)u, o, lane), hi = shup_u((unsigned)(u >> 32), o, lane); return __builtin_bit_cast(double, ((unsigned long long)hi << 32) | lo); }
DI unsigned rdl_u(unsigned v, int src) { return (unsigned)__builtin_amdgcn_readlane((int)v, src); }
DI float wave_sum(float v) { v += xor1(v); v += xor2(v); v += ror4(v); v += ror8(v); v = sum16x(v); return sum32x(v); }
DI float wave_max(float v) { v = fmaxf(v, xor1(v)); v = fmaxf(v, xor2(v)); v = fmaxf(v, ror4(v)); v = fmaxf(v, ror8(v)); v = max16x(v); return max32x(v); }
typedef __bf16 bf16x2e_t __attribute__((ext_vector_type(2)));
DI unsigned cvtpk_(float lo, float hi) { f32x2 v = {lo, hi}; bf16x2e_t b = __builtin_convertvector(v, bf16x2e_t); return __builtin_bit_cast(unsigned, b); }
DI float fexp2(float x) { return __builtin_amdgcn_exp2f(x); }
DI float fexp(float x) { return __builtin_amdgcn_exp2f(x * LOG2E); }
DI float frcp(float x) { return __builtin_amdgcn_rcpf(x); }
DI float sigmoidf_(float x) { return frcp(1.0f + fexp(-x)); }
#define WSYNC() do { asm volatile("s_waitcnt lgkmcnt(0)" ::: "memory"); __builtin_amdgcn_wave_barrier(); } while (0)

namespace pg8 {
constexpr int BM = 256, BK = 64, HALF = 128, HTB = HALF * BK * 2, STAGE_BYTES = 8 * HTB, NXCD = 8, WGM = 8;
__host__ __device__ __forceinline__ int lds_byte(int r, int c) { const int st = (r >> 4) * 2 + (c >> 5), rr = r & 15, cc = c & 31, ob = rr * 64 + cc * 2; return st * 1024 + (ob ^ (((ob >> 9) & 1) << 5)); }
__host__ __device__ __forceinline__ void stage_rc(int b, int& R, int& C) { const int st = b / 1024, sb = b % 1024, swz = sb ^ (((sb >> 9) & 1) << 5); R = (st >> 1) * 16 + swz / 64; C = (st & 1) * 32 + (swz % 64) / 2; }
__host__ __device__ __forceinline__ int perm32(int rho) { const int n = rho >> 4, i = rho & 15; return 8 * (i >> 2) + 4 * n + (i & 3); }
struct Unit { int pm, pn; };
struct Gemm { const bf16_t* A; const bf16_t* Bt; int M, N, K; };
struct StaticOrder {
    int nM, nN, nwg, G, c;
    __host__ __device__ void init(int M, int N, int G_, int c_) { nM = M / BM; nN = N / BM; nwg = nM * nN; G = G_; c = c_; }
    __host__ __device__ bool next(int i, Unit& u) const {
        const long L = (long)i * G + c; if (L >= nwg) return false;
        int wgid = (int)L; { const int q = nwg / NXCD, r = nwg % NXCD, xcd = wgid % NXCD, off = wgid / NXCD; wgid = (xcd < r ? xcd * (q + 1) : r * (q + 1) + (xcd - r) * q) + off; }
        const int nig = WGM * nN, gid = wgid / nig, fm = gid * WGM, gsz = (nM - fm) < WGM ? (nM - fm) : WGM;
        u.pm = fm + ((wgid % nig) % gsz); u.pn = (wgid % nig) / gsz; return true;
    }
};
template <class Epi, bool ALIGN_EPI>
__device__ __forceinline__ void gemm_phase(LAS unsigned char* lds, const Gemm g, const StaticOrder& S, const Epi& E, int tid_in) {
    int tid_ = tid_in; asm volatile("" : "+v"(tid_));
    int K_ = g.K; asm volatile("" : "+s"(K_));
    const int tid = tid_, wid = __builtin_amdgcn_readfirstlane(tid >> 6), lane = tid & 63, wr = wid >> 2, wc = wid & 3, fr = lane & 15, fq = lane >> 4;
    const int K = K_, nt = K / BK;
    unsigned voffA[2], voffB[2];
#pragma unroll
    for (int i = 0; i < 2; ++i) { int R, C; stage_rc(tid * 16 + i * 8192, R, C); const int Rb = Epi::PERM ? ((R & ~31) + perm32(R & 31)) : R;
        voffA[i] = (unsigned)(R * K + C) * 2u; voffB[i] = (unsigned)(Rb * K + C) * 2u; }
    const size_t kstep = (size_t)(BK * 2);
    const size_t hstep = (size_t)HALF * K * 2;
    const size_t tstep = 2 * hstep;
    const unsigned ldsw = (unsigned)wid * 1024u;
    const int aoff = lds_byte(wr * 64 + fr, fq * 8), boff = lds_byte(wc * 32 + fr, fq * 8);
#define PG8_SA(b, h) (((b) * 2 + (h)) * HTB)
#define PG8_SB(b, h) ((4 + (b) * 2 + (h)) * HTB)
#define PG8_STAGE(bufoff, gbase, voff) do { _Pragma("unroll") for (int _i = 0; _i < 2; ++_i) \
        __builtin_amdgcn_global_load_lds((const unsigned*)((const char*)(gbase) + (voff)[_i]), (LAS unsigned*)(lds + (bufoff) + ldsw + _i * 8192), 16, 0, 0); } while (0)
#define PG8_LDA(dst, b, h) do { _Pragma("unroll") for (int m = 0; m < 4; ++m) _Pragma("unroll") for (int k = 0; k < 2; ++k) dst[m][k] = *(const LAS bf16x8*)(lds + PG8_SA(b, h) + aoff + m * 2048 + k * 1024); } while (0)
#define PG8_LDB(dst, b, h) do { _Pragma("unroll") for (int n = 0; n < 2; ++n) _Pragma("unroll") for (int k = 0; k < 2; ++k) dst[n][k] = *(const LAS bf16x8*)(lds + PG8_SB(b, h) + boff + n * 2048 + k * 1024); } while (0)
#define PG8_MMA(ai, bj, At, Bt) do { __builtin_amdgcn_s_setprio(1); _Pragma("unroll") for (int m = 0; m < 4; ++m) _Pragma("unroll") for (int n = 0; n < 2; ++n) _Pragma("unroll") for (int k = 0; k < 2; ++k) \
        acc[ai][bj][m][n] = __builtin_amdgcn_mfma_f32_16x16x32_bf16(Bt[n][k], At[m][k], acc[ai][bj][m][n], 0, 0, 0); __builtin_amdgcn_s_setprio(0); } while (0)
#define PG8_WAIT_V(n) asm volatile("s_waitcnt vmcnt(" #n ")" ::: "memory")
#define PG8_WAIT_L(n) asm volatile("s_waitcnt lgkmcnt(" #n ")" ::: "memory")
#define PG8_BAR __builtin_amdgcn_s_barrier()
#define PG8_SCHED __builtin_amdgcn_sched_barrier(0)
    Unit cur, nxt; int ui = 0;
    if (!S.next(0, cur)) return;
    f32x4 acc[2][2][4][2];
    if constexpr (Epi::INIT) { int fr_ = fr, fq_ = fq, wr_ = wr, wc_ = wc; asm volatile("" : "+v"(fr_), "+v"(fq_), "+s"(wr_), "+s"(wc_)); E.init(acc, cur, wr_, wc_, fr_, fq_); }
    else {
#pragma unroll
    for (int a = 0; a < 2; ++a)
#pragma unroll
        for (int b = 0; b < 2; ++b)
#pragma unroll
            for (int m = 0; m < 4; ++m)
#pragma unroll
                for (int n = 0; n < 2; ++n) acc[a][b][m][n] = (f32x4){0.f, 0.f, 0.f, 0.f};
    }
    bf16x8 At[4][2], B0[2][2], B1[2][2];
    const char* cA = (const char*)g.A + (size_t)cur.pm * tstep; const char* cB = (const char*)g.Bt + (size_t)cur.pn * tstep;
    PG8_STAGE(PG8_SB(0, 0), cB, voffB); PG8_STAGE(PG8_SB(0, 1), cB + hstep, voffB); PG8_STAGE(PG8_SA(0, 0), cA, voffA); PG8_STAGE(PG8_SA(0, 1), cA + hstep, voffA);
    if (wr == 1) PG8_BAR;
    PG8_WAIT_V(2); PG8_BAR;
    PG8_STAGE(PG8_SB(1, 0), cB + kstep, voffB); PG8_STAGE(PG8_SA(1, 0), cA + kstep, voffA); PG8_STAGE(PG8_SB(1, 1), cB + hstep + kstep, voffB);
    PG8_WAIT_V(6); PG8_BAR;
    for (;;) {
        const bool has_next = S.next(ui + 1, nxt);
        const char* nA = has_next ? (const char*)g.A + (size_t)nxt.pm * tstep : cA; const char* nB = has_next ? (const char*)g.Bt + (size_t)nxt.pn * tstep : cB;
        for (int t = 0; t < nt; t += 2) {
            const bool last = (t == nt - 2);
            const char* a1 = cA + (size_t)(t + 1) * kstep;
            const char* a2 = last ? nA : cA + (size_t)(t + 2) * kstep; const char* b2 = last ? nB : cB + (size_t)(t + 2) * kstep;
            const char* a3 = a2 + kstep; const char* b3 = b2 + kstep;
            if constexpr (Epi::MIDK) { if (t == 8 || t == 16) { int fr_ = fr, fq_ = fq, wr_ = wr, wc_ = wc; asm volatile("" : "+v"(fr_), "+v"(fq_), "+s"(wr_), "+s"(wc_)); E.mid(acc, cur, t, wr_, wc_, fr_, fq_); } }
            PG8_LDB(B0, 0, 0); PG8_LDB(B1, 0, 1); PG8_SCHED; PG8_LDA(At, 0, 0); PG8_STAGE(PG8_SA(1, 1), a1 + hstep, voffA);
            PG8_WAIT_V(8); PG8_WAIT_L(0); PG8_BAR; PG8_MMA(0, 0, At, B0); PG8_MMA(0, 1, At, B1); PG8_BAR; PG8_SCHED;
            PG8_LDA(At, 0, 1); PG8_STAGE(PG8_SB(0, 0), b2, voffB); PG8_STAGE(PG8_SB(0, 1), b2 + hstep, voffB); PG8_STAGE(PG8_SA(0, 0), a2, voffA);
            PG8_WAIT_V(8); PG8_WAIT_L(0); PG8_BAR; PG8_MMA(1, 0, At, B0); PG8_MMA(1, 1, At, B1); PG8_BAR; PG8_SCHED;
            PG8_LDB(B0, 1, 0); PG8_LDB(B1, 1, 1); PG8_SCHED; PG8_LDA(At, 1, 0); PG8_STAGE(PG8_SA(0, 1), a2 + hstep, voffA);
            PG8_WAIT_V(8); PG8_WAIT_L(0); PG8_BAR; PG8_MMA(0, 0, At, B0); PG8_MMA(0, 1, At, B1); PG8_BAR; PG8_SCHED;
            PG8_LDA(At, 1, 1); PG8_STAGE(PG8_SB(1, 0), b3, voffB); PG8_STAGE(PG8_SB(1, 1), b3 + hstep, voffB); PG8_STAGE(PG8_SA(1, 0), a3, voffA);
            PG8_WAIT_V(8); PG8_WAIT_L(0); PG8_BAR; PG8_MMA(1, 0, At, B0); PG8_MMA(1, 1, At, B1); PG8_BAR; PG8_SCHED;
        }
        if constexpr (ALIGN_EPI) { if (wr == 0) PG8_BAR; }
        { int fr_ = fr, fq_ = fq, wr_ = wr, wc_ = wc; asm volatile("" : "+v"(fr_), "+v"(fq_), "+s"(wr_), "+s"(wc_)); E(acc, cur, wr_, wc_, fr_, fq_); }
        if (!has_next) break;
        if constexpr (Epi::INIT) { int fr_ = fr, fq_ = fq, wr_ = wr, wc_ = wc; asm volatile("" : "+v"(fr_), "+v"(fq_), "+s"(wr_), "+s"(wc_)); E.init(acc, nxt, wr_, wc_, fr_, fq_); }
        else {
#pragma unroll
        for (int a = 0; a < 2; ++a)
#pragma unroll
            for (int b = 0; b < 2; ++b)
#pragma unroll
                for (int m = 0; m < 4; ++m)
#pragma unroll
                    for (int n = 0; n < 2; ++n) acc[a][b][m][n] = (f32x4){0.f, 0.f, 0.f, 0.f};
        }
        cur = nxt; cA = nA; cB = nB; ++ui;
        if constexpr (ALIGN_EPI) { if (wr == 1) PG8_BAR; }
    }
    PG8_WAIT_V(0);
    if constexpr (!ALIGN_EPI) { if (wr == 0) PG8_BAR; }
    PG8_BAR;
#undef PG8_SA
#undef PG8_SB
#undef PG8_STAGE
#undef PG8_LDA
#undef PG8_LDB
#undef PG8_MMA
#undef PG8_WAIT_V
#undef PG8_WAIT_L
#undef PG8_BAR
#undef PG8_SCHED
}
}

#define XB_TMO      128
#define XB_XCNT(j)  (256  + 64 * (j))
#define XB_XSUB(j)  (1280 + 64 * (j))
#define XB_XGEN(j)  (2304 + 64 * (j))
#define XB_TOP      3328
#define XB_TOPGEN   3392
#define XCD_BAR_WORDS 3456
#define XB_SPIN_CAP (1u << 24)
DI unsigned xb_ld(unsigned* p)              { return __hip_atomic_load(p, __ATOMIC_RELAXED, __HIP_MEMORY_SCOPE_AGENT); }
DI unsigned xb_add(unsigned* p, unsigned v) { return __hip_atomic_fetch_add(p, v, __ATOMIC_RELAXED, __HIP_MEMORY_SCOPE_AGENT); }
DI unsigned xb_xcc_id() { return (unsigned)__builtin_amdgcn_s_getreg((3 << 11) | 20) & 0xFu; }
#define XB_SPIN(cond, bar) do { unsigned _sp = 0; while (cond) { __builtin_amdgcn_s_sleep(1); \
    if ((++_sp & 255u) == 0u) { if (xb_ld(&(bar)[XB_TMO])) break; if (_sp > XB_SPIN_CAP) { atomicAdd(&(bar)[XB_TMO], 1u); break; } } } } while (0)
struct XcdBarrier { unsigned* bar; unsigned x; volatile LAS unsigned* st; };
DI XcdBarrier xcd_barrier_post(unsigned* bar, volatile LAS unsigned* st) {
    XcdBarrier b; b.bar = bar; b.x = xb_xcc_id(); b.st = st;
    if (threadIdx.x == 0) (void)xb_add(&bar[XB_XCNT(b.x)], 1u);
    return b;
}
DI void xcd_barrier_complete(unsigned* bar, unsigned x, unsigned& nloc, unsigned& nx) {
    const unsigned G = gridDim.x * gridDim.y * gridDim.z;
    unsigned sum, cnt, mine, sp = 0u;
    for (;;) {
        sum = 0u; cnt = 0u; mine = 0u;
#pragma unroll
        for (unsigned j = 0; j < 16; ++j) { const unsigned c = xb_ld(&bar[XB_XCNT(j)]); sum += c; cnt += (c > 0u) ? 1u : 0u; mine = (j == x) ? c : mine; }
        if (sum == G) break;
        __builtin_amdgcn_s_sleep(1);
        if ((++sp & 255u) == 0u) { if (xb_ld(&bar[XB_TMO])) break; if (sp > XB_SPIN_CAP) { atomicAdd(&bar[XB_TMO], 1u); break; } }
    }
    nloc = mine > 0u ? mine : 1u; nx = cnt > 0u ? cnt : 1u;
}
DI void xcd_barrier(const XcdBarrier& b_in) {
    XcdBarrier b = b_in; { unsigned x_ = b.x; asm volatile("" : "+s"(x_)); b.x = x_; }
    asm volatile("s_waitcnt vmcnt(0)" ::: "memory");
    __syncthreads();
    if (threadIdx.x == 0) {
        unsigned* bar = b.bar;
        __builtin_amdgcn_s_waitcnt(0);
        unsigned nloc = b.st[0], nx = b.st[1];
        if (nloc == 0u) { xcd_barrier_complete(bar, b.x, nloc, nx); b.st[0] = nloc; b.st[1] = nx; }
        const unsigned old = xb_add(&bar[XB_XSUB(b.x)], 1u);
        const unsigned gen = old / nloc;
        if (old + 1u == (gen + 1u) * nloc) {
            __builtin_amdgcn_fence(__ATOMIC_RELEASE, "agent");
            asm volatile("s_waitcnt vmcnt(0)" ::: "memory");
            const unsigned og = xb_add(&bar[XB_TOP], 1u);
            const unsigned tg = og / nx;
            if (og + 1u == (tg + 1u) * nx) xb_add(&bar[XB_TOPGEN], 1u);
            else XB_SPIN(xb_ld(&bar[XB_TOPGEN]) == tg, bar);
            __builtin_amdgcn_fence(__ATOMIC_ACQUIRE, "agent");
            xb_add(&bar[XB_XGEN(b.x)], 1u);
            asm volatile("s_waitcnt vmcnt(0)" ::: "memory");
        } else {
            XB_SPIN(xb_ld(&bar[XB_XGEN(b.x)]) == gen, bar);
            __builtin_amdgcn_fence(__ATOMIC_ACQUIRE, "agent");
            asm volatile("s_waitcnt vmcnt(0)" ::: "memory");
        }
    }
    __syncthreads();
}

struct Args { const float* in[21]; float* out; unsigned char* ws; int it_lo, it_hi, ph_lo, ph_hi; };
enum { I_X = 0, I_NMG, I_WIN, I_BG, I_CW, I_CB, I_GB, I_MNG, I_KVNG, I_WKV, I_SQG, I_SKG, I_DQG, I_DKG, I_LAM, I_DOG, I_WBR, I_WOUT, I_NFG, I_WGU, I_WD };

struct Frame {
    LAS unsigned char* lds;
    unsigned char* ws;
    int tid, lane, wave, G, bid;
    int wave0;
    DI void refresh() {
        int l_; asm volatile("v_mbcnt_lo_u32_b32 %0, -1, 0\n\tv_mbcnt_hi_u32_b32 %0, -1, %0" : "=v"(l_));
        unsigned char* w_ = ws; int g_ = G, b_ = bid, wv_ = wave0; asm volatile("" : "+s"(w_), "+s"(g_), "+s"(b_), "+s"(wv_));
        ws = w_; G = g_; bid = b_; lane = l_; wave = wv_; tid = wv_ * 64 + l_; }
};

DI int map_in(int n) {
    const int pn = n >> 8, p = n & 255, bj = p >> 7, wcq = p & 127, wc = wcq >> 5, q = wcq & 31;
    const int hd = 32 * bj + q;
    switch (pn) {
        case 0: case 1: case 2: case 3: return Z_MQK + n;
        case 4: case 5: return Z_MV + (n - 4 * 256);
        case 6: case 7: return Z_MO + (n - 6 * 256);
        case 8: case 9: return Z_SQ + (4 * (pn - 8) + wc) * 64 + hd;
        case 10: return Z_CKV + p;
        case 11: return Z_IQ + wc * 64 + hd;
        case 12: case 13: return Z_DQ + (4 * (pn - 12) + wc) * 64 + hd;
        case 14: case 15: return Z_DK + (4 * (pn - 14) + wc) * 64 + hd;
        case 16: case 17: return Z_DV + (n - 16 * 256);
        default:
            if (wc == 0) return Z_IK + hd;
            if (wc == 1 && bj == 0) { if (q < 8) return Z_MIF + q; if (q < 12) return Z_IW + (q - 8); }
            return -1;
    }
}
DI int map_kv(int n) {
    const int pn = n >> 8, p = n & 255, bj = p >> 7, wcq = p & 127, wc = wcq >> 5, q = wcq & 31;
    if (pn < 2) return (4 * pn + wc) * 64 + 32 * bj + q;
    return n;
}
DI int map_gu(int n) {
    const int pn = n >> 8, p = n & 255;
    return (p >> 7) * FF + 128 * pn + (p & 127);
}
template <int MAP>
DI void transpose_item(const float* W, int ldw, int cbase, const float* kscale, bf16_t* WT, int ldo, int koff, int nblk, LAS float* scr, int item, int lane) {
    const int kb = item / nblk, nb = item % nblk, k0 = 64 * kb, n0 = 32 * nb;
    const int n = n0 + (lane & 31);
    int src;
    if (MAP == 0) src = n; else if (MAP == 1) src = map_in(n); else if (MAP == 2) src = map_kv(n); else src = map_gu(n);
    float tv_[32];
    const int srcc = src >= 0 ? src : 0;
#pragma unroll
    for (int i = 0; i < 32; ++i) tv_[i] = W[(size_t)(k0 + 2 * i + (lane >> 5)) * ldw + cbase + srcc];
#pragma unroll
    for (int i = 0; i < 32; ++i) { const int kk = 2 * i + (lane >> 5);
        float v = src >= 0 ? tv_[i] : 0.f;
        if (kscale) v *= kscale[k0 + kk];
        scr[kk * 33 + (lane & 31)] = v; }
    WSYNC();
    const int c = lane & 7;
#pragma unroll
    for (int j = 0; j < 4; ++j) { const int nn = (lane >> 3) + 8 * j; const LAS float* s = scr + (8 * c) * 33 + nn;
        u32x4 o; o.x = pk2(s[0 * 33], s[1 * 33]); o.y = pk2(s[2 * 33], s[3 * 33]); o.z = pk2(s[4 * 33], s[5 * 33]); o.w = pk2(s[6 * 33], s[7 * 33]);
        *(u32x4*)(WT + (size_t)(n0 + nn) * ldo + koff + k0 + 8 * c) = o; }
    WSYNC();
}
__device__ const float INVF[32] = {1.000000000e+00f, 7.498942018e-01f, 5.623413324e-01f, 4.216965139e-01f, 3.162277639e-01f, 2.371373922e-01f, 1.778279394e-01f, 1.333521456e-01f,
    1.000000015e-01f, 7.498941571e-02f, 5.623412877e-02f, 4.216964915e-02f, 3.162277862e-02f, 2.371373586e-02f, 1.778279431e-02f, 1.333521493e-02f,
    9.999999776e-03f, 7.498942316e-03f, 5.623413250e-03f, 4.216964822e-03f, 3.162277862e-03f, 2.371373819e-03f, 1.778279431e-03f, 1.333521446e-03f,
    1.000000047e-03f, 7.498941850e-04f, 5.623413017e-04f, 4.216965463e-04f, 3.162277862e-04f, 2.371373848e-04f, 1.778279402e-04f, 1.333521504e-04f};
DI void sincos_acc(float angf, float& c, float& s) {
    const double x = (double)angf;
    const double kd = __builtin_rint(x * 0.63661977236758134308);
    const double r = (x - kd * 1.5707963267948965580) - kd * 6.1232339957367658860e-17;
    const double r2 = r * r;
    double sp = -1.0 / 39916800.0; sp = sp * r2 + 1.0 / 362880.0; sp = sp * r2 - 1.0 / 5040.0; sp = sp * r2 + 1.0 / 120.0; sp = sp * r2 - 1.0 / 6.0; sp = sp * r2 + 1.0; sp *= r;
    double cp = 1.0 / 479001600.0; cp = cp * r2 - 1.0 / 3628800.0; cp = cp * r2 + 1.0 / 40320.0; cp = cp * r2 - 1.0 / 720.0; cp = cp * r2 + 1.0 / 24.0; cp = cp * r2 - 0.5; cp = cp * r2 + 1.0;
    const int k = (int)kd & 3;
    double cc, ss;
    if (k == 0) { cc = cp; ss = sp; } else if (k == 1) { cc = -sp; ss = cp; } else if (k == 2) { cc = -cp; ss = -sp; } else { cc = sp; ss = -cp; }
    c = (float)cc; s = (float)ss;
}
DI void phase_prologue(Frame& F, const Args& a) {
    F.refresh();
    LAS float* scr = (LAS float*)(F.lds + F.wave * 16384);
    const int gw = F.bid * NWAVES + F.wave, NGW = F.G * NWAVES;
    float* COS = (float*)(F.ws + WS_COS); float* SIN = (float*)(F.ws + WS_SIN);
    for (int i = gw * 64 + F.lane; i < SEQ * 32; i += NGW * 64) { const int t = i >> 5, f = i & 31; float c, s; sincos_acc((float)t * INVF[f], c, s); COS[i] = c; SIN[i] = s; }
    if (gw == 0) { float* GN = (float*)(F.ws + WS_GAIN);
        for (int l = 0; l < DEPTH; ++l) { GN[(l * 4 + 0) * 64 + F.lane] = a.in[I_SQG][l * 64 + F.lane]; GN[(l * 4 + 1) * 64 + F.lane] = a.in[I_DQG][l * 64 + F.lane];
            GN[(l * 4 + 2) * 64 + F.lane] = a.in[I_DKG][l * 64 + F.lane]; GN[(l * 4 + 3) * 64 + F.lane] = a.in[I_SKG][l * 64 + F.lane]; } }
    for (int l = 0; l < DEPTH; ++l) {
        unsigned char* wl = F.ws + WS_W + (size_t)l * W_LAYER;
        const float* w_in = a.in[I_WIN] + (size_t)l * DM * IN_COLS;
        { const int nblk = NT_IN * 256 / 32, nit = (DM / 64) * nblk;
          for (int it = gw; it < nit; it += NGW) transpose_item<1>(w_in, IN_COLS, 0, nullptr, (bf16_t*)(wl + WO_IN), DM, 0, nblk, scr, it, F.lane); }
        { const int nblk = 3072 / 32, nit = (DM / 64) * nblk;
          for (int it = gw; it < nit; it += NGW) transpose_item<0>(w_in, IN_COLS, Z_G, nullptr, (bf16_t*)(wl + WO_G), DM, 0, nblk, scr, it, F.lane); }
        { const int nblk = 1024 / 32, nit = (256 / 64) * nblk;
          for (int it = gw; it < nit; it += NGW) transpose_item<2>(a.in[I_WKV] + (size_t)l * 256 * 1024, 1024, 0, a.in[I_KVNG] + l * 256, (bf16_t*)(wl + WO_KV), 256, 0, nblk, scr, it, F.lane); }
        for (int b = 0; b < 3; ++b) { const int nblk = 1024 / 32, nit = (512 / 64) * nblk;
          for (int it = gw; it < nit; it += NGW) transpose_item<0>(a.in[I_WBR] + ((size_t)l * 3 + b) * 512 * 1024, 1024, 0, nullptr, (bf16_t*)(wl + WO_BR), 1536, b * 512, nblk, scr, it, F.lane); }
        { const int nblk = 1024 / 32, nit = (1024 / 64) * nblk;
          for (int it = gw; it < nit; it += NGW) transpose_item<0>(a.in[I_WOUT] + (size_t)l * 1024 * 1024, 1024, 0, nullptr, (bf16_t*)(wl + WO_OUT), 1024, 0, nblk, scr, it, F.lane); }
        { const int nblk = 5632 / 32, nit = (1024 / 64) * nblk;
          for (int it = gw; it < nit; it += NGW) transpose_item<3>(a.in[I_WGU] + (size_t)l * 1024 * 5632, 5632, 0, nullptr, (bf16_t*)(wl + WO_GU), 1024, 0, nblk, scr, it, F.lane); }
        { const int nblk = 1024 / 32, nit = (2816 / 64) * nblk;
          for (int it = gw; it < nit; it += NGW) transpose_item<0>(a.in[I_WD] + (size_t)l * 2816 * 1024, 1024, 0, nullptr, (bf16_t*)(wl + WO_D), 2816, 0, nblk, scr, it, F.lane); }
    }
}

DI void phase_rmsnorm(Frame& F, const void* xv, const bool src16, const float* gain, bf16_t* out) {
    F.refresh();
    const int gw = F.bid * NWAVES + F.wave, NGW = F.G * NWAVES;
    f32x4 gv[4];
#pragma unroll
    for (int j = 0; j < 4; ++j) gv[j] = *(const f32x4*)(gain + 4 * F.lane + 256 * j);
    for (int m = gw; m < MC; m += NGW) {
        f32x4 v[4]; float s = 0.f;
        if (src16) { const GAS u32x2* xr = (const GAS u32x2*)((const bf16_t*)xv + (size_t)m * DM) + F.lane;
#pragma unroll
            for (int j = 0; j < 4; ++j) { const u32x2 w = xr[64 * j]; v[j] = (f32x4){bflo(w.x), bfhi(w.x), bflo(w.y), bfhi(w.y)}; }
        } else { const GAS f32x4* xr = (const GAS f32x4*)((const float*)xv + (size_t)m * DM) + F.lane;
#pragma unroll
            for (int j = 0; j < 4; ++j) v[j] = xr[64 * j]; }
#pragma unroll
        for (int j = 0; j < 4; ++j) s += (v[j].x * v[j].x + v[j].y * v[j].y) + (v[j].z * v[j].z + v[j].w * v[j].w);
        const float r = 1.0f / sqrtf(wave_sum(s) * (1.f / DM) + EPS);
        u32x2* o8 = (u32x2*)(out + (size_t)m * DM) + F.lane;
#pragma unroll
        for (int j = 0; j < 4; ++j) { u32x2 w; w.x = cvtpk_(v[j].x * r * gv[j].x, v[j].y * r * gv[j].y); w.y = cvtpk_(v[j].z * r * gv[j].z, v[j].w * r * gv[j].w); o8[64 * j] = w; }
    }
}
DI float log_sigmoid(float x) {
    const float ax = fabsf(x), y = fexp(-ax);
    float l1p;
    if (y < 0.06f) l1p = y * (1.f - y * (0.5f - y * (0.33333333f - y * (0.25f - y * 0.2f))));
    else l1p = __builtin_amdgcn_logf(1.f + y) * 0.69314718056f;
    return fminf(x, 0.f) - l1p;
}
DI void phase_token(Frame& F, const Args& a, int l, const int probe) {
    F.refresh();
    const int gw0 = F.bid * NWAVES + F.wave, NGW = F.G * NWAVES, NSC = CB * 4, NCV = NGW - NSC;
    const bool scanw = (F.wave == NWAVES - 1) && (F.bid < NSC);
    const int gw = scanw ? NCV : gw0 - ((gw0 >> 3) < NSC ? (gw0 >> 3) : NSC);
    if (!scanw) { if (probe != 2) {
    const bf16_t* QKRAW = (const bf16_t*)(F.ws + WS_QKRAW); bf16_t* QK = (bf16_t*)(F.ws + WS_QK);
    const bf16_t* CKV = (const bf16_t*)(F.ws + WS_CKV); float* RT = (float*)(F.ws + WS_RT);
    const float* cw = a.in[I_CW] + (size_t)l * 4 * 1024; const float* cb = a.in[I_CB] + (size_t)l * 1024;
    const int c0 = F.lane * 16;
    float w[4][16], bs[16];
#pragma unroll
    for (int j = 0; j < 4; ++j)
#pragma unroll
        for (int i = 0; i < 16; ++i) w[j][i] = cw[j * 1024 + c0 + i];
#pragma unroll
    for (int i = 0; i < 16; ++i) bs[i] = cb[c0 + i];
    const float ksc = (c0 >= 512) ? 0.08838834764831845f : 1.0f;
    for (int m = gw; m < MC; m += NCV) {
        const int t = m & (SEQ - 1);
        float accv[16];
#pragma unroll
        for (int i = 0; i < 16; ++i) accv[i] = bs[i];
        u32x4 tv[4][2];
#pragma unroll
        for (int j = 0; j < 4; ++j) { const int tt = t - 3 + j; const u32x4* p = (const u32x4*)(QKRAW + (size_t)(tt >= 0 ? m - 3 + j : m) * 1024 + c0); tv[j][0] = p[0]; tv[j][1] = p[1]; }
        const u32x2 ckv4 = *(const u32x2*)(CKV + (size_t)m * 256 + 4 * F.lane);
#pragma unroll
        for (int j = 0; j < 4; ++j) { const float on = (t - 3 + j >= 0) ? 1.f : 0.f;
            const unsigned ww[8] = {tv[j][0].x, tv[j][0].y, tv[j][0].z, tv[j][0].w, tv[j][1].x, tv[j][1].y, tv[j][1].z, tv[j][1].w};
#pragma unroll
            for (int i = 0; i < 8; ++i) { accv[2 * i] += on * w[j][2 * i] * bflo(ww[i]); accv[2 * i + 1] += on * w[j][2 * i + 1] * bfhi(ww[i]); } }
        unsigned o[8];
#pragma unroll
        for (int i = 0; i < 8; ++i) { const float x0 = accv[2 * i], x1 = accv[2 * i + 1]; o[i] = pk2(x0 * sigmoidf_(x0) * ksc, x1 * sigmoidf_(x1) * ksc); }
        u32x4* q = (u32x4*)(QK + (size_t)m * 1024 + c0); q[0] = (u32x4){o[0], o[1], o[2], o[3]}; q[1] = (u32x4){o[4], o[5], o[6], o[7]};
        { const u32x2 v = ckv4; const float a0 = bflo(v.x), a1 = bfhi(v.x), a2 = bflo(v.y), a3 = bfhi(v.y);
          const float ss = wave_sum((a0 * a0 + a1 * a1) + (a2 * a2 + a3 * a3)); if (F.lane == 0) RT[m] = 1.0f / sqrtf(ss * (1.f / 256.f) + EPS); }
    }
    } } else if (probe != 1) {
        const int sq = F.bid, b = sq >> 2, h = sq & 3, lane = F.lane; const float* IFb = (const float*)(F.ws + WS_IF) + (size_t)b * SEQ * 8;
        float* AK = (float*)(F.ws + WS_AK) + (size_t)sq * SEQ; float* MQ = (float*)(F.ws + WS_MQ) + (size_t)sq * SEQ; float* EM = (float*)(F.ws + WS_EM) + (size_t)sq * SEQ;
        LAS float* X0 = (LAS float*)F.lds; LAS float* X1 = X0 + 4160; LAS float* X2 = X1 + 4160;
#pragma unroll 1
        for (int c = 0; c < 4; ++c) { float fv[16], iv[16];
#pragma unroll
            for (int kk = 0; kk < 16; ++kk) { const size_t t = (size_t)64 * (16 * c + kk) + lane; fv[kk] = *(const GAS float*)(IFb + t * 8 + 4 + h); iv[kk] = *(const GAS float*)(IFb + t * 8 + h); }
#pragma unroll
            for (int kk = 0; kk < 16; ++kk) { const int t = 64 * (16 * c + kk) + lane; X0[t + (t >> 6)] = fv[kk]; X1[t + (t >> 6)] = iv[kk]; } }
        WSYNC();
        const int tb = 65 * lane;
        double sum = 0.0;
#pragma unroll 8
        for (int j = 0; j < 64; ++j) { const float lf = log_sigmoid(X0[tb + j]); X0[tb + j] = lf; sum += (double)lf; }
        double inc = sum;
#pragma unroll
        for (int o = 1; o < 64; o <<= 1) { const double y = shup_d(inc, o, lane); if (lane >= o) inc += y; }
        double bb = inc - sum; float mx = -INFINITY;
#pragma unroll 8
        for (int j = 0; j < 64; ++j) { bb += (double)X0[tb + j]; const float av = (float)((double)X1[tb + j] - bb); X1[tb + j] = av; X0[tb + j] = (float)bb; mx = fmaxf(mx, av); }
        float minc = mx;
#pragma unroll
        for (int o = 1; o < 64; o <<= 1) { const float y = shup_f(minc, o, lane); if (lane >= o) minc = fmaxf(minc, y); }
        float mrun = shup_f(minc, 1, lane); if (lane == 0) mrun = -INFINITY;
#pragma unroll 8
        for (int j = 0; j < 64; ++j) { mrun = fmaxf(mrun, X1[tb + j]); X2[tb + j] = mrun; X0[tb + j] = fexp(-(X0[tb + j] + mrun)); }
        WSYNC();
#pragma unroll 8
        for (int k = 0; k < 64; ++k) { const int t = 64 * k + lane, ix = t + k; AK[t] = X1[ix]; MQ[t] = X2[ix]; EM[t] = X0[ix]; }
    }
}

DI void store8(bf16_t* p, f32x4 v0, f32x4 v1) { u32x4 w; w.x = cvtpk_(v0[0], v0[1]); w.y = cvtpk_(v0[2], v0[3]); w.z = cvtpk_(v1[0], v1[1]); w.w = cvtpk_(v1[2], v1[3]); *(u32x4*)p = w; }
DI void head_norm_rope(f32x4 (&x)[2][2], bool norm, const f32x4 (&gn)[2][2], const float* cosr, const float* sinr, int fq, float scale) {
    if (norm) {
        float ss = 0.f;
#pragma unroll
        for (int bj = 0; bj < 2; ++bj)
#pragma unroll
            for (int n = 0; n < 2; ++n) ss += (x[bj][n][0] * x[bj][n][0] + x[bj][n][1] * x[bj][n][1]) + (x[bj][n][2] * x[bj][n][2] + x[bj][n][3] * x[bj][n][3]);
        ss = sum16x(ss); ss = sum32x(ss);
        const float r = 1.0f / sqrtf(ss * (1.f / 64.f) + EPS);
#pragma unroll
        for (int bj = 0; bj < 2; ++bj)
#pragma unroll
            for (int n = 0; n < 2; ++n) x[bj][n] = x[bj][n] * r * gn[bj][n];
    }
#pragma unroll
    for (int n = 0; n < 2; ++n) { const f32x4 c = *(const f32x4*)(cosr + 8 * fq + 4 * n), s = *(const f32x4*)(sinr + 8 * fq + 4 * n);
        const f32x4 x1 = x[0][n], x2 = x[1][n]; x[0][n] = (x1 * c - x2 * s) * scale; x[1][n] = (x1 * s + x2 * c) * scale; }
}
DI void head_norm_rope_cs(f32x4 (&x)[2][2], bool norm, const f32x4 (&gn)[2][2], const f32x4 (&c)[2], const f32x4 (&sn)[2], float scale) {
    if (norm) {
        float ss = 0.f;
#pragma unroll
        for (int bj = 0; bj < 2; ++bj)
#pragma unroll
            for (int n = 0; n < 2; ++n) ss += (x[bj][n][0] * x[bj][n][0] + x[bj][n][1] * x[bj][n][1]) + (x[bj][n][2] * x[bj][n][2] + x[bj][n][3] * x[bj][n][3]);
        ss = sum16x(ss); ss = sum32x(ss);
        const float r = 1.0f / sqrtf(ss * (1.f / 64.f) + EPS);
#pragma unroll
        for (int bj = 0; bj < 2; ++bj)
#pragma unroll
            for (int n = 0; n < 2; ++n) x[bj][n] = x[bj][n] * r * gn[bj][n];
    }
#pragma unroll
    for (int n = 0; n < 2; ++n) { const f32x4 x1 = x[0][n], x2 = x[1][n]; x[0][n] = (x1 * c[n] - x2 * sn[n]) * scale; x[1][n] = (x1 * sn[n] + x2 * c[n]) * scale; }
}
struct EpiInProj {
    static constexpr bool PERM = true, MIDK = false, INIT = false;
    unsigned char* ws; const float* gate_b; int layer;
    DI void operator()(const f32x4 (&acc)[2][2][4][2], const pg8::Unit& u, int wr, int wc, int fr, int fq) const {
        const int pn = u.pn; const int rowb = u.pm * 256 + wr * 64 + fr;
        if (pn < 8 || pn == 10 || pn == 16 || pn == 17) {
            size_t doff; int ldc, cb; bool sg = false;
            if (pn < 4) { doff = WS_QKRAW; ldc = 1024; cb = pn * 256; }
            else if (pn < 6) { doff = WS_VM; ldc = 512; cb = (pn - 4) * 256; }
            else if (pn < 8) { doff = WS_OM; ldc = 512; cb = (pn - 6) * 256; sg = true; }
            else if (pn == 10) { doff = WS_CKV; ldc = 256; cb = 0; }
            else { doff = WS_DV; ldc = 512; cb = (pn - 16) * 256; }
            bf16_t* dst = (bf16_t*)(ws + doff);
#pragma unroll
            for (int ai = 0; ai < 2; ++ai)
#pragma unroll
                for (int m = 0; m < 4; ++m) { bf16_t* rowp = dst + (size_t)(rowb + ai * 128 + m * 16) * ldc + cb + wc * 32 + 8 * fq;
#pragma unroll
                    for (int bj = 0; bj < 2; ++bj) { f32x4 v0 = acc[ai][bj][m][0], v1 = acc[ai][bj][m][1];
                        if (sg) {
#pragma unroll
                            for (int j = 0; j < 4; ++j) { v0[j] = sigmoidf_(v0[j]); v1[j] = sigmoidf_(v1[j]); } }
                        store8(rowp + bj * 128, v0, v1); } }
        } else if (pn == 18) {
            const float* COS = (const float*)(ws + WS_COS); const float* SIN = (const float*)(ws + WS_SIN);
            if (wc == 0) {
                bf16_t* dst = (bf16_t*)(ws + WS_IK); f32x4 gn[2][2];
#pragma unroll
                for (int bj = 0; bj < 2; ++bj)
#pragma unroll
                    for (int n = 0; n < 2; ++n) gn[bj][n] = (f32x4){1.f, 1.f, 1.f, 1.f};
#pragma unroll
                for (int ai = 0; ai < 2; ++ai)
#pragma unroll
                    for (int m = 0; m < 4; ++m) { const int row = rowb + ai * 128 + m * 16, t = row & (SEQ - 1);
                        f32x4 x[2][2] = {{acc[ai][0][m][0], acc[ai][0][m][1]}, {acc[ai][1][m][0], acc[ai][1][m][1]}};
                        head_norm_rope(x, false, gn, COS + t * 32, SIN + t * 32, fq, 1.0f);
#pragma unroll
                        for (int bj = 0; bj < 2; ++bj) store8(dst + (size_t)row * 64 + 32 * bj + 8 * fq, x[bj][0], x[bj][1]);
                        asm volatile("" ::: "memory"); }
            } else if (wc == 1) {
                float* IFp = (float*)(ws + WS_IF); float* IWp = (float*)(ws + WS_IW);
#pragma unroll
                for (int ai = 0; ai < 2; ++ai)
#pragma unroll
                    for (int m = 0; m < 4; ++m) { const int row = rowb + ai * 128 + m * 16;
                        if (fq == 0) { *(f32x4*)(IFp + (size_t)row * 8) = acc[ai][0][m][0] + *(const f32x4*)gate_b; *(f32x4*)(IFp + (size_t)row * 8 + 4) = acc[ai][0][m][1] + *(const f32x4*)(gate_b + 4); }
                        else if (fq == 1) { *(f32x4*)(IWp + (size_t)row * 4) = acc[ai][0][m][0] * 0.0625f; } }
            }
        } else {
            const float* COS = (const float*)(ws + WS_COS); const float* SIN = (const float*)(ws + WS_SIN);
            size_t doff; int gi, pn0; float scale; bool norm = true; int ldc = 512;
            if (pn < 10) { doff = WS_SQ; gi = 0; pn0 = 8; scale = C2; }
            else if (pn == 11) { doff = WS_IQ; gi = 0; pn0 = 11; scale = 1.f; norm = false; ldc = 256; }
            else if (pn < 14) { doff = WS_DQ; gi = 1; pn0 = 12; scale = C2; }
            else { doff = WS_DK; gi = 2; pn0 = 14; scale = 1.f; }
            bf16_t* dst = (bf16_t*)(ws + doff); const float* g = (const float*)(ws + WS_GAIN) + (layer * 4 + gi) * 64;
            f32x4 gn[2][2];
#pragma unroll
            for (int bj = 0; bj < 2; ++bj)
#pragma unroll
                for (int n = 0; n < 2; ++n) gn[bj][n] = *(const f32x4*)(g + 32 * bj + 8 * fq + 4 * n);
            const int head = 4 * (pn - pn0) + wc;
#pragma unroll
            for (int ai = 0; ai < 2; ++ai)
#pragma unroll
              for (int mp = 0; mp < 4; mp += 2) {
                f32x4 cc[2][2], sn[2][2];
#pragma unroll
                for (int m = 0; m < 2; ++m) { const int t = (rowb + ai * 128 + (mp + m) * 16) & (SEQ - 1);
#pragma unroll
                    for (int n = 0; n < 2; ++n) { cc[m][n] = *(const GAS f32x4*)(COS + t * 32 + 8 * fq + 4 * n); sn[m][n] = *(const GAS f32x4*)(SIN + t * 32 + 8 * fq + 4 * n); } }
#pragma unroll
                for (int m = 0; m < 2; ++m) { const int row = rowb + ai * 128 + (mp + m) * 16;
                    f32x4 x[2][2] = {{acc[ai][0][mp + m][0], acc[ai][0][mp + m][1]}, {acc[ai][1][mp + m][0], acc[ai][1][mp + m][1]}};
                    head_norm_rope_cs(x, norm, gn, cc[m], sn[m], scale);
#pragma unroll
                    for (int bj = 0; bj < 2; ++bj) store8(dst + (size_t)row * ldc + head * 64 + 32 * bj + 8 * fq, x[bj][0], x[bj][1]); }
                asm volatile("" ::: "memory");
              }
        }
    }
};
struct EpiKV {
    static constexpr bool PERM = true, MIDK = false, INIT = false;
    unsigned char* ws; int layer;
    DI void operator()(const f32x4 (&acc)[2][2][4][2], const pg8::Unit& u, int wr, int wc, int fr, int fq) const {
        const int pn = u.pn; const int rowb = u.pm * 256 + wr * 64 + fr; const float* RT = (const float*)(ws + WS_RT);
        if (pn >= 2) {
            bf16_t* dst = (bf16_t*)(ws + WS_SV);
#pragma unroll
            for (int ai = 0; ai < 2; ++ai)
#pragma unroll
                for (int m = 0; m < 4; ++m) { const int row = rowb + ai * 128 + m * 16; const float r = RT[row]; bf16_t* rowp = dst + (size_t)row * 512 + (pn - 2) * 256 + wc * 32 + 8 * fq;
#pragma unroll
                    for (int bj = 0; bj < 2; ++bj) store8(rowp + bj * 128, acc[ai][bj][m][0] * r, acc[ai][bj][m][1] * r); }
        } else {
            const float* COS = (const float*)(ws + WS_COS); const float* SIN = (const float*)(ws + WS_SIN);
            bf16_t* dst = (bf16_t*)(ws + WS_SK); f32x4 gn[2][2];
#pragma unroll
            for (int bj = 0; bj < 2; ++bj)
#pragma unroll
                for (int n = 0; n < 2; ++n) gn[bj][n] = *(const f32x4*)((const float*)(ws + WS_GAIN) + (layer * 4 + 3) * 64 + 32 * bj + 8 * fq + 4 * n);
            const int head = 4 * pn + wc;
#pragma unroll
            for (int ai = 0; ai < 2; ++ai)
#pragma unroll
              for (int mp = 0; mp < 4; mp += 2) {
                f32x4 cc[2][2], sn[2][2]; float rr[2];
#pragma unroll
                for (int m = 0; m < 2; ++m) { const int row = rowb + ai * 128 + (mp + m) * 16, t = row & (SEQ - 1); rr[m] = *(const GAS float*)(RT + row);
#pragma unroll
                    for (int n = 0; n < 2; ++n) { cc[m][n] = *(const GAS f32x4*)(COS + t * 32 + 8 * fq + 4 * n); sn[m][n] = *(const GAS f32x4*)(SIN + t * 32 + 8 * fq + 4 * n); } }
#pragma unroll
                for (int m = 0; m < 2; ++m) { const int row = rowb + ai * 128 + (mp + m) * 16; const float r = rr[m];
                    f32x4 x[2][2] = {{acc[ai][0][mp + m][0] * r, acc[ai][0][mp + m][1] * r}, {acc[ai][1][mp + m][0] * r, acc[ai][1][mp + m][1] * r}};
                    head_norm_rope_cs(x, true, gn, cc[m], sn[m], 1.0f);
#pragma unroll
                    for (int bj = 0; bj < 2; ++bj) store8(dst + (size_t)row * 512 + head * 64 + 32 * bj + 8 * fq, x[bj][0], x[bj][1]); }
                asm volatile("" ::: "memory");
              }
        }
    }
};
DI size_t gq_off(int pm, int png, int wave, int am, int lane) { return ((((size_t)pm * 12 + png) * 8 + wave) * 8 + am) * 1024 + (size_t)lane * 16; }
struct EpiGate {
    static constexpr bool PERM = true, MIDK = false, INIT = false;
    unsigned char* G; const float* bias;
    DI void operator()(const f32x4 (&acc)[2][2][4][2], const pg8::Unit& u, int wr, int wc, int fr, int fq) const {
        const int col0 = u.pn * 256 + wc * 32 + 8 * fq, wave = wr * 4 + wc, lane = fq * 16 + fr;
        f32x4 bv[2][2];
#pragma unroll
        for (int bj = 0; bj < 2; ++bj)
#pragma unroll
            for (int n = 0; n < 2; ++n) bv[bj][n] = *(const f32x4*)(bias + col0 + bj * 128 + 4 * n);
#pragma unroll
        for (int ai = 0; ai < 2; ++ai)
#pragma unroll
            for (int m = 0; m < 4; ++m) { unsigned w[4];
#pragma unroll
                for (int bj = 0; bj < 2; ++bj)
#pragma unroll
                    for (int n = 0; n < 2; ++n) { const f32x4 v = acc[ai][bj][m][n] + bv[bj][n]; unsigned q = 0u;
#pragma unroll
                        for (int j = 0; j < 4; ++j) q = __builtin_amdgcn_cvt_pk_u8_f32(sigmoidf_(v[j]) * 255.0f, j, q);
                        w[2 * bj + n] = q; }
                *(u32x4*)(G + gq_off(u.pm, u.pn, wave, ai * 4 + m, lane)) = (u32x4){w[0], w[1], w[2], w[3]}; }
    }
};
struct EpiMerge {
    static constexpr bool PERM = true, MIDK = true, INIT = false;
    const unsigned char* G; bf16_t* MG;
    DI static float ub(unsigned w, int k) { return (float)((w >> (8 * k)) & 0xFFu); }
    DI void mid(f32x4 (&acc)[2][2][4][2], const pg8::Unit& u, int t, int wr, int wc, int fr, int fq) const {
        const int seg = (t >> 3) - 1, wave = wr * 4 + wc, lane = fq * 16 + fr;
#pragma unroll
        for (int ai = 0; ai < 2; ++ai) {
            u32x4 ga[4], gb[4];
#pragma unroll
            for (int m = 0; m < 4; ++m) { ga[m] = *(const GAS u32x4*)(G + gq_off(u.pm, seg * 4 + u.pn, wave, ai * 4 + m, lane)); gb[m] = *(const GAS u32x4*)(G + gq_off(u.pm, (seg + 1) * 4 + u.pn, wave, ai * 4 + m, lane)); }
#pragma unroll
            for (int m = 0; m < 4; ++m) { const unsigned aw[4] = {ga[m].x, ga[m].y, ga[m].z, ga[m].w}, bw[4] = {gb[m].x, gb[m].y, gb[m].z, gb[m].w};
#pragma unroll
                for (int bj = 0; bj < 2; ++bj)
#pragma unroll
                    for (int n = 0; n < 2; ++n)
#pragma unroll
                        for (int j = 0; j < 4; ++j) acc[ai][bj][m][n][j] *= fmaxf(ub(aw[2 * bj + n], j), 1e-6f) * frcp(fmaxf(ub(bw[2 * bj + n], j), 1e-6f)); }
            asm volatile("" ::: "memory");
        }
    }
    DI void operator()(const f32x4 (&acc)[2][2][4][2], const pg8::Unit& u, int wr, int wc, int fr, int fq) const {
        const int rowb = u.pm * 256 + wr * 64 + fr, col0 = u.pn * 256 + wc * 32 + 8 * fq, wave = wr * 4 + wc, lane = fq * 16 + fr;
#pragma unroll
        for (int ai = 0; ai < 2; ++ai) {
            u32x4 gc[4];
#pragma unroll
            for (int m = 0; m < 4; ++m) gc[m] = *(const GAS u32x4*)(G + gq_off(u.pm, 8 + u.pn, wave, ai * 4 + m, lane));
#pragma unroll
            for (int m = 0; m < 4; ++m) { const unsigned cw[4] = {gc[m].x, gc[m].y, gc[m].z, gc[m].w};
#pragma unroll
                for (int bj = 0; bj < 2; ++bj) { f32x4 v0 = acc[ai][bj][m][0], v1 = acc[ai][bj][m][1];
#pragma unroll
                    for (int j = 0; j < 4; ++j) { v0[j] *= fmaxf(ub(cw[2 * bj], j), 1e-6f) * (1.0f / 255.0f); v1[j] *= fmaxf(ub(cw[2 * bj + 1], j), 1e-6f) * (1.0f / 255.0f); }
                    store8(MG + (size_t)(rowb + ai * 128 + m * 16) * 1024 + col0 + bj * 128, v0, v1); } }
            asm volatile("" ::: "memory");
        }
    }
};
struct EpiResid {
    static constexpr bool PERM = true, MIDK = false, INIT = true;
    const void* base; void* out; bool in16, out16;
    DI void init(f32x4 (&acc)[2][2][4][2], const pg8::Unit& u, int wr, int wc, int fr, int fq) const {
        const int rowb = u.pm * 256 + wr * 64 + fr, col0 = u.pn * 256 + wc * 32 + 8 * fq;
#pragma unroll
        for (int ai = 0; ai < 2; ++ai)
#pragma unroll
            for (int m = 0; m < 4; ++m) { const size_t off = (size_t)(rowb + ai * 128 + m * 16) * DM + col0;
#pragma unroll
                for (int bj = 0; bj < 2; ++bj) {
                    if (in16) { const u32x4 w = *(const GAS u32x4*)((const bf16_t*)base + off + bj * 128);
                        acc[ai][bj][m][0] = (f32x4){bflo(w.x), bfhi(w.x), bflo(w.y), bfhi(w.y)}; acc[ai][bj][m][1] = (f32x4){bflo(w.z), bfhi(w.z), bflo(w.w), bfhi(w.w)}; }
                    else { acc[ai][bj][m][0] = *(const GAS f32x4*)((const float*)base + off + bj * 128); acc[ai][bj][m][1] = *(const GAS f32x4*)((const float*)base + off + bj * 128 + 4); } } }
    }
    DI void operator()(const f32x4 (&acc)[2][2][4][2], const pg8::Unit& u, int wr, int wc, int fr, int fq) const {
        const int rowb = u.pm * 256 + wr * 64 + fr, col0 = u.pn * 256 + wc * 32 + 8 * fq;
#pragma unroll
        for (int ai = 0; ai < 2; ++ai)
#pragma unroll
            for (int m = 0; m < 4; ++m) { const size_t off = (size_t)(rowb + ai * 128 + m * 16) * DM + col0;
#pragma unroll
                for (int bj = 0; bj < 2; ++bj) {
                    if (out16) store8((bf16_t*)out + off + bj * 128, acc[ai][bj][m][0], acc[ai][bj][m][1]);
                    else { *(f32x4*)((float*)out + off + bj * 128) = acc[ai][bj][m][0]; *(f32x4*)((float*)out + off + bj * 128 + 4) = acc[ai][bj][m][1]; } } }
    }
};
struct EpiSwiGLU {
    static constexpr bool PERM = true, MIDK = false, INIT = false;
    bf16_t* H;
    DI void operator()(const f32x4 (&acc)[2][2][4][2], const pg8::Unit& u, int wr, int wc, int fr, int fq) const {
        const int rowb = u.pm * 256 + wr * 64 + fr, col0 = u.pn * 128 + wc * 32 + 8 * fq;
#pragma unroll
        for (int ai = 0; ai < 2; ++ai)
#pragma unroll
            for (int m = 0; m < 4; ++m) { f32x4 v0, v1;
#pragma unroll
                for (int j = 0; j < 4; ++j) { const float g0 = acc[ai][0][m][0][j], g1 = acc[ai][0][m][1][j]; v0[j] = g0 * sigmoidf_(g0) * acc[ai][1][m][0][j]; v1[j] = g1 * sigmoidf_(g1) * acc[ai][1][m][1][j]; }
                store8(H + (size_t)(rowb + ai * 128 + m * 16) * FF + col0, v0, v1); }
    }
};

DI unsigned mono_key(float f) { const unsigned u = __float_as_uint(f + 0.0f); return u ^ ((unsigned)((int)u >> 31) | 0x80000000u); }
DI unsigned pack_mask(unsigned long long bm, int h) {
    unsigned r = 0;
#pragma unroll
    for (int p = 0; p < 2; ++p)
#pragma unroll
        for (int g = 0; g < 4; ++g) r |= (unsigned)((bm >> (32 * p + 8 * g + 4 * h)) & 0xFull) << (16 * p + 4 * g);
    return r;
}
DI unsigned long long unpack_mask(unsigned w0, unsigned w1) {
    unsigned long long bm = 0;
#pragma unroll
    for (int p = 0; p < 2; ++p)
#pragma unroll
        for (int g = 0; g < 4; ++g) { bm |= (unsigned long long)((w0 >> (16 * p + 4 * g)) & 0xFu) << (32 * p + 8 * g); bm |= (unsigned long long)((w1 >> (16 * p + 4 * g)) & 0xFu) << (32 * p + 8 * g + 4); }
    return bm;
}
DI void ld8f(const bf16_t* p, float (&g)[8]) { const u32x4 w = *(const u32x4*)p; g[0] = bflo(w.x); g[1] = bfhi(w.x); g[2] = bflo(w.y); g[3] = bfhi(w.y); g[4] = bflo(w.z); g[5] = bfhi(w.z); g[6] = bflo(w.w); g[7] = bfhi(w.w); }

DI void naive_select(Frame& F) {
    F.refresh();
    if (F.wave >= 4) return;
    const int gw = F.bid * 4 + F.wave, NGW = F.G * 4;
    LAS unsigned char* wl = F.lds + F.wave * 20480;
    LAS float* sc = (LAS float*)wl; LAS float* iqf = (LAS float*)(wl + 16384); LAS unsigned* hist = (LAS unsigned*)(wl + 16384 + 1024);
    const bf16_t* IQ = (const bf16_t*)(F.ws + WS_IQ); const bf16_t* IK = (const bf16_t*)(F.ws + WS_IK); const float* IW = (const float*)(F.ws + WS_IW);
    unsigned* MASK = (unsigned*)(F.ws + WS_MASK);
    const int lane = F.lane;
    for (int row = gw; row < MC; row += NGW) {
        const int b = row >> 12, t = row & (SEQ - 1), n = t + 1;
        { const u32x2 v = *(const u32x2*)(IQ + (size_t)row * 256 + 4 * lane); iqf[4 * lane] = bflo(v.x); iqf[4 * lane + 1] = bfhi(v.x); iqf[4 * lane + 2] = bflo(v.y); iqf[4 * lane + 3] = bfhi(v.y); }
        const f32x4 wv = *(const f32x4*)(IW + (size_t)row * 4);
        WSYNC();
        for (int s = lane; s < n; s += 64) {
            const bf16_t* kr = IK + ((size_t)b * SEQ + s) * 64;
            float d0 = 0.f, d1 = 0.f, d2 = 0.f, d3 = 0.f;
#pragma unroll
            for (int c = 0; c < 8; ++c) { float kv[8]; ld8f(kr + 8 * c, kv);
#pragma unroll
                for (int j = 0; j < 8; ++j) { const float k = kv[j]; d0 += iqf[8 * c + j] * k; d1 += iqf[64 + 8 * c + j] * k; d2 += iqf[128 + 8 * c + j] * k; d3 += iqf[192 + 8 * c + j] * k; } }
            sc[s] = wv[0] * fmaxf(d0, 0.f) + wv[1] * fmaxf(d1, 0.f) + wv[2] * fmaxf(d2, 0.f) + wv[3] * fmaxf(d3, 0.f);
        }
        WSYNC();
        unsigned thr = 0u; int need = 256;
        if (n > 256) {
            unsigned prefix = 0u, pmask = 0u;
            for (int pass = 0; pass < 4; ++pass) {
                const int shift = 24 - 8 * pass;
                { unsigned z_ = 0u; asm volatile("" : "+v"(z_)); hist[lane] = z_; hist[lane + 64] = z_; hist[lane + 128] = z_; hist[lane + 192] = z_; }
                WSYNC();
                for (int s = lane; s < n; s += 64) { const unsigned key = mono_key(sc[s]); if ((key & pmask) == prefix) __hip_atomic_fetch_add(&hist[(key >> shift) & 255u], 1u, __ATOMIC_RELAXED, __HIP_MEMORY_SCOPE_WORKGROUP); }
                WSYNC();
                const unsigned c0 = hist[4 * lane], c1 = hist[4 * lane + 1], c2 = hist[4 * lane + 2], c3 = hist[4 * lane + 3];
                const unsigned ls = c0 + c1 + c2 + c3; unsigned inc = ls;
#pragma unroll
                for (int o = 1; o < 64; o <<= 1) { const unsigned y = __shfl_up(inc, o); if (lane >= o) inc += y; }
                const unsigned total = __shfl(inc, 63);
                unsigned cum = total - inc;
                int fbin = -1; unsigned fneed = 0u;
                const unsigned cc[4] = {c0, c1, c2, c3};
#pragma unroll
                for (int bq = 3; bq >= 0; --bq) { if (fbin < 0 && cum < (unsigned)need && cum + cc[bq] >= (unsigned)need) { fbin = 4 * lane + bq; fneed = (unsigned)need - cum; } cum += cc[bq]; }
                const unsigned long long fm = __ballot(fbin >= 0);
                const int src = __ffsll((long long)fm) - 1;
                const int bin = __shfl(fbin, src); need = (int)__shfl(fneed, src);
                prefix |= (unsigned)bin << shift; pmask |= 0xFFu << shift;
                WSYNC();
            }
            thr = prefix;
        }
        int eqc = 0;
        for (int i = 0; i < 64; ++i) {
            const int s = 64 * i + lane; bool sel = false;
            if (64 * i < n) {
                const bool valid = s < n;
                if (n <= 256) sel = valid;
                else { const unsigned key = valid ? mono_key(sc[s]) : 0u; const bool eq = valid && key == thr; const unsigned long long em = __ballot(eq);
                    const int rank = eqc + __popcll(em & ((1ull << lane) - 1ull)); sel = valid && (key > thr || (eq && rank < need)); eqc += __popcll(em); }
            }
            const unsigned long long bm = __ballot(sel);
            if (lane == 0) { MASK[((size_t)row * 2 + 0) * 64 + i] = pack_mask(bm, 0); MASK[((size_t)row * 2 + 1) * 64 + i] = pack_mask(bm, 1); }
        }
        WSYNC();
    }
}
DI void naive_dsa(Frame& F) {
    F.refresh();
    if (F.wave >= 4) return;
    const int gw = F.bid * 4 + F.wave, NGW = F.G * 4;
    LAS unsigned char* wl = F.lds + F.wave * 20480;
    LAS float* sc = (LAS float*)wl;
    LAS float* sqf = (LAS float*)(wl + 8192);
    LAS unsigned* list = (LAS unsigned*)(wl + 8192 + 2048);
    LAS float* invs = (LAS float*)(wl + 8192 + 2048 + 2048);
    const bf16_t* SQ = (const bf16_t*)(F.ws + WS_SQ); const bf16_t* SK = (const bf16_t*)(F.ws + WS_SK); const bf16_t* SV = (const bf16_t*)(F.ws + WS_SV);
    const unsigned* MASK = (const unsigned*)(F.ws + WS_MASK); bf16_t* Y = (bf16_t*)(F.ws + WS_Y);
    const int lane = F.lane;
    for (int row = gw; row < MC; row += NGW) {
        const int b = row >> 12, t = row & (SEQ - 1);
        { float q[8]; ld8f(SQ + (size_t)row * 512 + 8 * lane, q);
#pragma unroll
          for (int j = 0; j < 8; ++j) sqf[8 * lane + j] = q[j]; }
        int nsel = 0;
        for (int i = 0; i <= (t >> 6); ++i) {
            const unsigned w0 = MASK[((size_t)row * 2 + 0) * 64 + i], w1 = MASK[((size_t)row * 2 + 1) * 64 + i];
            const unsigned long long bm = unpack_mask(w0, w1);
            const bool sel = (bm >> lane) & 1ull;
            const int pos = nsel + __popcll(bm & ((1ull << lane) - 1ull));
            if (sel && pos < 256) list[pos] = (unsigned)(64 * i + lane);
            nsel += __popcll(bm);
        }
        if (nsel > 256) nsel = 256;
        WSYNC();
        for (int k = lane; k < nsel; k += 64) {
            const bf16_t* kr = SK + ((size_t)b * SEQ + list[k]) * 512;
#pragma unroll 1
            for (int h = 0; h < 8; ++h) { float d = 0.f;
#pragma unroll
                for (int c = 0; c < 8; ++c) { float kv[8]; ld8f(kr + h * 64 + 8 * c, kv);
#pragma unroll
                    for (int j = 0; j < 8; ++j) d += sqf[h * 64 + 8 * c + j] * kv[j]; }
                sc[h * 256 + k] = d; }
        }
        WSYNC();
#pragma unroll 1
        for (int h = 0; h < 8; ++h) {
            float mx = -INFINITY; for (int k = lane; k < nsel; k += 64) mx = fmaxf(mx, sc[h * 256 + k]);
            mx = wave_max(mx); float sum = 0.f;
            for (int k = lane; k < nsel; k += 64) { const float p = fexp2(sc[h * 256 + k] - mx); sc[h * 256 + k] = p; sum += p; }
            sum = wave_sum(sum); if (lane == 0) invs[h] = 1.0f / sum;
        }
        WSYNC();
        { const int h = lane >> 3, d0 = (lane & 7) * 8; float accv[8] = {0.f, 0.f, 0.f, 0.f, 0.f, 0.f, 0.f, 0.f};
          for (int k = 0; k < nsel; ++k) { const float p = sc[h * 256 + k]; float v[8]; ld8f(SV + ((size_t)b * SEQ + list[k]) * 512 + h * 64 + d0, v);
#pragma unroll
              for (int j = 0; j < 8; ++j) accv[j] += p * v[j]; }
          const float inv = invs[h];
          u32x4 o; o.x = pk2(accv[0] * inv, accv[1] * inv); o.y = pk2(accv[2] * inv, accv[3] * inv); o.z = pk2(accv[4] * inv, accv[5] * inv); o.w = pk2(accv[6] * inv, accv[7] * inv);
          *(u32x4*)(Y + (size_t)row * 1536 + 512 + h * 64 + d0) = o; }
        WSYNC();
    }
}
DI void naive_mlstm(Frame& F, const Args& a, int l) {
    F.refresh();
    const int gw = F.bid * NWAVES + F.wave, NGW = F.G * NWAVES;
    LAS unsigned char* wl = F.lds + F.wave * 16384;
    LAS float* pl = (LAS float*)wl;
    const bf16_t* QK = (const bf16_t*)(F.ws + WS_QK); const bf16_t* VM = (const bf16_t*)(F.ws + WS_VM); const bf16_t* OM = (const bf16_t*)(F.ws + WS_OM);
    const float* AK = (const float*)(F.ws + WS_AK); const float* MQ = (const float*)(F.ws + WS_MQ); const float* EM = (const float*)(F.ws + WS_EM);
    bf16_t* Y = (bf16_t*)(F.ws + WS_Y); const float* mng = a.in[I_MNG] + (size_t)l * 512;
    const int lane = F.lane;
    for (int qi = gw; qi < MC * 4; qi += NGW) {
        const int row = qi >> 2, h = qi & 3, b = row >> 12, t = row & (SEQ - 1), seq = b * 4 + h;
        const unsigned qw = *(const unsigned*)(QK + (size_t)row * 1024 + h * 128 + 2 * lane);
        const float q0 = bflo(qw), q1 = bfhi(qw);
        const float Mt = MQ[(size_t)seq * SEQ + t];
        float denp = 0.f;
        for (int s0 = 0; s0 <= t; s0 += 64) {
            const int s = s0 + lane; const bool valid = s <= t; const int sr = valid ? s : t;
            const bf16_t* kr = QK + ((size_t)b * SEQ + sr) * 1024 + 512 + h * 128;
            float d = 0.f;
#pragma unroll 4
            for (int c = 0; c < 16; ++c) { float kv[8]; ld8f(kr + 8 * c, kv);
#pragma unroll
                for (int j = 0; j < 4; ++j) { d += __shfl(q0, 4 * c + j) * kv[2 * j] + __shfl(q1, 4 * c + j) * kv[2 * j + 1]; } }
            const float p = valid ? d * fexp(AK[(size_t)seq * SEQ + sr] - Mt) : 0.f;
            pl[s] = p;
            denp += p;
        }
        const float den = wave_sum(denp);
        WSYNC();
        float a0 = 0.f, a1 = 0.f;
        for (int s = 0; s <= t; ++s) { const float p = pl[s]; const unsigned vw = *(const unsigned*)(VM + ((size_t)b * SEQ + s) * 512 + h * 128 + 2 * lane); a0 += p * bflo(vw); a1 += p * bfhi(vw); }
        const float hd = fmaxf(fabsf(den), EM[(size_t)seq * SEQ + t]);
        a0 /= hd; a1 /= hd;
        const float ss = wave_sum(a0 * a0 + a1 * a1); const float r = 1.0f / sqrtf(ss * (1.f / 128.f) + EPS);
        const unsigned ow = *(const unsigned*)(OM + (size_t)row * 512 + h * 128 + 2 * lane);
        const float y0 = a0 * r * mng[h * 128 + 2 * lane] * bflo(ow), y1 = a1 * r * mng[h * 128 + 2 * lane + 1] * bfhi(ow);
        *(unsigned*)(Y + (size_t)row * 1536 + h * 128 + 2 * lane) = pk2(y0, y1);
        WSYNC();
    }
}
DI void naive_diff(Frame& F, const Args& a, int l) {
    F.refresh();
    if (F.wave >= 4) return;
    const int gw = F.bid * 4 + F.wave, NGW = F.G * 4;
    LAS unsigned char* wl = F.lds + F.wave * 32768;
    LAS float* p0 = (LAS float*)wl; LAS float* p1 = (LAS float*)(wl + 16384);
    const bf16_t* DQ = (const bf16_t*)(F.ws + WS_DQ); const bf16_t* DK = (const bf16_t*)(F.ws + WS_DK); const bf16_t* DV = (const bf16_t*)(F.ws + WS_DV);
    bf16_t* Y = (bf16_t*)(F.ws + WS_Y); const float* dog = a.in[I_DOG] + (size_t)l * 128; const float* lam = a.in[I_LAM] + (size_t)l * 256;
    const int lane = F.lane;
    const float lam_init = (l == 0) ? 0.2f : 0.35550906759096934f;
    const float s01 = wave_sum(lam[lane] * lam[64 + lane]), s23 = wave_sum(lam[128 + lane] * lam[192 + lane]);
    const float lam_val = fexp(s01) - fexp(s23) + lam_init;
    for (int qi = gw; qi < MC * 4; qi += NGW) {
        const int row = qi >> 2, h = qi & 3, b = row >> 12, t = row & (SEQ - 1);
        const float qa = bf2f(DQ[(size_t)row * 512 + (2 * h) * 64 + lane]), qb = bf2f(DQ[(size_t)row * 512 + (2 * h + 1) * 64 + lane]);
        float mx0 = -INFINITY, mx1 = -INFINITY;
        for (int s0 = 0; s0 <= t; s0 += 64) {
            const int s = s0 + lane; const bool valid = s <= t; const int sr = valid ? s : t;
            const bf16_t* kr = DK + ((size_t)b * SEQ + sr) * 512 + (2 * h) * 64;
            float d0 = 0.f, d1 = 0.f;
#pragma unroll 4
            for (int c = 0; c < 8; ++c) { float ka[8], kb[8]; ld8f(kr + 8 * c, ka); ld8f(kr + 64 + 8 * c, kb);
#pragma unroll
                for (int j = 0; j < 8; ++j) { d0 += __shfl(qa, 8 * c + j) * ka[j]; d1 += __shfl(qb, 8 * c + j) * kb[j]; } }
            if (valid) { p0[s] = d0; p1[s] = d1; mx0 = fmaxf(mx0, d0); mx1 = fmaxf(mx1, d1); }
        }
        mx0 = wave_max(mx0); mx1 = wave_max(mx1);
        WSYNC();
        float sm0 = 0.f, sm1 = 0.f;
        for (int s = lane; s <= t; s += 64) { const float e0 = fexp2(p0[s] - mx0), e1 = fexp2(p1[s] - mx1); p0[s] = e0; p1[s] = e1; sm0 += e0; sm1 += e1; }
        const float i0 = 1.0f / wave_sum(sm0), i1 = lam_val / wave_sum(sm1);
        WSYNC();
        float a0 = 0.f, a1 = 0.f;
        for (int s = 0; s <= t; ++s) { const float av = p0[s] * i0 - p1[s] * i1; const unsigned vw = *(const unsigned*)(DV + ((size_t)b * SEQ + s) * 512 + h * 128 + 2 * lane); a0 += av * bflo(vw); a1 += av * bfhi(vw); }
        const float ss = wave_sum(a0 * a0 + a1 * a1); const float r = 1.0f / sqrtf(ss * (1.f / 128.f) + EPS) * (1.0f - lam_init);
        *(unsigned*)(Y + (size_t)row * 1536 + 1024 + h * 128 + 2 * lane) = pk2(a0 * r * dog[2 * lane], a1 * r * dog[2 * lane + 1]);
        WSYNC();
    }
}

typedef float f32x16 __attribute__((ext_vector_type(16)));
typedef short s16x4 __attribute__((ext_vector_type(4)));
typedef __bf16 bf16x2_t __attribute__((ext_vector_type(2)));
DI unsigned cvtpk(float lo, float hi) { f32x2 v = {lo, hi}; bf16x2_t b = __builtin_convertvector(v, bf16x2_t); return __builtin_bit_cast(unsigned, b); }
#define MFMA32(a, b, c) __builtin_amdgcn_mfma_f32_32x32x16_bf16((a), (b), (c), 0, 0, 0)
DI s16x4 trread(LAS const unsigned char* p) { return __builtin_bit_cast(s16x4, __builtin_amdgcn_ds_read_tr16_b64_v4i16((LAS s16x4*)p)); }
#ifndef MIXMODES
#define MIXMODES 7
#endif
constexpr int CW_QUEUE = 8192;
constexpr int ATT_WSF_OFF = RING_BYTES + 1024;
constexpr float NEGBIG = -1.0e30f;
constexpr float RESC_THR = 16.0f;

DI float max3f(float a, float b, float c) { float r_; asm("v_max3_f32 %0, %1, %2, %3" : "=v"(r_) : "v"(a), "v"(b), "v"(c)); return r_; }
template <int MODE>
DI void attn_qk(f32x16& s0, f32x16& s1, const bf16x8 (&qf)[MODE == 2 ? 8 : 4], LAS const unsigned char* kb, int koff, int j, int q0w, int r, int h, unsigned mw, const bool DIAG) {
    constexpr int KW = MODE == 0 ? 64 : 128, DQK = MODE == 2 ? 128 : 64, DV = MODE == 0 ? 64 : 128, KROWB = KW * 2 + 16, VROWB = MODE == 0 ? 192 : 320, KBYTES = 64 * KROWB, VBYTES = 64 * VROWB;
    constexpr int NKS = DQK / 16, NVB = DV / 32;
    (void)KBYTES; (void)VBYTES; (void)NVB;
    if (MODE == 0) {
        const unsigned nmw = ~mw;
#pragma unroll
        for (int i = 0; i < 16; ++i) { s0[i] = __uint_as_float((unsigned)((int)(nmw << (31 - i)) >> 31) & 0xF149F2CAu); s1[i] = __uint_as_float((unsigned)((int)(nmw << (15 - i)) >> 31) & 0xF149F2CAu); }
    } else if (MODE == 1 && DIAG) {
        const int qd = q0w + r - 64 * j;
#pragma unroll
        for (int i = 0; i < 16; ++i) { const int kk = (i & 3) + 8 * (i >> 2) + 4 * h; s0[i] = kk > qd ? NEGBIG : 0.f; s1[i] = kk + 32 > qd ? NEGBIG : 0.f; }
    } else {
#pragma unroll
        for (int i = 0; i < 16; ++i) { s0[i] = 0.f; s1[i] = 0.f; }
    }
#pragma unroll
    for (int s = 0; s < NKS; ++s) {
        const bf16x8 k0 = *(LAS const bf16x8*)(kb + koff + 32 * s);
        const bf16x8 k1 = *(LAS const bf16x8*)(kb + koff + 32 * KROWB + 32 * s);
        s0 = MFMA32(k0, qf[s], s0); s1 = MFMA32(k1, qf[s], s1);
    }
}
template <int MODE>
DI void attn_pv(f32x16 (&o)[MODE == 0 ? 2 : 4], float& lsum, float& mref, f32x16& s0, f32x16& s1, LAS const unsigned char* vb, int voff,
                int j, int q0w, int r, int h, float M2, LAS float* wsf, const bool DIAG, const int probe) {
    constexpr int DV = MODE == 0 ? 64 : 128, VROWB = MODE == 0 ? 192 : 320, VBYTES = 64 * VROWB;
    constexpr int NVB = DV / 32;
    LAS const unsigned char* ab = vb + VBYTES;
    if (MODE == 2) {
        float part = 0.f;
        if (DIAG) {
            const int qd = q0w + r - 64 * j;
#pragma unroll
            for (int g = 0; g < 4; ++g) {
                const f32x4 a0 = *(LAS const f32x4*)(ab + (8 * g + 4 * h) * 4), a1 = *(LAS const f32x4*)(ab + (32 + 8 * g + 4 * h) * 4);
#pragma unroll
                for (int e = 0; e < 4; ++e) { const int i = 4 * g + e, kk = 8 * g + 4 * h + e;
                    float w0 = fexp2(a0[e] - M2), w1 = fexp2(a1[e] - M2);
                    if (kk > qd) w0 = 0.f; if (kk + 32 > qd) w1 = 0.f;
                    s0[i] *= w0; s1[i] *= w1; part += s0[i] + s1[i]; }
            }
        } else {
#pragma unroll
            for (int g = 0; g < 4; ++g) {
                const f32x4 a0 = *(LAS const f32x4*)(ab + (8 * g + 4 * h) * 4), a1 = *(LAS const f32x4*)(ab + (32 + 8 * g + 4 * h) * 4);
#pragma unroll
                for (int e = 0; e < 4; ++e) { const int i = 4 * g + e;
                    s0[i] *= fexp2(a0[e] - M2); s1[i] *= fexp2(a1[e] - M2); part += s0[i] + s1[i]; }
            }
        }
        lsum += part;
    } else {
        if (probe != 2) {
        asm volatile("s_nop 15\n\ts_nop 7" : "+v"(s0), "+v"(s1));
        float ta = max3f(s0[0], s0[1], s1[0]), tb = max3f(s0[2], s0[3], s1[1]); ta = max3f(ta, s1[2], s1[3]);
#pragma unroll
        for (int i = 4; i < 16; i += 4) { ta = max3f(ta, s0[i], s0[i + 1]); tb = max3f(tb, s0[i + 2], s0[i + 3]); ta = max3f(ta, s1[i], s1[i + 1]); tb = max3f(tb, s1[i + 2], s1[i + 3]); }
        float tm = max3f(ta, tb, tb); tm = max32x(tm);
        if (__any(tm > mref + RESC_THR)) {
            const float nm = tm > mref + RESC_THR ? tm : mref, al = fexp2(mref - nm);
            mref = nm; lsum *= al;
            if (h == 0) wsf[r] = al;
            WSYNC();
#pragma unroll
            for (int g = 0; g < 4; ++g) { const f32x4 av = *(LAS const f32x4*)(wsf + 8 * g + 4 * h);
#pragma unroll
                for (int v = 0; v < NVB; ++v)
#pragma unroll
                    for (int e = 0; e < 4; ++e) o[v][4 * g + e] *= av[e]; }
            WSYNC();
        }
        if (__any(mref != 0.f)) {
#pragma unroll
            for (int i = 0; i < 16; ++i) { s0[i] -= mref; s1[i] -= mref; }
        }
        float part = 0.f;
#pragma unroll
        for (int i = 0; i < 16; ++i) { s0[i] = fexp2(s0[i]); s1[i] = fexp2(s1[i]); part += s0[i] + s1[i]; }
        lsum += part;
        }
    }
    bf16x8 pf[2][2];
#pragma unroll
    for (int s2 = 0; s2 < 2; ++s2) {
        u32x4 t0, t1;
        t0.x = cvtpk(s0[8 * s2 + 0], s0[8 * s2 + 1]); t0.y = cvtpk(s0[8 * s2 + 2], s0[8 * s2 + 3]); t0.z = cvtpk(s0[8 * s2 + 4], s0[8 * s2 + 5]); t0.w = cvtpk(s0[8 * s2 + 6], s0[8 * s2 + 7]);
        t1.x = cvtpk(s1[8 * s2 + 0], s1[8 * s2 + 1]); t1.y = cvtpk(s1[8 * s2 + 2], s1[8 * s2 + 3]); t1.z = cvtpk(s1[8 * s2 + 4], s1[8 * s2 + 5]); t1.w = cvtpk(s1[8 * s2 + 6], s1[8 * s2 + 7]);
        pf[0][s2] = __builtin_bit_cast(bf16x8, t0); pf[1][s2] = __builtin_bit_cast(bf16x8, t1);
    }
    if (probe != 3)
#pragma unroll
    for (int v = 0; v < NVB; ++v)
#pragma unroll
        for (int p = 0; p < 2; ++p)
#pragma unroll
            for (int s2 = 0; s2 < 2; ++s2) {
                const s16x4 lo = trread(vb + voff + (32 * p + 16 * s2) * VROWB + 64 * v), hi = trread(vb + voff + (32 * p + 16 * s2 + 8) * VROWB + 64 * v);
                const bf16x8 vf = (bf16x8){lo[0], lo[1], lo[2], lo[3], hi[0], hi[1], hi[2], hi[3]};
                o[v] = MFMA32(pf[p][s2], vf, o[v]);
            }
}

template <int MODE>
DI void attn_tile(f32x16 (&o)[MODE == 0 ? 2 : 4], float& lsum, float& mref, const bf16x8 (&qf)[MODE == 2 ? 8 : 4], LAS const unsigned char* kb, int koff, int voff,
                  int j, int q0w, int r, int h, unsigned mw, float M2, LAS float* wsf, const bool DIAG, const int probe) {
    constexpr int KW = MODE == 0 ? 64 : 128, KROWB = KW * 2 + 16, KBYTES = 64 * KROWB;
    f32x16 s0, s1;
    attn_qk<MODE>(s0, s1, qf, kb, koff, j, q0w, r, h, mw, DIAG);
    attn_pv<MODE>(o, lsum, mref, s0, s1, kb + KBYTES, voff, j, q0w, r, h, M2, wsf, DIAG, probe);
}
template <int MODE>
DI void attn_unit(Frame& F, const Args& a, int l, int b, int head, int qb, float lam_val, float lam_init) {
    constexpr int KW = MODE == 0 ? 64 : 128, DQK = MODE == 2 ? 128 : 64, NCOMP = 1, NPASS = 1, DV = MODE == 0 ? 64 : 128;
    constexpr int KROWB = KW * 2 + 16, VROWB = MODE == 0 ? 192 : 320;
    constexpr int KBYTES = 64 * KROWB, VBYTES = 64 * VROWB, STAGE = KBYTES + VBYTES + 256;
    constexpr int NKS = DQK / 16, NVB = DV / 32, KCH = KW / 64, VCH = DV / 64;
    static_assert(2 * STAGE <= 98304, "tile buffers");
    F.refresh();
    const int probe = (REPMASK != 0) ? ((volatile LAS int*)(F.lds + MISC_OFF + 96))[2] : 0;
    const int tid = F.tid, lane = F.lane, w = F.wave, r = lane & 31, h = lane >> 5;
    const bf16_t* Qp; const bf16_t* Kp; const bf16_t* Vp; int ldq, ldk;
    if (MODE == 0) { Qp = (const bf16_t*)(F.ws + WS_SQ) + head * 64; Kp = (const bf16_t*)(F.ws + WS_SK) + head * 64; Vp = (const bf16_t*)(F.ws + WS_SV) + head * 64; ldq = 512; ldk = 512; }
    else if (MODE == 1) { Qp = (const bf16_t*)(F.ws + WS_DQ) + head * 128; Kp = (const bf16_t*)(F.ws + WS_DK) + head * 128; Vp = (const bf16_t*)(F.ws + WS_DV) + head * 128; ldq = 512; ldk = 512; }
    else { Qp = (const bf16_t*)(F.ws + WS_QK) + head * 128; Kp = (const bf16_t*)(F.ws + WS_QK) + 512 + head * 128; Vp = (const bf16_t*)(F.ws + WS_VM) + head * 128; ldq = 1024; ldk = 1024; }
    const size_t rowb = (size_t)b * SEQ;
    const int comp = MODE == 1 ? (w >> 2) : 0;
    const int q0w = MODE == 1 ? qb * 128 + (w & 3) * 32 : qb * 256 + w * 32;
    const int seq = b * 4 + head;
    LAS float* wsf = (LAS float*)(F.lds + ATT_WSF_OFF + w * 256);
    f32x16 o[NCOMP][NVB];
    float lsum[NCOMP], mref[NCOMP];
    const int i16 = lane & 15, vq = i16 >> 2, vp = i16 & 3, vcs = (lane >> 4) & 1;
    const int voff = (4 * h + vq) * VROWB + (16 * vcs + 4 * vp) * 2;
    const int koff = r * KROWB + 16 * h;
    const int NT = MODE == 2 ? 4 : (MODE == 1 ? 2 * (qb + 1) : 4 * (qb + 1)), JB = MODE == 2 ? 4 * qb : 0;
#pragma unroll 1
    for (int pass = 0; pass < NPASS; ++pass) {
    bf16x8 qf[NCOMP][NKS];
#pragma unroll
    for (int c = 0; c < NCOMP; ++c)
#pragma unroll
        for (int s = 0; s < NKS; ++s) qf[c][s] = *(const GAS bf16x8*)(Qp + (rowb + q0w + r) * ldq + comp * 64 + 16 * s + 8 * h);
#pragma unroll
    for (int c = 0; c < NCOMP; ++c)
#pragma unroll
        for (int v = 0; v < NVB; ++v)
#pragma unroll
            for (int i = 0; i < 16; ++i) o[c][v][i] = 0.f;
#pragma unroll
    for (int c = 0; c < NCOMP; ++c) { lsum[c] = 0.f; mref[c] = 0.f; }
    float M2 = 0.f;
    if (MODE == 2) M2 = ((const float*)(F.ws + WS_MQ))[(size_t)seq * SEQ + q0w + r] * LOG2E;
    const unsigned* mrow = (const unsigned*)(F.ws + WS_MASK) + ((rowb + q0w + r) * 2 + h) * 64;
    const int srow = tid >> 3, sch = tid & 7;
    const bf16_t* kg = Kp + (rowb + srow) * ldk + sch * 8; const bf16_t* vg = Vp + (rowb + srow) * 512 + sch * 8;
    const float* ag = (const float*)(F.ws + WS_AK) + (size_t)seq * SEQ;
    u32x4 kreg[KCH], vreg[VCH]; float areg = 0.f; unsigned mw = 0u; u32x4 mw4 = (u32x4){0u, 0u, 0u, 0u}, mw4n = (u32x4){0u, 0u, 0u, 0u};
#define ST_LOAD(j) do { _Pragma("unroll") for (int c_ = 0; c_ < KCH; ++c_) kreg[c_] = *(const GAS u32x4*)(kg + (size_t)(j) * 64 * ldk + c_ * 64); \
        _Pragma("unroll") for (int c_ = 0; c_ < VCH; ++c_) vreg[c_] = *(const GAS u32x4*)(vg + (size_t)(j) * 64 * 512 + c_ * 64); \
        if (MODE == 2) { if (tid < 64) areg = *(const GAS float*)(ag + (j) * 64 + tid); } \
        asm volatile("" ::: "memory"); } while (0)
#define ST_WRITE(buf) do { LAS unsigned char* sb_ = F.lds + (buf) * STAGE; \
        _Pragma("unroll") for (int c_ = 0; c_ < KCH; ++c_) *(LAS u32x4*)(sb_ + srow * KROWB + (sch + 8 * c_) * 16) = kreg[c_]; \
        _Pragma("unroll") for (int c_ = 0; c_ < VCH; ++c_) *(LAS u32x4*)(sb_ + KBYTES + srow * VROWB + (sch + 8 * c_) * 16) = vreg[c_]; \
        if (MODE == 2) { if (tid < 64) *(LAS float*)(sb_ + KBYTES + VBYTES + tid * 4) = areg * LOG2E; } } while (0)
    if (MODE == 0) mw4n = *(const GAS u32x4*)(mrow + JB);
    ST_LOAD(JB); ST_WRITE(0);
    __syncthreads();
    for (int j = JB; j < JB + NT; ++j) {
        const int cur = j & 1;
        if (MODE == 0) {
            if ((j & 3) == 0) { mw4 = mw4n; if (j + 4 < JB + NT) mw4n = *(const GAS u32x4*)(mrow + j + 4); }
            mw = (j & 3) == 0 ? mw4.x : ((j & 3) == 1 ? mw4.y : ((j & 3) == 2 ? mw4.z : mw4.w));
        }
        if (j + 1 < JB + NT && (probe == 0 || probe == 2 || probe == 3)) ST_LOAD(j + 1);
        if (64 * j <= q0w + 31) {
            LAS const unsigned char* kb = F.lds + cur * STAGE;
            attn_tile<MODE>(o[0], lsum[0], mref[0], qf[0], kb, koff + comp * 128, voff, j, q0w, r, h, mw, M2, wsf, 64 * j + 63 > q0w, probe);
        }
        if (probe != 4) { if (j + 1 < JB + NT) ST_WRITE(cur ^ 1);
        __syncthreads(); }
    }
#undef ST_LOAD
#undef ST_WRITE
    }
    if (MODE == 2) { if (qb > 0) {
        const float Mp2 = ((const float*)(F.ws + WS_MQ))[(size_t)seq * SEQ + 256 * qb - 1] * LOG2E;
        const float M2s = ((const float*)(F.ws + WS_MQ))[(size_t)seq * SEQ + q0w + r] * LOG2E;
        const float g = fexp2(Mp2 - M2s);
        const float* NSn = (const float*)(F.ws + WS_MN + 128 * 1024) + ((size_t)seq * 16 + qb) * 128;
        const bf16_t* Cn = (const bf16_t*)(F.ws + WS_MC) + ((size_t)seq * 16 + qb) * 16384;
        bf16x8 qs[8]; float dpart = 0.f;
#pragma unroll
        for (int s = 0; s < 8; ++s) {
            const bf16x8 qv = *(const GAS bf16x8*)(Qp + (rowb + q0w + r) * ldq + 16 * s + 8 * h);
            const u32x4 qw = __builtin_bit_cast(u32x4, qv);
            const f32x4 n0 = *(const GAS f32x4*)(NSn + 16 * s + 8 * h), n1 = *(const GAS f32x4*)(NSn + 16 * s + 8 * h + 4);
            const float q0 = bflo(qw.x), q1 = bfhi(qw.x), q2 = bflo(qw.y), q3 = bfhi(qw.y), q4 = bflo(qw.z), q5 = bfhi(qw.z), q6 = bflo(qw.w), q7 = bfhi(qw.w);
            dpart += (q0 * n0[0] + q1 * n0[1]) + (q2 * n0[2] + q3 * n0[3]) + (q4 * n1[0] + q5 * n1[1]) + (q6 * n1[2] + q7 * n1[3]);
            u32x4 t; t.x = cvtpk(q0 * g, q1 * g); t.y = cvtpk(q2 * g, q3 * g); t.z = cvtpk(q4 * g, q5 * g); t.w = cvtpk(q6 * g, q7 * g);
            qs[s] = __builtin_bit_cast(bf16x8, t);
        }
        lsum[0] += g * dpart;
#pragma unroll
        for (int v = 0; v < NVB; ++v) {
            bf16x8 cf[8];
#pragma unroll
            for (int s = 0; s < 8; ++s) cf[s] = *(const GAS bf16x8*)(Cn + (size_t)(32 * v + r) * 128 + 16 * s + 8 * h);
#pragma unroll
            for (int s = 0; s < 8; ++s) o[0][v] = MFMA32(qs[s], cf[s], o[0][v]);
        }
    } }
    float sc0; const float sc1 = 0.f;
    if (MODE == 1) { lam_val = ((volatile LAS float*)(F.lds + MISC_OFF + 96))[0]; lam_init = ((volatile LAS float*)(F.lds + MISC_OFF + 96))[1]; }
    { float lt = sum32x(lsum[0]);
      if (MODE == 2) sc0 = frcp(fmaxf(fabsf(lt), ((const float*)(F.ws + WS_EM))[(size_t)seq * SEQ + q0w + r]));
      else if (MODE == 1) sc0 = (comp ? lam_val : 1.0f) * frcp(lt);
      else sc0 = frcp(lt); }
    if (h == 0) { wsf[r] = sc0; wsf[32 + r] = sc1; }
    WSYNC();
    LAS float* stg = (LAS float*)(F.lds + w * 16384);
#pragma unroll
    for (int g = 0; g < 4; ++g) {
        const f32x4 av = *(LAS const f32x4*)(wsf + 8 * g + 4 * h);
#pragma unroll
        for (int e = 0; e < 4; ++e) { const int i = 4 * g + e, row = 8 * g + 4 * h + e;
#pragma unroll
            for (int v = 0; v < NVB; ++v) { float val = o[0][v][i] * av[e]; stg[row * DV + 32 * v + r] = val; } }
    }
    WSYNC();
    if (MODE == 1) __syncthreads();
    if (MODE != 1 || comp == 0) {
        const int q = lane >> 1, hf = lane & 1; constexpr int HC = DV / 2;
        LAS float* srow_ = stg + q * DV + hf * HC;
        if (MODE == 1) {
            LAS const float* prow_ = (LAS const float*)(F.lds + (w + 4) * 16384) + q * DV + hf * HC;
#pragma unroll
            for (int c4 = 0; c4 < HC / 4; ++c4) *(LAS f32x4*)(srow_ + 4 * c4) = *(LAS const f32x4*)(srow_ + 4 * c4) - *(LAS const f32x4*)(prow_ + 4 * c4);
        }
        size_t grow = rowb + q0w + q;
        bf16_t* Y = (bf16_t*)(F.ws + (probe ? WS_MD : WS_Y)); if (probe) grow &= 4095;
        if (MODE == 0) {
            bf16_t* yp = Y + grow * 1536 + 512 + head * 64 + hf * HC;
#pragma unroll
            for (int c8 = 0; c8 < HC / 8; ++c8) { const f32x4 x0 = *(LAS const f32x4*)(srow_ + 8 * c8), x1 = *(LAS const f32x4*)(srow_ + 8 * c8 + 4);
                u32x4 ov; ov.x = cvtpk(x0[0], x0[1]); ov.y = cvtpk(x0[2], x0[3]); ov.z = cvtpk(x1[0], x1[1]); ov.w = cvtpk(x1[2], x1[3]); *(u32x4*)(yp + 8 * c8) = ov; }
        } else {
            float ss = 0.f;
#pragma unroll
            for (int c4 = 0; c4 < HC / 4; ++c4) { const f32x4 x = *(LAS const f32x4*)(srow_ + 4 * c4); ss += (x[0] * x[0] + x[1] * x[1]) + (x[2] * x[2] + x[3] * x[3]); }
            ss += xor1(ss);
            float rs = 1.0f / sqrtf(ss * (1.f / 128.f) + EPS);
            const float* gain; bf16_t* yp; const bf16_t* gatep = nullptr;
            if (MODE == 1) { rs *= (1.0f - lam_init); gain = a.in[I_DOG] + (size_t)l * 128 + hf * HC; yp = Y + grow * 1536 + 1024 + head * 128 + hf * HC; }
            else { gain = a.in[I_MNG] + (size_t)l * 512 + head * 128 + hf * HC; yp = Y + grow * 1536 + head * 128 + hf * HC; gatep = (const bf16_t*)(F.ws + WS_OM) + grow * 512 + head * 128 + hf * HC; }
#pragma unroll
            for (int c8 = 0; c8 < HC / 8; ++c8) {
                f32x4 x0 = *(LAS const f32x4*)(srow_ + 8 * c8), x1 = *(LAS const f32x4*)(srow_ + 8 * c8 + 4);
                const f32x4 g0 = *(const f32x4*)(gain + 8 * c8), g1 = *(const f32x4*)(gain + 8 * c8 + 4);
                x0 = x0 * rs * g0; x1 = x1 * rs * g1;
                if (MODE == 2) { float gt[8]; ld8f(gatep + 8 * c8, gt);
#pragma unroll
                    for (int e = 0; e < 4; ++e) { x0[e] *= gt[e]; x1[e] *= gt[4 + e]; } }
                u32x4 ov; ov.x = cvtpk(x0[0], x0[1]); ov.y = cvtpk(x0[2], x0[3]); ov.z = cvtpk(x1[0], x1[1]); ov.w = cvtpk(x1[2], x1[3]); *(u32x4*)(yp + 8 * c8) = ov;
            }
        }
    }
    __syncthreads();
}
DI void phase_mixers(Frame& F, const Args& a, int l, int it, int modes, int probe) {
    F.refresh();
    const float* lam = a.in[I_LAM] + (size_t)l * 256;
    const float lam_init = (l == 0) ? 0.2f : 0.35550906759096934f;
    const float s01 = wave_sum(lam[F.lane] * lam[64 + F.lane]), s23 = wave_sum(lam[128 + F.lane] * lam[192 + F.lane]);
    { const float lv = fexp(s01) - fexp(s23) + lam_init; if (F.tid == 0) { ((volatile LAS int*)(F.lds + MISC_OFF + 96))[2] = probe; ((volatile LAS float*)(F.lds + MISC_OFF + 96))[0] = lv; ((volatile LAS float*)(F.lds + MISC_OFF + 96))[1] = lam_init; } }
    const float lam_val = 0.f;
    unsigned* qhead = (unsigned*)(F.ws + WS_CTL) + CW_QUEUE + it * 64;
    volatile LAS unsigned* slot = (volatile LAS unsigned*)(F.lds + MISC_OFF + 64);
    for (;;) {
        if (F.tid == 0) *slot = __hip_atomic_fetch_add(qhead, 1u, __ATOMIC_RELAXED, __HIP_MEMORY_SCOPE_AGENT);
        __syncthreads();
        const int u = __builtin_amdgcn_readfirstlane((int)*slot);
        __syncthreads();
        if (u >= 1280) break;
        if (u < 1024) { const int p_ = u >> 6, k = u & 63;
            if (k < 16) { if (modes & MIXMODES & 2) attn_unit<1>(F, a, l, k >> 2, k & 3, 31 - 2 * p_, lam_val, lam_init); }
            else if (k < 48) { if (modes & MIXMODES & 1) attn_unit<0>(F, a, l, (k - 16) >> 3, (k - 16) & 7, 15 - p_, lam_val, lam_init); }
            else { if (modes & MIXMODES & 2) attn_unit<1>(F, a, l, (k - 48) >> 2, (k - 48) & 3, 30 - 2 * p_, lam_val, lam_init); }
        } else { const int m_ = u - 1024; if (modes & MIXMODES & 4) attn_unit<2>(F, a, l, (m_ >> 2) & 3, m_ & 3, 15 - (m_ >> 4), lam_val, lam_init); }
    }
}

DI void mlstm_state_unit(Frame& F, int sq, int n) {
    F.refresh();
    constexpr int KROWB = 272, VROWB = 320, KBYTES = 64 * KROWB, VBYTES = 64 * VROWB;
    const int tid = F.tid, lane = F.lane, w = F.wave, r = lane & 31, h = lane >> 5, b = sq >> 2, head = sq & 3;
    const size_t rowb = (size_t)b * SEQ;
    const bf16_t* Kp = (const bf16_t*)(F.ws + WS_QK) + 512 + head * 128; const bf16_t* Vp = (const bf16_t*)(F.ws + WS_VM) + head * 128;
    const float* ag = (const float*)(F.ws + WS_AK) + (size_t)sq * SEQ;
    const float Mend = ((const float*)(F.ws + WS_MQ))[(size_t)sq * SEQ + 256 * n + 255];
    f32x16 acc[2];
#pragma unroll
    for (int c = 0; c < 2; ++c)
#pragma unroll
        for (int i = 0; i < 16; ++i) acc[c][i] = 0.f;
    const int dvb = w >> 1, dkb0 = 2 * (w & 1);
    const int srow = tid >> 3, sch = tid & 7;
    const int i16 = lane & 15, vq = i16 >> 2, vp = i16 & 3, vcs = (lane >> 4) & 1;
    const int toffV = (4 * h + vq) * VROWB + (16 * vcs + 4 * vp) * 2, toffK = (4 * h + vq) * KROWB + (16 * vcs + 4 * vp) * 2;
    LAS unsigned char* kb = F.lds; LAS unsigned char* vb = kb + KBYTES; LAS float* wts = (LAS float*)(vb + VBYTES);
    float nacc = 0.f; const int ndk = tid & 127, npart = tid >> 7;
    for (int jt = 0; jt < 4; ++jt) {
        const int j = 4 * n + jt;
        const float wr_ = fexp(*(const GAS float*)(ag + 64 * j + srow) - Mend);
        u32x4 kreg[2], vreg[2];
#pragma unroll
        for (int c = 0; c < 2; ++c) { kreg[c] = *(const GAS u32x4*)(Kp + (rowb + 64 * j + srow) * 1024 + (sch + 8 * c) * 8); vreg[c] = *(const GAS u32x4*)(Vp + (rowb + 64 * j + srow) * 512 + (sch + 8 * c) * 8); }
#pragma unroll
        for (int c = 0; c < 2; ++c) { u32x4 t = vreg[c];
            t.x = cvtpk(bflo(t.x) * wr_, bfhi(t.x) * wr_); t.y = cvtpk(bflo(t.y) * wr_, bfhi(t.y) * wr_); t.z = cvtpk(bflo(t.z) * wr_, bfhi(t.z) * wr_); t.w = cvtpk(bflo(t.w) * wr_, bfhi(t.w) * wr_); vreg[c] = t; }
        __syncthreads();
#pragma unroll
        for (int c = 0; c < 2; ++c) { *(LAS u32x4*)(kb + srow * KROWB + (sch + 8 * c) * 16) = kreg[c]; *(LAS u32x4*)(vb + srow * VROWB + (sch + 8 * c) * 16) = vreg[c]; }
        if (sch == 0) wts[srow] = wr_;
        __syncthreads();
#pragma unroll
        for (int sg = 0; sg < 4; ++sg) {
            const s16x4 alo = trread(vb + toffV + (16 * sg) * VROWB + 64 * dvb), ahi = trread(vb + toffV + (16 * sg + 8) * VROWB + 64 * dvb);
            const bf16x8 af = (bf16x8){alo[0], alo[1], alo[2], alo[3], ahi[0], ahi[1], ahi[2], ahi[3]};
#pragma unroll
            for (int c = 0; c < 2; ++c) {
                const s16x4 blo = trread(kb + toffK + (16 * sg) * KROWB + 64 * (dkb0 + c)), bhi = trread(kb + toffK + (16 * sg + 8) * KROWB + 64 * (dkb0 + c));
                const bf16x8 bfr = (bf16x8){blo[0], blo[1], blo[2], blo[3], bhi[0], bhi[1], bhi[2], bhi[3]};
                acc[c] = MFMA32(af, bfr, acc[c]);
            }
        }
#pragma unroll 4
        for (int s_ = 0; s_ < 16; ++s_) { const int ks = 16 * npart + s_; nacc += wts[ks] * bf2f(*(LAS const bf16_t*)(kb + ks * KROWB + ndk * 2)); }
    }
    float* D = (float*)(F.ws + WS_MD) + ((size_t)sq * 16 + n) * 16384;
#pragma unroll
    for (int c = 0; c < 2; ++c)
#pragma unroll
        for (int i = 0; i < 16; ++i) D[(32 * dvb + (i & 3) + 8 * (i >> 2) + 4 * h) * 128 + 32 * (dkb0 + c) + r] = acc[c][i];
    __syncthreads();
    LAS float* red = (LAS float*)F.lds;
    red[npart * 128 + ndk] = nacc;
    __syncthreads();
    if (tid < 128) ((float*)(F.ws + WS_MN))[((size_t)sq * 16 + n) * 128 + tid] = (red[tid] + red[128 + tid]) + (red[256 + tid] + red[384 + tid]);
    __syncthreads();
}
DI void mlstm_state_scan(Frame& F) {
    const int gid = (F.bid * NWAVES + F.wave) * 64 + F.lane, NG_ = F.G * NWAVES * 64;
    const float* D = (const float*)(F.ws + WS_MD); bf16_t* C = (bf16_t*)(F.ws + WS_MC); const float* MQ = (const float*)(F.ws + WS_MQ);
    for (int e = gid; e < CB * 4 * 16384; e += NG_) {
        const int sq = e >> 14, idx = e & 16383;
        float d[15], me[15];
#pragma unroll
        for (int n = 0; n < 15; ++n) { d[n] = D[((size_t)sq * 16 + n) * 16384 + idx]; me[n] = MQ[(size_t)sq * SEQ + 256 * n + 255]; }
        float c = 0.f;
#pragma unroll
        for (int n = 0; n < 15; ++n) { const float f = n == 0 ? 0.f : fexp(me[n - 1] - me[n]); c = f * c + d[n]; C[((size_t)sq * 16 + n + 1) * 16384 + idx] = (bf16_t)f2bf(c); }
    }
    const float* Nv = (const float*)(F.ws + WS_MN); float* NS = (float*)(F.ws + WS_MN + 128 * 1024);
    for (int e = gid; e < CB * 4 * 128; e += NG_) {
        const int sq = e >> 7, idx = e & 127; float c = 0.f;
#pragma unroll
        for (int n = 0; n < 15; ++n) { const float me = MQ[(size_t)sq * SEQ + 256 * n + 255]; const float f = n == 0 ? 0.f : fexp(MQ[(size_t)sq * SEQ + 256 * (n - 1) + 255] - me);
            c = f * c + Nv[((size_t)sq * 16 + n) * 128 + idx]; NS[((size_t)sq * 16 + n + 1) * 128 + idx] = c; }
    }
}

constexpr size_t SC_BSTRIDE = (size_t)4096 * (64 * 65 / 2);
DI size_t sc_off(int b, int t) { const int qb = t >> 6; return (size_t)b * SC_BSTRIDE + (size_t)4096 * (qb * (qb + 1) / 2) + (size_t)(t & 63) * 64 * (qb + 1); }
constexpr int CW_QUEUE2 = 12288;
DI void phase_scores(Frame& F, int it) {
    F.refresh();
    unsigned* qhead = (unsigned*)(F.ws + WS_CTL) + CW_QUEUE2 + it * 64;
    volatile LAS unsigned* slot = (volatile LAS unsigned*)(F.lds + MISC_OFF + 64);
    const bf16_t* IQ = (const bf16_t*)(F.ws + WS_IQ); const bf16_t* IK = (const bf16_t*)(F.ws + WS_IK); const float* IW = (const float*)(F.ws + WS_IW);
    float* SC = (float*)(F.ws + WS_HREG);
    for (;;) {
        if (F.tid == 0) *slot = __hip_atomic_fetch_add(qhead, 1u, __ATOMIC_RELAXED, __HIP_MEMORY_SCOPE_AGENT);
        __syncthreads();
        const int u = __builtin_amdgcn_readfirstlane((int)*slot);
        __syncthreads();
        if (u >= CB * 160 + 240) break;
        if (u >= CB * 160) { const int m_ = u - CB * 160; mlstm_state_unit(F, m_ & 15, m_ >> 4); continue; }
        int b = u / 160, k = u % 160, qb, seg;
        {
          int cls = 3, base = 0;
          for (;; --cls) { const int cnt = 16 * (cls + 1); if (k < base + cnt) break; base += cnt; }
          const int kk = k - base; qb = 16 * cls + (kk % 16); seg = kk / 16; }
        F.refresh();
        const int lane = F.lane, w = F.wave, r = lane & 31, h = lane >> 5, qh = w & 1;
        const int t0 = 64 * qb + 32 * qh;
        const size_t rowq = (size_t)b * SEQ + t0 + r;
        const f32x4 wv = *(const GAS f32x4*)(IW + rowq * 4);
        bf16x8 qf[4][4];
#pragma unroll
        for (int hd = 0; hd < 4; ++hd)
#pragma unroll
            for (int s = 0; s < 4; ++s) qf[hd][s] = *(const GAS bf16x8*)(IQ + rowq * 256 + hd * 64 + 16 * s + 8 * h);
        LAS unsigned* T = (LAS unsigned*)(F.lds + w * 8448);
        const int jplast = ((16 * seg + 15 < qb) ? 16 * seg + 15 : qb) >> 1;
        unsigned short* scb = (unsigned short*)(F.ws + WS_HREG) + sc_off(b, t0);
        const int rstride = 64 * (qb + 1);
        for (int jp = 8 * seg + (w >> 1); jp <= jplast; jp += 4) {
            const int nt2 = (2 * jp + 1 <= qb) ? 2 : 1;
            bf16x8 kfa[4][4];
#pragma unroll
            for (int q4 = 0; q4 < 4; ++q4) { const int jq = 2 * jp + ((q4 >> 1) < nt2 ? (q4 >> 1) : 0);
#pragma unroll
                for (int s = 0; s < 4; ++s) kfa[q4][s] = *(const GAS bf16x8*)(IK + ((size_t)b * SEQ + 64 * jq + 32 * (q4 & 1) + r) * 64 + 8 * h + 16 * s); }
#pragma unroll
            for (int ts = 0; ts < 2; ++ts) { if (ts < nt2) {
#pragma unroll
                for (int p = 0; p < 2; ++p) {
                    float sc[16];
#pragma unroll
                    for (int i = 0; i < 16; ++i) sc[i] = 0.f;
#pragma unroll
                    for (int hd = 0; hd < 4; ++hd) {
                        f32x16 acc;
#pragma unroll
                        for (int i = 0; i < 16; ++i) acc[i] = 0.f;
#pragma unroll
                        for (int s = 0; s < 4; ++s) acc = MFMA32(kfa[2 * ts + p][s], qf[hd][s], acc);
#pragma unroll
                        for (int i = 0; i < 16; ++i) sc[i] += wv[hd] * fmaxf(acc[i], 0.f);
                    }
#pragma unroll
                    for (int i = 0; i < 16; i += 2) {
                        const unsigned lo = __builtin_bit_cast(unsigned short, (_Float16)(sc[i] + 0.0f)), hi = __builtin_bit_cast(unsigned short, (_Float16)(sc[i + 1] + 0.0f));
                        T[r * 65 + ((64 * ts + 32 * p + (i & 3) + 8 * (i >> 2) + 4 * h) >> 1)] = lo | (hi << 16); }
                }
            } }
            WSYNC();
            if (lane < 32 * nt2) {
#pragma unroll 8
                for (int q = 0; q < 32; ++q) *(unsigned*)(scb + (size_t)q * rstride + 128 * jp + 2 * lane) = T[q * 65 + lane];
            }
            WSYNC();
        }
    }
}
DI unsigned long long spread32(unsigned x) {
    unsigned long long v = x;
    v = (v | (v << 16)) & 0x0000FFFF0000FFFFull; v = (v | (v << 8)) & 0x00FF00FF00FF00FFull; v = (v | (v << 4)) & 0x0F0F0F0F0F0F0F0Full;
    v = (v | (v << 2)) & 0x3333333333333333ull; v = (v | (v << 1)) & 0x5555555555555555ull; return v;
}
DI unsigned pack_nib(unsigned long long bm, int hh) {
    unsigned long long x = (bm >> (4 * hh)) & 0x0F0F0F0F0F0F0F0Full;
    x = (x | (x >> 4)) & 0x00FF00FF00FF00FFull; x = (x | (x >> 8)) & 0x0000FFFF0000FFFFull; x = (x | (x >> 16)) & 0x00000000FFFFFFFFull; return (unsigned)x;
}
DI void radix_find(LAS unsigned* hist, int lane, int& need, unsigned& digit, unsigned& cnt) {
    const u32x4 c = *(LAS const u32x4*)(hist + 4 * lane);
    const unsigned ls = (c.x + c.y) + (c.z + c.w); unsigned inc = ls;
#pragma unroll
    for (int o = 1; o < 64; o <<= 1) { const unsigned y = shup_u(inc, o, lane); if (lane >= o) inc += y; }
    const unsigned total = rdl_u(inc, 63);
    unsigned cum = total - inc; int fbin = -1; unsigned fneed = 0u, fcnt = 0u;
    if (cum < (unsigned)need && cum + c.w >= (unsigned)need) { fbin = 4 * lane + 3; fneed = (unsigned)need - cum; fcnt = c.w; } cum += c.w;
    if (fbin < 0 && cum < (unsigned)need && cum + c.z >= (unsigned)need) { fbin = 4 * lane + 2; fneed = (unsigned)need - cum; fcnt = c.z; } cum += c.z;
    if (fbin < 0 && cum < (unsigned)need && cum + c.y >= (unsigned)need) { fbin = 4 * lane + 1; fneed = (unsigned)need - cum; fcnt = c.y; } cum += c.y;
    if (fbin < 0 && cum < (unsigned)need && cum + c.x >= (unsigned)need) { fbin = 4 * lane; fneed = (unsigned)need - cum; fcnt = c.x; }
    const int src = __ffsll((long long)__ballot(fbin >= 0)) - 1;
    digit = rdl_u((unsigned)fbin, src); need = (int)rdl_u(fneed, src); cnt = rdl_u(fcnt, src);
}
template <int NGP>
DI void select_row(int row, int lane, LAS unsigned* hist, const unsigned (&raw)[32], unsigned* MASK, const int probe) {
        const int b = row >> 12, t = row & (SEQ - 1), n = t + 1, ngp = (t >> 7) + 1;
        unsigned key[NGP];
        (void)b;
#pragma unroll
        for (int i = 0; i < NGP; ++i) key[i] = raw[i];
#pragma unroll
        for (int i = 0; i < NGP; ++i) { const int e2 = 64 * i + lane; unsigned w_ = key[i];
            { const unsigned sg_ = (w_ >> 15) & 0x00010001u; w_ ^= ((sg_ << 15) - sg_) + 0x80008000u; }
            if (2 * e2 >= n) w_ &= 0xFFFF0000u; if (2 * e2 + 1 >= n) w_ &= 0x0000FFFFu; key[i] = w_; }
        unsigned thr = 0u; int need = 256; bool ties = false;
        if (n > 256 && probe != 1 && probe != 3) {
            unsigned dA = 0u, dB = 0u, cnt = 0u;
            { unsigned z_ = 0u; asm volatile("" : "+v"(z_)); *(LAS u32x4*)(hist + 4 * lane) = (u32x4){z_, z_, z_, z_}; }
            WSYNC();
#pragma unroll
            for (int i = 0; i < NGP; ++i) if (i < ngp) { const unsigned kx = key[i];
                __hip_atomic_fetch_add(&hist[(kx >> 8) & 255u], 1u, __ATOMIC_RELAXED, __HIP_MEMORY_SCOPE_WORKGROUP); __hip_atomic_fetch_add(&hist[kx >> 24], 1u, __ATOMIC_RELAXED, __HIP_MEMORY_SCOPE_WORKGROUP); }
            WSYNC();
            radix_find(hist, lane, need, dA, cnt);
            WSYNC();
            if ((unsigned)need != cnt) {
                { unsigned z_ = 0u; asm volatile("" : "+v"(z_)); *(LAS u32x4*)(hist + 4 * lane) = (u32x4){z_, z_, z_, z_}; }
                WSYNC();
#pragma unroll
                for (int i = 0; i < NGP; ++i) if (i < ngp) { const unsigned kx = key[i];
                    if (((kx >> 8) & 255u) == dA) __hip_atomic_fetch_add(&hist[kx & 255u], 1u, __ATOMIC_RELAXED, __HIP_MEMORY_SCOPE_WORKGROUP);
                    if ((kx >> 24) == dA) __hip_atomic_fetch_add(&hist[(kx >> 16) & 255u], 1u, __ATOMIC_RELAXED, __HIP_MEMORY_SCOPE_WORKGROUP); }
                WSYNC();
                radix_find(hist, lane, need, dB, cnt);
                WSYNC();
                thr = (dA << 8) | dB; ties = (unsigned)need != cnt;
            } else { thr = dA << 8; ties = false; }
        }
        unsigned elo = 0u, ehi = 0u, olo = 0u, ohi = 0u; int eqc = 0;
        if (probe == 1 || probe == 3) thr = 0x9000u;
        if (probe < 2)
        {
#define SEL_STEP(i) if constexpr ((i) < NGP) if ((i) < ngp) { const unsigned kx = key[(i) < NGP ? (i) : 0], kl = kx & 0xFFFFu, kh = kx >> 16; bool sl, sh; \
            if (n <= 256) { sl = kl != 0u; sh = kh != 0u; } \
            else if (!ties) { sl = kl >= thr; sh = kh >= thr; } \
            else { const bool ql = kl == thr, qh = kh == thr; const unsigned long long ml = __ballot(ql), mh = __ballot(qh), lt = (1ull << lane) - 1ull; \
                const int rl = eqc + __popcll(ml & lt) + __popcll(mh & lt), rh = rl + (ql ? 1 : 0); \
                sl = kl > thr || (ql && rl < need); sh = kh > thr || (qh && rh < need); eqc += __popcll(ml) + __popcll(mh); } \
            const unsigned long long be = __ballot(sl), bo = __ballot(sh); const unsigned e0 = (unsigned)be, e1 = (unsigned)(be >> 32), o0 = (unsigned)bo, o1 = (unsigned)(bo >> 32); \
            asm volatile("s_nop 4\n\tv_writelane_b32 %0, %4, " #i "\n\tv_writelane_b32 %1, %5, " #i "\n\tv_writelane_b32 %2, %6, " #i "\n\tv_writelane_b32 %3, %7, " #i \
                         : "+v"(elo), "+v"(ehi), "+v"(olo), "+v"(ohi) : "s"(e0), "s"(e1), "s"(o0), "s"(o1)); }
#define SEL8(b) SEL_STEP(b) SEL_STEP(b + 1) SEL_STEP(b + 2) SEL_STEP(b + 3) SEL_STEP(b + 4) SEL_STEP(b + 5) SEL_STEP(b + 6) SEL_STEP(b + 7)
        SEL8(0) SEL8(8) SEL8(16) SEL8(24)
#undef SEL8
#undef SEL_STEP
        }
        if (lane < 32) {
            const unsigned long long ta = spread32(elo) | (spread32(olo) << 1), tb = spread32(ehi) | (spread32(ohi) << 1);
            *(u32x2*)(MASK + ((size_t)row * 2 + 0) * 64 + 2 * lane) = (u32x2){pack_nib(ta, 0), pack_nib(tb, 0)};
            *(u32x2*)(MASK + ((size_t)row * 2 + 1) * 64 + 2 * lane) = (u32x2){pack_nib(ta, 1), pack_nib(tb, 1)};
        }
}
DI void phase_select(Frame& F, const int probe) {
    F.refresh();
    const int gw = F.bid * NWAVES + F.wave, NGW = F.G * NWAVES, lane = F.lane;
    LAS unsigned* hist = (LAS unsigned*)(F.lds + F.wave * 1024);
    const unsigned short* SC = (const unsigned short*)(F.ws + WS_HREG); unsigned* MASK = (unsigned*)(F.ws + WS_MASK);
    if (!probe) mlstm_state_scan(F);
    unsigned cur[32];
#define LOAD_ROW(dst, rw) do { const int t_ = (rw) & (SEQ - 1), em_ = t_ >> 1; const unsigned* sr_ = (const unsigned*)(SC + sc_off((rw) >> 12, t_)); \
        _Pragma("unroll") for (int i_ = 0; i_ < 32; ++i_) { const int e_ = 64 * i_ + lane; dst[i_] = *(const GAS unsigned*)(sr_ + (e_ < em_ ? e_ : em_)); } } while (0)
    const int nstep = (MC + NGW - 1) / NGW;
#define ROW_OF(k) ((NGW == 2048) ? (((k) >> 1) * SEQ + (((k) & 1) ? (SEQ - 1 - gw) : gw)) : (gw + (k) * NGW))
    if (gw < MC) LOAD_ROW(cur, ROW_OF(0));
    for (int k = 0; k < nstep; ++k) {
        const int row = ROW_OF(k); if (row >= MC) break;
        unsigned nxt[32]; const int nrow = (k + 1 < nstep && ROW_OF(k + 1) < MC) ? ROW_OF(k + 1) : row;
        LOAD_ROW(nxt, nrow);
        asm volatile("" ::: "memory");
        const int cls = (row & (SEQ - 1)) >> 10;
        unsigned* mk = probe ? (unsigned*)(F.ws + WS_QKRAW) : MASK;
        if (cls == 0) select_row<8>(row, lane, hist, cur, mk, probe);
        else if (cls == 1) select_row<16>(row, lane, hist, cur, mk, probe);
        else if (cls == 2) select_row<24>(row, lane, hist, cur, mk, probe);
        else select_row<32>(row, lane, hist, cur, mk, probe);
#pragma unroll
        for (int i = 0; i < 32; ++i) cur[i] = nxt[i];
    }
#undef ROW_OF
#undef LOAD_ROW
}

#ifndef MK_ONE_LAUNCH
#define MK_ONE_LAUNCH 1
#endif
constexpr int NPHASE = 13;
__global__ void __launch_bounds__(NWAVES * 64, 2) fwd(Args args) {
    extern __shared__ __attribute__((aligned(16))) unsigned char lds[];
    Frame F;
    F.lds = (LAS unsigned char*)lds; F.ws = args.ws;
    F.tid = threadIdx.x; F.lane = F.tid & 63; F.wave = __builtin_amdgcn_readfirstlane(F.tid >> 6); F.wave0 = F.wave;
    F.G = gridDim.x; F.bid = blockIdx.x;
    volatile LAS unsigned* MISC = (volatile LAS unsigned*)(F.lds + MISC_OFF);
    for (int u = F.tid; u < (LDS_BYTES - LDSCTL_OFF) / 4; u += NWAVES * 64) ((LAS unsigned*)(F.lds + LDSCTL_OFF))[u] = 0u;
    __syncthreads();
    const bool multi = MK_ONE_LAUNCH ? true : !(args.it_hi - args.it_lo == 1 && args.ph_hi - args.ph_lo == 1);
    XcdBarrier bar; bar.bar = (unsigned*)(F.ws + WS_CTL) + CW_BAR; bar.x = 0; bar.st = nullptr;
    if (multi) bar = xcd_barrier_post((unsigned*)(F.ws + WS_CTL) + CW_BAR, MISC + 8);
#define GRID_BAR() do { if (multi) { xcd_barrier(bar); if ((REPMASK >> 15) & 1) xcd_barrier(bar); } } while (0)
    const int lo = args.ph_lo, hi = args.ph_hi; (void)lo; (void)hi;
#ifndef PHMASK
#define PHMASK 0xFFFF
#endif
#if MK_ONE_LAUNCH
#define IN(k) ((PHMASK >> (k)) & 1)
#else
#define IN(k) (((PHMASK >> (k)) & 1) && lo <= (k) && (k) < hi)
#endif
#define REPS(k) (1 + ((REPMASK >> (k)) & 1))
    if (IN(0) && args.it_lo == 0) for (int rp = 0; rp < REPS(0); ++rp) { phase_prologue(F, args); GRID_BAR(); }
    for (int it = args.it_lo; it < args.it_hi; ++it) {
        const int chunk = it >> 1, l = it & 1;
        unsigned char* wl = F.ws + WS_W + (size_t)l * W_LAYER;
        const size_t xoff = (size_t)chunk * MC * DM;
        const float* xin = args.in[I_X] + xoff;
        float* Xout = args.out + xoff;
        bf16_t* X16 = (bf16_t*)(F.ws + WS_X16);
        bf16_t* XN = (bf16_t*)(F.ws + WS_XN);
        if (IN(1)) for (int rp = 0; rp < REPS(1); ++rp) { phase_rmsnorm(F, l == 0 ? (const void*)xin : (const void*)X16, l != 0, args.in[I_NMG] + (size_t)l * DM, XN); GRID_BAR(); }
        if (IN(2)) for (int rp = 0; rp < REPS(2); ++rp) {
            pg8::Gemm g{XN, (const bf16_t*)(wl + WO_IN), MC, NT_IN * 256, DM}; F.refresh(); pg8::StaticOrder S; S.init(MC, NT_IN * 256, F.G, F.bid);
            EpiInProj E{F.ws, args.in[I_GB] + l * 8, l};
            pg8::gemm_phase<EpiInProj, true>(F.lds, g, S, E, F.tid);
            GRID_BAR();
        }
        if (IN(3)) for (int rp = 0; rp < REPS(3); ++rp) { phase_token(F, args, l, rp == 0 ? 0 : PROBE_NOLOAD); GRID_BAR(); }
        if (IN(4)) for (int rp = 0; rp < REPS(4); ++rp) {
            pg8::Gemm g{(const bf16_t*)(F.ws + WS_CKV), (const bf16_t*)(wl + WO_KV), MC, 1024, 256}; F.refresh(); pg8::StaticOrder S; S.init(MC, 1024, F.G, F.bid);
            EpiKV E{F.ws, l};
            pg8::gemm_phase<EpiKV, true>(F.lds, g, S, E, F.tid);
            if (rp + 1 < REPS(4)) GRID_BAR();
        }
#ifdef NAIVE_SEL
        if (IN(5)) { naive_select(F); GRID_BAR(); }
#else
        if (IN(5)) { for (int rp = 0; rp < REPS(5); ++rp) { phase_scores(F, it + 8 * rp); GRID_BAR(); } for (int rp = 0; rp < REPS(13); ++rp) { phase_select(F, rp == 0 ? 0 : PROBE_NOLOAD); GRID_BAR(); } }
#endif
                if (IN(7)) for (int rp = 0; rp < REPS(7); ++rp) {
            pg8::Gemm g{XN, (const bf16_t*)(wl + WO_G), MC, 3072, DM}; F.refresh(); pg8::StaticOrder S; S.init(MC, 3072, F.G, F.bid);
            EpiGate E{F.ws + WS_HREG, args.in[I_BG] + (size_t)l * 3072};
            pg8::gemm_phase<EpiGate, true>(F.lds, g, S, E, F.tid);
            if (rp + 1 < REPS(7)) GRID_BAR();
        }
#ifdef NAIVE_MIX
        if (IN(6)) { naive_dsa(F); __syncthreads(); naive_mlstm(F, args, l); __syncthreads(); naive_diff(F, args, l); GRID_BAR(); }
#else
        if (IN(6)) for (int rp = 0; rp < REPS(6); ++rp) { phase_mixers(F, args, l, it + 8 * rp, rp == 0 ? 7 : PROBE_MODES, rp == 0 ? 0 : PROBE_NOLOAD); GRID_BAR(); }
#endif
        if (IN(8)) for (int rp = 0; rp < REPS(8); ++rp) {
            pg8::Gemm g{(const bf16_t*)(F.ws + WS_Y), (const bf16_t*)(wl + WO_BR), MC, 1024, 1536}; F.refresh(); pg8::StaticOrder S; S.init(MC, 1024, F.G, F.bid);
            EpiMerge E{F.ws + WS_HREG, (bf16_t*)(F.ws + WS_MG)};
            pg8::gemm_phase<EpiMerge, false>(F.lds, g, S, E, F.tid);
            GRID_BAR();
        }
        if (IN(9)) for (int rp = 0; rp < REPS(9); ++rp) {
            pg8::Gemm g{(const bf16_t*)(F.ws + WS_MG), (const bf16_t*)(wl + WO_OUT), MC, 1024, 1024}; F.refresh(); pg8::StaticOrder S; S.init(MC, 1024, F.G, F.bid);
            EpiResid E{l == 0 ? (const void*)xin : (const void*)X16, (void*)X16, l != 0, true};
            pg8::gemm_phase<EpiResid, false>(F.lds, g, S, E, F.tid);
            GRID_BAR();
        }
        if (IN(10)) for (int rp = 0; rp < REPS(10); ++rp) { phase_rmsnorm(F, X16, true, args.in[I_NFG] + (size_t)l * DM, XN); GRID_BAR(); }
        if (IN(11)) for (int rp = 0; rp < REPS(11); ++rp) {
            pg8::Gemm g{XN, (const bf16_t*)(wl + WO_GU), MC, 5632, DM}; F.refresh(); pg8::StaticOrder S; S.init(MC, 5632, F.G, F.bid);
            EpiSwiGLU E{(bf16_t*)(F.ws + WS_HREG)};
            pg8::gemm_phase<EpiSwiGLU, true>(F.lds, g, S, E, F.tid);
            GRID_BAR();
        }
        if (IN(12)) for (int rp = 0; rp < REPS(12); ++rp) {
            pg8::Gemm g{(const bf16_t*)(F.ws + WS_HREG), (const bf16_t*)(wl + WO_D), MC, 1024, FF}; F.refresh(); pg8::StaticOrder S; S.init(MC, 1024, F.G, F.bid);
            EpiResid E{(const void*)X16, l == DEPTH - 1 ? (void*)Xout : (void*)X16, true, l != DEPTH - 1};
            pg8::gemm_phase<EpiResid, false>(F.lds, g, S, E, F.tid);
            GRID_BAR();
        }
    }
#undef IN
#undef GRID_BAR
}

extern "C" void kernel_launch(void* const* d_in, const int* in_sizes, int n_in, void* d_out, int out_size, void* d_ws, size_t ws_size, hipStream_t stream) {
    static int grid = 0;
    if (grid == 0) {
        if (n_in != 21 || ws_size < WS_END) { fprintf(stderr, "kernel_launch: unexpected inputs (n_in %d, ws %zu)\n", n_in, ws_size); grid = -1; return; }
        int dev = 0, cus = 0;
        if (hipGetDevice(&dev) != hipSuccess || hipDeviceGetAttribute(&cus, hipDeviceAttributeMultiprocessorCount, dev) != hipSuccess) { grid = -1; return; }
        if (hipFuncSetAttribute((const void*)fwd, hipFuncAttributeMaxDynamicSharedMemorySize, LDS_BYTES) != hipSuccess) { grid = -1; return; }
        int per_cu = 0;
        if (hipOccupancyMaxActiveBlocksPerMultiprocessor(&per_cu, (const void*)fwd, NWAVES * 64, LDS_BYTES) != hipSuccess || per_cu < 1) fprintf(stderr, "kernel_launch: occupancy query says %d\n", per_cu);
        (void)hipGetLastError();
        grid = cus;
    }
    if (grid < 0) return;
    (void)hipMemsetAsync((char*)d_ws + WS_CTL, 0, CTL_ZERO_BYTES, stream);
    Args a{};
    for (int i = 0; i < 21; ++i) a.in[i] = (const float*)d_in[i];
    a.out = (float*)d_out; a.ws = (unsigned char*)d_ws;
#if MK_ONE_LAUNCH
    a.it_lo = 0; a.it_hi = NCHUNK * DEPTH; a.ph_lo = 0; a.ph_hi = NPHASE;
    hipLaunchKernelGGL(fwd, dim3(grid), dim3(NWAVES * 64), LDS_BYTES, stream, a);
#else
    a.it_lo = 0; a.it_hi = 1; a.ph_lo = 0; a.ph_hi = 1;
    hipLaunchKernelGGL(fwd, dim3(grid), dim3(NWAVES * 64), LDS_BYTES, stream, a);
    for (int it = 0; it < NCHUNK * DEPTH; ++it)
        for (int ph = 1; ph < NPHASE; ++ph) { a.it_lo = it; a.it_hi = it + 1; a.ph_lo = ph; a.ph_hi = ph + 1; hipLaunchKernelGGL(fwd, dim3(grid), dim3(NWAVES * 64), LDS_BYTES, stream, a); }
#endif
}
```

```cpp
#include <hip/hip_runtime.h>
#include <cstdio>
#include <cstdint>

#ifndef REPMASK
#define REPMASK 0
#endif
#define PROBE_MODES 7
#define PROBE_NOLOAD 0
#define DI __device__ __forceinline__
#define LAS __attribute__((address_space(3)))
#define GAS __attribute__((address_space(1)))

typedef unsigned short bf16_t;
typedef short bf16x8 __attribute__((ext_vector_type(8)));
typedef float f32x4 __attribute__((ext_vector_type(4)));
typedef float f32x2 __attribute__((ext_vector_type(2)));
typedef unsigned u32x4 __attribute__((ext_vector_type(4)));
typedef unsigned u32x2 __attribute__((ext_vector_type(2)));

constexpr int BATCH = 8, SEQ = 4096, DM = 1024, DEPTH = 2;
constexpr int CB = 4;
constexpr int MC = CB * SEQ;
constexpr int NCHUNK = BATCH / CB;
constexpr int IN_COLS = 7756;
constexpr int FF = 2816;
constexpr float EPS = 1e-6f;
constexpr float LOG2E = 1.4426950408889634f;
constexpr float C2 = 0.125f * LOG2E;
constexpr int Z_MQK = 0, Z_MV = 1024, Z_MO = 1536, Z_MIF = 2048, Z_SQ = 2056, Z_CKV = 2568, Z_IQ = 2824, Z_IK = 3080, Z_IW = 3144, Z_DQ = 3148, Z_DK = 3660, Z_DV = 4172, Z_G = 4684;
constexpr int NT_IN = 19;

constexpr size_t MiB = 1u << 20;
constexpr size_t WS_CTL = 0, CTL_ZERO_BYTES = 128 * 1024;
constexpr size_t WS_COS = 1 * MiB, WS_SIN = 1 * MiB + 512 * 1024;
constexpr size_t WS_W = 2 * MiB, W_LAYER = 38 * MiB;
constexpr size_t WO_IN = 0;
constexpr size_t WO_G = WO_IN + (size_t)NT_IN * 256 * 1024 * 2;
constexpr size_t WO_KV = WO_G + (size_t)3072 * 1024 * 2;
constexpr size_t WO_BR = WO_KV + (size_t)1024 * 256 * 2;
constexpr size_t WO_OUT = WO_BR + (size_t)1024 * 1536 * 2;
constexpr size_t WO_GU = WO_OUT + (size_t)1024 * 1024 * 2;
constexpr size_t WO_D = WO_GU + (size_t)5632 * 1024 * 2;
static_assert(WO_D + (size_t)1024 * 2816 * 2 <= W_LAYER, "weights per layer");
constexpr size_t WS_ACT = WS_W + 2 * W_LAYER;
constexpr size_t WS_XN = WS_ACT;
constexpr size_t WS_QKRAW = WS_XN + 32 * MiB;
constexpr size_t WS_CKV = WS_QKRAW + 32 * MiB;
constexpr size_t WS_IQ = WS_CKV + 8 * MiB;
constexpr size_t WS_Y = WS_QKRAW;
constexpr size_t WS_QK = WS_IQ + 8 * MiB;
constexpr size_t WS_MG = WS_QK;
constexpr size_t WS_VM = WS_QK + 32 * MiB;
constexpr size_t WS_OM = WS_VM + 16 * MiB;
constexpr size_t WS_SQ = WS_OM + 16 * MiB;
constexpr size_t WS_DQ = WS_SQ + 16 * MiB;
constexpr size_t WS_DK = WS_DQ + 16 * MiB;
constexpr size_t WS_DV = WS_DK + 16 * MiB;
constexpr size_t WS_SK = WS_DV + 16 * MiB;
constexpr size_t WS_SV = WS_SK + 16 * MiB;
constexpr size_t WS_IK = WS_SV + 16 * MiB;
constexpr size_t WS_IF = WS_IK + 2 * MiB;
constexpr size_t WS_IW = WS_IF + 512 * 1024;
constexpr size_t WS_RT = WS_IW + 256 * 1024;
constexpr size_t WS_AK = WS_RT + 256 * 1024;
constexpr size_t WS_MQ = WS_AK + 256 * 1024;
constexpr size_t WS_EM = WS_MQ + 256 * 1024;
constexpr size_t WS_MASK = WS_IK + 4 * MiB;
constexpr size_t WS_HREG = WS_MASK + 8 * MiB;
constexpr size_t WS_X16 = WS_HREG + 96 * MiB;
constexpr size_t WS_MD = WS_X16 + 32 * MiB;
constexpr size_t WS_MC = WS_MD + 16 * MiB;
constexpr size_t WS_MN = WS_MC + 8 * MiB;
constexpr size_t WS_END = WS_MN + 1 * MiB;
static_assert(WS_EM + 256 * 1024 <= WS_MASK, "small buffers");
static_assert(WS_END <= 512 * MiB, "workspace");
constexpr int CW_BAR = 4096;
constexpr size_t WS_GAIN = 512 * 1024;

constexpr int RING_BYTES = 131072;
constexpr int LDSCTL_OFF = RING_BYTES, MISC_OFF = LDSCTL_OFF + 320;
constexpr int LDS_BYTES = 147456;
constexpr int NWAVES = 8;

DI float bf2f(unsigned v) { return __uint_as_float(v << 16); }
DI unsigned f2bf(float f) { unsigned u = __float_as_uint(f); return (u + 0x7fffu + ((u >> 16) & 1u)) >> 16; }
DI unsigned pk2(float lo, float hi) { return f2bf(lo) | (f2bf(hi) << 16); }
DI float bflo(unsigned w) { return __uint_as_float(w << 16); }
DI float bfhi(unsigned w) { return __uint_as_float(w & 0xffff0000u); }
typedef unsigned u32x2v __attribute__((ext_vector_type(2)));
DI float xor1(float v)  { return __uint_as_float((unsigned)__builtin_amdgcn_mov_dpp((int)__float_as_uint(v), 0xB1, 0xF, 0xF, true)); }
DI float xor2(float v)  { return __uint_as_float((unsigned)__builtin_amdgcn_mov_dpp((int)__float_as_uint(v), 0x4E, 0xF, 0xF, true)); }
DI float ror4(float v)  { return __uint_as_float((unsigned)__builtin_amdgcn_mov_dpp((int)__float_as_uint(v), 0x124, 0xF, 0xF, true)); }
DI float ror8(float v)  { return __uint_as_float((unsigned)__builtin_amdgcn_mov_dpp((int)__float_as_uint(v), 0x128, 0xF, 0xF, true)); }
DI float sum16x(float v) { const unsigned u = __float_as_uint(v); const auto r = __builtin_amdgcn_permlane16_swap(u, u, false, false); return __uint_as_float(r[0]) + __uint_as_float(r[1]); }
DI float sum32x(float v) { const unsigned u = __float_as_uint(v); const auto r = __builtin_amdgcn_permlane32_swap(u, u, false, false); return __uint_as_float(r[0]) + __uint_as_float(r[1]); }
DI float max16x(float v) { const unsigned u = __float_as_uint(v); const auto r = __builtin_amdgcn_permlane16_swap(u, u, false, false); return fmaxf(__uint_as_float(r[0]), __uint_as_float(r[1])); }
DI float max32x(float v) { const unsigned u = __float_as_uint(v); const auto r = __builtin_amdgcn_permlane32_swap(u, u, false, false); return fmaxf(__uint_as_float(r[0]), __uint_as_float(r[1])); }
DI unsigned shup_u(unsigned v, int o, int lane) { return (unsigned)__builtin_amdgcn_ds_bpermute(((lane - o) & 63) << 2, (int)v); }
DI float shup_f(float v, int o, int lane) { return __uint_as_float(shup_u(__float_as_uint(v), o, lane)); }
DI double shup_d(double v, int o, int lane) { const unsigned long long u = __builtin_bit_cast(unsigned long long, v); const unsigned lo = shup_u((unsigned)u, o, lane), hi = shup_u((unsigned)(u >> 32), o, lane); return __builtin_bit_cast(double, ((unsigned long long)hi << 32) | lo); }
DI unsigned rdl_u(unsigned v, int src) { return (unsigned)__builtin_amdgcn_readlane((int)v, src); }
DI float wave_sum(float v) { v += xor1(v); v += xor2(v); v += ror4(v); v += ror8(v); v = sum16x(v); return sum32x(v); }
DI float wave_max(float v) { v = fmaxf(v, xor1(v)); v = fmaxf(v, xor2(v)); v = fmaxf(v, ror4(v)); v = fmaxf(v, ror8(v)); v = max16x(v); return max32x(v); }
typedef __bf16 bf16x2e_t __attribute__((ext_vector_type(2)));
DI unsigned cvtpk_(float lo, float hi) { f32x2 v = {lo, hi}; bf16x2e_t b = __builtin_convertvector(v, bf16x2e_t); return __builtin_bit_cast(unsigned, b); }
DI float fexp2(float x) { return __builtin_amdgcn_exp2f(x); }
DI float fexp(float x) { return __builtin_amdgcn_exp2f(x * LOG2E); }
DI float frcp(float x) { return __builtin_amdgcn_rcpf(x); }
DI float sigmoidf_(float x) { return frcp(1.0f + fexp(-x)); }
#define WSYNC() do { asm volatile("s_waitcnt lgkmcnt(0)" ::: "memory"); __builtin_amdgcn_wave_barrier(); } while (0)

namespace pg8 {
constexpr int BM = 256, BK = 64, HALF = 128, HTB = HALF * BK * 2, STAGE_BYTES = 8 * HTB, NXCD = 8, WGM = 8;
__host__ __device__ __forceinline__ int lds_byte(int r, int c) { const int st = (r >> 4) * 2 + (c >> 5), rr = r & 15, cc = c & 31, ob = rr * 64 + cc * 2; return st * 1024 + (ob ^ (((ob >> 9) & 1) << 5)); }
__host__ __device__ __forceinline__ void stage_rc(int b, int& R, int& C) { const int st = b / 1024, sb = b % 1024, swz = sb ^ (((sb >> 9) & 1) << 5); R = (st >> 1) * 16 + swz / 64; C = (st & 1) * 32 + (swz % 64) / 2; }
__host__ __device__ __forceinline__ int perm32(int rho) { const int n = rho >> 4, i = rho & 15; return 8 * (i >> 2) + 4 * n + (i & 3); }
struct Unit { int pm, pn; };
struct Gemm { const bf16_t* A; const bf16_t* Bt; int M, N, K; };
struct StaticOrder {
    int nM, nN, nwg, G, c;
    __host__ __device__ void init(int M, int N, int G_, int c_) { nM = M / BM; nN = N / BM; nwg = nM * nN; G = G_; c = c_; }
    __host__ __device__ bool next(int i, Unit& u) const {
        const long L = (long)i * G + c; if (L >= nwg) return false;
        int wgid = (int)L; { const int q = nwg / NXCD, r = nwg % NXCD, xcd = wgid % NXCD, off = wgid / NXCD; wgid = (xcd < r ? xcd * (q + 1) : r * (q + 1) + (xcd - r) * q) + off; }
        const int nig = WGM * nN, gid = wgid / nig, fm = gid * WGM, gsz = (nM - fm) < WGM ? (nM - fm) : WGM;
        u.pm = fm + ((wgid % nig) % gsz); u.pn = (wgid % nig) / gsz; return true;
    }
};
template <class Epi, bool ALIGN_EPI>
__device__ __forceinline__ void gemm_phase(LAS unsigned char* lds, const Gemm g, const StaticOrder& S, const Epi& E, int tid_in) {
    int tid_ = tid_in; asm volatile("" : "+v"(tid_));
    int K_ = g.K; asm volatile("" : "+s"(K_));
    const int tid = tid_, wid = __builtin_amdgcn_readfirstlane(tid >> 6), lane = tid & 63, wr = wid >> 2, wc = wid & 3, fr = lane & 15, fq = lane >> 4;
    const int K = K_, nt = K / BK;
    unsigned voffA[2], voffB[2];
#pragma unroll
    for (int i = 0; i < 2; ++i) { int R, C; stage_rc(tid * 16 + i * 8192, R, C); const int Rb = Epi::PERM ? ((R & ~31) + perm32(R & 31)) : R;
        voffA[i] = (unsigned)(R * K + C) * 2u; voffB[i] = (unsigned)(Rb * K + C) * 2u; }
    const size_t kstep = (size_t)(BK * 2);
    const size_t hstep = (size_t)HALF * K * 2;
    const size_t tstep = 2 * hstep;
    const unsigned ldsw = (unsigned)wid * 1024u;
    const int aoff = lds_byte(wr * 64 + fr, fq * 8), boff = lds_byte(wc * 32 + fr, fq * 8);
#define PG8_SA(b, h) (((b) * 2 + (h)) * HTB)
#define PG8_SB(b, h) ((4 + (b) * 2 + (h)) * HTB)
#define PG8_STAGE(bufoff, gbase, voff) do { _Pragma("unroll") for (int _i = 0; _i < 2; ++_i) \
        __builtin_amdgcn_global_load_lds((const unsigned*)((const char*)(gbase) + (voff)[_i]), (LAS unsigned*)(lds + (bufoff) + ldsw + _i * 8192), 16, 0, 0); } while (0)
#define PG8_LDA(dst, b, h) do { _Pragma("unroll") for (int m = 0; m < 4; ++m) _Pragma("unroll") for (int k = 0; k < 2; ++k) dst[m][k] = *(const LAS bf16x8*)(lds + PG8_SA(b, h) + aoff + m * 2048 + k * 1024); } while (0)
#define PG8_LDB(dst, b, h) do { _Pragma("unroll") for (int n = 0; n < 2; ++n) _Pragma("unroll") for (int k = 0; k < 2; ++k) dst[n][k] = *(const LAS bf16x8*)(lds + PG8_SB(b, h) + boff + n * 2048 + k * 1024); } while (0)
#define PG8_MMA(ai, bj, At, Bt) do { __builtin_amdgcn_s_setprio(1); _Pragma("unroll") for (int m = 0; m < 4; ++m) _Pragma("unroll") for (int n = 0; n < 2; ++n) _Pragma("unroll") for (int k = 0; k < 2; ++k) \
        acc[ai][bj][m][n] = __builtin_amdgcn_mfma_f32_16x16x32_bf16(Bt[n][k], At[m][k], acc[ai][bj][m][n], 0, 0, 0); __builtin_amdgcn_s_setprio(0); } while (0)
#define PG8_WAIT_V(n) asm volatile("s_waitcnt vmcnt(" #n ")" ::: "memory")
#define PG8_WAIT_L(n) asm volatile("s_waitcnt lgkmcnt(" #n ")" ::: "memory")
#define PG8_BAR __builtin_amdgcn_s_barrier()
#define PG8_SCHED __builtin_amdgcn_sched_barrier(0)
    Unit cur, nxt; int ui = 0;
    if (!S.next(0, cur)) return;
    f32x4 acc[2][2][4][2];
    if constexpr (Epi::INIT) { int fr_ = fr, fq_ = fq, wr_ = wr, wc_ = wc; asm volatile("" : "+v"(fr_), "+v"(fq_), "+s"(wr_), "+s"(wc_)); E.init(acc, cur, wr_, wc_, fr_, fq_); }
    else {
#pragma unroll
    for (int a = 0; a < 2; ++a)
#pragma unroll
        for (int b = 0; b < 2; ++b)
#pragma unroll
            for (int m = 0; m < 4; ++m)
#pragma unroll
                for (int n = 0; n < 2; ++n) acc[a][b][m][n] = (f32x4){0.f, 0.f, 0.f, 0.f};
    }
    bf16x8 At[4][2], B0[2][2], B1[2][2];
    const char* cA = (const char*)g.A + (size_t)cur.pm * tstep; const char* cB = (const char*)g.Bt + (size_t)cur.pn * tstep;
    PG8_STAGE(PG8_SB(0, 0), cB, voffB); PG8_STAGE(PG8_SB(0, 1), cB + hstep, voffB); PG8_STAGE(PG8_SA(0, 0), cA, voffA); PG8_STAGE(PG8_SA(0, 1), cA + hstep, voffA);
    if (wr == 1) PG8_BAR;
    PG8_WAIT_V(2); PG8_BAR;
    PG8_STAGE(PG8_SB(1, 0), cB + kstep, voffB); PG8_STAGE(PG8_SA(1, 0), cA + kstep, voffA); PG8_STAGE(PG8_SB(1, 1), cB + hstep + kstep, voffB);
    PG8_WAIT_V(6); PG8_BAR;
    for (;;) {
        const bool has_next = S.next(ui + 1, nxt);
        const char* nA = has_next ? (const char*)g.A + (size_t)nxt.pm * tstep : cA; const char* nB = has_next ? (const char*)g.Bt + (size_t)nxt.pn * tstep : cB;
        for (int t = 0; t < nt; t += 2) {
            const bool last = (t == nt - 2);
            const char* a1 = cA + (size_t)(t + 1) * kstep;
            const char* a2 = last ? nA : cA + (size_t)(t + 2) * kstep; const char* b2 = last ? nB : cB + (size_t)(t + 2) * kstep;
            const char* a3 = a2 + kstep; const char* b3 = b2 + kstep;
            if constexpr (Epi::MIDK) { if (t == 8 || t == 16) { int fr_ = fr, fq_ = fq, wr_ = wr, wc_ = wc; asm volatile("" : "+v"(fr_), "+v"(fq_), "+s"(wr_), "+s"(wc_)); E.mid(acc, cur, t, wr_, wc_, fr_, fq_); } }
            PG8_LDB(B0, 0, 0); PG8_LDB(B1, 0, 1); PG8_SCHED; PG8_LDA(At, 0, 0); PG8_STAGE(PG8_SA(1, 1), a1 + hstep, voffA);
            PG8_WAIT_V(8); PG8_WAIT_L(0); PG8_BAR; PG8_MMA(0, 0, At, B0); PG8_MMA(0, 1, At, B1); PG8_BAR; PG8_SCHED;
            PG8_LDA(At, 0, 1); PG8_STAGE(PG8_SB(0, 0), b2, voffB); PG8_STAGE(PG8_SB(0, 1), b2 + hstep, voffB); PG8_STAGE(PG8_SA(0, 0), a2, voffA);
            PG8_WAIT_V(8); PG8_WAIT_L(0); PG8_BAR; PG8_MMA(1, 0, At, B0); PG8_MMA(1, 1, At, B1); PG8_BAR; PG8_SCHED;
            PG8_LDB(B0, 1, 0); PG8_LDB(B1, 1, 1); PG8_SCHED; PG8_LDA(At, 1, 0); PG8_STAGE(PG8_SA(0, 1), a2 + hstep, voffA);
            PG8_WAIT_V(8); PG8_WAIT_L(0); PG8_BAR; PG8_MMA(0, 0, At, B0); PG8_MMA(0, 1, At, B1); PG8_BAR; PG8_SCHED;
            PG8_LDA(At, 1, 1); PG8_STAGE(PG8_SB(1, 0), b3, voffB); PG8_STAGE(PG8_SB(1, 1), b3 + hstep, voffB); PG8_STAGE(PG8_SA(1, 0), a3, voffA);
            PG8_WAIT_V(8); PG8_WAIT_L(0); PG8_BAR; PG8_MMA(1, 0, At, B0); PG8_MMA(1, 1, At, B1); PG8_BAR; PG8_SCHED;
        }
        if constexpr (ALIGN_EPI) { if (wr == 0) PG8_BAR; }
        { int fr_ = fr, fq_ = fq, wr_ = wr, wc_ = wc; asm volatile("" : "+v"(fr_), "+v"(fq_), "+s"(wr_), "+s"(wc_)); E(acc, cur, wr_, wc_, fr_, fq_); }
        if (!has_next) break;
        if constexpr (Epi::INIT) { int fr_ = fr, fq_ = fq, wr_ = wr, wc_ = wc; asm volatile("" : "+v"(fr_), "+v"(fq_), "+s"(wr_), "+s"(wc_)); E.init(acc, nxt, wr_, wc_, fr_, fq_); }
        else {
#pragma unroll
        for (int a = 0; a < 2; ++a)
#pragma unroll
            for (int b = 0; b < 2; ++b)
#pragma unroll
                for (int m = 0; m < 4; ++m)
#pragma unroll
                    for (int n = 0; n < 2; ++n) acc[a][b][m][n] = (f32x4){0.f, 0.f, 0.f, 0.f};
        }
        cur = nxt; cA = nA; cB = nB; ++ui;
        if constexpr (ALIGN_EPI) { if (wr == 1) PG8_BAR; }
    }
    PG8_WAIT_V(0);
    if constexpr (!ALIGN_EPI) { if (wr == 0) PG8_BAR; }
    PG8_BAR;
#undef PG8_SA
#undef PG8_SB
#undef PG8_STAGE
#undef PG8_LDA
#undef PG8_LDB
#undef PG8_MMA
#undef PG8_WAIT_V
#undef PG8_WAIT_L
#undef PG8_BAR
#undef PG8_SCHED
}
}

#define XB_TMO      128
#define XB_XCNT(j)  (256  + 64 * (j))
#define XB_XSUB(j)  (1280 + 64 * (j))
#define XB_XGEN(j)  (2304 + 64 * (j))
#define XB_TOP      3328
#define XB_TOPGEN   3392
#define XCD_BAR_WORDS 3456
#define XB_SPIN_CAP (1u << 24)
DI unsigned xb_ld(unsigned* p)              { return __hip_atomic_load(p, __ATOMIC_RELAXED, __HIP_MEMORY_SCOPE_AGENT); }
DI unsigned xb_add(unsigned* p, unsigned v) { return __hip_atomic_fetch_add(p, v, __ATOMIC_RELAXED, __HIP_MEMORY_SCOPE_AGENT); }
DI unsigned xb_xcc_id() { return (unsigned)__builtin_amdgcn_s_getreg((3 << 11) | 20) & 0xFu; }
#define XB_SPIN(cond, bar) do { unsigned _sp = 0; while (cond) { __builtin_amdgcn_s_sleep(1); \
    if ((++_sp & 255u) == 0u) { if (xb_ld(&(bar)[XB_TMO])) break; if (_sp > XB_SPIN_CAP) { atomicAdd(&(bar)[XB_TMO], 1u); break; } } } } while (0)
struct XcdBarrier { unsigned* bar; unsigned x; volatile LAS unsigned* st; };
DI XcdBarrier xcd_barrier_post(unsigned* bar, volatile LAS unsigned* st) {
    XcdBarrier b; b.bar = bar; b.x = xb_xcc_id(); b.st = st;
    if (threadIdx.x == 0) (void)xb_add(&bar[XB_XCNT(b.x)], 1u);
    return b;
}
DI void xcd_barrier_complete(unsigned* bar, unsigned x, unsigned& nloc, unsigned& nx) {
    const unsigned G = gridDim.x * gridDim.y * gridDim.z;
    unsigned sum, cnt, mine, sp = 0u;
    for (;;) {
        sum = 0u; cnt = 0u; mine = 0u;
#pragma unroll
        for (unsigned j = 0; j < 16; ++j) { const unsigned c = xb_ld(&bar[XB_XCNT(j)]); sum += c; cnt += (c > 0u) ? 1u : 0u; mine = (j == x) ? c : mine; }
        if (sum == G) break;
        __builtin_amdgcn_s_sleep(1);
        if ((++sp & 255u) == 0u) { if (xb_ld(&bar[XB_TMO])) break; if (sp > XB_SPIN_CAP) { atomicAdd(&bar[XB_TMO], 1u); break; } }
    }
    nloc = mine > 0u ? mine : 1u; nx = cnt > 0u ? cnt : 1u;
}
DI void xcd_barrier(const XcdBarrier& b_in) {
    XcdBarrier b = b_in; { unsigned x_ = b.x; asm volatile("" : "+s"(x_)); b.x = x_; }
    asm volatile("s_waitcnt vmcnt(0)" ::: "memory");
    __syncthreads();
    if (threadIdx.x == 0) {
        unsigned* bar = b.bar;
        __builtin_amdgcn_s_waitcnt(0);
        unsigned nloc = b.st[0], nx = b.st[1];
        if (nloc == 0u) { xcd_barrier_complete(bar, b.x, nloc, nx); b.st[0] = nloc; b.st[1] = nx; }
        const unsigned old = xb_add(&bar[XB_XSUB(b.x)], 1u);
        const unsigned gen = old / nloc;
        if (old + 1u == (gen + 1u) * nloc) {
            __builtin_amdgcn_fence(__ATOMIC_RELEASE, "agent");
            asm volatile("s_waitcnt vmcnt(0)" ::: "memory");
            const unsigned og = xb_add(&bar[XB_TOP], 1u);
            const unsigned tg = og / nx;
            if (og + 1u == (tg + 1u) * nx) xb_add(&bar[XB_TOPGEN], 1u);
            else XB_SPIN(xb_ld(&bar[XB_TOPGEN]) == tg, bar);
            __builtin_amdgcn_fence(__ATOMIC_ACQUIRE, "agent");
            xb_add(&bar[XB_XGEN(b.x)], 1u);
            asm volatile("s_waitcnt vmcnt(0)" ::: "memory");
        } else {
            XB_SPIN(xb_ld(&bar[XB_XGEN(b.x)]) == gen, bar);
            __builtin_amdgcn_fence(__ATOMIC_ACQUIRE, "agent");
            asm volatile("s_waitcnt vmcnt(0)" ::: "memory");
        }
    }
    __syncthreads();
}

struct Args { const float* in[21]; float* out; unsigned char* ws; int it_lo, it_hi, ph_lo, ph_hi; };
enum { I_X = 0, I_NMG, I_WIN, I_BG, I_CW, I_CB, I_GB, I_MNG, I_KVNG, I_WKV, I_SQG, I_SKG, I_DQG, I_DKG, I_LAM, I_DOG, I_WBR, I_WOUT, I_NFG, I_WGU, I_WD };

struct Frame {
    LAS unsigned char* lds;
    unsigned char* ws;
    int tid, lane, wave, G, bid;
    int wave0;
    DI void refresh() {
        int l_; asm volatile("v_mbcnt_lo_u32_b32 %0, -1, 0\n\tv_mbcnt_hi_u32_b32 %0, -1, %0" : "=v"(l_));
        unsigned char* w_ = ws; int g_ = G, b_ = bid, wv_ = wave0; asm volatile("" : "+s"(w_), "+s"(g_), "+s"(b_), "+s"(wv_));
        ws = w_; G = g_; bid = b_; lane = l_; wave = wv_; tid = wv_ * 64 + l_; }
};

DI int map_in(int n) {
    const int pn = n >> 8, p = n & 255, bj = p >> 7, wcq = p & 127, wc = wcq >> 5, q = wcq & 31;
    const int hd = 32 * bj + q;
    switch (pn) {
        case 0: case 1: case 2: case 3: return Z_MQK + n;
        case 4: case 5: return Z_MV + (n - 4 * 256);
        case 6: case 7: return Z_MO + (n - 6 * 256);
        case 8: case 9: return Z_SQ + (4 * (pn - 8) + wc) * 64 + hd;
        case 10: return Z_CKV + p;
        case 11: return Z_IQ + wc * 64 + hd;
        case 12: case 13: return Z_DQ + (4 * (pn - 12) + wc) * 64 + hd;
        case 14: case 15: return Z_DK + (4 * (pn - 14) + wc) * 64 + hd;
        case 16: case 17: return Z_DV + (n - 16 * 256);
        default:
            if (wc == 0) return Z_IK + hd;
            if (wc == 1 && bj == 0) { if (q < 8) return Z_MIF + q; if (q < 12) return Z_IW + (q - 8); }
            return -1;
    }
}
DI int map_kv(int n) {
    const int pn = n >> 8, p = n & 255, bj = p >> 7, wcq = p & 127, wc = wcq >> 5, q = wcq & 31;
    if (pn < 2) return (4 * pn + wc) * 64 + 32 * bj + q;
    return n;
}
DI int map_gu(int n) {
    const int pn = n >> 8, p = n & 255;
    return (p >> 7) * FF + 128 * pn + (p & 127);
}
template <int MAP>
DI void transpose_item(const float* W, int ldw, int cbase, const float* kscale, bf16_t* WT, int ldo, int koff, int nblk, LAS float* scr, int item, int lane) {
    const int kb = item / nblk, nb = item % nblk, k0 = 64 * kb, n0 = 32 * nb;
    const int n = n0 + (lane & 31);
    int src;
    if (MAP == 0) src = n; else if (MAP == 1) src = map_in(n); else if (MAP == 2) src = map_kv(n); else src = map_gu(n);
    float tv_[32];
    const int srcc = src >= 0 ? src : 0;
#pragma unroll
    for (int i = 0; i < 32; ++i) tv_[i] = W[(size_t)(k0 + 2 * i + (lane >> 5)) * ldw + cbase + srcc];
#pragma unroll
    for (int i = 0; i < 32; ++i) { const int kk = 2 * i + (lane >> 5);
        float v = src >= 0 ? tv_[i] : 0.f;
        if (kscale) v *= kscale[k0 + kk];
        scr[kk * 33 + (lane & 31)] = v; }
    WSYNC();
    const int c = lane & 7;
#pragma unroll
    for (int j = 0; j < 4; ++j) { const int nn = (lane >> 3) + 8 * j; const LAS float* s = scr + (8 * c) * 33 + nn;
        u32x4 o; o.x = pk2(s[0 * 33], s[1 * 33]); o.y = pk2(s[2 * 33], s[3 * 33]); o.z = pk2(s[4 * 33], s[5 * 33]); o.w = pk2(s[6 * 33], s[7 * 33]);
        *(u32x4*)(WT + (size_t)(n0 + nn) * ldo + koff + k0 + 8 * c) = o; }
    WSYNC();
}
__device__ const float INVF[32] = {1.000000000e+00f, 7.498942018e-01f, 5.623413324e-01f, 4.216965139e-01f, 3.162277639e-01f, 2.371373922e-01f, 1.778279394e-01f, 1.333521456e-01f,
    1.000000015e-01f, 7.498941571e-02f, 5.623412877e-02f, 4.216964915e-02f, 3.162277862e-02f, 2.371373586e-02f, 1.778279431e-02f, 1.333521493e-02f,
    9.999999776e-03f, 7.498942316e-03f, 5.623413250e-03f, 4.216964822e-03f, 3.162277862e-03f, 2.371373819e-03f, 1.778279431e-03f, 1.333521446e-03f,
    1.000000047e-03f, 7.498941850e-04f, 5.623413017e-04f, 4.216965463e-04f, 3.162277862e-04f, 2.371373848e-04f, 1.778279402e-04f, 1.333521504e-04f};
DI void sincos_acc(float angf, float& c, float& s) {
    const double x = (double)angf;
    const double kd = __builtin_rint(x * 0.63661977236758134308);
    const double r = (x - kd * 1.5707963267948965580) - kd * 6.1232339957367658860e-17;
    const double r2 = r * r;
    double sp = -1.0 / 39916800.0; sp = sp * r2 + 1.0 / 362880.0; sp = sp * r2 - 1.0 / 5040.0; sp = sp * r2 + 1.0 / 120.0; sp = sp * r2 - 1.0 / 6.0; sp = sp * r2 + 1.0; sp *= r;
    double cp = 1.0 / 479001600.0; cp = cp * r2 - 1.0 / 3628800.0; cp = cp * r2 + 1.0 / 40320.0; cp = cp * r2 - 1.0 / 720.0; cp = cp * r2 + 1.0 / 24.0; cp = cp * r2 - 0.5; cp = cp * r2 + 1.0;
    const int k = (int)kd & 3;
    double cc, ss;
    if (k == 0) { cc = cp; ss = sp; } else if (k == 1) { cc = -sp; ss = cp; } else if (k == 2) { cc = -cp; ss = -sp; } else { cc = sp; ss = -cp; }
    c = (float)cc; s = (float)ss;
}
DI void phase_prologue(Frame& F, const Args& a) {
    F.refresh();
    LAS float* scr = (LAS float*)(F.lds + F.wave * 16384);
    const int gw = F.bid * NWAVES + F.wave, NGW = F.G * NWAVES;
    float* COS = (float*)(F.ws + WS_COS); float* SIN = (float*)(F.ws + WS_SIN);
    for (int i = gw * 64 + F.lane; i < SEQ * 32; i += NGW * 64) { const int t = i >> 5, f = i & 31; float c, s; sincos_acc((float)t * INVF[f], c, s); COS[i] = c; SIN[i] = s; }
    if (gw == 0) { float* GN = (float*)(F.ws + WS_GAIN);
        for (int l = 0; l < DEPTH; ++l) { GN[(l * 4 + 0) * 64 + F.lane] = a.in[I_SQG][l * 64 + F.lane]; GN[(l * 4 + 1) * 64 + F.lane] = a.in[I_DQG][l * 64 + F.lane];
            GN[(l * 4 + 2) * 64 + F.lane] = a.in[I_DKG][l * 64 + F.lane]; GN[(l * 4 + 3) * 64 + F.lane] = a.in[I_SKG][l * 64 + F.lane]; } }
    for (int l = 0; l < DEPTH; ++l) {
        unsigned char* wl = F.ws + WS_W + (size_t)l * W_LAYER;
        const float* w_in = a.in[I_WIN] + (size_t)l * DM * IN_COLS;
        { const int nblk = NT_IN * 256 / 32, nit = (DM / 64) * nblk;
          for (int it = gw; it < nit; it += NGW) transpose_item<1>(w_in, IN_COLS, 0, nullptr, (bf16_t*)(wl + WO_IN), DM, 0, nblk, scr, it, F.lane); }
        { const int nblk = 3072 / 32, nit = (DM / 64) * nblk;
          for (int it = gw; it < nit; it += NGW) transpose_item<0>(w_in, IN_COLS, Z_G, nullptr, (bf16_t*)(wl + WO_G), DM, 0, nblk, scr, it, F.lane); }
        { const int nblk = 1024 / 32, nit = (256 / 64) * nblk;
          for (int it = gw; it < nit; it += NGW) transpose_item<2>(a.in[I_WKV] + (size_t)l * 256 * 1024, 1024, 0, a.in[I_KVNG] + l * 256, (bf16_t*)(wl + WO_KV), 256, 0, nblk, scr, it, F.lane); }
        for (int b = 0; b < 3; ++b) { const int nblk = 1024 / 32, nit = (512 / 64) * nblk;
          for (int it = gw; it < nit; it += NGW) transpose_item<0>(a.in[I_WBR] + ((size_t)l * 3 + b) * 512 * 1024, 1024, 0, nullptr, (bf16_t*)(wl + WO_BR), 1536, b * 512, nblk, scr, it, F.lane); }
        { const int nblk = 1024 / 32, nit = (1024 / 64) * nblk;
          for (int it = gw; it < nit; it += NGW) transpose_item<0>(a.in[I_WOUT] + (size_t)l * 1024 * 1024, 1024, 0, nullptr, (bf16_t*)(wl + WO_OUT), 1024, 0, nblk, scr, it, F.lane); }
        { const int nblk = 5632 / 32, nit = (1024 / 64) * nblk;
          for (int it = gw; it < nit; it += NGW) transpose_item<3>(a.in[I_WGU] + (size_t)l * 1024 * 5632, 5632, 0, nullptr, (bf16_t*)(wl + WO_GU), 1024, 0, nblk, scr, it, F.lane); }
        { const int nblk = 1024 / 32, nit = (2816 / 64) * nblk;
          for (int it = gw; it < nit; it += NGW) transpose_item<0>(a.in[I_WD] + (size_t)l * 2816 * 1024, 1024, 0, nullptr, (bf16_t*)(wl + WO_D), 2816, 0, nblk, scr, it, F.lane); }
    }
}

DI void phase_rmsnorm(Frame& F, const void* xv, const bool src16, const float* gain, bf16_t* out) {
    F.refresh();
    const int gw = F.bid * NWAVES + F.wave, NGW = F.G * NWAVES;
    f32x4 gv[4];
#pragma unroll
    for (int j = 0; j < 4; ++j) gv[j] = *(const f32x4*)(gain + 4 * F.lane + 256 * j);
    for (int m = gw; m < MC; m += NGW) {
        f32x4 v[4]; float s = 0.f;
        if (src16) { const GAS u32x2* xr = (const GAS u32x2*)((const bf16_t*)xv + (size_t)m * DM) + F.lane;
#pragma unroll
            for (int j = 0; j < 4; ++j) { const u32x2 w = xr[64 * j]; v[j] = (f32x4){bflo(w.x), bfhi(w.x), bflo(w.y), bfhi(w.y)}; }
        } else { const GAS f32x4* xr = (const GAS f32x4*)((const float*)xv + (size_t)m * DM) + F.lane;
#pragma unroll
            for (int j = 0; j < 4; ++j) v[j] = xr[64 * j]; }
#pragma unroll
        for (int j = 0; j < 4; ++j) s += (v[j].x * v[j].x + v[j].y * v[j].y) + (v[j].z * v[j].z + v[j].w * v[j].w);
        const float r = 1.0f / sqrtf(wave_sum(s) * (1.f / DM) + EPS);
        u32x2* o8 = (u32x2*)(out + (size_t)m * DM) + F.lane;
#pragma unroll
        for (int j = 0; j < 4; ++j) { u32x2 w; w.x = cvtpk_(v[j].x * r * gv[j].x, v[j].y * r * gv[j].y); w.y = cvtpk_(v[j].z * r * gv[j].z, v[j].w * r * gv[j].w); o8[64 * j] = w; }
    }
}
DI float log_sigmoid(float x) {
    const float ax = fabsf(x), y = fexp(-ax);
    float l1p;
    if (y < 0.06f) l1p = y * (1.f - y * (0.5f - y * (0.33333333f - y * (0.25f - y * 0.2f))));
    else l1p = __builtin_amdgcn_logf(1.f + y) * 0.69314718056f;
    return fminf(x, 0.f) - l1p;
}
DI void phase_token(Frame& F, const Args& a, int l, const int probe) {
    F.refresh();
    const int gw0 = F.bid * NWAVES + F.wave, NGW = F.G * NWAVES, NSC = CB * 4, NCV = NGW - NSC;
    const bool scanw = (F.wave == NWAVES - 1) && (F.bid < NSC);
    const int gw = scanw ? NCV : gw0 - ((gw0 >> 3) < NSC ? (gw0 >> 3) : NSC);
    if (!scanw) { if (probe != 2) {
    const bf16_t* QKRAW = (const bf16_t*)(F.ws + WS_QKRAW); bf16_t* QK = (bf16_t*)(F.ws + WS_QK);
    const bf16_t* CKV = (const bf16_t*)(F.ws + WS_CKV); float* RT = (float*)(F.ws + WS_RT);
    const float* cw = a.in[I_CW] + (size_t)l * 4 * 1024; const float* cb = a.in[I_CB] + (size_t)l * 1024;
    const int c0 = F.lane * 16;
    float w[4][16], bs[16];
#pragma unroll
    for (int j = 0; j < 4; ++j)
#pragma unroll
        for (int i = 0; i < 16; ++i) w[j][i] = cw[j * 1024 + c0 + i];
#pragma unroll
    for (int i = 0; i < 16; ++i) bs[i] = cb[c0 + i];
    const float ksc = (c0 >= 512) ? 0.08838834764831845f : 1.0f;
    for (int m = gw; m < MC; m += NCV) {
        const int t = m & (SEQ - 1);
        float accv[16];
#pragma unroll
        for (int i = 0; i < 16; ++i) accv[i] = bs[i];
        u32x4 tv[4][2];
#pragma unroll
        for (int j = 0; j < 4; ++j) { const int tt = t - 3 + j; const u32x4* p = (const u32x4*)(QKRAW + (size_t)(tt >= 0 ? m - 3 + j : m) * 1024 + c0); tv[j][0] = p[0]; tv[j][1] = p[1]; }
        const u32x2 ckv4 = *(const u32x2*)(CKV + (size_t)m * 256 + 4 * F.lane);
#pragma unroll
        for (int j = 0; j < 4; ++j) { const float on = (t - 3 + j >= 0) ? 1.f : 0.f;
            const unsigned ww[8] = {tv[j][0].x, tv[j][0].y, tv[j][0].z, tv[j][0].w, tv[j][1].x, tv[j][1].y, tv[j][1].z, tv[j][1].w};
#pragma unroll
            for (int i = 0; i < 8; ++i) { accv[2 * i] += on * w[j][2 * i] * bflo(ww[i]); accv[2 * i + 1] += on * w[j][2 * i + 1] * bfhi(ww[i]); } }
        unsigned o[8];
#pragma unroll
        for (int i = 0; i < 8; ++i) { const float x0 = accv[2 * i], x1 = accv[2 * i + 1]; o[i] = pk2(x0 * sigmoidf_(x0) * ksc, x1 * sigmoidf_(x1) * ksc); }
        u32x4* q = (u32x4*)(QK + (size_t)m * 1024 + c0); q[0] = (u32x4){o[0], o[1], o[2], o[3]}; q[1] = (u32x4){o[4], o[5], o[6], o[7]};
        { const u32x2 v = ckv4; const float a0 = bflo(v.x), a1 = bfhi(v.x), a2 = bflo(v.y), a3 = bfhi(v.y);
          const float ss = wave_sum((a0 * a0 + a1 * a1) + (a2 * a2 + a3 * a3)); if (F.lane == 0) RT[m] = 1.0f / sqrtf(ss * (1.f / 256.f) + EPS); }
    }
    } } else if (probe != 1) {
        const int sq = F.bid, b = sq >> 2, h = sq & 3, lane = F.lane; const float* IFb = (const float*)(F.ws + WS_IF) + (size_t)b * SEQ * 8;
        float* AK = (float*)(F.ws + WS_AK) + (size_t)sq * SEQ; float* MQ = (float*)(F.ws + WS_MQ) + (size_t)sq * SEQ; float* EM = (float*)(F.ws + WS_EM) + (size_t)sq * SEQ;
        LAS float* X0 = (LAS float*)F.lds; LAS float* X1 = X0 + 4160; LAS float* X2 = X1 + 4160;
#pragma unroll 1
        for (int c = 0; c < 4; ++c) { float fv[16], iv[16];
#pragma unroll
            for (int kk = 0; kk < 16; ++kk) { const size_t t = (size_t)64 * (16 * c + kk) + lane; fv[kk] = *(const GAS float*)(IFb + t * 8 + 4 + h); iv[kk] = *(const GAS float*)(IFb + t * 8 + h); }
#pragma unroll
            for (int kk = 0; kk < 16; ++kk) { const int t = 64 * (16 * c + kk) + lane; X0[t + (t >> 6)] = fv[kk]; X1[t + (t >> 6)] = iv[kk]; } }
        WSYNC();
        const int tb = 65 * lane;
        double sum = 0.0;
#pragma unroll 8
        for (int j = 0; j < 64; ++j) { const float lf = log_sigmoid(X0[tb + j]); X0[tb + j] = lf; sum += (double)lf; }
        double inc = sum;
#pragma unroll
        for (int o = 1; o < 64; o <<= 1) { const double y = shup_d(inc, o, lane); if (lane >= o) inc += y; }
        double bb = inc - sum; float mx = -INFINITY;
#pragma unroll 8
        for (int j = 0; j < 64; ++j) { bb += (double)X0[tb + j]; const float av = (float)((double)X1[tb + j] - bb); X1[tb + j] = av; X0[tb + j] = (float)bb; mx = fmaxf(mx, av); }
        float minc = mx;
#pragma unroll
        for (int o = 1; o < 64; o <<= 1) { const float y = shup_f(minc, o, lane); if (lane >= o) minc = fmaxf(minc, y); }
        float mrun = shup_f(minc, 1, lane); if (lane == 0) mrun = -INFINITY;
#pragma unroll 8
        for (int j = 0; j < 64; ++j) { mrun = fmaxf(mrun, X1[tb + j]); X2[tb + j] = mrun; X0[tb + j] = fexp(-(X0[tb + j] + mrun)); }
        WSYNC();
#pragma unroll 8
        for (int k = 0; k < 64; ++k) { const int t = 64 * k + lane, ix = t + k; AK[t] = X1[ix]; MQ[t] = X2[ix]; EM[t] = X0[ix]; }
    }
}

DI void store8(bf16_t* p, f32x4 v0, f32x4 v1) { u32x4 w; w.x = cvtpk_(v0[0], v0[1]); w.y = cvtpk_(v0[2], v0[3]); w.z = cvtpk_(v1[0], v1[1]); w.w = cvtpk_(v1[2], v1[3]); *(u32x4*)p = w; }
DI void head_norm_rope(f32x4 (&x)[2][2], bool norm, const f32x4 (&gn)[2][2], const float* cosr, const float* sinr, int fq, float scale) {
    if (norm) {
        float ss = 0.f;
#pragma unroll
        for (int bj = 0; bj < 2; ++bj)
#pragma unroll
            for (int n = 0; n < 2; ++n) ss += (x[bj][n][0] * x[bj][n][0] + x[bj][n][1] * x[bj][n][1]) + (x[bj][n][2] * x[bj][n][2] + x[bj][n][3] * x[bj][n][3]);
        ss = sum16x(ss); ss = sum32x(ss);
        const float r = 1.0f / sqrtf(ss * (1.f / 64.f) + EPS);
#pragma unroll
        for (int bj = 0; bj < 2; ++bj)
#pragma unroll
            for (int n = 0; n < 2; ++n) x[bj][n] = x[bj][n] * r * gn[bj][n];
    }
#pragma unroll
    for (int n = 0; n < 2; ++n) { const f32x4 c = *(const f32x4*)(cosr + 8 * fq + 4 * n), s = *(const f32x4*)(sinr + 8 * fq + 4 * n);
        const f32x4 x1 = x[0][n], x2 = x[1][n]; x[0][n] = (x1 * c - x2 * s) * scale; x[1][n] = (x1 * s + x2 * c) * scale; }
}
DI void head_norm_rope_cs(f32x4 (&x)[2][2], bool norm, const f32x4 (&gn)[2][2], const f32x4 (&c)[2], const f32x4 (&sn)[2], float scale) {
    if (norm) {
        float ss = 0.f;
#pragma unroll
        for (int bj = 0; bj < 2; ++bj)
#pragma unroll
            for (int n = 0; n < 2; ++n) ss += (x[bj][n][0] * x[bj][n][0] + x[bj][n][1] * x[bj][n][1]) + (x[bj][n][2] * x[bj][n][2] + x[bj][n][3] * x[bj][n][3]);
        ss = sum16x(ss); ss = sum32x(ss);
        const float r = 1.0f / sqrtf(ss * (1.f / 64.f) + EPS);
#pragma unroll
        for (int bj = 0; bj < 2; ++bj)
#pragma unroll
            for (int n = 0; n < 2; ++n) x[bj][n] = x[bj][n] * r * gn[bj][n];
    }
#pragma unroll
    for (int n = 0; n < 2; ++n) { const f32x4 x1 = x[0][n], x2 = x[1][n]; x[0][n] = (x1 * c[n] - x2 * sn[n]) * scale; x[1][n] = (x1 * sn[n] + x2 * c[n]) * scale; }
}
struct EpiInProj {
    static constexpr bool PERM = true, MIDK = false, INIT = false;
    unsigned char* ws; const float* gate_b; int layer;
    DI void operator()(const f32x4 (&acc)[2][2][4][2], const pg8::Unit& u, int wr, int wc, int fr, int fq) const {
        const int pn = u.pn; const int rowb = u.pm * 256 + wr * 64 + fr;
        if (pn < 8 || pn == 10 || pn == 16 || pn == 17) {
            size_t doff; int ldc, cb; bool sg = false;
            if (pn < 4) { doff = WS_QKRAW; ldc = 1024; cb = pn * 256; }
            else if (pn < 6) { doff = WS_VM; ldc = 512; cb = (pn - 4) * 256; }
            else if (pn < 8) { doff = WS_OM; ldc = 512; cb = (pn - 6) * 256; sg = true; }
            else if (pn == 10) { doff = WS_CKV; ldc = 256; cb = 0; }
            else { doff = WS_DV; ldc = 512; cb = (pn - 16) * 256; }
            bf16_t* dst = (bf16_t*)(ws + doff);
#pragma unroll
            for (int ai = 0; ai < 2; ++ai)
#pragma unroll
                for (int m = 0; m < 4; ++m) { bf16_t* rowp = dst + (size_t)(rowb + ai * 128 + m * 16) * ldc + cb + wc * 32 + 8 * fq;
#pragma unroll
                    for (int bj = 0; bj < 2; ++bj) { f32x4 v0 = acc[ai][bj][m][0], v1 = acc[ai][bj][m][1];
                        if (sg) {
#pragma unroll
                            for (int j = 0; j < 4; ++j) { v0[j] = sigmoidf_(v0[j]); v1[j] = sigmoidf_(v1[j]); } }
                        store8(rowp + bj * 128, v0, v1); } }
        } else if (pn == 18) {
            const float* COS = (const float*)(ws + WS_COS); const float* SIN = (const float*)(ws + WS_SIN);
            if (wc == 0) {
                bf16_t* dst = (bf16_t*)(ws + WS_IK); f32x4 gn[2][2];
#pragma unroll
                for (int bj = 0; bj < 2; ++bj)
#pragma unroll
                    for (int n = 0; n < 2; ++n) gn[bj][n] = (f32x4){1.f, 1.f, 1.f, 1.f};
#pragma unroll
                for (int ai = 0; ai < 2; ++ai)
#pragma unroll
                    for (int m = 0; m < 4; ++m) { const int row = rowb + ai * 128 + m * 16, t = row & (SEQ - 1);
                        f32x4 x[2][2] = {{acc[ai][0][m][0], acc[ai][0][m][1]}, {acc[ai][1][m][0], acc[ai][1][m][1]}};
                        head_norm_rope(x, false, gn, COS + t * 32, SIN + t * 32, fq, 1.0f);
#pragma unroll
                        for (int bj = 0; bj < 2; ++bj) store8(dst + (size_t)row * 64 + 32 * bj + 8 * fq, x[bj][0], x[bj][1]);
                        asm volatile("" ::: "memory"); }
            } else if (wc == 1) {
                float* IFp = (float*)(ws + WS_IF); float* IWp = (float*)(ws + WS_IW);
#pragma unroll
                for (int ai = 0; ai < 2; ++ai)
#pragma unroll
                    for (int m = 0; m < 4; ++m) { const int row = rowb + ai * 128 + m * 16;
                        if (fq == 0) { *(f32x4*)(IFp + (size_t)row * 8) = acc[ai][0][m][0] + *(const f32x4*)gate_b; *(f32x4*)(IFp + (size_t)row * 8 + 4) = acc[ai][0][m][1] + *(const f32x4*)(gate_b + 4); }
                        else if (fq == 1) { *(f32x4*)(IWp + (size_t)row * 4) = acc[ai][0][m][0] * 0.0625f; } }
            }
        } else {
            const float* COS = (const float*)(ws + WS_COS); const float* SIN = (const float*)(ws + WS_SIN);
            size_t doff; int gi, pn0; float scale; bool norm = true; int ldc = 512;
            if (pn < 10) { doff = WS_SQ; gi = 0; pn0 = 8; scale = C2; }
            else if (pn == 11) { doff = WS_IQ; gi = 0; pn0 = 11; scale = 1.f; norm = false; ldc = 256; }
            else if (pn < 14) { doff = WS_DQ; gi = 1; pn0 = 12; scale = C2; }
            else { doff = WS_DK; gi = 2; pn0 = 14; scale = 1.f; }
            bf16_t* dst = (bf16_t*)(ws + doff); const float* g = (const float*)(ws + WS_GAIN) + (layer * 4 + gi) * 64;
            f32x4 gn[2][2];
#pragma unroll
            for (int bj = 0; bj < 2; ++bj)
#pragma unroll
                for (int n = 0; n < 2; ++n) gn[bj][n] = *(const f32x4*)(g + 32 * bj + 8 * fq + 4 * n);
            const int head = 4 * (pn - pn0) + wc;
#pragma unroll
            for (int ai = 0; ai < 2; ++ai)
#pragma unroll
              for (int mp = 0; mp < 4; mp += 2) {
                f32x4 cc[2][2], sn[2][2];
#pragma unroll
                for (int m = 0; m < 2; ++m) { const int t = (rowb + ai * 128 + (mp + m) * 16) & (SEQ - 1);
#pragma unroll
                    for (int n = 0; n < 2; ++n) { cc[m][n] = *(const GAS f32x4*)(COS + t * 32 + 8 * fq + 4 * n); sn[m][n] = *(const GAS f32x4*)(SIN + t * 32 + 8 * fq + 4 * n); } }
#pragma unroll
                for (int m = 0; m < 2; ++m) { const int row = rowb + ai * 128 + (mp + m) * 16;
                    f32x4 x[2][2] = {{acc[ai][0][mp + m][0], acc[ai][0][mp + m][1]}, {acc[ai][1][mp + m][0], acc[ai][1][mp + m][1]}};
                    head_norm_rope_cs(x, norm, gn, cc[m], sn[m], scale);
#pragma unroll
                    for (int bj = 0; bj < 2; ++bj) store8(dst + (size_t)row * ldc + head * 64 + 32 * bj + 8 * fq, x[bj][0], x[bj][1]); }
                asm volatile("" ::: "memory");
              }
        }
    }
};
struct EpiKV {
    static constexpr bool PERM = true, MIDK = false, INIT = false;
    unsigned char* ws; int layer;
    DI void operator()(const f32x4 (&acc)[2][2][4][2], const pg8::Unit& u, int wr, int wc, int fr, int fq) const {
        const int pn = u.pn; const int rowb = u.pm * 256 + wr * 64 + fr; const float* RT = (const float*)(ws + WS_RT);
        if (pn >= 2) {
            bf16_t* dst = (bf16_t*)(ws + WS_SV);
#pragma unroll
            for (int ai = 0; ai < 2; ++ai)
#pragma unroll
                for (int m = 0; m < 4; ++m) { const int row = rowb + ai * 128 + m * 16; const float r = RT[row]; bf16_t* rowp = dst + (size_t)row * 512 + (pn - 2) * 256 + wc * 32 + 8 * fq;
#pragma unroll
                    for (int bj = 0; bj < 2; ++bj) store8(rowp + bj * 128, acc[ai][bj][m][0] * r, acc[ai][bj][m][1] * r); }
        } else {
            const float* COS = (const float*)(ws + WS_COS); const float* SIN = (const float*)(ws + WS_SIN);
            bf16_t* dst = (bf16_t*)(ws + WS_SK); f32x4 gn[2][2];
#pragma unroll
            for (int bj = 0; bj < 2; ++bj)
#pragma unroll
                for (int n = 0; n < 2; ++n) gn[bj][n] = *(const f32x4*)((const float*)(ws + WS_GAIN) + (layer * 4 + 3) * 64 + 32 * bj + 8 * fq + 4 * n);
            const int head = 4 * pn + wc;
#pragma unroll
            for (int ai = 0; ai < 2; ++ai)
#pragma unroll
              for (int mp = 0; mp < 4; mp += 2) {
                f32x4 cc[2][2], sn[2][2]; float rr[2];
#pragma unroll
                for (int m = 0; m < 2; ++m) { const int row = rowb + ai * 128 + (mp + m) * 16, t = row & (SEQ - 1); rr[m] = *(const GAS float*)(RT + row);
#pragma unroll
                    for (int n = 0; n < 2; ++n) { cc[m][n] = *(const GAS f32x4*)(COS + t * 32 + 8 * fq + 4 * n); sn[m][n] = *(const GAS f32x4*)(SIN + t * 32 + 8 * fq + 4 * n); } }
#pragma unroll
                for (int m = 0; m < 2; ++m) { const int row = rowb + ai * 128 + (mp + m) * 16; const float r = rr[m];
                    f32x4 x[2][2] = {{acc[ai][0][mp + m][0] * r, acc[ai][0][mp + m][1] * r}, {acc[ai][1][mp + m][0] * r, acc[ai][1][mp + m][1] * r}};
                    head_norm_rope_cs(x, true, gn, cc[m], sn[m], 1.0f);
#pragma unroll
                    for (int bj = 0; bj < 2; ++bj) store8(dst + (size_t)row * 512 + head * 64 + 32 * bj + 8 * fq, x[bj][0], x[bj][1]); }
                asm volatile("" ::: "memory");
              }
        }
    }
};
DI size_t gq_off(int pm, int png, int wave, int am, int lane) { return ((((size_t)pm * 12 + png) * 8 + wave) * 8 + am) * 1024 + (size_t)lane * 16; }
struct EpiGate {
    static constexpr bool PERM = true, MIDK = false, INIT = false;
    unsigned char* G; const float* bias;
    DI void operator()(const f32x4 (&acc)[2][2][4][2], const pg8::Unit& u, int wr, int wc, int fr, int fq) const {
        const int col0 = u.pn * 256 + wc * 32 + 8 * fq, wave = wr * 4 + wc, lane = fq * 16 + fr;
        f32x4 bv[2][2];
#pragma unroll
        for (int bj = 0; bj < 2; ++bj)
#pragma unroll
            for (int n = 0; n < 2; ++n) bv[bj][n] = *(const f32x4*)(bias + col0 + bj * 128 + 4 * n);
#pragma unroll
        for (int ai = 0; ai < 2; ++ai)
#pragma unroll
            for (int m = 0; m < 4; ++m) { unsigned w[4];
#pragma unroll
                for (int bj = 0; bj < 2; ++bj)
#pragma unroll
                    for (int n = 0; n < 2; ++n) { const f32x4 v = acc[ai][bj][m][n] + bv[bj][n]; unsigned q = 0u;
#pragma unroll
                        for (int j = 0; j < 4; ++j) q = __builtin_amdgcn_cvt_pk_u8_f32(sigmoidf_(v[j]) * 255.0f, j, q);
                        w[2 * bj + n] = q; }
                *(u32x4*)(G + gq_off(u.pm, u.pn, wave, ai * 4 + m, lane)) = (u32x4){w[0], w[1], w[2], w[3]}; }
    }
};
struct EpiMerge {
    static constexpr bool PERM = true, MIDK = true, INIT = false;
    const unsigned char* G; bf16_t* MG;
    DI static float ub(unsigned w, int k) { return (float)((w >> (8 * k)) & 0xFFu); }
    DI void mid(f32x4 (&acc)[2][2][4][2], const pg8::Unit& u, int t, int wr, int wc, int fr, int fq) const {
        const int seg = (t >> 3) - 1, wave = wr * 4 + wc, lane = fq * 16 + fr;
#pragma unroll
        for (int ai = 0; ai < 2; ++ai) {
            u32x4 ga[4], gb[4];
#pragma unroll
            for (int m = 0; m < 4; ++m) { ga[m] = *(const GAS u32x4*)(G + gq_off(u.pm, seg * 4 + u.pn, wave, ai * 4 + m, lane)); gb[m] = *(const GAS u32x4*)(G + gq_off(u.pm, (seg + 1) * 4 + u.pn, wave, ai * 4 + m, lane)); }
#pragma unroll
            for (int m = 0; m < 4; ++m) { const unsigned aw[4] = {ga[m].x, ga[m].y, ga[m].z, ga[m].w}, bw[4] = {gb[m].x, gb[m].y, gb[m].z, gb[m].w};
#pragma unroll
                for (int bj = 0; bj < 2; ++bj)
#pragma unroll
                    for (int n = 0; n < 2; ++n)
#pragma unroll
                        for (int j = 0; j < 4; ++j) acc[ai][bj][m][n][j] *= fmaxf(ub(aw[2 * bj + n], j), 1e-6f) * frcp(fmaxf(ub(bw[2 * bj + n], j), 1e-6f)); }
            asm volatile("" ::: "memory");
        }
    }
    DI void operator()(const f32x4 (&acc)[2][2][4][2], const pg8::Unit& u, int wr, int wc, int fr, int fq) const {
        const int rowb = u.pm * 256 + wr * 64 + fr, col0 = u.pn * 256 + wc * 32 + 8 * fq, wave = wr * 4 + wc, lane = fq * 16 + fr;
#pragma unroll
        for (int ai = 0; ai < 2; ++ai) {
            u32x4 gc[4];
#pragma unroll
            for (int m = 0; m < 4; ++m) gc[m] = *(const GAS u32x4*)(G + gq_off(u.pm, 8 + u.pn, wave, ai * 4 + m, lane));
#pragma unroll
            for (int m = 0; m < 4; ++m) { const unsigned cw[4] = {gc[m].x, gc[m].y, gc[m].z, gc[m].w};
#pragma unroll
                for (int bj = 0; bj < 2; ++bj) { f32x4 v0 = acc[ai][bj][m][0], v1 = acc[ai][bj][m][1];
#pragma unroll
                    for (int j = 0; j < 4; ++j) { v0[j] *= fmaxf(ub(cw[2 * bj], j), 1e-6f) * (1.0f / 255.0f); v1[j] *= fmaxf(ub(cw[2 * bj + 1], j), 1e-6f) * (1.0f / 255.0f); }
                    store8(MG + (size_t)(rowb + ai * 128 + m * 16) * 1024 + col0 + bj * 128, v0, v1); } }
            asm volatile("" ::: "memory");
        }
    }
};
struct EpiResid {
    static constexpr bool PERM = true, MIDK = false, INIT = true;
    const void* base; void* out; bool in16, out16;
    DI void init(f32x4 (&acc)[2][2][4][2], const pg8::Unit& u, int wr, int wc, int fr, int fq) const {
        const int rowb = u.pm * 256 + wr * 64 + fr, col0 = u.pn * 256 + wc * 32 + 8 * fq;
#pragma unroll
        for (int ai = 0; ai < 2; ++ai)
#pragma unroll
            for (int m = 0; m < 4; ++m) { const size_t off = (size_t)(rowb + ai * 128 + m * 16) * DM + col0;
#pragma unroll
                for (int bj = 0; bj < 2; ++bj) {
                    if (in16) { const u32x4 w = *(const GAS u32x4*)((const bf16_t*)base + off + bj * 128);
                        acc[ai][bj][m][0] = (f32x4){bflo(w.x), bfhi(w.x), bflo(w.y), bfhi(w.y)}; acc[ai][bj][m][1] = (f32x4){bflo(w.z), bfhi(w.z), bflo(w.w), bfhi(w.w)}; }
                    else { acc[ai][bj][m][0] = *(const GAS f32x4*)((const float*)base + off + bj * 128); acc[ai][bj][m][1] = *(const GAS f32x4*)((const float*)base + off + bj * 128 + 4); } } }
    }
    DI void operator()(const f32x4 (&acc)[2][2][4][2], const pg8::Unit& u, int wr, int wc, int fr, int fq) const {
        const int rowb = u.pm * 256 + wr * 64 + fr, col0 = u.pn * 256 + wc * 32 + 8 * fq;
#pragma unroll
        for (int ai = 0; ai < 2; ++ai)
#pragma unroll
            for (int m = 0; m < 4; ++m) { const size_t off = (size_t)(rowb + ai * 128 + m * 16) * DM + col0;
#pragma unroll
                for (int bj = 0; bj < 2; ++bj) {
                    if (out16) store8((bf16_t*)out + off + bj * 128, acc[ai][bj][m][0], acc[ai][bj][m][1]);
                    else { *(f32x4*)((float*)out + off + bj * 128) = acc[ai][bj][m][0]; *(f32x4*)((float*)out + off + bj * 128 + 4) = acc[ai][bj][m][1]; } } }
    }
};
struct EpiSwiGLU {
    static constexpr bool PERM = true, MIDK = false, INIT = false;
    bf16_t* H;
    DI void operator()(const f32x4 (&acc)[2][2][4][2], const pg8::Unit& u, int wr, int wc, int fr, int fq) const {
        const int rowb = u.pm * 256 + wr * 64 + fr, col0 = u.pn * 128 + wc * 32 + 8 * fq;
#pragma unroll
        for (int ai = 0; ai < 2; ++ai)
#pragma unroll
            for (int m = 0; m < 4; ++m) { f32x4 v0, v1;
#pragma unroll
                for (int j = 0; j < 4; ++j) { const float g0 = acc[ai][0][m][0][j], g1 = acc[ai][0][m][1][j]; v0[j] = g0 * sigmoidf_(g0) * acc[ai][1][m][0][j]; v1[j] = g1 * sigmoidf_(g1) * acc[ai][1][m][1][j]; }
                store8(H + (size_t)(rowb + ai * 128 + m * 16) * FF + col0, v0, v1); }
    }
};

DI unsigned mono_key(float f) { const unsigned u = __float_as_uint(f + 0.0f); return u ^ ((unsigned)((int)u >> 31) | 0x80000000u); }
DI unsigned pack_mask(unsigned long long bm, int h) {
    unsigned r = 0;
#pragma unroll
    for (int p = 0; p < 2; ++p)
#pragma unroll
        for (int g = 0; g < 4; ++g) r |= (unsigned)((bm >> (32 * p + 8 * g + 4 * h)) & 0xFull) << (16 * p + 4 * g);
    return r;
}
DI unsigned long long unpack_mask(unsigned w0, unsigned w1) {
    unsigned long long bm = 0;
#pragma unroll
    for (int p = 0; p < 2; ++p)
#pragma unroll
        for (int g = 0; g < 4; ++g) { bm |= (unsigned long long)((w0 >> (16 * p + 4 * g)) & 0xFu) << (32 * p + 8 * g); bm |= (unsigned long long)((w1 >> (16 * p + 4 * g)) & 0xFu) << (32 * p + 8 * g + 4); }
    return bm;
}
DI void ld8f(const bf16_t* p, float (&g)[8]) { const u32x4 w = *(const u32x4*)p; g[0] = bflo(w.x); g[1] = bfhi(w.x); g[2] = bflo(w.y); g[3] = bfhi(w.y); g[4] = bflo(w.z); g[5] = bfhi(w.z); g[6] = bflo(w.w); g[7] = bfhi(w.w); }

DI void naive_select(Frame& F) {
    F.refresh();
    if (F.wave >= 4) return;
    const int gw = F.bid * 4 + F.wave, NGW = F.G * 4;
    LAS unsigned char* wl = F.lds + F.wave * 20480;
    LAS float* sc = (LAS float*)wl; LAS float* iqf = (LAS float*)(wl + 16384); LAS unsigned* hist = (LAS unsigned*)(wl + 16384 + 1024);
    const bf16_t* IQ = (const bf16_t*)(F.ws + WS_IQ); const bf16_t* IK = (const bf16_t*)(F.ws + WS_IK); const float* IW = (const float*)(F.ws + WS_IW);
    unsigned* MASK = (unsigned*)(F.ws + WS_MASK);
    const int lane = F.lane;
    for (int row = gw; row < MC; row += NGW) {
        const int b = row >> 12, t = row & (SEQ - 1), n = t + 1;
        { const u32x2 v = *(const u32x2*)(IQ + (size_t)row * 256 + 4 * lane); iqf[4 * lane] = bflo(v.x); iqf[4 * lane + 1] = bfhi(v.x); iqf[4 * lane + 2] = bflo(v.y); iqf[4 * lane + 3] = bfhi(v.y); }
        const f32x4 wv = *(const f32x4*)(IW + (size_t)row * 4);
        WSYNC();
        for (int s = lane; s < n; s += 64) {
            const bf16_t* kr = IK + ((size_t)b * SEQ + s) * 64;
            float d0 = 0.f, d1 = 0.f, d2 = 0.f, d3 = 0.f;
#pragma unroll
            for (int c = 0; c < 8; ++c) { float kv[8]; ld8f(kr + 8 * c, kv);
#pragma unroll
                for (int j = 0; j < 8; ++j) { const float k = kv[j]; d0 += iqf[8 * c + j] * k; d1 += iqf[64 + 8 * c + j] * k; d2 += iqf[128 + 8 * c + j] * k; d3 += iqf[192 + 8 * c + j] * k; } }
            sc[s] = wv[0] * fmaxf(d0, 0.f) + wv[1] * fmaxf(d1, 0.f) + wv[2] * fmaxf(d2, 0.f) + wv[3] * fmaxf(d3, 0.f);
        }
        WSYNC();
        unsigned thr = 0u; int need = 256;
        if (n > 256) {
            unsigned prefix = 0u, pmask = 0u;
            for (int pass = 0; pass < 4; ++pass) {
                const int shift = 24 - 8 * pass;
                { unsigned z_ = 0u; asm volatile("" : "+v"(z_)); hist[lane] = z_; hist[lane + 64] = z_; hist[lane + 128] = z_; hist[lane + 192] = z_; }
                WSYNC();
                for (int s = lane; s < n; s += 64) { const unsigned key = mono_key(sc[s]); if ((key & pmask) == prefix) __hip_atomic_fetch_add(&hist[(key >> shift) & 255u], 1u, __ATOMIC_RELAXED, __HIP_MEMORY_SCOPE_WORKGROUP); }
                WSYNC();
                const unsigned c0 = hist[4 * lane], c1 = hist[4 * lane + 1], c2 = hist[4 * lane + 2], c3 = hist[4 * lane + 3];
                const unsigned ls = c0 + c1 + c2 + c3; unsigned inc = ls;
#pragma unroll
                for (int o = 1; o < 64; o <<= 1) { const unsigned y = __shfl_up(inc, o); if (lane >= o) inc += y; }
                const unsigned total = __shfl(inc, 63);
                unsigned cum = total - inc;
                int fbin = -1; unsigned fneed = 0u;
                const unsigned cc[4] = {c0, c1, c2, c3};
#pragma unroll
                for (int bq = 3; bq >= 0; --bq) { if (fbin < 0 && cum < (unsigned)need && cum + cc[bq] >= (unsigned)need) { fbin = 4 * lane + bq; fneed = (unsigned)need - cum; } cum += cc[bq]; }
                const unsigned long long fm = __ballot(fbin >= 0);
                const int src = __ffsll((long long)fm) - 1;
                const int bin = __shfl(fbin, src); need = (int)__shfl(fneed, src);
                prefix |= (unsigned)bin << shift; pmask |= 0xFFu << shift;
                WSYNC();
            }
            thr = prefix;
        }
        int eqc = 0;
        for (int i = 0; i < 64; ++i) {
            const int s = 64 * i + lane; bool sel = false;
            if (64 * i < n) {
                const bool valid = s < n;
                if (n <= 256) sel = valid;
                else { const unsigned key = valid ? mono_key(sc[s]) : 0u; const bool eq = valid && key == thr; const unsigned long long em = __ballot(eq);
                    const int rank = eqc + __popcll(em & ((1ull << lane) - 1ull)); sel = valid && (key > thr || (eq && rank < need)); eqc += __popcll(em); }
            }
            const unsigned long long bm = __ballot(sel);
            if (lane == 0) { MASK[((size_t)row * 2 + 0) * 64 + i] = pack_mask(bm, 0); MASK[((size_t)row * 2 + 1) * 64 + i] = pack_mask(bm, 1); }
        }
        WSYNC();
    }
}
DI void naive_dsa(Frame& F) {
    F.refresh();
    if (F.wave >= 4) return;
    const int gw = F.bid * 4 + F.wave, NGW = F.G * 4;
    LAS unsigned char* wl = F.lds + F.wave * 20480;
    LAS float* sc = (LAS float*)wl;
    LAS float* sqf = (LAS float*)(wl + 8192);
    LAS unsigned* list = (LAS unsigned*)(wl + 8192 + 2048);
    LAS float* invs = (LAS float*)(wl + 8192 + 2048 + 2048);
    const bf16_t* SQ = (const bf16_t*)(F.ws + WS_SQ); const bf16_t* SK = (const bf16_t*)(F.ws + WS_SK); const bf16_t* SV = (const bf16_t*)(F.ws + WS_SV);
    const unsigned* MASK = (const unsigned*)(F.ws + WS_MASK); bf16_t* Y = (bf16_t*)(F.ws + WS_Y);
    const int lane = F.lane;
    for (int row = gw; row < MC; row += NGW) {
        const int b = row >> 12, t = row & (SEQ - 1);
        { float q[8]; ld8f(SQ + (size_t)row * 512 + 8 * lane, q);
#pragma unroll
          for (int j = 0; j < 8; ++j) sqf[8 * lane + j] = q[j]; }
        int nsel = 0;
        for (int i = 0; i <= (t >> 6); ++i) {
            const unsigned w0 = MASK[((size_t)row * 2 + 0) * 64 + i], w1 = MASK[((size_t)row * 2 + 1) * 64 + i];
            const unsigned long long bm = unpack_mask(w0, w1);
            const bool sel = (bm >> lane) & 1ull;
            const int pos = nsel + __popcll(bm & ((1ull << lane) - 1ull));
            if (sel && pos < 256) list[pos] = (unsigned)(64 * i + lane);
            nsel += __popcll(bm);
        }
        if (nsel > 256) nsel = 256;
        WSYNC();
        for (int k = lane; k < nsel; k += 64) {
            const bf16_t* kr = SK + ((size_t)b * SEQ + list[k]) * 512;
#pragma unroll 1
            for (int h = 0; h < 8; ++h) { float d = 0.f;
#pragma unroll
                for (int c = 0; c < 8; ++c) { float kv[8]; ld8f(kr + h * 64 + 8 * c, kv);
#pragma unroll
                    for (int j = 0; j < 8; ++j) d += sqf[h * 64 + 8 * c + j] * kv[j]; }
                sc[h * 256 + k] = d; }
        }
        WSYNC();
#pragma unroll 1
        for (int h = 0; h < 8; ++h) {
            float mx = -INFINITY; for (int k = lane; k < nsel; k += 64) mx = fmaxf(mx, sc[h * 256 + k]);
            mx = wave_max(mx); float sum = 0.f;
            for (int k = lane; k < nsel; k += 64) { const float p = fexp2(sc[h * 256 + k] - mx); sc[h * 256 + k] = p; sum += p; }
            sum = wave_sum(sum); if (lane == 0) invs[h] = 1.0f / sum;
        }
        WSYNC();
        { const int h = lane >> 3, d0 = (lane & 7) * 8; float accv[8] = {0.f, 0.f, 0.f, 0.f, 0.f, 0.f, 0.f, 0.f};
          for (int k = 0; k < nsel; ++k) { const float p = sc[h * 256 + k]; float v[8]; ld8f(SV + ((size_t)b * SEQ + list[k]) * 512 + h * 64 + d0, v);
#pragma unroll
              for (int j = 0; j < 8; ++j) accv[j] += p * v[j]; }
          const float inv = invs[h];
          u32x4 o; o.x = pk2(accv[0] * inv, accv[1] * inv); o.y = pk2(accv[2] * inv, accv[3] * inv); o.z = pk2(accv[4] * inv, accv[5] * inv); o.w = pk2(accv[6] * inv, accv[7] * inv);
          *(u32x4*)(Y + (size_t)row * 1536 + 512 + h * 64 + d0) = o; }
        WSYNC();
    }
}
DI void naive_mlstm(Frame& F, const Args& a, int l) {
    F.refresh();
    const int gw = F.bid * NWAVES + F.wave, NGW = F.G * NWAVES;
    LAS unsigned char* wl = F.lds + F.wave * 16384;
    LAS float* pl = (LAS float*)wl;
    const bf16_t* QK = (const bf16_t*)(F.ws + WS_QK); const bf16_t* VM = (const bf16_t*)(F.ws + WS_VM); const bf16_t* OM = (const bf16_t*)(F.ws + WS_OM);
    const float* AK = (const float*)(F.ws + WS_AK); const float* MQ = (const float*)(F.ws + WS_MQ); const float* EM = (const float*)(F.ws + WS_EM);
    bf16_t* Y = (bf16_t*)(F.ws + WS_Y); const float* mng = a.in[I_MNG] + (size_t)l * 512;
    const int lane = F.lane;
    for (int qi = gw; qi < MC * 4; qi += NGW) {
        const int row = qi >> 2, h = qi & 3, b = row >> 12, t = row & (SEQ - 1), seq = b * 4 + h;
        const unsigned qw = *(const unsigned*)(QK + (size_t)row * 1024 + h * 128 + 2 * lane);
        const float q0 = bflo(qw), q1 = bfhi(qw);
        const float Mt = MQ[(size_t)seq * SEQ + t];
        float denp = 0.f;
        for (int s0 = 0; s0 <= t; s0 += 64) {
            const int s = s0 + lane; const bool valid = s <= t; const int sr = valid ? s : t;
            const bf16_t* kr = QK + ((size_t)b * SEQ + sr) * 1024 + 512 + h * 128;
            float d = 0.f;
#pragma unroll 4
            for (int c = 0; c < 16; ++c) { float kv[8]; ld8f(kr + 8 * c, kv);
#pragma unroll
                for (int j = 0; j < 4; ++j) { d += __shfl(q0, 4 * c + j) * kv[2 * j] + __shfl(q1, 4 * c + j) * kv[2 * j + 1]; } }
            const float p = valid ? d * fexp(AK[(size_t)seq * SEQ + sr] - Mt) : 0.f;
            pl[s] = p;
            denp += p;
        }
        const float den = wave_sum(denp);
        WSYNC();
        float a0 = 0.f, a1 = 0.f;
        for (int s = 0; s <= t; ++s) { const float p = pl[s]; const unsigned vw = *(const unsigned*)(VM + ((size_t)b * SEQ + s) * 512 + h * 128 + 2 * lane); a0 += p * bflo(vw); a1 += p * bfhi(vw); }
        const float hd = fmaxf(fabsf(den), EM[(size_t)seq * SEQ + t]);
        a0 /= hd; a1 /= hd;
        const float ss = wave_sum(a0 * a0 + a1 * a1); const float r = 1.0f / sqrtf(ss * (1.f / 128.f) + EPS);
        const unsigned ow = *(const unsigned*)(OM + (size_t)row * 512 + h * 128 + 2 * lane);
        const float y0 = a0 * r * mng[h * 128 + 2 * lane] * bflo(ow), y1 = a1 * r * mng[h * 128 + 2 * lane + 1] * bfhi(ow);
        *(unsigned*)(Y + (size_t)row * 1536 + h * 128 + 2 * lane) = pk2(y0, y1);
        WSYNC();
    }
}
DI void naive_diff(Frame& F, const Args& a, int l) {
    F.refresh();
    if (F.wave >= 4) return;
    const int gw = F.bid * 4 + F.wave, NGW = F.G * 4;
    LAS unsigned char* wl = F.lds + F.wave * 32768;
    LAS float* p0 = (LAS float*)wl; LAS float* p1 = (LAS float*)(wl + 16384);
    const bf16_t* DQ = (const bf16_t*)(F.ws + WS_DQ); const bf16_t* DK = (const bf16_t*)(F.ws + WS_DK); const bf16_t* DV = (const bf16_t*)(F.ws + WS_DV);
    bf16_t* Y = (bf16_t*)(F.ws + WS_Y); const float* dog = a.in[I_DOG] + (size_t)l * 128; const float* lam = a.in[I_LAM] + (size_t)l * 256;
    const int lane = F.lane;
    const float lam_init = (l == 0) ? 0.2f : 0.35550906759096934f;
    const float s01 = wave_sum(lam[lane] * lam[64 + lane]), s23 = wave_sum(lam[128 + lane] * lam[192 + lane]);
    const float lam_val = fexp(s01) - fexp(s23) + lam_init;
    for (int qi = gw; qi < MC * 4; qi += NGW) {
        const int row = qi >> 2, h = qi & 3, b = row >> 12, t = row & (SEQ - 1);
        const float qa = bf2f(DQ[(size_t)row * 512 + (2 * h) * 64 + lane]), qb = bf2f(DQ[(size_t)row * 512 + (2 * h + 1) * 64 + lane]);
        float mx0 = -INFINITY, mx1 = -INFINITY;
        for (int s0 = 0; s0 <= t; s0 += 64) {
            const int s = s0 + lane; const bool valid = s <= t; const int sr = valid ? s : t;
            const bf16_t* kr = DK + ((size_t)b * SEQ + sr) * 512 + (2 * h) * 64;
            float d0 = 0.f, d1 = 0.f;
#pragma unroll 4
            for (int c = 0; c < 8; ++c) { float ka[8], kb[8]; ld8f(kr + 8 * c, ka); ld8f(kr + 64 + 8 * c, kb);
#pragma unroll
                for (int j = 0; j < 8; ++j) { d0 += __shfl(qa, 8 * c + j) * ka[j]; d1 += __shfl(qb, 8 * c + j) * kb[j]; } }
            if (valid) { p0[s] = d0; p1[s] = d1; mx0 = fmaxf(mx0, d0); mx1 = fmaxf(mx1, d1); }
        }
        mx0 = wave_max(mx0); mx1 = wave_max(mx1);
        WSYNC();
        float sm0 = 0.f, sm1 = 0.f;
        for (int s = lane; s <= t; s += 64) { const float e0 = fexp2(p0[s] - mx0), e1 = fexp2(p1[s] - mx1); p0[s] = e0; p1[s] = e1; sm0 += e0; sm1 += e1; }
        const float i0 = 1.0f / wave_sum(sm0), i1 = lam_val / wave_sum(sm1);
        WSYNC();
        float a0 = 0.f, a1 = 0.f;
        for (int s = 0; s <= t; ++s) { const float av = p0[s] * i0 - p1[s] * i1; const unsigned vw = *(const unsigned*)(DV + ((size_t)b * SEQ + s) * 512 + h * 128 + 2 * lane); a0 += av * bflo(vw); a1 += av * bfhi(vw); }
        const float ss = wave_sum(a0 * a0 + a1 * a1); const float r = 1.0f / sqrtf(ss * (1.f / 128.f) + EPS) * (1.0f - lam_init);
        *(unsigned*)(Y + (size_t)row * 1536 + 1024 + h * 128 + 2 * lane) = pk2(a0 * r * dog[2 * lane], a1 * r * dog[2 * lane + 1]);
        WSYNC();
    }
}

typedef float f32x16 __attribute__((ext_vector_type(16)));
typedef short s16x4 __attribute__((ext_vector_type(4)));
typedef __bf16 bf16x2_t __attribute__((ext_vector_type(2)));
DI unsigned cvtpk(float lo, float hi) { f32x2 v = {lo, hi}; bf16x2_t b = __builtin_convertvector(v, bf16x2_t); return __builtin_bit_cast(unsigned, b); }
#define MFMA32(a, b, c) __builtin_amdgcn_mfma_f32_32x32x16_bf16((a), (b), (c), 0, 0, 0)
DI s16x4 trread(LAS const unsigned char* p) { return __builtin_bit_cast(s16x4, __builtin_amdgcn_ds_read_tr16_b64_v4i16((LAS s16x4*)p)); }
#ifndef MIXMODES
#define MIXMODES 7
#endif
constexpr int CW_QUEUE = 8192;
constexpr int ATT_WSF_OFF = RING_BYTES + 1024;
constexpr float NEGBIG = -1.0e30f;
constexpr float RESC_THR = 16.0f;

DI float max3f(float a, float b, float c) { float r_; asm("v_max3_f32 %0, %1, %2, %3" : "=v"(r_) : "v"(a), "v"(b), "v"(c)); return r_; }
template <int MODE>
DI void attn_qk(f32x16& s0, f32x16& s1, const bf16x8 (&qf)[MODE == 2 ? 8 : 4], LAS const unsigned char* kb, int koff, int j, int q0w, int r, int h, unsigned mw, const bool DIAG) {
    constexpr int KW = MODE == 0 ? 64 : 128, DQK = MODE == 2 ? 128 : 64, DV = MODE == 0 ? 64 : 128, KROWB = KW * 2 + 16, VROWB = MODE == 0 ? 192 : 320, KBYTES = 64 * KROWB, VBYTES = 64 * VROWB;
    constexpr int NKS = DQK / 16, NVB = DV / 32;
    (void)KBYTES; (void)VBYTES; (void)NVB;
    if (MODE == 0) {
        const unsigned nmw = ~mw;
#define CI_(i) { int a_, b_; asm("v_bfe_i32 %0, %1, " #i ", 1" : "=v"(a_) : "v"(nmw)); asm("v_bfe_i32 %0, %1, 16+" #i ", 1" : "=v"(b_) : "v"(nmw)); \
                 s0[i] = __uint_as_float((unsigned)a_ & 0xF149F2CAu); s1[i] = __uint_as_float((unsigned)b_ & 0xF149F2CAu); }
        CI_(0) CI_(1) CI_(2) CI_(3) CI_(4) CI_(5) CI_(6) CI_(7) CI_(8) CI_(9) CI_(10) CI_(11) CI_(12) CI_(13) CI_(14) CI_(15)
#undef CI_
    } else if (MODE == 1 && DIAG) {
        const int qd = q0w + r - 64 * j;
#pragma unroll
        for (int i = 0; i < 16; ++i) { const int kk = (i & 3) + 8 * (i >> 2) + 4 * h; s0[i] = kk > qd ? NEGBIG : 0.f; s1[i] = kk + 32 > qd ? NEGBIG : 0.f; }
    } else {
#pragma unroll
        for (int i = 0; i < 16; ++i) { s0[i] = 0.f; s1[i] = 0.f; }
    }
#pragma unroll
    for (int s = 0; s < NKS; ++s) {
        const bf16x8 k0 = *(LAS const bf16x8*)(kb + koff + 32 * s);
        const bf16x8 k1 = *(LAS const bf16x8*)(kb + koff + 32 * KROWB + 32 * s);
        s0 = MFMA32(k0, qf[s], s0); s1 = MFMA32(k1, qf[s], s1);
    }
}
template <int MODE>
DI void attn_pv(f32x16 (&o)[MODE == 0 ? 2 : 4], float& lsum, float& mref, f32x16& s0, f32x16& s1, LAS const unsigned char* vb, int voff,
                int j, int q0w, int r, int h, float M2, LAS float* wsf, const bool DIAG, const int probe) {
    constexpr int DV = MODE == 0 ? 64 : 128, VROWB = MODE == 0 ? 192 : 320, VBYTES = 64 * VROWB;
    constexpr int NVB = DV / 32;
    LAS const unsigned char* ab = vb + VBYTES;
    if (MODE == 2) {
        float part = 0.f;
        if (DIAG) {
            const int qd = q0w + r - 64 * j;
#pragma unroll
            for (int g = 0; g < 4; ++g) {
                const f32x4 a0 = *(LAS const f32x4*)(ab + (8 * g + 4 * h) * 4), a1 = *(LAS const f32x4*)(ab + (32 + 8 * g + 4 * h) * 4);
#pragma unroll
                for (int e = 0; e < 4; ++e) { const int i = 4 * g + e, kk = 8 * g + 4 * h + e;
                    float w0 = fexp2(a0[e] - M2), w1 = fexp2(a1[e] - M2);
                    if (kk > qd) w0 = 0.f; if (kk + 32 > qd) w1 = 0.f;
                    s0[i] *= w0; s1[i] *= w1; part += s0[i] + s1[i]; }
            }
        } else {
#pragma unroll
            for (int g = 0; g < 4; ++g) {
                const f32x4 a0 = *(LAS const f32x4*)(ab + (8 * g + 4 * h) * 4), a1 = *(LAS const f32x4*)(ab + (32 + 8 * g + 4 * h) * 4);
#pragma unroll
                for (int e = 0; e < 4; ++e) { const int i = 4 * g + e;
                    s0[i] *= fexp2(a0[e] - M2); s1[i] *= fexp2(a1[e] - M2); part += s0[i] + s1[i]; }
            }
        }
        lsum += part;
    } else {
        if (probe != 2) {
        asm volatile("s_nop 15\n\ts_nop 7" : "+v"(s0), "+v"(s1));
        float ta = max3f(s0[0], s0[1], s1[0]), tb = max3f(s0[2], s0[3], s1[1]); ta = max3f(ta, s1[2], s1[3]);
#pragma unroll
        for (int i = 4; i < 16; i += 4) { ta = max3f(ta, s0[i], s0[i + 1]); tb = max3f(tb, s0[i + 2], s0[i + 3]); ta = max3f(ta, s1[i], s1[i + 1]); tb = max3f(tb, s1[i + 2], s1[i + 3]); }
        float tm = max3f(ta, tb, tb); tm = max32x(tm);
        if (__any(tm > mref + RESC_THR)) {
            const float nm = tm > mref + RESC_THR ? tm : mref, al = fexp2(mref - nm);
            mref = nm; lsum *= al;
            if (h == 0) wsf[r] = al;
            WSYNC();
#pragma unroll
            for (int g = 0; g < 4; ++g) { const f32x4 av = *(LAS const f32x4*)(wsf + 8 * g + 4 * h);
#pragma unroll
                for (int v = 0; v < NVB; ++v)
#pragma unroll
                    for (int e = 0; e < 4; ++e) o[v][4 * g + e] *= av[e]; }
            WSYNC();
        }
        if (__any(mref != 0.f)) {
#pragma unroll
            for (int i = 0; i < 16; ++i) { s0[i] -= mref; s1[i] -= mref; }
        }
        float part = 0.f;
#pragma unroll
        for (int i = 0; i < 16; ++i) { s0[i] = fexp2(s0[i]); s1[i] = fexp2(s1[i]); part += s0[i] + s1[i]; }
        lsum += part;
        }
    }
    bf16x8 pf[2][2];
#pragma unroll
    for (int s2 = 0; s2 < 2; ++s2) {
        u32x4 t0, t1;
        t0.x = cvtpk(s0[8 * s2 + 0], s0[8 * s2 + 1]); t0.y = cvtpk(s0[8 * s2 + 2], s0[8 * s2 + 3]); t0.z = cvtpk(s0[8 * s2 + 4], s0[8 * s2 + 5]); t0.w = cvtpk(s0[8 * s2 + 6], s0[8 * s2 + 7]);
        t1.x = cvtpk(s1[8 * s2 + 0], s1[8 * s2 + 1]); t1.y = cvtpk(s1[8 * s2 + 2], s1[8 * s2 + 3]); t1.z = cvtpk(s1[8 * s2 + 4], s1[8 * s2 + 5]); t1.w = cvtpk(s1[8 * s2 + 6], s1[8 * s2 + 7]);
        pf[0][s2] = __builtin_bit_cast(bf16x8, t0); pf[1][s2] = __builtin_bit_cast(bf16x8, t1);
    }
    if (probe != 3)
#pragma unroll
    for (int v = 0; v < NVB; ++v)
#pragma unroll
        for (int p = 0; p < 2; ++p)
#pragma unroll
            for (int s2 = 0; s2 < 2; ++s2) {
                const s16x4 lo = trread(vb + voff + (32 * p + 16 * s2) * VROWB + 64 * v), hi = trread(vb + voff + (32 * p + 16 * s2 + 8) * VROWB + 64 * v);
                const bf16x8 vf = (bf16x8){lo[0], lo[1], lo[2], lo[3], hi[0], hi[1], hi[2], hi[3]};
                o[v] = MFMA32(pf[p][s2], vf, o[v]);
            }
}

template <int MODE>
DI void attn_tile(f32x16 (&o)[MODE == 0 ? 2 : 4], float& lsum, float& mref, const bf16x8 (&qf)[MODE == 2 ? 8 : 4], LAS const unsigned char* kb, int koff, int voff,
                  int j, int q0w, int r, int h, unsigned mw, float M2, LAS float* wsf, const bool DIAG, const int probe) {
    constexpr int KW = MODE == 0 ? 64 : 128, KROWB = KW * 2 + 16, KBYTES = 64 * KROWB;
    f32x16 s0, s1;
    attn_qk<MODE>(s0, s1, qf, kb, koff, j, q0w, r, h, mw, DIAG);
    attn_pv<MODE>(o, lsum, mref, s0, s1, kb + KBYTES, voff, j, q0w, r, h, M2, wsf, DIAG, probe);
}
template <int MODE>
DI void attn_unit(Frame& F, const Args& a, int l, int b, int head, int qb, float lam_val, float lam_init) {
    constexpr int KW = MODE == 0 ? 64 : 128, DQK = MODE == 2 ? 128 : 64, NCOMP = 1, NPASS = 1, DV = MODE == 0 ? 64 : 128;
    constexpr int KROWB = KW * 2 + 16, VROWB = MODE == 0 ? 192 : 320;
    constexpr int KBYTES = 64 * KROWB, VBYTES = 64 * VROWB, STAGE = KBYTES + VBYTES + 256;
    constexpr int NKS = DQK / 16, NVB = DV / 32, KCH = KW / 64, VCH = DV / 64;
    static_assert(2 * STAGE <= 98304, "tile buffers");
    F.refresh();
    const int probe = (REPMASK != 0) ? ((volatile LAS int*)(F.lds + MISC_OFF + 96))[2] : 0;
    const int tid = F.tid, lane = F.lane, w = F.wave, r = lane & 31, h = lane >> 5;
    const bf16_t* Qp; const bf16_t* Kp; const bf16_t* Vp; int ldq, ldk;
    if (MODE == 0) { Qp = (const bf16_t*)(F.ws + WS_SQ) + head * 64; Kp = (const bf16_t*)(F.ws + WS_SK) + head * 64; Vp = (const bf16_t*)(F.ws + WS_SV) + head * 64; ldq = 512; ldk = 512; }
    else if (MODE == 1) { Qp = (const bf16_t*)(F.ws + WS_DQ) + head * 128; Kp = (const bf16_t*)(F.ws + WS_DK) + head * 128; Vp = (const bf16_t*)(F.ws + WS_DV) + head * 128; ldq = 512; ldk = 512; }
    else { Qp = (const bf16_t*)(F.ws + WS_QK) + head * 128; Kp = (const bf16_t*)(F.ws + WS_QK) + 512 + head * 128; Vp = (const bf16_t*)(F.ws + WS_VM) + head * 128; ldq = 1024; ldk = 1024; }
    const size_t rowb = (size_t)b * SEQ;
    const int comp = MODE == 1 ? (w >> 2) : 0;
    const int q0w = MODE == 1 ? qb * 128 + (w & 3) * 32 : qb * 256 + w * 32;
    const int seq = b * 4 + head;
    LAS float* wsf = (LAS float*)(F.lds + ATT_WSF_OFF + w * 256);
    f32x16 o[NCOMP][NVB];
    float lsum[NCOMP], mref[NCOMP];
    const int i16 = lane & 15, vq = i16 >> 2, vp = i16 & 3, vcs = (lane >> 4) & 1;
    const int voff = (4 * h + vq) * VROWB + (16 * vcs + 4 * vp) * 2;
    const int koff = r * KROWB + 16 * h;
    const int NT = MODE == 2 ? 4 : (MODE == 1 ? 2 * (qb + 1) : 4 * (qb + 1)), JB = MODE == 2 ? 4 * qb : 0;
#pragma unroll 1
    for (int pass = 0; pass < NPASS; ++pass) {
    bf16x8 qf[NCOMP][NKS];
#pragma unroll
    for (int c = 0; c < NCOMP; ++c)
#pragma unroll
        for (int s = 0; s < NKS; ++s) qf[c][s] = *(const GAS bf16x8*)(Qp + (rowb + q0w + r) * ldq + comp * 64 + 16 * s + 8 * h);
#pragma unroll
    for (int c = 0; c < NCOMP; ++c)
#pragma unroll
        for (int v = 0; v < NVB; ++v)
#pragma unroll
            for (int i = 0; i < 16; ++i) o[c][v][i] = 0.f;
#pragma unroll
    for (int c = 0; c < NCOMP; ++c) { lsum[c] = 0.f; mref[c] = 0.f; }
    float M2 = 0.f;
    if (MODE == 2) M2 = ((const float*)(F.ws + WS_MQ))[(size_t)seq * SEQ + q0w + r] * LOG2E;
    const unsigned* mrow = (const unsigned*)(F.ws + WS_MASK) + ((rowb + q0w + r) * 2 + h) * 64;
    const int srow = tid >> 3, sch = tid & 7;
    const bf16_t* kg = Kp + (rowb + srow) * ldk + sch * 8; const bf16_t* vg = Vp + (rowb + srow) * 512 + sch * 8;
    const float* ag = (const float*)(F.ws + WS_AK) + (size_t)seq * SEQ;
    u32x4 kreg[KCH], vreg[VCH]; float areg = 0.f; unsigned mw = 0u; u32x4 mw4 = (u32x4){0u, 0u, 0u, 0u}, mw4n = (u32x4){0u, 0u, 0u, 0u};
#define ST_LOAD(j) do { _Pragma("unroll") for (int c_ = 0; c_ < KCH; ++c_) kreg[c_] = *(const GAS u32x4*)(kg + (size_t)(j) * 64 * ldk + c_ * 64); \
        _Pragma("unroll") for (int c_ = 0; c_ < VCH; ++c_) vreg[c_] = *(const GAS u32x4*)(vg + (size_t)(j) * 64 * 512 + c_ * 64); \
        if (MODE == 2) { if (tid < 64) areg = *(const GAS float*)(ag + (j) * 64 + tid); } \
        asm volatile("" ::: "memory"); } while (0)
#define ST_WRITE(buf) do { LAS unsigned char* sb_ = F.lds + (buf) * STAGE; \
        _Pragma("unroll") for (int c_ = 0; c_ < KCH; ++c_) *(LAS u32x4*)(sb_ + srow * KROWB + (sch + 8 * c_) * 16) = kreg[c_]; \
        _Pragma("unroll") for (int c_ = 0; c_ < VCH; ++c_) *(LAS u32x4*)(sb_ + KBYTES + srow * VROWB + (sch + 8 * c_) * 16) = vreg[c_]; \
        if (MODE == 2) { if (tid < 64) *(LAS float*)(sb_ + KBYTES + VBYTES + tid * 4) = areg * LOG2E; } } while (0)
    if (MODE == 0) mw4n = *(const GAS u32x4*)(mrow + JB);
    ST_LOAD(JB); ST_WRITE(0);
    __syncthreads();
    for (int j = JB; j < JB + NT; ++j) {
        const int cur = j & 1;
        if (MODE == 0) {
            if ((j & 3) == 0) { mw4 = mw4n; if (j + 4 < JB + NT) mw4n = *(const GAS u32x4*)(mrow + j + 4); }
            mw = (j & 3) == 0 ? mw4.x : ((j & 3) == 1 ? mw4.y : ((j & 3) == 2 ? mw4.z : mw4.w));
        }
        if (j + 1 < JB + NT && (probe == 0 || probe == 2 || probe == 3)) ST_LOAD(j + 1);
        if (64 * j <= q0w + 31) {
            LAS const unsigned char* kb = F.lds + cur * STAGE;
            attn_tile<MODE>(o[0], lsum[0], mref[0], qf[0], kb, koff + comp * 128, voff, j, q0w, r, h, mw, M2, wsf, 64 * j + 63 > q0w, probe);
        }
        if (probe != 4) { if (j + 1 < JB + NT) ST_WRITE(cur ^ 1);
        __syncthreads(); }
    }
#undef ST_LOAD
#undef ST_WRITE
    }
    if (MODE == 2) { if (qb > 0) {
        const float Mp2 = ((const float*)(F.ws + WS_MQ))[(size_t)seq * SEQ + 256 * qb - 1] * LOG2E;
        const float M2s = ((const float*)(F.ws + WS_MQ))[(size_t)seq * SEQ + q0w + r] * LOG2E;
        const float g = fexp2(Mp2 - M2s);
        const float* NSn = (const float*)(F.ws + WS_MN + 128 * 1024) + ((size_t)seq * 16 + qb) * 128;
        const bf16_t* Cn = (const bf16_t*)(F.ws + WS_MC) + ((size_t)seq * 16 + qb) * 16384;
        bf16x8 qs[8]; float dpart = 0.f;
#pragma unroll
        for (int s = 0; s < 8; ++s) {
            const bf16x8 qv = *(const GAS bf16x8*)(Qp + (rowb + q0w + r) * ldq + 16 * s + 8 * h);
            const u32x4 qw = __builtin_bit_cast(u32x4, qv);
            const f32x4 n0 = *(const GAS f32x4*)(NSn + 16 * s + 8 * h), n1 = *(const GAS f32x4*)(NSn + 16 * s + 8 * h + 4);
            const float q0 = bflo(qw.x), q1 = bfhi(qw.x), q2 = bflo(qw.y), q3 = bfhi(qw.y), q4 = bflo(qw.z), q5 = bfhi(qw.z), q6 = bflo(qw.w), q7 = bfhi(qw.w);
            dpart += (q0 * n0[0] + q1 * n0[1]) + (q2 * n0[2] + q3 * n0[3]) + (q4 * n1[0] + q5 * n1[1]) + (q6 * n1[2] + q7 * n1[3]);
            u32x4 t; t.x = cvtpk(q0 * g, q1 * g); t.y = cvtpk(q2 * g, q3 * g); t.z = cvtpk(q4 * g, q5 * g); t.w = cvtpk(q6 * g, q7 * g);
            qs[s] = __builtin_bit_cast(bf16x8, t);
        }
        lsum[0] += g * dpart;
#pragma unroll
        for (int v = 0; v < NVB; ++v) {
            bf16x8 cf[8];
#pragma unroll
            for (int s = 0; s < 8; ++s) cf[s] = *(const GAS bf16x8*)(Cn + (size_t)(32 * v + r) * 128 + 16 * s + 8 * h);
#pragma unroll
            for (int s = 0; s < 8; ++s) o[0][v] = MFMA32(qs[s], cf[s], o[0][v]);
        }
    } }
    float sc0; const float sc1 = 0.f;
    if (MODE == 1) { lam_val = ((volatile LAS float*)(F.lds + MISC_OFF + 96))[0]; lam_init = ((volatile LAS float*)(F.lds + MISC_OFF + 96))[1]; }
    { float lt = sum32x(lsum[0]);
      if (MODE == 2) sc0 = frcp(fmaxf(fabsf(lt), ((const float*)(F.ws + WS_EM))[(size_t)seq * SEQ + q0w + r]));
      else if (MODE == 1) sc0 = (comp ? lam_val : 1.0f) * frcp(lt);
      else sc0 = frcp(lt); }
    if (h == 0) { wsf[r] = sc0; wsf[32 + r] = sc1; }
    WSYNC();
    LAS float* stg = (LAS float*)(F.lds + w * 16384);
#pragma unroll
    for (int g = 0; g < 4; ++g) {
        const f32x4 av = *(LAS const f32x4*)(wsf + 8 * g + 4 * h);
#pragma unroll
        for (int e = 0; e < 4; ++e) { const int i = 4 * g + e, row = 8 * g + 4 * h + e;
#pragma unroll
            for (int v = 0; v < NVB; ++v) { float val = o[0][v][i] * av[e]; stg[row * DV + 32 * v + r] = val; } }
    }
    WSYNC();
    if (MODE == 1) __syncthreads();
    if (MODE != 1 || comp == 0) {
        const int q = lane >> 1, hf = lane & 1; constexpr int HC = DV / 2;
        LAS float* srow_ = stg + q * DV + hf * HC;
        if (MODE == 1) {
            LAS const float* prow_ = (LAS const float*)(F.lds + (w + 4) * 16384) + q * DV + hf * HC;
#pragma unroll
            for (int c4 = 0; c4 < HC / 4; ++c4) *(LAS f32x4*)(srow_ + 4 * c4) = *(LAS const f32x4*)(srow_ + 4 * c4) - *(LAS const f32x4*)(prow_ + 4 * c4);
        }
        size_t grow = rowb + q0w + q;
        bf16_t* Y = (bf16_t*)(F.ws + (probe ? WS_MD : WS_Y)); if (probe) grow &= 4095;
        if (MODE == 0) {
            bf16_t* yp = Y + grow * 1536 + 512 + head * 64 + hf * HC;
#pragma unroll
            for (int c8 = 0; c8 < HC / 8; ++c8) { const f32x4 x0 = *(LAS const f32x4*)(srow_ + 8 * c8), x1 = *(LAS const f32x4*)(srow_ + 8 * c8 + 4);
                u32x4 ov; ov.x = cvtpk(x0[0], x0[1]); ov.y = cvtpk(x0[2], x0[3]); ov.z = cvtpk(x1[0], x1[1]); ov.w = cvtpk(x1[2], x1[3]); *(u32x4*)(yp + 8 * c8) = ov; }
        } else {
            float ss = 0.f;
#pragma unroll
            for (int c4 = 0; c4 < HC / 4; ++c4) { const f32x4 x = *(LAS const f32x4*)(srow_ + 4 * c4); ss += (x[0] * x[0] + x[1] * x[1]) + (x[2] * x[2] + x[3] * x[3]); }
            ss += xor1(ss);
            float rs = 1.0f / sqrtf(ss * (1.f / 128.f) + EPS);
            const float* gain; bf16_t* yp; const bf16_t* gatep = nullptr;
            if (MODE == 1) { rs *= (1.0f - lam_init); gain = a.in[I_DOG] + (size_t)l * 128 + hf * HC; yp = Y + grow * 1536 + 1024 + head * 128 + hf * HC; }
            else { gain = a.in[I_MNG] + (size_t)l * 512 + head * 128 + hf * HC; yp = Y + grow * 1536 + head * 128 + hf * HC; gatep = (const bf16_t*)(F.ws + WS_OM) + grow * 512 + head * 128 + hf * HC; }
#pragma unroll
            for (int c8 = 0; c8 < HC / 8; ++c8) {
                f32x4 x0 = *(LAS const f32x4*)(srow_ + 8 * c8), x1 = *(LAS const f32x4*)(srow_ + 8 * c8 + 4);
                const f32x4 g0 = *(const f32x4*)(gain + 8 * c8), g1 = *(const f32x4*)(gain + 8 * c8 + 4);
                x0 = x0 * rs * g0; x1 = x1 * rs * g1;
                if (MODE == 2) { float gt[8]; ld8f(gatep + 8 * c8, gt);
#pragma unroll
                    for (int e = 0; e < 4; ++e) { x0[e] *= gt[e]; x1[e] *= gt[4 + e]; } }
                u32x4 ov; ov.x = cvtpk(x0[0], x0[1]); ov.y = cvtpk(x0[2], x0[3]); ov.z = cvtpk(x1[0], x1[1]); ov.w = cvtpk(x1[2], x1[3]); *(u32x4*)(yp + 8 * c8) = ov;
            }
        }
    }
    __syncthreads();
}
DI void phase_mixers(Frame& F, const Args& a, int l, int it, int modes, int probe) {
    F.refresh();
    const float* lam = a.in[I_LAM] + (size_t)l * 256;
    const float lam_init = (l == 0) ? 0.2f : 0.35550906759096934f;
    const float s01 = wave_sum(lam[F.lane] * lam[64 + F.lane]), s23 = wave_sum(lam[128 + F.lane] * lam[192 + F.lane]);
    { const float lv = fexp(s01) - fexp(s23) + lam_init; if (F.tid == 0) { ((volatile LAS int*)(F.lds + MISC_OFF + 96))[2] = probe; ((volatile LAS float*)(F.lds + MISC_OFF + 96))[0] = lv; ((volatile LAS float*)(F.lds + MISC_OFF + 96))[1] = lam_init; } }
    const float lam_val = 0.f;
    unsigned* qhead = (unsigned*)(F.ws + WS_CTL) + CW_QUEUE + it * 64;
    volatile LAS unsigned* slot = (volatile LAS unsigned*)(F.lds + MISC_OFF + 64);
    for (;;) {
        if (F.tid == 0) *slot = __hip_atomic_fetch_add(qhead, 1u, __ATOMIC_RELAXED, __HIP_MEMORY_SCOPE_AGENT);
        __syncthreads();
        const int u = __builtin_amdgcn_readfirstlane((int)*slot);
        __syncthreads();
        if (u >= 1280) break;
        if (u < 1024) { const int p_ = u >> 6, k = u & 63;
            if (k < 16) { if (modes & MIXMODES & 2) attn_unit<1>(F, a, l, k >> 2, k & 3, 31 - 2 * p_, lam_val, lam_init); }
            else if (k < 48) { if (modes & MIXMODES & 1) attn_unit<0>(F, a, l, (k - 16) >> 3, (k - 16) & 7, 15 - p_, lam_val, lam_init); }
            else { if (modes & MIXMODES & 2) attn_unit<1>(F, a, l, (k - 48) >> 2, (k - 48) & 3, 30 - 2 * p_, lam_val, lam_init); }
        } else { const int m_ = u - 1024; if (modes & MIXMODES & 4) attn_unit<2>(F, a, l, (m_ >> 2) & 3, m_ & 3, 15 - (m_ >> 4), lam_val, lam_init); }
    }
}

DI void mlstm_state_unit(Frame& F, int sq, int n) {
    F.refresh();
    constexpr int KROWB = 272, VROWB = 320, KBYTES = 64 * KROWB, VBYTES = 64 * VROWB;
    const int tid = F.tid, lane = F.lane, w = F.wave, r = lane & 31, h = lane >> 5, b = sq >> 2, head = sq & 3;
    const size_t rowb = (size_t)b * SEQ;
    const bf16_t* Kp = (const bf16_t*)(F.ws + WS_QK) + 512 + head * 128; const bf16_t* Vp = (const bf16_t*)(F.ws + WS_VM) + head * 128;
    const float* ag = (const float*)(F.ws + WS_AK) + (size_t)sq * SEQ;
    const float Mend = ((const float*)(F.ws + WS_MQ))[(size_t)sq * SEQ + 256 * n + 255];
    f32x16 acc[2];
#pragma unroll
    for (int c = 0; c < 2; ++c)
#pragma unroll
        for (int i = 0; i < 16; ++i) acc[c][i] = 0.f;
    const int dvb = w >> 1, dkb0 = 2 * (w & 1);
    const int srow = tid >> 3, sch = tid & 7;
    const int i16 = lane & 15, vq = i16 >> 2, vp = i16 & 3, vcs = (lane >> 4) & 1;
    const int toffV = (4 * h + vq) * VROWB + (16 * vcs + 4 * vp) * 2, toffK = (4 * h + vq) * KROWB + (16 * vcs + 4 * vp) * 2;
    LAS unsigned char* kb = F.lds; LAS unsigned char* vb = kb + KBYTES; LAS float* wts = (LAS float*)(vb + VBYTES);
    float nacc = 0.f; const int ndk = tid & 127, npart = tid >> 7;
    for (int jt = 0; jt < 4; ++jt) {
        const int j = 4 * n + jt;
        const float wr_ = fexp(*(const GAS float*)(ag + 64 * j + srow) - Mend);
        u32x4 kreg[2], vreg[2];
#pragma unroll
        for (int c = 0; c < 2; ++c) { kreg[c] = *(const GAS u32x4*)(Kp + (rowb + 64 * j + srow) * 1024 + (sch + 8 * c) * 8); vreg[c] = *(const GAS u32x4*)(Vp + (rowb + 64 * j + srow) * 512 + (sch + 8 * c) * 8); }
#pragma unroll
        for (int c = 0; c < 2; ++c) { u32x4 t = vreg[c];
            t.x = cvtpk(bflo(t.x) * wr_, bfhi(t.x) * wr_); t.y = cvtpk(bflo(t.y) * wr_, bfhi(t.y) * wr_); t.z = cvtpk(bflo(t.z) * wr_, bfhi(t.z) * wr_); t.w = cvtpk(bflo(t.w) * wr_, bfhi(t.w) * wr_); vreg[c] = t; }
        __syncthreads();
#pragma unroll
        for (int c = 0; c < 2; ++c) { *(LAS u32x4*)(kb + srow * KROWB + (sch + 8 * c) * 16) = kreg[c]; *(LAS u32x4*)(vb + srow * VROWB + (sch + 8 * c) * 16) = vreg[c]; }
        if (sch == 0) wts[srow] = wr_;
        __syncthreads();
#pragma unroll
        for (int sg = 0; sg < 4; ++sg) {
            const s16x4 alo = trread(vb + toffV + (16 * sg) * VROWB + 64 * dvb), ahi = trread(vb + toffV + (16 * sg + 8) * VROWB + 64 * dvb);
            const bf16x8 af = (bf16x8){alo[0], alo[1], alo[2], alo[3], ahi[0], ahi[1], ahi[2], ahi[3]};
#pragma unroll
            for (int c = 0; c < 2; ++c) {
                const s16x4 blo = trread(kb + toffK + (16 * sg) * KROWB + 64 * (dkb0 + c)), bhi = trread(kb + toffK + (16 * sg + 8) * KROWB + 64 * (dkb0 + c));
                const bf16x8 bfr = (bf16x8){blo[0], blo[1], blo[2], blo[3], bhi[0], bhi[1], bhi[2], bhi[3]};
                acc[c] = MFMA32(af, bfr, acc[c]);
            }
        }
#pragma unroll 4
        for (int s_ = 0; s_ < 16; ++s_) { const int ks = 16 * npart + s_; nacc += wts[ks] * bf2f(*(LAS const bf16_t*)(kb + ks * KROWB + ndk * 2)); }
    }
    float* D = (float*)(F.ws + WS_MD) + ((size_t)sq * 16 + n) * 16384;
#pragma unroll
    for (int c = 0; c < 2; ++c)
#pragma unroll
        for (int i = 0; i < 16; ++i) D[(32 * dvb + (i & 3) + 8 * (i >> 2) + 4 * h) * 128 + 32 * (dkb0 + c) + r] = acc[c][i];
    __syncthreads();
    LAS float* red = (LAS float*)F.lds;
    red[npart * 128 + ndk] = nacc;
    __syncthreads();
    if (tid < 128) ((float*)(F.ws + WS_MN))[((size_t)sq * 16 + n) * 128 + tid] = (red[tid] + red[128 + tid]) + (red[256 + tid] + red[384 + tid]);
    __syncthreads();
}
DI void mlstm_state_scan(Frame& F) {
    const int gid = (F.bid * NWAVES + F.wave) * 64 + F.lane, NG_ = F.G * NWAVES * 64;
    const float* D = (const float*)(F.ws + WS_MD); bf16_t* C = (bf16_t*)(F.ws + WS_MC); const float* MQ = (const float*)(F.ws + WS_MQ);
    for (int e = gid; e < CB * 4 * 16384; e += NG_) {
        const int sq = e >> 14, idx = e & 16383;
        float d[15], me[15];
#pragma unroll
        for (int n = 0; n < 15; ++n) { d[n] = D[((size_t)sq * 16 + n) * 16384 + idx]; me[n] = MQ[(size_t)sq * SEQ + 256 * n + 255]; }
        float c = 0.f;
#pragma unroll
        for (int n = 0; n < 15; ++n) { const float f = n == 0 ? 0.f : fexp(me[n - 1] - me[n]); c = f * c + d[n]; C[((size_t)sq * 16 + n + 1) * 16384 + idx] = (bf16_t)f2bf(c); }
    }
    const float* Nv = (const float*)(F.ws + WS_MN); float* NS = (float*)(F.ws + WS_MN + 128 * 1024);
    for (int e = gid; e < CB * 4 * 128; e += NG_) {
        const int sq = e >> 7, idx = e & 127; float c = 0.f;
#pragma unroll
        for (int n = 0; n < 15; ++n) { const float me = MQ[(size_t)sq * SEQ + 256 * n + 255]; const float f = n == 0 ? 0.f : fexp(MQ[(size_t)sq * SEQ + 256 * (n - 1) + 255] - me);
            c = f * c + Nv[((size_t)sq * 16 + n) * 128 + idx]; NS[((size_t)sq * 16 + n + 1) * 128 + idx] = c; }
    }
}

constexpr size_t SC_BSTRIDE = (size_t)4096 * (64 * 65 / 2);
DI size_t sc_off(int b, int t) { const int qb = t >> 6; return (size_t)b * SC_BSTRIDE + (size_t)4096 * (qb * (qb + 1) / 2) + (size_t)(t & 63) * 64 * (qb + 1); }
constexpr int CW_QUEUE2 = 12288;
DI void phase_scores(Frame& F, int it) {
    F.refresh();
    unsigned* qhead = (unsigned*)(F.ws + WS_CTL) + CW_QUEUE2 + it * 64;
    volatile LAS unsigned* slot = (volatile LAS unsigned*)(F.lds + MISC_OFF + 64);
    const bf16_t* IQ = (const bf16_t*)(F.ws + WS_IQ); const bf16_t* IK = (const bf16_t*)(F.ws + WS_IK); const float* IW = (const float*)(F.ws + WS_IW);
    float* SC = (float*)(F.ws + WS_HREG);
    for (;;) {
        if (F.tid == 0) *slot = __hip_atomic_fetch_add(qhead, 1u, __ATOMIC_RELAXED, __HIP_MEMORY_SCOPE_AGENT);
        __syncthreads();
        const int u = __builtin_amdgcn_readfirstlane((int)*slot);
        __syncthreads();
        if (u >= CB * 160 + 240) break;
        if (u >= CB * 160) { const int m_ = u - CB * 160; mlstm_state_unit(F, m_ & 15, m_ >> 4); continue; }
        int b = u / 160, k = u % 160, qb, seg;
        {
          int cls = 3, base = 0;
          for (;; --cls) { const int cnt = 16 * (cls + 1); if (k < base + cnt) break; base += cnt; }
          const int kk = k - base; qb = 16 * cls + (kk % 16); seg = kk / 16; }
        F.refresh();
        const int lane = F.lane, w = F.wave, r = lane & 31, h = lane >> 5, qh = w & 1;
        const int t0 = 64 * qb + 32 * qh;
        const size_t rowq = (size_t)b * SEQ + t0 + r;
        const f32x4 wv = *(const GAS f32x4*)(IW + rowq * 4);
        bf16x8 qf[4][4];
#pragma unroll
        for (int hd = 0; hd < 4; ++hd)
#pragma unroll
            for (int s = 0; s < 4; ++s) qf[hd][s] = *(const GAS bf16x8*)(IQ + rowq * 256 + hd * 64 + 16 * s + 8 * h);
        LAS unsigned* T = (LAS unsigned*)(F.lds + w * 8448);
        const int jplast = ((16 * seg + 15 < qb) ? 16 * seg + 15 : qb) >> 1;
        unsigned short* scb = (unsigned short*)(F.ws + WS_HREG) + sc_off(b, t0);
        const int rstride = 64 * (qb + 1);
        for (int jp = 8 * seg + (w >> 1); jp <= jplast; jp += 4) {
            const int nt2 = (2 * jp + 1 <= qb) ? 2 : 1;
            bf16x8 kfa[4][4];
#pragma unroll
            for (int q4 = 0; q4 < 4; ++q4) { const int jq = 2 * jp + ((q4 >> 1) < nt2 ? (q4 >> 1) : 0);
#pragma unroll
                for (int s = 0; s < 4; ++s) kfa[q4][s] = *(const GAS bf16x8*)(IK + ((size_t)b * SEQ + 64 * jq + 32 * (q4 & 1) + r) * 64 + 8 * h + 16 * s); }
#pragma unroll
            for (int ts = 0; ts < 2; ++ts) { if (ts < nt2) {
#pragma unroll
                for (int p = 0; p < 2; ++p) {
                    float sc[16];
#pragma unroll
                    for (int i = 0; i < 16; ++i) sc[i] = 0.f;
#pragma unroll
                    for (int hd = 0; hd < 4; ++hd) {
                        f32x16 acc;
#pragma unroll
                        for (int i = 0; i < 16; ++i) acc[i] = 0.f;
#pragma unroll
                        for (int s = 0; s < 4; ++s) acc = MFMA32(kfa[2 * ts + p][s], qf[hd][s], acc);
#pragma unroll
                        for (int i = 0; i < 16; ++i) sc[i] += wv[hd] * fmaxf(acc[i], 0.f);
                    }
#pragma unroll
                    for (int i = 0; i < 16; i += 2) {
                        const unsigned lo = __builtin_bit_cast(unsigned short, (_Float16)(sc[i] + 0.0f)), hi = __builtin_bit_cast(unsigned short, (_Float16)(sc[i + 1] + 0.0f));
                        T[r * 65 + ((64 * ts + 32 * p + (i & 3) + 8 * (i >> 2) + 4 * h) >> 1)] = lo | (hi << 16); }
                }
            } }
            WSYNC();
            if (lane < 32 * nt2) {
#pragma unroll 8
                for (int q = 0; q < 32; ++q) *(unsigned*)(scb + (size_t)q * rstride + 128 * jp + 2 * lane) = T[q * 65 + lane];
            }
            WSYNC();
        }
    }
}
DI unsigned long long spread32(unsigned x) {
    unsigned long long v = x;
    v = (v | (v << 16)) & 0x0000FFFF0000FFFFull; v = (v | (v << 8)) & 0x00FF00FF00FF00FFull; v = (v | (v << 4)) & 0x0F0F0F0F0F0F0F0Full;
    v = (v | (v << 2)) & 0x3333333333333333ull; v = (v | (v << 1)) & 0x5555555555555555ull; return v;
}
DI unsigned pack_nib(unsigned long long bm, int hh) {
    unsigned long long x = (bm >> (4 * hh)) & 0x0F0F0F0F0F0F0F0Full;
    x = (x | (x >> 4)) & 0x00FF00FF00FF00FFull; x = (x | (x >> 8)) & 0x0000FFFF0000FFFFull; x = (x | (x >> 16)) & 0x00000000FFFFFFFFull; return (unsigned)x;
}
DI void radix_find(LAS unsigned* hist, int lane, int& need, unsigned& digit, unsigned& cnt) {
    const u32x4 c = *(LAS const u32x4*)(hist + 4 * lane);
    const unsigned ls = (c.x + c.y) + (c.z + c.w); unsigned inc = ls;
#pragma unroll
    for (int o = 1; o < 64; o <<= 1) { const unsigned y = shup_u(inc, o, lane); if (lane >= o) inc += y; }
    const unsigned total = rdl_u(inc, 63);
    unsigned cum = total - inc; int fbin = -1; unsigned fneed = 0u, fcnt = 0u;
    if (cum < (unsigned)need && cum + c.w >= (unsigned)need) { fbin = 4 * lane + 3; fneed = (unsigned)need - cum; fcnt = c.w; } cum += c.w;
    if (fbin < 0 && cum < (unsigned)need && cum + c.z >= (unsigned)need) { fbin = 4 * lane + 2; fneed = (unsigned)need - cum; fcnt = c.z; } cum += c.z;
    if (fbin < 0 && cum < (unsigned)need && cum + c.y >= (unsigned)need) { fbin = 4 * lane + 1; fneed = (unsigned)need - cum; fcnt = c.y; } cum += c.y;
    if (fbin < 0 && cum < (unsigned)need && cum + c.x >= (unsigned)need) { fbin = 4 * lane; fneed = (unsigned)need - cum; fcnt = c.x; }
    const int src = __ffsll((long long)__ballot(fbin >= 0)) - 1;
    digit = rdl_u((unsigned)fbin, src); need = (int)rdl_u(fneed, src); cnt = rdl_u(fcnt, src);
}
template <int NGP>
DI void select_row(int row, int lane, LAS unsigned* hist, const unsigned (&raw)[32], unsigned* MASK, const int probe) {
        const int b = row >> 12, t = row & (SEQ - 1), n = t + 1, ngp = (t >> 7) + 1;
        unsigned key[NGP];
        (void)b;
#pragma unroll
        for (int i = 0; i < NGP; ++i) key[i] = raw[i];
#pragma unroll
        for (int i = 0; i < NGP; ++i) { const int e2 = 64 * i + lane; unsigned w_ = key[i];
            { const unsigned sg_ = (w_ >> 15) & 0x00010001u; w_ ^= ((sg_ << 15) - sg_) + 0x80008000u; }
            if (2 * e2 >= n) w_ &= 0xFFFF0000u; if (2 * e2 + 1 >= n) w_ &= 0x0000FFFFu; key[i] = w_; }
        unsigned thr = 0u; int need = 256; bool ties = false;
        if (n > 256 && probe != 1 && probe != 3) {
            unsigned dA = 0u, dB = 0u, cnt = 0u;
            { unsigned z_ = 0u; asm volatile("" : "+v"(z_)); *(LAS u32x4*)(hist + 4 * lane) = (u32x4){z_, z_, z_, z_}; }
            WSYNC();
#pragma unroll
            for (int i = 0; i < NGP; ++i) if (i < ngp) { const unsigned kx = key[i];
                __hip_atomic_fetch_add(&hist[(kx >> 8) & 255u], 1u, __ATOMIC_RELAXED, __HIP_MEMORY_SCOPE_WORKGROUP); __hip_atomic_fetch_add(&hist[kx >> 24], 1u, __ATOMIC_RELAXED, __HIP_MEMORY_SCOPE_WORKGROUP); }
            WSYNC();
            radix_find(hist, lane, need, dA, cnt);
            WSYNC();
            if ((unsigned)need != cnt) {
                { unsigned z_ = 0u; asm volatile("" : "+v"(z_)); *(LAS u32x4*)(hist + 4 * lane) = (u32x4){z_, z_, z_, z_}; }
                WSYNC();
#pragma unroll
                for (int i = 0; i < NGP; ++i) if (i < ngp) { const unsigned kx = key[i];
                    if (((kx >> 8) & 255u) == dA) __hip_atomic_fetch_add(&hist[kx & 255u], 1u, __ATOMIC_RELAXED, __HIP_MEMORY_SCOPE_WORKGROUP);
                    if ((kx >> 24) == dA) __hip_atomic_fetch_add(&hist[(kx >> 16) & 255u], 1u, __ATOMIC_RELAXED, __HIP_MEMORY_SCOPE_WORKGROUP); }
                WSYNC();
                radix_find(hist, lane, need, dB, cnt);
                WSYNC();
                thr = (dA << 8) | dB; ties = (unsigned)need != cnt;
            } else { thr = dA << 8; ties = false; }
        }
        unsigned elo = 0u, ehi = 0u, olo = 0u, ohi = 0u; int eqc = 0;
        if (probe == 1 || probe == 3) thr = 0x9000u;
        if (probe < 2)
        {
#define SEL_STEP(i) if constexpr ((i) < NGP) if ((i) < ngp) { const unsigned kx = key[(i) < NGP ? (i) : 0], kl = kx & 0xFFFFu, kh = kx >> 16; bool sl, sh; \
            if (n <= 256) { sl = kl != 0u; sh = kh != 0u; } \
            else if (!ties) { sl = kl >= thr; sh = kh >= thr; } \
            else { const bool ql = kl == thr, qh = kh == thr; const unsigned long long ml = __ballot(ql), mh = __ballot(qh), lt = (1ull << lane) - 1ull; \
                const int rl = eqc + __popcll(ml & lt) + __popcll(mh & lt), rh = rl + (ql ? 1 : 0); \
                sl = kl > thr || (ql && rl < need); sh = kh > thr || (qh && rh < need); eqc += __popcll(ml) + __popcll(mh); } \
            const unsigned long long be = __ballot(sl), bo = __ballot(sh); const unsigned e0 = (unsigned)be, e1 = (unsigned)(be >> 32), o0 = (unsigned)bo, o1 = (unsigned)(bo >> 32); \
            asm volatile("s_nop 4\n\tv_writelane_b32 %0, %4, " #i "\n\tv_writelane_b32 %1, %5, " #i "\n\tv_writelane_b32 %2, %6, " #i "\n\tv_writelane_b32 %3, %7, " #i \
                         : "+v"(elo), "+v"(ehi), "+v"(olo), "+v"(ohi) : "s"(e0), "s"(e1), "s"(o0), "s"(o1)); }
#define SEL8(b) SEL_STEP(b) SEL_STEP(b + 1) SEL_STEP(b + 2) SEL_STEP(b + 3) SEL_STEP(b + 4) SEL_STEP(b + 5) SEL_STEP(b + 6) SEL_STEP(b + 7)
        SEL8(0) SEL8(8) SEL8(16) SEL8(24)
#undef SEL8
#undef SEL_STEP
        }
        if (lane < 32) {
            const unsigned long long ta = spread32(elo) | (spread32(olo) << 1), tb = spread32(ehi) | (spread32(ohi) << 1);
            *(u32x2*)(MASK + ((size_t)row * 2 + 0) * 64 + 2 * lane) = (u32x2){pack_nib(ta, 0), pack_nib(tb, 0)};
            *(u32x2*)(MASK + ((size_t)row * 2 + 1) * 64 + 2 * lane) = (u32x2){pack_nib(ta, 1), pack_nib(tb, 1)};
        }
}
DI void phase_select(Frame& F, const int probe) {
    F.refresh();
    const int gw = F.bid * NWAVES + F.wave, NGW = F.G * NWAVES, lane = F.lane;
    LAS unsigned* hist = (LAS unsigned*)(F.lds + F.wave * 1024);
    const unsigned short* SC = (const unsigned short*)(F.ws + WS_HREG); unsigned* MASK = (unsigned*)(F.ws + WS_MASK);
    if (!probe) mlstm_state_scan(F);
    unsigned cur[32];
#define LOAD_ROW(dst, rw) do { const int t_ = (rw) & (SEQ - 1), em_ = t_ >> 1; const unsigned* sr_ = (const unsigned*)(SC + sc_off((rw) >> 12, t_)); \
        _Pragma("unroll") for (int i_ = 0; i_ < 32; ++i_) { const int e_ = 64 * i_ + lane; dst[i_] = *(const GAS unsigned*)(sr_ + (e_ < em_ ? e_ : em_)); } } while (0)
    const int nstep = (MC + NGW - 1) / NGW;
#define ROW_OF(k) ((NGW == 2048) ? (((k) >> 1) * SEQ + (((k) & 1) ? (SEQ - 1 - gw) : gw)) : (gw + (k) * NGW))
    if (gw < MC) LOAD_ROW(cur, ROW_OF(0));
    for (int k = 0; k < nstep; ++k) {
        const int row = ROW_OF(k); if (row >= MC) break;
        unsigned nxt[32]; const int nrow = (k + 1 < nstep && ROW_OF(k + 1) < MC) ? ROW_OF(k + 1) : row;
        LOAD_ROW(nxt, nrow);
        asm volatile("" ::: "memory");
        const int cls = (row & (SEQ - 1)) >> 10;
        unsigned* mk = probe ? (unsigned*)(F.ws + WS_QKRAW) : MASK;
        if (cls == 0) select_row<8>(row, lane, hist, cur, mk, probe);
        else if (cls == 1) select_row<16>(row, lane, hist, cur, mk, probe);
        else if (cls == 2) select_row<24>(row, lane, hist, cur, mk, probe);
        else select_row<32>(row, lane, hist, cur, mk, probe);
#pragma unroll
        for (int i = 0; i < 32; ++i) cur[i] = nxt[i];
    }
#undef ROW_OF
#undef LOAD_ROW
}

#ifndef MK_ONE_LAUNCH
#define MK_ONE_LAUNCH 1
#endif
constexpr int NPHASE = 13;
__global__ void __launch_bounds__(NWAVES * 64, 2) fwd(Args args) {
    extern __shared__ __attribute__((aligned(16))) unsigned char lds[];
    Frame F;
    F.lds = (LAS unsigned char*)lds; F.ws = args.ws;
    F.tid = threadIdx.x; F.lane = F.tid & 63; F.wave = __builtin_amdgcn_readfirstlane(F.tid >> 6); F.wave0 = F.wave;
    F.G = gridDim.x; F.bid = blockIdx.x;
    volatile LAS unsigned* MISC = (volatile LAS unsigned*)(F.lds + MISC_OFF);
    for (int u = F.tid; u < (LDS_BYTES - LDSCTL_OFF) / 4; u += NWAVES * 64) ((LAS unsigned*)(F.lds + LDSCTL_OFF))[u] = 0u;
    __syncthreads();
    const bool multi = MK_ONE_LAUNCH ? true : !(args.it_hi - args.it_lo == 1 && args.ph_hi - args.ph_lo == 1);
    XcdBarrier bar; bar.bar = (unsigned*)(F.ws + WS_CTL) + CW_BAR; bar.x = 0; bar.st = nullptr;
    if (multi) bar = xcd_barrier_post((unsigned*)(F.ws + WS_CTL) + CW_BAR, MISC + 8);
#define GRID_BAR() do { if (multi) { xcd_barrier(bar); if ((REPMASK >> 15) & 1) xcd_barrier(bar); } } while (0)
    const int lo = args.ph_lo, hi = args.ph_hi; (void)lo; (void)hi;
#ifndef PHMASK
#define PHMASK 0xFFFF
#endif
#if MK_ONE_LAUNCH
#define IN(k) ((PHMASK >> (k)) & 1)
#else
#define IN(k) (((PHMASK >> (k)) & 1) && lo <= (k) && (k) < hi)
#endif
#define REPS(k) (1 + ((REPMASK >> (k)) & 1))
    if (IN(0) && args.it_lo == 0) for (int rp = 0; rp < REPS(0); ++rp) { phase_prologue(F, args); GRID_BAR(); }
    for (int it = args.it_lo; it < args.it_hi; ++it) {
        const int chunk = it >> 1, l = it & 1;
        unsigned char* wl = F.ws + WS_W + (size_t)l * W_LAYER;
        const size_t xoff = (size_t)chunk * MC * DM;
        const float* xin = args.in[I_X] + xoff;
        float* Xout = args.out + xoff;
        bf16_t* X16 = (bf16_t*)(F.ws + WS_X16);
        bf16_t* XN = (bf16_t*)(F.ws + WS_XN);
        if (IN(1)) for (int rp = 0; rp < REPS(1); ++rp) { phase_rmsnorm(F, l == 0 ? (const void*)xin : (const void*)X16, l != 0, args.in[I_NMG] + (size_t)l * DM, XN); GRID_BAR(); }
        if (IN(2)) for (int rp = 0; rp < REPS(2); ++rp) {
            pg8::Gemm g{XN, (const bf16_t*)(wl + WO_IN), MC, NT_IN * 256, DM}; F.refresh(); pg8::StaticOrder S; S.init(MC, NT_IN * 256, F.G, F.bid);
            EpiInProj E{F.ws, args.in[I_GB] + l * 8, l};
            pg8::gemm_phase<EpiInProj, true>(F.lds, g, S, E, F.tid);
            GRID_BAR();
        }
        if (IN(3)) for (int rp = 0; rp < REPS(3); ++rp) { phase_token(F, args, l, rp == 0 ? 0 : PROBE_NOLOAD); GRID_BAR(); }
        if (IN(4)) for (int rp = 0; rp < REPS(4); ++rp) {
            pg8::Gemm g{(const bf16_t*)(F.ws + WS_CKV), (const bf16_t*)(wl + WO_KV), MC, 1024, 256}; F.refresh(); pg8::StaticOrder S; S.init(MC, 1024, F.G, F.bid);
            EpiKV E{F.ws, l};
            pg8::gemm_phase<EpiKV, true>(F.lds, g, S, E, F.tid);
            if (rp + 1 < REPS(4)) GRID_BAR();
        }
#ifdef NAIVE_SEL
        if (IN(5)) { naive_select(F); GRID_BAR(); }
#else
        if (IN(5)) { for (int rp = 0; rp < REPS(5); ++rp) { phase_scores(F, it + 8 * rp); GRID_BAR(); } for (int rp = 0; rp < REPS(13); ++rp) { phase_select(F, rp == 0 ? 0 : PROBE_NOLOAD); GRID_BAR(); } }
#endif
                if (IN(7)) for (int rp = 0; rp < REPS(7); ++rp) {
            pg8::Gemm g{XN, (const bf16_t*)(wl + WO_G), MC, 3072, DM}; F.refresh(); pg8::StaticOrder S; S.init(MC, 3072, F.G, F.bid);
            EpiGate E{F.ws + WS_HREG, args.in[I_BG] + (size_t)l * 3072};
            pg8::gemm_phase<EpiGate, true>(F.lds, g, S, E, F.tid);
            if (rp + 1 < REPS(7)) GRID_BAR();
        }
#ifdef NAIVE_MIX
        if (IN(6)) { naive_dsa(F); __syncthreads(); naive_mlstm(F, args, l); __syncthreads(); naive_diff(F, args, l); GRID_BAR(); }
#else
        if (IN(6)) for (int rp = 0; rp < REPS(6); ++rp) { phase_mixers(F, args, l, it + 8 * rp, rp == 0 ? 7 : PROBE_MODES, rp == 0 ? 0 : PROBE_NOLOAD); GRID_BAR(); }
#endif
        if (IN(8)) for (int rp = 0; rp < REPS(8); ++rp) {
            pg8::Gemm g{(const bf16_t*)(F.ws + WS_Y), (const bf16_t*)(wl + WO_BR), MC, 1024, 1536}; F.refresh(); pg8::StaticOrder S; S.init(MC, 1024, F.G, F.bid);
            EpiMerge E{F.ws + WS_HREG, (bf16_t*)(F.ws + WS_MG)};
            pg8::gemm_phase<EpiMerge, false>(F.lds, g, S, E, F.tid);
            GRID_BAR();
        }
        if (IN(9)) for (int rp = 0; rp < REPS(9); ++rp) {
            pg8::Gemm g{(const bf16_t*)(F.ws + WS_MG), (const bf16_t*)(wl + WO_OUT), MC, 1024, 1024}; F.refresh(); pg8::StaticOrder S; S.init(MC, 1024, F.G, F.bid);
            EpiResid E{l == 0 ? (const void*)xin : (const void*)X16, (void*)X16, l != 0, true};
            pg8::gemm_phase<EpiResid, false>(F.lds, g, S, E, F.tid);
            GRID_BAR();
        }
        if (IN(10)) for (int rp = 0; rp < REPS(10); ++rp) { phase_rmsnorm(F, X16, true, args.in[I_NFG] + (size_t)l * DM, XN); GRID_BAR(); }
        if (IN(11)) for (int rp = 0; rp < REPS(11); ++rp) {
            pg8::Gemm g{XN, (const bf16_t*)(wl + WO_GU), MC, 5632, DM}; F.refresh(); pg8::StaticOrder S; S.init(MC, 5632, F.G, F.bid);
            EpiSwiGLU E{(bf16_t*)(F.ws + WS_HREG)};
            pg8::gemm_phase<EpiSwiGLU, true>(F.lds, g, S, E, F.tid);
            GRID_BAR();
        }
        if (IN(12)) for (int rp = 0; rp < REPS(12); ++rp) {
            pg8::Gemm g{(const bf16_t*)(F.ws + WS_HREG), (const bf16_t*)(wl + WO_D), MC, 1024, FF}; F.refresh(); pg8::StaticOrder S; S.init(MC, 1024, F.G, F.bid);
            EpiResid E{(const void*)X16, l == DEPTH - 1 ? (void*)Xout : (void*)X16, true, l != DEPTH - 1};
            pg8::gemm_phase<EpiResid, false>(F.lds, g, S, E, F.tid);
            GRID_BAR();
        }
    }
#undef IN
#undef GRID_BAR
}

extern "C" void kernel_launch(void* const* d_in, const int* in_sizes, int n_in, void* d_out, int out_size, void* d_ws, size_t ws_size, hipStream_t stream) {
    static int grid = 0;
    if (grid == 0) {
        if (n_in != 21 || ws_size < WS_END) { fprintf(stderr, "kernel_launch: unexpected inputs (n_in %d, ws %zu)\n", n_in, ws_size); grid = -1; return; }
        int dev = 0, cus = 0;
        if (hipGetDevice(&dev) != hipSuccess || hipDeviceGetAttribute(&cus, hipDeviceAttributeMultiprocessorCount, dev) != hipSuccess) { grid = -1; return; }
        if (hipFuncSetAttribute((const void*)fwd, hipFuncAttributeMaxDynamicSharedMemorySize, LDS_BYTES) != hipSuccess) { grid = -1; return; }
        int per_cu = 0;
        if (hipOccupancyMaxActiveBlocksPerMultiprocessor(&per_cu, (const void*)fwd, NWAVES * 64, LDS_BYTES) != hipSuccess || per_cu < 1) fprintf(stderr, "kernel_launch: occupancy query says %d\n", per_cu);
        (void)hipGetLastError();
        grid = cus;
    }
    if (grid < 0) return;
    (void)hipMemsetAsync((char*)d_ws + WS_CTL, 0, CTL_ZERO_BYTES, stream);
    Args a{};
    for (int i = 0; i < 21; ++i) a.in[i] = (const float*)d_in[i];
    a.out = (float*)d_out; a.ws = (unsigned char*)d_ws;
#if MK_ONE_LAUNCH
    a.it_lo = 0; a.it_hi = NCHUNK * DEPTH; a.ph_lo = 0; a.ph_hi = NPHASE;
    hipLaunchKernelGGL(fwd, dim3(grid), dim3(NWAVES * 64), LDS_BYTES, stream, a);
#else
    a.it_lo = 0; a.it_hi = 1; a.ph_lo = 0; a.ph_hi = 1;
    hipLaunchKernelGGL(fwd, dim3(grid), dim3(NWAVES * 64), LDS_BYTES, stream, a);
    for (int it = 0; it < NCHUNK * DEPTH; ++it)
        for (int ph = 1; ph < NPHASE; ++ph) { a.it_lo = it; a.it_hi = it + 1; a.ph_lo = ph; a.ph_hi = ph + 1; hipLaunchKernelGGL(fwd, dim3(grid), dim3(NWAVES * 64), LDS_BYTES, stream, a); }
#endif
}
```

```cpp
#include <hip/hip_runtime.h>
#include <cstdio>
#include <cstdint>

#ifndef REPMASK
#define REPMASK 0
#endif
#define PROBE_MODES 7
#define PROBE_NOLOAD 0
#define DI __device__ __forceinline__
#define LAS __attribute__((address_space(3)))
#define GAS __attribute__((address_space(1)))

typedef unsigned short bf16_t;
typedef short bf16x8 __attribute__((ext_vector_type(8)));
typedef float f32x4 __attribute__((ext_vector_type(4)));
typedef float f32x2 __attribute__((ext_vector_type(2)));
typedef unsigned u32x4 __attribute__((ext_vector_type(4)));
typedef unsigned u32x2 __attribute__((ext_vector_type(2)));

constexpr int BATCH = 8, SEQ = 4096, DM = 1024, DEPTH = 2;
constexpr int CB = 4;
constexpr int MC = CB * SEQ;
constexpr int NCHUNK = BATCH / CB;
constexpr int IN_COLS = 7756;
constexpr int FF = 2816;
constexpr float EPS = 1e-6f;
constexpr float LOG2E = 1.4426950408889634f;
constexpr float C2 = 0.125f * LOG2E;
constexpr int Z_MQK = 0, Z_MV = 1024, Z_MO = 1536, Z_MIF = 2048, Z_SQ = 2056, Z_CKV = 2568, Z_IQ = 2824, Z_IK = 3080, Z_IW = 3144, Z_DQ = 3148, Z_DK = 3660, Z_DV = 4172, Z_G = 4684;
constexpr int NT_IN = 19;

constexpr size_t MiB = 1u << 20;
constexpr size_t WS_CTL = 0, CTL_ZERO_BYTES = 128 * 1024;
constexpr size_t WS_COS = 1 * MiB, WS_SIN = 1 * MiB + 512 * 1024;
constexpr size_t WS_W = 2 * MiB, W_LAYER = 38 * MiB;
constexpr size_t WO_IN = 0;
constexpr size_t WO_G = WO_IN + (size_t)NT_IN * 256 * 1024 * 2;
constexpr size_t WO_KV = WO_G + (size_t)3072 * 1024 * 2;
constexpr size_t WO_BR = WO_KV + (size_t)1024 * 256 * 2;
constexpr size_t WO_OUT = WO_BR + (size_t)1024 * 1536 * 2;
constexpr size_t WO_GU = WO_OUT + (size_t)1024 * 1024 * 2;
constexpr size_t WO_D = WO_GU + (size_t)5632 * 1024 * 2;
static_assert(WO_D + (size_t)1024 * 2816 * 2 <= W_LAYER, "weights per layer");
constexpr size_t WS_ACT = WS_W + 2 * W_LAYER;
constexpr size_t WS_XN = WS_ACT;
constexpr size_t WS_QKRAW = WS_XN + 32 * MiB;
constexpr size_t WS_CKV = WS_QKRAW + 32 * MiB;
constexpr size_t WS_IQ = WS_CKV + 8 * MiB;
constexpr size_t WS_Y = WS_QKRAW;
constexpr size_t WS_QK = WS_IQ + 8 * MiB;
constexpr size_t WS_MG = WS_QK;
constexpr size_t WS_VM = WS_QK + 32 * MiB;
constexpr size_t WS_OM = WS_VM + 16 * MiB;
constexpr size_t WS_SQ = WS_OM + 16 * MiB;
constexpr size_t WS_DQ = WS_SQ + 16 * MiB;
constexpr size_t WS_DK = WS_DQ + 16 * MiB;
constexpr size_t WS_DV = WS_DK + 16 * MiB;
constexpr size_t WS_SK = WS_DV + 16 * MiB;
constexpr size_t WS_SV = WS_SK + 16 * MiB;
constexpr size_t WS_IK = WS_SV + 16 * MiB;
constexpr size_t WS_IF = WS_IK + 2 * MiB;
constexpr size_t WS_IW = WS_IF + 512 * 1024;
constexpr size_t WS_RT = WS_IW + 256 * 1024;
constexpr size_t WS_AK = WS_RT + 256 * 1024;
constexpr size_t WS_MQ = WS_AK + 256 * 1024;
constexpr size_t WS_EM = WS_MQ + 256 * 1024;
constexpr size_t WS_MASK = WS_IK + 4 * MiB;
constexpr size_t WS_HREG = WS_MASK + 8 * MiB;
constexpr size_t WS_X16 = WS_HREG + 96 * MiB;
constexpr size_t WS_MD = WS_X16 + 32 * MiB;
constexpr size_t WS_MC = WS_MD + 16 * MiB;
constexpr size_t WS_MN = WS_MC + 8 * MiB;
constexpr size_t WS_END = WS_MN + 1 * MiB;
static_assert(WS_EM + 256 * 1024 <= WS_MASK, "small buffers");
static_assert(WS_END <= 512 * MiB, "workspace");
constexpr int CW_BAR = 4096;
constexpr size_t WS_GAIN = 512 * 1024;

constexpr int RING_BYTES = 131072;
constexpr int LDSCTL_OFF = RING_BYTES, MISC_OFF = LDSCTL_OFF + 320;
constexpr int LDS_BYTES = 147456;
constexpr int NWAVES = 8;

DI float bf2f(unsigned v) { return __uint_as_float(v << 16); }
DI unsigned f2bf(float f) { unsigned u = __float_as_uint(f); return (u + 0x7fffu + ((u >> 16) & 1u)) >> 16; }
DI unsigned pk2(float lo, float hi) { return f2bf(lo) | (f2bf(hi) << 16); }
DI float bflo(unsigned w) { return __uint_as_float(w << 16); }
DI float bfhi(unsigned w) { return __uint_as_float(w & 0xffff0000u); }
typedef unsigned u32x2v __attribute__((ext_vector_type(2)));
DI float xor1(float v)  { return __uint_as_float((unsigned)__builtin_amdgcn_mov_dpp((int)__float_as_uint(v), 0xB1, 0xF, 0xF, true)); }
DI float xor2(float v)  { return __uint_as_float((unsigned)__builtin_amdgcn_mov_dpp((int)__float_as_uint(v), 0x4E, 0xF, 0xF, true)); }
DI float ror4(float v)  { return __uint_as_float((unsigned)__builtin_amdgcn_mov_dpp((int)__float_as_uint(v), 0x124, 0xF, 0xF, true)); }
DI float ror8(float v)  { return __uint_as_float((unsigned)__builtin_amdgcn_mov_dpp((int)__float_as_uint(v), 0x128, 0xF, 0xF, true)); }
DI float sum16x(float v) { const unsigned u = __float_as_uint(v); const auto r = __builtin_amdgcn_permlane16_swap(u, u, false, false); return __uint_as_float(r[0]) + __uint_as_float(r[1]); }
DI float sum32x(float v) { const unsigned u = __float_as_uint(v); const auto r = __builtin_amdgcn_permlane32_swap(u, u, false, false); return __uint_as_float(r[0]) + __uint_as_float(r[1]); }
DI float max16x(float v) { const unsigned u = __float_as_uint(v); const auto r = __builtin_amdgcn_permlane16_swap(u, u, false, false); return fmaxf(__uint_as_float(r[0]), __uint_as_float(r[1])); }
DI float max32x(float v) { const unsigned u = __float_as_uint(v); const auto r = __builtin_amdgcn_permlane32_swap(u, u, false, false); return fmaxf(__uint_as_float(r[0]), __uint_as_float(r[1])); }
DI unsigned shup_u(unsigned v, int o, int lane) { return (unsigned)__builtin_amdgcn_ds_bpermute(((lane - o) & 63) << 2, (int)v); }
DI float shup_f(float v, int o, int lane) { return __uint_as_float(shup_u(__float_as_uint(v), o, lane)); }
DI double shup_d(double v, int o, int lane) { const unsigned long long u = __builtin_bit_cast(unsigned long long, v); const unsigned lo = shup_u((unsigned)u, o, lane), hi = shup_u((unsigned)(u >> 32), o, lane); return __builtin_bit_cast(double, ((unsigned long long)hi << 32) | lo); }
DI unsigned rdl_u(unsigned v, int src) { return (unsigned)__builtin_amdgcn_readlane((int)v, src); }
DI float wave_sum(float v) { v += xor1(v); v += xor2(v); v += ror4(v); v += ror8(v); v = sum16x(v); return sum32x(v); }
DI float wave_max(float v) { v = fmaxf(v, xor1(v)); v = fmaxf(v, xor2(v)); v = fmaxf(v, ror4(v)); v = fmaxf(v, ror8(v)); v = max16x(v); return max32x(v); }
typedef __bf16 bf16x2e_t __attribute__((ext_vector_type(2)));
DI unsigned cvtpk_(float lo, float hi) { f32x2 v = {lo, hi}; bf16x2e_t b = __builtin_convertvector(v, bf16x2e_t); return __builtin_bit_cast(unsigned, b); }
DI float fexp2(float x) { return __builtin_amdgcn_exp2f(x); }
DI float fexp(float x) { return __builtin_amdgcn_exp2f(x * LOG2E); }
DI float frcp(float x) { return __builtin_amdgcn_rcpf(x); }
DI float sigmoidf_(float x) { return frcp(1.0f + fexp(-x)); }
#define WSYNC() do { asm volatile("s_waitcnt lgkmcnt(0)" ::: "memory"); __builtin_amdgcn_wave_barrier(); } while (0)

namespace pg8 {
constexpr int BM = 256, BK = 64, HALF = 128, HTB = HALF * BK * 2, STAGE_BYTES = 8 * HTB, NXCD = 8, WGM = 8;
__host__ __device__ __forceinline__ int lds_byte(int r, int c) { const int st = (r >> 4) * 2 + (c >> 5), rr = r & 15, cc = c & 31, ob = rr * 64 + cc * 2; return st * 1024 + (ob ^ (((ob >> 9) & 1) << 5)); }
__host__ __device__ __forceinline__ void stage_rc(int b, int& R, int& C) { const int st = b / 1024, sb = b % 1024, swz = sb ^ (((sb >> 9) & 1) << 5); R = (st >> 1) * 16 + swz / 64; C = (st & 1) * 32 + (swz % 64) / 2; }
__host__ __device__ __forceinline__ int perm32(int rho) { const int n = rho >> 4, i = rho & 15; return 8 * (i >> 2) + 4 * n + (i & 3); }
struct Unit { int pm, pn; };
struct Gemm { const bf16_t* A; const bf16_t* Bt; int M, N, K; };
struct StaticOrder {
    int nM, nN, nwg, G, c;
    __host__ __device__ void init(int M, int N, int G_, int c_) { nM = M / BM; nN = N / BM; nwg = nM * nN; G = G_; c = c_; }
    __host__ __device__ bool next(int i, Unit& u) const {
        const long L = (long)i * G + c; if (L >= nwg) return false;
        int wgid = (int)L; { const int q = nwg / NXCD, r = nwg % NXCD, xcd = wgid % NXCD, off = wgid / NXCD; wgid = (xcd < r ? xcd * (q + 1) : r * (q + 1) + (xcd - r) * q) + off; }
        const int nig = WGM * nN, gid = wgid / nig, fm = gid * WGM, gsz = (nM - fm) < WGM ? (nM - fm) : WGM;
        u.pm = fm + ((wgid % nig) % gsz); u.pn = (wgid % nig) / gsz; return true;
    }
};
template <class Epi, bool ALIGN_EPI>
__device__ __forceinline__ void gemm_phase(LAS unsigned char* lds, const Gemm g, const StaticOrder& S, const Epi& E, int tid_in) {
    int tid_ = tid_in; asm volatile("" : "+v"(tid_));
    int K_ = g.K; asm volatile("" : "+s"(K_));
    const int tid = tid_, wid = __builtin_amdgcn_readfirstlane(tid >> 6), lane = tid & 63, wr = wid >> 2, wc = wid & 3, fr = lane & 15, fq = lane >> 4;
    const int K = K_, nt = K / BK;
    unsigned voffA[2], voffB[2];
#pragma unroll
    for (int i = 0; i < 2; ++i) { int R, C; stage_rc(tid * 16 + i * 8192, R, C); const int Rb = Epi::PERM ? ((R & ~31) + perm32(R & 31)) : R;
        voffA[i] = (unsigned)(R * K + C) * 2u; voffB[i] = (unsigned)(Rb * K + C) * 2u; }
    const size_t kstep = (size_t)(BK * 2);
    const size_t hstep = (size_t)HALF * K * 2;
    const size_t tstep = 2 * hstep;
    const unsigned ldsw = (unsigned)wid * 1024u;
    const int aoff = lds_byte(wr * 64 + fr, fq * 8), boff = lds_byte(wc * 32 + fr, fq * 8);
#define PG8_SA(b, h) (((b) * 2 + (h)) * HTB)
#define PG8_SB(b, h) ((4 + (b) * 2 + (h)) * HTB)
#define PG8_STAGE(bufoff, gbase, voff) do { _Pragma("unroll") for (int _i = 0; _i < 2; ++_i) \
        __builtin_amdgcn_global_load_lds((const unsigned*)((const char*)(gbase) + (voff)[_i]), (LAS unsigned*)(lds + (bufoff) + ldsw + _i * 8192), 16, 0, 0); } while (0)
#define PG8_LDA(dst, b, h) do { _Pragma("unroll") for (int m = 0; m < 4; ++m) _Pragma("unroll") for (int k = 0; k < 2; ++k) dst[m][k] = *(const LAS bf16x8*)(lds + PG8_SA(b, h) + aoff + m * 2048 + k * 1024); } while (0)
#define PG8_LDB(dst, b, h) do { _Pragma("unroll") for (int n = 0; n < 2; ++n) _Pragma("unroll") for (int k = 0; k < 2; ++k) dst[n][k] = *(const LAS bf16x8*)(lds + PG8_SB(b, h) + boff + n * 2048 + k * 1024); } while (0)
#define PG8_MMA(ai, bj, At, Bt) do { __builtin_amdgcn_s_setprio(1); _Pragma("unroll") for (int m = 0; m < 4; ++m) _Pragma("unroll") for (int n = 0; n < 2; ++n) _Pragma("unroll") for (int k = 0; k < 2; ++k) \
        acc[ai][bj][m][n] = __builtin_amdgcn_mfma_f32_16x16x32_bf16(Bt[n][k], At[m][k], acc[ai][bj][m][n], 0, 0, 0); __builtin_amdgcn_s_setprio(0); } while (0)
#define PG8_WAIT_V(n) asm volatile("s_waitcnt vmcnt(" #n ")" ::: "memory")
#define PG8_WAIT_L(n) asm volatile("s_waitcnt lgkmcnt(" #n ")" ::: "memory")
#define PG8_BAR __builtin_amdgcn_s_barrier()
#define PG8_SCHED __builtin_amdgcn_sched_barrier(0)
    Unit cur, nxt; int ui = 0;
    if (!S.next(0, cur)) return;
    f32x4 acc[2][2][4][2];
    if constexpr (Epi::INIT) { int fr_ = fr, fq_ = fq, wr_ = wr, wc_ = wc; asm volatile("" : "+v"(fr_), "+v"(fq_), "+s"(wr_), "+s"(wc_)); E.init(acc, cur, wr_, wc_, fr_, fq_); }
    else {
#pragma unroll
    for (int a = 0; a < 2; ++a)
#pragma unroll
        for (int b = 0; b < 2; ++b)
#pragma unroll
            for (int m = 0; m < 4; ++m)
#pragma unroll
                for (int n = 0; n < 2; ++n) acc[a][b][m][n] = (f32x4){0.f, 0.f, 0.f, 0.f};
    }
    bf16x8 At[4][2], B0[2][2], B1[2][2];
    const char* cA = (const char*)g.A + (size_t)cur.pm * tstep; const char* cB = (const char*)g.Bt + (size_t)cur.pn * tstep;
    PG8_STAGE(PG8_SB(0, 0), cB, voffB); PG8_STAGE(PG8_SB(0, 1), cB + hstep, voffB); PG8_STAGE(PG8_SA(0, 0), cA, voffA); PG8_STAGE(PG8_SA(0, 1), cA + hstep, voffA);
    if (wr == 1) PG8_BAR;
    PG8_WAIT_V(2); PG8_BAR;
    PG8_STAGE(PG8_SB(1, 0), cB + kstep, voffB); PG8_STAGE(PG8_SA(1, 0), cA + kstep, voffA); PG8_STAGE(PG8_SB(1, 1), cB + hstep + kstep, voffB);
    PG8_WAIT_V(6); PG8_BAR;
    for (;;) {
        const bool has_next = S.next(ui + 1, nxt);
        const char* nA = has_next ? (const char*)g.A + (size_t)nxt.pm * tstep : cA; const char* nB = has_next ? (const char*)g.Bt + (size_t)nxt.pn * tstep : cB;
        for (int t = 0; t < nt; t += 2) {
            const bool last = (t == nt - 2);
            const char* a1 = cA + (size_t)(t + 1) * kstep;
            const char* a2 = last ? nA : cA + (size_t)(t + 2) * kstep; const char* b2 = last ? nB : cB + (size_t)(t + 2) * kstep;
            const char* a3 = a2 + kstep; const char* b3 = b2 + kstep;
            if constexpr (Epi::MIDK) { if (t == 8 || t == 16) { int fr_ = fr, fq_ = fq, wr_ = wr, wc_ = wc; asm volatile("" : "+v"(fr_), "+v"(fq_), "+s"(wr_), "+s"(wc_)); E.mid(acc, cur, t, wr_, wc_, fr_, fq_); } }
            PG8_LDB(B0, 0, 0); PG8_LDB(B1, 0, 1); PG8_SCHED; PG8_LDA(At, 0, 0); PG8_STAGE(PG8_SA(1, 1), a1 + hstep, voffA);
            PG8_WAIT_V(8); PG8_WAIT_L(0); PG8_BAR; PG8_MMA(0, 0, At, B0); PG8_MMA(0, 1, At, B1); PG8_BAR; PG8_SCHED;
            PG8_LDA(At, 0, 1); PG8_STAGE(PG8_SB(0, 0), b2, voffB); PG8_STAGE(PG8_SB(0, 1), b2 + hstep, voffB); PG8_STAGE(PG8_SA(0, 0), a2, voffA);
            PG8_WAIT_V(8); PG8_WAIT_L(0); PG8_BAR; PG8_MMA(1, 0, At, B0); PG8_MMA(1, 1, At, B1); PG8_BAR; PG8_SCHED;
            PG8_LDB(B0, 1, 0); PG8_LDB(B1, 1, 1); PG8_SCHED; PG8_LDA(At, 1, 0); PG8_STAGE(PG8_SA(0, 1), a2 + hstep, voffA);
            PG8_WAIT_V(8); PG8_WAIT_L(0); PG8_BAR; PG8_MMA(0, 0, At, B0); PG8_MMA(0, 1, At, B1); PG8_BAR; PG8_SCHED;
            PG8_LDA(At, 1, 1); PG8_STAGE(PG8_SB(1, 0), b3, voffB); PG8_STAGE(PG8_SB(1, 1), b3 + hstep, voffB); PG8_STAGE(PG8_SA(1, 0), a3, voffA);
            PG8_WAIT_V(8); PG8_WAIT_L(0); PG8_BAR; PG8_MMA(1, 0, At, B0); PG8_MMA(1, 1, At, B1); PG8_BAR; PG8_SCHED;
        }
        if constexpr (ALIGN_EPI) { if (wr == 0) PG8_BAR; }
        { int fr_ = fr, fq_ = fq, wr_ = wr, wc_ = wc; asm volatile("" : "+v"(fr_), "+v"(fq_), "+s"(wr_), "+s"(wc_)); E(acc, cur, wr_, wc_, fr_, fq_); }
        if (!has_next) break;
        if constexpr (Epi::INIT) { int fr_ = fr, fq_ = fq, wr_ = wr, wc_ = wc; asm volatile("" : "+v"(fr_), "+v"(fq_), "+s"(wr_), "+s"(wc_)); E.init(acc, nxt, wr_, wc_, fr_, fq_); }
        else {
#pragma unroll
        for (int a = 0; a < 2; ++a)
#pragma unroll
            for (int b = 0; b < 2; ++b)
#pragma unroll
                for (int m = 0; m < 4; ++m)
#pragma unroll
                    for (int n = 0; n < 2; ++n) acc[a][b][m][n] = (f32x4){0.f, 0.f, 0.f, 0.f};
        }
        cur = nxt; cA = nA; cB = nB; ++ui;
        if constexpr (ALIGN_EPI) { if (wr == 1) PG8_BAR; }
    }
    PG8_WAIT_V(0);
    if constexpr (!ALIGN_EPI) { if (wr == 0) PG8_BAR; }
    PG8_BAR;
#undef PG8_SA
#undef PG8_SB
#undef PG8_STAGE
#undef PG8_LDA
#undef PG8_LDB
#undef PG8_MMA
#undef PG8_WAIT_V
#undef PG8_WAIT_L
#undef PG8_BAR
#undef PG8_SCHED
}
}

#define XB_TMO      128
#define XB_XCNT(j)  (256  + 64 * (j))
#define XB_XSUB(j)  (1280 + 64 * (j))
#define XB_XGEN(j)  (2304 + 64 * (j))
#define XB_TOP      3328
#define XB_TOPGEN   3392
#define XCD_BAR_WORDS 3456
#define XB_SPIN_CAP (1u << 24)
DI unsigned xb_ld(unsigned* p)              { return __hip_atomic_load(p, __ATOMIC_RELAXED, __HIP_MEMORY_SCOPE_AGENT); }
DI unsigned xb_add(unsigned* p, unsigned v) { return __hip_atomic_fetch_add(p, v, __ATOMIC_RELAXED, __HIP_MEMORY_SCOPE_AGENT); }
DI unsigned xb_xcc_id() { return (unsigned)__builtin_amdgcn_s_getreg((3 << 11) | 20) & 0xFu; }
#define XB_SPIN(cond, bar) do { unsigned _sp = 0; while (cond) { __builtin_amdgcn_s_sleep(1); \
    if ((++_sp & 255u) == 0u) { if (xb_ld(&(bar)[XB_TMO])) break; if (_sp > XB_SPIN_CAP) { atomicAdd(&(bar)[XB_TMO], 1u); break; } } } } while (0)
struct XcdBarrier { unsigned* bar; unsigned x; volatile LAS unsigned* st; };
DI XcdBarrier xcd_barrier_post(unsigned* bar, volatile LAS unsigned* st) {
    XcdBarrier b; b.bar = bar; b.x = xb_xcc_id(); b.st = st;
    if (threadIdx.x == 0) (void)xb_add(&bar[XB_XCNT(b.x)], 1u);
    return b;
}
DI void xcd_barrier_complete(unsigned* bar, unsigned x, unsigned& nloc, unsigned& nx) {
    const unsigned G = gridDim.x * gridDim.y * gridDim.z;
    unsigned sum, cnt, mine, sp = 0u;
    for (;;) {
        sum = 0u; cnt = 0u; mine = 0u;
#pragma unroll
        for (unsigned j = 0; j < 16; ++j) { const unsigned c = xb_ld(&bar[XB_XCNT(j)]); sum += c; cnt += (c > 0u) ? 1u : 0u; mine = (j == x) ? c : mine; }
        if (sum == G) break;
        __builtin_amdgcn_s_sleep(1);
        if ((++sp & 255u) == 0u) { if (xb_ld(&bar[XB_TMO])) break; if (sp > XB_SPIN_CAP) { atomicAdd(&bar[XB_TMO], 1u); break; } }
    }
    nloc = mine > 0u ? mine : 1u; nx = cnt > 0u ? cnt : 1u;
}
DI void xcd_barrier(const XcdBarrier& b_in) {
    XcdBarrier b = b_in; { unsigned x_ = b.x; asm volatile("" : "+s"(x_)); b.x = x_; }
    asm volatile("s_waitcnt vmcnt(0)" ::: "memory");
    __syncthreads();
    if (threadIdx.x == 0) {
        unsigned* bar = b.bar;
        __builtin_amdgcn_s_waitcnt(0);
        unsigned nloc = b.st[0], nx = b.st[1];
        if (nloc == 0u) { xcd_barrier_complete(bar, b.x, nloc, nx); b.st[0] = nloc; b.st[1] = nx; }
        const unsigned old = xb_add(&bar[XB_XSUB(b.x)], 1u);
        const unsigned gen = old / nloc;
        if (old + 1u == (gen + 1u) * nloc) {
            __builtin_amdgcn_fence(__ATOMIC_RELEASE, "agent");
            asm volatile("s_waitcnt vmcnt(0)" ::: "memory");
            const unsigned og = xb_add(&bar[XB_TOP], 1u);
            const unsigned tg = og / nx;
            if (og + 1u == (tg + 1u) * nx) xb_add(&bar[XB_TOPGEN], 1u);
            else XB_SPIN(xb_ld(&bar[XB_TOPGEN]) == tg, bar);
            __builtin_amdgcn_fence(__ATOMIC_ACQUIRE, "agent");
            xb_add(&bar[XB_XGEN(b.x)], 1u);
            asm volatile("s_waitcnt vmcnt(0)" ::: "memory");
        } else {
            XB_SPIN(xb_ld(&bar[XB_XGEN(b.x)]) == gen, bar);
            __builtin_amdgcn_fence(__ATOMIC_ACQUIRE, "agent");
            asm volatile("s_waitcnt vmcnt(0)" ::: "memory");
        }
    }
    __syncthreads();
}

struct Args { const float* in[21]; float* out; unsigned char* ws; int it_lo, it_hi, ph_lo, ph_hi; };
enum { I_X = 0, I_NMG, I_WIN, I_BG, I_CW, I_CB, I_GB, I_MNG, I_KVNG, I_WKV, I_SQG, I_SKG, I_DQG, I_DKG, I_LAM, I_DOG, I_WBR, I_WOUT, I_NFG, I_WGU, I_WD };

struct Frame {
    LAS unsigned char* lds;
    unsigned char* ws;
    int tid, lane, wave, G, bid;
    int wave0;
    DI void refresh() {
        int l_; asm volatile("v_mbcnt_lo_u32_b32 %0, -1, 0\n\tv_mbcnt_hi_u32_b32 %0, -1, %0" : "=v"(l_));
        unsigned char* w_ = ws; int g_ = G, b_ = bid, wv_ = wave0; asm volatile("" : "+s"(w_), "+s"(g_), "+s"(b_), "+s"(wv_));
        ws = w_; G = g_; bid = b_; lane = l_; wave = wv_; tid = wv_ * 64 + l_; }
};

DI int map_in(int n) {
    const int pn = n >> 8, p = n & 255, bj = p >> 7, wcq = p & 127, wc = wcq >> 5, q = wcq & 31;
    const int hd = 32 * bj + q;
    switch (pn) {
        case 0: case 1: case 2: case 3: return Z_MQK + n;
        case 4: case 5: return Z_MV + (n - 4 * 256);
        case 6: case 7: return Z_MO + (n - 6 * 256);
        case 8: case 9: return Z_SQ + (4 * (pn - 8) + wc) * 64 + hd;
        case 10: return Z_CKV + p;
        case 11: return Z_IQ + wc * 64 + hd;
        case 12: case 13: return Z_DQ + (4 * (pn - 12) + wc) * 64 + hd;
        case 14: case 15: return Z_DK + (4 * (pn - 14) + wc) * 64 + hd;
        case 16: case 17: return Z_DV + (n - 16 * 256);
        default:
            if (wc == 0) return Z_IK + hd;
            if (wc == 1 && bj == 0) { if (q < 8) return Z_MIF + q; if (q < 12) return Z_IW + (q - 8); }
            return -1;
    }
}
DI int map_kv(int n) {
    const int pn = n >> 8, p = n & 255, bj = p >> 7, wcq = p & 127, wc = wcq >> 5, q = wcq & 31;
    if (pn < 2) return (4 * pn + wc) * 64 + 32 * bj + q;
    return n;
}
DI int map_gu(int n) {
    const int pn = n >> 8, p = n & 255;
    return (p >> 7) * FF + 128 * pn + (p & 127);
}
template <int MAP>
DI void transpose_item(const float* W, int ldw, int cbase, const float* kscale, bf16_t* WT, int ldo, int koff, int nblk, LAS float* scr, int item, int lane) {
    const int kb = item / nblk, nb = item % nblk, k0 = 64 * kb, n0 = 32 * nb;
    const int n = n0 + (lane & 31);
    int src;
    if (MAP == 0) src = n; else if (MAP == 1) src = map_in(n); else if (MAP == 2) src = map_kv(n); else src = map_gu(n);
    float tv_[32];
    const int srcc = src >= 0 ? src : 0;
#pragma unroll
    for (int i = 0; i < 32; ++i) tv_[i] = W[(size_t)(k0 + 2 * i + (lane >> 5)) * ldw + cbase + srcc];
#pragma unroll
    for (int i = 0; i < 32; ++i) { const int kk = 2 * i + (lane >> 5);
        float v = src >= 0 ? tv_[i] : 0.f;
        if (kscale) v *= kscale[k0 + kk];
        scr[kk * 33 + (lane & 31)] = v; }
    WSYNC();
    const int c = lane & 7;
#pragma unroll
    for (int j = 0; j < 4; ++j) { const int nn = (lane >> 3) + 8 * j; const LAS float* s = scr + (8 * c) * 33 + nn;
        u32x4 o; o.x = pk2(s[0 * 33], s[1 * 33]); o.y = pk2(s[2 * 33], s[3 * 33]); o.z = pk2(s[4 * 33], s[5 * 33]); o.w = pk2(s[6 * 33], s[7 * 33]);
        *(u32x4*)(WT + (size_t)(n0 + nn) * ldo + koff + k0 + 8 * c) = o; }
    WSYNC();
}
__device__ const float INVF[32] = {1.000000000e+00f, 7.498942018e-01f, 5.623413324e-01f, 4.216965139e-01f, 3.162277639e-01f, 2.371373922e-01f, 1.778279394e-01f, 1.333521456e-01f,
    1.000000015e-01f, 7.498941571e-02f, 5.623412877e-02f, 4.216964915e-02f, 3.162277862e-02f, 2.371373586e-02f, 1.778279431e-02f, 1.333521493e-02f,
    9.999999776e-03f, 7.498942316e-03f, 5.623413250e-03f, 4.216964822e-03f, 3.162277862e-03f, 2.371373819e-03f, 1.778279431e-03f, 1.333521446e-03f,
    1.000000047e-03f, 7.498941850e-04f, 5.623413017e-04f, 4.216965463e-04f, 3.162277862e-04f, 2.371373848e-04f, 1.778279402e-04f, 1.333521504e-04f};
DI void sincos_acc(float angf, float& c, float& s) {
    const double x = (double)angf;
    const double kd = __builtin_rint(x * 0.63661977236758134308);
    const double r = (x - kd * 1.5707963267948965580) - kd * 6.1232339957367658860e-17;
    const double r2 = r * r;
    double sp = -1.0 / 39916800.0; sp = sp * r2 + 1.0 / 362880.0; sp = sp * r2 - 1.0 / 5040.0; sp = sp * r2 + 1.0 / 120.0; sp = sp * r2 - 1.0 / 6.0; sp = sp * r2 + 1.0; sp *= r;
    double cp = 1.0 / 479001600.0; cp = cp * r2 - 1.0 / 3628800.0; cp = cp * r2 + 1.0 / 40320.0; cp = cp * r2 - 1.0 / 720.0; cp = cp * r2 + 1.0 / 24.0; cp = cp * r2 - 0.5; cp = cp * r2 + 1.0;
    const int k = (int)kd & 3;
    double cc, ss;
    if (k == 0) { cc = cp; ss = sp; } else if (k == 1) { cc = -sp; ss = cp; } else if (k == 2) { cc = -cp; ss = -sp; } else { cc = sp; ss = -cp; }
    c = (float)cc; s = (float)ss;
}
DI void phase_prologue(Frame& F, const Args& a) {
    F.refresh();
    LAS float* scr = (LAS float*)(F.lds + F.wave * 16384);
    const int gw = F.bid * NWAVES + F.wave, NGW = F.G * NWAVES;
    float* COS = (float*)(F.ws + WS_COS); float* SIN = (float*)(F.ws + WS_SIN);
    for (int i = gw * 64 + F.lane; i < SEQ * 32; i += NGW * 64) { const int t = i >> 5, f = i & 31; float c, s; sincos_acc((float)t * INVF[f], c, s); COS[i] = c; SIN[i] = s; }
    if (gw == 0) { float* GN = (float*)(F.ws + WS_GAIN);
        for (int l = 0; l < DEPTH; ++l) { GN[(l * 4 + 0) * 64 + F.lane] = a.in[I_SQG][l * 64 + F.lane]; GN[(l * 4 + 1) * 64 + F.lane] = a.in[I_DQG][l * 64 + F.lane];
            GN[(l * 4 + 2) * 64 + F.lane] = a.in[I_DKG][l * 64 + F.lane]; GN[(l * 4 + 3) * 64 + F.lane] = a.in[I_SKG][l * 64 + F.lane]; } }
    for (int l = 0; l < DEPTH; ++l) {
        unsigned char* wl = F.ws + WS_W + (size_t)l * W_LAYER;
        const float* w_in = a.in[I_WIN] + (size_t)l * DM * IN_COLS;
        { const int nblk = NT_IN * 256 / 32, nit = (DM / 64) * nblk;
          for (int it = gw; it < nit; it += NGW) transpose_item<1>(w_in, IN_COLS, 0, nullptr, (bf16_t*)(wl + WO_IN), DM, 0, nblk, scr, it, F.lane); }
        { const int nblk = 3072 / 32, nit = (DM / 64) * nblk;
          for (int it = gw; it < nit; it += NGW) transpose_item<0>(w_in, IN_COLS, Z_G, nullptr, (bf16_t*)(wl + WO_G), DM, 0, nblk, scr, it, F.lane); }
        { const int nblk = 1024 / 32, nit = (256 / 64) * nblk;
          for (int it = gw; it < nit; it += NGW) transpose_item<2>(a.in[I_WKV] + (size_t)l * 256 * 1024, 1024, 0, a.in[I_KVNG] + l * 256, (bf16_t*)(wl + WO_KV), 256, 0, nblk, scr, it, F.lane); }
        for (int b = 0; b < 3; ++b) { const int nblk = 1024 / 32, nit = (512 / 64) * nblk;
          for (int it = gw; it < nit; it += NGW) transpose_item<0>(a.in[I_WBR] + ((size_t)l * 3 + b) * 512 * 1024, 1024, 0, nullptr, (bf16_t*)(wl + WO_BR), 1536, b * 512, nblk, scr, it, F.lane); }
        { const int nblk = 1024 / 32, nit = (1024 / 64) * nblk;
          for (int it = gw; it < nit; it += NGW) transpose_item<0>(a.in[I_WOUT] + (size_t)l * 1024 * 1024, 1024, 0, nullptr, (bf16_t*)(wl + WO_OUT), 1024, 0, nblk, scr, it, F.lane); }
        { const int nblk = 5632 / 32, nit = (1024 / 64) * nblk;
          for (int it = gw; it < nit; it += NGW) transpose_item<3>(a.in[I_WGU] + (size_t)l * 1024 * 5632, 5632, 0, nullptr, (bf16_t*)(wl + WO_GU), 1024, 0, nblk, scr, it, F.lane); }
        { const int nblk = 1024 / 32, nit = (2816 / 64) * nblk;
          for (int it = gw; it < nit; it += NGW) transpose_item<0>(a.in[I_WD] + (size_t)l * 2816 * 1024, 1024, 0, nullptr, (bf16_t*)(wl + WO_D), 2816, 0, nblk, scr, it, F.lane); }
    }
}

DI void phase_rmsnorm(Frame& F, const void* xv, const bool src16, const float* gain, bf16_t* out) {
    F.refresh();
    const int gw = F.bid * NWAVES + F.wave, NGW = F.G * NWAVES;
    f32x4 gv[4];
#pragma unroll
    for (int j = 0; j < 4; ++j) gv[j] = *(const f32x4*)(gain + 4 * F.lane + 256 * j);
    for (int m = gw; m < MC; m += NGW) {
        f32x4 v[4]; float s = 0.f;
        if (src16) { const GAS u32x2* xr = (const GAS u32x2*)((const bf16_t*)xv + (size_t)m * DM) + F.lane;
#pragma unroll
            for (int j = 0; j < 4; ++j) { const u32x2 w = xr[64 * j]; v[j] = (f32x4){bflo(w.x), bfhi(w.x), bflo(w.y), bfhi(w.y)}; }
        } else { const GAS f32x4* xr = (const GAS f32x4*)((const float*)xv + (size_t)m * DM) + F.lane;
#pragma unroll
            for (int j = 0; j < 4; ++j) v[j] = xr[64 * j]; }
#pragma unroll
        for (int j = 0; j < 4; ++j) s += (v[j].x * v[j].x + v[j].y * v[j].y) + (v[j].z * v[j].z + v[j].w * v[j].w);
        const float r = 1.0f / sqrtf(wave_sum(s) * (1.f / DM) + EPS);
        u32x2* o8 = (u32x2*)(out + (size_t)m * DM) + F.lane;
#pragma unroll
        for (int j = 0; j < 4; ++j) { u32x2 w; w.x = cvtpk_(v[j].x * r * gv[j].x, v[j].y * r * gv[j].y); w.y = cvtpk_(v[j].z * r * gv[j].z, v[j].w * r * gv[j].w); o8[64 * j] = w; }
    }
}
DI float log_sigmoid(float x) {
    const float ax = fabsf(x), y = fexp(-ax);
    float l1p;
    if (y < 0.06f) l1p = y * (1.f - y * (0.5f - y * (0.33333333f - y * (0.25f - y * 0.2f))));
    else l1p = __builtin_amdgcn_logf(1.f + y) * 0.69314718056f;
    return fminf(x, 0.f) - l1p;
}
DI void phase_token(Frame& F, const Args& a, int l, const int probe) {
    F.refresh();
    const int gw0 = F.bid * NWAVES + F.wave, NGW = F.G * NWAVES, NSC = CB * 4, NCV = NGW - NSC;
    const bool scanw = (F.wave == NWAVES - 1) && (F.bid < NSC);
    const int gw = scanw ? NCV : gw0 - ((gw0 >> 3) < NSC ? (gw0 >> 3) : NSC);
    if (!scanw) { if (probe != 2) {
    const bf16_t* QKRAW = (const bf16_t*)(F.ws + WS_QKRAW); bf16_t* QK = (bf16_t*)(F.ws + WS_QK);
    const bf16_t* CKV = (const bf16_t*)(F.ws + WS_CKV); float* RT = (float*)(F.ws + WS_RT);
    const float* cw = a.in[I_CW] + (size_t)l * 4 * 1024; const float* cb = a.in[I_CB] + (size_t)l * 1024;
    const int c0 = F.lane * 16;
    float w[4][16], bs[16];
#pragma unroll
    for (int j = 0; j < 4; ++j)
#pragma unroll
        for (int i = 0; i < 16; ++i) w[j][i] = cw[j * 1024 + c0 + i];
#pragma unroll
    for (int i = 0; i < 16; ++i) bs[i] = cb[c0 + i];
    const float ksc = (c0 >= 512) ? 0.08838834764831845f : 1.0f;
    for (int m = gw; m < MC; m += NCV) {
        const int t = m & (SEQ - 1);
        float accv[16];
#pragma unroll
        for (int i = 0; i < 16; ++i) accv[i] = bs[i];
        u32x4 tv[4][2];
#pragma unroll
        for (int j = 0; j < 4; ++j) { const int tt = t - 3 + j; const u32x4* p = (const u32x4*)(QKRAW + (size_t)(tt >= 0 ? m - 3 + j : m) * 1024 + c0); tv[j][0] = p[0]; tv[j][1] = p[1]; }
        const u32x2 ckv4 = *(const u32x2*)(CKV + (size_t)m * 256 + 4 * F.lane);
#pragma unroll
        for (int j = 0; j < 4; ++j) { const float on = (t - 3 + j >= 0) ? 1.f : 0.f;
            const unsigned ww[8] = {tv[j][0].x, tv[j][0].y, tv[j][0].z, tv[j][0].w, tv[j][1].x, tv[j][1].y, tv[j][1].z, tv[j][1].w};
#pragma unroll
            for (int i = 0; i < 8; ++i) { accv[2 * i] += on * w[j][2 * i] * bflo(ww[i]); accv[2 * i + 1] += on * w[j][2 * i + 1] * bfhi(ww[i]); } }
        unsigned o[8];
#pragma unroll
        for (int i = 0; i < 8; ++i) { const float x0 = accv[2 * i], x1 = accv[2 * i + 1]; o[i] = pk2(x0 * sigmoidf_(x0) * ksc, x1 * sigmoidf_(x1) * ksc); }
        u32x4* q = (u32x4*)(QK + (size_t)m * 1024 + c0); q[0] = (u32x4){o[0], o[1], o[2], o[3]}; q[1] = (u32x4){o[4], o[5], o[6], o[7]};
        { const u32x2 v = ckv4; const float a0 = bflo(v.x), a1 = bfhi(v.x), a2 = bflo(v.y), a3 = bfhi(v.y);
          const float ss = wave_sum((a0 * a0 + a1 * a1) + (a2 * a2 + a3 * a3)); if (F.lane == 0) RT[m] = 1.0f / sqrtf(ss * (1.f / 256.f) + EPS); }
    }
    } } else if (probe != 1) {
        const int sq = F.bid, b = sq >> 2, h = sq & 3, lane = F.lane; const float* IFb = (const float*)(F.ws + WS_IF) + (size_t)b * SEQ * 8;
        float* AK = (float*)(F.ws + WS_AK) + (size_t)sq * SEQ; float* MQ = (float*)(F.ws + WS_MQ) + (size_t)sq * SEQ; float* EM = (float*)(F.ws + WS_EM) + (size_t)sq * SEQ;
        LAS float* X0 = (LAS float*)F.lds; LAS float* X1 = X0 + 4160; LAS float* X2 = X1 + 4160;
#pragma unroll 1
        for (int c = 0; c < 4; ++c) { float fv[16], iv[16];
#pragma unroll
            for (int kk = 0; kk < 16; ++kk) { const size_t t = (size_t)64 * (16 * c + kk) + lane; fv[kk] = *(const GAS float*)(IFb + t * 8 + 4 + h); iv[kk] = *(const GAS float*)(IFb + t * 8 + h); }
#pragma unroll
            for (int kk = 0; kk < 16; ++kk) { const int t = 64 * (16 * c + kk) + lane; X0[t + (t >> 6)] = fv[kk]; X1[t + (t >> 6)] = iv[kk]; } }
        WSYNC();
        const int tb = 65 * lane;
        double sum = 0.0;
#pragma unroll 8
        for (int j = 0; j < 64; ++j) { const float lf = log_sigmoid(X0[tb + j]); X0[tb + j] = lf; sum += (double)lf; }
        double inc = sum;
#pragma unroll
        for (int o = 1; o < 64; o <<= 1) { const double y = shup_d(inc, o, lane); if (lane >= o) inc += y; }
        double bb = inc - sum; float mx = -INFINITY;
#pragma unroll 8
        for (int j = 0; j < 64; ++j) { bb += (double)X0[tb + j]; const float av = (float)((double)X1[tb + j] - bb); X1[tb + j] = av; X0[tb + j] = (float)bb; mx = fmaxf(mx, av); }
        float minc = mx;
#pragma unroll
        for (int o = 1; o < 64; o <<= 1) { const float y = shup_f(minc, o, lane); if (lane >= o) minc = fmaxf(minc, y); }
        float mrun = shup_f(minc, 1, lane); if (lane == 0) mrun = -INFINITY;
#pragma unroll 8
        for (int j = 0; j < 64; ++j) { mrun = fmaxf(mrun, X1[tb + j]); X2[tb + j] = mrun; X0[tb + j] = fexp(-(X0[tb + j] + mrun)); }
        WSYNC();
#pragma unroll 8
        for (int k = 0; k < 64; ++k) { const int t = 64 * k + lane, ix = t + k; AK[t] = X1[ix]; MQ[t] = X2[ix]; EM[t] = X0[ix]; }
    }
}

DI void store8(bf16_t* p, f32x4 v0, f32x4 v1) { u32x4 w; w.x = cvtpk_(v0[0], v0[1]); w.y = cvtpk_(v0[2], v0[3]); w.z = cvtpk_(v1[0], v1[1]); w.w = cvtpk_(v1[2], v1[3]); *(u32x4*)p = w; }
DI void head_norm_rope(f32x4 (&x)[2][2], bool norm, const f32x4 (&gn)[2][2], const float* cosr, const float* sinr, int fq, float scale) {
    if (norm) {
        float ss = 0.f;
#pragma unroll
        for (int bj = 0; bj < 2; ++bj)
#pragma unroll
            for (int n = 0; n < 2; ++n) ss += (x[bj][n][0] * x[bj][n][0] + x[bj][n][1] * x[bj][n][1]) + (x[bj][n][2] * x[bj][n][2] + x[bj][n][3] * x[bj][n][3]);
        ss = sum16x(ss); ss = sum32x(ss);
        const float r = 1.0f / sqrtf(ss * (1.f / 64.f) + EPS);
#pragma unroll
        for (int bj = 0; bj < 2; ++bj)
#pragma unroll
            for (int n = 0; n < 2; ++n) x[bj][n] = x[bj][n] * r * gn[bj][n];
    }
#pragma unroll
    for (int n = 0; n < 2; ++n) { const f32x4 c = *(const f32x4*)(cosr + 8 * fq + 4 * n), s = *(const f32x4*)(sinr + 8 * fq + 4 * n);
        const f32x4 x1 = x[0][n], x2 = x[1][n]; x[0][n] = (x1 * c - x2 * s) * scale; x[1][n] = (x1 * s + x2 * c) * scale; }
}
DI void head_norm_rope_cs(f32x4 (&x)[2][2], bool norm, const f32x4 (&gn)[2][2], const f32x4 (&c)[2], const f32x4 (&sn)[2], float scale) {
    if (norm) {
        float ss = 0.f;
#pragma unroll
        for (int bj = 0; bj < 2; ++bj)
#pragma unroll
            for (int n = 0; n < 2; ++n) ss += (x[bj][n][0] * x[bj][n][0] + x[bj][n][1] * x[bj][n][1]) + (x[bj][n][2] * x[bj][n][2] + x[bj][n][3] * x[bj][n][3]);
        ss = sum16x(ss); ss = sum32x(ss);
        const float r = 1.0f / sqrtf(ss * (1.f / 64.f) + EPS);
#pragma unroll
        for (int bj = 0; bj < 2; ++bj)
#pragma unroll
            for (int n = 0; n < 2; ++n) x[bj][n] = x[bj][n] * r * gn[bj][n];
    }
#pragma unroll
    for (int n = 0; n < 2; ++n) { const f32x4 x1 = x[0][n], x2 = x[1][n]; x[0][n] = (x1 * c[n] - x2 * sn[n]) * scale; x[1][n] = (x1 * sn[n] + x2 * c[n]) * scale; }
}
struct EpiInProj {
    static constexpr bool PERM = true, MIDK = false, INIT = false;
    unsigned char* ws; const float* gate_b; int layer;
    DI void operator()(const f32x4 (&acc)[2][2][4][2], const pg8::Unit& u, int wr, int wc, int fr, int fq) const {
        const int pn = u.pn; const int rowb = u.pm * 256 + wr * 64 + fr;
        if (pn < 8 || pn == 10 || pn == 16 || pn == 17) {
            size_t doff; int ldc, cb; bool sg = false;
            if (pn < 4) { doff = WS_QKRAW; ldc = 1024; cb = pn * 256; }
            else if (pn < 6) { doff = WS_VM; ldc = 512; cb = (pn - 4) * 256; }
            else if (pn < 8) { doff = WS_OM; ldc = 512; cb = (pn - 6) * 256; sg = true; }
            else if (pn == 10) { doff = WS_CKV; ldc = 256; cb = 0; }
            else { doff = WS_DV; ldc = 512; cb = (pn - 16) * 256; }
            bf16_t* dst = (bf16_t*)(ws + doff);
#pragma unroll
            for (int ai = 0; ai < 2; ++ai)
#pragma unroll
                for (int m = 0; m < 4; ++m) { bf16_t* rowp = dst + (size_t)(rowb + ai * 128 + m * 16) * ldc + cb + wc * 32 + 8 * fq;
#pragma unroll
                    for (int bj = 0; bj < 2; ++bj) { f32x4 v0 = acc[ai][bj][m][0], v1 = acc[ai][bj][m][1];
                        if (sg) {
#pragma unroll
                            for (int j = 0; j < 4; ++j) { v0[j] = sigmoidf_(v0[j]); v1[j] = sigmoidf_(v1[j]); } }
                        store8(rowp + bj * 128, v0, v1); } }
        } else if (pn == 18) {
            const float* COS = (const float*)(ws + WS_COS); const float* SIN = (const float*)(ws + WS_SIN);
            if (wc == 0) {
                bf16_t* dst = (bf16_t*)(ws + WS_IK); f32x4 gn[2][2];
#pragma unroll
                for (int bj = 0; bj < 2; ++bj)
#pragma unroll
                    for (int n = 0; n < 2; ++n) gn[bj][n] = (f32x4){1.f, 1.f, 1.f, 1.f};
#pragma unroll
                for (int ai = 0; ai < 2; ++ai)
#pragma unroll
                    for (int m = 0; m < 4; ++m) { const int row = rowb + ai * 128 + m * 16, t = row & (SEQ - 1);
                        f32x4 x[2][2] = {{acc[ai][0][m][0], acc[ai][0][m][1]}, {acc[ai][1][m][0], acc[ai][1][m][1]}};
                        head_norm_rope(x, false, gn, COS + t * 32, SIN + t * 32, fq, 1.0f);
#pragma unroll
                        for (int bj = 0; bj < 2; ++bj) store8(dst + (size_t)row * 64 + 32 * bj + 8 * fq, x[bj][0], x[bj][1]);
                        asm volatile("" ::: "memory"); }
            } else if (wc == 1) {
                float* IFp = (float*)(ws + WS_IF); float* IWp = (float*)(ws + WS_IW);
#pragma unroll
                for (int ai = 0; ai < 2; ++ai)
#pragma unroll
                    for (int m = 0; m < 4; ++m) { const int row = rowb + ai * 128 + m * 16;
                        if (fq == 0) { *(f32x4*)(IFp + (size_t)row * 8) = acc[ai][0][m][0] + *(const f32x4*)gate_b; *(f32x4*)(IFp + (size_t)row * 8 + 4) = acc[ai][0][m][1] + *(const f32x4*)(gate_b + 4); }
                        else if (fq == 1) { *(f32x4*)(IWp + (size_t)row * 4) = acc[ai][0][m][0] * 0.0625f; } }
            }
        } else {
            const float* COS = (const float*)(ws + WS_COS); const float* SIN = (const float*)(ws + WS_SIN);
            size_t doff; int gi, pn0; float scale; bool norm = true; int ldc = 512;
            if (pn < 10) { doff = WS_SQ; gi = 0; pn0 = 8; scale = C2; }
            else if (pn == 11) { doff = WS_IQ; gi = 0; pn0 = 11; scale = 1.f; norm = false; ldc = 256; }
            else if (pn < 14) { doff = WS_DQ; gi = 1; pn0 = 12; scale = C2; }
            else { doff = WS_DK; gi = 2; pn0 = 14; scale = 1.f; }
            bf16_t* dst = (bf16_t*)(ws + doff); const float* g = (const float*)(ws + WS_GAIN) + (layer * 4 + gi) * 64;
            f32x4 gn[2][2];
#pragma unroll
            for (int bj = 0; bj < 2; ++bj)
#pragma unroll
                for (int n = 0; n < 2; ++n) gn[bj][n] = *(const f32x4*)(g + 32 * bj + 8 * fq + 4 * n);
            const int head = 4 * (pn - pn0) + wc;
#pragma unroll
            for (int ai = 0; ai < 2; ++ai)
#pragma unroll
              for (int mp = 0; mp < 4; mp += 2) {
                f32x4 cc[2][2], sn[2][2];
#pragma unroll
                for (int m = 0; m < 2; ++m) { const int t = (rowb + ai * 128 + (mp + m) * 16) & (SEQ - 1);
#pragma unroll
                    for (int n = 0; n < 2; ++n) { cc[m][n] = *(const GAS f32x4*)(COS + t * 32 + 8 * fq + 4 * n); sn[m][n] = *(const GAS f32x4*)(SIN + t * 32 + 8 * fq + 4 * n); } }
#pragma unroll
                for (int m = 0; m < 2; ++m) { const int row = rowb + ai * 128 + (mp + m) * 16;
                    f32x4 x[2][2] = {{acc[ai][0][mp + m][0], acc[ai][0][mp + m][1]}, {acc[ai][1][mp + m][0], acc[ai][1][mp + m][1]}};
                    head_norm_rope_cs(x, norm, gn, cc[m], sn[m], scale);
#pragma unroll
                    for (int bj = 0; bj < 2; ++bj) store8(dst + (size_t)row * ldc + head * 64 + 32 * bj + 8 * fq, x[bj][0], x[bj][1]); }
                asm volatile("" ::: "memory");
              }
        }
    }
};
struct EpiKV {
    static constexpr bool PERM = true, MIDK = false, INIT = false;
    unsigned char* ws; int layer;
    DI void operator()(const f32x4 (&acc)[2][2][4][2], const pg8::Unit& u, int wr, int wc, int fr, int fq) const {
        const int pn = u.pn; const int rowb = u.pm * 256 + wr * 64 + fr; const float* RT = (const float*)(ws + WS_RT);
        if (pn >= 2) {
            bf16_t* dst = (bf16_t*)(ws + WS_SV);
#pragma unroll
            for (int ai = 0; ai < 2; ++ai)
#pragma unroll
                for (int m = 0; m < 4; ++m) { const int row = rowb + ai * 128 + m * 16; const float r = RT[row]; bf16_t* rowp = dst + (size_t)row * 512 + (pn - 2) * 256 + wc * 32 + 8 * fq;
#pragma unroll
                    for (int bj = 0; bj < 2; ++bj) store8(rowp + bj * 128, acc[ai][bj][m][0] * r, acc[ai][bj][m][1] * r); }
        } else {
            const float* COS = (const float*)(ws + WS_COS); const float* SIN = (const float*)(ws + WS_SIN);
            bf16_t* dst = (bf16_t*)(ws + WS_SK); f32x4 gn[2][2];
#pragma unroll
            for (int bj = 0; bj < 2; ++bj)
#pragma unroll
                for (int n = 0; n < 2; ++n) gn[bj][n] = *(const f32x4*)((const float*)(ws + WS_GAIN) + (layer * 4 + 3) * 64 + 32 * bj + 8 * fq + 4 * n);
            const int head = 4 * pn + wc;
#pragma unroll
            for (int ai = 0; ai < 2; ++ai)
#pragma unroll
              for (int mp = 0; mp < 4; mp += 2) {
                f32x4 cc[2][2], sn[2][2]; float rr[2];
#pragma unroll
                for (int m = 0; m < 2; ++m) { const int row = rowb + ai * 128 + (mp + m) * 16, t = row & (SEQ - 1); rr[m] = *(const GAS float*)(RT + row);
#pragma unroll
                    for (int n = 0; n < 2; ++n) { cc[m][n] = *(const GAS f32x4*)(COS + t * 32 + 8 * fq + 4 * n); sn[m][n] = *(const GAS f32x4*)(SIN + t * 32 + 8 * fq + 4 * n); } }
#pragma unroll
                for (int m = 0; m < 2; ++m) { const int row = rowb + ai * 128 + (mp + m) * 16; const float r = rr[m];
                    f32x4 x[2][2] = {{acc[ai][0][mp + m][0] * r, acc[ai][0][mp + m][1] * r}, {acc[ai][1][mp + m][0] * r, acc[ai][1][mp + m][1] * r}};
                    head_norm_rope_cs(x, true, gn, cc[m], sn[m], 1.0f);
#pragma unroll
                    for (int bj = 0; bj < 2; ++bj) store8(dst + (size_t)row * 512 + head * 64 + 32 * bj + 8 * fq, x[bj][0], x[bj][1]); }
                asm volatile("" ::: "memory");
              }
        }
    }
};
DI size_t gq_off(int pm, int png, int wave, int am, int lane) { return ((((size_t)pm * 12 + png) * 8 + wave) * 8 + am) * 1024 + (size_t)lane * 16; }
struct EpiGate {
    static constexpr bool PERM = true, MIDK = false, INIT = false;
    unsigned char* G; const float* bias;
    DI void operator()(const f32x4 (&acc)[2][2][4][2], const pg8::Unit& u, int wr, int wc, int fr, int fq) const {
        const int col0 = u.pn * 256 + wc * 32 + 8 * fq, wave = wr * 4 + wc, lane = fq * 16 + fr;
        f32x4 bv[2][2];
#pragma unroll
        for (int bj = 0; bj < 2; ++bj)
#pragma unroll
            for (int n = 0; n < 2; ++n) bv[bj][n] = *(const f32x4*)(bias + col0 + bj * 128 + 4 * n);
#pragma unroll
        for (int ai = 0; ai < 2; ++ai)
#pragma unroll
            for (int m = 0; m < 4; ++m) { unsigned w[4];
#pragma unroll
                for (int bj = 0; bj < 2; ++bj)
#pragma unroll
                    for (int n = 0; n < 2; ++n) { const f32x4 v = acc[ai][bj][m][n] + bv[bj][n]; unsigned q = 0u;
#pragma unroll
                        for (int j = 0; j < 4; ++j) q = __builtin_amdgcn_cvt_pk_u8_f32(sigmoidf_(v[j]) * 255.0f, j, q);
                        w[2 * bj + n] = q; }
                *(u32x4*)(G + gq_off(u.pm, u.pn, wave, ai * 4 + m, lane)) = (u32x4){w[0], w[1], w[2], w[3]}; }
    }
};
struct EpiMerge {
    static constexpr bool PERM = true, MIDK = true, INIT = false;
    const unsigned char* G; bf16_t* MG;
    DI static float ub(unsigned w, int k) { return (float)((w >> (8 * k)) & 0xFFu); }
    DI void mid(f32x4 (&acc)[2][2][4][2], const pg8::Unit& u, int t, int wr, int wc, int fr, int fq) const {
        const int seg = (t >> 3) - 1, wave = wr * 4 + wc, lane = fq * 16 + fr;
#pragma unroll
        for (int ai = 0; ai < 2; ++ai) {
            u32x4 ga[4], gb[4];
#pragma unroll
            for (int m = 0; m < 4; ++m) { ga[m] = *(const GAS u32x4*)(G + gq_off(u.pm, seg * 4 + u.pn, wave, ai * 4 + m, lane)); gb[m] = *(const GAS u32x4*)(G + gq_off(u.pm, (seg + 1) * 4 + u.pn, wave, ai * 4 + m, lane)); }
#pragma unroll
            for (int m = 0; m < 4; ++m) { const unsigned aw[4] = {ga[m].x, ga[m].y, ga[m].z, ga[m].w}, bw[4] = {gb[m].x, gb[m].y, gb[m].z, gb[m].w};
#pragma unroll
                for (int bj = 0; bj < 2; ++bj)
#pragma unroll
                    for (int n = 0; n < 2; ++n)
#pragma unroll
                        for (int j = 0; j < 4; ++j) acc[ai][bj][m][n][j] *= fmaxf(ub(aw[2 * bj + n], j), 1e-6f) * frcp(fmaxf(ub(bw[2 * bj + n], j), 1e-6f)); }
            asm volatile("" ::: "memory");
        }
    }
    DI void operator()(const f32x4 (&acc)[2][2][4][2], const pg8::Unit& u, int wr, int wc, int fr, int fq) const {
        const int rowb = u.pm * 256 + wr * 64 + fr, col0 = u.pn * 256 + wc * 32 + 8 * fq, wave = wr * 4 + wc, lane = fq * 16 + fr;
#pragma unroll
        for (int ai = 0; ai < 2; ++ai) {
            u32x4 gc[4];
#pragma unroll
            for (int m = 0; m < 4; ++m) gc[m] = *(const GAS u32x4*)(G + gq_off(u.pm, 8 + u.pn, wave, ai * 4 + m, lane));
#pragma unroll
            for (int m = 0; m < 4; ++m) { const unsigned cw[4] = {gc[m].x, gc[m].y, gc[m].z, gc[m].w};
#pragma unroll
                for (int bj = 0; bj < 2; ++bj) { f32x4 v0 = acc[ai][bj][m][0], v1 = acc[ai][bj][m][1];
#pragma unroll
                    for (int j = 0; j < 4; ++j) { v0[j] *= fmaxf(ub(cw[2 * bj], j), 1e-6f) * (1.0f / 255.0f); v1[j] *= fmaxf(ub(cw[2 * bj + 1], j), 1e-6f) * (1.0f / 255.0f); }
                    store8(MG + (size_t)(rowb + ai * 128 + m * 16) * 1024 + col0 + bj * 128, v0, v1); } }
            asm volatile("" ::: "memory");
        }
    }
};
struct EpiResid {
    static constexpr bool PERM = true, MIDK = false, INIT = true;
    const void* base; void* out; bool in16, out16;
    DI void init(f32x4 (&acc)[2][2][4][2], const pg8::Unit& u, int wr, int wc, int fr, int fq) const {
        const int rowb = u.pm * 256 + wr * 64 + fr, col0 = u.pn * 256 + wc * 32 + 8 * fq;
#pragma unroll
        for (int ai = 0; ai < 2; ++ai)
#pragma unroll
            for (int m = 0; m < 4; ++m) { const size_t off = (size_t)(rowb + ai * 128 + m * 16) * DM + col0;
#pragma unroll
                for (int bj = 0; bj < 2; ++bj) {
                    if (in16) { const u32x4 w = *(const GAS u32x4*)((const bf16_t*)base + off + bj * 128);
                        acc[ai][bj][m][0] = (f32x4){bflo(w.x), bfhi(w.x), bflo(w.y), bfhi(w.y)}; acc[ai][bj][m][1] = (f32x4){bflo(w.z), bfhi(w.z), bflo(w.w), bfhi(w.w)}; }
                    else { acc[ai][bj][m][0] = *(const GAS f32x4*)((const float*)base + off + bj * 128); acc[ai][bj][m][1] = *(const GAS f32x4*)((const float*)base + off + bj * 128 + 4); } } }
    }
    DI void operator()(const f32x4 (&acc)[2][2][4][2], const pg8::Unit& u, int wr, int wc, int fr, int fq) const {
        const int rowb = u.pm * 256 + wr * 64 + fr, col0 = u.pn * 256 + wc * 32 + 8 * fq;
#pragma unroll
        for (int ai = 0; ai < 2; ++ai)
#pragma unroll
            for (int m = 0; m < 4; ++m) { const size_t off = (size_t)(rowb + ai * 128 + m * 16) * DM + col0;
#pragma unroll
                for (int bj = 0; bj < 2; ++bj) {
                    if (out16) store8((bf16_t*)out + off + bj * 128, acc[ai][bj][m][0], acc[ai][bj][m][1]);
                    else { *(f32x4*)((float*)out + off + bj * 128) = acc[ai][bj][m][0]; *(f32x4*)((float*)out + off + bj * 128 + 4) = acc[ai][bj][m][1]; } } }
    }
};
struct EpiSwiGLU {
    static constexpr bool PERM = true, MIDK = false, INIT = false;
    bf16_t* H;
    DI void operator()(const f32x4 (&acc)[2][2][4][2], const pg8::Unit& u, int wr, int wc, int fr, int fq) const {
        const int rowb = u.pm * 256 + wr * 64 + fr, col0 = u.pn * 128 + wc * 32 + 8 * fq;
#pragma unroll
        for (int ai = 0; ai < 2; ++ai)
#pragma unroll
            for (int m = 0; m < 4; ++m) { f32x4 v0, v1;
#pragma unroll
                for (int j = 0; j < 4; ++j) { const float g0 = acc[ai][0][m][0][j], g1 = acc[ai][0][m][1][j]; v0[j] = g0 * sigmoidf_(g0) * acc[ai][1][m][0][j]; v1[j] = g1 * sigmoidf_(g1) * acc[ai][1][m][1][j]; }
                store8(H + (size_t)(rowb + ai * 128 + m * 16) * FF + col0, v0, v1); }
    }
};

DI unsigned mono_key(float f) { const unsigned u = __float_as_uint(f + 0.0f); return u ^ ((unsigned)((int)u >> 31) | 0x80000000u); }
DI unsigned pack_mask(unsigned long long bm, int h) {
    unsigned r = 0;
#pragma unroll
    for (int p = 0; p < 2; ++p)
#pragma unroll
        for (int g = 0; g < 4; ++g) r |= (unsigned)((bm >> (32 * p + 8 * g + 4 * h)) & 0xFull) << (16 * p + 4 * g);
    return r;
}
DI unsigned long long unpack_mask(unsigned w0, unsigned w1) {
    unsigned long long bm = 0;
#pragma unroll
    for (int p = 0; p < 2; ++p)
#pragma unroll
        for (int g = 0; g < 4; ++g) { bm |= (unsigned long long)((w0 >> (16 * p + 4 * g)) & 0xFu) << (32 * p + 8 * g); bm |= (unsigned long long)((w1 >> (16 * p + 4 * g)) & 0xFu) << (32 * p + 8 * g + 4); }
    return bm;
}
DI void ld8f(const bf16_t* p, float (&g)[8]) { const u32x4 w = *(const u32x4*)p; g[0] = bflo(w.x); g[1] = bfhi(w.x); g[2] = bflo(w.y); g[3] = bfhi(w.y); g[4] = bflo(w.z); g[5] = bfhi(w.z); g[6] = bflo(w.w); g[7] = bfhi(w.w); }

DI void naive_select(Frame& F) {
    F.refresh();
    if (F.wave >= 4) return;
    const int gw = F.bid * 4 + F.wave, NGW = F.G * 4;
    LAS unsigned char* wl = F.lds + F.wave * 20480;
    LAS float* sc = (LAS float*)wl; LAS float* iqf = (LAS float*)(wl + 16384); LAS unsigned* hist = (LAS unsigned*)(wl + 16384 + 1024);
    const bf16_t* IQ = (const bf16_t*)(F.ws + WS_IQ); const bf16_t* IK = (const bf16_t*)(F.ws + WS_IK); const float* IW = (const float*)(F.ws + WS_IW);
    unsigned* MASK = (unsigned*)(F.ws + WS_MASK);
    const int lane = F.lane;
    for (int row = gw; row < MC; row += NGW) {
        const int b = row >> 12, t = row & (SEQ - 1), n = t + 1;
        { const u32x2 v = *(const u32x2*)(IQ + (size_t)row * 256 + 4 * lane); iqf[4 * lane] = bflo(v.x); iqf[4 * lane + 1] = bfhi(v.x); iqf[4 * lane + 2] = bflo(v.y); iqf[4 * lane + 3] = bfhi(v.y); }
        const f32x4 wv = *(const f32x4*)(IW + (size_t)row * 4);
        WSYNC();
        for (int s = lane; s < n; s += 64) {
            const bf16_t* kr = IK + ((size_t)b * SEQ + s) * 64;
            float d0 = 0.f, d1 = 0.f, d2 = 0.f, d3 = 0.f;
#pragma unroll
            for (int c = 0; c < 8; ++c) { float kv[8]; ld8f(kr + 8 * c, kv);
#pragma unroll
                for (int j = 0; j < 8; ++j) { const float k = kv[j]; d0 += iqf[8 * c + j] * k; d1 += iqf[64 + 8 * c + j] * k; d2 += iqf[128 + 8 * c + j] * k; d3 += iqf[192 + 8 * c + j] * k; } }
            sc[s] = wv[0] * fmaxf(d0, 0.f) + wv[1] * fmaxf(d1, 0.f) + wv[2] * fmaxf(d2, 0.f) + wv[3] * fmaxf(d3, 0.f);
        }
        WSYNC();
        unsigned thr = 0u; int need = 256;
        if (n > 256) {
            unsigned prefix = 0u, pmask = 0u;
            for (int pass = 0; pass < 4; ++pass) {
                const int shift = 24 - 8 * pass;
                { unsigned z_ = 0u; asm volatile("" : "+v"(z_)); hist[lane] = z_; hist[lane + 64] = z_; hist[lane + 128] = z_; hist[lane + 192] = z_; }
                WSYNC();
                for (int s = lane; s < n; s += 64) { const unsigned key = mono_key(sc[s]); if ((key & pmask) == prefix) __hip_atomic_fetch_add(&hist[(key >> shift) & 255u], 1u, __ATOMIC_RELAXED, __HIP_MEMORY_SCOPE_WORKGROUP); }
                WSYNC();
                const unsigned c0 = hist[4 * lane], c1 = hist[4 * lane + 1], c2 = hist[4 * lane + 2], c3 = hist[4 * lane + 3];
                const unsigned ls = c0 + c1 + c2 + c3; unsigned inc = ls;
#pragma unroll
                for (int o = 1; o < 64; o <<= 1) { const unsigned y = __shfl_up(inc, o); if (lane >= o) inc += y; }
                const unsigned total = __shfl(inc, 63);
                unsigned cum = total - inc;
                int fbin = -1; unsigned fneed = 0u;
                const unsigned cc[4] = {c0, c1, c2, c3};
#pragma unroll
                for (int bq = 3; bq >= 0; --bq) { if (fbin < 0 && cum < (unsigned)need && cum + cc[bq] >= (unsigned)need) { fbin = 4 * lane + bq; fneed = (unsigned)need - cum; } cum += cc[bq]; }
                const unsigned long long fm = __ballot(fbin >= 0);
                const int src = __ffsll((long long)fm) - 1;
                const int bin = __shfl(fbin, src); need = (int)__shfl(fneed, src);
                prefix |= (unsigned)bin << shift; pmask |= 0xFFu << shift;
                WSYNC();
            }
            thr = prefix;
        }
        int eqc = 0;
        for (int i = 0; i < 64; ++i) {
            const int s = 64 * i + lane; bool sel = false;
            if (64 * i < n) {
                const bool valid = s < n;
                if (n <= 256) sel = valid;
                else { const unsigned key = valid ? mono_key(sc[s]) : 0u; const bool eq = valid && key == thr; const unsigned long long em = __ballot(eq);
                    const int rank = eqc + __popcll(em & ((1ull << lane) - 1ull)); sel = valid && (key > thr || (eq && rank < need)); eqc += __popcll(em); }
            }
            const unsigned long long bm = __ballot(sel);
            if (lane == 0) { MASK[((size_t)row * 2 + 0) * 64 + i] = pack_mask(bm, 0); MASK[((size_t)row * 2 + 1) * 64 + i] = pack_mask(bm, 1); }
        }
        WSYNC();
    }
}
DI void naive_dsa(Frame& F) {
    F.refresh();
    if (F.wave >= 4) return;
    const int gw = F.bid * 4 + F.wave, NGW = F.G * 4;
    LAS unsigned char* wl = F.lds + F.wave * 20480;
    LAS float* sc = (LAS float*)wl;
    LAS float* sqf = (LAS float*)(wl + 8192);
    LAS unsigned* list = (LAS unsigned*)(wl + 8192 + 2048);
    LAS float* invs = (LAS float*)(wl + 8192 + 2048 + 2048);
    const bf16_t* SQ = (const bf16_t*)(F.ws + WS_SQ); const bf16_t* SK = (const bf16_t*)(F.ws + WS_SK); const bf16_t* SV = (const bf16_t*)(F.ws + WS_SV);
    const unsigned* MASK = (const unsigned*)(F.ws + WS_MASK); bf16_t* Y = (bf16_t*)(F.ws + WS_Y);
    const int lane = F.lane;
    for (int row = gw; row < MC; row += NGW) {
        const int b = row >> 12, t = row & (SEQ - 1);
        { float q[8]; ld8f(SQ + (size_t)row * 512 + 8 * lane, q);
#pragma unroll
          for (int j = 0; j < 8; ++j) sqf[8 * lane + j] = q[j]; }
        int nsel = 0;
        for (int i = 0; i <= (t >> 6); ++i) {
            const unsigned w0 = MASK[((size_t)row * 2 + 0) * 64 + i], w1 = MASK[((size_t)row * 2 + 1) * 64 + i];
            const unsigned long long bm = unpack_mask(w0, w1);
            const bool sel = (bm >> lane) & 1ull;
            const int pos = nsel + __popcll(bm & ((1ull << lane) - 1ull));
            if (sel && pos < 256) list[pos] = (unsigned)(64 * i + lane);
            nsel += __popcll(bm);
        }
        if (nsel > 256) nsel = 256;
        WSYNC();
        for (int k = lane; k < nsel; k += 64) {
            const bf16_t* kr = SK + ((size_t)b * SEQ + list[k]) * 512;
#pragma unroll 1
            for (int h = 0; h < 8; ++h) { float d = 0.f;
#pragma unroll
                for (int c = 0; c < 8; ++c) { float kv[8]; ld8f(kr + h * 64 + 8 * c, kv);
#pragma unroll
                    for (int j = 0; j < 8; ++j) d += sqf[h * 64 + 8 * c + j] * kv[j]; }
                sc[h * 256 + k] = d; }
        }
        WSYNC();
#pragma unroll 1
        for (int h = 0; h < 8; ++h) {
            float mx = -INFINITY; for (int k = lane; k < nsel; k += 64) mx = fmaxf(mx, sc[h * 256 + k]);
            mx = wave_max(mx); float sum = 0.f;
            for (int k = lane; k < nsel; k += 64) { const float p = fexp2(sc[h * 256 + k] - mx); sc[h * 256 + k] = p; sum += p; }
            sum = wave_sum(sum); if (lane == 0) invs[h] = 1.0f / sum;
        }
        WSYNC();
        { const int h = lane >> 3, d0 = (lane & 7) * 8; float accv[8] = {0.f, 0.f, 0.f, 0.f, 0.f, 0.f, 0.f, 0.f};
          for (int k = 0; k < nsel; ++k) { const float p = sc[h * 256 + k]; float v[8]; ld8f(SV + ((size_t)b * SEQ + list[k]) * 512 + h * 64 + d0, v);
#pragma unroll
              for (int j = 0; j < 8; ++j) accv[j] += p * v[j]; }
          const float inv = invs[h];
          u32x4 o; o.x = pk2(accv[0] * inv, accv[1] * inv); o.y = pk2(accv[2] * inv, accv[3] * inv); o.z = pk2(accv[4] * inv, accv[5] * inv); o.w = pk2(accv[6] * inv, accv[7] * inv);
          *(u32x4*)(Y + (size_t)row * 1536 + 512 + h * 64 + d0) = o; }
        WSYNC();
    }
}
DI void naive_mlstm(Frame& F, const Args& a, int l) {
    F.refresh();
    const int gw = F.bid * NWAVES + F.wave, NGW = F.G * NWAVES;
    LAS unsigned char* wl = F.lds + F.wave * 16384;
    LAS float* pl = (LAS float*)wl;
    const bf16_t* QK = (const bf16_t*)(F.ws + WS_QK); const bf16_t* VM = (const bf16_t*)(F.ws + WS_VM); const bf16_t* OM = (const bf16_t*)(F.ws + WS_OM);
    const float* AK = (const float*)(F.ws + WS_AK); const float* MQ = (const float*)(F.ws + WS_MQ); const float* EM = (const float*)(F.ws + WS_EM);
    bf16_t* Y = (bf16_t*)(F.ws + WS_Y); const float* mng = a.in[I_MNG] + (size_t)l * 512;
    const int lane = F.lane;
    for (int qi = gw; qi < MC * 4; qi += NGW) {
        const int row = qi >> 2, h = qi & 3, b = row >> 12, t = row & (SEQ - 1), seq = b * 4 + h;
        const unsigned qw = *(const unsigned*)(QK + (size_t)row * 1024 + h * 128 + 2 * lane);
        const float q0 = bflo(qw), q1 = bfhi(qw);
        const float Mt = MQ[(size_t)seq * SEQ + t];
        float denp = 0.f;
        for (int s0 = 0; s0 <= t; s0 += 64) {
            const int s = s0 + lane; const bool valid = s <= t; const int sr = valid ? s : t;
            const bf16_t* kr = QK + ((size_t)b * SEQ + sr) * 1024 + 512 + h * 128;
            float d = 0.f;
#pragma unroll 4
            for (int c = 0; c < 16; ++c) { float kv[8]; ld8f(kr + 8 * c, kv);
#pragma unroll
                for (int j = 0; j < 4; ++j) { d += __shfl(q0, 4 * c + j) * kv[2 * j] + __shfl(q1, 4 * c + j) * kv[2 * j + 1]; } }
            const float p = valid ? d * fexp(AK[(size_t)seq * SEQ + sr] - Mt) : 0.f;
            pl[s] = p;
            denp += p;
        }
        const float den = wave_sum(denp);
        WSYNC();
        float a0 = 0.f, a1 = 0.f;
        for (int s = 0; s <= t; ++s) { const float p = pl[s]; const unsigned vw = *(const unsigned*)(VM + ((size_t)b * SEQ + s) * 512 + h * 128 + 2 * lane); a0 += p * bflo(vw); a1 += p * bfhi(vw); }
        const float hd = fmaxf(fabsf(den), EM[(size_t)seq * SEQ + t]);
        a0 /= hd; a1 /= hd;
        const float ss = wave_sum(a0 * a0 + a1 * a1); const float r = 1.0f / sqrtf(ss * (1.f / 128.f) + EPS);
        const unsigned ow = *(const unsigned*)(OM + (size_t)row * 512 + h * 128 + 2 * lane);
        const float y0 = a0 * r * mng[h * 128 + 2 * lane] * bflo(ow), y1 = a1 * r * mng[h * 128 + 2 * lane + 1] * bfhi(ow);
        *(unsigned*)(Y + (size_t)row * 1536 + h * 128 + 2 * lane) = pk2(y0, y1);
        WSYNC();
    }
}
DI void naive_diff(Frame& F, const Args& a, int l) {
    F.refresh();
    if (F.wave >= 4) return;
    const int gw = F.bid * 4 + F.wave, NGW = F.G * 4;
    LAS unsigned char* wl = F.lds + F.wave * 32768;
    LAS float* p0 = (LAS float*)wl; LAS float* p1 = (LAS float*)(wl + 16384);
    const bf16_t* DQ = (const bf16_t*)(F.ws + WS_DQ); const bf16_t* DK = (const bf16_t*)(F.ws + WS_DK); const bf16_t* DV = (const bf16_t*)(F.ws + WS_DV);
    bf16_t* Y = (bf16_t*)(F.ws + WS_Y); const float* dog = a.in[I_DOG] + (size_t)l * 128; const float* lam = a.in[I_LAM] + (size_t)l * 256;
    const int lane = F.lane;
    const float lam_init = (l == 0) ? 0.2f : 0.35550906759096934f;
    const float s01 = wave_sum(lam[lane] * lam[64 + lane]), s23 = wave_sum(lam[128 + lane] * lam[192 + lane]);
    const float lam_val = fexp(s01) - fexp(s23) + lam_init;
    for (int qi = gw; qi < MC * 4; qi += NGW) {
        const int row = qi >> 2, h = qi & 3, b = row >> 12, t = row & (SEQ - 1);
        const float qa = bf2f(DQ[(size_t)row * 512 + (2 * h) * 64 + lane]), qb = bf2f(DQ[(size_t)row * 512 + (2 * h + 1) * 64 + lane]);
        float mx0 = -INFINITY, mx1 = -INFINITY;
        for (int s0 = 0; s0 <= t; s0 += 64) {
            const int s = s0 + lane; const bool valid = s <= t; const int sr = valid ? s : t;
            const bf16_t* kr = DK + ((size_t)b * SEQ + sr) * 512 + (2 * h) * 64;
            float d0 = 0.f, d1 = 0.f;
#pragma unroll 4
            for (int c = 0; c < 8; ++c) { float ka[8], kb[8]; ld8f(kr + 8 * c, ka); ld8f(kr + 64 + 8 * c, kb);
#pragma unroll
                for (int j = 0; j < 8; ++j) { d0 += __shfl(qa, 8 * c + j) * ka[j]; d1 += __shfl(qb, 8 * c + j) * kb[j]; } }
            if (valid) { p0[s] = d0; p1[s] = d1; mx0 = fmaxf(mx0, d0); mx1 = fmaxf(mx1, d1); }
        }
        mx0 = wave_max(mx0); mx1 = wave_max(mx1);
        WSYNC();
        float sm0 = 0.f, sm1 = 0.f;
        for (int s = lane; s <= t; s += 64) { const float e0 = fexp2(p0[s] - mx0), e1 = fexp2(p1[s] - mx1); p0[s] = e0; p1[s] = e1; sm0 += e0; sm1 += e1; }
        const float i0 = 1.0f / wave_sum(sm0), i1 = lam_val / wave_sum(sm1);
        WSYNC();
        float a0 = 0.f, a1 = 0.f;
        for (int s = 0; s <= t; ++s) { const float av = p0[s] * i0 - p1[s] * i1; const unsigned vw = *(const unsigned*)(DV + ((size_t)b * SEQ + s) * 512 + h * 128 + 2 * lane); a0 += av * bflo(vw); a1 += av * bfhi(vw); }
        const float ss = wave_sum(a0 * a0 + a1 * a1); const float r = 1.0f / sqrtf(ss * (1.f / 128.f) + EPS) * (1.0f - lam_init);
        *(unsigned*)(Y + (size_t)row * 1536 + 1024 + h * 128 + 2 * lane) = pk2(a0 * r * dog[2 * lane], a1 * r * dog[2 * lane + 1]);
        WSYNC();
    }
}

typedef float f32x16 __attribute__((ext_vector_type(16)));
typedef short s16x4 __attribute__((ext_vector_type(4)));
typedef __bf16 bf16x2_t __attribute__((ext_vector_type(2)));
DI unsigned cvtpk(float lo, float hi) { f32x2 v = {lo, hi}; bf16x2_t b = __builtin_convertvector(v, bf16x2_t); return __builtin_bit_cast(unsigned, b); }
#define MFMA32(a, b, c) __builtin_amdgcn_mfma_f32_32x32x16_bf16((a), (b), (c), 0, 0, 0)
#define SBAR() __builtin_amdgcn_sched_barrier(0)
DI s16x4 trread(LAS const unsigned char* p) { return __builtin_bit_cast(s16x4, __builtin_amdgcn_ds_read_tr16_b64_v4i16((LAS s16x4*)p)); }
#ifndef MIXMODES
#define MIXMODES 7
#endif
constexpr int CW_QUEUE = 8192;
constexpr int ATT_WSF_OFF = RING_BYTES + 1024;
constexpr float NEGBIG = -1.0e30f;
constexpr float RESC_THR = 16.0f;

DI float max3f(float a, float b, float c) { float r_; asm("v_max3_f32 %0, %1, %2, %3" : "=v"(r_) : "v"(a), "v"(b), "v"(c)); return r_; }
template <int MODE>
DI void attn_qk(f32x16& s0, f32x16& s1, const bf16x8 (&qf)[MODE == 2 ? 8 : 4], LAS const unsigned char* kb, int koff, int j, int q0w, int r, int h, unsigned mw, const bool DIAG) {
    constexpr int KW = MODE == 0 ? 64 : 128, DQK = MODE == 2 ? 128 : 64, DV = MODE == 0 ? 64 : 128, KROWB = KW * 2 + 16, VROWB = MODE == 0 ? 192 : 320, KBYTES = 64 * KROWB, VBYTES = 64 * VROWB;
    constexpr int NKS = DQK / 16, NVB = DV / 32;
    (void)KBYTES; (void)VBYTES; (void)NVB;
    bf16x8 kf[8];
#pragma unroll
    for (int s = 0; s < 4; ++s) { kf[2 * s] = *(LAS const bf16x8*)(kb + koff + 32 * s); kf[2 * s + 1] = *(LAS const bf16x8*)(kb + koff + 32 * KROWB + 32 * s); }
    SBAR();
    if (MODE == 0) {
        const unsigned nmw = ~mw;
#define CI_(i) { int a_, b_; asm("v_bfe_i32 %0, %1, " #i ", 1" : "=v"(a_) : "v"(nmw)); asm("v_bfe_i32 %0, %1, 16+" #i ", 1" : "=v"(b_) : "v"(nmw)); \
                 s0[i] = __uint_as_float((unsigned)a_ & 0xF149F2CAu); s1[i] = __uint_as_float((unsigned)b_ & 0xF149F2CAu); }
        CI_(0) CI_(1) CI_(2) CI_(3) CI_(4) CI_(5) CI_(6) CI_(7) CI_(8) CI_(9) CI_(10) CI_(11) CI_(12) CI_(13) CI_(14) CI_(15)
#undef CI_
    } else if (MODE == 1 && DIAG) {
        const int qd = q0w + r - 64 * j;
#pragma unroll
        for (int i = 0; i < 16; ++i) { const int kk = (i & 3) + 8 * (i >> 2) + 4 * h; s0[i] = kk > qd ? NEGBIG : 0.f; s1[i] = kk + 32 > qd ? NEGBIG : 0.f; }
    } else {
#pragma unroll
        for (int i = 0; i < 16; ++i) { s0[i] = 0.f; s1[i] = 0.f; }
    }
    SBAR();
#pragma unroll
    for (int g = 0; g < NKS / 2; ++g) {
#pragma unroll
        for (int e = 0; e < 2; ++e) { const int s = 2 * g + e; s0 = MFMA32(kf[(4 * g + 2 * e) & 7], qf[s], s0); s1 = MFMA32(kf[(4 * g + 2 * e + 1) & 7], qf[s], s1); }
        if (g + 2 < NKS / 2) {
#pragma unroll
            for (int e = 0; e < 2; ++e) { const int s = 2 * (g + 2) + e;
                kf[(4 * g + 2 * e) & 7] = *(LAS const bf16x8*)(kb + koff + 32 * s); kf[(4 * g + 2 * e + 1) & 7] = *(LAS const bf16x8*)(kb + koff + 32 * KROWB + 32 * s); }
        }
        SBAR();
    }
}
template <int MODE>
DI void attn_pv(f32x16 (&o)[MODE == 0 ? 2 : 4], float& lsum, float& mref, f32x16& s0, f32x16& s1, LAS const unsigned char* vb, int voff,
                int j, int q0w, int r, int h, float M2, LAS float* wsf, const bool DIAG, const int probe) {
    constexpr int DV = MODE == 0 ? 64 : 128, VROWB = MODE == 0 ? 192 : 320, VBYTES = 64 * VROWB;
    constexpr int NVB = DV / 32;
    LAS const unsigned char* ab = vb + VBYTES;
    bf16x8 vfr[NVB > 2 ? 2 : 1][8];
#define VLOAD_(bb) do { _Pragma("unroll") for (int v_ = 0; v_ < 2; ++v_) _Pragma("unroll") for (int p_ = 0; p_ < 2; ++p_) _Pragma("unroll") for (int s2_ = 0; s2_ < 2; ++s2_) { \
        const s16x4 lo_ = trread(vb + voff + (32 * p_ + 16 * s2_) * VROWB + 64 * (2 * (bb) + v_)), hi_ = trread(vb + voff + (32 * p_ + 16 * s2_ + 8) * VROWB + 64 * (2 * (bb) + v_)); \
        vfr[(bb) & (NVB > 2 ? 1 : 0)][4 * v_ + 2 * p_ + s2_] = (bf16x8){lo_[0], lo_[1], lo_[2], lo_[3], hi_[0], hi_[1], hi_[2], hi_[3]}; } } while (0)
    if (probe != 3) VLOAD_(0);
    SBAR();
    if (MODE == 2) {
        float part = 0.f;
        if (DIAG) {
            const int qd = q0w + r - 64 * j;
#pragma unroll
            for (int g = 0; g < 4; ++g) {
                const f32x4 a0 = *(LAS const f32x4*)(ab + (8 * g + 4 * h) * 4), a1 = *(LAS const f32x4*)(ab + (32 + 8 * g + 4 * h) * 4);
#pragma unroll
                for (int e = 0; e < 4; ++e) { const int i = 4 * g + e, kk = 8 * g + 4 * h + e;
                    float w0 = fexp2(a0[e] - M2), w1 = fexp2(a1[e] - M2);
                    if (kk > qd) w0 = 0.f; if (kk + 32 > qd) w1 = 0.f;
                    s0[i] *= w0; s1[i] *= w1; part += s0[i] + s1[i]; }
            }
        } else {
#pragma unroll
            for (int g = 0; g < 4; ++g) {
                const f32x4 a0 = *(LAS const f32x4*)(ab + (8 * g + 4 * h) * 4), a1 = *(LAS const f32x4*)(ab + (32 + 8 * g + 4 * h) * 4);
#pragma unroll
                for (int e = 0; e < 4; ++e) { const int i = 4 * g + e;
                    s0[i] *= fexp2(a0[e] - M2); s1[i] *= fexp2(a1[e] - M2); part += s0[i] + s1[i]; }
            }
        }
        lsum += part;
    } else {
        if (probe != 2) {
        asm volatile("s_nop 15\n\ts_nop 7" : "+v"(s0), "+v"(s1));
        float ta = max3f(s0[0], s0[1], s1[0]), tb = max3f(s0[2], s0[3], s1[1]); ta = max3f(ta, s1[2], s1[3]);
#pragma unroll
        for (int i = 4; i < 16; i += 4) { ta = max3f(ta, s0[i], s0[i + 1]); tb = max3f(tb, s0[i + 2], s0[i + 3]); ta = max3f(ta, s1[i], s1[i + 1]); tb = max3f(tb, s1[i + 2], s1[i + 3]); }
        float tm = max3f(ta, tb, tb); tm = max32x(tm);
        if (__any(tm > mref + RESC_THR)) {
            const float nm = tm > mref + RESC_THR ? tm : mref, al = fexp2(mref - nm);
            mref = nm; lsum *= al;
            if (h == 0) wsf[r] = al;
            WSYNC();
#pragma unroll
            for (int g = 0; g < 4; ++g) { const f32x4 av = *(LAS const f32x4*)(wsf + 8 * g + 4 * h);
#pragma unroll
                for (int v = 0; v < NVB; ++v)
#pragma unroll
                    for (int e = 0; e < 4; ++e) o[v][4 * g + e] *= av[e]; }
            WSYNC();
        }
        if (__any(mref != 0.f)) {
#pragma unroll
            for (int i = 0; i < 16; ++i) { s0[i] -= mref; s1[i] -= mref; }
        }
        float part = 0.f;
#pragma unroll
        for (int i = 0; i < 16; ++i) { s0[i] = fexp2(s0[i]); s1[i] = fexp2(s1[i]); part += s0[i] + s1[i]; }
        lsum += part;
        }
    }
    bf16x8 pf[2][2];
#pragma unroll
    for (int s2 = 0; s2 < 2; ++s2) {
        u32x4 t0, t1;
        t0.x = cvtpk(s0[8 * s2 + 0], s0[8 * s2 + 1]); t0.y = cvtpk(s0[8 * s2 + 2], s0[8 * s2 + 3]); t0.z = cvtpk(s0[8 * s2 + 4], s0[8 * s2 + 5]); t0.w = cvtpk(s0[8 * s2 + 6], s0[8 * s2 + 7]);
        t1.x = cvtpk(s1[8 * s2 + 0], s1[8 * s2 + 1]); t1.y = cvtpk(s1[8 * s2 + 2], s1[8 * s2 + 3]); t1.z = cvtpk(s1[8 * s2 + 4], s1[8 * s2 + 5]); t1.w = cvtpk(s1[8 * s2 + 6], s1[8 * s2 + 7]);
        pf[0][s2] = __builtin_bit_cast(bf16x8, t0); pf[1][s2] = __builtin_bit_cast(bf16x8, t1);
    }
    SBAR();
    if (probe != 3)
#pragma unroll
    for (int b = 0; b < NVB / 2; ++b) {
        if (b + 1 < NVB / 2) VLOAD_(b + 1);
#pragma unroll
        for (int v_ = 0; v_ < 2; ++v_)
#pragma unroll
            for (int p = 0; p < 2; ++p)
#pragma unroll
                for (int s2 = 0; s2 < 2; ++s2) o[2 * b + v_] = MFMA32(pf[p][s2], vfr[b & (NVB > 2 ? 1 : 0)][4 * v_ + 2 * p + s2], o[2 * b + v_]);
        SBAR();
    }
#undef VLOAD_
}

template <int MODE>
DI void attn_tile(f32x16 (&o)[MODE == 0 ? 2 : 4], float& lsum, float& mref, const bf16x8 (&qf)[MODE == 2 ? 8 : 4], LAS const unsigned char* kb, int koff, int voff,
                  int j, int q0w, int r, int h, unsigned mw, float M2, LAS float* wsf, const bool DIAG, const int probe) {
    constexpr int KW = MODE == 0 ? 64 : 128, KROWB = KW * 2 + 16, KBYTES = 64 * KROWB;
    f32x16 s0, s1;
    attn_qk<MODE>(s0, s1, qf, kb, koff, j, q0w, r, h, mw, DIAG);
    attn_pv<MODE>(o, lsum, mref, s0, s1, kb + KBYTES, voff, j, q0w, r, h, M2, wsf, DIAG, probe);
}
template <int MODE>
DI void attn_unit(Frame& F, const Args& a, int l, int b, int head, int qb, float lam_val, float lam_init) {
    constexpr int KW = MODE == 0 ? 64 : 128, DQK = MODE == 2 ? 128 : 64, NCOMP = 1, NPASS = 1, DV = MODE == 0 ? 64 : 128;
    constexpr int KROWB = KW * 2 + 16, VROWB = MODE == 0 ? 192 : 320;
    constexpr int KBYTES = 64 * KROWB, VBYTES = 64 * VROWB, STAGE = KBYTES + VBYTES + 256;
    constexpr int NKS = DQK / 16, NVB = DV / 32, KCH = KW / 64, VCH = DV / 64;
    static_assert(2 * STAGE <= 98304, "tile buffers");
    F.refresh();
    const int probe = (REPMASK != 0) ? ((volatile LAS int*)(F.lds + MISC_OFF + 96))[2] : 0;
    const int tid = F.tid, lane = F.lane, w = F.wave, r = lane & 31, h = lane >> 5;
    const bf16_t* Qp; const bf16_t* Kp; const bf16_t* Vp; int ldq, ldk;
    if (MODE == 0) { Qp = (const bf16_t*)(F.ws + WS_SQ) + head * 64; Kp = (const bf16_t*)(F.ws + WS_SK) + head * 64; Vp = (const bf16_t*)(F.ws + WS_SV) + head * 64; ldq = 512; ldk = 512; }
    else if (MODE == 1) { Qp = (const bf16_t*)(F.ws + WS_DQ) + head * 128; Kp = (const bf16_t*)(F.ws + WS_DK) + head * 128; Vp = (const bf16_t*)(F.ws + WS_DV) + head * 128; ldq = 512; ldk = 512; }
    else { Qp = (const bf16_t*)(F.ws + WS_QK) + head * 128; Kp = (const bf16_t*)(F.ws + WS_QK) + 512 + head * 128; Vp = (const bf16_t*)(F.ws + WS_VM) + head * 128; ldq = 1024; ldk = 1024; }
    const size_t rowb = (size_t)b * SEQ;
    const int comp = MODE == 1 ? (w >> 2) : 0;
    const int q0w = MODE == 1 ? qb * 128 + (w & 3) * 32 : qb * 256 + w * 32;
    const int seq = b * 4 + head;
    LAS float* wsf = (LAS float*)(F.lds + ATT_WSF_OFF + w * 256);
    f32x16 o[NCOMP][NVB];
    float lsum[NCOMP], mref[NCOMP];
    const int i16 = lane & 15, vq = i16 >> 2, vp = i16 & 3, vcs = (lane >> 4) & 1;
    const int voff = (4 * h + vq) * VROWB + (16 * vcs + 4 * vp) * 2;
    const int koff = r * KROWB + 16 * h;
    const int NT = MODE == 2 ? 4 : (MODE == 1 ? 2 * (qb + 1) : 4 * (qb + 1)), JB = MODE == 2 ? 4 * qb : 0;
#pragma unroll 1
    for (int pass = 0; pass < NPASS; ++pass) {
    bf16x8 qf[NCOMP][NKS];
#pragma unroll
    for (int c = 0; c < NCOMP; ++c)
#pragma unroll
        for (int s = 0; s < NKS; ++s) qf[c][s] = *(const GAS bf16x8*)(Qp + (rowb + q0w + r) * ldq + comp * 64 + 16 * s + 8 * h);
#pragma unroll
    for (int c = 0; c < NCOMP; ++c)
#pragma unroll
        for (int v = 0; v < NVB; ++v)
#pragma unroll
            for (int i = 0; i < 16; ++i) o[c][v][i] = 0.f;
#pragma unroll
    for (int c = 0; c < NCOMP; ++c) { lsum[c] = 0.f; mref[c] = 0.f; }
    float M2 = 0.f;
    if (MODE == 2) M2 = ((const float*)(F.ws + WS_MQ))[(size_t)seq * SEQ + q0w + r] * LOG2E;
    const unsigned* mrow = (const unsigned*)(F.ws + WS_MASK) + ((rowb + q0w + r) * 2 + h) * 64;
    const int srow = tid >> 3, sch = tid & 7;
    const bf16_t* kg = Kp + (rowb + srow) * ldk + sch * 8; const bf16_t* vg = Vp + (rowb + srow) * 512 + sch * 8;
    const float* ag = (const float*)(F.ws + WS_AK) + (size_t)seq * SEQ;
    u32x4 kreg[KCH], vreg[VCH]; float areg = 0.f; unsigned mw = 0u; u32x4 mw4 = (u32x4){0u, 0u, 0u, 0u}, mw4n = (u32x4){0u, 0u, 0u, 0u};
#define ST_LOAD(j) do { _Pragma("unroll") for (int c_ = 0; c_ < KCH; ++c_) kreg[c_] = *(const GAS u32x4*)(kg + (size_t)(j) * 64 * ldk + c_ * 64); \
        _Pragma("unroll") for (int c_ = 0; c_ < VCH; ++c_) vreg[c_] = *(const GAS u32x4*)(vg + (size_t)(j) * 64 * 512 + c_ * 64); \
        if (MODE == 2) { if (tid < 64) areg = *(const GAS float*)(ag + (j) * 64 + tid); } \
        asm volatile("" ::: "memory"); } while (0)
#define ST_WRITE(buf) do { LAS unsigned char* sb_ = F.lds + (buf) * STAGE; \
        _Pragma("unroll") for (int c_ = 0; c_ < KCH; ++c_) *(LAS u32x4*)(sb_ + srow * KROWB + (sch + 8 * c_) * 16) = kreg[c_]; \
        _Pragma("unroll") for (int c_ = 0; c_ < VCH; ++c_) *(LAS u32x4*)(sb_ + KBYTES + srow * VROWB + (sch + 8 * c_) * 16) = vreg[c_]; \
        if (MODE == 2) { if (tid < 64) *(LAS float*)(sb_ + KBYTES + VBYTES + tid * 4) = areg * LOG2E; } } while (0)
    if (MODE == 0) mw4n = *(const GAS u32x4*)(mrow + JB);
    ST_LOAD(JB); ST_WRITE(0);
    __syncthreads();
    for (int j = JB; j < JB + NT; ++j) {
        const int cur = j & 1;
        if (MODE == 0) {
            if ((j & 3) == 0) { mw4 = mw4n; if (j + 4 < JB + NT) mw4n = *(const GAS u32x4*)(mrow + j + 4); }
            mw = (j & 3) == 0 ? mw4.x : ((j & 3) == 1 ? mw4.y : ((j & 3) == 2 ? mw4.z : mw4.w));
        }
        if (j + 1 < JB + NT && (probe == 0 || probe == 2 || probe == 3)) ST_LOAD(j + 1);
        if (64 * j <= q0w + 31) {
            LAS const unsigned char* kb = F.lds + cur * STAGE;
            attn_tile<MODE>(o[0], lsum[0], mref[0], qf[0], kb, koff + comp * 128, voff, j, q0w, r, h, mw, M2, wsf, 64 * j + 63 > q0w, probe);
        }
        if (probe != 4) { if (j + 1 < JB + NT) ST_WRITE(cur ^ 1);
        __syncthreads(); }
    }
#undef ST_LOAD
#undef ST_WRITE
    }
    if (MODE == 2) { if (qb > 0) {
        const float Mp2 = ((const float*)(F.ws + WS_MQ))[(size_t)seq * SEQ + 256 * qb - 1] * LOG2E;
        const float M2s = ((const float*)(F.ws + WS_MQ))[(size_t)seq * SEQ + q0w + r] * LOG2E;
        const float g = fexp2(Mp2 - M2s);
        const float* NSn = (const float*)(F.ws + WS_MN + 128 * 1024) + ((size_t)seq * 16 + qb) * 128;
        const bf16_t* Cn = (const bf16_t*)(F.ws + WS_MC) + ((size_t)seq * 16 + qb) * 16384;
        bf16x8 qs[8]; float dpart = 0.f;
#pragma unroll
        for (int s = 0; s < 8; ++s) {
            const bf16x8 qv = *(const GAS bf16x8*)(Qp + (rowb + q0w + r) * ldq + 16 * s + 8 * h);
            const u32x4 qw = __builtin_bit_cast(u32x4, qv);
            const f32x4 n0 = *(const GAS f32x4*)(NSn + 16 * s + 8 * h), n1 = *(const GAS f32x4*)(NSn + 16 * s + 8 * h + 4);
            const float q0 = bflo(qw.x), q1 = bfhi(qw.x), q2 = bflo(qw.y), q3 = bfhi(qw.y), q4 = bflo(qw.z), q5 = bfhi(qw.z), q6 = bflo(qw.w), q7 = bfhi(qw.w);
            dpart += (q0 * n0[0] + q1 * n0[1]) + (q2 * n0[2] + q3 * n0[3]) + (q4 * n1[0] + q5 * n1[1]) + (q6 * n1[2] + q7 * n1[3]);
            u32x4 t; t.x = cvtpk(q0 * g, q1 * g); t.y = cvtpk(q2 * g, q3 * g); t.z = cvtpk(q4 * g, q5 * g); t.w = cvtpk(q6 * g, q7 * g);
            qs[s] = __builtin_bit_cast(bf16x8, t);
        }
        lsum[0] += g * dpart;
#pragma unroll
        for (int v = 0; v < NVB; ++v) {
            bf16x8 cf[8];
#pragma unroll
            for (int s = 0; s < 8; ++s) cf[s] = *(const GAS bf16x8*)(Cn + (size_t)(32 * v + r) * 128 + 16 * s + 8 * h);
#pragma unroll
            for (int s = 0; s < 8; ++s) o[0][v] = MFMA32(qs[s], cf[s], o[0][v]);
        }
    } }
    float sc0; const float sc1 = 0.f;
    if (MODE == 1) { lam_val = ((volatile LAS float*)(F.lds + MISC_OFF + 96))[0]; lam_init = ((volatile LAS float*)(F.lds + MISC_OFF + 96))[1]; }
    { float lt = sum32x(lsum[0]);
      if (MODE == 2) sc0 = frcp(fmaxf(fabsf(lt), ((const float*)(F.ws + WS_EM))[(size_t)seq * SEQ + q0w + r]));
      else if (MODE == 1) sc0 = (comp ? lam_val : 1.0f) * frcp(lt);
      else sc0 = frcp(lt); }
    if (h == 0) { wsf[r] = sc0; wsf[32 + r] = sc1; }
    WSYNC();
    LAS float* stg = (LAS float*)(F.lds + w * 16384);
#pragma unroll
    for (int g = 0; g < 4; ++g) {
        const f32x4 av = *(LAS const f32x4*)(wsf + 8 * g + 4 * h);
#pragma unroll
        for (int e = 0; e < 4; ++e) { const int i = 4 * g + e, row = 8 * g + 4 * h + e;
#pragma unroll
            for (int v = 0; v < NVB; ++v) { float val = o[0][v][i] * av[e]; stg[row * DV + 32 * v + r] = val; } }
    }
    WSYNC();
    if (MODE == 1) __syncthreads();
    if (MODE != 1 || comp == 0) {
        const int q = lane >> 1, hf = lane & 1; constexpr int HC = DV / 2;
        LAS float* srow_ = stg + q * DV + hf * HC;
        if (MODE == 1) {
            LAS const float* prow_ = (LAS const float*)(F.lds + (w + 4) * 16384) + q * DV + hf * HC;
#pragma unroll
            for (int c4 = 0; c4 < HC / 4; ++c4) *(LAS f32x4*)(srow_ + 4 * c4) = *(LAS const f32x4*)(srow_ + 4 * c4) - *(LAS const f32x4*)(prow_ + 4 * c4);
        }
        size_t grow = rowb + q0w + q;
        bf16_t* Y = (bf16_t*)(F.ws + (probe ? WS_MD : WS_Y)); if (probe) grow &= 4095;
        if (MODE == 0) {
            bf16_t* yp = Y + grow * 1536 + 512 + head * 64 + hf * HC;
#pragma unroll
            for (int c8 = 0; c8 < HC / 8; ++c8) { const f32x4 x0 = *(LAS const f32x4*)(srow_ + 8 * c8), x1 = *(LAS const f32x4*)(srow_ + 8 * c8 + 4);
                u32x4 ov; ov.x = cvtpk(x0[0], x0[1]); ov.y = cvtpk(x0[2], x0[3]); ov.z = cvtpk(x1[0], x1[1]); ov.w = cvtpk(x1[2], x1[3]); *(u32x4*)(yp + 8 * c8) = ov; }
        } else {
            float ss = 0.f;
#pragma unroll
            for (int c4 = 0; c4 < HC / 4; ++c4) { const f32x4 x = *(LAS const f32x4*)(srow_ + 4 * c4); ss += (x[0] * x[0] + x[1] * x[1]) + (x[2] * x[2] + x[3] * x[3]); }
            ss += xor1(ss);
            float rs = 1.0f / sqrtf(ss * (1.f / 128.f) + EPS);
            const float* gain; bf16_t* yp; const bf16_t* gatep = nullptr;
            if (MODE == 1) { rs *= (1.0f - lam_init); gain = a.in[I_DOG] + (size_t)l * 128 + hf * HC; yp = Y + grow * 1536 + 1024 + head * 128 + hf * HC; }
            else { gain = a.in[I_MNG] + (size_t)l * 512 + head * 128 + hf * HC; yp = Y + grow * 1536 + head * 128 + hf * HC; gatep = (const bf16_t*)(F.ws + WS_OM) + grow * 512 + head * 128 + hf * HC; }
#pragma unroll
            for (int c8 = 0; c8 < HC / 8; ++c8) {
                f32x4 x0 = *(LAS const f32x4*)(srow_ + 8 * c8), x1 = *(LAS const f32x4*)(srow_ + 8 * c8 + 4);
                const f32x4 g0 = *(const f32x4*)(gain + 8 * c8), g1 = *(const f32x4*)(gain + 8 * c8 + 4);
                x0 = x0 * rs * g0; x1 = x1 * rs * g1;
                if (MODE == 2) { float gt[8]; ld8f(gatep + 8 * c8, gt);
#pragma unroll
                    for (int e = 0; e < 4; ++e) { x0[e] *= gt[e]; x1[e] *= gt[4 + e]; } }
                u32x4 ov; ov.x = cvtpk(x0[0], x0[1]); ov.y = cvtpk(x0[2], x0[3]); ov.z = cvtpk(x1[0], x1[1]); ov.w = cvtpk(x1[2], x1[3]); *(u32x4*)(yp + 8 * c8) = ov;
            }
        }
    }
    __syncthreads();
}
DI void phase_mixers(Frame& F, const Args& a, int l, int it, int modes, int probe) {
    F.refresh();
    const float* lam = a.in[I_LAM] + (size_t)l * 256;
    const float lam_init = (l == 0) ? 0.2f : 0.35550906759096934f;
    const float s01 = wave_sum(lam[F.lane] * lam[64 + F.lane]), s23 = wave_sum(lam[128 + F.lane] * lam[192 + F.lane]);
    { const float lv = fexp(s01) - fexp(s23) + lam_init; if (F.tid == 0) { ((volatile LAS int*)(F.lds + MISC_OFF + 96))[2] = probe; ((volatile LAS float*)(F.lds + MISC_OFF + 96))[0] = lv; ((volatile LAS float*)(F.lds + MISC_OFF + 96))[1] = lam_init; } }
    const float lam_val = 0.f;
    unsigned* qhead = (unsigned*)(F.ws + WS_CTL) + CW_QUEUE + it * 64;
    volatile LAS unsigned* slot = (volatile LAS unsigned*)(F.lds + MISC_OFF + 64);
    for (;;) {
        if (F.tid == 0) *slot = __hip_atomic_fetch_add(qhead, 1u, __ATOMIC_RELAXED, __HIP_MEMORY_SCOPE_AGENT);
        __syncthreads();
        const int u = __builtin_amdgcn_readfirstlane((int)*slot);
        __syncthreads();
        if (u >= 1280) break;
        if (u < 1024) { const int p_ = u >> 6, k = u & 63;
            if (k < 16) { if (modes & MIXMODES & 2) attn_unit<1>(F, a, l, k >> 2, k & 3, 31 - 2 * p_, lam_val, lam_init); }
            else if (k < 48) { if (modes & MIXMODES & 1) attn_unit<0>(F, a, l, (k - 16) >> 3, (k - 16) & 7, 15 - p_, lam_val, lam_init); }
            else { if (modes & MIXMODES & 2) attn_unit<1>(F, a, l, (k - 48) >> 2, (k - 48) & 3, 30 - 2 * p_, lam_val, lam_init); }
        } else { const int m_ = u - 1024; if (modes & MIXMODES & 4) attn_unit<2>(F, a, l, (m_ >> 2) & 3, m_ & 3, 15 - (m_ >> 4), lam_val, lam_init); }
    }
}

DI void mlstm_state_unit(Frame& F, int sq, int n) {
    F.refresh();
    constexpr int KROWB = 272, VROWB = 320, KBYTES = 64 * KROWB, VBYTES = 64 * VROWB;
    const int tid = F.tid, lane = F.lane, w = F.wave, r = lane & 31, h = lane >> 5, b = sq >> 2, head = sq & 3;
    const size_t rowb = (size_t)b * SEQ;
    const bf16_t* Kp = (const bf16_t*)(F.ws + WS_QK) + 512 + head * 128; const bf16_t* Vp = (const bf16_t*)(F.ws + WS_VM) + head * 128;
    const float* ag = (const float*)(F.ws + WS_AK) + (size_t)sq * SEQ;
    const float Mend = ((const float*)(F.ws + WS_MQ))[(size_t)sq * SEQ + 256 * n + 255];
    f32x16 acc[2];
#pragma unroll
    for (int c = 0; c < 2; ++c)
#pragma unroll
        for (int i = 0; i < 16; ++i) acc[c][i] = 0.f;
    const int dvb = w >> 1, dkb0 = 2 * (w & 1);
    const int srow = tid >> 3, sch = tid & 7;
    const int i16 = lane & 15, vq = i16 >> 2, vp = i16 & 3, vcs = (lane >> 4) & 1;
    const int toffV = (4 * h + vq) * VROWB + (16 * vcs + 4 * vp) * 2, toffK = (4 * h + vq) * KROWB + (16 * vcs + 4 * vp) * 2;
    LAS unsigned char* kb = F.lds; LAS unsigned char* vb = kb + KBYTES; LAS float* wts = (LAS float*)(vb + VBYTES);
    float nacc = 0.f; const int ndk = tid & 127, npart = tid >> 7;
    for (int jt = 0; jt < 4; ++jt) {
        const int j = 4 * n + jt;
        const float wr_ = fexp(*(const GAS float*)(ag + 64 * j + srow) - Mend);
        u32x4 kreg[2], vreg[2];
#pragma unroll
        for (int c = 0; c < 2; ++c) { kreg[c] = *(const GAS u32x4*)(Kp + (rowb + 64 * j + srow) * 1024 + (sch + 8 * c) * 8); vreg[c] = *(const GAS u32x4*)(Vp + (rowb + 64 * j + srow) * 512 + (sch + 8 * c) * 8); }
#pragma unroll
        for (int c = 0; c < 2; ++c) { u32x4 t = vreg[c];
            t.x = cvtpk(bflo(t.x) * wr_, bfhi(t.x) * wr_); t.y = cvtpk(bflo(t.y) * wr_, bfhi(t.y) * wr_); t.z = cvtpk(bflo(t.z) * wr_, bfhi(t.z) * wr_); t.w = cvtpk(bflo(t.w) * wr_, bfhi(t.w) * wr_); vreg[c] = t; }
        __syncthreads();
#pragma unroll
        for (int c = 0; c < 2; ++c) { *(LAS u32x4*)(kb + srow * KROWB + (sch + 8 * c) * 16) = kreg[c]; *(LAS u32x4*)(vb + srow * VROWB + (sch + 8 * c) * 16) = vreg[c]; }
        if (sch == 0) wts[srow] = wr_;
        __syncthreads();
#pragma unroll
        for (int sg = 0; sg < 4; ++sg) {
            const s16x4 alo = trread(vb + toffV + (16 * sg) * VROWB + 64 * dvb), ahi = trread(vb + toffV + (16 * sg + 8) * VROWB + 64 * dvb);
            const bf16x8 af = (bf16x8){alo[0], alo[1], alo[2], alo[3], ahi[0], ahi[1], ahi[2], ahi[3]};
#pragma unroll
            for (int c = 0; c < 2; ++c) {
                const s16x4 blo = trread(kb + toffK + (16 * sg) * KROWB + 64 * (dkb0 + c)), bhi = trread(kb + toffK + (16 * sg + 8) * KROWB + 64 * (dkb0 + c));
                const bf16x8 bfr = (bf16x8){blo[0], blo[1], blo[2], blo[3], bhi[0], bhi[1], bhi[2], bhi[3]};
                acc[c] = MFMA32(af, bfr, acc[c]);
            }
        }
#pragma unroll 4
        for (int s_ = 0; s_ < 16; ++s_) { const int ks = 16 * npart + s_; nacc += wts[ks] * bf2f(*(LAS const bf16_t*)(kb + ks * KROWB + ndk * 2)); }
    }
    float* D = (float*)(F.ws + WS_MD) + ((size_t)sq * 16 + n) * 16384;
#pragma unroll
    for (int c = 0; c < 2; ++c)
#pragma unroll
        for (int i = 0; i < 16; ++i) D[(32 * dvb + (i & 3) + 8 * (i >> 2) + 4 * h) * 128 + 32 * (dkb0 + c) + r] = acc[c][i];
    __syncthreads();
    LAS float* red = (LAS float*)F.lds;
    red[npart * 128 + ndk] = nacc;
    __syncthreads();
    if (tid < 128) ((float*)(F.ws + WS_MN))[((size_t)sq * 16 + n) * 128 + tid] = (red[tid] + red[128 + tid]) + (red[256 + tid] + red[384 + tid]);
    __syncthreads();
}
DI void mlstm_state_scan(Frame& F) {
    const int gid = (F.bid * NWAVES + F.wave) * 64 + F.lane, NG_ = F.G * NWAVES * 64;
    const float* D = (const float*)(F.ws + WS_MD); bf16_t* C = (bf16_t*)(F.ws + WS_MC); const float* MQ = (const float*)(F.ws + WS_MQ);
    for (int e = gid; e < CB * 4 * 16384; e += NG_) {
        const int sq = e >> 14, idx = e & 16383;
        float d[15], me[15];
#pragma unroll
        for (int n = 0; n < 15; ++n) { d[n] = D[((size_t)sq * 16 + n) * 16384 + idx]; me[n] = MQ[(size_t)sq * SEQ + 256 * n + 255]; }
        float c = 0.f;
#pragma unroll
        for (int n = 0; n < 15; ++n) { const float f = n == 0 ? 0.f : fexp(me[n - 1] - me[n]); c = f * c + d[n]; C[((size_t)sq * 16 + n + 1) * 16384 + idx] = (bf16_t)f2bf(c); }
    }
    const float* Nv = (const float*)(F.ws + WS_MN); float* NS = (float*)(F.ws + WS_MN + 128 * 1024);
    for (int e = gid; e < CB * 4 * 128; e += NG_) {
        const int sq = e >> 7, idx = e & 127; float c = 0.f;
#pragma unroll
        for (int n = 0; n < 15; ++n) { const float me = MQ[(size_t)sq * SEQ + 256 * n + 255]; const float f = n == 0 ? 0.f : fexp(MQ[(size_t)sq * SEQ + 256 * (n - 1) + 255] - me);
            c = f * c + Nv[((size_t)sq * 16 + n) * 128 + idx]; NS[((size_t)sq * 16 + n + 1) * 128 + idx] = c; }
    }
}

constexpr size_t SC_BSTRIDE = (size_t)4096 * (64 * 65 / 2);
DI size_t sc_off(int b, int t) { const int qb = t >> 6; return (size_t)b * SC_BSTRIDE + (size_t)4096 * (qb * (qb + 1) / 2) + (size_t)(t & 63) * 64 * (qb + 1); }
constexpr int CW_QUEUE2 = 12288;
DI void phase_scores(Frame& F, int it) {
    F.refresh();
    unsigned* qhead = (unsigned*)(F.ws + WS_CTL) + CW_QUEUE2 + it * 64;
    volatile LAS unsigned* slot = (volatile LAS unsigned*)(F.lds + MISC_OFF + 64);
    const bf16_t* IQ = (const bf16_t*)(F.ws + WS_IQ); const bf16_t* IK = (const bf16_t*)(F.ws + WS_IK); const float* IW = (const float*)(F.ws + WS_IW);
    float* SC = (float*)(F.ws + WS_HREG);
    for (;;) {
        if (F.tid == 0) *slot = __hip_atomic_fetch_add(qhead, 1u, __ATOMIC_RELAXED, __HIP_MEMORY_SCOPE_AGENT);
        __syncthreads();
        const int u = __builtin_amdgcn_readfirstlane((int)*slot);
        __syncthreads();
        if (u >= CB * 160 + 240) break;
        if (u >= CB * 160) { const int m_ = u - CB * 160; mlstm_state_unit(F, m_ & 15, m_ >> 4); continue; }
        int b = u / 160, k = u % 160, qb, seg;
        {
          int cls = 3, base = 0;
          for (;; --cls) { const int cnt = 16 * (cls + 1); if (k < base + cnt) break; base += cnt; }
          const int kk = k - base; qb = 16 * cls + (kk % 16); seg = kk / 16; }
        F.refresh();
        const int lane = F.lane, w = F.wave, r = lane & 31, h = lane >> 5, qh = w & 1;
        const int t0 = 64 * qb + 32 * qh;
        const size_t rowq = (size_t)b * SEQ + t0 + r;
        const f32x4 wv = *(const GAS f32x4*)(IW + rowq * 4);
        bf16x8 qf[4][4];
#pragma unroll
        for (int hd = 0; hd < 4; ++hd)
#pragma unroll
            for (int s = 0; s < 4; ++s) qf[hd][s] = *(const GAS bf16x8*)(IQ + rowq * 256 + hd * 64 + 16 * s + 8 * h);
        LAS unsigned* T = (LAS unsigned*)(F.lds + w * 8448);
        const int jplast = ((16 * seg + 15 < qb) ? 16 * seg + 15 : qb) >> 1;
        unsigned short* scb = (unsigned short*)(F.ws + WS_HREG) + sc_off(b, t0);
        const int rstride = 64 * (qb + 1);
        for (int jp = 8 * seg + (w >> 1); jp <= jplast; jp += 4) {
            const int nt2 = (2 * jp + 1 <= qb) ? 2 : 1;
            bf16x8 kfa[4][4];
#pragma unroll
            for (int q4 = 0; q4 < 4; ++q4) { const int jq = 2 * jp + ((q4 >> 1) < nt2 ? (q4 >> 1) : 0);
#pragma unroll
                for (int s = 0; s < 4; ++s) kfa[q4][s] = *(const GAS bf16x8*)(IK + ((size_t)b * SEQ + 64 * jq + 32 * (q4 & 1) + r) * 64 + 8 * h + 16 * s); }
#pragma unroll
            for (int ts = 0; ts < 2; ++ts) { if (ts < nt2) {
#pragma unroll
                for (int p = 0; p < 2; ++p) {
                    float sc[16];
#pragma unroll
                    for (int i = 0; i < 16; ++i) sc[i] = 0.f;
#pragma unroll
                    for (int hd = 0; hd < 4; ++hd) {
                        f32x16 acc;
#pragma unroll
                        for (int i = 0; i < 16; ++i) acc[i] = 0.f;
#pragma unroll
                        for (int s = 0; s < 4; ++s) acc = MFMA32(kfa[2 * ts + p][s], qf[hd][s], acc);
#pragma unroll
                        for (int i = 0; i < 16; ++i) sc[i] += wv[hd] * fmaxf(acc[i], 0.f);
                    }
#pragma unroll
                    for (int i = 0; i < 16; i += 2) {
                        const unsigned lo = __builtin_bit_cast(unsigned short, (_Float16)(sc[i] + 0.0f)), hi = __builtin_bit_cast(unsigned short, (_Float16)(sc[i + 1] + 0.0f));
                        T[r * 65 + ((64 * ts + 32 * p + (i & 3) + 8 * (i >> 2) + 4 * h) >> 1)] = lo | (hi << 16); }
                }
            } }
            WSYNC();
            if (lane < 32 * nt2) {
#pragma unroll 8
                for (int q = 0; q < 32; ++q) *(unsigned*)(scb + (size_t)q * rstride + 128 * jp + 2 * lane) = T[q * 65 + lane];
            }
            WSYNC();
        }
    }
}
DI unsigned long long spread32(unsigned x) {
    unsigned long long v = x;
    v = (v | (v << 16)) & 0x0000FFFF0000FFFFull; v = (v | (v << 8)) & 0x00FF00FF00FF00FFull; v = (v | (v << 4)) & 0x0F0F0F0F0F0F0F0Full;
    v = (v | (v << 2)) & 0x3333333333333333ull; v = (v | (v << 1)) & 0x5555555555555555ull; return v;
}
DI unsigned pack_nib(unsigned long long bm, int hh) {
    unsigned long long x = (bm >> (4 * hh)) & 0x0F0F0F0F0F0F0F0Full;
    x = (x | (x >> 4)) & 0x00FF00FF00FF00FFull; x = (x | (x >> 8)) & 0x0000FFFF0000FFFFull; x = (x | (x >> 16)) & 0x00000000FFFFFFFFull; return (unsigned)x;
}
DI void radix_find(LAS unsigned* hist, int lane, int& need, unsigned& digit, unsigned& cnt) {
    const u32x4 c = *(LAS const u32x4*)(hist + 4 * lane);
    const unsigned ls = (c.x + c.y) + (c.z + c.w); unsigned inc = ls;
#pragma unroll
    for (int o = 1; o < 64; o <<= 1) { const unsigned y = shup_u(inc, o, lane); if (lane >= o) inc += y; }
    const unsigned total = rdl_u(inc, 63);
    unsigned cum = total - inc; int fbin = -1; unsigned fneed = 0u, fcnt = 0u;
    if (cum < (unsigned)need && cum + c.w >= (unsigned)need) { fbin = 4 * lane + 3; fneed = (unsigned)need - cum; fcnt = c.w; } cum += c.w;
    if (fbin < 0 && cum < (unsigned)need && cum + c.z >= (unsigned)need) { fbin = 4 * lane + 2; fneed = (unsigned)need - cum; fcnt = c.z; } cum += c.z;
    if (fbin < 0 && cum < (unsigned)need && cum + c.y >= (unsigned)need) { fbin = 4 * lane + 1; fneed = (unsigned)need - cum; fcnt = c.y; } cum += c.y;
    if (fbin < 0 && cum < (unsigned)need && cum + c.x >= (unsigned)need) { fbin = 4 * lane; fneed = (unsigned)need - cum; fcnt = c.x; }
    const int src = __ffsll((long long)__ballot(fbin >= 0)) - 1;
    digit = rdl_u((unsigned)fbin, src); need = (int)rdl_u(fneed, src); cnt = rdl_u(fcnt, src);
}
template <int NGP>
DI void select_row(int row, int lane, LAS unsigned* hist, const unsigned (&raw)[32], unsigned* MASK, const int probe) {
        const int b = row >> 12, t = row & (SEQ - 1), n = t + 1, ngp = (t >> 7) + 1;
        unsigned key[NGP];
        (void)b;
#pragma unroll
        for (int i = 0; i < NGP; ++i) key[i] = raw[i];
#pragma unroll
        for (int i = 0; i < NGP; ++i) { const int e2 = 64 * i + lane; unsigned w_ = key[i];
            { const unsigned sg_ = (w_ >> 15) & 0x00010001u; w_ ^= ((sg_ << 15) - sg_) + 0x80008000u; }
            if (2 * e2 >= n) w_ &= 0xFFFF0000u; if (2 * e2 + 1 >= n) w_ &= 0x0000FFFFu; key[i] = w_; }
        unsigned thr = 0u; int need = 256; bool ties = false;
        if (n > 256 && probe != 1 && probe != 3) {
            unsigned dA = 0u, dB = 0u, cnt = 0u;
            { unsigned z_ = 0u; asm volatile("" : "+v"(z_)); *(LAS u32x4*)(hist + 4 * lane) = (u32x4){z_, z_, z_, z_}; }
            WSYNC();
#pragma unroll
            for (int i = 0; i < NGP; ++i) if (i < ngp) { const unsigned kx = key[i];
                __hip_atomic_fetch_add(&hist[(kx >> 8) & 255u], 1u, __ATOMIC_RELAXED, __HIP_MEMORY_SCOPE_WORKGROUP); __hip_atomic_fetch_add(&hist[kx >> 24], 1u, __ATOMIC_RELAXED, __HIP_MEMORY_SCOPE_WORKGROUP); }
            WSYNC();
            radix_find(hist, lane, need, dA, cnt);
            WSYNC();
            if ((unsigned)need != cnt) {
                { unsigned z_ = 0u; asm volatile("" : "+v"(z_)); *(LAS u32x4*)(hist + 4 * lane) = (u32x4){z_, z_, z_, z_}; }
                WSYNC();
#pragma unroll
                for (int i = 0; i < NGP; ++i) if (i < ngp) { const unsigned kx = key[i];
                    if (((kx >> 8) & 255u) == dA) __hip_atomic_fetch_add(&hist[kx & 255u], 1u, __ATOMIC_RELAXED, __HIP_MEMORY_SCOPE_WORKGROUP);
                    if ((kx >> 24) == dA) __hip_atomic_fetch_add(&hist[(kx >> 16) & 255u], 1u, __ATOMIC_RELAXED, __HIP_MEMORY_SCOPE_WORKGROUP); }
                WSYNC();
                radix_find(hist, lane, need, dB, cnt);
                WSYNC();
                thr = (dA << 8) | dB; ties = (unsigned)need != cnt;
            } else { thr = dA << 8; ties = false; }
        }
        unsigned elo = 0u, ehi = 0u, olo = 0u, ohi = 0u; int eqc = 0;
        if (probe == 1 || probe == 3) thr = 0x9000u;
        if (probe < 2)
        {
#define SEL_STEP(i) if constexpr ((i) < NGP) if ((i) < ngp) { const unsigned kx = key[(i) < NGP ? (i) : 0], kl = kx & 0xFFFFu, kh = kx >> 16; bool sl, sh; \
            if (n <= 256) { sl = kl != 0u; sh = kh != 0u; } \
            else if (!ties) { sl = kl >= thr; sh = kh >= thr; } \
            else { const bool ql = kl == thr, qh = kh == thr; const unsigned long long ml = __ballot(ql), mh = __ballot(qh), lt = (1ull << lane) - 1ull; \
                const int rl = eqc + __popcll(ml & lt) + __popcll(mh & lt), rh = rl + (ql ? 1 : 0); \
                sl = kl > thr || (ql && rl < need); sh = kh > thr || (qh && rh < need); eqc += __popcll(ml) + __popcll(mh); } \
            const unsigned long long be = __ballot(sl), bo = __ballot(sh); const unsigned e0 = (unsigned)be, e1 = (unsigned)(be >> 32), o0 = (unsigned)bo, o1 = (unsigned)(bo >> 32); \
            asm volatile("s_nop 4\n\tv_writelane_b32 %0, %4, " #i "\n\tv_writelane_b32 %1, %5, " #i "\n\tv_writelane_b32 %2, %6, " #i "\n\tv_writelane_b32 %3, %7, " #i \
                         : "+v"(elo), "+v"(ehi), "+v"(olo), "+v"(ohi) : "s"(e0), "s"(e1), "s"(o0), "s"(o1)); }
#define SEL8(b) SEL_STEP(b) SEL_STEP(b + 1) SEL_STEP(b + 2) SEL_STEP(b + 3) SEL_STEP(b + 4) SEL_STEP(b + 5) SEL_STEP(b + 6) SEL_STEP(b + 7)
        SEL8(0) SEL8(8) SEL8(16) SEL8(24)
#undef SEL8
#undef SEL_STEP
        }
        if (lane < 32) {
            const unsigned long long ta = spread32(elo) | (spread32(olo) << 1), tb = spread32(ehi) | (spread32(ohi) << 1);
            *(u32x2*)(MASK + ((size_t)row * 2 + 0) * 64 + 2 * lane) = (u32x2){pack_nib(ta, 0), pack_nib(tb, 0)};
            *(u32x2*)(MASK + ((size_t)row * 2 + 1) * 64 + 2 * lane) = (u32x2){pack_nib(ta, 1), pack_nib(tb, 1)};
        }
}
DI void phase_select(Frame& F, const int probe) {
    F.refresh();
    const int gw = F.bid * NWAVES + F.wave, NGW = F.G * NWAVES, lane = F.lane;
    LAS unsigned* hist = (LAS unsigned*)(F.lds + F.wave * 1024);
    const unsigned short* SC = (const unsigned short*)(F.ws + WS_HREG); unsigned* MASK = (unsigned*)(F.ws + WS_MASK);
    if (!probe) mlstm_state_scan(F);
    unsigned cur[32];
#define LOAD_ROW(dst, rw) do { const int t_ = (rw) & (SEQ - 1), em_ = t_ >> 1; const unsigned* sr_ = (const unsigned*)(SC + sc_off((rw) >> 12, t_)); \
        _Pragma("unroll") for (int i_ = 0; i_ < 32; ++i_) { const int e_ = 64 * i_ + lane; dst[i_] = *(const GAS unsigned*)(sr_ + (e_ < em_ ? e_ : em_)); } } while (0)
    const int nstep = (MC + NGW - 1) / NGW;
#define ROW_OF(k) ((NGW == 2048) ? (((k) >> 1) * SEQ + (((k) & 1) ? (SEQ - 1 - gw) : gw)) : (gw + (k) * NGW))
    if (gw < MC) LOAD_ROW(cur, ROW_OF(0));
    for (int k = 0; k < nstep; ++k) {
        const int row = ROW_OF(k); if (row >= MC) break;
        unsigned nxt[32]; const int nrow = (k + 1 < nstep && ROW_OF(k + 1) < MC) ? ROW_OF(k + 1) : row;
        LOAD_ROW(nxt, nrow);
        asm volatile("" ::: "memory");
        const int cls = (row & (SEQ - 1)) >> 10;
        unsigned* mk = probe ? (unsigned*)(F.ws + WS_QKRAW) : MASK;
        if (cls == 0) select_row<8>(row, lane, hist, cur, mk, probe);
        else if (cls == 1) select_row<16>(row, lane, hist, cur, mk, probe);
        else if (cls == 2) select_row<24>(row, lane, hist, cur, mk, probe);
        else select_row<32>(row, lane, hist, cur, mk, probe);
#pragma unroll
        for (int i = 0; i < 32; ++i) cur[i] = nxt[i];
    }
#undef ROW_OF
#undef LOAD_ROW
}

#ifndef MK_ONE_LAUNCH
#define MK_ONE_LAUNCH 1
#endif
constexpr int NPHASE = 13;
__global__ void __launch_bounds__(NWAVES * 64, 2) fwd(Args args) {
    extern __shared__ __attribute__((aligned(16))) unsigned char lds[];
    Frame F;
    F.lds = (LAS unsigned char*)lds; F.ws = args.ws;
    F.tid = threadIdx.x; F.lane = F.tid & 63; F.wave = __builtin_amdgcn_readfirstlane(F.tid >> 6); F.wave0 = F.wave;
    F.G = gridDim.x; F.bid = blockIdx.x;
    volatile LAS unsigned* MISC = (volatile LAS unsigned*)(F.lds + MISC_OFF);
    for (int u = F.tid; u < (LDS_BYTES - LDSCTL_OFF) / 4; u += NWAVES * 64) ((LAS unsigned*)(F.lds + LDSCTL_OFF))[u] = 0u;
    __syncthreads();
    const bool multi = MK_ONE_LAUNCH ? true : !(args.it_hi - args.it_lo == 1 && args.ph_hi - args.ph_lo == 1);
    XcdBarrier bar; bar.bar = (unsigned*)(F.ws + WS_CTL) + CW_BAR; bar.x = 0; bar.st = nullptr;
    if (multi) bar = xcd_barrier_post((unsigned*)(F.ws + WS_CTL) + CW_BAR, MISC + 8);
#define GRID_BAR() do { if (multi) { xcd_barrier(bar); if ((REPMASK >> 15) & 1) xcd_barrier(bar); } } while (0)
    const int lo = args.ph_lo, hi = args.ph_hi; (void)lo; (void)hi;
#ifndef PHMASK
#define PHMASK 0xFFFF
#endif
#if MK_ONE_LAUNCH
#define IN(k) ((PHMASK >> (k)) & 1)
#else
#define IN(k) (((PHMASK >> (k)) & 1) && lo <= (k) && (k) < hi)
#endif
#define REPS(k) (1 + ((REPMASK >> (k)) & 1))
    if (IN(0) && args.it_lo == 0) for (int rp = 0; rp < REPS(0); ++rp) { phase_prologue(F, args); GRID_BAR(); }
    for (int it = args.it_lo; it < args.it_hi; ++it) {
        const int chunk = it >> 1, l = it & 1;
        unsigned char* wl = F.ws + WS_W + (size_t)l * W_LAYER;
        const size_t xoff = (size_t)chunk * MC * DM;
        const float* xin = args.in[I_X] + xoff;
        float* Xout = args.out + xoff;
        bf16_t* X16 = (bf16_t*)(F.ws + WS_X16);
        bf16_t* XN = (bf16_t*)(F.ws + WS_XN);
        if (IN(1)) for (int rp = 0; rp < REPS(1); ++rp) { phase_rmsnorm(F, l == 0 ? (const void*)xin : (const void*)X16, l != 0, args.in[I_NMG] + (size_t)l * DM, XN); GRID_BAR(); }
        if (IN(2)) for (int rp = 0; rp < REPS(2); ++rp) {
            pg8::Gemm g{XN, (const bf16_t*)(wl + WO_IN), MC, NT_IN * 256, DM}; F.refresh(); pg8::StaticOrder S; S.init(MC, NT_IN * 256, F.G, F.bid);
            EpiInProj E{F.ws, args.in[I_GB] + l * 8, l};
            pg8::gemm_phase<EpiInProj, true>(F.lds, g, S, E, F.tid);
            GRID_BAR();
        }
        if (IN(3)) for (int rp = 0; rp < REPS(3); ++rp) { phase_token(F, args, l, rp == 0 ? 0 : PROBE_NOLOAD); GRID_BAR(); }
        if (IN(4)) for (int rp = 0; rp < REPS(4); ++rp) {
            pg8::Gemm g{(const bf16_t*)(F.ws + WS_CKV), (const bf16_t*)(wl + WO_KV), MC, 1024, 256}; F.refresh(); pg8::StaticOrder S; S.init(MC, 1024, F.G, F.bid);
            EpiKV E{F.ws, l};
            pg8::gemm_phase<EpiKV, true>(F.lds, g, S, E, F.tid);
            if (rp + 1 < REPS(4)) GRID_BAR();
        }
#ifdef NAIVE_SEL
        if (IN(5)) { naive_select(F); GRID_BAR(); }
#else
        if (IN(5)) { for (int rp = 0; rp < REPS(5); ++rp) { phase_scores(F, it + 8 * rp); GRID_BAR(); } for (int rp = 0; rp < REPS(13); ++rp) { phase_select(F, rp == 0 ? 0 : PROBE_NOLOAD); GRID_BAR(); } }
#endif
                if (IN(7)) for (int rp = 0; rp < REPS(7); ++rp) {
            pg8::Gemm g{XN, (const bf16_t*)(wl + WO_G), MC, 3072, DM}; F.refresh(); pg8::StaticOrder S; S.init(MC, 3072, F.G, F.bid);
            EpiGate E{F.ws + WS_HREG, args.in[I_BG] + (size_t)l * 3072};
            pg8::gemm_phase<EpiGate, true>(F.lds, g, S, E, F.tid);
            if (rp + 1 < REPS(7)) GRID_BAR();
        }
#ifdef NAIVE_MIX
        if (IN(6)) { naive_dsa(F); __syncthreads(); naive_mlstm(F, args, l); __syncthreads(); naive_diff(F, args, l); GRID_BAR(); }
#else
        if (IN(6)) for (int rp = 0; rp < REPS(6); ++rp) { phase_mixers(F, args, l, it + 8 * rp, rp == 0 ? 7 : PROBE_MODES, rp == 0 ? 0 : PROBE_NOLOAD); GRID_BAR(); }
#endif
        if (IN(8)) for (int rp = 0; rp < REPS(8); ++rp) {
            pg8::Gemm g{(const bf16_t*)(F.ws + WS_Y), (const bf16_t*)(wl + WO_BR), MC, 1024, 1536}; F.refresh(); pg8::StaticOrder S; S.init(MC, 1024, F.G, F.bid);
            EpiMerge E{F.ws + WS_HREG, (bf16_t*)(F.ws + WS_MG)};
            pg8::gemm_phase<EpiMerge, false>(F.lds, g, S, E, F.tid);
            GRID_BAR();
        }
        if (IN(9)) for (int rp = 0; rp < REPS(9); ++rp) {
            pg8::Gemm g{(const bf16_t*)(F.ws + WS_MG), (const bf16_t*)(wl + WO_OUT), MC, 1024, 1024}; F.refresh(); pg8::StaticOrder S; S.init(MC, 1024, F.G, F.bid);
            EpiResid E{l == 0 ? (const void*)xin : (const void*)X16, (void*)X16, l != 0, true};
            pg8::gemm_phase<EpiResid, false>(F.lds, g, S, E, F.tid);
            GRID_BAR();
        }
        if (IN(10)) for (int rp = 0; rp < REPS(10); ++rp) { phase_rmsnorm(F, X16, true, args.in[I_NFG] + (size_t)l * DM, XN); GRID_BAR(); }
        if (IN(11)) for (int rp = 0; rp < REPS(11); ++rp) {
            pg8::Gemm g{XN, (const bf16_t*)(wl + WO_GU), MC, 5632, DM}; F.refresh(); pg8::StaticOrder S; S.init(MC, 5632, F.G, F.bid);
            EpiSwiGLU E{(bf16_t*)(F.ws + WS_HREG)};
            pg8::gemm_phase<EpiSwiGLU, true>(F.lds, g, S, E, F.tid);
            GRID_BAR();
        }
        if (IN(12)) for (int rp = 0; rp < REPS(12); ++rp) {
            pg8::Gemm g{(const bf16_t*)(F.ws + WS_HREG), (const bf16_t*)(wl + WO_D), MC, 1024, FF}; F.refresh(); pg8::StaticOrder S; S.init(MC, 1024, F.G, F.bid);
            EpiResid E{(const void*)X16, l == DEPTH - 1 ? (void*)Xout : (void*)X16, true, l != DEPTH - 1};
            pg8::gemm_phase<EpiResid, false>(F.lds, g, S, E, F.tid);
            GRID_BAR();
        }
    }
#undef IN
#undef GRID_BAR
}

extern "C" void kernel_launch(void* const* d_in, const int* in_sizes, int n_in, void* d_out, int out_size, void* d_ws, size_t ws_size, hipStream_t stream) {
    static int grid = 0;
    if (grid == 0) {
        if (n_in != 21 || ws_size < WS_END) { fprintf(stderr, "kernel_launch: unexpected inputs (n_in %d, ws %zu)\n", n_in, ws_size); grid = -1; return; }
        int dev = 0, cus = 0;
        if (hipGetDevice(&dev) != hipSuccess || hipDeviceGetAttribute(&cus, hipDeviceAttributeMultiprocessorCount, dev) != hipSuccess) { grid = -1; return; }
        if (hipFuncSetAttribute((const void*)fwd, hipFuncAttributeMaxDynamicSharedMemorySize, LDS_BYTES) != hipSuccess) { grid = -1; return; }
        int per_cu = 0;
        if (hipOccupancyMaxActiveBlocksPerMultiprocessor(&per_cu, (const void*)fwd, NWAVES * 64, LDS_BYTES) != hipSuccess || per_cu < 1) fprintf(stderr, "kernel_launch: occupancy query says %d\n", per_cu);
        (void)hipGetLastError();
        grid = cus;
    }
    if (grid < 0) return;
    (void)hipMemsetAsync((char*)d_ws + WS_CTL, 0, CTL_ZERO_BYTES, stream);
    Args a{};
    for (int i = 0; i < 21; ++i) a.in[i] = (const float*)d_in[i];
    a.out = (float*)d_out; a.ws = (unsigned char*)d_ws;
#if MK_ONE_LAUNCH
    a.it_lo = 0; a.it_hi = NCHUNK * DEPTH; a.ph_lo = 0; a.ph_hi = NPHASE;
    hipLaunchKernelGGL(fwd, dim3(grid), dim3(NWAVES * 64), LDS_BYTES, stream, a);
#else
    a.it_lo = 0; a.it_hi = 1; a.ph_lo = 0; a.ph_hi = 1;
    hipLaunchKernelGGL(fwd, dim3(grid), dim3(NWAVES * 64), LDS_BYTES, stream, a);
    for (int it = 0; it < NCHUNK * DEPTH; ++it)
        for (int ph = 1; ph < NPHASE; ++ph) { a.it_lo = it; a.it_hi = it + 1; a.ph_lo = ph; a.ph_hi = ph + 1; hipLaunchKernelGGL(fwd, dim3(grid), dim3(NWAVES * 64), LDS_BYTES, stream, a); }
#endif
}
```

```cpp
#include <hip/hip_runtime.h>
#include <cstdio>
#include <cstdint>

#ifndef REPMASK
#define REPMASK 0
#endif
#define PROBE_MODES 7
#define PROBE_NOLOAD 0
#define DI __device__ __forceinline__
#define LAS __attribute__((address_space(3)))
#define GAS __attribute__((address_space(1)))

typedef unsigned short bf16_t;
typedef short bf16x8 __attribute__((ext_vector_type(8)));
typedef float f32x4 __attribute__((ext_vector_type(4)));
typedef float f32x2 __attribute__((ext_vector_type(2)));
typedef unsigned u32x4 __attribute__((ext_vector_type(4)));
typedef unsigned u32x2 __attribute__((ext_vector_type(2)));

constexpr int BATCH = 8, SEQ = 4096, DM = 1024, DEPTH = 2;
constexpr int CB = 4;
constexpr int MC = CB * SEQ;
constexpr int NCHUNK = BATCH / CB;
constexpr int IN_COLS = 7756;
constexpr int FF = 2816;
constexpr float EPS = 1e-6f;
constexpr float LOG2E = 1.4426950408889634f;
constexpr float C2 = 0.125f * LOG2E;
constexpr int Z_MQK = 0, Z_MV = 1024, Z_MO = 1536, Z_MIF = 2048, Z_SQ = 2056, Z_CKV = 2568, Z_IQ = 2824, Z_IK = 3080, Z_IW = 3144, Z_DQ = 3148, Z_DK = 3660, Z_DV = 4172, Z_G = 4684;
constexpr int NT_IN = 19;

constexpr size_t MiB = 1u << 20;
constexpr size_t WS_CTL = 0, CTL_ZERO_BYTES = 128 * 1024;
constexpr size_t WS_COS = 1 * MiB, WS_SIN = 1 * MiB + 512 * 1024;
constexpr size_t WS_W = 2 * MiB, W_LAYER = 38 * MiB;
constexpr size_t WO_IN = 0;
constexpr size_t WO_G = WO_IN + (size_t)NT_IN * 256 * 1024 * 2;
constexpr size_t WO_KV = WO_G + (size_t)3072 * 1024 * 2;
constexpr size_t WO_BR = WO_KV + (size_t)1024 * 256 * 2;
constexpr size_t WO_OUT = WO_BR + (size_t)1024 * 1536 * 2;
constexpr size_t WO_GU = WO_OUT + (size_t)1024 * 1024 * 2;
constexpr size_t WO_D = WO_GU + (size_t)5632 * 1024 * 2;
static_assert(WO_D + (size_t)1024 * 2816 * 2 <= W_LAYER, "weights per layer");
constexpr size_t WS_ACT = WS_W + 2 * W_LAYER;
constexpr size_t WS_XN = WS_ACT;
constexpr size_t WS_QKRAW = WS_XN + 32 * MiB;
constexpr size_t WS_CKV = WS_QKRAW + 32 * MiB;
constexpr size_t WS_IQ = WS_CKV + 8 * MiB;
constexpr size_t WS_Y = WS_QKRAW;
constexpr size_t WS_QK = WS_IQ + 8 * MiB;
constexpr size_t WS_MG = WS_QK;
constexpr size_t WS_VM = WS_QK + 32 * MiB;
constexpr size_t WS_OM = WS_VM + 16 * MiB;
constexpr size_t WS_SQ = WS_OM + 16 * MiB;
constexpr size_t WS_DQ = WS_SQ + 16 * MiB;
constexpr size_t WS_DK = WS_DQ + 16 * MiB;
constexpr size_t WS_DV = WS_DK + 16 * MiB;
constexpr size_t WS_SK = WS_DV + 16 * MiB;
constexpr size_t WS_SV = WS_SK + 16 * MiB;
constexpr size_t WS_IK = WS_SV + 16 * MiB;
constexpr size_t WS_IF = WS_IK + 2 * MiB;
constexpr size_t WS_IW = WS_IF + 512 * 1024;
constexpr size_t WS_RT = WS_IW + 256 * 1024;
constexpr size_t WS_AK = WS_RT + 256 * 1024;
constexpr size_t WS_MQ = WS_AK + 256 * 1024;
constexpr size_t WS_EM = WS_MQ + 256 * 1024;
constexpr size_t WS_MASK = WS_IK + 4 * MiB;
constexpr size_t WS_HREG = WS_MASK + 8 * MiB;
constexpr size_t WS_X16 = WS_HREG + 96 * MiB;
constexpr size_t WS_MD = WS_X16 + 32 * MiB;
constexpr size_t WS_MC = WS_MD + 16 * MiB;
constexpr size_t WS_MN = WS_MC + 8 * MiB;
constexpr size_t WS_END = WS_MN + 1 * MiB;
static_assert(WS_EM + 256 * 1024 <= WS_MASK, "small buffers");
static_assert(WS_END <= 512 * MiB, "workspace");
constexpr int CW_BAR = 4096;
constexpr size_t WS_GAIN = 512 * 1024;

constexpr int RING_BYTES = 131072;
constexpr int LDSCTL_OFF = RING_BYTES, MISC_OFF = LDSCTL_OFF + 320;
constexpr int LDS_BYTES = 147456;
constexpr int NWAVES = 8;

DI float bf2f(unsigned v) { return __uint_as_float(v << 16); }
DI unsigned f2bf(float f) { unsigned u = __float_as_uint(f); return (u + 0x7fffu + ((u >> 16) & 1u)) >> 16; }
DI unsigned pk2(float lo, float hi) { return f2bf(lo) | (f2bf(hi) << 16); }
DI float bflo(unsigned w) { return __uint_as_float(w << 16); }
DI float bfhi(unsigned w) { return __uint_as_float(w & 0xffff0000u); }
typedef unsigned u32x2v __attribute__((ext_vector_type(2)));
DI float xor1(float v)  { return __uint_as_float((unsigned)__builtin_amdgcn_mov_dpp((int)__float_as_uint(v), 0xB1, 0xF, 0xF, true)); }
DI float xor2(float v)  { return __uint_as_float((unsigned)__builtin_amdgcn_mov_dpp((int)__float_as_uint(v), 0x4E, 0xF, 0xF, true)); }
DI float ror4(float v)  { return __uint_as_float((unsigned)__builtin_amdgcn_mov_dpp((int)__float_as_uint(v), 0x124, 0xF, 0xF, true)); }
DI float ror8(float v)  { return __uint_as_float((unsigned)__builtin_amdgcn_mov_dpp((int)__float_as_uint(v), 0x128, 0xF, 0xF, true)); }
DI float sum16x(float v) { const unsigned u = __float_as_uint(v); const auto r = __builtin_amdgcn_permlane16_swap(u, u, false, false); return __uint_as_float(r[0]) + __uint_as_float(r[1]); }
DI float sum32x(float v) { const unsigned u = __float_as_uint(v); const auto r = __builtin_amdgcn_permlane32_swap(u, u, false, false); return __uint_as_float(r[0]) + __uint_as_float(r[1]); }
DI float max16x(float v) { const unsigned u = __float_as_uint(v); const auto r = __builtin_amdgcn_permlane16_swap(u, u, false, false); return fmaxf(__uint_as_float(r[0]), __uint_as_float(r[1])); }
DI float max32x(float v) { const unsigned u = __float_as_uint(v); const auto r = __builtin_amdgcn_permlane32_swap(u, u, false, false); return fmaxf(__uint_as_float(r[0]), __uint_as_float(r[1])); }
DI unsigned shup_u(unsigned v, int o, int lane) { return (unsigned)__builtin_amdgcn_ds_bpermute(((lane - o) & 63) << 2, (int)v); }
DI float shup_f(float v, int o, int lane) { return __uint_as_float(shup_u(__float_as_uint(v), o, lane)); }
DI double shup_d(double v, int o, int lane) { const unsigned long long u = __builtin_bit_cast(unsigned long long, v); const unsigned lo = shup_u((unsigned)u, o, lane), hi = shup_u((unsigned)(u >> 32), o, lane); return __builtin_bit_cast(double, ((unsigned long long)hi << 32) | lo); }
DI unsigned rdl_u(unsigned v, int src) { return (unsigned)__builtin_amdgcn_readlane((int)v, src); }
DI float wave_sum(float v) { v += xor1(v); v += xor2(v); v += ror4(v); v += ror8(v); v = sum16x(v); return sum32x(v); }
DI float wave_max(float v) { v = fmaxf(v, xor1(v)); v = fmaxf(v, xor2(v)); v = fmaxf(v, ror4(v)); v = fmaxf(v, ror8(v)); v = max16x(v); return max32x(v); }
typedef __bf16 bf16x2e_t __attribute__((ext_vector_type(2)));
DI unsigned cvtpk_(float lo, float hi) { f32x2 v = {lo, hi}; bf16x2e_t b = __builtin_convertvector(v, bf16x2e_t); return __builtin_bit_cast(unsigned, b); }
DI float fexp2(float x) { return __builtin_amdgcn_exp2f(x); }
DI float fexp(float x) { return __builtin_amdgcn_exp2f(x * LOG2E); }
DI float frcp(float x) { return __builtin_amdgcn_rcpf(x); }
DI float sigmoidf_(float x) { return frcp(1.0f + fexp(-x)); }
#define WSYNC() do { asm volatile("s_waitcnt lgkmcnt(0)" ::: "memory"); __builtin_amdgcn_wave_barrier(); } while (0)

namespace pg8 {
constexpr int BM = 256, BK = 64, HALF = 128, HTB = HALF * BK * 2, STAGE_BYTES = 8 * HTB, NXCD = 8, WGM = 8;
__host__ __device__ __forceinline__ int lds_byte(int r, int c) { const int st = (r >> 4) * 2 + (c >> 5), rr = r & 15, cc = c & 31, ob = rr * 64 + cc * 2; return st * 1024 + (ob ^ (((ob >> 9) & 1) << 5)); }
__host__ __device__ __forceinline__ void stage_rc(int b, int& R, int& C) { const int st = b / 1024, sb = b % 1024, swz = sb ^ (((sb >> 9) & 1) << 5); R = (st >> 1) * 16 + swz / 64; C = (st & 1) * 32 + (swz % 64) / 2; }
__host__ __device__ __forceinline__ int perm32(int rho) { const int n = rho >> 4, i = rho & 15; return 8 * (i >> 2) + 4 * n + (i & 3); }
struct Unit { int pm, pn; };
struct Gemm { const bf16_t* A; const bf16_t* Bt; int M, N, K; };
struct StaticOrder {
    int nM, nN, nwg, G, c;
    __host__ __device__ void init(int M, int N, int G_, int c_) { nM = M / BM; nN = N / BM; nwg = nM * nN; G = G_; c = c_; }
    __host__ __device__ bool next(int i, Unit& u) const {
        const long L = (long)i * G + c; if (L >= nwg) return false;
        int wgid = (int)L; { const int q = nwg / NXCD, r = nwg % NXCD, xcd = wgid % NXCD, off = wgid / NXCD; wgid = (xcd < r ? xcd * (q + 1) : r * (q + 1) + (xcd - r) * q) + off; }
        const int nig = WGM * nN, gid = wgid / nig, fm = gid * WGM, gsz = (nM - fm) < WGM ? (nM - fm) : WGM;
        u.pm = fm + ((wgid % nig) % gsz); u.pn = (wgid % nig) / gsz; return true;
    }
};
template <class Epi, bool ALIGN_EPI>
__device__ __forceinline__ void gemm_phase(LAS unsigned char* lds, const Gemm g, const StaticOrder& S, const Epi& E, int tid_in) {
    int tid_ = tid_in; asm volatile("" : "+v"(tid_));
    int K_ = g.K; asm volatile("" : "+s"(K_));
    const int tid = tid_, wid = __builtin_amdgcn_readfirstlane(tid >> 6), lane = tid & 63, wr = wid >> 2, wc = wid & 3, fr = lane & 15, fq = lane >> 4;
    const int K = K_, nt = K / BK;
    unsigned voffA[2], voffB[2];
#pragma unroll
    for (int i = 0; i < 2; ++i) { int R, C; stage_rc(tid * 16 + i * 8192, R, C); const int Rb = Epi::PERM ? ((R & ~31) + perm32(R & 31)) : R;
        voffA[i] = (unsigned)(R * K + C) * 2u; voffB[i] = (unsigned)(Rb * K + C) * 2u; }
    const size_t kstep = (size_t)(BK * 2);
    const size_t hstep = (size_t)HALF * K * 2;
    const size_t tstep = 2 * hstep;
    const unsigned ldsw = (unsigned)wid * 1024u;
    const int aoff = lds_byte(wr * 64 + fr, fq * 8), boff = lds_byte(wc * 32 + fr, fq * 8);
#define PG8_SA(b, h) (((b) * 2 + (h)) * HTB)
#define PG8_SB(b, h) ((4 + (b) * 2 + (h)) * HTB)
#define PG8_STAGE(bufoff, gbase, voff) do { _Pragma("unroll") for (int _i = 0; _i < 2; ++_i) \
        __builtin_amdgcn_global_load_lds((const unsigned*)((const char*)(gbase) + (voff)[_i]), (LAS unsigned*)(lds + (bufoff) + ldsw + _i * 8192), 16, 0, 0); } while (0)
#define PG8_LDA(dst, b, h) do { _Pragma("unroll") for (int m = 0; m < 4; ++m) _Pragma("unroll") for (int k = 0; k < 2; ++k) dst[m][k] = *(const LAS bf16x8*)(lds + PG8_SA(b, h) + aoff + m * 2048 + k * 1024); } while (0)
#define PG8_LDB(dst, b, h) do { _Pragma("unroll") for (int n = 0; n < 2; ++n) _Pragma("unroll") for (int k = 0; k < 2; ++k) dst[n][k] = *(const LAS bf16x8*)(lds + PG8_SB(b, h) + boff + n * 2048 + k * 1024); } while (0)
#define PG8_MMA(ai, bj, At, Bt) do { __builtin_amdgcn_s_setprio(1); _Pragma("unroll") for (int m = 0; m < 4; ++m) _Pragma("unroll") for (int n = 0; n < 2; ++n) _Pragma("unroll") for (int k = 0; k < 2; ++k) \
        acc[ai][bj][m][n] = __builtin_amdgcn_mfma_f32_16x16x32_bf16(Bt[n][k], At[m][k], acc[ai][bj][m][n], 0, 0, 0); __builtin_amdgcn_s_setprio(0); } while (0)
#define PG8_WAIT_V(n) asm volatile("s_waitcnt vmcnt(" #n ")" ::: "memory")
#define PG8_WAIT_L(n) asm volatile("s_waitcnt lgkmcnt(" #n ")" ::: "memory")
#define PG8_BAR __builtin_amdgcn_s_barrier()
#define PG8_SCHED __builtin_amdgcn_sched_barrier(0)
    Unit cur, nxt; int ui = 0;
    if (!S.next(0, cur)) return;
    f32x4 acc[2][2][4][2];
    if constexpr (Epi::INIT) { int fr_ = fr, fq_ = fq, wr_ = wr, wc_ = wc; asm volatile("" : "+v"(fr_), "+v"(fq_), "+s"(wr_), "+s"(wc_)); E.init(acc, cur, wr_, wc_, fr_, fq_); }
    else {
#pragma unroll
    for (int a = 0; a < 2; ++a)
#pragma unroll
        for (int b = 0; b < 2; ++b)
#pragma unroll
            for (int m = 0; m < 4; ++m)
#pragma unroll
                for (int n = 0; n < 2; ++n) acc[a][b][m][n] = (f32x4){0.f, 0.f, 0.f, 0.f};
    }
    bf16x8 At[4][2], B0[2][2], B1[2][2];
    const char* cA = (const char*)g.A + (size_t)cur.pm * tstep; const char* cB = (const char*)g.Bt + (size_t)cur.pn * tstep;
    PG8_STAGE(PG8_SB(0, 0), cB, voffB); PG8_STAGE(PG8_SB(0, 1), cB + hstep, voffB); PG8_STAGE(PG8_SA(0, 0), cA, voffA); PG8_STAGE(PG8_SA(0, 1), cA + hstep, voffA);
    if (wr == 1) PG8_BAR;
    PG8_WAIT_V(2); PG8_BAR;
    PG8_STAGE(PG8_SB(1, 0), cB + kstep, voffB); PG8_STAGE(PG8_SA(1, 0), cA + kstep, voffA); PG8_STAGE(PG8_SB(1, 1), cB + hstep + kstep, voffB);
    PG8_WAIT_V(6); PG8_BAR;
    for (;;) {
        const bool has_next = S.next(ui + 1, nxt);
        const char* nA = has_next ? (const char*)g.A + (size_t)nxt.pm * tstep : cA; const char* nB = has_next ? (const char*)g.Bt + (size_t)nxt.pn * tstep : cB;
        for (int t = 0; t < nt; t += 2) {
            const bool last = (t == nt - 2);
            const char* a1 = cA + (size_t)(t + 1) * kstep;
            const char* a2 = last ? nA : cA + (size_t)(t + 2) * kstep; const char* b2 = last ? nB : cB + (size_t)(t + 2) * kstep;
            const char* a3 = a2 + kstep; const char* b3 = b2 + kstep;
            if constexpr (Epi::MIDK) { if (t == 8 || t == 16) { int fr_ = fr, fq_ = fq, wr_ = wr, wc_ = wc; asm volatile("" : "+v"(fr_), "+v"(fq_), "+s"(wr_), "+s"(wc_)); E.mid(acc, cur, t, wr_, wc_, fr_, fq_); } }
            PG8_LDB(B0, 0, 0); PG8_LDB(B1, 0, 1); PG8_SCHED; PG8_LDA(At, 0, 0); PG8_STAGE(PG8_SA(1, 1), a1 + hstep, voffA);
            PG8_WAIT_V(8); PG8_WAIT_L(0); PG8_BAR; PG8_MMA(0, 0, At, B0); PG8_MMA(0, 1, At, B1); PG8_BAR; PG8_SCHED;
            PG8_LDA(At, 0, 1); PG8_STAGE(PG8_SB(0, 0), b2, voffB); PG8_STAGE(PG8_SB(0, 1), b2 + hstep, voffB); PG8_STAGE(PG8_SA(0, 0), a2, voffA);
            PG8_WAIT_V(8); PG8_WAIT_L(0); PG8_BAR; PG8_MMA(1, 0, At, B0); PG8_MMA(1, 1, At, B1); PG8_BAR; PG8_SCHED;
            PG8_LDB(B0, 1, 0); PG8_LDB(B1, 1, 1); PG8_SCHED; PG8_LDA(At, 1, 0); PG8_STAGE(PG8_SA(0, 1), a2 + hstep, voffA);
            PG8_WAIT_V(8); PG8_WAIT_L(0); PG8_BAR; PG8_MMA(0, 0, At, B0); PG8_MMA(0, 1, At, B1); PG8_BAR; PG8_SCHED;
            PG8_LDA(At, 1, 1); PG8_STAGE(PG8_SB(1, 0), b3, voffB); PG8_STAGE(PG8_SB(1, 1), b3 + hstep, voffB); PG8_STAGE(PG8_SA(1, 0), a3, voffA);
            PG8_WAIT_V(8); PG8_WAIT_L(0); PG8_BAR; PG8_MMA(1, 0, At, B0); PG8_MMA(1, 1, At, B1); PG8_BAR; PG8_SCHED;
        }
        if constexpr (ALIGN_EPI) { if (wr == 0) PG8_BAR; }
        { int fr_ = fr, fq_ = fq, wr_ = wr, wc_ = wc; asm volatile("" : "+v"(fr_), "+v"(fq_), "+s"(wr_), "+s"(wc_)); E(acc, cur, wr_, wc_, fr_, fq_); }
        if (!has_next) break;
        if constexpr (Epi::INIT) { int fr_ = fr, fq_ = fq, wr_ = wr, wc_ = wc; asm volatile("" : "+v"(fr_), "+v"(fq_), "+s"(wr_), "+s"(wc_)); E.init(acc, nxt, wr_, wc_, fr_, fq_); }
        else {
#pragma unroll
        for (int a = 0; a < 2; ++a)
#pragma unroll
            for (int b = 0; b < 2; ++b)
#pragma unroll
                for (int m = 0; m < 4; ++m)
#pragma unroll
                    for (int n = 0; n < 2; ++n) acc[a][b][m][n] = (f32x4){0.f, 0.f, 0.f, 0.f};
        }
        cur = nxt; cA = nA; cB = nB; ++ui;
        if constexpr (ALIGN_EPI) { if (wr == 1) PG8_BAR; }
    }
    PG8_WAIT_V(0);
    if constexpr (!ALIGN_EPI) { if (wr == 0) PG8_BAR; }
    PG8_BAR;
#undef PG8_SA
#undef PG8_SB
#undef PG8_STAGE
#undef PG8_LDA
#undef PG8_LDB
#undef PG8_MMA
#undef PG8_WAIT_V
#undef PG8_WAIT_L
#undef PG8_BAR
#undef PG8_SCHED
}
}

#define XB_TMO      128
#define XB_XCNT(j)  (256  + 64 * (j))
#define XB_XSUB(j)  (1280 + 64 * (j))
#define XB_XGEN(j)  (2304 + 64 * (j))
#define XB_TOP      3328
#define XB_TOPGEN   3392
#define XCD_BAR_WORDS 3456
#define XB_SPIN_CAP (1u << 24)
DI unsigned xb_ld(unsigned* p)              { return __hip_atomic_load(p, __ATOMIC_RELAXED, __HIP_MEMORY_SCOPE_AGENT); }
DI unsigned xb_add(unsigned* p, unsigned v) { return __hip_atomic_fetch_add(p, v, __ATOMIC_RELAXED, __HIP_MEMORY_SCOPE_AGENT); }
DI unsigned xb_xcc_id() { return (unsigned)__builtin_amdgcn_s_getreg((3 << 11) | 20) & 0xFu; }
#define XB_SPIN(cond, bar) do { unsigned _sp = 0; while (cond) { __builtin_amdgcn_s_sleep(1); \
    if ((++_sp & 255u) == 0u) { if (xb_ld(&(bar)[XB_TMO])) break; if (_sp > XB_SPIN_CAP) { atomicAdd(&(bar)[XB_TMO], 1u); break; } } } } while (0)
struct XcdBarrier { unsigned* bar; unsigned x; volatile LAS unsigned* st; };
DI XcdBarrier xcd_barrier_post(unsigned* bar, volatile LAS unsigned* st) {
    XcdBarrier b; b.bar = bar; b.x = xb_xcc_id(); b.st = st;
    if (threadIdx.x == 0) (void)xb_add(&bar[XB_XCNT(b.x)], 1u);
    return b;
}
DI void xcd_barrier_complete(unsigned* bar, unsigned x, unsigned& nloc, unsigned& nx) {
    const unsigned G = gridDim.x * gridDim.y * gridDim.z;
    unsigned sum, cnt, mine, sp = 0u;
    for (;;) {
        sum = 0u; cnt = 0u; mine = 0u;
#pragma unroll
        for (unsigned j = 0; j < 16; ++j) { const unsigned c = xb_ld(&bar[XB_XCNT(j)]); sum += c; cnt += (c > 0u) ? 1u : 0u; mine = (j == x) ? c : mine; }
        if (sum == G) break;
        __builtin_amdgcn_s_sleep(1);
        if ((++sp & 255u) == 0u) { if (xb_ld(&bar[XB_TMO])) break; if (sp > XB_SPIN_CAP) { atomicAdd(&bar[XB_TMO], 1u); break; } }
    }
    nloc = mine > 0u ? mine : 1u; nx = cnt > 0u ? cnt : 1u;
}
DI void xcd_barrier(const XcdBarrier& b_in) {
    XcdBarrier b = b_in; { unsigned x_ = b.x; asm volatile("" : "+s"(x_)); b.x = x_; }
    asm volatile("s_waitcnt vmcnt(0)" ::: "memory");
    __syncthreads();
    if (threadIdx.x == 0) {
        unsigned* bar = b.bar;
        __builtin_amdgcn_s_waitcnt(0);
        unsigned nloc = b.st[0], nx = b.st[1];
        if (nloc == 0u) { xcd_barrier_complete(bar, b.x, nloc, nx); b.st[0] = nloc; b.st[1] = nx; }
        const unsigned old = xb_add(&bar[XB_XSUB(b.x)], 1u);
        const unsigned gen = old / nloc;
        if (old + 1u == (gen + 1u) * nloc) {
            __builtin_amdgcn_fence(__ATOMIC_RELEASE, "agent");
            asm volatile("s_waitcnt vmcnt(0)" ::: "memory");
            const unsigned og = xb_add(&bar[XB_TOP], 1u);
            const unsigned tg = og / nx;
            if (og + 1u == (tg + 1u) * nx) xb_add(&bar[XB_TOPGEN], 1u);
            else XB_SPIN(xb_ld(&bar[XB_TOPGEN]) == tg, bar);
            __builtin_amdgcn_fence(__ATOMIC_ACQUIRE, "agent");
            xb_add(&bar[XB_XGEN(b.x)], 1u);
            asm volatile("s_waitcnt vmcnt(0)" ::: "memory");
        } else {
            XB_SPIN(xb_ld(&bar[XB_XGEN(b.x)]) == gen, bar);
            __builtin_amdgcn_fence(__ATOMIC_ACQUIRE, "agent");
            asm volatile("s_waitcnt vmcnt(0)" ::: "memory");
        }
    }
    __syncthreads();
}

struct Args { const float* in[21]; float* out; unsigned char* ws; int it_lo, it_hi, ph_lo, ph_hi; };
enum { I_X = 0, I_NMG, I_WIN, I_BG, I_CW, I_CB, I_GB, I_MNG, I_KVNG, I_WKV, I_SQG, I_SKG, I_DQG, I_DKG, I_LAM, I_DOG, I_WBR, I_WOUT, I_NFG, I_WGU, I_WD };

struct Frame {
    LAS unsigned char* lds;
    unsigned char* ws;
    int tid, lane, wave, G, bid;
    int wave0;
    DI void refresh() {
        int l_; asm volatile("v_mbcnt_lo_u32_b32 %0, -1, 0\n\tv_mbcnt_hi_u32_b32 %0, -1, %0" : "=v"(l_));
        unsigned char* w_ = ws; int g_ = G, b_ = bid, wv_ = wave0; asm volatile("" : "+s"(w_), "+s"(g_), "+s"(b_), "+s"(wv_));
        ws = w_; G = g_; bid = b_; lane = l_; wave = wv_; tid = wv_ * 64 + l_; }
};

DI int map_in(int n) {
    const int pn = n >> 8, p = n & 255, bj = p >> 7, wcq = p & 127, wc = wcq >> 5, q = wcq & 31;
    const int hd = 32 * bj + q;
    switch (pn) {
        case 0: case 1: case 2: case 3: return Z_MQK + n;
        case 4: case 5: return Z_MV + (n - 4 * 256);
        case 6: case 7: return Z_MO + (n - 6 * 256);
        case 8: case 9: return Z_SQ + (4 * (pn - 8) + wc) * 64 + hd;
        case 10: return Z_CKV + p;
        case 11: return Z_IQ + wc * 64 + hd;
        case 12: case 13: return Z_DQ + (4 * (pn - 12) + wc) * 64 + hd;
        case 14: case 15: return Z_DK + (4 * (pn - 14) + wc) * 64 + hd;
        case 16: case 17: return Z_DV + (n - 16 * 256);
        default:
            if (wc == 0) return Z_IK + hd;
            if (wc == 1 && bj == 0) { if (q < 8) return Z_MIF + q; if (q < 12) return Z_IW + (q - 8); }
            return -1;
    }
}
DI int map_kv(int n) {
    const int pn = n >> 8, p = n & 255, bj = p >> 7, wcq = p & 127, wc = wcq >> 5, q = wcq & 31;
    if (pn < 2) return (4 * pn + wc) * 64 + 32 * bj + q;
    return n;
}
DI int map_gu(int n) {
    const int pn = n >> 8, p = n & 255;
    return (p >> 7) * FF + 128 * pn + (p & 127);
}
template <int MAP>
DI void transpose_item(const float* W, int ldw, int cbase, const float* kscale, bf16_t* WT, int ldo, int koff, int nblk, LAS float* scr, int item, int lane) {
    const int kb = item / nblk, nb = item % nblk, k0 = 64 * kb, n0 = 32 * nb;
    const int n = n0 + (lane & 31);
    int src;
    if (MAP == 0) src = n; else if (MAP == 1) src = map_in(n); else if (MAP == 2) src = map_kv(n); else src = map_gu(n);
    float tv_[32];
    const int srcc = src >= 0 ? src : 0;
#pragma unroll
    for (int i = 0; i < 32; ++i) tv_[i] = W[(size_t)(k0 + 2 * i + (lane >> 5)) * ldw + cbase + srcc];
#pragma unroll
    for (int i = 0; i < 32; ++i) { const int kk = 2 * i + (lane >> 5);
        float v = src >= 0 ? tv_[i] : 0.f;
        if (kscale) v *= kscale[k0 + kk];
        scr[kk * 33 + (lane & 31)] = v; }
    WSYNC();
    const int c = lane & 7;
#pragma unroll
    for (int j = 0; j < 4; ++j) { const int nn = (lane >> 3) + 8 * j; const LAS float* s = scr + (8 * c) * 33 + nn;
        u32x4 o; o.x = pk2(s[0 * 33], s[1 * 33]); o.y = pk2(s[2 * 33], s[3 * 33]); o.z = pk2(s[4 * 33], s[5 * 33]); o.w = pk2(s[6 * 33], s[7 * 33]);
        *(u32x4*)(WT + (size_t)(n0 + nn) * ldo + koff + k0 + 8 * c) = o; }
    WSYNC();
}
__device__ const float INVF[32] = {1.000000000e+00f, 7.498942018e-01f, 5.623413324e-01f, 4.216965139e-01f, 3.162277639e-01f, 2.371373922e-01f, 1.778279394e-01f, 1.333521456e-01f,
    1.000000015e-01f, 7.498941571e-02f, 5.623412877e-02f, 4.216964915e-02f, 3.162277862e-02f, 2.371373586e-02f, 1.778279431e-02f, 1.333521493e-02f,
    9.999999776e-03f, 7.498942316e-03f, 5.623413250e-03f, 4.216964822e-03f, 3.162277862e-03f, 2.371373819e-03f, 1.778279431e-03f, 1.333521446e-03f,
    1.000000047e-03f, 7.498941850e-04f, 5.623413017e-04f, 4.216965463e-04f, 3.162277862e-04f, 2.371373848e-04f, 1.778279402e-04f, 1.333521504e-04f};
DI void sincos_acc(float angf, float& c, float& s) {
    const double x = (double)angf;
    const double kd = __builtin_rint(x * 0.63661977236758134308);
    const double r = (x - kd * 1.5707963267948965580) - kd * 6.1232339957367658860e-17;
    const double r2 = r * r;
    double sp = -1.0 / 39916800.0; sp = sp * r2 + 1.0 / 362880.0; sp = sp * r2 - 1.0 / 5040.0; sp = sp * r2 + 1.0 / 120.0; sp = sp * r2 - 1.0 / 6.0; sp = sp * r2 + 1.0; sp *= r;
    double cp = 1.0 / 479001600.0; cp = cp * r2 - 1.0 / 3628800.0; cp = cp * r2 + 1.0 / 40320.0; cp = cp * r2 - 1.0 / 720.0; cp = cp * r2 + 1.0 / 24.0; cp = cp * r2 - 0.5; cp = cp * r2 + 1.0;
    const int k = (int)kd & 3;
    double cc, ss;
    if (k == 0) { cc = cp; ss = sp; } else if (k == 1) { cc = -sp; ss = cp; } else if (k == 2) { cc = -cp; ss = -sp; } else { cc = sp; ss = -cp; }
    c = (float)cc; s = (float)ss;
}
DI void phase_prologue(Frame& F, const Args& a) {
    F.refresh();
    LAS float* scr = (LAS float*)(F.lds + F.wave * 16384);
    const int gw = F.bid * NWAVES + F.wave, NGW = F.G * NWAVES;
    float* COS = (float*)(F.ws + WS_COS); float* SIN = (float*)(F.ws + WS_SIN);
    for (int i = gw * 64 + F.lane; i < SEQ * 32; i += NGW * 64) { const int t = i >> 5, f = i & 31; float c, s; sincos_acc((float)t * INVF[f], c, s); COS[i] = c; SIN[i] = s; }
    if (gw == 0) { float* GN = (float*)(F.ws + WS_GAIN);
        for (int l = 0; l < DEPTH; ++l) { GN[(l * 4 + 0) * 64 + F.lane] = a.in[I_SQG][l * 64 + F.lane]; GN[(l * 4 + 1) * 64 + F.lane] = a.in[I_DQG][l * 64 + F.lane];
            GN[(l * 4 + 2) * 64 + F.lane] = a.in[I_DKG][l * 64 + F.lane]; GN[(l * 4 + 3) * 64 + F.lane] = a.in[I_SKG][l * 64 + F.lane]; } }
    for (int l = 0; l < DEPTH; ++l) {
        unsigned char* wl = F.ws + WS_W + (size_t)l * W_LAYER;
        const float* w_in = a.in[I_WIN] + (size_t)l * DM * IN_COLS;
        { const int nblk = NT_IN * 256 / 32, nit = (DM / 64) * nblk;
          for (int it = gw; it < nit; it += NGW) transpose_item<1>(w_in, IN_COLS, 0, nullptr, (bf16_t*)(wl + WO_IN), DM, 0, nblk, scr, it, F.lane); }
        { const int nblk = 3072 / 32, nit = (DM / 64) * nblk;
          for (int it = gw; it < nit; it += NGW) transpose_item<0>(w_in, IN_COLS, Z_G, nullptr, (bf16_t*)(wl + WO_G), DM, 0, nblk, scr, it, F.lane); }
        { const int nblk = 1024 / 32, nit = (256 / 64) * nblk;
          for (int it = gw; it < nit; it += NGW) transpose_item<2>(a.in[I_WKV] + (size_t)l * 256 * 1024, 1024, 0, a.in[I_KVNG] + l * 256, (bf16_t*)(wl + WO_KV), 256, 0, nblk, scr, it, F.lane); }
        for (int b = 0; b < 3; ++b) { const int nblk = 1024 / 32, nit = (512 / 64) * nblk;
          for (int it = gw; it < nit; it += NGW) transpose_item<0>(a.in[I_WBR] + ((size_t)l * 3 + b) * 512 * 1024, 1024, 0, nullptr, (bf16_t*)(wl + WO_BR), 1536, b * 512, nblk, scr, it, F.lane); }
        { const int nblk = 1024 / 32, nit = (1024 / 64) * nblk;
          for (int it = gw; it < nit; it += NGW) transpose_item<0>(a.in[I_WOUT] + (size_t)l * 1024 * 1024, 1024, 0, nullptr, (bf16_t*)(wl + WO_OUT), 1024, 0, nblk, scr, it, F.lane); }
        { const int nblk = 5632 / 32, nit = (1024 / 64) * nblk;
          for (int it = gw; it < nit; it += NGW) transpose_item<3>(a.in[I_WGU] + (size_t)l * 1024 * 5632, 5632, 0, nullptr, (bf16_t*)(wl + WO_GU), 1024, 0, nblk, scr, it, F.lane); }
        { const int nblk = 1024 / 32, nit = (2816 / 64) * nblk;
          for (int it = gw; it < nit; it += NGW) transpose_item<0>(a.in[I_WD] + (size_t)l * 2816 * 1024, 1024, 0, nullptr, (bf16_t*)(wl + WO_D), 2816, 0, nblk, scr, it, F.lane); }
    }
}

DI void phase_rmsnorm(Frame& F, const void* xv, const bool src16, const float* gain, bf16_t* out) {
    F.refresh();
    const int gw = F.bid * NWAVES + F.wave, NGW = F.G * NWAVES;
    f32x4 gv[4];
#pragma unroll
    for (int j = 0; j < 4; ++j) gv[j] = *(const f32x4*)(gain + 4 * F.lane + 256 * j);
    for (int m = gw; m < MC; m += NGW) {
        f32x4 v[4]; float s = 0.f;
        if (src16) { const GAS u32x2* xr = (const GAS u32x2*)((const bf16_t*)xv + (size_t)m * DM) + F.lane;
#pragma unroll
            for (int j = 0; j < 4; ++j) { const u32x2 w = xr[64 * j]; v[j] = (f32x4){bflo(w.x), bfhi(w.x), bflo(w.y), bfhi(w.y)}; }
        } else { const GAS f32x4* xr = (const GAS f32x4*)((const float*)xv + (size_t)m * DM) + F.lane;
#pragma unroll
            for (int j = 0; j < 4; ++j) v[j] = xr[64 * j]; }
#pragma unroll
        for (int j = 0; j < 4; ++j) s += (v[j].x * v[j].x + v[j].y * v[j].y) + (v[j].z * v[j].z + v[j].w * v[j].w);
        const float r = 1.0f / sqrtf(wave_sum(s) * (1.f / DM) + EPS);
        u32x2* o8 = (u32x2*)(out + (size_t)m * DM) + F.lane;
#pragma unroll
        for (int j = 0; j < 4; ++j) { u32x2 w; w.x = cvtpk_(v[j].x * r * gv[j].x, v[j].y * r * gv[j].y); w.y = cvtpk_(v[j].z * r * gv[j].z, v[j].w * r * gv[j].w); o8[64 * j] = w; }
    }
}
DI float log_sigmoid(float x) {
    const float ax = fabsf(x), y = fexp(-ax);
    float l1p;
    if (y < 0.06f) l1p = y * (1.f - y * (0.5f - y * (0.33333333f - y * (0.25f - y * 0.2f))));
    else l1p = __builtin_amdgcn_logf(1.f + y) * 0.69314718056f;
    return fminf(x, 0.f) - l1p;
}
DI void phase_token(Frame& F, const Args& a, int l, const int probe) {
    F.refresh();
    const int gw0 = F.bid * NWAVES + F.wave, NGW = F.G * NWAVES, NSC = CB * 4, NCV = NGW - NSC;
    const bool scanw = (F.wave == NWAVES - 1) && (F.bid < NSC);
    const int gw = scanw ? NCV : gw0 - ((gw0 >> 3) < NSC ? (gw0 >> 3) : NSC);
    if (!scanw) { if (probe != 2) {
    const bf16_t* QKRAW = (const bf16_t*)(F.ws + WS_QKRAW); bf16_t* QK = (bf16_t*)(F.ws + WS_QK);
    const bf16_t* CKV = (const bf16_t*)(F.ws + WS_CKV); float* RT = (float*)(F.ws + WS_RT);
    const float* cw = a.in[I_CW] + (size_t)l * 4 * 1024; const float* cb = a.in[I_CB] + (size_t)l * 1024;
    const int c0 = F.lane * 16;
    float w[4][16], bs[16];
#pragma unroll
    for (int j = 0; j < 4; ++j)
#pragma unroll
        for (int i = 0; i < 16; ++i) w[j][i] = cw[j * 1024 + c0 + i];
#pragma unroll
    for (int i = 0; i < 16; ++i) bs[i] = cb[c0 + i];
    const float ksc = (c0 >= 512) ? 0.08838834764831845f : 1.0f;
    for (int m = gw; m < MC; m += NCV) {
        const int t = m & (SEQ - 1);
        float accv[16];
#pragma unroll
        for (int i = 0; i < 16; ++i) accv[i] = bs[i];
        u32x4 tv[4][2];
#pragma unroll
        for (int j = 0; j < 4; ++j) { const int tt = t - 3 + j; const u32x4* p = (const u32x4*)(QKRAW + (size_t)(tt >= 0 ? m - 3 + j : m) * 1024 + c0); tv[j][0] = p[0]; tv[j][1] = p[1]; }
        const u32x2 ckv4 = *(const u32x2*)(CKV + (size_t)m * 256 + 4 * F.lane);
#pragma unroll
        for (int j = 0; j < 4; ++j) { const float on = (t - 3 + j >= 0) ? 1.f : 0.f;
            const unsigned ww[8] = {tv[j][0].x, tv[j][0].y, tv[j][0].z, tv[j][0].w, tv[j][1].x, tv[j][1].y, tv[j][1].z, tv[j][1].w};
#pragma unroll
            for (int i = 0; i < 8; ++i) { accv[2 * i] += on * w[j][2 * i] * bflo(ww[i]); accv[2 * i + 1] += on * w[j][2 * i + 1] * bfhi(ww[i]); } }
        unsigned o[8];
#pragma unroll
        for (int i = 0; i < 8; ++i) { const float x0 = accv[2 * i], x1 = accv[2 * i + 1]; o[i] = pk2(x0 * sigmoidf_(x0) * ksc, x1 * sigmoidf_(x1) * ksc); }
        u32x4* q = (u32x4*)(QK + (size_t)m * 1024 + c0); q[0] = (u32x4){o[0], o[1], o[2], o[3]}; q[1] = (u32x4){o[4], o[5], o[6], o[7]};
        { const u32x2 v = ckv4; const float a0 = bflo(v.x), a1 = bfhi(v.x), a2 = bflo(v.y), a3 = bfhi(v.y);
          const float ss = wave_sum((a0 * a0 + a1 * a1) + (a2 * a2 + a3 * a3)); if (F.lane == 0) RT[m] = 1.0f / sqrtf(ss * (1.f / 256.f) + EPS); }
    }
    } } else if (probe != 1) {
        const int sq = F.bid, b = sq >> 2, h = sq & 3, lane = F.lane; const float* IFb = (const float*)(F.ws + WS_IF) + (size_t)b * SEQ * 8;
        float* AK = (float*)(F.ws + WS_AK) + (size_t)sq * SEQ; float* MQ = (float*)(F.ws + WS_MQ) + (size_t)sq * SEQ; float* EM = (float*)(F.ws + WS_EM) + (size_t)sq * SEQ;
        LAS float* X0 = (LAS float*)F.lds; LAS float* X1 = X0 + 4160; LAS float* X2 = X1 + 4160;
#pragma unroll 1
        for (int c = 0; c < 4; ++c) { float fv[16], iv[16];
#pragma unroll
            for (int kk = 0; kk < 16; ++kk) { const size_t t = (size_t)64 * (16 * c + kk) + lane; fv[kk] = *(const GAS float*)(IFb + t * 8 + 4 + h); iv[kk] = *(const GAS float*)(IFb + t * 8 + h); }
#pragma unroll
            for (int kk = 0; kk < 16; ++kk) { const int t = 64 * (16 * c + kk) + lane; X0[t + (t >> 6)] = fv[kk]; X1[t + (t >> 6)] = iv[kk]; } }
        WSYNC();
        const int tb = 65 * lane;
        double sum = 0.0;
#pragma unroll 8
        for (int j = 0; j < 64; ++j) { const float lf = log_sigmoid(X0[tb + j]); X0[tb + j] = lf; sum += (double)lf; }
        double inc = sum;
#pragma unroll
        for (int o = 1; o < 64; o <<= 1) { const double y = shup_d(inc, o, lane); if (lane >= o) inc += y; }
        double bb = inc - sum; float mx = -INFINITY;
#pragma unroll 8
        for (int j = 0; j < 64; ++j) { bb += (double)X0[tb + j]; const float av = (float)((double)X1[tb + j] - bb); X1[tb + j] = av; X0[tb + j] = (float)bb; mx = fmaxf(mx, av); }
        float minc = mx;
#pragma unroll
        for (int o = 1; o < 64; o <<= 1) { const float y = shup_f(minc, o, lane); if (lane >= o) minc = fmaxf(minc, y); }
        float mrun = shup_f(minc, 1, lane); if (lane == 0) mrun = -INFINITY;
#pragma unroll 8
        for (int j = 0; j < 64; ++j) { mrun = fmaxf(mrun, X1[tb + j]); X2[tb + j] = mrun; X0[tb + j] = fexp(-(X0[tb + j] + mrun)); }
        WSYNC();
#pragma unroll 8
        for (int k = 0; k < 64; ++k) { const int t = 64 * k + lane, ix = t + k; AK[t] = X1[ix]; MQ[t] = X2[ix]; EM[t] = X0[ix]; }
    }
}

DI void store8(bf16_t* p, f32x4 v0, f32x4 v1) { u32x4 w; w.x = cvtpk_(v0[0], v0[1]); w.y = cvtpk_(v0[2], v0[3]); w.z = cvtpk_(v1[0], v1[1]); w.w = cvtpk_(v1[2], v1[3]); *(u32x4*)p = w; }
DI void head_norm_rope(f32x4 (&x)[2][2], bool norm, const f32x4 (&gn)[2][2], const float* cosr, const float* sinr, int fq, float scale) {
    if (norm) {
        float ss = 0.f;
#pragma unroll
        for (int bj = 0; bj < 2; ++bj)
#pragma unroll
            for (int n = 0; n < 2; ++n) ss += (x[bj][n][0] * x[bj][n][0] + x[bj][n][1] * x[bj][n][1]) + (x[bj][n][2] * x[bj][n][2] + x[bj][n][3] * x[bj][n][3]);
        ss = sum16x(ss); ss = sum32x(ss);
        const float r = 1.0f / sqrtf(ss * (1.f / 64.f) + EPS);
#pragma unroll
        for (int bj = 0; bj < 2; ++bj)
#pragma unroll
            for (int n = 0; n < 2; ++n) x[bj][n] = x[bj][n] * r * gn[bj][n];
    }
#pragma unroll
    for (int n = 0; n < 2; ++n) { const f32x4 c = *(const f32x4*)(cosr + 8 * fq + 4 * n), s = *(const f32x4*)(sinr + 8 * fq + 4 * n);
        const f32x4 x1 = x[0][n], x2 = x[1][n]; x[0][n] = (x1 * c - x2 * s) * scale; x[1][n] = (x1 * s + x2 * c) * scale; }
}
DI void head_norm_rope_cs(f32x4 (&x)[2][2], bool norm, const f32x4 (&gn)[2][2], const f32x4 (&c)[2], const f32x4 (&sn)[2], float scale) {
    if (norm) {
        float ss = 0.f;
#pragma unroll
        for (int bj = 0; bj < 2; ++bj)
#pragma unroll
            for (int n = 0; n < 2; ++n) ss += (x[bj][n][0] * x[bj][n][0] + x[bj][n][1] * x[bj][n][1]) + (x[bj][n][2] * x[bj][n][2] + x[bj][n][3] * x[bj][n][3]);
        ss = sum16x(ss); ss = sum32x(ss);
        const float r = 1.0f / sqrtf(ss * (1.f / 64.f) + EPS);
#pragma unroll
        for (int bj = 0; bj < 2; ++bj)
#pragma unroll
            for (int n = 0; n < 2; ++n) x[bj][n] = x[bj][n] * r * gn[bj][n];
    }
#pragma unroll
    for (int n = 0; n < 2; ++n) { const f32x4 x1 = x[0][n], x2 = x[1][n]; x[0][n] = (x1 * c[n] - x2 * sn[n]) * scale; x[1][n] = (x1 * sn[n] + x2 * c[n]) * scale; }
}
struct EpiInProj {
    static constexpr bool PERM = true, MIDK = false, INIT = false;
    unsigned char* ws; const float* gate_b; int layer;
    DI void operator()(const f32x4 (&acc)[2][2][4][2], const pg8::Unit& u, int wr, int wc, int fr, int fq) const {
        const int pn = u.pn; const int rowb = u.pm * 256 + wr * 64 + fr;
        if (pn < 8 || pn == 10 || pn == 16 || pn == 17) {
            size_t doff; int ldc, cb; bool sg = false;
            if (pn < 4) { doff = WS_QKRAW; ldc = 1024; cb = pn * 256; }
            else if (pn < 6) { doff = WS_VM; ldc = 512; cb = (pn - 4) * 256; }
            else if (pn < 8) { doff = WS_OM; ldc = 512; cb = (pn - 6) * 256; sg = true; }
            else if (pn == 10) { doff = WS_CKV; ldc = 256; cb = 0; }
            else { doff = WS_DV; ldc = 512; cb = (pn - 16) * 256; }
            bf16_t* dst = (bf16_t*)(ws + doff);
#pragma unroll
            for (int ai = 0; ai < 2; ++ai)
#pragma unroll
                for (int m = 0; m < 4; ++m) { bf16_t* rowp = dst + (size_t)(rowb + ai * 128 + m * 16) * ldc + cb + wc * 32 + 8 * fq;
#pragma unroll
                    for (int bj = 0; bj < 2; ++bj) { f32x4 v0 = acc[ai][bj][m][0], v1 = acc[ai][bj][m][1];
                        if (sg) {
#pragma unroll
                            for (int j = 0; j < 4; ++j) { v0[j] = sigmoidf_(v0[j]); v1[j] = sigmoidf_(v1[j]); } }
                        store8(rowp + bj * 128, v0, v1); } }
        } else if (pn == 18) {
            const float* COS = (const float*)(ws + WS_COS); const float* SIN = (const float*)(ws + WS_SIN);
            if (wc == 0) {
                bf16_t* dst = (bf16_t*)(ws + WS_IK); f32x4 gn[2][2];
#pragma unroll
                for (int bj = 0; bj < 2; ++bj)
#pragma unroll
                    for (int n = 0; n < 2; ++n) gn[bj][n] = (f32x4){1.f, 1.f, 1.f, 1.f};
#pragma unroll
                for (int ai = 0; ai < 2; ++ai)
#pragma unroll
                    for (int m = 0; m < 4; ++m) { const int row = rowb + ai * 128 + m * 16, t = row & (SEQ - 1);
                        f32x4 x[2][2] = {{acc[ai][0][m][0], acc[ai][0][m][1]}, {acc[ai][1][m][0], acc[ai][1][m][1]}};
                        head_norm_rope(x, false, gn, COS + t * 32, SIN + t * 32, fq, 1.0f);
#pragma unroll
                        for (int bj = 0; bj < 2; ++bj) store8(dst + (size_t)row * 64 + 32 * bj + 8 * fq, x[bj][0], x[bj][1]);
                        asm volatile("" ::: "memory"); }
            } else if (wc == 1) {
                float* IFp = (float*)(ws + WS_IF); float* IWp = (float*)(ws + WS_IW);
#pragma unroll
                for (int ai = 0; ai < 2; ++ai)
#pragma unroll
                    for (int m = 0; m < 4; ++m) { const int row = rowb + ai * 128 + m * 16;
                        if (fq == 0) { *(f32x4*)(IFp + (size_t)row * 8) = acc[ai][0][m][0] + *(const f32x4*)gate_b; *(f32x4*)(IFp + (size_t)row * 8 + 4) = acc[ai][0][m][1] + *(const f32x4*)(gate_b + 4); }
                        else if (fq == 1) { *(f32x4*)(IWp + (size_t)row * 4) = acc[ai][0][m][0] * 0.0625f; } }
            }
        } else {
            const float* COS = (const float*)(ws + WS_COS); const float* SIN = (const float*)(ws + WS_SIN);
            size_t doff; int gi, pn0; float scale; bool norm = true; int ldc = 512;
            if (pn < 10) { doff = WS_SQ; gi = 0; pn0 = 8; scale = C2; }
            else if (pn == 11) { doff = WS_IQ; gi = 0; pn0 = 11; scale = 1.f; norm = false; ldc = 256; }
            else if (pn < 14) { doff = WS_DQ; gi = 1; pn0 = 12; scale = C2; }
            else { doff = WS_DK; gi = 2; pn0 = 14; scale = 1.f; }
            bf16_t* dst = (bf16_t*)(ws + doff); const float* g = (const float*)(ws + WS_GAIN) + (layer * 4 + gi) * 64;
            f32x4 gn[2][2];
#pragma unroll
            for (int bj = 0; bj < 2; ++bj)
#pragma unroll
                for (int n = 0; n < 2; ++n) gn[bj][n] = *(const f32x4*)(g + 32 * bj + 8 * fq + 4 * n);
            const int head = 4 * (pn - pn0) + wc;
#pragma unroll
            for (int ai = 0; ai < 2; ++ai)
#pragma unroll
              for (int mp = 0; mp < 4; mp += 2) {
                f32x4 cc[2][2], sn[2][2];
#pragma unroll
                for (int m = 0; m < 2; ++m) { const int t = (rowb + ai * 128 + (mp + m) * 16) & (SEQ - 1);
#pragma unroll
                    for (int n = 0; n < 2; ++n) { cc[m][n] = *(const GAS f32x4*)(COS + t * 32 + 8 * fq + 4 * n); sn[m][n] = *(const GAS f32x4*)(SIN + t * 32 + 8 * fq + 4 * n); } }
#pragma unroll
                for (int m = 0; m < 2; ++m) { const int row = rowb + ai * 128 + (mp + m) * 16;
                    f32x4 x[2][2] = {{acc[ai][0][mp + m][0], acc[ai][0][mp + m][1]}, {acc[ai][1][mp + m][0], acc[ai][1][mp + m][1]}};
                    head_norm_rope_cs(x, norm, gn, cc[m], sn[m], scale);
#pragma unroll
                    for (int bj = 0; bj < 2; ++bj) store8(dst + (size_t)row * ldc + head * 64 + 32 * bj + 8 * fq, x[bj][0], x[bj][1]); }
                asm volatile("" ::: "memory");
              }
        }
    }
};
struct EpiKV {
    static constexpr bool PERM = true, MIDK = false, INIT = false;
    unsigned char* ws; int layer;
    DI void operator()(const f32x4 (&acc)[2][2][4][2], const pg8::Unit& u, int wr, int wc, int fr, int fq) const {
        const int pn = u.pn; const int rowb = u.pm * 256 + wr * 64 + fr; const float* RT = (const float*)(ws + WS_RT);
        if (pn >= 2) {
            bf16_t* dst = (bf16_t*)(ws + WS_SV);
#pragma unroll
            for (int ai = 0; ai < 2; ++ai)
#pragma unroll
                for (int m = 0; m < 4; ++m) { const int row = rowb + ai * 128 + m * 16; const float r = RT[row]; bf16_t* rowp = dst + (size_t)row * 512 + (pn - 2) * 256 + wc * 32 + 8 * fq;
#pragma unroll
                    for (int bj = 0; bj < 2; ++bj) store8(rowp + bj * 128, acc[ai][bj][m][0] * r, acc[ai][bj][m][1] * r); }
        } else {
            const float* COS = (const float*)(ws + WS_COS); const float* SIN = (const float*)(ws + WS_SIN);
            bf16_t* dst = (bf16_t*)(ws + WS_SK); f32x4 gn[2][2];
#pragma unroll
            for (int bj = 0; bj < 2; ++bj)
#pragma unroll
                for (int n = 0; n < 2; ++n) gn[bj][n] = *(const f32x4*)((const float*)(ws + WS_GAIN) + (layer * 4 + 3) * 64 + 32 * bj + 8 * fq + 4 * n);
            const int head = 4 * pn + wc;
#pragma unroll
            for (int ai = 0; ai < 2; ++ai)
#pragma unroll
              for (int mp = 0; mp < 4; mp += 2) {
                f32x4 cc[2][2], sn[2][2]; float rr[2];
#pragma unroll
                for (int m = 0; m < 2; ++m) { const int row = rowb + ai * 128 + (mp + m) * 16, t = row & (SEQ - 1); rr[m] = *(const GAS float*)(RT + row);
#pragma unroll
                    for (int n = 0; n < 2; ++n) { cc[m][n] = *(const GAS f32x4*)(COS + t * 32 + 8 * fq + 4 * n); sn[m][n] = *(const GAS f32x4*)(SIN + t * 32 + 8 * fq + 4 * n); } }
#pragma unroll
                for (int m = 0; m < 2; ++m) { const int row = rowb + ai * 128 + (mp + m) * 16; const float r = rr[m];
                    f32x4 x[2][2] = {{acc[ai][0][mp + m][0] * r, acc[ai][0][mp + m][1] * r}, {acc[ai][1][mp + m][0] * r, acc[ai][1][mp + m][1] * r}};
                    head_norm_rope_cs(x, true, gn, cc[m], sn[m], 1.0f);
#pragma unroll
                    for (int bj = 0; bj < 2; ++bj) store8(dst + (size_t)row * 512 + head * 64 + 32 * bj + 8 * fq, x[bj][0], x[bj][1]); }
                asm volatile("" ::: "memory");
              }
        }
    }
};
DI size_t gq_off(int pm, int png, int wave, int am, int lane) { return ((((size_t)pm * 12 + png) * 8 + wave) * 8 + am) * 1024 + (size_t)lane * 16; }
struct EpiGate {
    static constexpr bool PERM = true, MIDK = false, INIT = false;
    unsigned char* G; const float* bias;
    DI void operator()(const f32x4 (&acc)[2][2][4][2], const pg8::Unit& u, int wr, int wc, int fr, int fq) const {
        const int col0 = u.pn * 256 + wc * 32 + 8 * fq, wave = wr * 4 + wc, lane = fq * 16 + fr;
        f32x4 bv[2][2];
#pragma unroll
        for (int bj = 0; bj < 2; ++bj)
#pragma unroll
            for (int n = 0; n < 2; ++n) bv[bj][n] = *(const f32x4*)(bias + col0 + bj * 128 + 4 * n);
#pragma unroll
        for (int ai = 0; ai < 2; ++ai)
#pragma unroll
            for (int m = 0; m < 4; ++m) { unsigned w[4];
#pragma unroll
                for (int bj = 0; bj < 2; ++bj)
#pragma unroll
                    for (int n = 0; n < 2; ++n) { const f32x4 v = acc[ai][bj][m][n] + bv[bj][n]; unsigned q = 0u;
#pragma unroll
                        for (int j = 0; j < 4; ++j) q = __builtin_amdgcn_cvt_pk_u8_f32(sigmoidf_(v[j]) * 255.0f, j, q);
                        w[2 * bj + n] = q; }
                *(u32x4*)(G + gq_off(u.pm, u.pn, wave, ai * 4 + m, lane)) = (u32x4){w[0], w[1], w[2], w[3]}; }
    }
};
struct EpiMerge {
    static constexpr bool PERM = true, MIDK = true, INIT = false;
    const unsigned char* G; bf16_t* MG;
    DI static float ub(unsigned w, int k) { return (float)((w >> (8 * k)) & 0xFFu); }
    DI void mid(f32x4 (&acc)[2][2][4][2], const pg8::Unit& u, int t, int wr, int wc, int fr, int fq) const {
        const int seg = (t >> 3) - 1, wave = wr * 4 + wc, lane = fq * 16 + fr;
#pragma unroll
        for (int ai = 0; ai < 2; ++ai) {
            u32x4 ga[4], gb[4];
#pragma unroll
            for (int m = 0; m < 4; ++m) { ga[m] = *(const GAS u32x4*)(G + gq_off(u.pm, seg * 4 + u.pn, wave, ai * 4 + m, lane)); gb[m] = *(const GAS u32x4*)(G + gq_off(u.pm, (seg + 1) * 4 + u.pn, wave, ai * 4 + m, lane)); }
#pragma unroll
            for (int m = 0; m < 4; ++m) { const unsigned aw[4] = {ga[m].x, ga[m].y, ga[m].z, ga[m].w}, bw[4] = {gb[m].x, gb[m].y, gb[m].z, gb[m].w};
#pragma unroll
                for (int bj = 0; bj < 2; ++bj)
#pragma unroll
                    for (int n = 0; n < 2; ++n)
#pragma unroll
                        for (int j = 0; j < 4; ++j) acc[ai][bj][m][n][j] *= fmaxf(ub(aw[2 * bj + n], j), 1e-6f) * frcp(fmaxf(ub(bw[2 * bj + n], j), 1e-6f)); }
            asm volatile("" ::: "memory");
        }
    }
    DI void operator()(const f32x4 (&acc)[2][2][4][2], const pg8::Unit& u, int wr, int wc, int fr, int fq) const {
        const int rowb = u.pm * 256 + wr * 64 + fr, col0 = u.pn * 256 + wc * 32 + 8 * fq, wave = wr * 4 + wc, lane = fq * 16 + fr;
#pragma unroll
        for (int ai = 0; ai < 2; ++ai) {
            u32x4 gc[4];
#pragma unroll
            for (int m = 0; m < 4; ++m) gc[m] = *(const GAS u32x4*)(G + gq_off(u.pm, 8 + u.pn, wave, ai * 4 + m, lane));
#pragma unroll
            for (int m = 0; m < 4; ++m) { const unsigned cw[4] = {gc[m].x, gc[m].y, gc[m].z, gc[m].w};
#pragma unroll
                for (int bj = 0; bj < 2; ++bj) { f32x4 v0 = acc[ai][bj][m][0], v1 = acc[ai][bj][m][1];
#pragma unroll
                    for (int j = 0; j < 4; ++j) { v0[j] *= fmaxf(ub(cw[2 * bj], j), 1e-6f) * (1.0f / 255.0f); v1[j] *= fmaxf(ub(cw[2 * bj + 1], j), 1e-6f) * (1.0f / 255.0f); }
                    store8(MG + (size_t)(rowb + ai * 128 + m * 16) * 1024 + col0 + bj * 128, v0, v1); } }
            asm volatile("" ::: "memory");
        }
    }
};
struct EpiResid {
    static constexpr bool PERM = true, MIDK = false, INIT = true;
    const void* base; void* out; bool in16, out16;
    DI void init(f32x4 (&acc)[2][2][4][2], const pg8::Unit& u, int wr, int wc, int fr, int fq) const {
        const int rowb = u.pm * 256 + wr * 64 + fr, col0 = u.pn * 256 + wc * 32 + 8 * fq;
#pragma unroll
        for (int ai = 0; ai < 2; ++ai)
#pragma unroll
            for (int m = 0; m < 4; ++m) { const size_t off = (size_t)(rowb + ai * 128 + m * 16) * DM + col0;
#pragma unroll
                for (int bj = 0; bj < 2; ++bj) {
                    if (in16) { const u32x4 w = *(const GAS u32x4*)((const bf16_t*)base + off + bj * 128);
                        acc[ai][bj][m][0] = (f32x4){bflo(w.x), bfhi(w.x), bflo(w.y), bfhi(w.y)}; acc[ai][bj][m][1] = (f32x4){bflo(w.z), bfhi(w.z), bflo(w.w), bfhi(w.w)}; }
                    else { acc[ai][bj][m][0] = *(const GAS f32x4*)((const float*)base + off + bj * 128); acc[ai][bj][m][1] = *(const GAS f32x4*)((const float*)base + off + bj * 128 + 4); } } }
    }
    DI void operator()(const f32x4 (&acc)[2][2][4][2], const pg8::Unit& u, int wr, int wc, int fr, int fq) const {
        const int rowb = u.pm * 256 + wr * 64 + fr, col0 = u.pn * 256 + wc * 32 + 8 * fq;
#pragma unroll
        for (int ai = 0; ai < 2; ++ai)
#pragma unroll
            for (int m = 0; m < 4; ++m) { const size_t off = (size_t)(rowb + ai * 128 + m * 16) * DM + col0;
#pragma unroll
                for (int bj = 0; bj < 2; ++bj) {
                    if (out16) store8((bf16_t*)out + off + bj * 128, acc[ai][bj][m][0], acc[ai][bj][m][1]);
                    else { *(f32x4*)((float*)out + off + bj * 128) = acc[ai][bj][m][0]; *(f32x4*)((float*)out + off + bj * 128 + 4) = acc[ai][bj][m][1]; } } }
    }
};
struct EpiSwiGLU {
    static constexpr bool PERM = true, MIDK = false, INIT = false;
    bf16_t* H;
    DI void operator()(const f32x4 (&acc)[2][2][4][2], const pg8::Unit& u, int wr, int wc, int fr, int fq) const {
        const int rowb = u.pm * 256 + wr * 64 + fr, col0 = u.pn * 128 + wc * 32 + 8 * fq;
#pragma unroll
        for (int ai = 0; ai < 2; ++ai)
#pragma unroll
            for (int m = 0; m < 4; ++m) { f32x4 v0, v1;
#pragma unroll
                for (int j = 0; j < 4; ++j) { const float g0 = acc[ai][0][m][0][j], g1 = acc[ai][0][m][1][j]; v0[j] = g0 * sigmoidf_(g0) * acc[ai][1][m][0][j]; v1[j] = g1 * sigmoidf_(g1) * acc[ai][1][m][1][j]; }
                store8(H + (size_t)(rowb + ai * 128 + m * 16) * FF + col0, v0, v1); }
    }
};

DI unsigned mono_key(float f) { const unsigned u = __float_as_uint(f + 0.0f); return u ^ ((unsigned)((int)u >> 31) | 0x80000000u); }
DI unsigned pack_mask(unsigned long long bm, int h) {
    unsigned r = 0;
#pragma unroll
    for (int p = 0; p < 2; ++p)
#pragma unroll
        for (int g = 0; g < 4; ++g) r |= (unsigned)((bm >> (32 * p + 8 * g + 4 * h)) & 0xFull) << (16 * p + 4 * g);
    return r;
}
DI unsigned long long unpack_mask(unsigned w0, unsigned w1) {
    unsigned long long bm = 0;
#pragma unroll
    for (int p = 0; p < 2; ++p)
#pragma unroll
        for (int g = 0; g < 4; ++g) { bm |= (unsigned long long)((w0 >> (16 * p + 4 * g)) & 0xFu) << (32 * p + 8 * g); bm |= (unsigned long long)((w1 >> (16 * p + 4 * g)) & 0xFu) << (32 * p + 8 * g + 4); }
    return bm;
}
DI void ld8f(const bf16_t* p, float (&g)[8]) { const u32x4 w = *(const u32x4*)p; g[0] = bflo(w.x); g[1] = bfhi(w.x); g[2] = bflo(w.y); g[3] = bfhi(w.y); g[4] = bflo(w.z); g[5] = bfhi(w.z); g[6] = bflo(w.w); g[7] = bfhi(w.w); }

DI void naive_select(Frame& F) {
    F.refresh();
    if (F.wave >= 4) return;
    const int gw = F.bid * 4 + F.wave, NGW = F.G * 4;
    LAS unsigned char* wl = F.lds + F.wave * 20480;
    LAS float* sc = (LAS float*)wl; LAS float* iqf = (LAS float*)(wl + 16384); LAS unsigned* hist = (LAS unsigned*)(wl + 16384 + 1024);
    const bf16_t* IQ = (const bf16_t*)(F.ws + WS_IQ); const bf16_t* IK = (const bf16_t*)(F.ws + WS_IK); const float* IW = (const float*)(F.ws + WS_IW);
    unsigned* MASK = (unsigned*)(F.ws + WS_MASK);
    const int lane = F.lane;
    for (int row = gw; row < MC; row += NGW) {
        const int b = row >> 12, t = row & (SEQ - 1), n = t + 1;
        { const u32x2 v = *(const u32x2*)(IQ + (size_t)row * 256 + 4 * lane); iqf[4 * lane] = bflo(v.x); iqf[4 * lane + 1] = bfhi(v.x); iqf[4 * lane + 2] = bflo(v.y); iqf[4 * lane + 3] = bfhi(v.y); }
        const f32x4 wv = *(const f32x4*)(IW + (size_t)row * 4);
        WSYNC();
        for (int s = lane; s < n; s += 64) {
            const bf16_t* kr = IK + ((size_t)b * SEQ + s) * 64;
            float d0 = 0.f, d1 = 0.f, d2 = 0.f, d3 = 0.f;
#pragma unroll
            for (int c = 0; c < 8; ++c) { float kv[8]; ld8f(kr + 8 * c, kv);
#pragma unroll
                for (int j = 0; j < 8; ++j) { const float k = kv[j]; d0 += iqf[8 * c + j] * k; d1 += iqf[64 + 8 * c + j] * k; d2 += iqf[128 + 8 * c + j] * k; d3 += iqf[192 + 8 * c + j] * k; } }
            sc[s] = wv[0] * fmaxf(d0, 0.f) + wv[1] * fmaxf(d1, 0.f) + wv[2] * fmaxf(d2, 0.f) + wv[3] * fmaxf(d3, 0.f);
        }
        WSYNC();
        unsigned thr = 0u; int need = 256;
        if (n > 256) {
            unsigned prefix = 0u, pmask = 0u;
            for (int pass = 0; pass < 4; ++pass) {
                const int shift = 24 - 8 * pass;
                { unsigned z_ = 0u; asm volatile("" : "+v"(z_)); hist[lane] = z_; hist[lane + 64] = z_; hist[lane + 128] = z_; hist[lane + 192] = z_; }
                WSYNC();
                for (int s = lane; s < n; s += 64) { const unsigned key = mono_key(sc[s]); if ((key & pmask) == prefix) __hip_atomic_fetch_add(&hist[(key >> shift) & 255u], 1u, __ATOMIC_RELAXED, __HIP_MEMORY_SCOPE_WORKGROUP); }
                WSYNC();
                const unsigned c0 = hist[4 * lane], c1 = hist[4 * lane + 1], c2 = hist[4 * lane + 2], c3 = hist[4 * lane + 3];
                const unsigned ls = c0 + c1 + c2 + c3; unsigned inc = ls;
#pragma unroll
                for (int o = 1; o < 64; o <<= 1) { const unsigned y = __shfl_up(inc, o); if (lane >= o) inc += y; }
                const unsigned total = __shfl(inc, 63);
                unsigned cum = total - inc;
                int fbin = -1; unsigned fneed = 0u;
                const unsigned cc[4] = {c0, c1, c2, c3};
#pragma unroll
                for (int bq = 3; bq >= 0; --bq) { if (fbin < 0 && cum < (unsigned)need && cum + cc[bq] >= (unsigned)need) { fbin = 4 * lane + bq; fneed = (unsigned)need - cum; } cum += cc[bq]; }
                const unsigned long long fm = __ballot(fbin >= 0);
                const int src = __ffsll((long long)fm) - 1;
                const int bin = __shfl(fbin, src); need = (int)__shfl(fneed, src);
                prefix |= (unsigned)bin << shift; pmask |= 0xFFu << shift;
                WSYNC();
            }
            thr = prefix;
        }
        int eqc = 0;
        for (int i = 0; i < 64; ++i) {
            const int s = 64 * i + lane; bool sel = false;
            if (64 * i < n) {
                const bool valid = s < n;
                if (n <= 256) sel = valid;
                else { const unsigned key = valid ? mono_key(sc[s]) : 0u; const bool eq = valid && key == thr; const unsigned long long em = __ballot(eq);
                    const int rank = eqc + __popcll(em & ((1ull << lane) - 1ull)); sel = valid && (key > thr || (eq && rank < need)); eqc += __popcll(em); }
            }
            const unsigned long long bm = __ballot(sel);
            if (lane == 0) { MASK[((size_t)row * 2 + 0) * 64 + i] = pack_mask(bm, 0); MASK[((size_t)row * 2 + 1) * 64 + i] = pack_mask(bm, 1); }
        }
        WSYNC();
    }
}
DI void naive_dsa(Frame& F) {
    F.refresh();
    if (F.wave >= 4) return;
    const int gw = F.bid * 4 + F.wave, NGW = F.G * 4;
    LAS unsigned char* wl = F.lds + F.wave * 20480;
    LAS float* sc = (LAS float*)wl;
    LAS float* sqf = (LAS float*)(wl + 8192);
    LAS unsigned* list = (LAS unsigned*)(wl + 8192 + 2048);
    LAS float* invs = (LAS float*)(wl + 8192 + 2048 + 2048);
    const bf16_t* SQ = (const bf16_t*)(F.ws + WS_SQ); const bf16_t* SK = (const bf16_t*)(F.ws + WS_SK); const bf16_t* SV = (const bf16_t*)(F.ws + WS_SV);
    const unsigned* MASK = (const unsigned*)(F.ws + WS_MASK); bf16_t* Y = (bf16_t*)(F.ws + WS_Y);
    const int lane = F.lane;
    for (int row = gw; row < MC; row += NGW) {
        const int b = row >> 12, t = row & (SEQ - 1);
        { float q[8]; ld8f(SQ + (size_t)row * 512 + 8 * lane, q);
#pragma unroll
          for (int j = 0; j < 8; ++j) sqf[8 * lane + j] = q[j]; }
        int nsel = 0;
        for (int i = 0; i <= (t >> 6); ++i) {
            const unsigned w0 = MASK[((size_t)row * 2 + 0) * 64 + i], w1 = MASK[((size_t)row * 2 + 1) * 64 + i];
            const unsigned long long bm = unpack_mask(w0, w1);
            const bool sel = (bm >> lane) & 1ull;
            const int pos = nsel + __popcll(bm & ((1ull << lane) - 1ull));
            if (sel && pos < 256) list[pos] = (unsigned)(64 * i + lane);
            nsel += __popcll(bm);
        }
        if (nsel > 256) nsel = 256;
        WSYNC();
        for (int k = lane; k < nsel; k += 64) {
            const bf16_t* kr = SK + ((size_t)b * SEQ + list[k]) * 512;
#pragma unroll 1
            for (int h = 0; h < 8; ++h) { float d = 0.f;
#pragma unroll
                for (int c = 0; c < 8; ++c) { float kv[8]; ld8f(kr + h * 64 + 8 * c, kv);
#pragma unroll
                    for (int j = 0; j < 8; ++j) d += sqf[h * 64 + 8 * c + j] * kv[j]; }
                sc[h * 256 + k] = d; }
        }
        WSYNC();
#pragma unroll 1
        for (int h = 0; h < 8; ++h) {
            float mx = -INFINITY; for (int k = lane; k < nsel; k += 64) mx = fmaxf(mx, sc[h * 256 + k]);
            mx = wave_max(mx); float sum = 0.f;
            for (int k = lane; k < nsel; k += 64) { const float p = fexp2(sc[h * 256 + k] - mx); sc[h * 256 + k] = p; sum += p; }
            sum = wave_sum(sum); if (lane == 0) invs[h] = 1.0f / sum;
        }
        WSYNC();
        { const int h = lane >> 3, d0 = (lane & 7) * 8; float accv[8] = {0.f, 0.f, 0.f, 0.f, 0.f, 0.f, 0.f, 0.f};
          for (int k = 0; k < nsel; ++k) { const float p = sc[h * 256 + k]; float v[8]; ld8f(SV + ((size_t)b * SEQ + list[k]) * 512 + h * 64 + d0, v);
#pragma unroll
              for (int j = 0; j < 8; ++j) accv[j] += p * v[j]; }
          const float inv = invs[h];
          u32x4 o; o.x = pk2(accv[0] * inv, accv[1] * inv); o.y = pk2(accv[2] * inv, accv[3] * inv); o.z = pk2(accv[4] * inv, accv[5] * inv); o.w = pk2(accv[6] * inv, accv[7] * inv);
          *(u32x4*)(Y + (size_t)row * 1536 + 512 + h * 64 + d0) = o; }
        WSYNC();
    }
}
DI void naive_mlstm(Frame& F, const Args& a, int l) {
    F.refresh();
    const int gw = F.bid * NWAVES + F.wave, NGW = F.G * NWAVES;
    LAS unsigned char* wl = F.lds + F.wave * 16384;
    LAS float* pl = (LAS float*)wl;
    const bf16_t* QK = (const bf16_t*)(F.ws + WS_QK); const bf16_t* VM = (const bf16_t*)(F.ws + WS_VM); const bf16_t* OM = (const bf16_t*)(F.ws + WS_OM);
    const float* AK = (const float*)(F.ws + WS_AK); const float* MQ = (const float*)(F.ws + WS_MQ); const float* EM = (const float*)(F.ws + WS_EM);
    bf16_t* Y = (bf16_t*)(F.ws + WS_Y); const float* mng = a.in[I_MNG] + (size_t)l * 512;
    const int lane = F.lane;
    for (int qi = gw; qi < MC * 4; qi += NGW) {
        const int row = qi >> 2, h = qi & 3, b = row >> 12, t = row & (SEQ - 1), seq = b * 4 + h;
        const unsigned qw = *(const unsigned*)(QK + (size_t)row * 1024 + h * 128 + 2 * lane);
        const float q0 = bflo(qw), q1 = bfhi(qw);
        const float Mt = MQ[(size_t)seq * SEQ + t];
        float denp = 0.f;
        for (int s0 = 0; s0 <= t; s0 += 64) {
            const int s = s0 + lane; const bool valid = s <= t; const int sr = valid ? s : t;
            const bf16_t* kr = QK + ((size_t)b * SEQ + sr) * 1024 + 512 + h * 128;
            float d = 0.f;
#pragma unroll 4
            for (int c = 0; c < 16; ++c) { float kv[8]; ld8f(kr + 8 * c, kv);
#pragma unroll
                for (int j = 0; j < 4; ++j) { d += __shfl(q0, 4 * c + j) * kv[2 * j] + __shfl(q1, 4 * c + j) * kv[2 * j + 1]; } }
            const float p = valid ? d * fexp(AK[(size_t)seq * SEQ + sr] - Mt) : 0.f;
            pl[s] = p;
            denp += p;
        }
        const float den = wave_sum(denp);
        WSYNC();
        float a0 = 0.f, a1 = 0.f;
        for (int s = 0; s <= t; ++s) { const float p = pl[s]; const unsigned vw = *(const unsigned*)(VM + ((size_t)b * SEQ + s) * 512 + h * 128 + 2 * lane); a0 += p * bflo(vw); a1 += p * bfhi(vw); }
        const float hd = fmaxf(fabsf(den), EM[(size_t)seq * SEQ + t]);
        a0 /= hd; a1 /= hd;
        const float ss = wave_sum(a0 * a0 + a1 * a1); const float r = 1.0f / sqrtf(ss * (1.f / 128.f) + EPS);
        const unsigned ow = *(const unsigned*)(OM + (size_t)row * 512 + h * 128 + 2 * lane);
        const float y0 = a0 * r * mng[h * 128 + 2 * lane] * bflo(ow), y1 = a1 * r * mng[h * 128 + 2 * lane + 1] * bfhi(ow);
        *(unsigned*)(Y + (size_t)row * 1536 + h * 128 + 2 * lane) = pk2(y0, y1);
        WSYNC();
    }
}
DI void naive_diff(Frame& F, const Args& a, int l) {
    F.refresh();
    if (F.wave >= 4) return;
    const int gw = F.bid * 4 + F.wave, NGW = F.G * 4;
    LAS unsigned char* wl = F.lds + F.wave * 32768;
    LAS float* p0 = (LAS float*)wl; LAS float* p1 = (LAS float*)(wl + 16384);
    const bf16_t* DQ = (const bf16_t*)(F.ws + WS_DQ); const bf16_t* DK = (const bf16_t*)(F.ws + WS_DK); const bf16_t* DV = (const bf16_t*)(F.ws + WS_DV);
    bf16_t* Y = (bf16_t*)(F.ws + WS_Y); const float* dog = a.in[I_DOG] + (size_t)l * 128; const float* lam = a.in[I_LAM] + (size_t)l * 256;
    const int lane = F.lane;
    const float lam_init = (l == 0) ? 0.2f : 0.35550906759096934f;
    const float s01 = wave_sum(lam[lane] * lam[64 + lane]), s23 = wave_sum(lam[128 + lane] * lam[192 + lane]);
    const float lam_val = fexp(s01) - fexp(s23) + lam_init;
    for (int qi = gw; qi < MC * 4; qi += NGW) {
        const int row = qi >> 2, h = qi & 3, b = row >> 12, t = row & (SEQ - 1);
        const float qa = bf2f(DQ[(size_t)row * 512 + (2 * h) * 64 + lane]), qb = bf2f(DQ[(size_t)row * 512 + (2 * h + 1) * 64 + lane]);
        float mx0 = -INFINITY, mx1 = -INFINITY;
        for (int s0 = 0; s0 <= t; s0 += 64) {
            const int s = s0 + lane; const bool valid = s <= t; const int sr = valid ? s : t;
            const bf16_t* kr = DK + ((size_t)b * SEQ + sr) * 512 + (2 * h) * 64;
            float d0 = 0.f, d1 = 0.f;
#pragma unroll 4
            for (int c = 0; c < 8; ++c) { float ka[8], kb[8]; ld8f(kr + 8 * c, ka); ld8f(kr + 64 + 8 * c, kb);
#pragma unroll
                for (int j = 0; j < 8; ++j) { d0 += __shfl(qa, 8 * c + j) * ka[j]; d1 += __shfl(qb, 8 * c + j) * kb[j]; } }
            if (valid) { p0[s] = d0; p1[s] = d1; mx0 = fmaxf(mx0, d0); mx1 = fmaxf(mx1, d1); }
        }
        mx0 = wave_max(mx0); mx1 = wave_max(mx1);
        WSYNC();
        float sm0 = 0.f, sm1 = 0.f;
        for (int s = lane; s <= t; s += 64) { const float e0 = fexp2(p0[s] - mx0), e1 = fexp2(p1[s] - mx1); p0[s] = e0; p1[s] = e1; sm0 += e0; sm1 += e1; }
        const float i0 = 1.0f / wave_sum(sm0), i1 = lam_val / wave_sum(sm1);
        WSYNC();
        float a0 = 0.f, a1 = 0.f;
        for (int s = 0; s <= t; ++s) { const float av = p0[s] * i0 - p1[s] * i1; const unsigned vw = *(const unsigned*)(DV + ((size_t)b * SEQ + s) * 512 + h * 128 + 2 * lane); a0 += av * bflo(vw); a1 += av * bfhi(vw); }
        const float ss = wave_sum(a0 * a0 + a1 * a1); const float r = 1.0f / sqrtf(ss * (1.f / 128.f) + EPS) * (1.0f - lam_init);
        *(unsigned*)(Y + (size_t)row * 1536 + 1024 + h * 128 + 2 * lane) = pk2(a0 * r * dog[2 * lane], a1 * r * dog[2 * lane + 1]);
        WSYNC();
    }
}

typedef float f32x16 __attribute__((ext_vector_type(16)));
typedef short s16x4 __attribute__((ext_vector_type(4)));
typedef __bf16 bf16x2_t __attribute__((ext_vector_type(2)));
DI unsigned cvtpk(float lo, float hi) { f32x2 v = {lo, hi}; bf16x2_t b = __builtin_convertvector(v, bf16x2_t); return __builtin_bit_cast(unsigned, b); }
#define MFMA32(a, b, c) __builtin_amdgcn_mfma_f32_32x32x16_bf16((a), (b), (c), 0, 0, 0)
#define SBAR() __builtin_amdgcn_sched_barrier(0)
DI s16x4 trread(LAS const unsigned char* p) { return __builtin_bit_cast(s16x4, __builtin_amdgcn_ds_read_tr16_b64_v4i16((LAS s16x4*)p)); }
#ifndef MIXMODES
#define MIXMODES 7
#endif
constexpr int CW_QUEUE = 8192;
constexpr int ATT_WSF_OFF = RING_BYTES + 1024;
constexpr float NEGBIG = -1.0e30f;
constexpr float RESC_THR = 16.0f;

DI float max3f(float a, float b, float c) { float r_; asm("v_max3_f32 %0, %1, %2, %3" : "=v"(r_) : "v"(a), "v"(b), "v"(c)); return r_; }
template <int MODE>
DI void attn_qk(f32x16& s0, f32x16& s1, const bf16x8 (&qf)[MODE == 2 ? 8 : 4], LAS const unsigned char* kb, int koff, int j, int q0w, int r, int h, unsigned mw, const bool DIAG) {
    constexpr int KW = MODE == 0 ? 64 : 128, DQK = MODE == 2 ? 128 : 64, DV = MODE == 0 ? 64 : 128, KROWB = KW * 2 + 16, VROWB = MODE == 0 ? 192 : 320, KBYTES = 64 * KROWB, VBYTES = 64 * VROWB;
    constexpr int NKS = DQK / 16, NVB = DV / 32;
    (void)KBYTES; (void)VBYTES; (void)NVB;
    bf16x8 kf[8];
#pragma unroll
    for (int s = 0; s < 4; ++s) { kf[2 * s] = *(LAS const bf16x8*)(kb + koff + 32 * s); kf[2 * s + 1] = *(LAS const bf16x8*)(kb + koff + 32 * KROWB + 32 * s); }
    SBAR();
    if (MODE == 0) {
        const unsigned nmw = ~mw;
#define CI_(i) { int a_, b_; asm("v_bfe_i32 %0, %1, " #i ", 1" : "=v"(a_) : "v"(nmw)); asm("v_bfe_i32 %0, %1, 16+" #i ", 1" : "=v"(b_) : "v"(nmw)); \
                 s0[i] = __uint_as_float((unsigned)a_ & 0xF149F2CAu); s1[i] = __uint_as_float((unsigned)b_ & 0xF149F2CAu); }
        CI_(0) CI_(1) CI_(2) CI_(3) CI_(4) CI_(5) CI_(6) CI_(7) CI_(8) CI_(9) CI_(10) CI_(11) CI_(12) CI_(13) CI_(14) CI_(15)
#undef CI_
    } else if (MODE == 1 && DIAG) {
        const int qd = q0w + r - 64 * j;
#pragma unroll
        for (int i = 0; i < 16; ++i) { const int kk = (i & 3) + 8 * (i >> 2) + 4 * h; s0[i] = kk > qd ? NEGBIG : 0.f; s1[i] = kk + 32 > qd ? NEGBIG : 0.f; }
    } else {
#pragma unroll
        for (int i = 0; i < 16; ++i) { s0[i] = 0.f; s1[i] = 0.f; }
    }
    SBAR();
#pragma unroll
    for (int g = 0; g < NKS / 2; ++g) {
#pragma unroll
        for (int e = 0; e < 2; ++e) { const int s = 2 * g + e; s0 = MFMA32(kf[(4 * g + 2 * e) & 7], qf[s], s0); s1 = MFMA32(kf[(4 * g + 2 * e + 1) & 7], qf[s], s1); }
        if (g + 2 < NKS / 2) {
#pragma unroll
            for (int e = 0; e < 2; ++e) { const int s = 2 * (g + 2) + e;
                kf[(4 * g + 2 * e) & 7] = *(LAS const bf16x8*)(kb + koff + 32 * s); kf[(4 * g + 2 * e + 1) & 7] = *(LAS const bf16x8*)(kb + koff + 32 * KROWB + 32 * s); }
        }
        SBAR();
    }
}
template <int MODE>
DI void attn_pv(f32x16 (&o)[MODE == 0 ? 2 : 4], float& lsum, float& mref, f32x16& s0, f32x16& s1, LAS const unsigned char* vb, int voff,
                int j, int q0w, int r, int h, float M2, LAS float* wsf, const bool DIAG, const int probe) {
    constexpr int DV = MODE == 0 ? 64 : 128, VROWB = MODE == 0 ? 192 : 320, VBYTES = 64 * VROWB;
    constexpr int NVB = DV / 32;
    LAS const unsigned char* ab = vb + VBYTES;
    bf16x8 vfr[NVB > 2 ? 2 : 1][8];
#define VLOAD_(bb) do { _Pragma("unroll") for (int v_ = 0; v_ < 2; ++v_) _Pragma("unroll") for (int p_ = 0; p_ < 2; ++p_) _Pragma("unroll") for (int s2_ = 0; s2_ < 2; ++s2_) { \
        const s16x4 lo_ = trread(vb + voff + (32 * p_ + 16 * s2_) * VROWB + 64 * (2 * (bb) + v_)), hi_ = trread(vb + voff + (32 * p_ + 16 * s2_ + 8) * VROWB + 64 * (2 * (bb) + v_)); \
        vfr[(bb) & (NVB > 2 ? 1 : 0)][4 * v_ + 2 * p_ + s2_] = (bf16x8){lo_[0], lo_[1], lo_[2], lo_[3], hi_[0], hi_[1], hi_[2], hi_[3]}; } } while (0)
    if (probe != 3) VLOAD_(0);
    SBAR();
    if (MODE == 2) {
        float part = 0.f;
        if (DIAG) {
            const int qd = q0w + r - 64 * j;
#pragma unroll
            for (int g = 0; g < 4; ++g) {
                const f32x4 a0 = *(LAS const f32x4*)(ab + (8 * g + 4 * h) * 4), a1 = *(LAS const f32x4*)(ab + (32 + 8 * g + 4 * h) * 4);
#pragma unroll
                for (int e = 0; e < 4; ++e) { const int i = 4 * g + e, kk = 8 * g + 4 * h + e;
                    float w0 = fexp2(a0[e] - M2), w1 = fexp2(a1[e] - M2);
                    if (kk > qd) w0 = 0.f; if (kk + 32 > qd) w1 = 0.f;
                    s0[i] *= w0; s1[i] *= w1; part += s0[i] + s1[i]; }
            }
        } else {
#pragma unroll
            for (int g = 0; g < 4; ++g) {
                const f32x4 a0 = *(LAS const f32x4*)(ab + (8 * g + 4 * h) * 4), a1 = *(LAS const f32x4*)(ab + (32 + 8 * g + 4 * h) * 4);
#pragma unroll
                for (int e = 0; e < 4; ++e) { const int i = 4 * g + e;
                    s0[i] *= fexp2(a0[e] - M2); s1[i] *= fexp2(a1[e] - M2); part += s0[i] + s1[i]; }
            }
        }
        lsum += part;
    } else {
        if (probe != 2) {
        asm volatile("s_nop 15\n\ts_nop 7" : "+v"(s0), "+v"(s1));
        float ta = max3f(s0[0], s0[1], s1[0]), tb = max3f(s0[2], s0[3], s1[1]); ta = max3f(ta, s1[2], s1[3]);
#pragma unroll
        for (int i = 4; i < 16; i += 4) { ta = max3f(ta, s0[i], s0[i + 1]); tb = max3f(tb, s0[i + 2], s0[i + 3]); ta = max3f(ta, s1[i], s1[i + 1]); tb = max3f(tb, s1[i + 2], s1[i + 3]); }
        float tm = max3f(ta, tb, tb); tm = max32x(tm);
        if (__any(tm > mref + RESC_THR)) {
            const float nm = tm > mref + RESC_THR ? tm : mref, al = fexp2(mref - nm);
            mref = nm; lsum *= al;
            if (h == 0) wsf[r] = al;
            WSYNC();
#pragma unroll
            for (int g = 0; g < 4; ++g) { const f32x4 av = *(LAS const f32x4*)(wsf + 8 * g + 4 * h);
#pragma unroll
                for (int v = 0; v < NVB; ++v)
#pragma unroll
                    for (int e = 0; e < 4; ++e) o[v][4 * g + e] *= av[e]; }
            WSYNC();
        }
        if (__any(mref != 0.f)) {
#pragma unroll
            for (int i = 0; i < 16; ++i) { s0[i] -= mref; s1[i] -= mref; }
        }
        float part = 0.f;
#pragma unroll
        for (int i = 0; i < 16; ++i) { s0[i] = fexp2(s0[i]); s1[i] = fexp2(s1[i]); part += s0[i] + s1[i]; }
        lsum += part;
        }
    }
    bf16x8 pf[2][2];
#pragma unroll
    for (int s2 = 0; s2 < 2; ++s2) {
        u32x4 t0, t1;
        t0.x = cvtpk(s0[8 * s2 + 0], s0[8 * s2 + 1]); t0.y = cvtpk(s0[8 * s2 + 2], s0[8 * s2 + 3]); t0.z = cvtpk(s0[8 * s2 + 4], s0[8 * s2 + 5]); t0.w = cvtpk(s0[8 * s2 + 6], s0[8 * s2 + 7]);
        t1.x = cvtpk(s1[8 * s2 + 0], s1[8 * s2 + 1]); t1.y = cvtpk(s1[8 * s2 + 2], s1[8 * s2 + 3]); t1.z = cvtpk(s1[8 * s2 + 4], s1[8 * s2 + 5]); t1.w = cvtpk(s1[8 * s2 + 6], s1[8 * s2 + 7]);
        pf[0][s2] = __builtin_bit_cast(bf16x8, t0); pf[1][s2] = __builtin_bit_cast(bf16x8, t1);
    }
    SBAR();
    if (probe != 3)
#pragma unroll
    for (int b = 0; b < NVB / 2; ++b) {
        if (b + 1 < NVB / 2) VLOAD_(b + 1);
#pragma unroll
        for (int v_ = 0; v_ < 2; ++v_)
#pragma unroll
            for (int p = 0; p < 2; ++p)
#pragma unroll
                for (int s2 = 0; s2 < 2; ++s2) o[2 * b + v_] = MFMA32(pf[p][s2], vfr[b & (NVB > 2 ? 1 : 0)][4 * v_ + 2 * p + s2], o[2 * b + v_]);
        SBAR();
    }
#undef VLOAD_
}

template <int MODE>
DI void attn_tile(f32x16 (&o)[MODE == 0 ? 2 : 4], float& lsum, float& mref, const bf16x8 (&qf)[MODE == 2 ? 8 : 4], LAS const unsigned char* kb, int koff, int voff,
                  int j, int q0w, int r, int h, unsigned mw, float M2, LAS float* wsf, const bool DIAG, const int probe) {
    constexpr int KW = MODE == 0 ? 64 : 128, KROWB = KW * 2 + 16, KBYTES = 64 * KROWB;
    f32x16 s0, s1;
    attn_qk<MODE>(s0, s1, qf, kb, koff, j, q0w, r, h, mw, DIAG);
    attn_pv<MODE>(o, lsum, mref, s0, s1, kb + KBYTES, voff, j, q0w, r, h, M2, wsf, DIAG, probe);
}
template <int MODE>
DI void attn_unit(Frame& F, const Args& a, int l, int b, int head, int qb, float lam_val, float lam_init) {
    constexpr int KW = MODE == 0 ? 64 : 128, DQK = MODE == 2 ? 128 : 64, NCOMP = 1, NPASS = 1, DV = MODE == 0 ? 64 : 128;
    constexpr int KROWB = KW * 2 + 16, VROWB = MODE == 0 ? 192 : 320;
    constexpr int KBYTES = 64 * KROWB, VBYTES = 64 * VROWB, STAGE = KBYTES + VBYTES + 256;
    constexpr int NKS = DQK / 16, NVB = DV / 32, KCH = KW / 64, VCH = DV / 64;
    static_assert(2 * STAGE <= 98304, "tile buffers");
    F.refresh();
    const int probe = (REPMASK != 0) ? ((volatile LAS int*)(F.lds + MISC_OFF + 96))[2] : 0;
    const int tid = F.tid, lane = F.lane, w = F.wave, r = lane & 31, h = lane >> 5;
    const bf16_t* Qp; const bf16_t* Kp; const bf16_t* Vp; int ldq, ldk;
    if (MODE == 0) { Qp = (const bf16_t*)(F.ws + WS_SQ) + head * 64; Kp = (const bf16_t*)(F.ws + WS_SK) + head * 64; Vp = (const bf16_t*)(F.ws + WS_SV) + head * 64; ldq = 512; ldk = 512; }
    else if (MODE == 1) { Qp = (const bf16_t*)(F.ws + WS_DQ) + head * 128; Kp = (const bf16_t*)(F.ws + WS_DK) + head * 128; Vp = (const bf16_t*)(F.ws + WS_DV) + head * 128; ldq = 512; ldk = 512; }
    else { Qp = (const bf16_t*)(F.ws + WS_QK) + head * 128; Kp = (const bf16_t*)(F.ws + WS_QK) + 512 + head * 128; Vp = (const bf16_t*)(F.ws + WS_VM) + head * 128; ldq = 1024; ldk = 1024; }
    const size_t rowb = (size_t)b * SEQ;
    const int comp = MODE == 1 ? (w >> 2) : 0;
    const int q0w = MODE == 1 ? qb * 128 + (w & 3) * 32 : qb * 256 + w * 32;
    const int seq = b * 4 + head;
    LAS float* wsf = (LAS float*)(F.lds + ATT_WSF_OFF + w * 256);
    f32x16 o[NCOMP][NVB];
    float lsum[NCOMP], mref[NCOMP];
    const int i16 = lane & 15, vq = i16 >> 2, vp = i16 & 3, vcs = (lane >> 4) & 1;
    const int voff = (4 * h + vq) * VROWB + (16 * vcs + 4 * vp) * 2;
    const int koff = r * KROWB + 16 * h;
    const int NT = MODE == 2 ? 4 : (MODE == 1 ? 2 * (qb + 1) : 4 * (qb + 1)), JB = MODE == 2 ? 4 * qb : 0;
#pragma unroll 1
    for (int pass = 0; pass < NPASS; ++pass) {
    bf16x8 qf[NCOMP][NKS];
#pragma unroll
    for (int c = 0; c < NCOMP; ++c)
#pragma unroll
        for (int s = 0; s < NKS; ++s) qf[c][s] = *(const GAS bf16x8*)(Qp + (rowb + q0w + r) * ldq + comp * 64 + 16 * s + 8 * h);
#pragma unroll
    for (int c = 0; c < NCOMP; ++c)
#pragma unroll
        for (int v = 0; v < NVB; ++v)
#pragma unroll
            for (int i = 0; i < 16; ++i) o[c][v][i] = 0.f;
#pragma unroll
    for (int c = 0; c < NCOMP; ++c) { lsum[c] = 0.f; mref[c] = 0.f; }
    float M2 = 0.f;
    if (MODE == 2) M2 = ((const float*)(F.ws + WS_MQ))[(size_t)seq * SEQ + q0w + r] * LOG2E;
    const unsigned* mrow = (const unsigned*)(F.ws + WS_MASK) + ((rowb + q0w + r) * 2 + h) * 64;
    const int srow = tid >> 3, sch = tid & 7;
    const bf16_t* kg = Kp + (rowb + srow) * ldk + sch * 8; const bf16_t* vg = Vp + (rowb + srow) * 512 + sch * 8;
    const float* ag = (const float*)(F.ws + WS_AK) + (size_t)seq * SEQ;
    u32x4 kreg[KCH], vreg[VCH]; float areg = 0.f; unsigned mw = 0u; u32x4 mw4 = (u32x4){0u, 0u, 0u, 0u}, mw4n = (u32x4){0u, 0u, 0u, 0u};
#define ST_LOAD(j) do { _Pragma("unroll") for (int c_ = 0; c_ < KCH; ++c_) kreg[c_] = *(const GAS u32x4*)(kg + (size_t)(j) * 64 * ldk + c_ * 64); \
        _Pragma("unroll") for (int c_ = 0; c_ < VCH; ++c_) vreg[c_] = *(const GAS u32x4*)(vg + (size_t)(j) * 64 * 512 + c_ * 64); \
        if (MODE == 2) { if (tid < 64) areg = *(const GAS float*)(ag + (j) * 64 + tid); } \
        asm volatile("" ::: "memory"); } while (0)
#define ST_WRITE(buf) do { LAS unsigned char* sb_ = F.lds + (buf) * STAGE; \
        _Pragma("unroll") for (int c_ = 0; c_ < KCH; ++c_) *(LAS u32x4*)(sb_ + srow * KROWB + (sch + 8 * c_) * 16) = kreg[c_]; \
        _Pragma("unroll") for (int c_ = 0; c_ < VCH; ++c_) *(LAS u32x4*)(sb_ + KBYTES + srow * VROWB + (sch + 8 * c_) * 16) = vreg[c_]; \
        if (MODE == 2) { if (tid < 64) *(LAS float*)(sb_ + KBYTES + VBYTES + tid * 4) = areg * LOG2E; } } while (0)
    if (MODE == 0) mw4n = *(const GAS u32x4*)(mrow + JB);
    ST_LOAD(JB); ST_WRITE(0);
    __syncthreads();
    for (int j = JB; j < JB + NT; ++j) {
        const int cur = j & 1;
        if (MODE == 0) {
            if ((j & 3) == 0) { mw4 = mw4n; if (j + 4 < JB + NT) mw4n = *(const GAS u32x4*)(mrow + j + 4); }
            mw = (j & 3) == 0 ? mw4.x : ((j & 3) == 1 ? mw4.y : ((j & 3) == 2 ? mw4.z : mw4.w));
        }
        if (j + 1 < JB + NT && (probe == 0 || probe == 2 || probe == 3)) ST_LOAD(j + 1);
        if (64 * j <= q0w + 31) {
            LAS const unsigned char* kb = F.lds + cur * STAGE;
            attn_tile<MODE>(o[0], lsum[0], mref[0], qf[0], kb, koff + comp * 128, voff, j, q0w, r, h, mw, M2, wsf, 64 * j + 63 > q0w, probe);
        }
        if (probe != 4) { if (j + 1 < JB + NT) ST_WRITE(cur ^ 1);
        __syncthreads(); }
    }
#undef ST_LOAD
#undef ST_WRITE
    }
    if (MODE == 2) { if (qb > 0) {
        const float Mp2 = ((const float*)(F.ws + WS_MQ))[(size_t)seq * SEQ + 256 * qb - 1] * LOG2E;
        const float M2s = ((const float*)(F.ws + WS_MQ))[(size_t)seq * SEQ + q0w + r] * LOG2E;
        const float g = fexp2(Mp2 - M2s);
        const float* NSn = (const float*)(F.ws + WS_MN + 128 * 1024) + ((size_t)seq * 16 + qb) * 128;
        const bf16_t* Cn = (const bf16_t*)(F.ws + WS_MC) + ((size_t)seq * 16 + qb) * 16384;
        bf16x8 qs[8]; float dpart = 0.f;
#pragma unroll
        for (int s = 0; s < 8; ++s) {
            const bf16x8 qv = *(const GAS bf16x8*)(Qp + (rowb + q0w + r) * ldq + 16 * s + 8 * h);
            const u32x4 qw = __builtin_bit_cast(u32x4, qv);
            const f32x4 n0 = *(const GAS f32x4*)(NSn + 16 * s + 8 * h), n1 = *(const GAS f32x4*)(NSn + 16 * s + 8 * h + 4);
            const float q0 = bflo(qw.x), q1 = bfhi(qw.x), q2 = bflo(qw.y), q3 = bfhi(qw.y), q4 = bflo(qw.z), q5 = bfhi(qw.z), q6 = bflo(qw.w), q7 = bfhi(qw.w);
            dpart += (q0 * n0[0] + q1 * n0[1]) + (q2 * n0[2] + q3 * n0[3]) + (q4 * n1[0] + q5 * n1[1]) + (q6 * n1[2] + q7 * n1[3]);
            u32x4 t; t.x = cvtpk(q0 * g, q1 * g); t.y = cvtpk(q2 * g, q3 * g); t.z = cvtpk(q4 * g, q5 * g); t.w = cvtpk(q6 * g, q7 * g);
            qs[s] = __builtin_bit_cast(bf16x8, t);
        }
        lsum[0] += g * dpart;
#pragma unroll
        for (int v = 0; v < NVB; ++v) {
            bf16x8 cf[8];
#pragma unroll
            for (int s = 0; s < 8; ++s) cf[s] = *(const GAS bf16x8*)(Cn + (size_t)(32 * v + r) * 128 + 16 * s + 8 * h);
#pragma unroll
            for (int s = 0; s < 8; ++s) o[0][v] = MFMA32(qs[s], cf[s], o[0][v]);
        }
    } }
    float sc0; const float sc1 = 0.f;
    if (MODE == 1) { lam_val = ((volatile LAS float*)(F.lds + MISC_OFF + 96))[0]; lam_init = ((volatile LAS float*)(F.lds + MISC_OFF + 96))[1]; }
    { float lt = sum32x(lsum[0]);
      if (MODE == 2) sc0 = frcp(fmaxf(fabsf(lt), ((const float*)(F.ws + WS_EM))[(size_t)seq * SEQ + q0w + r]));
      else if (MODE == 1) sc0 = (comp ? lam_val : 1.0f) * frcp(lt);
      else sc0 = frcp(lt); }
    if (h == 0) { wsf[r] = sc0; wsf[32 + r] = sc1; }
    WSYNC();
    LAS float* stg = (LAS float*)(F.lds + w * 16384);
#pragma unroll
    for (int g = 0; g < 4; ++g) {
        const f32x4 av = *(LAS const f32x4*)(wsf + 8 * g + 4 * h);
#pragma unroll
        for (int e = 0; e < 4; ++e) { const int i = 4 * g + e, row = 8 * g + 4 * h + e;
#pragma unroll
            for (int v = 0; v < NVB; ++v) { float val = o[0][v][i] * av[e]; stg[row * DV + 32 * v + r] = val; } }
    }
    WSYNC();
    if (MODE == 1) __syncthreads();
    if (MODE != 1 || comp == 0) {
        const int q = lane >> 1, hf = lane & 1; constexpr int HC = DV / 2;
        LAS float* srow_ = stg + q * DV + hf * HC;
        if (MODE == 1) {
            LAS const float* prow_ = (LAS const float*)(F.lds + (w + 4) * 16384) + q * DV + hf * HC;
#pragma unroll
            for (int c4 = 0; c4 < HC / 4; ++c4) *(LAS f32x4*)(srow_ + 4 * c4) = *(LAS const f32x4*)(srow_ + 4 * c4) - *(LAS const f32x4*)(prow_ + 4 * c4);
        }
        size_t grow = rowb + q0w + q;
        bf16_t* Y = (bf16_t*)(F.ws + (probe ? WS_MD : WS_Y)); if (probe) grow &= 4095;
        if (MODE == 0) {
            bf16_t* yp = Y + grow * 1536 + 512 + head * 64 + hf * HC;
#pragma unroll
            for (int c8 = 0; c8 < HC / 8; ++c8) { const f32x4 x0 = *(LAS const f32x4*)(srow_ + 8 * c8), x1 = *(LAS const f32x4*)(srow_ + 8 * c8 + 4);
                u32x4 ov; ov.x = cvtpk(x0[0], x0[1]); ov.y = cvtpk(x0[2], x0[3]); ov.z = cvtpk(x1[0], x1[1]); ov.w = cvtpk(x1[2], x1[3]); *(u32x4*)(yp + 8 * c8) = ov; }
        } else {
            float ss = 0.f;
#pragma unroll
            for (int c4 = 0; c4 < HC / 4; ++c4) { const f32x4 x = *(LAS const f32x4*)(srow_ + 4 * c4); ss += (x[0] * x[0] + x[1] * x[1]) + (x[2] * x[2] + x[3] * x[3]); }
            ss += xor1(ss);
            float rs = 1.0f / sqrtf(ss * (1.f / 128.f) + EPS);
            const float* gain; bf16_t* yp; const bf16_t* gatep = nullptr;
            if (MODE == 1) { rs *= (1.0f - lam_init); gain = a.in[I_DOG] + (size_t)l * 128 + hf * HC; yp = Y + grow * 1536 + 1024 + head * 128 + hf * HC; }
            else { gain = a.in[I_MNG] + (size_t)l * 512 + head * 128 + hf * HC; yp = Y + grow * 1536 + head * 128 + hf * HC; gatep = (const bf16_t*)(F.ws + WS_OM) + grow * 512 + head * 128 + hf * HC; }
#pragma unroll
            for (int c8 = 0; c8 < HC / 8; ++c8) {
                f32x4 x0 = *(LAS const f32x4*)(srow_ + 8 * c8), x1 = *(LAS const f32x4*)(srow_ + 8 * c8 + 4);
                const f32x4 g0 = *(const f32x4*)(gain + 8 * c8), g1 = *(const f32x4*)(gain + 8 * c8 + 4);
                x0 = x0 * rs * g0; x1 = x1 * rs * g1;
                if (MODE == 2) { float gt[8]; ld8f(gatep + 8 * c8, gt);
#pragma unroll
                    for (int e = 0; e < 4; ++e) { x0[e] *= gt[e]; x1[e] *= gt[4 + e]; } }
                u32x4 ov; ov.x = cvtpk(x0[0], x0[1]); ov.y = cvtpk(x0[2], x0[3]); ov.z = cvtpk(x1[0], x1[1]); ov.w = cvtpk(x1[2], x1[3]); *(u32x4*)(yp + 8 * c8) = ov;
            }
        }
    }
    __syncthreads();
}
#define PIN(x) asm volatile("" : "+v"(x))
DI int lane_now() { int l_; asm volatile("v_mbcnt_lo_u32_b32 %0, -1, 0\n\tv_mbcnt_hi_u32_b32 %0, -1, %0" : "=v"(l_)); return l_; }
DI void dsa_unit(Frame& F, const Args& a, int l, int b, int head, int qb) {
    constexpr int KROWB = 144, VROWB = 192, KBYTES = 64 * KROWB, VBYTES = 64 * VROWB;
    constexpr int KS = 0, VS = 2 * KBYTES, STG_OFF = 65536;
    F.refresh();
    const int tid = F.tid, lane = F.lane, w = F.wave, r = lane & 31, h = lane >> 5;
    const bf16_t* Qp = (const bf16_t*)(F.ws + WS_SQ) + head * 64; const bf16_t* Kp = (const bf16_t*)(F.ws + WS_SK) + head * 64; const bf16_t* Vp = (const bf16_t*)(F.ws + WS_SV) + head * 64;
    const size_t rowb = (size_t)b * SEQ;
    const int q0w = qb * 256 + w * 32, NT = 4 * (qb + 1), jact = (q0w + 31) >> 6;
    LAS float* wsf = (LAS float*)(F.lds + ATT_WSF_OFF + w * 256);
    const int i16 = lane & 15, vq = i16 >> 2, vp = i16 & 3, vcs = (lane >> 4) & 1;
    const int voff = (4 * h + vq) * VROWB + (16 * vcs + 4 * vp) * 2;
    const int koff = r * KROWB + 16 * h;
    bf16x8 qf[4];
#pragma unroll
    for (int s = 0; s < 4; ++s) qf[s] = *(const GAS bf16x8*)(Qp + (rowb + q0w + r) * 512 + 16 * s + 8 * h);
    f32x16 o0, o1, pA0, pA1, pB0, pB1;
#pragma unroll
    for (int i = 0; i < 16; ++i) { o0[i] = 0.f; o1[i] = 0.f; pB0[i] = 0.f; pB1[i] = 0.f; }
    float lsum = 0.f, mref = 0.f;
    const unsigned* mrow = (const unsigned*)(F.ws + WS_MASK) + ((rowb + q0w + r) * 2 + h) * 64;
    const int srow = tid >> 3, sch = tid & 7;
    const bf16_t* kg = Kp + (rowb + srow) * 512 + sch * 8; const bf16_t* vg = Vp + (rowb + srow) * 512 + sch * 8;
    LAS unsigned char* kwr = F.lds + KS + srow * KROWB + sch * 16;
    LAS unsigned char* vwr = F.lds + VS + srow * VROWB + sch * 16;
    u32x4 kreg, vreg, mw4, mw4n, pw0, pw1, pw2, pw3; bf16x8 kf[8]; s16x4 vlo[8], vhi[8];
    unsigned nmw;
#define D_CI1(NX, i, bit) { int a_; asm("v_bfe_i32 %0, %1, " #bit ", 1" : "=v"(a_) : "v"(nmw)); NX[i] = __uint_as_float((unsigned)a_ & 0xF149F2CAu); }
#define D_CI4(NX, i, bit) D_CI1(NX, i, bit) D_CI1(NX, i + 1, bit + 1) D_CI1(NX, i + 2, bit + 2) D_CI1(NX, i + 3, bit + 3)
    mw4 = *(const GAS u32x4*)(mrow); mw4n = *(const GAS u32x4*)(mrow + 4);
    kreg = *(const GAS u32x4*)(kg); vreg = *(const GAS u32x4*)(kg + (size_t)64 * 512);
    *(LAS u32x4*)(kwr) = kreg; *(LAS u32x4*)(kwr + KBYTES) = vreg;
    { unsigned z_ = 0u; asm volatile("" : "+v"(z_));
      *(LAS u32x4*)(F.lds + VS + VBYTES + tid * 16) = (u32x4){z_, z_, z_, z_}; *(LAS u32x2*)(F.lds + VS + VBYTES + 8192 + tid * 8) = (u32x2){z_, z_}; }
    __syncthreads();
#pragma unroll
    for (int g = 0; g < 8; ++g) kf[g] = *(LAS const bf16x8*)(F.lds + KS + koff + 32 * (g >> 1) + (g & 1) * 32 * KROWB);
    nmw = ~mw4.x;
    D_CI4(pA0, 0, 0) D_CI4(pA0, 4, 4) D_CI4(pA0, 8, 8) D_CI4(pA0, 12, 12) D_CI4(pA1, 0, 16) D_CI4(pA1, 4, 20) D_CI4(pA1, 8, 24) D_CI4(pA1, 12, 28)
#define D_VFR(g) (bf16x8){vlo[g][0], vlo[g][1], vlo[g][2], vlo[g][3], vhi[g][0], vhi[g][1], vhi[g][2], vhi[g][3]}
#define D_VRD(g, vb_) do { vlo[g] = trread((vb_) + (32 * ((g) >> 2) + 16 * (((g) >> 1) & 1)) * VROWB + 64 * ((g) & 1)); vhi[g] = trread((vb_) + (32 * ((g) >> 2) + 16 * (((g) >> 1) & 1) + 8) * VROWB + 64 * ((g) & 1)); } while (0)
#define D_GAPA(g, CX, QF, PX, pi, PW, c0) do { D_VRD(g, vprev); \
        CX = MFMA32(kf[g], qf[QF], CX); \
        sacc += PX[pi]; sacc += PX[pi + 1]; sacc += PX[pi + 2]; sacc += PX[pi + 3]; \
        PW[c0] = cvtpk(PX[pi], PX[pi + 1]); PW[c0 + 1] = cvtpk(PX[pi + 2], PX[pi + 3]); \
        PIN(PW); PIN(sacc); SBAR(); } while (0)
#define D_GAPB(g, OX, PW, CX, ci, NX, bit) do { OX = MFMA32(__builtin_bit_cast(bf16x8, PW), D_VFR(g), OX); \
        CX[ci] = fexp2(CX[ci]); CX[ci + 1] = fexp2(CX[ci + 1]); CX[ci + 2] = fexp2(CX[ci + 2]); CX[ci + 3] = fexp2(CX[ci + 3]); \
        kf[g] = *(LAS const bf16x8*)(knext + 32 * ((g) >> 1) + ((g) & 1) * 32 * KROWB); \
        D_CI4(NX, ci, bit) \
        PIN(CX); PIN(NX); SBAR(); } while (0)
#define D_STEP(C0, C1, P0, P1, t, PAR) do { \
        { const int jn = (t) + 1; \
          if (PAR) { if ((jn & 3) == 0) { mw4 = mw4n; int jl = jn + 4; jl = jl > 60 ? 60 : jl; mw4n = *(const GAS u32x4*)(mrow + jl); } } \
          unsigned mwn = PAR ? ((jn & 2) ? mw4.z : mw4.x) : ((jn & 2) ? mw4.w : mw4.y); \
          if (jn > jact) mwn = 0u; \
          nmw = ~mwn; } \
        { int jk = (t) + 2; jk = jk > NT - 1 ? NT - 1 : jk; \
          kreg = *(const GAS u32x4*)(kg + (size_t)jk * 64 * 512); vreg = *(const GAS u32x4*)(vg + (size_t)(t) * 64 * 512); } \
        LAS const unsigned char* vprev = F.lds + VS + (1 - PAR) * VBYTES + voff; \
        LAS const unsigned char* knext = F.lds + KS + (1 - PAR) * KBYTES + koff; \
        float sacc = 0.f; \
        SBAR(); \
        D_GAPA(0, C0, 0, P0, 0, pw0, 0); D_GAPA(1, C1, 0, P0, 4, pw0, 2); D_GAPA(2, C0, 1, P0, 8, pw1, 0); D_GAPA(3, C1, 1, P0, 12, pw1, 2); \
        D_GAPA(4, C0, 2, P1, 0, pw2, 0); D_GAPA(5, C1, 2, P1, 4, pw2, 2); D_GAPA(6, C0, 3, P1, 8, pw3, 0); D_GAPA(7, C1, 3, P1, 12, pw3, 2); \
        lsum += sacc; \
        bool resc = false; \
        { asm volatile("s_nop 15\n\ts_nop 7" : "+v"(C0), "+v"(C1)); \
          float ta = max3f(C0[0], C0[1], C1[0]), tb = max3f(C0[2], C0[3], C1[1]); ta = max3f(ta, C1[2], C1[3]); \
          _Pragma("unroll") for (int i = 4; i < 16; i += 4) { ta = max3f(ta, C0[i], C0[i + 1]); tb = max3f(tb, C0[i + 2], C0[i + 3]); ta = max3f(ta, C1[i], C1[i + 1]); tb = max3f(tb, C1[i + 2], C1[i + 3]); } \
          float tm = max3f(ta, tb, tb); tm = max32x(tm); \
          if (__any(tm > mref + RESC_THR)) {            \
              const float nm = tm > mref + RESC_THR ? tm : mref, al = fexp2(mref - nm); \
              mref = nm; lsum *= al; if (h == 0) wsf[r] = al; resc = true; } \
          if (__any(mref != 0.f)) { _Pragma("unroll") for (int i = 0; i < 16; ++i) { C0[i] -= mref; C1[i] -= mref; } } } \
        SBAR(); \
        D_GAPB(0, o0, pw0, C0, 0, P0, 0); D_GAPB(1, o1, pw0, C0, 4, P0, 4); D_GAPB(2, o0, pw1, C0, 8, P0, 8); D_GAPB(3, o1, pw1, C0, 12, P0, 12); \
        D_GAPB(4, o0, pw2, C1, 0, P1, 16); D_GAPB(5, o1, pw2, C1, 4, P1, 20); D_GAPB(6, o0, pw3, C1, 8, P1, 24); D_GAPB(7, o1, pw3, C1, 12, P1, 28); \
        if (resc) { WSYNC(); \
            _Pragma("unroll") for (int g = 0; g < 4; ++g) { const f32x4 av = *(LAS const f32x4*)(wsf + 8 * g + 4 * h); \
                _Pragma("unroll") for (int e = 0; e < 4; ++e) { o0[4 * g + e] *= av[e]; o1[4 * g + e] *= av[e]; } } \
            WSYNC(); } \
        *(LAS u32x4*)(kwr + PAR * KBYTES) = kreg; *(LAS u32x4*)(vwr + PAR * VBYTES) = vreg; \
        __syncthreads(); } while (0)
    for (int t = 0; t < NT; t += 2) {
        D_STEP(pA0, pA1, pB0, pB1, t, 0);
        D_STEP(pB0, pB1, pA0, pA1, t + 1, 1);
    }
    { float sacc = 0.f;
#pragma unroll
      for (int i = 0; i < 16; ++i) sacc += pB0[i] + pB1[i];
      lsum += sacc;
      pw0 = (u32x4){cvtpk(pB0[0], pB0[1]), cvtpk(pB0[2], pB0[3]), cvtpk(pB0[4], pB0[5]), cvtpk(pB0[6], pB0[7])}; pw1 = (u32x4){cvtpk(pB0[8], pB0[9]), cvtpk(pB0[10], pB0[11]), cvtpk(pB0[12], pB0[13]), cvtpk(pB0[14], pB0[15])};
      pw2 = (u32x4){cvtpk(pB1[0], pB1[1]), cvtpk(pB1[2], pB1[3]), cvtpk(pB1[4], pB1[5]), cvtpk(pB1[6], pB1[7])}; pw3 = (u32x4){cvtpk(pB1[8], pB1[9]), cvtpk(pB1[10], pB1[11]), cvtpk(pB1[12], pB1[13]), cvtpk(pB1[14], pB1[15])};
      LAS const unsigned char* vlast = F.lds + VS + VBYTES + voff;
      D_VRD(0, vlast); D_VRD(1, vlast); D_VRD(2, vlast); D_VRD(3, vlast); D_VRD(4, vlast); D_VRD(5, vlast); D_VRD(6, vlast); D_VRD(7, vlast);
      o0 = MFMA32(__builtin_bit_cast(bf16x8, pw0), D_VFR(0), o0); o1 = MFMA32(__builtin_bit_cast(bf16x8, pw0), D_VFR(1), o1); o0 = MFMA32(__builtin_bit_cast(bf16x8, pw1), D_VFR(2), o0); o1 = MFMA32(__builtin_bit_cast(bf16x8, pw1), D_VFR(3), o1);
      o0 = MFMA32(__builtin_bit_cast(bf16x8, pw2), D_VFR(4), o0); o1 = MFMA32(__builtin_bit_cast(bf16x8, pw2), D_VFR(5), o1); o0 = MFMA32(__builtin_bit_cast(bf16x8, pw3), D_VFR(6), o0); o1 = MFMA32(__builtin_bit_cast(bf16x8, pw3), D_VFR(7), o1); }
#undef D_STEP
#undef D_GAPA
#undef D_GAPB
#undef D_VRD
#undef D_VFR
#undef D_CI4
#undef D_CI1
    { const float sc0 = frcp(sum32x(lsum)); if (h == 0) wsf[r] = sc0; }
    WSYNC();
    LAS float* stg = (LAS float*)(F.lds + STG_OFF + w * 8192);
#pragma unroll
    for (int g = 0; g < 4; ++g) {
        const f32x4 av = *(LAS const f32x4*)(wsf + 8 * g + 4 * h);
#pragma unroll
        for (int e = 0; e < 4; ++e) { const int i = 4 * g + e, row = 8 * g + 4 * h + e; stg[row * 64 + r] = o0[i] * av[e]; stg[row * 64 + 32 + r] = o1[i] * av[e]; }
    }
    WSYNC();
    { const int q = lane >> 1, hf = lane & 1;
      LAS const float* srow_ = stg + q * 64 + hf * 32;
      bf16_t* yp = (bf16_t*)(F.ws + WS_Y) + (rowb + q0w + q) * 1536 + 512 + head * 64 + hf * 32;
#pragma unroll
      for (int c8 = 0; c8 < 4; ++c8) { const f32x4 x0 = *(LAS const f32x4*)(srow_ + 8 * c8), x1 = *(LAS const f32x4*)(srow_ + 8 * c8 + 4);
          u32x4 ov; ov.x = cvtpk(x0[0], x0[1]); ov.y = cvtpk(x0[2], x0[3]); ov.z = cvtpk(x1[0], x1[1]); ov.w = cvtpk(x1[2], x1[3]); *(u32x4*)(yp + 8 * c8) = ov; } }
    __syncthreads();
}
DI void diff_unit(Frame& F, const Args& a, int l, int b, int head, int qb) {
    constexpr int KROWB = 272, VROWB = 320, KBYTES = 64 * KROWB, VBYTES = 64 * VROWB;
    constexpr int KS = 0, VS = 2 * KBYTES;
    static_assert(VS + 2 * VBYTES <= RING_BYTES, "tile slots");
    F.refresh();
    const int tid = F.tid, lane = F.lane, w = F.wave, r = lane & 31, h = lane >> 5;
    const bf16_t* Qp = (const bf16_t*)(F.ws + WS_DQ) + head * 128;
    const size_t rowb = (size_t)b * SEQ;
    const int comp = w >> 2;
    const int q0w = qb * 128 + (w & 3) * 32, NT = 2 * (qb + 1);
#define wsf ((LAS float*)(F.lds + ATT_WSF_OFF + w * 256))
    const int i16 = lane & 15, vq = i16 >> 2, vp = i16 & 3, vcs = (lane >> 4) & 1;
    const int voff = (4 * h + vq) * VROWB + (16 * vcs + 4 * vp) * 2;
    const int koff = r * KROWB + 16 * h + comp * 128;
    bf16x8 qf[4];
#pragma unroll
    for (int s = 0; s < 4; ++s) qf[s] = *(const GAS bf16x8*)(Qp + (rowb + q0w + r) * 512 + comp * 64 + 16 * s + 8 * h);
    f32x16 o0, o1, o2, o3, c0, c1;
#pragma unroll
    for (int i = 0; i < 16; ++i) { o0[i] = 0.f; o1[i] = 0.f; o2[i] = 0.f; o3[i] = 0.f; }
    float lsum = 0.f, mref = 0.f;
    const int srow = tid >> 3, sch = tid & 7;
    const GAS unsigned char* kgb = (const GAS unsigned char*)(F.ws + WS_DK); const GAS unsigned char* vgb = (const GAS unsigned char*)(F.ws + WS_DV);
    const unsigned goff = (unsigned)(((rowb + srow) * 512 + sch * 8 + head * 128) * 2);
    LAS unsigned char* kwr = F.lds + KS + srow * KROWB + sch * 16;
    LAS unsigned char* vwr = F.lds + VS + srow * VROWB + sch * 16;
    u32x4 kreg0, kreg1, vreg0, vreg1, pwa0, pwa1, pwa2, pwa3, pwb0, pwb1, pwb2, pwb3; bf16x8 kf[8]; s16x4 valo[8], vahi[8], vblo[8], vbhi[8];
    kreg0 = *(const GAS u32x4*)(kgb + goff); kreg1 = *(const GAS u32x4*)(kgb + goff + 128); vreg0 = *(const GAS u32x4*)(kgb + goff + 65536); vreg1 = *(const GAS u32x4*)(kgb + goff + 65536 + 128);
    *(LAS u32x4*)(kwr) = kreg0; *(LAS u32x4*)(kwr + 128) = kreg1; *(LAS u32x4*)(kwr + KBYTES) = vreg0; *(LAS u32x4*)(kwr + KBYTES + 128) = vreg1;
    { unsigned z_ = 0u; asm volatile("" : "+v"(z_));
      *(LAS u32x4*)(F.lds + VS + VBYTES + tid * 16) = (u32x4){z_, z_, z_, z_}; *(LAS u32x4*)(F.lds + VS + VBYTES + 8192 + tid * 16) = (u32x4){z_, z_, z_, z_}; *(LAS u32x2*)(F.lds + VS + VBYTES + 16384 + tid * 8) = (u32x2){z_, z_};
      pwb0 = (u32x4){z_, z_, z_, z_}; pwb1 = pwb0; pwb2 = pwb0; pwb3 = pwb0; }
    __syncthreads();
#pragma unroll
    for (int g = 0; g < 8; ++g) kf[g] = *(LAS const bf16x8*)(F.lds + KS + koff + 32 * (g >> 1) + (g & 1) * 32 * KROWB);
#define F_VFR(LO, HI, g) (bf16x8){LO[g][0], LO[g][1], LO[g][2], LO[g][3], HI[g][0], HI[g][1], HI[g][2], HI[g][3]}
#define F_VRD(LO, HI, g, vb_, bb) do { LO[g] = trread((vb_) + (32 * ((g) >> 2) + 16 * (((g) >> 1) & 1)) * VROWB + 64 * (2 * (bb) + ((g) & 1))); \
        HI[g] = trread((vb_) + (32 * ((g) >> 2) + 16 * (((g) >> 1) & 1) + 8) * VROWB + 64 * (2 * (bb) + ((g) & 1))); } while (0)
#define F_GAPA(g, CX, QF, FIRST) do { F_VRD(valo, vahi, g, vprev, 0); \
        if (FIRST) CX = MFMA32(kf[g], qf[QF], zero16_); else CX = MFMA32(kf[g], qf[QF], CX); \
        SBAR(); } while (0)
#define F_SM(G, CX, ci, PW) { const float x_ = fexp2(CX[ci]), y_ = fexp2(CX[ci + 1]); sacc += x_; sacc += y_; PW[(G) & 3] = cvtpk(x_, y_); }
#define F_GAPB0(G, OX, PWP, CX, ci, PWC) do { OX = MFMA32(__builtin_bit_cast(bf16x8, PWP), F_VFR(valo, vahi, G), OX); \
        F_SM(G, CX, ci, PWC) \
        F_VRD(vblo, vbhi, G, vprev, 1); \
        PIN(PWC); PIN(sacc); SBAR(); } while (0)
#define F_GAPB1(G, OX, PWP, CX, ci, PWC) do { OX = MFMA32(__builtin_bit_cast(bf16x8, PWP), F_VFR(vblo, vbhi, (G) - 8), OX); \
        F_SM(G, CX, ci, PWC) \
        kf[(G) - 8] = *(LAS const bf16x8*)(knext + 32 * (((G) - 8) >> 1) + (((G) - 8) & 1) * 32 * KROWB); \
        PIN(PWC); PIN(sacc); SBAR(); } while (0)
#define F_STEP(P0_, P1_, P2_, P3_, N0_, N1_, N2_, N3_, t, PAR) do { \
        { int jk = (t) + 2; jk = jk > NT - 1 ? NT - 1 : jk; \
          const GAS unsigned char* kt_ = kgb + (size_t)jk * 65536; const GAS unsigned char* vt_ = vgb + (size_t)(t) * 65536; \
          kreg0 = *(const GAS u32x4*)(kt_ + goff); kreg1 = *(const GAS u32x4*)(kt_ + goff + 128); \
          vreg0 = *(const GAS u32x4*)(vt_ + goff); vreg1 = *(const GAS u32x4*)(vt_ + goff + 128); } \
        LAS const unsigned char* vprev = F.lds + VS + (1 - PAR) * VBYTES + voff; \
        LAS const unsigned char* knext = F.lds + KS + (1 - PAR) * KBYTES + koff; \
        f32x16 zero16_; _Pragma("unroll") for (int i = 0; i < 16; ++i) zero16_[i] = 0.f; \
        SBAR(); \
        F_GAPA(0, c0, 0, true); F_GAPA(1, c1, 0, true); F_GAPA(2, c0, 1, false); F_GAPA(3, c1, 1, false); F_GAPA(4, c0, 2, false); F_GAPA(5, c1, 2, false); F_GAPA(6, c0, 3, false); F_GAPA(7, c1, 3, false); \
        bool resc = false; \
        { asm volatile("s_nop 15\n\ts_nop 7" : "+v"(c0), "+v"(c1)); \
          if (64 * (t) + 63 > q0w) {                     \
              const int ln_ = lane_now(), qd = q0w + (ln_ & 31) - 64 * (t) - 4 * (ln_ >> 5); \
              _Pragma("unroll") for (int i = 0; i < 16; ++i) { const int kk = (i & 3) + 8 * (i >> 2); if (kk > qd) c0[i] = NEGBIG; if (kk + 32 > qd) c1[i] = NEGBIG; } \
              asm volatile("" : "+v"(c0), "+v"(c1)); } \
          float ta = max3f(c0[0], c0[1], c1[0]), tb = max3f(c0[2], c0[3], c1[1]); ta = max3f(ta, c1[2], c1[3]); \
          _Pragma("unroll") for (int i = 4; i < 16; i += 4) { ta = max3f(ta, c0[i], c0[i + 1]); tb = max3f(tb, c0[i + 2], c0[i + 3]); ta = max3f(ta, c1[i], c1[i + 1]); tb = max3f(tb, c1[i + 2], c1[i + 3]); } \
          float tm = max3f(ta, tb, tb); tm = max32x(tm); \
          if (__any(tm > mref + RESC_THR)) {            \
              const float nm = tm > mref + RESC_THR ? tm : mref, al = fexp2(mref - nm); \
              mref = nm; lsum *= al; { const int ln_ = lane_now(); if (ln_ < 32) wsf[ln_] = al; } resc = true; } \
          if (__any(mref != 0.f)) { _Pragma("unroll") for (int i = 0; i < 16; ++i) { c0[i] -= mref; c1[i] -= mref; } } } \
        float sacc = 0.f; \
        SBAR(); \
        F_GAPB0(0, o0, P0_, c0, 0, N0_); F_GAPB0(1, o1, P0_, c0, 2, N0_); F_GAPB0(2, o0, P1_, c0, 4, N0_); F_GAPB0(3, o1, P1_, c0, 6, N0_); \
        F_GAPB0(4, o0, P2_, c0, 8, N1_); F_GAPB0(5, o1, P2_, c0, 10, N1_); F_GAPB0(6, o0, P3_, c0, 12, N1_); F_GAPB0(7, o1, P3_, c0, 14, N1_); \
        F_GAPB1(8, o2, P0_, c1, 0, N2_); F_GAPB1(9, o3, P0_, c1, 2, N2_); F_GAPB1(10, o2, P1_, c1, 4, N2_); F_GAPB1(11, o3, P1_, c1, 6, N2_); \
        F_GAPB1(12, o2, P2_, c1, 8, N3_); F_GAPB1(13, o3, P2_, c1, 10, N3_); F_GAPB1(14, o2, P3_, c1, 12, N3_); F_GAPB1(15, o3, P3_, c1, 14, N3_); \
        lsum += sacc; \
        if (resc) { WSYNC(); const int h_ = lane_now() >> 5; \
            _Pragma("unroll") for (int g = 0; g < 4; ++g) { const f32x4 av = *(LAS const f32x4*)(wsf + 8 * g + 4 * h_); \
                _Pragma("unroll") for (int e = 0; e < 4; ++e) { o0[4 * g + e] *= av[e]; o1[4 * g + e] *= av[e]; o2[4 * g + e] *= av[e]; o3[4 * g + e] *= av[e]; } } \
            WSYNC(); } \
        *(LAS u32x4*)(kwr + PAR * KBYTES) = kreg0; *(LAS u32x4*)(kwr + PAR * KBYTES + 128) = kreg1; *(LAS u32x4*)(vwr + PAR * VBYTES) = vreg0; *(LAS u32x4*)(vwr + PAR * VBYTES + 128) = vreg1; \
        __syncthreads(); } while (0)
    for (int t = 0; t < NT; t += 2) {
        F_STEP(pwb0, pwb1, pwb2, pwb3, pwa0, pwa1, pwa2, pwa3, t, 0);
        F_STEP(pwa0, pwa1, pwa2, pwa3, pwb0, pwb1, pwb2, pwb3, t + 1, 1);
    }
    { LAS const unsigned char* vlast = F.lds + VS + VBYTES + voff;
#pragma unroll
      for (int g = 0; g < 8; ++g) { F_VRD(valo, vahi, g, vlast, 0); F_VRD(vblo, vbhi, g, vlast, 1); }
      o0 = MFMA32(__builtin_bit_cast(bf16x8, pwb0), F_VFR(valo, vahi, 0), o0); o1 = MFMA32(__builtin_bit_cast(bf16x8, pwb0), F_VFR(valo, vahi, 1), o1); o0 = MFMA32(__builtin_bit_cast(bf16x8, pwb1), F_VFR(valo, vahi, 2), o0); o1 = MFMA32(__builtin_bit_cast(bf16x8, pwb1), F_VFR(valo, vahi, 3), o1);
      o0 = MFMA32(__builtin_bit_cast(bf16x8, pwb2), F_VFR(valo, vahi, 4), o0); o1 = MFMA32(__builtin_bit_cast(bf16x8, pwb2), F_VFR(valo, vahi, 5), o1); o0 = MFMA32(__builtin_bit_cast(bf16x8, pwb3), F_VFR(valo, vahi, 6), o0); o1 = MFMA32(__builtin_bit_cast(bf16x8, pwb3), F_VFR(valo, vahi, 7), o1);
      o2 = MFMA32(__builtin_bit_cast(bf16x8, pwb0), F_VFR(vblo, vbhi, 0), o2); o3 = MFMA32(__builtin_bit_cast(bf16x8, pwb0), F_VFR(vblo, vbhi, 1), o3); o2 = MFMA32(__builtin_bit_cast(bf16x8, pwb1), F_VFR(vblo, vbhi, 2), o2); o3 = MFMA32(__builtin_bit_cast(bf16x8, pwb1), F_VFR(vblo, vbhi, 3), o3);
      o2 = MFMA32(__builtin_bit_cast(bf16x8, pwb2), F_VFR(vblo, vbhi, 4), o2); o3 = MFMA32(__builtin_bit_cast(bf16x8, pwb2), F_VFR(vblo, vbhi, 5), o3); o2 = MFMA32(__builtin_bit_cast(bf16x8, pwb3), F_VFR(vblo, vbhi, 6), o2); o3 = MFMA32(__builtin_bit_cast(bf16x8, pwb3), F_VFR(vblo, vbhi, 7), o3); }
#undef F_STEP
#undef F_GAPA
#undef F_GAPB0
#undef F_GAPB1
#undef F_SM
#undef F_VRD
#undef F_VFR
    __syncthreads();
    const int lane2 = lane_now(), r2 = lane2 & 31, h2 = lane2 >> 5;
    const float lam_val = ((volatile LAS float*)(F.lds + MISC_OFF + 96))[0], lam_init = ((volatile LAS float*)(F.lds + MISC_OFF + 96))[1];
    { const float sc0 = (comp ? lam_val : 1.0f) * frcp(sum32x(lsum)); if (h2 == 0) wsf[r2] = sc0; }
    WSYNC();
    LAS float* stg = (LAS float*)(F.lds + w * 16384);
#pragma unroll
    for (int g = 0; g < 4; ++g) {
        const f32x4 av = *(LAS const f32x4*)(wsf + 8 * g + 4 * h2);
#pragma unroll
        for (int e = 0; e < 4; ++e) { const int i = 4 * g + e, row = 8 * g + 4 * h2 + e;
            stg[row * 128 + r2] = o0[i] * av[e]; stg[row * 128 + 32 + r2] = o1[i] * av[e]; stg[row * 128 + 64 + r2] = o2[i] * av[e]; stg[row * 128 + 96 + r2] = o3[i] * av[e]; }
    }
    WSYNC();
    __syncthreads();
    if (comp == 0) {
        const int q = lane2 >> 1, hf = lane2 & 1; constexpr int HC = 64;
        LAS float* srow_ = stg + q * 128 + hf * HC;
        LAS const float* prow_ = (LAS const float*)(F.lds + (w + 4) * 16384) + q * 128 + hf * HC;
#pragma unroll
        for (int c4 = 0; c4 < HC / 4; ++c4) *(LAS f32x4*)(srow_ + 4 * c4) = *(LAS const f32x4*)(srow_ + 4 * c4) - *(LAS const f32x4*)(prow_ + 4 * c4);
        const size_t grow = rowb + q0w + q;
        float ss = 0.f;
#pragma unroll
        for (int c4 = 0; c4 < HC / 4; ++c4) { const f32x4 x = *(LAS const f32x4*)(srow_ + 4 * c4); ss += (x[0] * x[0] + x[1] * x[1]) + (x[2] * x[2] + x[3] * x[3]); }
        ss += xor1(ss);
        const float rs = (1.0f - lam_init) / sqrtf(ss * (1.f / 128.f) + EPS);
        const float* gain = a.in[I_DOG] + (size_t)l * 128 + hf * HC;
        bf16_t* yp = (bf16_t*)(F.ws + WS_Y) + grow * 1536 + 1024 + head * 128 + hf * HC;
#pragma unroll
        for (int c8 = 0; c8 < HC / 8; ++c8) {
            f32x4 x0 = *(LAS const f32x4*)(srow_ + 8 * c8), x1 = *(LAS const f32x4*)(srow_ + 8 * c8 + 4);
            const f32x4 g0 = *(const f32x4*)(gain + 8 * c8), g1 = *(const f32x4*)(gain + 8 * c8 + 4);
            x0 = x0 * rs * g0; x1 = x1 * rs * g1;
            u32x4 ov; ov.x = cvtpk(x0[0], x0[1]); ov.y = cvtpk(x0[2], x0[3]); ov.z = cvtpk(x1[0], x1[1]); ov.w = cvtpk(x1[2], x1[3]); *(u32x4*)(yp + 8 * c8) = ov;
        }
    }
    __syncthreads();
#undef wsf
}
DI void phase_mixers(Frame& F, const Args& a, int l, int it, int modes, int probe) {
    F.refresh();
    const float* lam = a.in[I_LAM] + (size_t)l * 256;
    const float lam_init = (l == 0) ? 0.2f : 0.35550906759096934f;
    const float s01 = wave_sum(lam[F.lane] * lam[64 + F.lane]), s23 = wave_sum(lam[128 + F.lane] * lam[192 + F.lane]);
    { const float lv = fexp(s01) - fexp(s23) + lam_init; if (F.tid == 0) { ((volatile LAS int*)(F.lds + MISC_OFF + 96))[2] = probe; ((volatile LAS float*)(F.lds + MISC_OFF + 96))[0] = lv; ((volatile LAS float*)(F.lds + MISC_OFF + 96))[1] = lam_init; } }
    const float lam_val = 0.f;
    unsigned* qhead = (unsigned*)(F.ws + WS_CTL) + CW_QUEUE + it * 64;
    volatile LAS unsigned* slot = (volatile LAS unsigned*)(F.lds + MISC_OFF + 64);
    for (;;) {
        if (F.tid == 0) *slot = __hip_atomic_fetch_add(qhead, 1u, __ATOMIC_RELAXED, __HIP_MEMORY_SCOPE_AGENT);
        __syncthreads();
        const int u = __builtin_amdgcn_readfirstlane((int)*slot);
        __syncthreads();
        if (u >= 1280) break;
        if (u < 1024) { const int p_ = u >> 6, k = u & 63;
            if (k < 16) { if (modes & MIXMODES & 2) diff_unit(F, a, l, k >> 2, k & 3, 31 - 2 * p_); }
            else if (k < 48) { if (modes & MIXMODES & 1) dsa_unit(F, a, l, (k - 16) >> 3, (k - 16) & 7, 15 - p_); }
            else { if (modes & MIXMODES & 2) diff_unit(F, a, l, (k - 48) >> 2, (k - 48) & 3, 30 - 2 * p_); }
        } else { const int m_ = u - 1024; if (modes & MIXMODES & 4) attn_unit<2>(F, a, l, (m_ >> 2) & 3, m_ & 3, 15 - (m_ >> 4), lam_val, lam_init); }
    }
}

DI void mlstm_state_unit(Frame& F, int sq, int n) {
    F.refresh();
    constexpr int KROWB = 272, VROWB = 320, KBYTES = 64 * KROWB, VBYTES = 64 * VROWB;
    const int tid = F.tid, lane = F.lane, w = F.wave, r = lane & 31, h = lane >> 5, b = sq >> 2, head = sq & 3;
    const size_t rowb = (size_t)b * SEQ;
    const bf16_t* Kp = (const bf16_t*)(F.ws + WS_QK) + 512 + head * 128; const bf16_t* Vp = (const bf16_t*)(F.ws + WS_VM) + head * 128;
    const float* ag = (const float*)(F.ws + WS_AK) + (size_t)sq * SEQ;
    const float Mend = ((const float*)(F.ws + WS_MQ))[(size_t)sq * SEQ + 256 * n + 255];
    f32x16 acc[2];
#pragma unroll
    for (int c = 0; c < 2; ++c)
#pragma unroll
        for (int i = 0; i < 16; ++i) acc[c][i] = 0.f;
    const int dvb = w >> 1, dkb0 = 2 * (w & 1);
    const int srow = tid >> 3, sch = tid & 7;
    const int i16 = lane & 15, vq = i16 >> 2, vp = i16 & 3, vcs = (lane >> 4) & 1;
    const int toffV = (4 * h + vq) * VROWB + (16 * vcs + 4 * vp) * 2, toffK = (4 * h + vq) * KROWB + (16 * vcs + 4 * vp) * 2;
    LAS unsigned char* kb = F.lds; LAS unsigned char* vb = kb + KBYTES; LAS float* wts = (LAS float*)(vb + VBYTES);
    float nacc = 0.f; const int ndk = tid & 127, npart = tid >> 7;
    for (int jt = 0; jt < 4; ++jt) {
        const int j = 4 * n + jt;
        const float wr_ = fexp(*(const GAS float*)(ag + 64 * j + srow) - Mend);
        u32x4 kreg[2], vreg[2];
#pragma unroll
        for (int c = 0; c < 2; ++c) { kreg[c] = *(const GAS u32x4*)(Kp + (rowb + 64 * j + srow) * 1024 + (sch + 8 * c) * 8); vreg[c] = *(const GAS u32x4*)(Vp + (rowb + 64 * j + srow) * 512 + (sch + 8 * c) * 8); }
#pragma unroll
        for (int c = 0; c < 2; ++c) { u32x4 t = vreg[c];
            t.x = cvtpk(bflo(t.x) * wr_, bfhi(t.x) * wr_); t.y = cvtpk(bflo(t.y) * wr_, bfhi(t.y) * wr_); t.z = cvtpk(bflo(t.z) * wr_, bfhi(t.z) * wr_); t.w = cvtpk(bflo(t.w) * wr_, bfhi(t.w) * wr_); vreg[c] = t; }
        __syncthreads();
#pragma unroll
        for (int c = 0; c < 2; ++c) { *(LAS u32x4*)(kb + srow * KROWB + (sch + 8 * c) * 16) = kreg[c]; *(LAS u32x4*)(vb + srow * VROWB + (sch + 8 * c) * 16) = vreg[c]; }
        if (sch == 0) wts[srow] = wr_;
        __syncthreads();
#pragma unroll
        for (int sg = 0; sg < 4; ++sg) {
            const s16x4 alo = trread(vb + toffV + (16 * sg) * VROWB + 64 * dvb), ahi = trread(vb + toffV + (16 * sg + 8) * VROWB + 64 * dvb);
            const bf16x8 af = (bf16x8){alo[0], alo[1], alo[2], alo[3], ahi[0], ahi[1], ahi[2], ahi[3]};
#pragma unroll
            for (int c = 0; c < 2; ++c) {
                const s16x4 blo = trread(kb + toffK + (16 * sg) * KROWB + 64 * (dkb0 + c)), bhi = trread(kb + toffK + (16 * sg + 8) * KROWB + 64 * (dkb0 + c));
                const bf16x8 bfr = (bf16x8){blo[0], blo[1], blo[2], blo[3], bhi[0], bhi[1], bhi[2], bhi[3]};
                acc[c] = MFMA32(af, bfr, acc[c]);
            }
        }
#pragma unroll 4
        for (int s_ = 0; s_ < 16; ++s_) { const int ks = 16 * npart + s_; nacc += wts[ks] * bf2f(*(LAS const bf16_t*)(kb + ks * KROWB + ndk * 2)); }
    }
    float* D = (float*)(F.ws + WS_MD) + ((size_t)sq * 16 + n) * 16384;
#pragma unroll
    for (int c = 0; c < 2; ++c)
#pragma unroll
        for (int i = 0; i < 16; ++i) D[(32 * dvb + (i & 3) + 8 * (i >> 2) + 4 * h) * 128 + 32 * (dkb0 + c) + r] = acc[c][i];
    __syncthreads();
    LAS float* red = (LAS float*)F.lds;
    red[npart * 128 + ndk] = nacc;
    __syncthreads();
    if (tid < 128) ((float*)(F.ws + WS_MN))[((size_t)sq * 16 + n) * 128 + tid] = (red[tid] + red[128 + tid]) + (red[256 + tid] + red[384 + tid]);
    __syncthreads();
}
DI void mlstm_state_scan(Frame& F) {
    const int gid = (F.bid * NWAVES + F.wave) * 64 + F.lane, NG_ = F.G * NWAVES * 64;
    const float* D = (const float*)(F.ws + WS_MD); bf16_t* C = (bf16_t*)(F.ws + WS_MC); const float* MQ = (const float*)(F.ws + WS_MQ);
    for (int e = gid; e < CB * 4 * 16384; e += NG_) {
        const int sq = e >> 14, idx = e & 16383;
        float d[15], me[15];
#pragma unroll
        for (int n = 0; n < 15; ++n) { d[n] = D[((size_t)sq * 16 + n) * 16384 + idx]; me[n] = MQ[(size_t)sq * SEQ + 256 * n + 255]; }
        float c = 0.f;
#pragma unroll
        for (int n = 0; n < 15; ++n) { const float f = n == 0 ? 0.f : fexp(me[n - 1] - me[n]); c = f * c + d[n]; C[((size_t)sq * 16 + n + 1) * 16384 + idx] = (bf16_t)f2bf(c); }
    }
    const float* Nv = (const float*)(F.ws + WS_MN); float* NS = (float*)(F.ws + WS_MN + 128 * 1024);
    for (int e = gid; e < CB * 4 * 128; e += NG_) {
        const int sq = e >> 7, idx = e & 127; float c = 0.f;
#pragma unroll
        for (int n = 0; n < 15; ++n) { const float me = MQ[(size_t)sq * SEQ + 256 * n + 255]; const float f = n == 0 ? 0.f : fexp(MQ[(size_t)sq * SEQ + 256 * (n - 1) + 255] - me);
            c = f * c + Nv[((size_t)sq * 16 + n) * 128 + idx]; NS[((size_t)sq * 16 + n + 1) * 128 + idx] = c; }
    }
}

constexpr size_t SC_BSTRIDE = (size_t)4096 * (64 * 65 / 2);
DI size_t sc_off(int b, int t) { const int qb = t >> 6; return (size_t)b * SC_BSTRIDE + (size_t)4096 * (qb * (qb + 1) / 2) + (size_t)(t & 63) * 64 * (qb + 1); }
constexpr int CW_QUEUE2 = 12288;
DI void phase_scores(Frame& F, int it) {
    F.refresh();
    unsigned* qhead = (unsigned*)(F.ws + WS_CTL) + CW_QUEUE2 + it * 64;
    volatile LAS unsigned* slot = (volatile LAS unsigned*)(F.lds + MISC_OFF + 64);
    const bf16_t* IQ = (const bf16_t*)(F.ws + WS_IQ); const bf16_t* IK = (const bf16_t*)(F.ws + WS_IK); const float* IW = (const float*)(F.ws + WS_IW);
    float* SC = (float*)(F.ws + WS_HREG);
    for (;;) {
        if (F.tid == 0) *slot = __hip_atomic_fetch_add(qhead, 1u, __ATOMIC_RELAXED, __HIP_MEMORY_SCOPE_AGENT);
        __syncthreads();
        const int u = __builtin_amdgcn_readfirstlane((int)*slot);
        __syncthreads();
        if (u >= CB * 160 + 240) break;
        if (u >= CB * 160) { const int m_ = u - CB * 160; mlstm_state_unit(F, m_ & 15, m_ >> 4); continue; }
        int b = u / 160, k = u % 160, qb, seg;
        {
          int cls = 3, base = 0;
          for (;; --cls) { const int cnt = 16 * (cls + 1); if (k < base + cnt) break; base += cnt; }
          const int kk = k - base; qb = 16 * cls + (kk % 16); seg = kk / 16; }
        F.refresh();
        const int lane = F.lane, w = F.wave, r = lane & 31, h = lane >> 5, qh = w & 1;
        const int t0 = 64 * qb + 32 * qh;
        const size_t rowq = (size_t)b * SEQ + t0 + r;
        const f32x4 wv = *(const GAS f32x4*)(IW + rowq * 4);
        bf16x8 qf[4][4];
#pragma unroll
        for (int hd = 0; hd < 4; ++hd)
#pragma unroll
            for (int s = 0; s < 4; ++s) qf[hd][s] = *(const GAS bf16x8*)(IQ + rowq * 256 + hd * 64 + 16 * s + 8 * h);
        LAS unsigned* T = (LAS unsigned*)(F.lds + w * 8448);
        const int jplast = ((16 * seg + 15 < qb) ? 16 * seg + 15 : qb) >> 1;
        unsigned short* scb = (unsigned short*)(F.ws + WS_HREG) + sc_off(b, t0);
        const int rstride = 64 * (qb + 1);
        for (int jp = 8 * seg + (w >> 1); jp <= jplast; jp += 4) {
            const int nt2 = (2 * jp + 1 <= qb) ? 2 : 1;
            bf16x8 kfa[4][4];
#pragma unroll
            for (int q4 = 0; q4 < 4; ++q4) { const int jq = 2 * jp + ((q4 >> 1) < nt2 ? (q4 >> 1) : 0);
#pragma unroll
                for (int s = 0; s < 4; ++s) kfa[q4][s] = *(const GAS bf16x8*)(IK + ((size_t)b * SEQ + 64 * jq + 32 * (q4 & 1) + r) * 64 + 8 * h + 16 * s); }
#pragma unroll
            for (int ts = 0; ts < 2; ++ts) { if (ts < nt2) {
#pragma unroll
                for (int p = 0; p < 2; ++p) {
                    float sc[16];
#pragma unroll
                    for (int i = 0; i < 16; ++i) sc[i] = 0.f;
#pragma unroll
                    for (int hd = 0; hd < 4; ++hd) {
                        f32x16 acc;
#pragma unroll
                        for (int i = 0; i < 16; ++i) acc[i] = 0.f;
#pragma unroll
                        for (int s = 0; s < 4; ++s) acc = MFMA32(kfa[2 * ts + p][s], qf[hd][s], acc);
#pragma unroll
                        for (int i = 0; i < 16; ++i) sc[i] += wv[hd] * fmaxf(acc[i], 0.f);
                    }
#pragma unroll
                    for (int i = 0; i < 16; i += 2) {
                        const unsigned lo = __builtin_bit_cast(unsigned short, (_Float16)(sc[i] + 0.0f)), hi = __builtin_bit_cast(unsigned short, (_Float16)(sc[i + 1] + 0.0f));
                        T[r * 65 + ((64 * ts + 32 * p + (i & 3) + 8 * (i >> 2) + 4 * h) >> 1)] = lo | (hi << 16); }
                }
            } }
            WSYNC();
            if (lane < 32 * nt2) {
#pragma unroll 8
                for (int q = 0; q < 32; ++q) *(unsigned*)(scb + (size_t)q * rstride + 128 * jp + 2 * lane) = T[q * 65 + lane];
            }
            WSYNC();
        }
    }
}
DI unsigned long long spread32(unsigned x) {
    unsigned long long v = x;
    v = (v | (v << 16)) & 0x0000FFFF0000FFFFull; v = (v | (v << 8)) & 0x00FF00FF00FF00FFull; v = (v | (v << 4)) & 0x0F0F0F0F0F0F0F0Full;
    v = (v | (v << 2)) & 0x3333333333333333ull; v = (v | (v << 1)) & 0x5555555555555555ull; return v;
}
DI unsigned pack_nib(unsigned long long bm, int hh) {
    unsigned long long x = (bm >> (4 * hh)) & 0x0F0F0F0F0F0F0F0Full;
    x = (x | (x >> 4)) & 0x00FF00FF00FF00FFull; x = (x | (x >> 8)) & 0x0000FFFF0000FFFFull; x = (x | (x >> 16)) & 0x00000000FFFFFFFFull; return (unsigned)x;
}
DI void radix_find(LAS unsigned* hist, int lane, int& need, unsigned& digit, unsigned& cnt) {
    const u32x4 c = *(LAS const u32x4*)(hist + 4 * lane);
    const unsigned ls = (c.x + c.y) + (c.z + c.w); unsigned inc = ls;
#pragma unroll
    for (int o = 1; o < 64; o <<= 1) { const unsigned y = shup_u(inc, o, lane); if (lane >= o) inc += y; }
    const unsigned total = rdl_u(inc, 63);
    unsigned cum = total - inc; int fbin = -1; unsigned fneed = 0u, fcnt = 0u;
    if (cum < (unsigned)need && cum + c.w >= (unsigned)need) { fbin = 4 * lane + 3; fneed = (unsigned)need - cum; fcnt = c.w; } cum += c.w;
    if (fbin < 0 && cum < (unsigned)need && cum + c.z >= (unsigned)need) { fbin = 4 * lane + 2; fneed = (unsigned)need - cum; fcnt = c.z; } cum += c.z;
    if (fbin < 0 && cum < (unsigned)need && cum + c.y >= (unsigned)need) { fbin = 4 * lane + 1; fneed = (unsigned)need - cum; fcnt = c.y; } cum += c.y;
    if (fbin < 0 && cum < (unsigned)need && cum + c.x >= (unsigned)need) { fbin = 4 * lane; fneed = (unsigned)need - cum; fcnt = c.x; }
    const int src = __ffsll((long long)__ballot(fbin >= 0)) - 1;
    digit = rdl_u((unsigned)fbin, src); need = (int)rdl_u(fneed, src); cnt = rdl_u(fcnt, src);
}
template <int NGP>
DI void select_row(int row, int lane, LAS unsigned* hist, const unsigned (&raw)[32], unsigned* MASK, const int probe) {
        const int b = row >> 12, t = row & (SEQ - 1), n = t + 1, ngp = (t >> 7) + 1;
        unsigned key[NGP];
        (void)b;
#pragma unroll
        for (int i = 0; i < NGP; ++i) key[i] = raw[i];
#pragma unroll
        for (int i = 0; i < NGP; ++i) { const int e2 = 64 * i + lane; unsigned w_ = key[i];
            { const unsigned sg_ = (w_ >> 15) & 0x00010001u; w_ ^= ((sg_ << 15) - sg_) + 0x80008000u; }
            if (2 * e2 >= n) w_ &= 0xFFFF0000u; if (2 * e2 + 1 >= n) w_ &= 0x0000FFFFu; key[i] = w_; }
        unsigned thr = 0u; int need = 256; bool ties = false;
        if (n > 256 && probe != 1 && probe != 3) {
            unsigned dA = 0u, dB = 0u, cnt = 0u;
            { unsigned z_ = 0u; asm volatile("" : "+v"(z_)); *(LAS u32x4*)(hist + 4 * lane) = (u32x4){z_, z_, z_, z_}; }
            WSYNC();
#pragma unroll
            for (int i = 0; i < NGP; ++i) if (i < ngp) { const unsigned kx = key[i];
                __hip_atomic_fetch_add(&hist[(kx >> 8) & 255u], 1u, __ATOMIC_RELAXED, __HIP_MEMORY_SCOPE_WORKGROUP); __hip_atomic_fetch_add(&hist[kx >> 24], 1u, __ATOMIC_RELAXED, __HIP_MEMORY_SCOPE_WORKGROUP); }
            WSYNC();
            radix_find(hist, lane, need, dA, cnt);
            WSYNC();
            if ((unsigned)need != cnt) {
                { unsigned z_ = 0u; asm volatile("" : "+v"(z_)); *(LAS u32x4*)(hist + 4 * lane) = (u32x4){z_, z_, z_, z_}; }
                WSYNC();
#pragma unroll
                for (int i = 0; i < NGP; ++i) if (i < ngp) { const unsigned kx = key[i];
                    if (((kx >> 8) & 255u) == dA) __hip_atomic_fetch_add(&hist[kx & 255u], 1u, __ATOMIC_RELAXED, __HIP_MEMORY_SCOPE_WORKGROUP);
                    if ((kx >> 24) == dA) __hip_atomic_fetch_add(&hist[(kx >> 16) & 255u], 1u, __ATOMIC_RELAXED, __HIP_MEMORY_SCOPE_WORKGROUP); }
                WSYNC();
                radix_find(hist, lane, need, dB, cnt);
                WSYNC();
                thr = (dA << 8) | dB; ties = (unsigned)need != cnt;
            } else { thr = dA << 8; ties = false; }
        }
        unsigned elo = 0u, ehi = 0u, olo = 0u, ohi = 0u; int eqc = 0;
        if (probe == 1 || probe == 3) thr = 0x9000u;
        if (probe < 2)
        {
#define SEL_STEP(i) if constexpr ((i) < NGP) if ((i) < ngp) { const unsigned kx = key[(i) < NGP ? (i) : 0], kl = kx & 0xFFFFu, kh = kx >> 16; bool sl, sh; \
            if (n <= 256) { sl = kl != 0u; sh = kh != 0u; } \
            else if (!ties) { sl = kl >= thr; sh = kh >= thr; } \
            else { const bool ql = kl == thr, qh = kh == thr; const unsigned long long ml = __ballot(ql), mh = __ballot(qh), lt = (1ull << lane) - 1ull; \
                const int rl = eqc + __popcll(ml & lt) + __popcll(mh & lt), rh = rl + (ql ? 1 : 0); \
                sl = kl > thr || (ql && rl < need); sh = kh > thr || (qh && rh < need); eqc += __popcll(ml) + __popcll(mh); } \
            const unsigned long long be = __ballot(sl), bo = __ballot(sh); const unsigned e0 = (unsigned)be, e1 = (unsigned)(be >> 32), o0 = (unsigned)bo, o1 = (unsigned)(bo >> 32); \
            asm volatile("s_nop 4\n\tv_writelane_b32 %0, %4, " #i "\n\tv_writelane_b32 %1, %5, " #i "\n\tv_writelane_b32 %2, %6, " #i "\n\tv_writelane_b32 %3, %7, " #i \
                         : "+v"(elo), "+v"(ehi), "+v"(olo), "+v"(ohi) : "s"(e0), "s"(e1), "s"(o0), "s"(o1)); }
#define SEL8(b) SEL_STEP(b) SEL_STEP(b + 1) SEL_STEP(b + 2) SEL_STEP(b + 3) SEL_STEP(b + 4) SEL_STEP(b + 5) SEL_STEP(b + 6) SEL_STEP(b + 7)
        SEL8(0) SEL8(8) SEL8(16) SEL8(24)
#undef SEL8
#undef SEL_STEP
        }
        if (lane < 32) {
            const unsigned long long ta = spread32(elo) | (spread32(olo) << 1), tb = spread32(ehi) | (spread32(ohi) << 1);
            *(u32x2*)(MASK + ((size_t)row * 2 + 0) * 64 + 2 * lane) = (u32x2){pack_nib(ta, 0), pack_nib(tb, 0)};
            *(u32x2*)(MASK + ((size_t)row * 2 + 1) * 64 + 2 * lane) = (u32x2){pack_nib(ta, 1), pack_nib(tb, 1)};
        }
}
DI void phase_select(Frame& F, const int probe) {
    F.refresh();
    const int gw = F.bid * NWAVES + F.wave, NGW = F.G * NWAVES, lane = F.lane;
    LAS unsigned* hist = (LAS unsigned*)(F.lds + F.wave * 1024);
    const unsigned short* SC = (const unsigned short*)(F.ws + WS_HREG); unsigned* MASK = (unsigned*)(F.ws + WS_MASK);
    if (!probe) mlstm_state_scan(F);
    unsigned cur[32];
#define LOAD_ROW(dst, rw) do { const int t_ = (rw) & (SEQ - 1), em_ = t_ >> 1; const unsigned* sr_ = (const unsigned*)(SC + sc_off((rw) >> 12, t_)); \
        _Pragma("unroll") for (int i_ = 0; i_ < 32; ++i_) { const int e_ = 64 * i_ + lane; dst[i_] = *(const GAS unsigned*)(sr_ + (e_ < em_ ? e_ : em_)); } } while (0)
    const int nstep = (MC + NGW - 1) / NGW;
#define ROW_OF(k) ((NGW == 2048) ? (((k) >> 1) * SEQ + (((k) & 1) ? (SEQ - 1 - gw) : gw)) : (gw + (k) * NGW))
    if (gw < MC) LOAD_ROW(cur, ROW_OF(0));
    for (int k = 0; k < nstep; ++k) {
        const int row = ROW_OF(k); if (row >= MC) break;
        unsigned nxt[32]; const int nrow = (k + 1 < nstep && ROW_OF(k + 1) < MC) ? ROW_OF(k + 1) : row;
        LOAD_ROW(nxt, nrow);
        asm volatile("" ::: "memory");
        const int cls = (row & (SEQ - 1)) >> 10;
        unsigned* mk = probe ? (unsigned*)(F.ws + WS_QKRAW) : MASK;
        if (cls == 0) select_row<8>(row, lane, hist, cur, mk, probe);
        else if (cls == 1) select_row<16>(row, lane, hist, cur, mk, probe);
        else if (cls == 2) select_row<24>(row, lane, hist, cur, mk, probe);
        else select_row<32>(row, lane, hist, cur, mk, probe);
#pragma unroll
        for (int i = 0; i < 32; ++i) cur[i] = nxt[i];
    }
#undef ROW_OF
#undef LOAD_ROW
}

#ifndef MK_ONE_LAUNCH
#define MK_ONE_LAUNCH 1
#endif
constexpr int NPHASE = 13;
__global__ void __launch_bounds__(NWAVES * 64, 2) fwd(Args args) {
    extern __shared__ __attribute__((aligned(16))) unsigned char lds[];
    Frame F;
    F.lds = (LAS unsigned char*)lds; F.ws = args.ws;
    F.tid = threadIdx.x; F.lane = F.tid & 63; F.wave = __builtin_amdgcn_readfirstlane(F.tid >> 6); F.wave0 = F.wave;
    F.G = gridDim.x; F.bid = blockIdx.x;
    volatile LAS unsigned* MISC = (volatile LAS unsigned*)(F.lds + MISC_OFF);
    for (int u = F.tid; u < (LDS_BYTES - LDSCTL_OFF) / 4; u += NWAVES * 64) ((LAS unsigned*)(F.lds + LDSCTL_OFF))[u] = 0u;
    __syncthreads();
    const bool multi = MK_ONE_LAUNCH ? true : !(args.it_hi - args.it_lo == 1 && args.ph_hi - args.ph_lo == 1);
    XcdBarrier bar; bar.bar = (unsigned*)(F.ws + WS_CTL) + CW_BAR; bar.x = 0; bar.st = nullptr;
    if (multi) bar = xcd_barrier_post((unsigned*)(F.ws + WS_CTL) + CW_BAR, MISC + 8);
#define GRID_BAR() do { if (multi) { xcd_barrier(bar); if ((REPMASK >> 15) & 1) xcd_barrier(bar); } } while (0)
    const int lo = args.ph_lo, hi = args.ph_hi; (void)lo; (void)hi;
#ifndef PHMASK
#define PHMASK 0xFFFF
#endif
#if MK_ONE_LAUNCH
#define IN(k) ((PHMASK >> (k)) & 1)
#else
#define IN(k) (((PHMASK >> (k)) & 1) && lo <= (k) && (k) < hi)
#endif
#define REPS(k) (1 + ((REPMASK >> (k)) & 1))
    if (IN(0) && args.it_lo == 0) for (int rp = 0; rp < REPS(0); ++rp) { phase_prologue(F, args); GRID_BAR(); }
    for (int it = args.it_lo; it < args.it_hi; ++it) {
        const int chunk = it >> 1, l = it & 1;
        unsigned char* wl = F.ws + WS_W + (size_t)l * W_LAYER;
        const size_t xoff = (size_t)chunk * MC * DM;
        const float* xin = args.in[I_X] + xoff;
        float* Xout = args.out + xoff;
        bf16_t* X16 = (bf16_t*)(F.ws + WS_X16);
        bf16_t* XN = (bf16_t*)(F.ws + WS_XN);
        if (IN(1)) for (int rp = 0; rp < REPS(1); ++rp) { phase_rmsnorm(F, l == 0 ? (const void*)xin : (const void*)X16, l != 0, args.in[I_NMG] + (size_t)l * DM, XN); GRID_BAR(); }
        if (IN(2)) for (int rp = 0; rp < REPS(2); ++rp) {
            pg8::Gemm g{XN, (const bf16_t*)(wl + WO_IN), MC, NT_IN * 256, DM}; F.refresh(); pg8::StaticOrder S; S.init(MC, NT_IN * 256, F.G, F.bid);
            EpiInProj E{F.ws, args.in[I_GB] + l * 8, l};
            pg8::gemm_phase<EpiInProj, true>(F.lds, g, S, E, F.tid);
            GRID_BAR();
        }
        if (IN(3)) for (int rp = 0; rp < REPS(3); ++rp) { phase_token(F, args, l, rp == 0 ? 0 : PROBE_NOLOAD); GRID_BAR(); }
        if (IN(4)) for (int rp = 0; rp < REPS(4); ++rp) {
            pg8::Gemm g{(const bf16_t*)(F.ws + WS_CKV), (const bf16_t*)(wl + WO_KV), MC, 1024, 256}; F.refresh(); pg8::StaticOrder S; S.init(MC, 1024, F.G, F.bid);
            EpiKV E{F.ws, l};
            pg8::gemm_phase<EpiKV, true>(F.lds, g, S, E, F.tid);
            if (rp + 1 < REPS(4)) GRID_BAR();
        }
#ifdef NAIVE_SEL
        if (IN(5)) { naive_select(F); GRID_BAR(); }
#else
        if (IN(5)) { for (int rp = 0; rp < REPS(5); ++rp) { phase_scores(F, it + 8 * rp); GRID_BAR(); } for (int rp = 0; rp < REPS(13); ++rp) { phase_select(F, rp == 0 ? 0 : PROBE_NOLOAD); GRID_BAR(); } }
#endif
                if (IN(7)) for (int rp = 0; rp < REPS(7); ++rp) {
            pg8::Gemm g{XN, (const bf16_t*)(wl + WO_G), MC, 3072, DM}; F.refresh(); pg8::StaticOrder S; S.init(MC, 3072, F.G, F.bid);
            EpiGate E{F.ws + WS_HREG, args.in[I_BG] + (size_t)l * 3072};
            pg8::gemm_phase<EpiGate, true>(F.lds, g, S, E, F.tid);
            if (rp + 1 < REPS(7)) GRID_BAR();
        }
#ifdef NAIVE_MIX
        if (IN(6)) { naive_dsa(F); __syncthreads(); naive_mlstm(F, args, l); __syncthreads(); naive_diff(F, args, l); GRID_BAR(); }
#else
        if (IN(6)) for (int rp = 0; rp < REPS(6); ++rp) { phase_mixers(F, args, l, it + 8 * rp, rp == 0 ? 7 : PROBE_MODES, rp == 0 ? 0 : PROBE_NOLOAD); GRID_BAR(); }
#endif
        if (IN(8)) for (int rp = 0; rp < REPS(8); ++rp) {
            pg8::Gemm g{(const bf16_t*)(F.ws + WS_Y), (const bf16_t*)(wl + WO_BR), MC, 1024, 1536}; F.refresh(); pg8::StaticOrder S; S.init(MC, 1024, F.G, F.bid);
            EpiMerge E{F.ws + WS_HREG, (bf16_t*)(F.ws + WS_MG)};
            pg8::gemm_phase<EpiMerge, false>(F.lds, g, S, E, F.tid);
            GRID_BAR();
        }
        if (IN(9)) for (int rp = 0; rp < REPS(9); ++rp) {
            pg8::Gemm g{(const bf16_t*)(F.ws + WS_MG), (const bf16_t*)(wl + WO_OUT), MC, 1024, 1024}; F.refresh(); pg8::StaticOrder S; S.init(MC, 1024, F.G, F.bid);
            EpiResid E{l == 0 ? (const void*)xin : (const void*)X16, (void*)X16, l != 0, true};
            pg8::gemm_phase<EpiResid, false>(F.lds, g, S, E, F.tid);
            GRID_BAR();
        }
        if (IN(10)) for (int rp = 0; rp < REPS(10); ++rp) { phase_rmsnorm(F, X16, true, args.in[I_NFG] + (size_t)l * DM, XN); GRID_BAR(); }
        if (IN(11)) for (int rp = 0; rp < REPS(11); ++rp) {
            pg8::Gemm g{XN, (const bf16_t*)(wl + WO_GU), MC, 5632, DM}; F.refresh(); pg8::StaticOrder S; S.init(MC, 5632, F.G, F.bid);
            EpiSwiGLU E{(bf16_t*)(F.ws + WS_HREG)};
            pg8::gemm_phase<EpiSwiGLU, true>(F.lds, g, S, E, F.tid);
            GRID_BAR();
        }
        if (IN(12)) for (int rp = 0; rp < REPS(12); ++rp) {
            pg8::Gemm g{(const bf16_t*)(F.ws + WS_HREG), (const bf16_t*)(wl + WO_D), MC, 1024, FF}; F.refresh(); pg8::StaticOrder S; S.init(MC, 1024, F.G, F.bid);
            EpiResid E{(const void*)X16, l == DEPTH - 1 ? (void*)Xout : (void*)X16, true, l != DEPTH - 1};
            pg8::gemm_phase<EpiResid, false>(F.lds, g, S, E, F.tid);
            GRID_BAR();
        }
    }
#undef IN
#undef GRID_BAR
}

extern "C" void kernel_launch(void* const* d_in, const int* in_sizes, int n_in, void* d_out, int out_size, void* d_ws, size_t ws_size, hipStream_t stream) {
    static int grid = 0;
    if (grid == 0) {
        if (n_in != 21 || ws_size < WS_END) { fprintf(stderr, "kernel_launch: unexpected inputs (n_in %d, ws %zu)\n", n_in, ws_size); grid = -1; return; }
        int dev = 0, cus = 0;
        if (hipGetDevice(&dev) != hipSuccess || hipDeviceGetAttribute(&cus, hipDeviceAttributeMultiprocessorCount, dev) != hipSuccess) { grid = -1; return; }
        if (hipFuncSetAttribute((const void*)fwd, hipFuncAttributeMaxDynamicSharedMemorySize, LDS_BYTES) != hipSuccess) { grid = -1; return; }
        int per_cu = 0;
        if (hipOccupancyMaxActiveBlocksPerMultiprocessor(&per_cu, (const void*)fwd, NWAVES * 64, LDS_BYTES) != hipSuccess || per_cu < 1) fprintf(stderr, "kernel_launch: occupancy query says %d\n", per_cu);
        (void)hipGetLastError();
        grid = cus;
    }
    if (grid < 0) return;
    (void)hipMemsetAsync((char*)d_ws + WS_CTL, 0, CTL_ZERO_BYTES, stream);
    Args a{};
    for (int i = 0; i < 21; ++i) a.in[i] = (const float*)d_in[i];
    a.out = (float*)d_out; a.ws = (unsigned char*)d_ws;
#if MK_ONE_LAUNCH
    a.it_lo = 0; a.it_hi = NCHUNK * DEPTH; a.ph_lo = 0; a.ph_hi = NPHASE;
    hipLaunchKernelGGL(fwd, dim3(grid), dim3(NWAVES * 64), LDS_BYTES, stream, a);
#else
    a.it_lo = 0; a.it_hi = 1; a.ph_lo = 0; a.ph_hi = 1;
    hipLaunchKernelGGL(fwd, dim3(grid), dim3(NWAVES * 64), LDS_BYTES, stream, a);
    for (int it = 0; it < NCHUNK * DEPTH; ++it)
        for (int ph = 1; ph < NPHASE; ++ph) { a.it_lo = it; a.it_hi = it + 1; a.ph_lo = ph; a.ph_hi = ph + 1; hipLaunchKernelGGL(fwd, dim3(grid), dim3(NWAVES * 64), LDS_BYTES, stream, a); }
#endif
}
```

```cpp
#include <hip/hip_runtime.h>
#include <cstdio>
#include <cstdint>

#ifndef REPMASK
#define REPMASK 0
#endif
#define PROBE_MODES 7
#define PROBE_NOLOAD 0
#define DI __device__ __forceinline__
#define LAS __attribute__((address_space(3)))
#define GAS __attribute__((address_space(1)))

typedef unsigned short bf16_t;
typedef short bf16x8 __attribute__((ext_vector_type(8)));
typedef float f32x4 __attribute__((ext_vector_type(4)));
typedef float f32x2 __attribute__((ext_vector_type(2)));
typedef unsigned u32x4 __attribute__((ext_vector_type(4)));
typedef unsigned u32x2 __attribute__((ext_vector_type(2)));

constexpr int BATCH = 8, SEQ = 4096, DM = 1024, DEPTH = 2;
constexpr int CB = 4;
constexpr int MC = CB * SEQ;
constexpr int NCHUNK = BATCH / CB;
constexpr int IN_COLS = 7756;
constexpr int FF = 2816;
constexpr float EPS = 1e-6f;
constexpr float LOG2E = 1.4426950408889634f;
constexpr float C2 = 0.125f * LOG2E;
constexpr int Z_MQK = 0, Z_MV = 1024, Z_MO = 1536, Z_MIF = 2048, Z_SQ = 2056, Z_CKV = 2568, Z_IQ = 2824, Z_IK = 3080, Z_IW = 3144, Z_DQ = 3148, Z_DK = 3660, Z_DV = 4172, Z_G = 4684;
constexpr int NT_IN = 19;

constexpr size_t MiB = 1u << 20;
constexpr size_t WS_CTL = 0, CTL_ZERO_BYTES = 128 * 1024;
constexpr size_t WS_COS = 1 * MiB, WS_SIN = 1 * MiB + 512 * 1024;
constexpr size_t WS_W = 2 * MiB, W_LAYER = 38 * MiB;
constexpr size_t WO_IN = 0;
constexpr size_t WO_G = WO_IN + (size_t)NT_IN * 256 * 1024 * 2;
constexpr size_t WO_KV = WO_G + (size_t)3072 * 1024 * 2;
constexpr size_t WO_BR = WO_KV + (size_t)1024 * 256 * 2;
constexpr size_t WO_OUT = WO_BR + (size_t)1024 * 1536 * 2;
constexpr size_t WO_GU = WO_OUT + (size_t)1024 * 1024 * 2;
constexpr size_t WO_D = WO_GU + (size_t)5632 * 1024 * 2;
static_assert(WO_D + (size_t)1024 * 2816 * 2 <= W_LAYER, "weights per layer");
constexpr size_t WS_ACT = WS_W + 2 * W_LAYER;
constexpr size_t WS_XN = WS_ACT;
constexpr size_t WS_QKRAW = WS_XN + 32 * MiB;
constexpr size_t WS_CKV = WS_QKRAW + 32 * MiB;
constexpr size_t WS_IQ = WS_CKV + 8 * MiB;
constexpr size_t WS_Y = WS_QKRAW;
constexpr size_t WS_QK = WS_IQ + 8 * MiB;
constexpr size_t WS_MG = WS_QK;
constexpr size_t WS_VM = WS_QK + 32 * MiB;
constexpr size_t WS_OM = WS_VM + 16 * MiB;
constexpr size_t WS_SQ = WS_OM + 16 * MiB;
constexpr size_t WS_DQ = WS_SQ + 16 * MiB;
constexpr size_t WS_DK = WS_DQ + 16 * MiB;
constexpr size_t WS_DV = WS_DK + 16 * MiB;
constexpr size_t WS_SK = WS_DV + 16 * MiB;
constexpr size_t WS_SV = WS_SK + 16 * MiB;
constexpr size_t WS_IK = WS_SV + 16 * MiB;
constexpr size_t WS_IF = WS_IK + 2 * MiB;
constexpr size_t WS_IW = WS_IF + 512 * 1024;
constexpr size_t WS_RT = WS_IW + 256 * 1024;
constexpr size_t WS_SS = WS_RT + 64 * 1024;
constexpr size_t WS_AK = WS_RT + 256 * 1024;
constexpr size_t WS_MQ = WS_AK + 256 * 1024;
constexpr size_t WS_EM = WS_MQ + 256 * 1024;
constexpr size_t WS_MASK = WS_IK + 4 * MiB;
constexpr size_t WS_HREG = WS_MASK + 8 * MiB;
constexpr size_t WS_X16 = WS_HREG + 96 * MiB;
constexpr size_t WS_MD = WS_X16 + 32 * MiB;
constexpr size_t WS_MC = WS_MD + 16 * MiB;
constexpr size_t WS_MN = WS_MC + 8 * MiB;
constexpr size_t WS_END = WS_MN + 1 * MiB;
static_assert(WS_EM + 256 * 1024 <= WS_MASK, "small buffers");
constexpr size_t WS_G0 = WS_END;
static_assert(WS_G0 + 4 * MiB <= 512 * MiB, "workspace");
constexpr int CW_BAR = 4096;
constexpr size_t WS_GAIN = 512 * 1024;

constexpr int RING_BYTES = 131072;
constexpr int LDSCTL_OFF = RING_BYTES, MISC_OFF = LDSCTL_OFF + 320;
constexpr int LDS_BYTES = 147456;
constexpr int NWAVES = 8;

DI float bf2f(unsigned v) { return __uint_as_float(v << 16); }
DI unsigned f2bf(float f) { unsigned u = __float_as_uint(f); return (u + 0x7fffu + ((u >> 16) & 1u)) >> 16; }
DI unsigned pk2(float lo, float hi) { return f2bf(lo) | (f2bf(hi) << 16); }
DI float bflo(unsigned w) { return __uint_as_float(w << 16); }
DI float bfhi(unsigned w) { return __uint_as_float(w & 0xffff0000u); }
typedef unsigned u32x2v __attribute__((ext_vector_type(2)));
DI float xor1(float v)  { return __uint_as_float((unsigned)__builtin_amdgcn_mov_dpp((int)__float_as_uint(v), 0xB1, 0xF, 0xF, true)); }
DI float xor2(float v)  { return __uint_as_float((unsigned)__builtin_amdgcn_mov_dpp((int)__float_as_uint(v), 0x4E, 0xF, 0xF, true)); }
DI float ror4(float v)  { return __uint_as_float((unsigned)__builtin_amdgcn_mov_dpp((int)__float_as_uint(v), 0x124, 0xF, 0xF, true)); }
DI float ror8(float v)  { return __uint_as_float((unsigned)__builtin_amdgcn_mov_dpp((int)__float_as_uint(v), 0x128, 0xF, 0xF, true)); }
DI float sum16x(float v) { const unsigned u = __float_as_uint(v); const auto r = __builtin_amdgcn_permlane16_swap(u, u, false, false); return __uint_as_float(r[0]) + __uint_as_float(r[1]); }
DI float sum32x(float v) { const unsigned u = __float_as_uint(v); const auto r = __builtin_amdgcn_permlane32_swap(u, u, false, false); return __uint_as_float(r[0]) + __uint_as_float(r[1]); }
DI float max16x(float v) { const unsigned u = __float_as_uint(v); const auto r = __builtin_amdgcn_permlane16_swap(u, u, false, false); return fmaxf(__uint_as_float(r[0]), __uint_as_float(r[1])); }
DI float max32x(float v) { const unsigned u = __float_as_uint(v); const auto r = __builtin_amdgcn_permlane32_swap(u, u, false, false); return fmaxf(__uint_as_float(r[0]), __uint_as_float(r[1])); }
DI unsigned shup_u(unsigned v, int o, int lane) { return (unsigned)__builtin_amdgcn_ds_bpermute(((lane - o) & 63) << 2, (int)v); }
DI float shup_f(float v, int o, int lane) { return __uint_as_float(shup_u(__float_as_uint(v), o, lane)); }
DI double shup_d(double v, int o, int lane) { const unsigned long long u = __builtin_bit_cast(unsigned long long, v); const unsigned lo = shup_u((unsigned)u, o, lane), hi = shup_u((unsigned)(u >> 32), o, lane); return __builtin_bit_cast(double, ((unsigned long long)hi << 32) | lo); }
DI unsigned rdl_u(unsigned v, int src) { return (unsigned)__builtin_amdgcn_readlane((int)v, src); }
DI float wave_sum(float v) { v += xor1(v); v += xor2(v); v += ror4(v); v += ror8(v); v = sum16x(v); return sum32x(v); }
DI float wave_max(float v) { v = fmaxf(v, xor1(v)); v = fmaxf(v, xor2(v)); v = fmaxf(v, ror4(v)); v = fmaxf(v, ror8(v)); v = max16x(v); return max32x(v); }
typedef __bf16 bf16x2e_t __attribute__((ext_vector_type(2)));
DI unsigned cvtpk_(float lo, float hi) { f32x2 v = {lo, hi}; bf16x2e_t b = __builtin_convertvector(v, bf16x2e_t); return __builtin_bit_cast(unsigned, b); }
DI float fexp2(float x) { return __builtin_amdgcn_exp2f(x); }
DI float fexp(float x) { return __builtin_amdgcn_exp2f(x * LOG2E); }
DI float frcp(float x) { return __builtin_amdgcn_rcpf(x); }
DI float sigmoidf_(float x) { return frcp(1.0f + fexp(-x)); }
#define WSYNC() do { asm volatile("s_waitcnt lgkmcnt(0)" ::: "memory"); __builtin_amdgcn_wave_barrier(); } while (0)

namespace pg8 {
constexpr int BM = 256, BK = 64, HALF = 128, HTB = HALF * BK * 2, STAGE_BYTES = 8 * HTB, NXCD = 8, WGM = 8;
__host__ __device__ __forceinline__ int lds_byte(int r, int c) { const int st = (r >> 4) * 2 + (c >> 5), rr = r & 15, cc = c & 31, ob = rr * 64 + cc * 2; return st * 1024 + (ob ^ (((ob >> 9) & 1) << 5)); }
__host__ __device__ __forceinline__ void stage_rc(int b, int& R, int& C) { const int st = b / 1024, sb = b % 1024, swz = sb ^ (((sb >> 9) & 1) << 5); R = (st >> 1) * 16 + swz / 64; C = (st & 1) * 32 + (swz % 64) / 2; }
__host__ __device__ __forceinline__ int perm32(int rho) { const int n = rho >> 4, i = rho & 15; return 8 * (i >> 2) + 4 * n + (i & 3); }
struct Unit { int pm, pn; };
struct Gemm { const bf16_t* A; const bf16_t* Bt; int M, N, K; };
struct StaticOrder {
    int nM, nN, nwg, G, c;
    __host__ __device__ void init(int M, int N, int G_, int c_) { nM = M / BM; nN = N / BM; nwg = nM * nN; G = G_; c = c_; }
    __host__ __device__ bool next(int i, Unit& u) const {
        const long L = (long)i * G + c; if (L >= nwg) return false;
        int wgid = (int)L; { const int q = nwg / NXCD, r = nwg % NXCD, xcd = wgid % NXCD, off = wgid / NXCD; wgid = (xcd < r ? xcd * (q + 1) : r * (q + 1) + (xcd - r) * q) + off; }
        const int nig = WGM * nN, gid = wgid / nig, fm = gid * WGM, gsz = (nM - fm) < WGM ? (nM - fm) : WGM;
        u.pm = fm + ((wgid % nig) % gsz); u.pn = (wgid % nig) / gsz; return true;
    }
};
template <class Epi, bool ALIGN_EPI>
__device__ __forceinline__ void gemm_phase(LAS unsigned char* lds, const Gemm g, const StaticOrder& S, const Epi& E, int tid_in) {
    int tid_ = tid_in; asm volatile("" : "+v"(tid_));
    int K_ = g.K; asm volatile("" : "+s"(K_));
    const int tid = tid_, wid = __builtin_amdgcn_readfirstlane(tid >> 6), lane = tid & 63, wr = wid >> 2, wc = wid & 3, fr = lane & 15, fq = lane >> 4;
    const int K = K_, nt = K / BK;
    unsigned voffA[2], voffB[2];
#pragma unroll
    for (int i = 0; i < 2; ++i) { int R, C; stage_rc(tid * 16 + i * 8192, R, C); const int Rb = Epi::PERM ? ((R & ~31) + perm32(R & 31)) : R;
        voffA[i] = (unsigned)(R * K + C) * 2u; voffB[i] = (unsigned)(Rb * K + C) * 2u; }
    const size_t kstep = (size_t)(BK * 2);
    const size_t hstep = (size_t)HALF * K * 2;
    const size_t tstep = 2 * hstep;
    const unsigned ldsw = (unsigned)wid * 1024u;
    const int aoff = lds_byte(wr * 64 + fr, fq * 8), boff = lds_byte(wc * 32 + fr, fq * 8);
#define PG8_SA(b, h) (((b) * 2 + (h)) * HTB)
#define PG8_SB(b, h) ((4 + (b) * 2 + (h)) * HTB)
#define PG8_STAGE(bufoff, gbase, voff) do { _Pragma("unroll") for (int _i = 0; _i < 2; ++_i) \
        __builtin_amdgcn_global_load_lds((const unsigned*)((const char*)(gbase) + (voff)[_i]), (LAS unsigned*)(lds + (bufoff) + ldsw + _i * 8192), 16, 0, 0); } while (0)
#define PG8_LDA(dst, b, h) do { _Pragma("unroll") for (int m = 0; m < 4; ++m) _Pragma("unroll") for (int k = 0; k < 2; ++k) dst[m][k] = *(const LAS bf16x8*)(lds + PG8_SA(b, h) + aoff + m * 2048 + k * 1024); } while (0)
#define PG8_LDB(dst, b, h) do { _Pragma("unroll") for (int n = 0; n < 2; ++n) _Pragma("unroll") for (int k = 0; k < 2; ++k) dst[n][k] = *(const LAS bf16x8*)(lds + PG8_SB(b, h) + boff + n * 2048 + k * 1024); } while (0)
#define PG8_MMA(ai, bj, At, Bt) do { __builtin_amdgcn_s_setprio(1); _Pragma("unroll") for (int m = 0; m < 4; ++m) _Pragma("unroll") for (int n = 0; n < 2; ++n) _Pragma("unroll") for (int k = 0; k < 2; ++k) \
        acc[ai][bj][m][n] = __builtin_amdgcn_mfma_f32_16x16x32_bf16(Bt[n][k], At[m][k], acc[ai][bj][m][n], 0, 0, 0); __builtin_amdgcn_s_setprio(0); } while (0)
#define PG8_WAIT_V(n) asm volatile("s_waitcnt vmcnt(" #n ")" ::: "memory")
#define PG8_WAIT_L(n) asm volatile("s_waitcnt lgkmcnt(" #n ")" ::: "memory")
#define PG8_BAR __builtin_amdgcn_s_barrier()
#define PG8_SCHED __builtin_amdgcn_sched_barrier(0)
    Unit cur, nxt; int ui = 0;
    if (!S.next(0, cur)) return;
    f32x4 acc[2][2][4][2];
    if constexpr (Epi::INIT) { int fr_ = fr, fq_ = fq, wr_ = wr, wc_ = wc; asm volatile("" : "+v"(fr_), "+v"(fq_), "+s"(wr_), "+s"(wc_)); E.init(acc, cur, wr_, wc_, fr_, fq_); }
    else {
#pragma unroll
    for (int a = 0; a < 2; ++a)
#pragma unroll
        for (int b = 0; b < 2; ++b)
#pragma unroll
            for (int m = 0; m < 4; ++m)
#pragma unroll
                for (int n = 0; n < 2; ++n) acc[a][b][m][n] = (f32x4){0.f, 0.f, 0.f, 0.f};
    }
    bf16x8 At[4][2], B0[2][2], B1[2][2];
    const char* cA = (const char*)g.A + (size_t)cur.pm * tstep; const char* cB = (const char*)g.Bt + (size_t)cur.pn * tstep;
    PG8_STAGE(PG8_SB(0, 0), cB, voffB); PG8_STAGE(PG8_SB(0, 1), cB + hstep, voffB); PG8_STAGE(PG8_SA(0, 0), cA, voffA); PG8_STAGE(PG8_SA(0, 1), cA + hstep, voffA);
    if (wr == 1) PG8_BAR;
    PG8_WAIT_V(2); PG8_BAR;
    PG8_STAGE(PG8_SB(1, 0), cB + kstep, voffB); PG8_STAGE(PG8_SA(1, 0), cA + kstep, voffA); PG8_STAGE(PG8_SB(1, 1), cB + hstep + kstep, voffB);
    PG8_WAIT_V(6); PG8_BAR;
    for (;;) {
        const bool has_next = S.next(ui + 1, nxt);
        const char* nA = has_next ? (const char*)g.A + (size_t)nxt.pm * tstep : cA; const char* nB = has_next ? (const char*)g.Bt + (size_t)nxt.pn * tstep : cB;
        asm volatile(".p2align 6");
        for (int t = 0; t < nt; t += 2) {
            const bool last = (t == nt - 2);
            const char* a1 = cA + (size_t)(t + 1) * kstep;
            const char* a2 = last ? nA : cA + (size_t)(t + 2) * kstep; const char* b2 = last ? nB : cB + (size_t)(t + 2) * kstep;
            const char* a3 = a2 + kstep; const char* b3 = b2 + kstep;
            if constexpr (Epi::MIDK) { if (t == 8 || t == 16) { int fr_ = fr, fq_ = fq, wr_ = wr, wc_ = wc; asm volatile("" : "+v"(fr_), "+v"(fq_), "+s"(wr_), "+s"(wc_)); E.mid(acc, cur, t, wr_, wc_, fr_, fq_); } }
            PG8_LDB(B0, 0, 0); PG8_LDB(B1, 0, 1); PG8_SCHED; PG8_LDA(At, 0, 0); PG8_STAGE(PG8_SA(1, 1), a1 + hstep, voffA);
            PG8_WAIT_V(8); PG8_WAIT_L(0); PG8_BAR; PG8_MMA(0, 0, At, B0); PG8_MMA(0, 1, At, B1); PG8_BAR; PG8_SCHED;
            PG8_LDA(At, 0, 1); PG8_STAGE(PG8_SB(0, 0), b2, voffB); PG8_STAGE(PG8_SB(0, 1), b2 + hstep, voffB); PG8_STAGE(PG8_SA(0, 0), a2, voffA);
            PG8_WAIT_V(8); PG8_WAIT_L(0); PG8_BAR; PG8_MMA(1, 0, At, B0); PG8_MMA(1, 1, At, B1); PG8_BAR; PG8_SCHED;
            PG8_LDB(B0, 1, 0); PG8_LDB(B1, 1, 1); PG8_SCHED; PG8_LDA(At, 1, 0); PG8_STAGE(PG8_SA(0, 1), a2 + hstep, voffA);
            PG8_WAIT_V(8); PG8_WAIT_L(0); PG8_BAR; PG8_MMA(0, 0, At, B0); PG8_MMA(0, 1, At, B1); PG8_BAR; PG8_SCHED;
            PG8_LDA(At, 1, 1); PG8_STAGE(PG8_SB(1, 0), b3, voffB); PG8_STAGE(PG8_SB(1, 1), b3 + hstep, voffB); PG8_STAGE(PG8_SA(1, 0), a3, voffA);
            PG8_WAIT_V(8); PG8_WAIT_L(0); PG8_BAR; PG8_MMA(1, 0, At, B0); PG8_MMA(1, 1, At, B1); PG8_BAR; PG8_SCHED;
        }
        if constexpr (ALIGN_EPI) { if (wr == 0) PG8_BAR; }
        { int fr_ = fr, fq_ = fq, wr_ = wr, wc_ = wc; asm volatile("" : "+v"(fr_), "+v"(fq_), "+s"(wr_), "+s"(wc_)); E(acc, cur, wr_, wc_, fr_, fq_); }
        if (!has_next) break;
        if constexpr (Epi::INIT) { int fr_ = fr, fq_ = fq, wr_ = wr, wc_ = wc; asm volatile("" : "+v"(fr_), "+v"(fq_), "+s"(wr_), "+s"(wc_)); E.init(acc, nxt, wr_, wc_, fr_, fq_); }
        else {
#pragma unroll
        for (int a = 0; a < 2; ++a)
#pragma unroll
            for (int b = 0; b < 2; ++b)
#pragma unroll
                for (int m = 0; m < 4; ++m)
#pragma unroll
                    for (int n = 0; n < 2; ++n) acc[a][b][m][n] = (f32x4){0.f, 0.f, 0.f, 0.f};
        }
        cur = nxt; cA = nA; cB = nB; ++ui;
        if constexpr (ALIGN_EPI) { if (wr == 1) PG8_BAR; }
    }
    PG8_WAIT_V(0);
    if constexpr (!ALIGN_EPI) { if (wr == 0) PG8_BAR; }
    PG8_BAR;
#undef PG8_SA
#undef PG8_SB
#undef PG8_STAGE
#undef PG8_LDA
#undef PG8_LDB
#undef PG8_MMA
#undef PG8_WAIT_V
#undef PG8_WAIT_L
#undef PG8_BAR
#undef PG8_SCHED
}
}

#define XB_TMO      128
#define XB_XCNT(j)  (256  + 64 * (j))
#define XB_XSUB(j)  (1280 + 64 * (j))
#define XB_XGEN(j)  (2304 + 64 * (j))
#define XB_TOP      3328
#define XB_TOPGEN   3392
#define XCD_BAR_WORDS 3456
#define XB_SPIN_CAP (1u << 24)
DI unsigned xb_ld(unsigned* p)              { return __hip_atomic_load(p, __ATOMIC_RELAXED, __HIP_MEMORY_SCOPE_AGENT); }
DI unsigned xb_add(unsigned* p, unsigned v) { return __hip_atomic_fetch_add(p, v, __ATOMIC_RELAXED, __HIP_MEMORY_SCOPE_AGENT); }
DI unsigned xb_xcc_id() { return (unsigned)__builtin_amdgcn_s_getreg((3 << 11) | 20) & 0xFu; }
#define XB_SPIN(cond, bar) do { unsigned _sp = 0; while (cond) { __builtin_amdgcn_s_sleep(1); \
    if ((++_sp & 255u) == 0u) { if (xb_ld(&(bar)[XB_TMO])) break; if (_sp > XB_SPIN_CAP) { atomicAdd(&(bar)[XB_TMO], 1u); break; } } } } while (0)
struct XcdBarrier { unsigned* bar; unsigned x; volatile LAS unsigned* st; };
DI XcdBarrier xcd_barrier_post(unsigned* bar, volatile LAS unsigned* st) {
    XcdBarrier b; b.bar = bar; b.x = xb_xcc_id(); b.st = st;
    if (threadIdx.x == 0) (void)xb_add(&bar[XB_XCNT(b.x)], 1u);
    return b;
}
DI void xcd_barrier_complete(unsigned* bar, unsigned x, unsigned& nloc, unsigned& nx) {
    const unsigned G = gridDim.x * gridDim.y * gridDim.z;
    unsigned sum, cnt, mine, sp = 0u;
    for (;;) {
        sum = 0u; cnt = 0u; mine = 0u;
#pragma unroll
        for (unsigned j = 0; j < 16; ++j) { const unsigned c = xb_ld(&bar[XB_XCNT(j)]); sum += c; cnt += (c > 0u) ? 1u : 0u; mine = (j == x) ? c : mine; }
        if (sum == G) break;
        __builtin_amdgcn_s_sleep(1);
        if ((++sp & 255u) == 0u) { if (xb_ld(&bar[XB_TMO])) break; if (sp > XB_SPIN_CAP) { atomicAdd(&bar[XB_TMO], 1u); break; } }
    }
    nloc = mine > 0u ? mine : 1u; nx = cnt > 0u ? cnt : 1u;
}
DI void xcd_barrier(const XcdBarrier& b_in) {
    XcdBarrier b = b_in; { unsigned x_ = b.x; asm volatile("" : "+s"(x_)); b.x = x_; }
    asm volatile("s_waitcnt vmcnt(0)" ::: "memory");
    __syncthreads();
    if (threadIdx.x == 0) {
        unsigned* bar = b.bar;
        __builtin_amdgcn_s_waitcnt(0);
        unsigned nloc = b.st[0], nx = b.st[1];
        if (nloc == 0u) { xcd_barrier_complete(bar, b.x, nloc, nx); b.st[0] = nloc; b.st[1] = nx; }
        const unsigned old = xb_add(&bar[XB_XSUB(b.x)], 1u);
        const unsigned gen = old / nloc;
        if (old + 1u == (gen + 1u) * nloc) {
            __builtin_amdgcn_fence(__ATOMIC_RELEASE, "agent");
            asm volatile("s_waitcnt vmcnt(0)" ::: "memory");
            const unsigned og = xb_add(&bar[XB_TOP], 1u);
            const unsigned tg = og / nx;
            if (og + 1u == (tg + 1u) * nx) xb_add(&bar[XB_TOPGEN], 1u);
            else XB_SPIN(xb_ld(&bar[XB_TOPGEN]) == tg, bar);
            __builtin_amdgcn_fence(__ATOMIC_ACQUIRE, "agent");
            xb_add(&bar[XB_XGEN(b.x)], 1u);
            asm volatile("s_waitcnt vmcnt(0)" ::: "memory");
        } else {
            XB_SPIN(xb_ld(&bar[XB_XGEN(b.x)]) == gen, bar);
            __builtin_amdgcn_fence(__ATOMIC_ACQUIRE, "agent");
            asm volatile("s_waitcnt vmcnt(0)" ::: "memory");
        }
    }
    __syncthreads();
}

struct Args { const float* in[21]; float* out; unsigned char* ws; int it_lo, it_hi, ph_lo, ph_hi; };
enum { I_X = 0, I_NMG, I_WIN, I_BG, I_CW, I_CB, I_GB, I_MNG, I_KVNG, I_WKV, I_SQG, I_SKG, I_DQG, I_DKG, I_LAM, I_DOG, I_WBR, I_WOUT, I_NFG, I_WGU, I_WD };

struct Frame {
    LAS unsigned char* lds;
    GAS unsigned char* ws;
    int tid, lane, wave, G, bid;
    int wave0;
    DI void refresh() {
        int l_; asm volatile("v_mbcnt_lo_u32_b32 %0, -1, 0\n\tv_mbcnt_hi_u32_b32 %0, -1, %0" : "=v"(l_));
        GAS unsigned char* w_ = ws; int g_ = G, b_ = bid, wv_ = wave0; asm volatile("" : "+s"(w_), "+s"(g_), "+s"(b_), "+s"(wv_));
        ws = w_; G = g_; bid = b_; lane = l_; wave = wv_; tid = wv_ * 64 + l_; }
};

DI int map_in(int n) {
    const int pn = n >> 8, p = n & 255, bj = p >> 7, wcq = p & 127, wc = wcq >> 5, q = wcq & 31;
    const int hd = 32 * bj + q;
    switch (pn) {
        case 0: case 1: case 2: case 3: return Z_MQK + n;
        case 4: case 5: return Z_MV + (n - 4 * 256);
        case 6: case 7: return Z_MO + (n - 6 * 256);
        case 8: case 9: return Z_SQ + (4 * (pn - 8) + wc) * 64 + hd;
        case 10: return Z_CKV + p;
        case 11: return Z_IQ + wc * 64 + hd;
        case 12: case 13: return Z_DQ + (4 * (pn - 12) + wc) * 64 + hd;
        case 14: case 15: return Z_DK + (4 * (pn - 14) + wc) * 64 + hd;
        case 16: case 17: return Z_DV + (n - 16 * 256);
        default:
            if (wc == 0) return Z_IK + hd;
            if (wc == 1 && bj == 0) { if (q < 8) return Z_MIF + q; if (q < 12) return Z_IW + (q - 8); }
            return -1;
    }
}
DI int map_kv(int n) {
    const int pn = n >> 8, p = n & 255, bj = p >> 7, wcq = p & 127, wc = wcq >> 5, q = wcq & 31;
    if (pn < 2) return (4 * pn + wc) * 64 + 32 * bj + q;
    return n;
}
DI int map_gu(int n) {
    const int pn = n >> 8, p = n & 255;
    return (p >> 7) * FF + 128 * pn + (p & 127);
}
template <int MAP>
DI void transpose_item(const float* W, int ldw, int cbase, const float* kscale, bf16_t* WT, int ldo, int koff, int nblk, LAS float* scr, int item, int lane) {
    const int kb = item / nblk, nb = item % nblk, k0 = 64 * kb, n0 = 32 * nb;
    const int n = n0 + (lane & 31);
    int src;
    if (MAP == 0) src = n; else if (MAP == 1) src = map_in(n); else if (MAP == 2) src = map_kv(n); else src = map_gu(n);
    float tv_[32];
    const int srcc = src >= 0 ? src : 0;
#pragma unroll
    for (int i = 0; i < 32; ++i) tv_[i] = W[(size_t)(k0 + 2 * i + (lane >> 5)) * ldw + cbase + srcc];
#pragma unroll
    for (int i = 0; i < 32; ++i) { const int kk = 2 * i + (lane >> 5);
        float v = src >= 0 ? tv_[i] : 0.f;
        if (kscale) v *= kscale[k0 + kk];
        scr[kk * 33 + (lane & 31)] = v; }
    WSYNC();
    const int c = lane & 7;
#pragma unroll
    for (int j = 0; j < 4; ++j) { const int nn = (lane >> 3) + 8 * j; const LAS float* s = scr + (8 * c) * 33 + nn;
        u32x4 o; o.x = pk2(s[0 * 33], s[1 * 33]); o.y = pk2(s[2 * 33], s[3 * 33]); o.z = pk2(s[4 * 33], s[5 * 33]); o.w = pk2(s[6 * 33], s[7 * 33]);
        *(u32x4*)(WT + (size_t)(n0 + nn) * ldo + koff + k0 + 8 * c) = o; }
    WSYNC();
}
__device__ const float INVF[32] = {1.000000000e+00f, 7.498942018e-01f, 5.623413324e-01f, 4.216965139e-01f, 3.162277639e-01f, 2.371373922e-01f, 1.778279394e-01f, 1.333521456e-01f,
    1.000000015e-01f, 7.498941571e-02f, 5.623412877e-02f, 4.216964915e-02f, 3.162277862e-02f, 2.371373586e-02f, 1.778279431e-02f, 1.333521493e-02f,
    9.999999776e-03f, 7.498942316e-03f, 5.623413250e-03f, 4.216964822e-03f, 3.162277862e-03f, 2.371373819e-03f, 1.778279431e-03f, 1.333521446e-03f,
    1.000000047e-03f, 7.498941850e-04f, 5.623413017e-04f, 4.216965463e-04f, 3.162277862e-04f, 2.371373848e-04f, 1.778279402e-04f, 1.333521504e-04f};
DI void sincos_acc(float angf, float& c, float& s) {
    const double x = (double)angf;
    const double kd = __builtin_rint(x * 0.63661977236758134308);
    const double r = (x - kd * 1.5707963267948965580) - kd * 6.1232339957367658860e-17;
    const double r2 = r * r;
    double sp = -1.0 / 39916800.0; sp = sp * r2 + 1.0 / 362880.0; sp = sp * r2 - 1.0 / 5040.0; sp = sp * r2 + 1.0 / 120.0; sp = sp * r2 - 1.0 / 6.0; sp = sp * r2 + 1.0; sp *= r;
    double cp = 1.0 / 479001600.0; cp = cp * r2 - 1.0 / 3628800.0; cp = cp * r2 + 1.0 / 40320.0; cp = cp * r2 - 1.0 / 720.0; cp = cp * r2 + 1.0 / 24.0; cp = cp * r2 - 0.5; cp = cp * r2 + 1.0;
    const int k = (int)kd & 3;
    double cc, ss;
    if (k == 0) { cc = cp; ss = sp; } else if (k == 1) { cc = -sp; ss = cp; } else if (k == 2) { cc = -cp; ss = -sp; } else { cc = sp; ss = -cp; }
    c = (float)cc; s = (float)ss;
}
DI void phase_prologue(Frame& F, const Args& a, const int l_lo, const int l_hi, const bool tables, const int gw, const int NGW) {
    F.refresh();
    LAS float* scr = (LAS float*)(F.lds + F.wave * 16384);
    if (tables) {
    float* COS = (float*)(F.ws + WS_COS); float* SIN = (float*)(F.ws + WS_SIN);
    for (int i = gw * 64 + F.lane; i < SEQ * 32; i += NGW * 64) { const int t = i >> 5, f = i & 31; float c, s; sincos_acc((float)t * INVF[f], c, s); COS[i] = c; SIN[i] = s; }
    if (gw == 0) { float* GN = (float*)(F.ws + WS_GAIN);
        for (int l = 0; l < DEPTH; ++l) { GN[(l * 4 + 0) * 64 + F.lane] = a.in[I_SQG][l * 64 + F.lane]; GN[(l * 4 + 1) * 64 + F.lane] = a.in[I_DQG][l * 64 + F.lane];
            GN[(l * 4 + 2) * 64 + F.lane] = a.in[I_DKG][l * 64 + F.lane]; GN[(l * 4 + 3) * 64 + F.lane] = a.in[I_SKG][l * 64 + F.lane]; } }
    }
    for (int l = l_lo; l < l_hi; ++l) {
        unsigned char* wl = (unsigned char*)(F.ws + WS_W + (size_t)l * W_LAYER);
        const float* w_in = a.in[I_WIN] + (size_t)l * DM * IN_COLS;
        { const int nblk = NT_IN * 256 / 32, nit = (DM / 64) * nblk;
          for (int it = gw; it < nit; it += NGW) transpose_item<1>(w_in, IN_COLS, 0, nullptr, (bf16_t*)(wl + WO_IN), DM, 0, nblk, scr, it, F.lane); }
        { const int nblk = 3072 / 32, nit = (DM / 64) * nblk;
          for (int it = gw; it < nit; it += NGW) transpose_item<0>(w_in, IN_COLS, Z_G, nullptr, (bf16_t*)(wl + WO_G), DM, 0, nblk, scr, it, F.lane); }
        { const int nblk = 1024 / 32, nit = (256 / 64) * nblk;
          for (int it = gw; it < nit; it += NGW) transpose_item<2>(a.in[I_WKV] + (size_t)l * 256 * 1024, 1024, 0, a.in[I_KVNG] + l * 256, (bf16_t*)(wl + WO_KV), 256, 0, nblk, scr, it, F.lane); }
        for (int b = 0; b < 3; ++b) { const int nblk = 1024 / 32, nit = (512 / 64) * nblk;
          for (int it = gw; it < nit; it += NGW) transpose_item<0>(a.in[I_WBR] + ((size_t)l * 3 + b) * 512 * 1024, 1024, 0, nullptr, (bf16_t*)(wl + WO_BR), 1536, b * 512, nblk, scr, it, F.lane); }
        { const int nblk = 1024 / 32, nit = (1024 / 64) * nblk;
          for (int it = gw; it < nit; it += NGW) transpose_item<0>(a.in[I_WOUT] + (size_t)l * 1024 * 1024, 1024, 0, nullptr, (bf16_t*)(wl + WO_OUT), 1024, 0, nblk, scr, it, F.lane); }
        { const int nblk = 5632 / 32, nit = (1024 / 64) * nblk;
          for (int it = gw; it < nit; it += NGW) transpose_item<3>(a.in[I_WGU] + (size_t)l * 1024 * 5632, 5632, 0, a.in[I_NFG] + (size_t)l * DM, (bf16_t*)(wl + WO_GU), 1024, 0, nblk, scr, it, F.lane); }
        { const int nblk = 1024 / 32, nit = (2816 / 64) * nblk;
          for (int it = gw; it < nit; it += NGW) transpose_item<0>(a.in[I_WD] + (size_t)l * 2816 * 1024, 1024, 0, nullptr, (bf16_t*)(wl + WO_D), 2816, 0, nblk, scr, it, F.lane); }
    }
}

DI void phase_rmsnorm(Frame& F, const void* xv, const bool src16, const float* gain, bf16_t* out, const int gw, const int NGW) {
    F.refresh();
    f32x4 gv[4];
#pragma unroll
    for (int j = 0; j < 4; ++j) gv[j] = *(const f32x4*)(gain + 4 * F.lane + 256 * j);
    for (int m = gw; m < MC; m += NGW) {
        f32x4 v[4]; float s = 0.f;
        if (src16) { const GAS u32x2* xr = (const GAS u32x2*)((const bf16_t*)xv + (size_t)m * DM) + F.lane;
#pragma unroll
            for (int j = 0; j < 4; ++j) { const u32x2 w = xr[64 * j]; v[j] = (f32x4){bflo(w.x), bfhi(w.x), bflo(w.y), bfhi(w.y)}; }
        } else { const GAS f32x4* xr = (const GAS f32x4*)((const float*)xv + (size_t)m * DM) + F.lane;
#pragma unroll
            for (int j = 0; j < 4; ++j) v[j] = xr[64 * j]; }
#pragma unroll
        for (int j = 0; j < 4; ++j) s += (v[j].x * v[j].x + v[j].y * v[j].y) + (v[j].z * v[j].z + v[j].w * v[j].w);
        const float r = 1.0f / sqrtf(wave_sum(s) * (1.f / DM) + EPS);
        u32x2* o8 = (u32x2*)(out + (size_t)m * DM) + F.lane;
#pragma unroll
        for (int j = 0; j < 4; ++j) { u32x2 w; w.x = cvtpk_(v[j].x * r * gv[j].x, v[j].y * r * gv[j].y); w.y = cvtpk_(v[j].z * r * gv[j].z, v[j].w * r * gv[j].w); o8[64 * j] = w; }
    }
}
DI float log_sigmoid(float x) {
    const float ax = fabsf(x), y = fexp(-ax);
    float l1p;
    if (y < 0.06f) l1p = y * (1.f - y * (0.5f - y * (0.33333333f - y * (0.25f - y * 0.2f))));
    else l1p = __builtin_amdgcn_logf(1.f + y) * 0.69314718056f;
    return fminf(x, 0.f) - l1p;
}
DI void phase_token(Frame& F, const Args& a, int l, const int probe) {
    F.refresh();
    const int gw = F.bid * NWAVES + F.wave, NGW = F.G * NWAVES, NCV = NGW;
    { float* SSz = (float*)(F.ws + WS_SS); for (int i = gw * 64 + F.lane; i < MC; i += NCV * 64) SSz[i] = 0.f; }
    { if (probe != 2) {
    const bf16_t* QKRAW = (const bf16_t*)(F.ws + WS_QKRAW); bf16_t* QK = (bf16_t*)(F.ws + WS_QK);
    const bf16_t* CKV = (const bf16_t*)(F.ws + WS_CKV); float* RT = (float*)(F.ws + WS_RT);
    const float* cw = a.in[I_CW] + (size_t)l * 4 * 1024; const float* cb = a.in[I_CB] + (size_t)l * 1024;
    const int c0 = F.lane * 16;
    float w[4][16], bs[16];
#pragma unroll
    for (int j = 0; j < 4; ++j)
#pragma unroll
        for (int i = 0; i < 16; ++i) w[j][i] = cw[j * 1024 + c0 + i];
#pragma unroll
    for (int i = 0; i < 16; ++i) bs[i] = cb[c0 + i];
    const float ksc = (c0 >= 512) ? 0.08838834764831845f : 1.0f;
#pragma unroll 1
    for (int blk = gw; blk < MC / 8; blk += NCV) {
        const int m0 = blk * 8, t0 = m0 & (SEQ - 1);
        u32x4 tv[11][2];
#pragma unroll
        for (int j = 0; j < 7; ++j) { const int mm = (t0 == 0 && j < 3) ? m0 : m0 - 3 + j; const GAS u32x4* p = (const GAS u32x4*)(QKRAW + (size_t)mm * 1024 + c0); tv[j][0] = p[0]; tv[j][1] = p[1]; }
        if (t0 == 0) {
#pragma unroll
            for (int j = 0; j < 3; ++j) { unsigned z_ = 0u; asm volatile("" : "+v"(z_)); tv[j][0] = (u32x4){z_, z_, z_, z_}; tv[j][1] = (u32x4){z_, z_, z_, z_}; } }
#pragma unroll
        for (int r8 = 0; r8 < 8; ++r8) {
            const int m = m0 + r8;
            const u32x2 ckvr = *(const GAS u32x2*)(CKV + (size_t)m * 256 + 4 * F.lane);
            float accv[16];
#pragma unroll
            for (int i = 0; i < 16; ++i) accv[i] = bs[i];
#pragma unroll
            for (int j = 0; j < 4; ++j) {
                const unsigned ww[8] = {tv[r8 + j][0].x, tv[r8 + j][0].y, tv[r8 + j][0].z, tv[r8 + j][0].w, tv[r8 + j][1].x, tv[r8 + j][1].y, tv[r8 + j][1].z, tv[r8 + j][1].w};
#pragma unroll
                for (int i = 0; i < 8; ++i) { accv[2 * i] += w[j][2 * i] * bflo(ww[i]); accv[2 * i + 1] += w[j][2 * i + 1] * bfhi(ww[i]); } }
            unsigned o[8];
#pragma unroll
            for (int i = 0; i < 8; ++i) { const float x0 = accv[2 * i], x1 = accv[2 * i + 1]; o[i] = pk2(x0 * sigmoidf_(x0) * ksc, x1 * sigmoidf_(x1) * ksc); }
            GAS u32x4* q = (GAS u32x4*)(QK + (size_t)m * 1024 + c0); q[0] = (u32x4){o[0], o[1], o[2], o[3]}; q[1] = (u32x4){o[4], o[5], o[6], o[7]};
            { const u32x2 v = ckvr; const float a0 = bflo(v.x), a1 = bfhi(v.x), a2 = bflo(v.y), a3 = bfhi(v.y);
              const float ss = wave_sum((a0 * a0 + a1 * a1) + (a2 * a2 + a3 * a3)); if (F.lane == 0) RT[m] = 1.0f / sqrtf(ss * (1.f / 256.f) + EPS); }
            if (r8 < 4) { const GAS u32x4* p = (const GAS u32x4*)(QKRAW + (size_t)(m0 + r8 + 4) * 1024 + c0); tv[r8 + 7][0] = p[0]; tv[r8 + 7][1] = p[1]; }
        }
    }
    } }
}
constexpr int CW_SCAN = 20000;
DI void gate_scan_unit(Frame& F, int sq_in, unsigned* scan_cnt) {
    F.refresh();
    if (F.wave == 0) {
        const int sq = sq_in, b = sq >> 2, h = sq & 3, lane = F.lane; const float* IFb = (const float*)(F.ws + WS_IF) + (size_t)b * SEQ * 8;

        float* AK = (float*)(F.ws + WS_AK) + (size_t)sq * SEQ; float* MQ = (float*)(F.ws + WS_MQ) + (size_t)sq * SEQ; float* EM = (float*)(F.ws + WS_EM) + (size_t)sq * SEQ;
        LAS float* X0 = (LAS float*)F.lds; LAS float* X1 = X0 + 4160; LAS float* X2 = X1 + 4160;
#pragma unroll 1
        for (int c = 0; c < 4; ++c) { float fv[16], iv[16];
#pragma unroll
            for (int kk = 0; kk < 16; ++kk) { const size_t t = (size_t)64 * (16 * c + kk) + lane; fv[kk] = *(const GAS float*)(IFb + t * 8 + 4 + h); iv[kk] = *(const GAS float*)(IFb + t * 8 + h); }
#pragma unroll
            for (int kk = 0; kk < 16; ++kk) { const int t = 64 * (16 * c + kk) + lane; X0[t + (t >> 6)] = fv[kk]; X1[t + (t >> 6)] = iv[kk]; } }
        WSYNC();
        const int tb = 65 * lane;
        double sum = 0.0;
#pragma unroll 8
        for (int j = 0; j < 64; ++j) { const float lf = log_sigmoid(X0[tb + j]); X0[tb + j] = lf; sum += (double)lf; }
        double inc = sum;
#pragma unroll
        for (int o = 1; o < 64; o <<= 1) { const double y = shup_d(inc, o, lane); if (lane >= o) inc += y; }
        double bb = inc - sum; float mx = -INFINITY;
#pragma unroll 8
        for (int j = 0; j < 64; ++j) { bb += (double)X0[tb + j]; const float av = (float)((double)X1[tb + j] - bb); X1[tb + j] = av; X0[tb + j] = (float)bb; mx = fmaxf(mx, av); }
        float minc = mx;
#pragma unroll
        for (int o = 1; o < 64; o <<= 1) { const float y = shup_f(minc, o, lane); if (lane >= o) minc = fmaxf(minc, y); }
        float mrun = shup_f(minc, 1, lane); if (lane == 0) mrun = -INFINITY;
#pragma unroll 8
        for (int j = 0; j < 64; ++j) { mrun = fmaxf(mrun, X1[tb + j]); X2[tb + j] = mrun; X0[tb + j] = fexp(-(X0[tb + j] + mrun)); }
        WSYNC();
#pragma unroll 8
        for (int k = 0; k < 64; ++k) { const int t = 64 * k + lane, ix = t + k; AK[t] = X1[ix]; MQ[t] = X2[ix]; EM[t] = X0[ix]; }
        __builtin_amdgcn_fence(__ATOMIC_RELEASE, "agent");
        asm volatile("s_waitcnt vmcnt(0)" ::: "memory");
        if (F.lane == 0) __hip_atomic_fetch_add(scan_cnt, 1u, __ATOMIC_RELAXED, __HIP_MEMORY_SCOPE_AGENT);
    }
    __syncthreads();
}

DI void store8(bf16_t* p, f32x4 v0, f32x4 v1) { u32x4 w; w.x = cvtpk_(v0[0], v0[1]); w.y = cvtpk_(v0[2], v0[3]); w.z = cvtpk_(v1[0], v1[1]); w.w = cvtpk_(v1[2], v1[3]); *(u32x4*)p = w; }
DI void head_norm_rope(f32x4 (&x)[2][2], bool norm, const f32x4 (&gn)[2][2], const float* cosr, const float* sinr, int fq, float scale) {
    if (norm) {
        float ss = 0.f;
#pragma unroll
        for (int bj = 0; bj < 2; ++bj)
#pragma unroll
            for (int n = 0; n < 2; ++n) ss += (x[bj][n][0] * x[bj][n][0] + x[bj][n][1] * x[bj][n][1]) + (x[bj][n][2] * x[bj][n][2] + x[bj][n][3] * x[bj][n][3]);
        ss = sum16x(ss); ss = sum32x(ss);
        const float r = 1.0f / sqrtf(ss * (1.f / 64.f) + EPS);
#pragma unroll
        for (int bj = 0; bj < 2; ++bj)
#pragma unroll
            for (int n = 0; n < 2; ++n) x[bj][n] = x[bj][n] * r * gn[bj][n];
    }
#pragma unroll
    for (int n = 0; n < 2; ++n) { const f32x4 c = *(const f32x4*)(cosr + 8 * fq + 4 * n), s = *(const f32x4*)(sinr + 8 * fq + 4 * n);
        const f32x4 x1 = x[0][n], x2 = x[1][n]; x[0][n] = (x1 * c - x2 * s) * scale; x[1][n] = (x1 * s + x2 * c) * scale; }
}
DI void head_norm_rope_cs(f32x4 (&x)[2][2], bool norm, const f32x4 (&gn)[2][2], const f32x4 (&c)[2], const f32x4 (&sn)[2], float scale) {
    if (norm) {
        float ss = 0.f;
#pragma unroll
        for (int bj = 0; bj < 2; ++bj)
#pragma unroll
            for (int n = 0; n < 2; ++n) ss += (x[bj][n][0] * x[bj][n][0] + x[bj][n][1] * x[bj][n][1]) + (x[bj][n][2] * x[bj][n][2] + x[bj][n][3] * x[bj][n][3]);
        ss = sum16x(ss); ss = sum32x(ss);
        const float r = 1.0f / sqrtf(ss * (1.f / 64.f) + EPS);
#pragma unroll
        for (int bj = 0; bj < 2; ++bj)
#pragma unroll
            for (int n = 0; n < 2; ++n) x[bj][n] = x[bj][n] * r * gn[bj][n];
    }
#pragma unroll
    for (int n = 0; n < 2; ++n) { const f32x4 x1 = x[0][n], x2 = x[1][n]; x[0][n] = (x1 * c[n] - x2 * sn[n]) * scale; x[1][n] = (x1 * sn[n] + x2 * c[n]) * scale; }
}
struct EpiInProj {
    static constexpr bool PERM = true, MIDK = false, INIT = false;
    unsigned char* ws; const float* gate_b; int layer;
    DI void operator()(const f32x4 (&acc)[2][2][4][2], const pg8::Unit& u, int wr, int wc, int fr, int fq) const {
        const int pn = u.pn; const int rowb = u.pm * 256 + wr * 64 + fr;
        if (pn < 8 || pn == 10 || pn == 16 || pn == 17) {
            size_t doff; int ldc, cb; bool sg = false;
            if (pn < 4) { doff = WS_QKRAW; ldc = 1024; cb = pn * 256; }
            else if (pn < 6) { doff = WS_VM; ldc = 512; cb = (pn - 4) * 256; }
            else if (pn < 8) { doff = WS_OM; ldc = 512; cb = (pn - 6) * 256; sg = true; }
            else if (pn == 10) { doff = WS_CKV; ldc = 256; cb = 0; }
            else { doff = WS_DV; ldc = 512; cb = (pn - 16) * 256; }
            bf16_t* dst = (bf16_t*)(ws + doff);
#pragma unroll
            for (int ai = 0; ai < 2; ++ai)
#pragma unroll
                for (int m = 0; m < 4; ++m) { bf16_t* rowp = dst + (size_t)(rowb + ai * 128 + m * 16) * ldc + cb + wc * 32 + 8 * fq;
#pragma unroll
                    for (int bj = 0; bj < 2; ++bj) { f32x4 v0 = acc[ai][bj][m][0], v1 = acc[ai][bj][m][1];
                        if (sg) {
#pragma unroll
                            for (int j = 0; j < 4; ++j) { v0[j] = sigmoidf_(v0[j]); v1[j] = sigmoidf_(v1[j]); } }
                        store8(rowp + bj * 128, v0, v1); } }
        } else if (pn == 18) {
            const float* COS = (const float*)(ws + WS_COS); const float* SIN = (const float*)(ws + WS_SIN);
            if (wc == 0) {
                bf16_t* dst = (bf16_t*)(ws + WS_IK); f32x4 gn[2][2];
#pragma unroll
                for (int bj = 0; bj < 2; ++bj)
#pragma unroll
                    for (int n = 0; n < 2; ++n) gn[bj][n] = (f32x4){1.f, 1.f, 1.f, 1.f};
#pragma unroll
                for (int ai = 0; ai < 2; ++ai)
#pragma unroll
                    for (int m = 0; m < 4; ++m) { const int row = rowb + ai * 128 + m * 16, t = row & (SEQ - 1);
                        f32x4 x[2][2] = {{acc[ai][0][m][0], acc[ai][0][m][1]}, {acc[ai][1][m][0], acc[ai][1][m][1]}};
                        head_norm_rope(x, false, gn, COS + t * 32, SIN + t * 32, fq, 1.0f);
#pragma unroll
                        for (int bj = 0; bj < 2; ++bj) store8(dst + (size_t)row * 64 + 32 * bj + 8 * fq, x[bj][0], x[bj][1]);
                        asm volatile("" ::: "memory"); }
            } else if (wc == 1) {
                float* IFp = (float*)(ws + WS_IF); float* IWp = (float*)(ws + WS_IW);
#pragma unroll
                for (int ai = 0; ai < 2; ++ai)
#pragma unroll
                    for (int m = 0; m < 4; ++m) { const int row = rowb + ai * 128 + m * 16;
                        if (fq == 0) { *(f32x4*)(IFp + (size_t)row * 8) = acc[ai][0][m][0] + *(const f32x4*)gate_b; *(f32x4*)(IFp + (size_t)row * 8 + 4) = acc[ai][0][m][1] + *(const f32x4*)(gate_b + 4); }
                        else if (fq == 1) { *(f32x4*)(IWp + (size_t)row * 4) = acc[ai][0][m][0] * 0.0625f; } }
            }
        } else {
            const float* COS = (const float*)(ws + WS_COS); const float* SIN = (const float*)(ws + WS_SIN);
            size_t doff; int gi, pn0; float scale; bool norm = true; int ldc = 512;
            if (pn < 10) { doff = WS_SQ; gi = 0; pn0 = 8; scale = C2; }
            else if (pn == 11) { doff = WS_IQ; gi = 0; pn0 = 11; scale = 1.f; norm = false; ldc = 256; }
            else if (pn < 14) { doff = WS_DQ; gi = 1; pn0 = 12; scale = C2; }
            else { doff = WS_DK; gi = 2; pn0 = 14; scale = 1.f; }
            bf16_t* dst = (bf16_t*)(ws + doff); const float* g = (const float*)(ws + WS_GAIN) + (layer * 4 + gi) * 64;
            f32x4 gn[2][2];
#pragma unroll
            for (int bj = 0; bj < 2; ++bj)
#pragma unroll
                for (int n = 0; n < 2; ++n) gn[bj][n] = *(const f32x4*)(g + 32 * bj + 8 * fq + 4 * n);
            const int head = 4 * (pn - pn0) + wc;
            f32x4 ccA[2], snA[2], ccB[2], snB[2];
#define RP_LOAD(CC, SN, b_) do { const int t = (rowb + ((b_) >> 2) * 128 + ((b_) & 3) * 16) & (SEQ - 1); \
                _Pragma("unroll") for (int n = 0; n < 2; ++n) { CC[n] = *(const GAS f32x4*)(COS + t * 32 + 8 * fq + 4 * n); SN[n] = *(const GAS f32x4*)(SIN + t * 32 + 8 * fq + 4 * n); } } while (0)
#define RP_DO(CC, SN, b_) do { const int ai = (b_) >> 2, mm = (b_) & 3, row = rowb + ai * 128 + mm * 16; \
                f32x4 x[2][2] = {{acc[ai][0][mm][0], acc[ai][0][mm][1]}, {acc[ai][1][mm][0], acc[ai][1][mm][1]}}; \
                head_norm_rope_cs(x, norm, gn, CC, SN, scale); \
                _Pragma("unroll") for (int bj = 0; bj < 2; ++bj) store8(dst + (size_t)row * ldc + head * 64 + 32 * bj + 8 * fq, x[bj][0], x[bj][1]); \
                asm volatile("" ::: "memory"); } while (0)
            RP_LOAD(ccA, snA, 0);
            RP_LOAD(ccB, snB, 1); RP_DO(ccA, snA, 0);
            RP_LOAD(ccA, snA, 2); RP_DO(ccB, snB, 1);
            RP_LOAD(ccB, snB, 3); RP_DO(ccA, snA, 2);
            RP_LOAD(ccA, snA, 4); RP_DO(ccB, snB, 3);
            RP_LOAD(ccB, snB, 5); RP_DO(ccA, snA, 4);
            RP_LOAD(ccA, snA, 6); RP_DO(ccB, snB, 5);
            RP_LOAD(ccB, snB, 7); RP_DO(ccA, snA, 6);
            RP_DO(ccB, snB, 7);
#undef RP_LOAD
#undef RP_DO
        }
    }
};
struct EpiKV {
    static constexpr bool PERM = true, MIDK = false, INIT = false;
    unsigned char* ws; int layer;
    DI void operator()(const f32x4 (&acc)[2][2][4][2], const pg8::Unit& u, int wr, int wc, int fr, int fq) const {
        const int pn = u.pn; const int rowb = u.pm * 256 + wr * 64 + fr; const float* RT = (const float*)(ws + WS_RT);
        if (pn >= 2) {
            bf16_t* dst = (bf16_t*)(ws + WS_SV);
            float rt8[2][4];
#pragma unroll
            for (int ai = 0; ai < 2; ++ai)
#pragma unroll
                for (int m = 0; m < 4; ++m) rt8[ai][m] = *(const GAS float*)(RT + rowb + ai * 128 + m * 16);
#pragma unroll
            for (int ai = 0; ai < 2; ++ai)
#pragma unroll
                for (int m = 0; m < 4; ++m) { const int row = rowb + ai * 128 + m * 16; const float r = rt8[ai][m]; bf16_t* rowp = dst + (size_t)row * 512 + (pn - 2) * 256 + wc * 32 + 8 * fq;
#pragma unroll
                    for (int bj = 0; bj < 2; ++bj) store8(rowp + bj * 128, acc[ai][bj][m][0] * r, acc[ai][bj][m][1] * r); }
        } else {
            const float* COS = (const float*)(ws + WS_COS); const float* SIN = (const float*)(ws + WS_SIN);
            bf16_t* dst = (bf16_t*)(ws + WS_SK); f32x4 gn[2][2];
#pragma unroll
            for (int bj = 0; bj < 2; ++bj)
#pragma unroll
                for (int n = 0; n < 2; ++n) gn[bj][n] = *(const f32x4*)((const float*)(ws + WS_GAIN) + (layer * 4 + 3) * 64 + 32 * bj + 8 * fq + 4 * n);
            const int head = 4 * pn + wc;
#pragma unroll
            for (int ai = 0; ai < 2; ++ai)
#pragma unroll
              for (int mp = 0; mp < 4; mp += 2) {
                f32x4 cc[2][2], sn[2][2]; float rr[2];
#pragma unroll
                for (int m = 0; m < 2; ++m) { const int row = rowb + ai * 128 + (mp + m) * 16, t = row & (SEQ - 1); rr[m] = *(const GAS float*)(RT + row);
#pragma unroll
                    for (int n = 0; n < 2; ++n) { cc[m][n] = *(const GAS f32x4*)(COS + t * 32 + 8 * fq + 4 * n); sn[m][n] = *(const GAS f32x4*)(SIN + t * 32 + 8 * fq + 4 * n); } }
#pragma unroll
                for (int m = 0; m < 2; ++m) { const int row = rowb + ai * 128 + (mp + m) * 16; const float r = rr[m];
                    f32x4 x[2][2] = {{acc[ai][0][mp + m][0] * r, acc[ai][0][mp + m][1] * r}, {acc[ai][1][mp + m][0] * r, acc[ai][1][mp + m][1] * r}};
                    head_norm_rope_cs(x, true, gn, cc[m], sn[m], 1.0f);
#pragma unroll
                    for (int bj = 0; bj < 2; ++bj) store8(dst + (size_t)row * 512 + head * 64 + 32 * bj + 8 * fq, x[bj][0], x[bj][1]); }
                asm volatile("" ::: "memory");
              }
        }
    }
};
DI size_t g0_off(int pm, int wave, int am, int lane) { return (((size_t)pm * 8 + wave) * 8 + am) * 1024 + (size_t)lane * 16; }
DI size_t gq_off(int pm, int png, int wave, int am, int lane) { return ((((size_t)pm * 12 + png) * 8 + wave) * 8 + am) * 1024 + (size_t)lane * 16; }
struct EpiGate {
    static constexpr bool PERM = true, MIDK = false, INIT = false;
    unsigned char* G; const float* bias; int pn_off; unsigned char* G0;
    DI void operator()(const f32x4 (&acc)[2][2][4][2], const pg8::Unit& u, int wr, int wc, int fr, int fq) const {
        const int pnn = u.pn + pn_off;
        const int col0 = pnn * 256 + wc * 32 + 8 * fq, wave = wr * 4 + wc, lane = fq * 16 + fr;
        f32x4 bv[2][2];
#pragma unroll
        for (int bj = 0; bj < 2; ++bj)
#pragma unroll
            for (int n = 0; n < 2; ++n) bv[bj][n] = *(const f32x4*)(bias + col0 + bj * 128 + 4 * n);
#pragma unroll
        for (int ai = 0; ai < 2; ++ai)
#pragma unroll
            for (int m = 0; m < 4; ++m) { unsigned w[4];
#pragma unroll
                for (int bj = 0; bj < 2; ++bj)
#pragma unroll
                    for (int n = 0; n < 2; ++n) { const f32x4 v = acc[ai][bj][m][n] + bv[bj][n]; unsigned q = 0u;
#pragma unroll
                        for (int j = 0; j < 4; ++j) q = __builtin_amdgcn_cvt_pk_u8_f32(sigmoidf_(v[j]) * 255.0f, j, q);
                        w[2 * bj + n] = q; }
                *(u32x4*)(pnn == 0 ? G0 + g0_off(u.pm, wave, ai * 4 + m, lane) : G + gq_off(u.pm, pnn, wave, ai * 4 + m, lane)) = (u32x4){w[0], w[1], w[2], w[3]}; }
    }
};
struct EpiMerge {
    static constexpr bool PERM = true, MIDK = true, INIT = false;
    const unsigned char* G; bf16_t* MG; const unsigned char* G0;
    DI const unsigned char* gp(int pm, int t, int wave, int am, int lane) const { return t == 0 ? G0 + g0_off(pm, wave, am, lane) : G + gq_off(pm, t, wave, am, lane); }
    DI static float ub(unsigned w, int k) { return (float)((w >> (8 * k)) & 0xFFu); }
    DI void mid(f32x4 (&acc)[2][2][4][2], const pg8::Unit& u, int t, int wr, int wc, int fr, int fq) const {
        const int seg = (t >> 3) - 1, wave = wr * 4 + wc, lane = fq * 16 + fr;
        u32x4 ga2[2][4], gb2[2][4];
#pragma unroll
        for (int ai = 0; ai < 2; ++ai)
#pragma unroll
            for (int m = 0; m < 4; ++m) { ga2[ai][m] = *(const GAS u32x4*)gp(u.pm, seg * 4 + u.pn, wave, ai * 4 + m, lane); gb2[ai][m] = *(const GAS u32x4*)gp(u.pm, (seg + 1) * 4 + u.pn, wave, ai * 4 + m, lane); }
#pragma unroll
        for (int ai = 0; ai < 2; ++ai) {
#pragma unroll
            for (int m = 0; m < 4; ++m) { const unsigned aw[4] = {ga2[ai][m].x, ga2[ai][m].y, ga2[ai][m].z, ga2[ai][m].w}, bw[4] = {gb2[ai][m].x, gb2[ai][m].y, gb2[ai][m].z, gb2[ai][m].w};
#pragma unroll
                for (int bj = 0; bj < 2; ++bj)
#pragma unroll
                    for (int n = 0; n < 2; ++n)
#pragma unroll
                        for (int j = 0; j < 4; ++j) acc[ai][bj][m][n][j] *= fmaxf(ub(aw[2 * bj + n], j), 1e-6f) * frcp(fmaxf(ub(bw[2 * bj + n], j), 1e-6f)); }
            asm volatile("" ::: "memory");
        }
    }
    DI void operator()(const f32x4 (&acc)[2][2][4][2], const pg8::Unit& u, int wr, int wc, int fr, int fq) const {
        const int rowb = u.pm * 256 + wr * 64 + fr, col0 = u.pn * 256 + wc * 32 + 8 * fq, wave = wr * 4 + wc, lane = fq * 16 + fr;
        u32x4 gc2[2][4];
#pragma unroll
        for (int ai = 0; ai < 2; ++ai)
#pragma unroll
            for (int m = 0; m < 4; ++m) gc2[ai][m] = *(const GAS u32x4*)gp(u.pm, 8 + u.pn, wave, ai * 4 + m, lane);
#pragma unroll
        for (int ai = 0; ai < 2; ++ai) {
#pragma unroll
            for (int m = 0; m < 4; ++m) { const unsigned cw[4] = {gc2[ai][m].x, gc2[ai][m].y, gc2[ai][m].z, gc2[ai][m].w};
#pragma unroll
                for (int bj = 0; bj < 2; ++bj) { f32x4 v0 = acc[ai][bj][m][0], v1 = acc[ai][bj][m][1];
#pragma unroll
                    for (int j = 0; j < 4; ++j) { v0[j] *= fmaxf(ub(cw[2 * bj], j), 1e-6f) * (1.0f / 255.0f); v1[j] *= fmaxf(ub(cw[2 * bj + 1], j), 1e-6f) * (1.0f / 255.0f); }
                    store8(MG + (size_t)(rowb + ai * 128 + m * 16) * 1024 + col0 + bj * 128, v0, v1); } }
            asm volatile("" ::: "memory");
        }
    }
};
struct EpiResid {
    static constexpr bool PERM = true, MIDK = false, INIT = true;
    const void* base; void* out; bool in16, out16; float* ss;
    DI void init(f32x4 (&acc)[2][2][4][2], const pg8::Unit& u, int wr, int wc, int fr, int fq) const {
        const int rowb = u.pm * 256 + wr * 64 + fr, col0 = u.pn * 256 + wc * 32 + 8 * fq;
#pragma unroll
        for (int ai = 0; ai < 2; ++ai)
#pragma unroll
            for (int m = 0; m < 4; ++m) { const size_t off = (size_t)(rowb + ai * 128 + m * 16) * DM + col0;
#pragma unroll
                for (int bj = 0; bj < 2; ++bj) {
                    if (in16) { const u32x4 w = *(const GAS u32x4*)((const bf16_t*)base + off + bj * 128);
                        acc[ai][bj][m][0] = (f32x4){bflo(w.x), bfhi(w.x), bflo(w.y), bfhi(w.y)}; acc[ai][bj][m][1] = (f32x4){bflo(w.z), bfhi(w.z), bflo(w.w), bfhi(w.w)}; }
                    else { acc[ai][bj][m][0] = *(const GAS f32x4*)((const float*)base + off + bj * 128); acc[ai][bj][m][1] = *(const GAS f32x4*)((const float*)base + off + bj * 128 + 4); } } }
    }
    DI void operator()(const f32x4 (&acc)[2][2][4][2], const pg8::Unit& u, int wr, int wc, int fr, int fq) const {
        const int rowb = u.pm * 256 + wr * 64 + fr, col0 = u.pn * 256 + wc * 32 + 8 * fq;
#pragma unroll
        for (int ai = 0; ai < 2; ++ai)
#pragma unroll
            for (int m = 0; m < 4; ++m) { const size_t row = (size_t)(rowb + ai * 128 + m * 16), off = row * DM + col0;
#pragma unroll
                for (int bj = 0; bj < 2; ++bj) {
                    if (out16) store8((bf16_t*)out + off + bj * 128, acc[ai][bj][m][0], acc[ai][bj][m][1]);
                    else { *(f32x4*)((float*)out + off + bj * 128) = acc[ai][bj][m][0]; *(f32x4*)((float*)out + off + bj * 128 + 4) = acc[ai][bj][m][1]; } }
                if (ss) { float sq = 0.f;
#pragma unroll
                    for (int bj = 0; bj < 2; ++bj)
#pragma unroll
                        for (int n = 0; n < 2; ++n) { const f32x4 v = acc[ai][bj][m][n]; sq += (v[0] * v[0] + v[1] * v[1]) + (v[2] * v[2] + v[3] * v[3]); }
                    sq = sum16x(sq); sq = sum32x(sq);
                    if (fq == 0) __hip_atomic_fetch_add(ss + row, sq, __ATOMIC_RELAXED, __HIP_MEMORY_SCOPE_AGENT); } }
    }
};
struct EpiSwiGLU {
    static constexpr bool PERM = true, MIDK = false, INIT = false;
    bf16_t* H; const float* ss;
    DI void operator()(const f32x4 (&acc)[2][2][4][2], const pg8::Unit& u, int wr, int wc, int fr, int fq) const {
        const int rowb = u.pm * 256 + wr * 64 + fr, col0 = u.pn * 128 + wc * 32 + 8 * fq;
        float rr8[2][4];
#pragma unroll
        for (int ai = 0; ai < 2; ++ai)
#pragma unroll
            for (int m = 0; m < 4; ++m) rr8[ai][m] = *(const GAS float*)(ss + rowb + ai * 128 + m * 16);
#pragma unroll
        for (int ai = 0; ai < 2; ++ai) {
#pragma unroll
            for (int m = 0; m < 4; ++m) { f32x4 v0, v1; const float r = 1.0f / sqrtf(rr8[ai][m] * (1.f / DM) + EPS);
#pragma unroll
                for (int j = 0; j < 4; ++j) { const float g0 = acc[ai][0][m][0][j] * r, g1 = acc[ai][0][m][1][j] * r; v0[j] = g0 * sigmoidf_(g0) * (acc[ai][1][m][0][j] * r); v1[j] = g1 * sigmoidf_(g1) * (acc[ai][1][m][1][j] * r); }
                store8(H + (size_t)(rowb + ai * 128 + m * 16) * FF + col0, v0, v1); }
        }
    }
};

DI unsigned mono_key(float f) { const unsigned u = __float_as_uint(f + 0.0f); return u ^ ((unsigned)((int)u >> 31) | 0x80000000u); }
DI unsigned pack_mask(unsigned long long bm, int h) {
    unsigned r = 0;
#pragma unroll
    for (int p = 0; p < 2; ++p)
#pragma unroll
        for (int g = 0; g < 4; ++g) r |= (unsigned)((bm >> (32 * p + 8 * g + 4 * h)) & 0xFull) << (16 * p + 4 * g);
    return r;
}
DI unsigned long long unpack_mask(unsigned w0, unsigned w1) {
    unsigned long long bm = 0;
#pragma unroll
    for (int p = 0; p < 2; ++p)
#pragma unroll
        for (int g = 0; g < 4; ++g) { bm |= (unsigned long long)((w0 >> (16 * p + 4 * g)) & 0xFu) << (32 * p + 8 * g); bm |= (unsigned long long)((w1 >> (16 * p + 4 * g)) & 0xFu) << (32 * p + 8 * g + 4); }
    return bm;
}
DI void ld8f(const bf16_t* p, float (&g)[8]) { const u32x4 w = *(const u32x4*)p; g[0] = bflo(w.x); g[1] = bfhi(w.x); g[2] = bflo(w.y); g[3] = bfhi(w.y); g[4] = bflo(w.z); g[5] = bfhi(w.z); g[6] = bflo(w.w); g[7] = bfhi(w.w); }

DI void naive_select(Frame& F) {
    F.refresh();
    if (F.wave >= 4) return;
    const int gw = F.bid * 4 + F.wave, NGW = F.G * 4;
    LAS unsigned char* wl = F.lds + F.wave * 20480;
    LAS float* sc = (LAS float*)wl; LAS float* iqf = (LAS float*)(wl + 16384); LAS unsigned* hist = (LAS unsigned*)(wl + 16384 + 1024);
    const bf16_t* IQ = (const bf16_t*)(F.ws + WS_IQ); const bf16_t* IK = (const bf16_t*)(F.ws + WS_IK); const float* IW = (const float*)(F.ws + WS_IW);
    unsigned* MASK = (unsigned*)(F.ws + WS_MASK);
    const int lane = F.lane;
    for (int row = gw; row < MC; row += NGW) {
        const int b = row >> 12, t = row & (SEQ - 1), n = t + 1;
        { const u32x2 v = *(const u32x2*)(IQ + (size_t)row * 256 + 4 * lane); iqf[4 * lane] = bflo(v.x); iqf[4 * lane + 1] = bfhi(v.x); iqf[4 * lane + 2] = bflo(v.y); iqf[4 * lane + 3] = bfhi(v.y); }
        const f32x4 wv = *(const f32x4*)(IW + (size_t)row * 4);
        WSYNC();
        for (int s = lane; s < n; s += 64) {
            const bf16_t* kr = IK + ((size_t)b * SEQ + s) * 64;
            float d0 = 0.f, d1 = 0.f, d2 = 0.f, d3 = 0.f;
#pragma unroll
            for (int c = 0; c < 8; ++c) { float kv[8]; ld8f(kr + 8 * c, kv);
#pragma unroll
                for (int j = 0; j < 8; ++j) { const float k = kv[j]; d0 += iqf[8 * c + j] * k; d1 += iqf[64 + 8 * c + j] * k; d2 += iqf[128 + 8 * c + j] * k; d3 += iqf[192 + 8 * c + j] * k; } }
            sc[s] = wv[0] * fmaxf(d0, 0.f) + wv[1] * fmaxf(d1, 0.f) + wv[2] * fmaxf(d2, 0.f) + wv[3] * fmaxf(d3, 0.f);
        }
        WSYNC();
        unsigned thr = 0u; int need = 256;
        if (n > 256) {
            unsigned prefix = 0u, pmask = 0u;
            for (int pass = 0; pass < 4; ++pass) {
                const int shift = 24 - 8 * pass;
                { unsigned z_ = 0u; asm volatile("" : "+v"(z_)); hist[lane] = z_; hist[lane + 64] = z_; hist[lane + 128] = z_; hist[lane + 192] = z_; }
                WSYNC();
                for (int s = lane; s < n; s += 64) { const unsigned key = mono_key(sc[s]); if ((key & pmask) == prefix) __hip_atomic_fetch_add(&hist[(key >> shift) & 255u], 1u, __ATOMIC_RELAXED, __HIP_MEMORY_SCOPE_WORKGROUP); }
                WSYNC();
                const unsigned c0 = hist[4 * lane], c1 = hist[4 * lane + 1], c2 = hist[4 * lane + 2], c3 = hist[4 * lane + 3];
                const unsigned ls = c0 + c1 + c2 + c3; unsigned inc = ls;
#pragma unroll
                for (int o = 1; o < 64; o <<= 1) { const unsigned y = __shfl_up(inc, o); if (lane >= o) inc += y; }
                const unsigned total = __shfl(inc, 63);
                unsigned cum = total - inc;
                int fbin = -1; unsigned fneed = 0u;
                const unsigned cc[4] = {c0, c1, c2, c3};
#pragma unroll
                for (int bq = 3; bq >= 0; --bq) { if (fbin < 0 && cum < (unsigned)need && cum + cc[bq] >= (unsigned)need) { fbin = 4 * lane + bq; fneed = (unsigned)need - cum; } cum += cc[bq]; }
                const unsigned long long fm = __ballot(fbin >= 0);
                const int src = __ffsll((long long)fm) - 1;
                const int bin = __shfl(fbin, src); need = (int)__shfl(fneed, src);
                prefix |= (unsigned)bin << shift; pmask |= 0xFFu << shift;
                WSYNC();
            }
            thr = prefix;
        }
        int eqc = 0;
        for (int i = 0; i < 64; ++i) {
            const int s = 64 * i + lane; bool sel = false;
            if (64 * i < n) {
                const bool valid = s < n;
                if (n <= 256) sel = valid;
                else { const unsigned key = valid ? mono_key(sc[s]) : 0u; const bool eq = valid && key == thr; const unsigned long long em = __ballot(eq);
                    const int rank = eqc + __popcll(em & ((1ull << lane) - 1ull)); sel = valid && (key > thr || (eq && rank < need)); eqc += __popcll(em); }
            }
            const unsigned long long bm = __ballot(sel);
            if (lane == 0) { MASK[((size_t)row * 2 + 0) * 64 + i] = pack_mask(bm, 0); MASK[((size_t)row * 2 + 1) * 64 + i] = pack_mask(bm, 1); }
        }
        WSYNC();
    }
}
DI void naive_dsa(Frame& F) {
    F.refresh();
    if (F.wave >= 4) return;
    const int gw = F.bid * 4 + F.wave, NGW = F.G * 4;
    LAS unsigned char* wl = F.lds + F.wave * 20480;
    LAS float* sc = (LAS float*)wl;
    LAS float* sqf = (LAS float*)(wl + 8192);
    LAS unsigned* list = (LAS unsigned*)(wl + 8192 + 2048);
    LAS float* invs = (LAS float*)(wl + 8192 + 2048 + 2048);
    const bf16_t* SQ = (const bf16_t*)(F.ws + WS_SQ); const bf16_t* SK = (const bf16_t*)(F.ws + WS_SK); const bf16_t* SV = (const bf16_t*)(F.ws + WS_SV);
    const unsigned* MASK = (const unsigned*)(F.ws + WS_MASK); bf16_t* Y = (bf16_t*)(F.ws + WS_Y);
    const int lane = F.lane;
    for (int row = gw; row < MC; row += NGW) {
        const int b = row >> 12, t = row & (SEQ - 1);
        { float q[8]; ld8f(SQ + (size_t)row * 512 + 8 * lane, q);
#pragma unroll
          for (int j = 0; j < 8; ++j) sqf[8 * lane + j] = q[j]; }
        int nsel = 0;
        for (int i = 0; i <= (t >> 6); ++i) {
            const unsigned w0 = MASK[((size_t)row * 2 + 0) * 64 + i], w1 = MASK[((size_t)row * 2 + 1) * 64 + i];
            const unsigned long long bm = unpack_mask(w0, w1);
            const bool sel = (bm >> lane) & 1ull;
            const int pos = nsel + __popcll(bm & ((1ull << lane) - 1ull));
            if (sel && pos < 256) list[pos] = (unsigned)(64 * i + lane);
            nsel += __popcll(bm);
        }
        if (nsel > 256) nsel = 256;
        WSYNC();
        for (int k = lane; k < nsel; k += 64) {
            const bf16_t* kr = SK + ((size_t)b * SEQ + list[k]) * 512;
#pragma unroll 1
            for (int h = 0; h < 8; ++h) { float d = 0.f;
#pragma unroll
                for (int c = 0; c < 8; ++c) { float kv[8]; ld8f(kr + h * 64 + 8 * c, kv);
#pragma unroll
                    for (int j = 0; j < 8; ++j) d += sqf[h * 64 + 8 * c + j] * kv[j]; }
                sc[h * 256 + k] = d; }
        }
        WSYNC();
#pragma unroll 1
        for (int h = 0; h < 8; ++h) {
            float mx = -INFINITY; for (int k = lane; k < nsel; k += 64) mx = fmaxf(mx, sc[h * 256 + k]);
            mx = wave_max(mx); float sum = 0.f;
            for (int k = lane; k < nsel; k += 64) { const float p = fexp2(sc[h * 256 + k] - mx); sc[h * 256 + k] = p; sum += p; }
            sum = wave_sum(sum); if (lane == 0) invs[h] = 1.0f / sum;
        }
        WSYNC();
        { const int h = lane >> 3, d0 = (lane & 7) * 8; float accv[8] = {0.f, 0.f, 0.f, 0.f, 0.f, 0.f, 0.f, 0.f};
          for (int k = 0; k < nsel; ++k) { const float p = sc[h * 256 + k]; float v[8]; ld8f(SV + ((size_t)b * SEQ + list[k]) * 512 + h * 64 + d0, v);
#pragma unroll
              for (int j = 0; j < 8; ++j) accv[j] += p * v[j]; }
          const float inv = invs[h];
          u32x4 o; o.x = pk2(accv[0] * inv, accv[1] * inv); o.y = pk2(accv[2] * inv, accv[3] * inv); o.z = pk2(accv[4] * inv, accv[5] * inv); o.w = pk2(accv[6] * inv, accv[7] * inv);
          *(u32x4*)(Y + (size_t)row * 1536 + 512 + h * 64 + d0) = o; }
        WSYNC();
    }
}
DI void naive_mlstm(Frame& F, const Args& a, int l) {
    F.refresh();
    const int gw = F.bid * NWAVES + F.wave, NGW = F.G * NWAVES;
    LAS unsigned char* wl = F.lds + F.wave * 16384;
    LAS float* pl = (LAS float*)wl;
    const bf16_t* QK = (const bf16_t*)(F.ws + WS_QK); const bf16_t* VM = (const bf16_t*)(F.ws + WS_VM); const bf16_t* OM = (const bf16_t*)(F.ws + WS_OM);
    const float* AK = (const float*)(F.ws + WS_AK); const float* MQ = (const float*)(F.ws + WS_MQ); const float* EM = (const float*)(F.ws + WS_EM);
    bf16_t* Y = (bf16_t*)(F.ws + WS_Y); const float* mng = a.in[I_MNG] + (size_t)l * 512;
    const int lane = F.lane;
    for (int qi = gw; qi < MC * 4; qi += NGW) {
        const int row = qi >> 2, h = qi & 3, b = row >> 12, t = row & (SEQ - 1), seq = b * 4 + h;
        const unsigned qw = *(const unsigned*)(QK + (size_t)row * 1024 + h * 128 + 2 * lane);
        const float q0 = bflo(qw), q1 = bfhi(qw);
        const float Mt = MQ[(size_t)seq * SEQ + t];
        float denp = 0.f;
        for (int s0 = 0; s0 <= t; s0 += 64) {
            const int s = s0 + lane; const bool valid = s <= t; const int sr = valid ? s : t;
            const bf16_t* kr = QK + ((size_t)b * SEQ + sr) * 1024 + 512 + h * 128;
            float d = 0.f;
#pragma unroll 4
            for (int c = 0; c < 16; ++c) { float kv[8]; ld8f(kr + 8 * c, kv);
#pragma unroll
                for (int j = 0; j < 4; ++j) { d += __shfl(q0, 4 * c + j) * kv[2 * j] + __shfl(q1, 4 * c + j) * kv[2 * j + 1]; } }
            const float p = valid ? d * fexp(AK[(size_t)seq * SEQ + sr] - Mt) : 0.f;
            pl[s] = p;
            denp += p;
        }
        const float den = wave_sum(denp);
        WSYNC();
        float a0 = 0.f, a1 = 0.f;
        for (int s = 0; s <= t; ++s) { const float p = pl[s]; const unsigned vw = *(const unsigned*)(VM + ((size_t)b * SEQ + s) * 512 + h * 128 + 2 * lane); a0 += p * bflo(vw); a1 += p * bfhi(vw); }
        const float hd = fmaxf(fabsf(den), EM[(size_t)seq * SEQ + t]);
        a0 /= hd; a1 /= hd;
        const float ss = wave_sum(a0 * a0 + a1 * a1); const float r = 1.0f / sqrtf(ss * (1.f / 128.f) + EPS);
        const unsigned ow = *(const unsigned*)(OM + (size_t)row * 512 + h * 128 + 2 * lane);
        const float y0 = a0 * r * mng[h * 128 + 2 * lane] * bflo(ow), y1 = a1 * r * mng[h * 128 + 2 * lane + 1] * bfhi(ow);
        *(unsigned*)(Y + (size_t)row * 1536 + h * 128 + 2 * lane) = pk2(y0, y1);
        WSYNC();
    }
}
DI void naive_diff(Frame& F, const Args& a, int l) {
    F.refresh();
    if (F.wave >= 4) return;
    const int gw = F.bid * 4 + F.wave, NGW = F.G * 4;
    LAS unsigned char* wl = F.lds + F.wave * 32768;
    LAS float* p0 = (LAS float*)wl; LAS float* p1 = (LAS float*)(wl + 16384);
    const bf16_t* DQ = (const bf16_t*)(F.ws + WS_DQ); const bf16_t* DK = (const bf16_t*)(F.ws + WS_DK); const bf16_t* DV = (const bf16_t*)(F.ws + WS_DV);
    bf16_t* Y = (bf16_t*)(F.ws + WS_Y); const float* dog = a.in[I_DOG] + (size_t)l * 128; const float* lam = a.in[I_LAM] + (size_t)l * 256;
    const int lane = F.lane;
    const float lam_init = (l == 0) ? 0.2f : 0.35550906759096934f;
    const float s01 = wave_sum(lam[lane] * lam[64 + lane]), s23 = wave_sum(lam[128 + lane] * lam[192 + lane]);
    const float lam_val = fexp(s01) - fexp(s23) + lam_init;
    for (int qi = gw; qi < MC * 4; qi += NGW) {
        const int row = qi >> 2, h = qi & 3, b = row >> 12, t = row & (SEQ - 1);
        const float qa = bf2f(DQ[(size_t)row * 512 + (2 * h) * 64 + lane]), qb = bf2f(DQ[(size_t)row * 512 + (2 * h + 1) * 64 + lane]);
        float mx0 = -INFINITY, mx1 = -INFINITY;
        for (int s0 = 0; s0 <= t; s0 += 64) {
            const int s = s0 + lane; const bool valid = s <= t; const int sr = valid ? s : t;
            const bf16_t* kr = DK + ((size_t)b * SEQ + sr) * 512 + (2 * h) * 64;
            float d0 = 0.f, d1 = 0.f;
#pragma unroll 4
            for (int c = 0; c < 8; ++c) { float ka[8], kb[8]; ld8f(kr + 8 * c, ka); ld8f(kr + 64 + 8 * c, kb);
#pragma unroll
                for (int j = 0; j < 8; ++j) { d0 += __shfl(qa, 8 * c + j) * ka[j]; d1 += __shfl(qb, 8 * c + j) * kb[j]; } }
            if (valid) { p0[s] = d0; p1[s] = d1; mx0 = fmaxf(mx0, d0); mx1 = fmaxf(mx1, d1); }
        }
        mx0 = wave_max(mx0); mx1 = wave_max(mx1);
        WSYNC();
        float sm0 = 0.f, sm1 = 0.f;
        for (int s = lane; s <= t; s += 64) { const float e0 = fexp2(p0[s] - mx0), e1 = fexp2(p1[s] - mx1); p0[s] = e0; p1[s] = e1; sm0 += e0; sm1 += e1; }
        const float i0 = 1.0f / wave_sum(sm0), i1 = lam_val / wave_sum(sm1);
        WSYNC();
        float a0 = 0.f, a1 = 0.f;
        for (int s = 0; s <= t; ++s) { const float av = p0[s] * i0 - p1[s] * i1; const unsigned vw = *(const unsigned*)(DV + ((size_t)b * SEQ + s) * 512 + h * 128 + 2 * lane); a0 += av * bflo(vw); a1 += av * bfhi(vw); }
        const float ss = wave_sum(a0 * a0 + a1 * a1); const float r = 1.0f / sqrtf(ss * (1.f / 128.f) + EPS) * (1.0f - lam_init);
        *(unsigned*)(Y + (size_t)row * 1536 + 1024 + h * 128 + 2 * lane) = pk2(a0 * r * dog[2 * lane], a1 * r * dog[2 * lane + 1]);
        WSYNC();
    }
}

typedef float f32x16 __attribute__((ext_vector_type(16)));
typedef short s16x4 __attribute__((ext_vector_type(4)));
typedef __bf16 bf16x2_t __attribute__((ext_vector_type(2)));
DI unsigned cvtpk(float lo, float hi) { f32x2 v = {lo, hi}; bf16x2_t b = __builtin_convertvector(v, bf16x2_t); return __builtin_bit_cast(unsigned, b); }
#define MFMA32(a, b, c) __builtin_amdgcn_mfma_f32_32x32x16_bf16((a), (b), (c), 0, 0, 0)
#define SBAR() __builtin_amdgcn_sched_barrier(0)
DI s16x4 trread(LAS const unsigned char* p) { return __builtin_bit_cast(s16x4, __builtin_amdgcn_ds_read_tr16_b64_v4i16((LAS s16x4*)p)); }
#ifndef MIXMODES
#define MIXMODES 7
#endif
constexpr int CW_QUEUE = 8192;
constexpr int ATT_WSF_OFF = RING_BYTES + 1024;
constexpr float NEGBIG = -1.0e30f;
constexpr float RESC_THR = 16.0f;

DI float max3f(float a, float b, float c) { float r_; asm("v_max3_f32 %0, %1, %2, %3" : "=v"(r_) : "v"(a), "v"(b), "v"(c)); return r_; }
template <int MODE>
DI void attn_qk(f32x16& s0, f32x16& s1, const bf16x8 (&qf)[MODE == 2 ? 8 : 4], LAS const unsigned char* kb, int koff, int j, int q0w, int r, int h, unsigned mw, const bool DIAG) {
    constexpr int KW = MODE == 0 ? 64 : 128, DQK = MODE == 2 ? 128 : 64, DV = MODE == 0 ? 64 : 128, KROWB = KW * 2 + 16, VROWB = MODE == 0 ? 192 : 320, KBYTES = 64 * KROWB, VBYTES = 64 * VROWB;
    constexpr int NKS = DQK / 16, NVB = DV / 32;
    (void)KBYTES; (void)VBYTES; (void)NVB;
    bf16x8 kf[8];
#pragma unroll
    for (int s = 0; s < 4; ++s) { kf[2 * s] = *(LAS const bf16x8*)(kb + koff + 32 * s); kf[2 * s + 1] = *(LAS const bf16x8*)(kb + koff + 32 * KROWB + 32 * s); }
    SBAR();
    if (MODE == 0) {
        const unsigned nmw = ~mw;
#define CI_(i) { int a_, b_; asm("v_bfe_i32 %0, %1, " #i ", 1" : "=v"(a_) : "v"(nmw)); asm("v_bfe_i32 %0, %1, 16+" #i ", 1" : "=v"(b_) : "v"(nmw)); \
                 s0[i] = __uint_as_float((unsigned)a_ & 0xF149F2CAu); s1[i] = __uint_as_float((unsigned)b_ & 0xF149F2CAu); }
        CI_(0) CI_(1) CI_(2) CI_(3) CI_(4) CI_(5) CI_(6) CI_(7) CI_(8) CI_(9) CI_(10) CI_(11) CI_(12) CI_(13) CI_(14) CI_(15)
#undef CI_
    } else if (MODE == 1 && DIAG) {
        const int qd = q0w + r - 64 * j;
#pragma unroll
        for (int i = 0; i < 16; ++i) { const int kk = (i & 3) + 8 * (i >> 2) + 4 * h; s0[i] = kk > qd ? NEGBIG : 0.f; s1[i] = kk + 32 > qd ? NEGBIG : 0.f; }
    } else {
#pragma unroll
        for (int i = 0; i < 16; ++i) { s0[i] = 0.f; s1[i] = 0.f; }
    }
    SBAR();
#pragma unroll
    for (int g = 0; g < NKS / 2; ++g) {
#pragma unroll
        for (int e = 0; e < 2; ++e) { const int s = 2 * g + e; s0 = MFMA32(kf[(4 * g + 2 * e) & 7], qf[s], s0); s1 = MFMA32(kf[(4 * g + 2 * e + 1) & 7], qf[s], s1); }
        if (g + 2 < NKS / 2) {
#pragma unroll
            for (int e = 0; e < 2; ++e) { const int s = 2 * (g + 2) + e;
                kf[(4 * g + 2 * e) & 7] = *(LAS const bf16x8*)(kb + koff + 32 * s); kf[(4 * g + 2 * e + 1) & 7] = *(LAS const bf16x8*)(kb + koff + 32 * KROWB + 32 * s); }
        }
        SBAR();
    }
}
template <int MODE>
DI void attn_pv(f32x16 (&o)[MODE == 0 ? 2 : 4], float& lsum, float& mref, f32x16& s0, f32x16& s1, LAS const unsigned char* vb, int voff,
                int j, int q0w, int r, int h, float M2, LAS float* wsf, const bool DIAG, const int probe) {
    constexpr int DV = MODE == 0 ? 64 : 128, VROWB = MODE == 0 ? 192 : 320, VBYTES = 64 * VROWB;
    constexpr int NVB = DV / 32;
    LAS const unsigned char* ab = vb + VBYTES;
    bf16x8 vfr[NVB > 2 ? 2 : 1][8];
#define VLOAD_(bb) do { _Pragma("unroll") for (int v_ = 0; v_ < 2; ++v_) _Pragma("unroll") for (int p_ = 0; p_ < 2; ++p_) _Pragma("unroll") for (int s2_ = 0; s2_ < 2; ++s2_) { \
        const s16x4 lo_ = trread(vb + voff + (32 * p_ + 16 * s2_) * VROWB + 64 * (2 * (bb) + v_)), hi_ = trread(vb + voff + (32 * p_ + 16 * s2_ + 8) * VROWB + 64 * (2 * (bb) + v_)); \
        vfr[(bb) & (NVB > 2 ? 1 : 0)][4 * v_ + 2 * p_ + s2_] = (bf16x8){lo_[0], lo_[1], lo_[2], lo_[3], hi_[0], hi_[1], hi_[2], hi_[3]}; } } while (0)
    if (probe != 3) VLOAD_(0);
    SBAR();
    if (MODE == 2) {
        float part = 0.f;
        if (DIAG) {
            const int qd = q0w + r - 64 * j;
#pragma unroll
            for (int g = 0; g < 4; ++g) {
                const f32x4 a0 = *(LAS const f32x4*)(ab + (8 * g + 4 * h) * 4), a1 = *(LAS const f32x4*)(ab + (32 + 8 * g + 4 * h) * 4);
#pragma unroll
                for (int e = 0; e < 4; ++e) { const int i = 4 * g + e, kk = 8 * g + 4 * h + e;
                    float w0 = fexp2(a0[e] - M2), w1 = fexp2(a1[e] - M2);
                    if (kk > qd) w0 = 0.f; if (kk + 32 > qd) w1 = 0.f;
                    s0[i] *= w0; s1[i] *= w1; part += s0[i] + s1[i]; }
            }
        } else {
#pragma unroll
            for (int g = 0; g < 4; ++g) {
                const f32x4 a0 = *(LAS const f32x4*)(ab + (8 * g + 4 * h) * 4), a1 = *(LAS const f32x4*)(ab + (32 + 8 * g + 4 * h) * 4);
#pragma unroll
                for (int e = 0; e < 4; ++e) { const int i = 4 * g + e;
                    s0[i] *= fexp2(a0[e] - M2); s1[i] *= fexp2(a1[e] - M2); part += s0[i] + s1[i]; }
            }
        }
        lsum += part;
    } else {
        if (probe != 2) {
        asm volatile("s_nop 15\n\ts_nop 7" : "+v"(s0), "+v"(s1));
        float ta = max3f(s0[0], s0[1], s1[0]), tb = max3f(s0[2], s0[3], s1[1]); ta = max3f(ta, s1[2], s1[3]);
#pragma unroll
        for (int i = 4; i < 16; i += 4) { ta = max3f(ta, s0[i], s0[i + 1]); tb = max3f(tb, s0[i + 2], s0[i + 3]); ta = max3f(ta, s1[i], s1[i + 1]); tb = max3f(tb, s1[i + 2], s1[i + 3]); }
        float tm = max3f(ta, tb, tb); tm = max32x(tm);
        if (__any(tm > mref + RESC_THR)) {
            const float nm = tm > mref + RESC_THR ? tm : mref, al = fexp2(mref - nm);
            mref = nm; lsum *= al;
            if (h == 0) wsf[r] = al;
            WSYNC();
#pragma unroll
            for (int g = 0; g < 4; ++g) { const f32x4 av = *(LAS const f32x4*)(wsf + 8 * g + 4 * h);
#pragma unroll
                for (int v = 0; v < NVB; ++v)
#pragma unroll
                    for (int e = 0; e < 4; ++e) o[v][4 * g + e] *= av[e]; }
            WSYNC();
        }
        if (__any(mref != 0.f)) {
#pragma unroll
            for (int i = 0; i < 16; ++i) { s0[i] -= mref; s1[i] -= mref; }
        }
        float part = 0.f;
#pragma unroll
        for (int i = 0; i < 16; ++i) { s0[i] = fexp2(s0[i]); s1[i] = fexp2(s1[i]); part += s0[i] + s1[i]; }
        lsum += part;
        }
    }
    bf16x8 pf[2][2];
#pragma unroll
    for (int s2 = 0; s2 < 2; ++s2) {
        u32x4 t0, t1;
        t0.x = cvtpk(s0[8 * s2 + 0], s0[8 * s2 + 1]); t0.y = cvtpk(s0[8 * s2 + 2], s0[8 * s2 + 3]); t0.z = cvtpk(s0[8 * s2 + 4], s0[8 * s2 + 5]); t0.w = cvtpk(s0[8 * s2 + 6], s0[8 * s2 + 7]);
        t1.x = cvtpk(s1[8 * s2 + 0], s1[8 * s2 + 1]); t1.y = cvtpk(s1[8 * s2 + 2], s1[8 * s2 + 3]); t1.z = cvtpk(s1[8 * s2 + 4], s1[8 * s2 + 5]); t1.w = cvtpk(s1[8 * s2 + 6], s1[8 * s2 + 7]);
        pf[0][s2] = __builtin_bit_cast(bf16x8, t0); pf[1][s2] = __builtin_bit_cast(bf16x8, t1);
    }
    SBAR();
    if (probe != 3)
#pragma unroll
    for (int b = 0; b < NVB / 2; ++b) {
        if (b + 1 < NVB / 2) VLOAD_(b + 1);
#pragma unroll
        for (int v_ = 0; v_ < 2; ++v_)
#pragma unroll
            for (int p = 0; p < 2; ++p)
#pragma unroll
                for (int s2 = 0; s2 < 2; ++s2) o[2 * b + v_] = MFMA32(pf[p][s2], vfr[b & (NVB > 2 ? 1 : 0)][4 * v_ + 2 * p + s2], o[2 * b + v_]);
        SBAR();
    }
#undef VLOAD_
}

template <int MODE>
DI void attn_tile(f32x16 (&o)[MODE == 0 ? 2 : 4], float& lsum, float& mref, const bf16x8 (&qf)[MODE == 2 ? 8 : 4], LAS const unsigned char* kb, int koff, int voff,
                  int j, int q0w, int r, int h, unsigned mw, float M2, LAS float* wsf, const bool DIAG, const int probe) {
    constexpr int KW = MODE == 0 ? 64 : 128, KROWB = KW * 2 + 16, KBYTES = 64 * KROWB;
    f32x16 s0, s1;
    attn_qk<MODE>(s0, s1, qf, kb, koff, j, q0w, r, h, mw, DIAG);
    attn_pv<MODE>(o, lsum, mref, s0, s1, kb + KBYTES, voff, j, q0w, r, h, M2, wsf, DIAG, probe);
}
template <int MODE>
DI void attn_unit(Frame& F, const Args& a, int l, int b, int head, int qb, float lam_val, float lam_init) {
    constexpr int KW = MODE == 0 ? 64 : 128, DQK = MODE == 2 ? 128 : 64, NCOMP = 1, NPASS = 1, DV = MODE == 0 ? 64 : 128;
    constexpr int KROWB = KW * 2 + 16, VROWB = MODE == 0 ? 192 : 320;
    constexpr int KBYTES = 64 * KROWB, VBYTES = 64 * VROWB, STAGE = KBYTES + VBYTES + 256;
    constexpr int NKS = DQK / 16, NVB = DV / 32, KCH = KW / 64, VCH = DV / 64;
    static_assert(2 * STAGE <= 98304, "tile buffers");
    F.refresh();
    const int probe = (REPMASK != 0) ? ((volatile LAS int*)(F.lds + MISC_OFF + 96))[2] : 0;
    const int tid = F.tid, lane = F.lane, w = F.wave, r = lane & 31, h = lane >> 5;
    const bf16_t* Qp; const bf16_t* Kp; const bf16_t* Vp; int ldq, ldk;
    if (MODE == 0) { Qp = (const bf16_t*)(F.ws + WS_SQ) + head * 64; Kp = (const bf16_t*)(F.ws + WS_SK) + head * 64; Vp = (const bf16_t*)(F.ws + WS_SV) + head * 64; ldq = 512; ldk = 512; }
    else if (MODE == 1) { Qp = (const bf16_t*)(F.ws + WS_DQ) + head * 128; Kp = (const bf16_t*)(F.ws + WS_DK) + head * 128; Vp = (const bf16_t*)(F.ws + WS_DV) + head * 128; ldq = 512; ldk = 512; }
    else { Qp = (const bf16_t*)(F.ws + WS_QK) + head * 128; Kp = (const bf16_t*)(F.ws + WS_QK) + 512 + head * 128; Vp = (const bf16_t*)(F.ws + WS_VM) + head * 128; ldq = 1024; ldk = 1024; }
    const size_t rowb = (size_t)b * SEQ;
    const int comp = MODE == 1 ? (w >> 2) : 0;
    const int q0w = MODE == 1 ? qb * 128 + (w & 3) * 32 : qb * 256 + w * 32;
    const int seq = b * 4 + head;
    LAS float* wsf = (LAS float*)(F.lds + ATT_WSF_OFF + w * 256);
    f32x16 o[NCOMP][NVB];
    float lsum[NCOMP], mref[NCOMP];
    const int i16 = lane & 15, vq = i16 >> 2, vp = i16 & 3, vcs = (lane >> 4) & 1;
    const int voff = (4 * h + vq) * VROWB + (16 * vcs + 4 * vp) * 2;
    const int koff = r * KROWB + 16 * h;
    const int NT = MODE == 2 ? 4 : (MODE == 1 ? 2 * (qb + 1) : 4 * (qb + 1)), JB = MODE == 2 ? 4 * qb : 0;
#pragma unroll 1
    for (int pass = 0; pass < NPASS; ++pass) {
    bf16x8 qf[NCOMP][NKS];
#pragma unroll
    for (int c = 0; c < NCOMP; ++c)
#pragma unroll
        for (int s = 0; s < NKS; ++s) qf[c][s] = *(const GAS bf16x8*)(Qp + (rowb + q0w + r) * ldq + comp * 64 + 16 * s + 8 * h);
#pragma unroll
    for (int c = 0; c < NCOMP; ++c)
#pragma unroll
        for (int v = 0; v < NVB; ++v)
#pragma unroll
            for (int i = 0; i < 16; ++i) o[c][v][i] = 0.f;
#pragma unroll
    for (int c = 0; c < NCOMP; ++c) { lsum[c] = 0.f; mref[c] = 0.f; }
    float M2 = 0.f;
    if (MODE == 2) M2 = ((const float*)(F.ws + WS_MQ))[(size_t)seq * SEQ + q0w + r] * LOG2E;
    const unsigned* mrow = (const unsigned*)(F.ws + WS_MASK) + ((rowb + q0w + r) * 2 + h) * 64;
    const int srow = tid >> 3, sch = tid & 7;
    const bf16_t* kg = Kp + (rowb + srow) * ldk + sch * 8; const bf16_t* vg = Vp + (rowb + srow) * 512 + sch * 8;
    const float* ag = (const float*)(F.ws + WS_AK) + (size_t)seq * SEQ;
    u32x4 kreg[KCH], vreg[VCH]; float areg = 0.f; unsigned mw = 0u; u32x4 mw4 = (u32x4){0u, 0u, 0u, 0u}, mw4n = (u32x4){0u, 0u, 0u, 0u};
#define ST_LOAD(j) do { _Pragma("unroll") for (int c_ = 0; c_ < KCH; ++c_) kreg[c_] = *(const GAS u32x4*)(kg + (size_t)(j) * 64 * ldk + c_ * 64); \
        _Pragma("unroll") for (int c_ = 0; c_ < VCH; ++c_) vreg[c_] = *(const GAS u32x4*)(vg + (size_t)(j) * 64 * 512 + c_ * 64); \
        if (MODE == 2) { if (tid < 64) areg = *(const GAS float*)(ag + (j) * 64 + tid); } \
        asm volatile("" ::: "memory"); } while (0)
#define ST_WRITE(buf) do { LAS unsigned char* sb_ = F.lds + (buf) * STAGE; \
        _Pragma("unroll") for (int c_ = 0; c_ < KCH; ++c_) *(LAS u32x4*)(sb_ + srow * KROWB + (sch + 8 * c_) * 16) = kreg[c_]; \
        _Pragma("unroll") for (int c_ = 0; c_ < VCH; ++c_) *(LAS u32x4*)(sb_ + KBYTES + srow * VROWB + (sch + 8 * c_) * 16) = vreg[c_]; \
        if (MODE == 2) { if (tid < 64) *(LAS float*)(sb_ + KBYTES + VBYTES + tid * 4) = areg * LOG2E; } } while (0)
    if (MODE == 0) mw4n = *(const GAS u32x4*)(mrow + JB);
    ST_LOAD(JB); ST_WRITE(0);
    __syncthreads();
    for (int j = JB; j < JB + NT; ++j) {
        const int cur = j & 1;
        if (MODE == 0) {
            if ((j & 3) == 0) { mw4 = mw4n; if (j + 4 < JB + NT) mw4n = *(const GAS u32x4*)(mrow + j + 4); }
            mw = (j & 3) == 0 ? mw4.x : ((j & 3) == 1 ? mw4.y : ((j & 3) == 2 ? mw4.z : mw4.w));
        }
        if (j + 1 < JB + NT && (probe == 0 || probe == 2 || probe == 3)) ST_LOAD(j + 1);
        if (64 * j <= q0w + 31) {
            LAS const unsigned char* kb = F.lds + cur * STAGE;
            attn_tile<MODE>(o[0], lsum[0], mref[0], qf[0], kb, koff + comp * 128, voff, j, q0w, r, h, mw, M2, wsf, 64 * j + 63 > q0w, probe);
        }
        if (probe != 4) { if (j + 1 < JB + NT) ST_WRITE(cur ^ 1);
        __syncthreads(); }
    }
#undef ST_LOAD
#undef ST_WRITE
    }
    if (MODE == 2) { if (qb > 0) {
        const float Mp2 = ((const float*)(F.ws + WS_MQ))[(size_t)seq * SEQ + 256 * qb - 1] * LOG2E;
        const float M2s = ((const float*)(F.ws + WS_MQ))[(size_t)seq * SEQ + q0w + r] * LOG2E;
        const float g = fexp2(Mp2 - M2s);
        const float* NSn = (const float*)(F.ws + WS_MN + 128 * 1024) + ((size_t)seq * 16 + qb) * 128;
        const bf16_t* Cn = (const bf16_t*)(F.ws + WS_MC) + ((size_t)seq * 16 + qb) * 16384;
        bf16x8 qs[8]; float dpart = 0.f;
#pragma unroll
        for (int s = 0; s < 8; ++s) {
            const bf16x8 qv = *(const GAS bf16x8*)(Qp + (rowb + q0w + r) * ldq + 16 * s + 8 * h);
            const u32x4 qw = __builtin_bit_cast(u32x4, qv);
            const f32x4 n0 = *(const GAS f32x4*)(NSn + 16 * s + 8 * h), n1 = *(const GAS f32x4*)(NSn + 16 * s + 8 * h + 4);
            const float q0 = bflo(qw.x), q1 = bfhi(qw.x), q2 = bflo(qw.y), q3 = bfhi(qw.y), q4 = bflo(qw.z), q5 = bfhi(qw.z), q6 = bflo(qw.w), q7 = bfhi(qw.w);
            dpart += (q0 * n0[0] + q1 * n0[1]) + (q2 * n0[2] + q3 * n0[3]) + (q4 * n1[0] + q5 * n1[1]) + (q6 * n1[2] + q7 * n1[3]);
            u32x4 t; t.x = cvtpk(q0 * g, q1 * g); t.y = cvtpk(q2 * g, q3 * g); t.z = cvtpk(q4 * g, q5 * g); t.w = cvtpk(q6 * g, q7 * g);
            qs[s] = __builtin_bit_cast(bf16x8, t);
        }
        lsum[0] += g * dpart;
        {
            bf16x8 cfa[8], cfb[8];
#define CF_LOAD(arr, v_) do { _Pragma("unroll") for (int s = 0; s < 8; ++s) arr[s] = *(const GAS bf16x8*)(Cn + (size_t)(32 * (v_) + r) * 128 + 16 * s + 8 * h); } while (0)
            CF_LOAD(cfa, 0); CF_LOAD(cfb, 1);
            SBAR();
#pragma unroll
            for (int s = 0; s < 8; ++s) o[0][0] = MFMA32(qs[s], cfa[s], o[0][0]);
            SBAR(); CF_LOAD(cfa, 2); SBAR();
#pragma unroll
            for (int s = 0; s < 8; ++s) o[0][1] = MFMA32(qs[s], cfb[s], o[0][1]);
            SBAR(); CF_LOAD(cfb, 3); SBAR();
#pragma unroll
            for (int s = 0; s < 8; ++s) o[0][2] = MFMA32(qs[s], cfa[s], o[0][2]);
#pragma unroll
            for (int s = 0; s < 8; ++s) o[0][3] = MFMA32(qs[s], cfb[s], o[0][3]);
            SBAR();
#undef CF_LOAD
        }
    } }
    float sc0; const float sc1 = 0.f;
    if (MODE == 1) { lam_val = ((volatile LAS float*)(F.lds + MISC_OFF + 96))[0]; lam_init = ((volatile LAS float*)(F.lds + MISC_OFF + 96))[1]; }
    { float lt = sum32x(lsum[0]);
      if (MODE == 2) sc0 = frcp(fmaxf(fabsf(lt), ((const float*)(F.ws + WS_EM))[(size_t)seq * SEQ + q0w + r]));
      else if (MODE == 1) sc0 = (comp ? lam_val : 1.0f) * frcp(lt);
      else sc0 = frcp(lt); }
    if (h == 0) { wsf[r] = sc0; wsf[32 + r] = sc1; }
    WSYNC();
    LAS float* stg = (LAS float*)(F.lds + w * 16384);
#pragma unroll
    for (int g = 0; g < 4; ++g) {
        const f32x4 av = *(LAS const f32x4*)(wsf + 8 * g + 4 * h);
#pragma unroll
        for (int e = 0; e < 4; ++e) { const int i = 4 * g + e, row = 8 * g + 4 * h + e;
#pragma unroll
            for (int v = 0; v < NVB; ++v) { float val = o[0][v][i] * av[e]; stg[row * DV + 32 * v + r] = val; } }
    }
    WSYNC();
    if (MODE == 1) __syncthreads();
    if (MODE != 1 || comp == 0) {
        const int q = lane >> 1, hf = lane & 1; constexpr int HC = DV / 2;
        LAS float* srow_ = stg + q * DV + hf * HC;
        if (MODE == 1) {
            LAS const float* prow_ = (LAS const float*)(F.lds + (w + 4) * 16384) + q * DV + hf * HC;
#pragma unroll
            for (int c4 = 0; c4 < HC / 4; ++c4) *(LAS f32x4*)(srow_ + 4 * c4) = *(LAS const f32x4*)(srow_ + 4 * c4) - *(LAS const f32x4*)(prow_ + 4 * c4);
        }
        size_t grow = rowb + q0w + q;
        bf16_t* Y = (bf16_t*)(F.ws + (probe ? WS_MD : WS_Y)); if (probe) grow &= 4095;
        if (MODE == 0) {
            bf16_t* yp = Y + grow * 1536 + 512 + head * 64 + hf * HC;
#pragma unroll
            for (int c8 = 0; c8 < HC / 8; ++c8) { const f32x4 x0 = *(LAS const f32x4*)(srow_ + 8 * c8), x1 = *(LAS const f32x4*)(srow_ + 8 * c8 + 4);
                u32x4 ov; ov.x = cvtpk(x0[0], x0[1]); ov.y = cvtpk(x0[2], x0[3]); ov.z = cvtpk(x1[0], x1[1]); ov.w = cvtpk(x1[2], x1[3]); *(u32x4*)(yp + 8 * c8) = ov; }
        } else {
            float ss = 0.f;
#pragma unroll
            for (int c4 = 0; c4 < HC / 4; ++c4) { const f32x4 x = *(LAS const f32x4*)(srow_ + 4 * c4); ss += (x[0] * x[0] + x[1] * x[1]) + (x[2] * x[2] + x[3] * x[3]); }
            ss += xor1(ss);
            float rs = 1.0f / sqrtf(ss * (1.f / 128.f) + EPS);
            const float* gain; bf16_t* yp; const bf16_t* gatep = nullptr;
            if (MODE == 1) { rs *= (1.0f - lam_init); gain = a.in[I_DOG] + (size_t)l * 128 + hf * HC; yp = Y + grow * 1536 + 1024 + head * 128 + hf * HC; }
            else { gain = a.in[I_MNG] + (size_t)l * 512 + head * 128 + hf * HC; yp = Y + grow * 1536 + head * 128 + hf * HC; gatep = (const bf16_t*)(F.ws + WS_OM) + grow * 512 + head * 128 + hf * HC; }
            f32x4 gpre[HC / 4]; u32x4 gtw[HC / 8];
#pragma unroll
            for (int c4 = 0; c4 < HC / 4; ++c4) gpre[c4] = *(const GAS f32x4*)(gain + 4 * c4);
            if (MODE == 2) {
#pragma unroll
                for (int c8 = 0; c8 < HC / 8; ++c8) gtw[c8] = *(const GAS u32x4*)(gatep + 8 * c8); }
#pragma unroll
            for (int c8 = 0; c8 < HC / 8; ++c8) {
                f32x4 x0 = *(LAS const f32x4*)(srow_ + 8 * c8), x1 = *(LAS const f32x4*)(srow_ + 8 * c8 + 4);
                const f32x4 g0 = gpre[2 * c8], g1 = gpre[2 * c8 + 1];
                x0 = x0 * rs * g0; x1 = x1 * rs * g1;
                if (MODE == 2) { const u32x4 w_ = gtw[c8]; const float gt[8] = {bflo(w_.x), bfhi(w_.x), bflo(w_.y), bfhi(w_.y), bflo(w_.z), bfhi(w_.z), bflo(w_.w), bfhi(w_.w)};
#pragma unroll
                    for (int e = 0; e < 4; ++e) { x0[e] *= gt[e]; x1[e] *= gt[4 + e]; } }
                u32x4 ov; ov.x = cvtpk(x0[0], x0[1]); ov.y = cvtpk(x0[2], x0[3]); ov.z = cvtpk(x1[0], x1[1]); ov.w = cvtpk(x1[2], x1[3]); *(u32x4*)(yp + 8 * c8) = ov;
            }
        }
    }
    __syncthreads();
}
#define PIN(x) asm volatile("" : "+v"(x))
DI int lane_now() { int l_; asm volatile("v_mbcnt_lo_u32_b32 %0, -1, 0\n\tv_mbcnt_hi_u32_b32 %0, -1, %0" : "=v"(l_)); return l_; }
DI void dsa_unit(Frame& F, const Args& a, int l, int b, int head, int qb) {
    constexpr int KROWB = 144, VROWB = 192, KBYTES = 64 * KROWB, VBYTES = 64 * VROWB;
    constexpr int KS = 0, VS = 2 * KBYTES, STG_OFF = 65536;
    F.refresh();
    const int tid = F.tid, lane = F.lane, w = F.wave, r = lane & 31, h = lane >> 5;
    const bf16_t* Qp = (const bf16_t*)(F.ws + WS_SQ) + head * 64; const bf16_t* Kp = (const bf16_t*)(F.ws + WS_SK) + head * 64; const bf16_t* Vp = (const bf16_t*)(F.ws + WS_SV) + head * 64;
    const size_t rowb = (size_t)b * SEQ;
    const int q0w = qb * 256 + w * 32, NT = 4 * (qb + 1), jact = (q0w + 31) >> 6;
    LAS float* wsf = (LAS float*)(F.lds + ATT_WSF_OFF + w * 256);
    const int i16 = lane & 15, vq = i16 >> 2, vp = i16 & 3, vcs = (lane >> 4) & 1;
    const int voff = (4 * h + vq) * VROWB + (16 * vcs + 4 * vp) * 2;
    const int koff = r * KROWB + 16 * h;
    bf16x8 qf[4];
#pragma unroll
    for (int s = 0; s < 4; ++s) qf[s] = *(const GAS bf16x8*)(Qp + (rowb + q0w + r) * 512 + 16 * s + 8 * h);
    f32x16 o0, o1, pA0, pA1, pB0, pB1;
#pragma unroll
    for (int i = 0; i < 16; ++i) { o0[i] = 0.f; o1[i] = 0.f; pB0[i] = 0.f; pB1[i] = 0.f; }
    float lsum = 0.f, mref = 0.f;
    const unsigned* mrow = (const unsigned*)(F.ws + WS_MASK) + ((rowb + q0w + r) * 2 + h) * 4;
    const int srow = tid >> 3, sch = tid & 7;
    const bf16_t* kg = Kp + (rowb + srow) * 512 + sch * 8; const bf16_t* vg = Vp + (rowb + srow) * 512 + sch * 8;
    LAS unsigned char* kwr = F.lds + KS + srow * KROWB + sch * 16;
    LAS unsigned char* vwr = F.lds + VS + srow * VROWB + sch * 16;
    u32x4 kreg, vreg, mw4, mw4n, pw0, pw1, pw2, pw3; bf16x8 kf[8]; s16x4 vlo[8], vhi[8];
    unsigned nmw;
#define D_CI1(NX, i, bit) { int a_; asm("v_bfe_i32 %0, %1, " #bit ", 1" : "=v"(a_) : "v"(nmw)); NX[i] = __uint_as_float((unsigned)a_ & 0xF149F2CAu); }
#define D_CI4(NX, i, bit) D_CI1(NX, i, bit) D_CI1(NX, i + 1, bit + 1) D_CI1(NX, i + 2, bit + 2) D_CI1(NX, i + 3, bit + 3)
    mw4 = *(const GAS u32x4*)(mrow); mw4n = *(const GAS u32x4*)(mrow + (size_t)MC * 8);
    kreg = *(const GAS u32x4*)(kg); vreg = *(const GAS u32x4*)(kg + (size_t)64 * 512);
    *(LAS u32x4*)(kwr) = kreg; *(LAS u32x4*)(kwr + KBYTES) = vreg;
    { unsigned z_ = 0u; asm volatile("" : "+v"(z_));
      *(LAS u32x4*)(F.lds + VS + VBYTES + tid * 16) = (u32x4){z_, z_, z_, z_}; *(LAS u32x2*)(F.lds + VS + VBYTES + 8192 + tid * 8) = (u32x2){z_, z_}; }
    __syncthreads();
#pragma unroll
    for (int g = 0; g < 8; ++g) kf[g] = *(LAS const bf16x8*)(F.lds + KS + koff + 32 * (g >> 1) + (g & 1) * 32 * KROWB);
    nmw = ~mw4.x;
    D_CI4(pA0, 0, 0) D_CI4(pA0, 4, 4) D_CI4(pA0, 8, 8) D_CI4(pA0, 12, 12) D_CI4(pA1, 0, 16) D_CI4(pA1, 4, 20) D_CI4(pA1, 8, 24) D_CI4(pA1, 12, 28)
#define D_VFR(g) (bf16x8){vlo[g][0], vlo[g][1], vlo[g][2], vlo[g][3], vhi[g][0], vhi[g][1], vhi[g][2], vhi[g][3]}
#define D_VRD(g, vb_) do { vlo[g] = trread((vb_) + (32 * ((g) >> 2) + 16 * (((g) >> 1) & 1)) * VROWB + 64 * ((g) & 1)); vhi[g] = trread((vb_) + (32 * ((g) >> 2) + 16 * (((g) >> 1) & 1) + 8) * VROWB + 64 * ((g) & 1)); } while (0)
#define D_GAPA(g, CX, QF, PX, pi, PW, c0) do { D_VRD(g, vprev); \
        CX = MFMA32(kf[g], qf[QF], CX); \
        sacc += PX[pi]; sacc += PX[pi + 1]; sacc += PX[pi + 2]; sacc += PX[pi + 3]; \
        PW[c0] = cvtpk(PX[pi], PX[pi + 1]); PW[c0 + 1] = cvtpk(PX[pi + 2], PX[pi + 3]); \
        PIN(PW); PIN(sacc); SBAR(); } while (0)
#define D_GAPB(g, OX, PW, CX, ci, NX, bit) do { OX = MFMA32(__builtin_bit_cast(bf16x8, PW), D_VFR(g), OX); \
        CX[ci] = fexp2(CX[ci]); CX[ci + 1] = fexp2(CX[ci + 1]); CX[ci + 2] = fexp2(CX[ci + 2]); CX[ci + 3] = fexp2(CX[ci + 3]); \
        kf[g] = *(LAS const bf16x8*)(knext + 32 * ((g) >> 1) + ((g) & 1) * 32 * KROWB); \
        D_CI4(NX, ci, bit) \
        PIN(CX); PIN(NX); SBAR(); } while (0)
#define D_STEP(C0, C1, P0, P1, t, PAR) do { \
        { const int jn = (t) + 1; \
          if (PAR) { if ((jn & 3) == 0) { mw4 = mw4n; int jl = jn + 4; jl = jl > 60 ? 60 : jl; mw4n = *(const GAS u32x4*)(mrow + (size_t)(jl >> 2) * (MC * 8)); } } \
          unsigned mwn = PAR ? ((jn & 2) ? mw4.z : mw4.x) : ((jn & 2) ? mw4.w : mw4.y); \
          if (jn > jact) mwn = 0u; \
          nmw = ~mwn; } \
        { int jk = (t) + 2; jk = jk > NT - 1 ? NT - 1 : jk; \
          kreg = *(const GAS u32x4*)(kg + (size_t)jk * 64 * 512); vreg = *(const GAS u32x4*)(vg + (size_t)(t) * 64 * 512); } \
        if ((t) <= jact + 1) {                           \
        LAS const unsigned char* vprev = F.lds + VS + (1 - PAR) * VBYTES + voff; \
        LAS const unsigned char* knext = F.lds + KS + (1 - PAR) * KBYTES + koff; \
        float sacc = 0.f; \
        SBAR(); \
        D_GAPA(0, C0, 0, P0, 0, pw0, 0); D_GAPA(1, C1, 0, P0, 4, pw0, 2); D_GAPA(2, C0, 1, P0, 8, pw1, 0); D_GAPA(3, C1, 1, P0, 12, pw1, 2); \
        D_GAPA(4, C0, 2, P1, 0, pw2, 0); D_GAPA(5, C1, 2, P1, 4, pw2, 2); D_GAPA(6, C0, 3, P1, 8, pw3, 0); D_GAPA(7, C1, 3, P1, 12, pw3, 2); \
        lsum += sacc; \
        bool resc = false; \
        { asm volatile("s_nop 15\n\ts_nop 7" : "+v"(C0), "+v"(C1)); \
          float ta = max3f(C0[0], C0[1], C1[0]), tb = max3f(C0[2], C0[3], C1[1]); ta = max3f(ta, C1[2], C1[3]); \
          _Pragma("unroll") for (int i = 4; i < 16; i += 4) { ta = max3f(ta, C0[i], C0[i + 1]); tb = max3f(tb, C0[i + 2], C0[i + 3]); ta = max3f(ta, C1[i], C1[i + 1]); tb = max3f(tb, C1[i + 2], C1[i + 3]); } \
          float tm = max3f(ta, tb, tb); tm = max32x(tm); \
          if (__any(tm > mref + RESC_THR)) {            \
              const float nm = tm > mref + RESC_THR ? tm : mref, al = fexp2(mref - nm); \
              mref = nm; lsum *= al; if (h == 0) wsf[r] = al; resc = true; } \
          if (__any(mref != 0.f)) { _Pragma("unroll") for (int i = 0; i < 16; ++i) { C0[i] -= mref; C1[i] -= mref; } } } \
        SBAR(); \
        D_GAPB(0, o0, pw0, C0, 0, P0, 0); D_GAPB(1, o1, pw0, C0, 4, P0, 4); D_GAPB(2, o0, pw1, C0, 8, P0, 8); D_GAPB(3, o1, pw1, C0, 12, P0, 12); \
        D_GAPB(4, o0, pw2, C1, 0, P1, 16); D_GAPB(5, o1, pw2, C1, 4, P1, 20); D_GAPB(6, o0, pw3, C1, 8, P1, 24); D_GAPB(7, o1, pw3, C1, 12, P1, 28); \
        if (resc) { WSYNC(); \
            _Pragma("unroll") for (int g = 0; g < 4; ++g) { const f32x4 av = *(LAS const f32x4*)(wsf + 8 * g + 4 * h); \
                _Pragma("unroll") for (int e = 0; e < 4; ++e) { o0[4 * g + e] *= av[e]; o1[4 * g + e] *= av[e]; } } \
            WSYNC(); } } \
        *(LAS u32x4*)(kwr + PAR * KBYTES) = kreg; *(LAS u32x4*)(vwr + PAR * VBYTES) = vreg; \
        __syncthreads(); } while (0)
    for (int t = 0; t < NT; t += 2) {
        D_STEP(pA0, pA1, pB0, pB1, t, 0);
        D_STEP(pB0, pB1, pA0, pA1, t + 1, 1);
    }
    if (jact >= NT - 1) { float sacc = 0.f;
#pragma unroll
      for (int i = 0; i < 16; ++i) sacc += pB0[i] + pB1[i];
      lsum += sacc;
      pw0 = (u32x4){cvtpk(pB0[0], pB0[1]), cvtpk(pB0[2], pB0[3]), cvtpk(pB0[4], pB0[5]), cvtpk(pB0[6], pB0[7])}; pw1 = (u32x4){cvtpk(pB0[8], pB0[9]), cvtpk(pB0[10], pB0[11]), cvtpk(pB0[12], pB0[13]), cvtpk(pB0[14], pB0[15])};
      pw2 = (u32x4){cvtpk(pB1[0], pB1[1]), cvtpk(pB1[2], pB1[3]), cvtpk(pB1[4], pB1[5]), cvtpk(pB1[6], pB1[7])}; pw3 = (u32x4){cvtpk(pB1[8], pB1[9]), cvtpk(pB1[10], pB1[11]), cvtpk(pB1[12], pB1[13]), cvtpk(pB1[14], pB1[15])};
      LAS const unsigned char* vlast = F.lds + VS + VBYTES + voff;
      D_VRD(0, vlast); D_VRD(1, vlast); D_VRD(2, vlast); D_VRD(3, vlast); D_VRD(4, vlast); D_VRD(5, vlast); D_VRD(6, vlast); D_VRD(7, vlast);
      o0 = MFMA32(__builtin_bit_cast(bf16x8, pw0), D_VFR(0), o0); o1 = MFMA32(__builtin_bit_cast(bf16x8, pw0), D_VFR(1), o1); o0 = MFMA32(__builtin_bit_cast(bf16x8, pw1), D_VFR(2), o0); o1 = MFMA32(__builtin_bit_cast(bf16x8, pw1), D_VFR(3), o1);
      o0 = MFMA32(__builtin_bit_cast(bf16x8, pw2), D_VFR(4), o0); o1 = MFMA32(__builtin_bit_cast(bf16x8, pw2), D_VFR(5), o1); o0 = MFMA32(__builtin_bit_cast(bf16x8, pw3), D_VFR(6), o0); o1 = MFMA32(__builtin_bit_cast(bf16x8, pw3), D_VFR(7), o1); }
#undef D_STEP
#undef D_GAPA
#undef D_GAPB
#undef D_VRD
#undef D_VFR
#undef D_CI4
#undef D_CI1
    { const float sc0 = frcp(sum32x(lsum)); if (h == 0) wsf[r] = sc0; }
    WSYNC();
    LAS float* stg = (LAS float*)(F.lds + STG_OFF + w * 8192);
#pragma unroll
    for (int g = 0; g < 4; ++g) {
        const f32x4 av = *(LAS const f32x4*)(wsf + 8 * g + 4 * h);
#pragma unroll
        for (int e = 0; e < 4; ++e) { const int i = 4 * g + e, row = 8 * g + 4 * h + e; stg[row * 64 + r] = o0[i] * av[e]; stg[row * 64 + 32 + r] = o1[i] * av[e]; }
    }
    WSYNC();
    { const int q = lane >> 1, hf = lane & 1;
      LAS const float* srow_ = stg + q * 64 + hf * 32;
      bf16_t* yp = (bf16_t*)(F.ws + WS_Y) + (rowb + q0w + q) * 1536 + 512 + head * 64 + hf * 32;
#pragma unroll
      for (int c8 = 0; c8 < 4; ++c8) { const f32x4 x0 = *(LAS const f32x4*)(srow_ + 8 * c8), x1 = *(LAS const f32x4*)(srow_ + 8 * c8 + 4);
          u32x4 ov; ov.x = cvtpk(x0[0], x0[1]); ov.y = cvtpk(x0[2], x0[3]); ov.z = cvtpk(x1[0], x1[1]); ov.w = cvtpk(x1[2], x1[3]); *(u32x4*)(yp + 8 * c8) = ov; } }
    __syncthreads();
}
DI void diff_unit(Frame& F, const Args& a, int l, int b, int head, int qb) {
    constexpr int KROWB = 272, VROWB = 320, KBYTES = 64 * KROWB, VBYTES = 64 * VROWB;
    constexpr int KS = 0, VS = 2 * KBYTES;
    static_assert(VS + 2 * VBYTES <= RING_BYTES, "tile slots");
    F.refresh();
    const int tid = F.tid, lane = F.lane, w = F.wave, r = lane & 31, h = lane >> 5;
    const bf16_t* Qp = (const bf16_t*)(F.ws + WS_DQ) + head * 128;
    const size_t rowb = (size_t)b * SEQ;
    const int comp = w >> 2;
    const int q0w = qb * 128 + (w & 3) * 32, NT = 2 * (qb + 1);
#define wsf ((LAS float*)(F.lds + ATT_WSF_OFF + w * 256))
    const int i16 = lane & 15, vq = i16 >> 2, vp = i16 & 3, vcs = (lane >> 4) & 1;
    const int voff = (4 * h + vq) * VROWB + (16 * vcs + 4 * vp) * 2;
    const int koff = r * KROWB + 16 * h + comp * 128;
    bf16x8 qf[4];
#pragma unroll
    for (int s = 0; s < 4; ++s) qf[s] = *(const GAS bf16x8*)(Qp + (rowb + q0w + r) * 512 + comp * 64 + 16 * s + 8 * h);
    f32x16 o0, o1, o2, o3, c0, c1;
#pragma unroll
    for (int i = 0; i < 16; ++i) { o0[i] = 0.f; o1[i] = 0.f; o2[i] = 0.f; o3[i] = 0.f; }
    float lsum = 0.f, mref = 0.f;
    const int srow = tid >> 3, sch = tid & 7;
    const GAS unsigned char* kgb = (const GAS unsigned char*)(F.ws + WS_DK); const GAS unsigned char* vgb = (const GAS unsigned char*)(F.ws + WS_DV);
    const unsigned goff = (unsigned)(((rowb + srow) * 512 + sch * 8 + head * 128) * 2);
    LAS unsigned char* kwr = F.lds + KS + srow * KROWB + sch * 16;
    LAS unsigned char* vwr = F.lds + VS + srow * VROWB + sch * 16;
    u32x4 kreg0, kreg1, vreg0, vreg1, pwa0, pwa1, pwa2, pwa3, pwb0, pwb1, pwb2, pwb3; bf16x8 kf[8]; s16x4 valo[8], vahi[8], vblo[8], vbhi[8];
    kreg0 = *(const GAS u32x4*)(kgb + goff); kreg1 = *(const GAS u32x4*)(kgb + goff + 128); vreg0 = *(const GAS u32x4*)(kgb + goff + 65536); vreg1 = *(const GAS u32x4*)(kgb + goff + 65536 + 128);
    *(LAS u32x4*)(kwr) = kreg0; *(LAS u32x4*)(kwr + 128) = kreg1; *(LAS u32x4*)(kwr + KBYTES) = vreg0; *(LAS u32x4*)(kwr + KBYTES + 128) = vreg1;
    { unsigned z_ = 0u; asm volatile("" : "+v"(z_));
      *(LAS u32x4*)(F.lds + VS + VBYTES + tid * 16) = (u32x4){z_, z_, z_, z_}; *(LAS u32x4*)(F.lds + VS + VBYTES + 8192 + tid * 16) = (u32x4){z_, z_, z_, z_}; *(LAS u32x2*)(F.lds + VS + VBYTES + 16384 + tid * 8) = (u32x2){z_, z_};
      pwb0 = (u32x4){z_, z_, z_, z_}; pwb1 = pwb0; pwb2 = pwb0; pwb3 = pwb0; }
    __syncthreads();
#pragma unroll
    for (int g = 0; g < 8; ++g) kf[g] = *(LAS const bf16x8*)(F.lds + KS + koff + 32 * (g >> 1) + (g & 1) * 32 * KROWB);
#define F_VFR(LO, HI, g) (bf16x8){LO[g][0], LO[g][1], LO[g][2], LO[g][3], HI[g][0], HI[g][1], HI[g][2], HI[g][3]}
#define F_VRD(LO, HI, g, vb_, bb) do { LO[g] = trread((vb_) + (32 * ((g) >> 2) + 16 * (((g) >> 1) & 1)) * VROWB + 64 * (2 * (bb) + ((g) & 1))); \
        HI[g] = trread((vb_) + (32 * ((g) >> 2) + 16 * (((g) >> 1) & 1) + 8) * VROWB + 64 * (2 * (bb) + ((g) & 1))); } while (0)
#define F_GAPA(g, CX, QF, FIRST) do { F_VRD(valo, vahi, g, vprev, 0); \
        if (FIRST) CX = MFMA32(kf[g], qf[QF], zero16_); else CX = MFMA32(kf[g], qf[QF], CX); \
        SBAR(); } while (0)
#define F_SM(G, CX, ci, PW) { const float x_ = fexp2(CX[ci]), y_ = fexp2(CX[ci + 1]); sacc += x_; sacc += y_; PW[(G) & 3] = cvtpk(x_, y_); }
#define F_GAPB0(G, OX, PWP, CX, ci, PWC) do { OX = MFMA32(__builtin_bit_cast(bf16x8, PWP), F_VFR(valo, vahi, G), OX); \
        F_SM(G, CX, ci, PWC) \
        F_VRD(vblo, vbhi, G, vprev, 1); \
        PIN(PWC); PIN(sacc); SBAR(); } while (0)
#define F_GAPB1(G, OX, PWP, CX, ci, PWC) do { OX = MFMA32(__builtin_bit_cast(bf16x8, PWP), F_VFR(vblo, vbhi, (G) - 8), OX); \
        F_SM(G, CX, ci, PWC) \
        kf[(G) - 8] = *(LAS const bf16x8*)(knext + 32 * (((G) - 8) >> 1) + (((G) - 8) & 1) * 32 * KROWB); \
        PIN(PWC); PIN(sacc); SBAR(); } while (0)
#define F_STEP(P0_, P1_, P2_, P3_, N0_, N1_, N2_, N3_, t, PAR) do { \
        { int jk = (t) + 2; jk = jk > NT - 1 ? NT - 1 : jk; \
          const GAS unsigned char* kt_ = kgb + (size_t)jk * 65536; const GAS unsigned char* vt_ = vgb + (size_t)(t) * 65536; \
          kreg0 = *(const GAS u32x4*)(kt_ + goff); kreg1 = *(const GAS u32x4*)(kt_ + goff + 128); \
          vreg0 = *(const GAS u32x4*)(vt_ + goff); vreg1 = *(const GAS u32x4*)(vt_ + goff + 128); } \
        LAS const unsigned char* vprev = F.lds + VS + (1 - PAR) * VBYTES + voff; \
        LAS const unsigned char* knext = F.lds + KS + (1 - PAR) * KBYTES + koff; \
        f32x16 zero16_; _Pragma("unroll") for (int i = 0; i < 16; ++i) zero16_[i] = 0.f; \
        SBAR(); \
        F_GAPA(0, c0, 0, true); F_GAPA(1, c1, 0, true); F_GAPA(2, c0, 1, false); F_GAPA(3, c1, 1, false); F_GAPA(4, c0, 2, false); F_GAPA(5, c1, 2, false); F_GAPA(6, c0, 3, false); F_GAPA(7, c1, 3, false); \
        bool resc = false; \
        { asm volatile("s_nop 15\n\ts_nop 7" : "+v"(c0), "+v"(c1)); \
          if (64 * (t) + 63 > q0w) {                     \
              const int ln_ = lane_now(), qd = q0w + (ln_ & 31) - 64 * (t) - 4 * (ln_ >> 5); \
              _Pragma("unroll") for (int i = 0; i < 16; ++i) { const int kk = (i & 3) + 8 * (i >> 2); if (kk > qd) c0[i] = NEGBIG; if (kk + 32 > qd) c1[i] = NEGBIG; } \
              asm volatile("" : "+v"(c0), "+v"(c1)); } \
          float ta = max3f(c0[0], c0[1], c1[0]), tb = max3f(c0[2], c0[3], c1[1]); ta = max3f(ta, c1[2], c1[3]); \
          _Pragma("unroll") for (int i = 4; i < 16; i += 4) { ta = max3f(ta, c0[i], c0[i + 1]); tb = max3f(tb, c0[i + 2], c0[i + 3]); ta = max3f(ta, c1[i], c1[i + 1]); tb = max3f(tb, c1[i + 2], c1[i + 3]); } \
          float tm = max3f(ta, tb, tb); tm = max32x(tm); \
          if (__any(tm > mref + RESC_THR)) {            \
              const float nm = tm > mref + RESC_THR ? tm : mref, al = fexp2(mref - nm); \
              mref = nm; lsum *= al; { const int ln_ = lane_now(); if (ln_ < 32) wsf[ln_] = al; } resc = true; } \
          if (__any(mref != 0.f)) { _Pragma("unroll") for (int i = 0; i < 16; ++i) { c0[i] -= mref; c1[i] -= mref; } } } \
        float sacc = 0.f; \
        SBAR(); \
        F_GAPB0(0, o0, P0_, c0, 0, N0_); F_GAPB0(1, o1, P0_, c0, 2, N0_); F_GAPB0(2, o0, P1_, c0, 4, N0_); F_GAPB0(3, o1, P1_, c0, 6, N0_); \
        F_GAPB0(4, o0, P2_, c0, 8, N1_); F_GAPB0(5, o1, P2_, c0, 10, N1_); F_GAPB0(6, o0, P3_, c0, 12, N1_); F_GAPB0(7, o1, P3_, c0, 14, N1_); \
        F_GAPB1(8, o2, P0_, c1, 0, N2_); F_GAPB1(9, o3, P0_, c1, 2, N2_); F_GAPB1(10, o2, P1_, c1, 4, N2_); F_GAPB1(11, o3, P1_, c1, 6, N2_); \
        F_GAPB1(12, o2, P2_, c1, 8, N3_); F_GAPB1(13, o3, P2_, c1, 10, N3_); F_GAPB1(14, o2, P3_, c1, 12, N3_); F_GAPB1(15, o3, P3_, c1, 14, N3_); \
        lsum += sacc; \
        if (resc) { WSYNC(); const int h_ = lane_now() >> 5; \
            _Pragma("unroll") for (int g = 0; g < 4; ++g) { const f32x4 av = *(LAS const f32x4*)(wsf + 8 * g + 4 * h_); \
                _Pragma("unroll") for (int e = 0; e < 4; ++e) { o0[4 * g + e] *= av[e]; o1[4 * g + e] *= av[e]; o2[4 * g + e] *= av[e]; o3[4 * g + e] *= av[e]; } } \
            WSYNC(); } \
        *(LAS u32x4*)(kwr + PAR * KBYTES) = kreg0; *(LAS u32x4*)(kwr + PAR * KBYTES + 128) = kreg1; *(LAS u32x4*)(vwr + PAR * VBYTES) = vreg0; *(LAS u32x4*)(vwr + PAR * VBYTES + 128) = vreg1; \
        __syncthreads(); } while (0)
    for (int t = 0; t < NT; t += 2) {
        F_STEP(pwb0, pwb1, pwb2, pwb3, pwa0, pwa1, pwa2, pwa3, t, 0);
        F_STEP(pwa0, pwa1, pwa2, pwa3, pwb0, pwb1, pwb2, pwb3, t + 1, 1);
    }
    { LAS const unsigned char* vlast = F.lds + VS + VBYTES + voff;
#pragma unroll
      for (int g = 0; g < 8; ++g) { F_VRD(valo, vahi, g, vlast, 0); F_VRD(vblo, vbhi, g, vlast, 1); }
      o0 = MFMA32(__builtin_bit_cast(bf16x8, pwb0), F_VFR(valo, vahi, 0), o0); o1 = MFMA32(__builtin_bit_cast(bf16x8, pwb0), F_VFR(valo, vahi, 1), o1); o0 = MFMA32(__builtin_bit_cast(bf16x8, pwb1), F_VFR(valo, vahi, 2), o0); o1 = MFMA32(__builtin_bit_cast(bf16x8, pwb1), F_VFR(valo, vahi, 3), o1);
      o0 = MFMA32(__builtin_bit_cast(bf16x8, pwb2), F_VFR(valo, vahi, 4), o0); o1 = MFMA32(__builtin_bit_cast(bf16x8, pwb2), F_VFR(valo, vahi, 5), o1); o0 = MFMA32(__builtin_bit_cast(bf16x8, pwb3), F_VFR(valo, vahi, 6), o0); o1 = MFMA32(__builtin_bit_cast(bf16x8, pwb3), F_VFR(valo, vahi, 7), o1);
      o2 = MFMA32(__builtin_bit_cast(bf16x8, pwb0), F_VFR(vblo, vbhi, 0), o2); o3 = MFMA32(__builtin_bit_cast(bf16x8, pwb0), F_VFR(vblo, vbhi, 1), o3); o2 = MFMA32(__builtin_bit_cast(bf16x8, pwb1), F_VFR(vblo, vbhi, 2), o2); o3 = MFMA32(__builtin_bit_cast(bf16x8, pwb1), F_VFR(vblo, vbhi, 3), o3);
      o2 = MFMA32(__builtin_bit_cast(bf16x8, pwb2), F_VFR(vblo, vbhi, 4), o2); o3 = MFMA32(__builtin_bit_cast(bf16x8, pwb2), F_VFR(vblo, vbhi, 5), o3); o2 = MFMA32(__builtin_bit_cast(bf16x8, pwb3), F_VFR(vblo, vbhi, 6), o2); o3 = MFMA32(__builtin_bit_cast(bf16x8, pwb3), F_VFR(vblo, vbhi, 7), o3); }
#undef F_STEP
#undef F_GAPA
#undef F_GAPB0
#undef F_GAPB1
#undef F_SM
#undef F_VRD
#undef F_VFR
    __syncthreads();
    const int lane2 = lane_now(), r2 = lane2 & 31, h2 = lane2 >> 5;
    const float lam_val = ((volatile LAS float*)(F.lds + MISC_OFF + 96))[0], lam_init = ((volatile LAS float*)(F.lds + MISC_OFF + 96))[1];
    { const float sc0 = (comp ? lam_val : 1.0f) * frcp(sum32x(lsum)); if (h2 == 0) wsf[r2] = sc0; }
    WSYNC();
    LAS float* stg = (LAS float*)(F.lds + w * 16384);
#pragma unroll
    for (int g = 0; g < 4; ++g) {
        const f32x4 av = *(LAS const f32x4*)(wsf + 8 * g + 4 * h2);
#pragma unroll
        for (int e = 0; e < 4; ++e) { const int i = 4 * g + e, row = 8 * g + 4 * h2 + e;
            stg[row * 128 + r2] = o0[i] * av[e]; stg[row * 128 + 32 + r2] = o1[i] * av[e]; stg[row * 128 + 64 + r2] = o2[i] * av[e]; stg[row * 128 + 96 + r2] = o3[i] * av[e]; }
    }
    WSYNC();
    __syncthreads();
    {
        const int wb = w & 3, q = 16 * (w >> 2) + (lane2 >> 2), qt = lane2 & 3; constexpr int HC = 32;
        LAS const float* srow_ = (LAS const float*)(F.lds + wb * 16384) + q * 128 + qt * HC;
        LAS const float* prow_ = (LAS const float*)(F.lds + (wb + 4) * 16384) + q * 128 + qt * HC;
        f32x4 x[HC / 4]; float ss = 0.f;
#pragma unroll
        for (int c4 = 0; c4 < HC / 4; ++c4) { x[c4] = *(LAS const f32x4*)(srow_ + 4 * c4) - *(LAS const f32x4*)(prow_ + 4 * c4); ss += (x[c4][0] * x[c4][0] + x[c4][1] * x[c4][1]) + (x[c4][2] * x[c4][2] + x[c4][3] * x[c4][3]); }
        ss += xor1(ss); ss += xor2(ss);
        const float rs = (1.0f - lam_init) / sqrtf(ss * (1.f / 128.f) + EPS);
        const size_t grow = rowb + qb * 128 + wb * 32 + q;
        const float* gain = a.in[I_DOG] + (size_t)l * 128 + qt * HC;
        bf16_t* yp = (bf16_t*)(F.ws + WS_Y) + grow * 1536 + 1024 + head * 128 + qt * HC;
        f32x4 gpre[HC / 4];
#pragma unroll
        for (int c4 = 0; c4 < HC / 4; ++c4) gpre[c4] = *(const GAS f32x4*)(gain + 4 * c4);
#pragma unroll
        for (int c8 = 0; c8 < HC / 8; ++c8) {
            const f32x4 x0 = x[2 * c8] * rs * gpre[2 * c8], x1 = x[2 * c8 + 1] * rs * gpre[2 * c8 + 1];
            u32x4 ov; ov.x = cvtpk(x0[0], x0[1]); ov.y = cvtpk(x0[2], x0[3]); ov.z = cvtpk(x1[0], x1[1]); ov.w = cvtpk(x1[2], x1[3]); *(u32x4*)(yp + 8 * c8) = ov;
        }
    }
    __syncthreads();
#undef wsf
}
DI void phase_mixers(Frame& F, const Args& a, int l, int it, int modes, int probe) {
    F.refresh();
    const float* lam = a.in[I_LAM] + (size_t)l * 256;
    const float lam_init = (l == 0) ? 0.2f : 0.35550906759096934f;
    const float s01 = wave_sum(lam[F.lane] * lam[64 + F.lane]), s23 = wave_sum(lam[128 + F.lane] * lam[192 + F.lane]);
    { const float lv = fexp(s01) - fexp(s23) + lam_init; if (F.tid == 0) { ((volatile LAS int*)(F.lds + MISC_OFF + 96))[2] = probe; ((volatile LAS float*)(F.lds + MISC_OFF + 96))[0] = lv; ((volatile LAS float*)(F.lds + MISC_OFF + 96))[1] = lam_init; } }
    const float lam_val = 0.f;
    unsigned* qhead = (unsigned*)(F.ws + WS_CTL) + CW_QUEUE + it * 64;
    volatile LAS unsigned* slot = (volatile LAS unsigned*)(F.lds + MISC_OFF + 64);
    for (;;) {
        if (F.tid == 0) *slot = __hip_atomic_fetch_add(qhead, 1u, __ATOMIC_RELAXED, __HIP_MEMORY_SCOPE_AGENT);
        __syncthreads();
        const int u = __builtin_amdgcn_readfirstlane((int)*slot);
        __syncthreads();
        if (u >= 1280) break;
        if (u < 1024) { const int p_ = u >> 6, k = u & 63;
            if (k < 16) { if (modes & MIXMODES & 2) diff_unit(F, a, l, k >> 2, k & 3, 31 - 2 * p_); }
            else if (k < 48) { if (modes & MIXMODES & 1) dsa_unit(F, a, l, (k - 16) >> 3, (k - 16) & 7, 15 - p_); }
            else { if (modes & MIXMODES & 2) diff_unit(F, a, l, (k - 48) >> 2, (k - 48) & 3, 30 - 2 * p_); }
        } else { const int m_ = u - 1024; if (modes & MIXMODES & 4) attn_unit<2>(F, a, l, (m_ >> 2) & 3, m_ & 3, 15 - (m_ >> 4), lam_val, lam_init); }
    }
}

DI void mlstm_state_unit(Frame& F, int sq, int n, unsigned* scan_cnt) {
    F.refresh();
    if (F.tid == 0) { while (__hip_atomic_load(scan_cnt, __ATOMIC_RELAXED, __HIP_MEMORY_SCOPE_AGENT) < (unsigned)(CB * 4)) __builtin_amdgcn_s_sleep(8); }
    __syncthreads();
    __builtin_amdgcn_fence(__ATOMIC_ACQUIRE, "agent");
    constexpr int KROWB = 272, VROWB = 320, KBYTES = 64 * KROWB, VBYTES = 64 * VROWB;
    const int tid = F.tid, lane = F.lane, w = F.wave, r = lane & 31, h = lane >> 5, b = sq >> 2, head = sq & 3;
    const size_t rowb = (size_t)b * SEQ;
    const bf16_t* Kp = (const bf16_t*)(F.ws + WS_QK) + 512 + head * 128; const bf16_t* Vp = (const bf16_t*)(F.ws + WS_VM) + head * 128;
    const float* ag = (const float*)(F.ws + WS_AK) + (size_t)sq * SEQ;
    const float Mend = ((const float*)(F.ws + WS_MQ))[(size_t)sq * SEQ + 256 * n + 255];
    f32x16 acc[2];
#pragma unroll
    for (int c = 0; c < 2; ++c)
#pragma unroll
        for (int i = 0; i < 16; ++i) acc[c][i] = 0.f;
    const int dvb = w >> 1, dkb0 = 2 * (w & 1);
    const int srow = tid >> 3, sch = tid & 7;
    const int i16 = lane & 15, vq = i16 >> 2, vp = i16 & 3, vcs = (lane >> 4) & 1;
    const int toffV = (4 * h + vq) * VROWB + (16 * vcs + 4 * vp) * 2, toffK = (4 * h + vq) * KROWB + (16 * vcs + 4 * vp) * 2;
    LAS unsigned char* kb = F.lds; LAS unsigned char* vb = kb + KBYTES; LAS float* wts = (LAS float*)(vb + VBYTES);
    float nacc = 0.f; const int ndk = tid & 127, npart = tid >> 7;
    u32x4 kreg[2], vreg[2]; float araw;
#define MS_LOAD(j_) do { araw = *(const GAS float*)(ag + 64 * (j_) + srow); \
        _Pragma("unroll") for (int c = 0; c < 2; ++c) { kreg[c] = *(const GAS u32x4*)(Kp + (rowb + 64 * (j_) + srow) * 1024 + (sch + 8 * c) * 8); vreg[c] = *(const GAS u32x4*)(Vp + (rowb + 64 * (j_) + srow) * 512 + (sch + 8 * c) * 8); } } while (0)
    MS_LOAD(4 * n);
    for (int jt = 0; jt < 4; ++jt) {
        const float wr_ = fexp(araw - Mend);
#pragma unroll
        for (int c = 0; c < 2; ++c) { u32x4 t = vreg[c];
            t.x = cvtpk(bflo(t.x) * wr_, bfhi(t.x) * wr_); t.y = cvtpk(bflo(t.y) * wr_, bfhi(t.y) * wr_); t.z = cvtpk(bflo(t.z) * wr_, bfhi(t.z) * wr_); t.w = cvtpk(bflo(t.w) * wr_, bfhi(t.w) * wr_); vreg[c] = t; }
        __syncthreads();
#pragma unroll
        for (int c = 0; c < 2; ++c) { *(LAS u32x4*)(kb + srow * KROWB + (sch + 8 * c) * 16) = kreg[c]; *(LAS u32x4*)(vb + srow * VROWB + (sch + 8 * c) * 16) = vreg[c]; }
        if (sch == 0) wts[srow] = wr_;
        if (jt < 3) MS_LOAD(4 * n + jt + 1);
        __syncthreads();
        {
            bf16x8 afr[4], bfr2[4][2];
#pragma unroll
            for (int sg = 0; sg < 4; ++sg) {
                const s16x4 alo = trread(vb + toffV + (16 * sg) * VROWB + 64 * dvb), ahi = trread(vb + toffV + (16 * sg + 8) * VROWB + 64 * dvb);
                afr[sg] = (bf16x8){alo[0], alo[1], alo[2], alo[3], ahi[0], ahi[1], ahi[2], ahi[3]};
#pragma unroll
                for (int c = 0; c < 2; ++c) {
                    const s16x4 blo = trread(kb + toffK + (16 * sg) * KROWB + 64 * (dkb0 + c)), bhi = trread(kb + toffK + (16 * sg + 8) * KROWB + 64 * (dkb0 + c));
                    bfr2[sg][c] = (bf16x8){blo[0], blo[1], blo[2], blo[3], bhi[0], bhi[1], bhi[2], bhi[3]}; }
            }
            SBAR();
#pragma unroll
            for (int sg = 0; sg < 4; ++sg)
#pragma unroll
                for (int c = 0; c < 2; ++c) acc[c] = MFMA32(afr[sg], bfr2[sg][c], acc[c]);
            SBAR();
        }
#pragma unroll 4
        for (int s_ = 0; s_ < 16; ++s_) { const int ks = 16 * npart + s_; nacc += wts[ks] * bf2f(*(LAS const bf16_t*)(kb + ks * KROWB + ndk * 2)); }
    }
#undef MS_LOAD
    float* D = (float*)(F.ws + WS_MD) + ((size_t)sq * 16 + n) * 16384;
#pragma unroll
    for (int c = 0; c < 2; ++c)
#pragma unroll
        for (int i = 0; i < 16; ++i) D[(32 * dvb + (i & 3) + 8 * (i >> 2) + 4 * h) * 128 + 32 * (dkb0 + c) + r] = acc[c][i];
    __syncthreads();
    LAS float* red = (LAS float*)F.lds;
    red[npart * 128 + ndk] = nacc;
    __syncthreads();
    if (tid < 128) ((float*)(F.ws + WS_MN))[((size_t)sq * 16 + n) * 128 + tid] = (red[tid] + red[128 + tid]) + (red[256 + tid] + red[384 + tid]);
    __syncthreads();
}
DI void mlstm_state_scan(Frame& F) {
    const int gid = (F.bid * NWAVES + F.wave) * 64 + F.lane, NG_ = F.G * NWAVES * 64;
    const float* D = (const float*)(F.ws + WS_MD); bf16_t* C = (bf16_t*)(F.ws + WS_MC); const float* MQ = (const float*)(F.ws + WS_MQ);
    for (int e = gid; e < CB * 4 * 16384; e += NG_) {
        const int sq = e >> 14, idx = e & 16383;
        float d[15], me[15];
#pragma unroll
        for (int n = 0; n < 15; ++n) { d[n] = D[((size_t)sq * 16 + n) * 16384 + idx]; me[n] = MQ[(size_t)sq * SEQ + 256 * n + 255]; }
        float c = 0.f;
#pragma unroll
        for (int n = 0; n < 15; ++n) { const float f = n == 0 ? 0.f : fexp(me[n - 1] - me[n]); c = f * c + d[n]; C[((size_t)sq * 16 + n + 1) * 16384 + idx] = (bf16_t)f2bf(c); }
    }
    const float* Nv = (const float*)(F.ws + WS_MN); float* NS = (float*)(F.ws + WS_MN + 128 * 1024);
    for (int e = gid; e < CB * 4 * 128; e += NG_) {
        const int sq = e >> 7, idx = e & 127; float c = 0.f;
#pragma unroll
        for (int n = 0; n < 15; ++n) { const float me = MQ[(size_t)sq * SEQ + 256 * n + 255]; const float f = n == 0 ? 0.f : fexp(MQ[(size_t)sq * SEQ + 256 * (n - 1) + 255] - me);
            c = f * c + Nv[((size_t)sq * 16 + n) * 128 + idx]; NS[((size_t)sq * 16 + n + 1) * 128 + idx] = c; }
    }
}

constexpr size_t SC_BSTRIDE = (size_t)4096 * (64 * 65 / 2);
DI size_t sc_off(int b, int t) { const int qb = t >> 6; return (size_t)b * SC_BSTRIDE + (size_t)4096 * (qb * (qb + 1) / 2) + (size_t)(t & 63) * 64 * (qb + 1); }
constexpr int CW_QUEUE2 = 12288;
DI void phase_scores(Frame& F, int it) {
    F.refresh();
    unsigned* qhead = (unsigned*)(F.ws + WS_CTL) + CW_QUEUE2 + it * 64; unsigned* scan_cnt = (unsigned*)(F.ws + WS_CTL) + CW_SCAN + it * 64;
    volatile LAS unsigned* slot = (volatile LAS unsigned*)(F.lds + MISC_OFF + 64);
    const bf16_t* IQ = (const bf16_t*)(F.ws + WS_IQ); const bf16_t* IK = (const bf16_t*)(F.ws + WS_IK); const float* IW = (const float*)(F.ws + WS_IW);
    float* SC = (float*)(F.ws + WS_HREG);
    for (;;) {
        if (F.tid == 0) *slot = __hip_atomic_fetch_add(qhead, 1u, __ATOMIC_RELAXED, __HIP_MEMORY_SCOPE_AGENT);
        __syncthreads();
        int u = __builtin_amdgcn_readfirstlane((int)*slot);
        __syncthreads();
        if (u >= CB * 4 + CB * 160 + 240) break;
        if (u < CB * 4) { gate_scan_unit(F, u, scan_cnt); continue; }
        u -= CB * 4;
        if (u >= CB * 160) { const int m_ = u - CB * 160; mlstm_state_unit(F, m_ & 15, m_ >> 4, scan_cnt); continue; }
        int b = u / 160, k = u % 160, qb, seg;
        {
          int cls = 3, base = 0;
          for (;; --cls) { const int cnt = 16 * (cls + 1); if (k < base + cnt) break; base += cnt; }
          const int kk = k - base; qb = 16 * cls + (kk % 16); seg = kk / 16; }
        F.refresh();
        const int lane = F.lane, w = F.wave, r = lane & 31, h = lane >> 5, qh = w & 1;
        const int t0 = 64 * qb + 32 * qh;
        const size_t rowq = (size_t)b * SEQ + t0 + r;
        const f32x4 wv = *(const GAS f32x4*)(IW + rowq * 4);
        bf16x8 qf[4][4];
#pragma unroll
        for (int hd = 0; hd < 4; ++hd)
#pragma unroll
            for (int s = 0; s < 4; ++s) qf[hd][s] = *(const GAS bf16x8*)(IQ + rowq * 256 + hd * 64 + 16 * s + 8 * h);
        LAS unsigned* T = (LAS unsigned*)(F.lds + w * 8448);
        const int jplast = ((16 * seg + 15 < qb) ? 16 * seg + 15 : qb) >> 1;
        unsigned short* scb = (unsigned short*)(F.ws + WS_HREG) + sc_off(b, t0);
        const int rstride = 64 * (qb + 1);
        bf16x8 kpre[4];
        { const int jp0 = 8 * seg + (w >> 1), jpc = jp0 <= jplast ? jp0 : jplast;
#pragma unroll
          for (int s = 0; s < 4; ++s) kpre[s] = *(const GAS bf16x8*)(IK + ((size_t)b * SEQ + 64 * (2 * jpc) + r) * 64 + 8 * h + 16 * s); }
        for (int jp = 8 * seg + (w >> 1); jp <= jplast; jp += 4) {
            const int nt2 = (2 * jp + 1 <= qb) ? 2 : 1;
            bf16x8 kfa[4][4];
#pragma unroll
            for (int s = 0; s < 4; ++s) kfa[0][s] = kpre[s];
#pragma unroll
            for (int q4 = 1; q4 < 4; ++q4) { const int jq = 2 * jp + ((q4 >> 1) < nt2 ? (q4 >> 1) : 0);
#pragma unroll
                for (int s = 0; s < 4; ++s) kfa[q4][s] = *(const GAS bf16x8*)(IK + ((size_t)b * SEQ + 64 * jq + 32 * (q4 & 1) + r) * 64 + 8 * h + 16 * s); }
#pragma unroll
            for (int ts = 0; ts < 2; ++ts) { if (ts < nt2) {
#pragma unroll
                for (int p = 0; p < 2; ++p) {
                    float sc[16];
#pragma unroll
                    for (int i = 0; i < 16; ++i) sc[i] = 0.f;
#pragma unroll
                    for (int hd = 0; hd < 4; ++hd) {
                        f32x16 acc;
#pragma unroll
                        for (int i = 0; i < 16; ++i) acc[i] = 0.f;
#pragma unroll
                        for (int s = 0; s < 4; ++s) acc = MFMA32(kfa[2 * ts + p][s], qf[hd][s], acc);
#pragma unroll
                        for (int i = 0; i < 16; ++i) sc[i] += wv[hd] * fmaxf(acc[i], 0.f);
                    }
#pragma unroll
                    for (int i = 0; i < 16; i += 2) {
                        const unsigned lo = __builtin_bit_cast(unsigned short, (_Float16)(sc[i] + 0.0f)), hi = __builtin_bit_cast(unsigned short, (_Float16)(sc[i + 1] + 0.0f));
                        T[r * 65 + ((64 * ts + 32 * p + (i & 3) + 8 * (i >> 2) + 4 * h) >> 1)] = lo | (hi << 16); }
                }
            } }
            { const int jpn = jp + 4 <= jplast ? jp + 4 : jp;
#pragma unroll
              for (int s = 0; s < 4; ++s) kpre[s] = *(const GAS bf16x8*)(IK + ((size_t)b * SEQ + 64 * (2 * jpn) + r) * 64 + 8 * h + 16 * s); }
            WSYNC();
            {
                const int qs_ = lane >> 4, c_ = (lane & 15) * 4;
                if (c_ < 32 * nt2) {
#pragma unroll
                    for (int i = 0; i < 8; ++i) { const int q = 4 * i + qs_; LAS const unsigned* tp_ = T + q * 65 + c_;
                        *(u32x4*)((unsigned*)(scb + (size_t)q * rstride + 128 * jp) + c_) = (u32x4){tp_[0], tp_[1], tp_[2], tp_[3]}; }
                }
            }
            WSYNC();
        }
    }
}
DI unsigned long long spread32(unsigned x) {
    unsigned long long v = x;
    v = (v | (v << 16)) & 0x0000FFFF0000FFFFull; v = (v | (v << 8)) & 0x00FF00FF00FF00FFull; v = (v | (v << 4)) & 0x0F0F0F0F0F0F0F0Full;
    v = (v | (v << 2)) & 0x3333333333333333ull; v = (v | (v << 1)) & 0x5555555555555555ull; return v;
}
DI unsigned pack_nib(unsigned long long bm, int hh) {
    unsigned long long x = (bm >> (4 * hh)) & 0x0F0F0F0F0F0F0F0Full;
    x = (x | (x >> 4)) & 0x00FF00FF00FF00FFull; x = (x | (x >> 8)) & 0x0000FFFF0000FFFFull; x = (x | (x >> 16)) & 0x00000000FFFFFFFFull; return (unsigned)x;
}
DI void radix_find(LAS unsigned* hist, int lane, int& need, unsigned& digit, unsigned& cnt) {
    const u32x4 c = *(LAS const u32x4*)(hist + 4 * lane);
    const unsigned ls = (c.x + c.y) + (c.z + c.w); unsigned inc = ls;
#pragma unroll
    for (int o = 1; o < 64; o <<= 1) { const unsigned y = shup_u(inc, o, lane); if (lane >= o) inc += y; }
    const unsigned total = rdl_u(inc, 63);
    unsigned cum = total - inc; int fbin = -1; unsigned fneed = 0u, fcnt = 0u;
    if (cum < (unsigned)need && cum + c.w >= (unsigned)need) { fbin = 4 * lane + 3; fneed = (unsigned)need - cum; fcnt = c.w; } cum += c.w;
    if (fbin < 0 && cum < (unsigned)need && cum + c.z >= (unsigned)need) { fbin = 4 * lane + 2; fneed = (unsigned)need - cum; fcnt = c.z; } cum += c.z;
    if (fbin < 0 && cum < (unsigned)need && cum + c.y >= (unsigned)need) { fbin = 4 * lane + 1; fneed = (unsigned)need - cum; fcnt = c.y; } cum += c.y;
    if (fbin < 0 && cum < (unsigned)need && cum + c.x >= (unsigned)need) { fbin = 4 * lane; fneed = (unsigned)need - cum; fcnt = c.x; }
    const int src = __ffsll((long long)__ballot(fbin >= 0)) - 1;
    digit = rdl_u((unsigned)fbin, src); need = (int)rdl_u(fneed, src); cnt = rdl_u(fcnt, src);
}
template <int NGP>
DI void select_row(int row, int lane, LAS unsigned* hist, const unsigned (&raw)[32], unsigned* MASK, const int probe) {
        const int b = row >> 12, t = row & (SEQ - 1), n = t + 1, ngp = (t >> 7) + 1;
        unsigned key[NGP];
        (void)b;
#pragma unroll
        for (int i = 0; i < NGP; ++i) key[i] = raw[i];
#pragma unroll
        for (int i = 0; i < NGP; ++i) { const int e2 = 64 * i + lane; unsigned w_ = key[i];
            { const unsigned sg_ = (w_ >> 15) & 0x00010001u; w_ ^= ((sg_ << 15) - sg_) + 0x80008000u; }
            if (2 * e2 >= n) w_ &= 0xFFFF0000u; if (2 * e2 + 1 >= n) w_ &= 0x0000FFFFu; key[i] = w_; }
        unsigned thr = 0u; int need = 256; bool ties = false;
        if (n > 256 && probe != 1 && probe != 3) {
            unsigned dA = 0u, dB = 0u, cnt = 0u;
            { unsigned z_ = 0u; asm volatile("" : "+v"(z_)); *(LAS u32x4*)(hist + 4 * lane) = (u32x4){z_, z_, z_, z_}; }
            WSYNC();
#pragma unroll
            for (int i = 0; i < NGP; ++i) if (i < ngp) { const unsigned kx = key[i];
                __hip_atomic_fetch_add(&hist[(kx >> 8) & 255u], 1u, __ATOMIC_RELAXED, __HIP_MEMORY_SCOPE_WORKGROUP); __hip_atomic_fetch_add(&hist[kx >> 24], 1u, __ATOMIC_RELAXED, __HIP_MEMORY_SCOPE_WORKGROUP); }
            WSYNC();
            radix_find(hist, lane, need, dA, cnt);
            WSYNC();
            if ((unsigned)need != cnt) {
                { unsigned z_ = 0u; asm volatile("" : "+v"(z_)); *(LAS u32x4*)(hist + 4 * lane) = (u32x4){z_, z_, z_, z_}; }
                WSYNC();
#pragma unroll
                for (int i = 0; i < NGP; ++i) if (i < ngp) { const unsigned kx = key[i];
                    if (((kx >> 8) & 255u) == dA) __hip_atomic_fetch_add(&hist[kx & 255u], 1u, __ATOMIC_RELAXED, __HIP_MEMORY_SCOPE_WORKGROUP);
                    if ((kx >> 24) == dA) __hip_atomic_fetch_add(&hist[(kx >> 16) & 255u], 1u, __ATOMIC_RELAXED, __HIP_MEMORY_SCOPE_WORKGROUP); }
                WSYNC();
                radix_find(hist, lane, need, dB, cnt);
                WSYNC();
                thr = (dA << 8) | dB; ties = (unsigned)need != cnt;
            } else { thr = dA << 8; ties = false; }
        }
        unsigned elo = 0u, ehi = 0u, olo = 0u, ohi = 0u; int eqc = 0;
        if (probe == 1 || probe == 3) thr = 0x9000u;
        if (probe < 2)
        {
#define SEL_STEP(i) if constexpr ((i) < NGP) if ((i) < ngp) { const unsigned kx = key[(i) < NGP ? (i) : 0], kl = kx & 0xFFFFu, kh = kx >> 16; bool sl, sh; \
            if (n <= 256) { sl = kl != 0u; sh = kh != 0u; } \
            else if (!ties) { sl = kl >= thr; sh = kh >= thr; } \
            else { const bool ql = kl == thr, qh = kh == thr; const unsigned long long ml = __ballot(ql), mh = __ballot(qh), lt = (1ull << lane) - 1ull; \
                const int rl = eqc + __popcll(ml & lt) + __popcll(mh & lt), rh = rl + (ql ? 1 : 0); \
                sl = kl > thr || (ql && rl < need); sh = kh > thr || (qh && rh < need); eqc += __popcll(ml) + __popcll(mh); } \
            const unsigned long long be = __ballot(sl), bo = __ballot(sh); const unsigned e0 = (unsigned)be, e1 = (unsigned)(be >> 32), o0 = (unsigned)bo, o1 = (unsigned)(bo >> 32); \
            asm volatile("s_nop 4\n\tv_writelane_b32 %0, %4, " #i "\n\tv_writelane_b32 %1, %5, " #i "\n\tv_writelane_b32 %2, %6, " #i "\n\tv_writelane_b32 %3, %7, " #i \
                         : "+v"(elo), "+v"(ehi), "+v"(olo), "+v"(ohi) : "s"(e0), "s"(e1), "s"(o0), "s"(o1)); }
#define SEL8(b) SEL_STEP(b) SEL_STEP(b + 1) SEL_STEP(b + 2) SEL_STEP(b + 3) SEL_STEP(b + 4) SEL_STEP(b + 5) SEL_STEP(b + 6) SEL_STEP(b + 7)
        SEL8(0) SEL8(8) SEL8(16) SEL8(24)
#undef SEL8
#undef SEL_STEP
        }
        if (lane < 32) {
            const unsigned long long ta = spread32(elo) | (spread32(olo) << 1), tb = spread32(ehi) | (spread32(ohi) << 1);
            unsigned* mp_ = MASK + (((size_t)(lane >> 1) * MC + row) * 2) * 4 + 2 * (lane & 1);
            *(u32x2*)(mp_) = (u32x2){pack_nib(ta, 0), pack_nib(tb, 0)};
            *(u32x2*)(mp_ + 4) = (u32x2){pack_nib(ta, 1), pack_nib(tb, 1)};
        }
}
DI void phase_select(Frame& F, const int probe) {
    F.refresh();
    const int gw = F.bid * NWAVES + F.wave, NGW = F.G * NWAVES, lane = F.lane;
    LAS unsigned* hist = (LAS unsigned*)(F.lds + F.wave * 1024);
    const unsigned short* SC = (const unsigned short*)(F.ws + WS_HREG); unsigned* MASK = (unsigned*)(F.ws + WS_MASK);
    if (!probe) mlstm_state_scan(F);
    unsigned cur[32];
#define LOAD_ROW(dst, rw) do { const int t_ = (rw) & (SEQ - 1), em_ = t_ >> 1; const unsigned* sr_ = (const unsigned*)(SC + sc_off((rw) >> 12, t_)); \
        _Pragma("unroll") for (int i_ = 0; i_ < 32; ++i_) { const int e_ = 64 * i_ + lane; dst[i_] = *(const GAS unsigned*)(sr_ + (e_ < em_ ? e_ : em_)); } } while (0)
    const int nstep = (MC + NGW - 1) / NGW;
#define ROW_OF(k) ((NGW == 2048) ? (((k) >> 1) * SEQ + (((k) & 1) ? (SEQ - 1 - gw) : gw)) : (gw + (k) * NGW))
    if (gw < MC) LOAD_ROW(cur, ROW_OF(0));
    for (int k = 0; k < nstep; ++k) {
        const int row = ROW_OF(k); if (row >= MC) break;
        unsigned nxt[32]; const int nrow = (k + 1 < nstep && ROW_OF(k + 1) < MC) ? ROW_OF(k + 1) : row;
        LOAD_ROW(nxt, nrow);
        asm volatile("" ::: "memory");
        const int cls = (row & (SEQ - 1)) >> 10;
        unsigned* mk = probe ? (unsigned*)(F.ws + WS_QKRAW) : MASK;
        if (cls == 0) select_row<8>(row, lane, hist, cur, mk, probe);
        else if (cls == 1) select_row<16>(row, lane, hist, cur, mk, probe);
        else if (cls == 2) select_row<24>(row, lane, hist, cur, mk, probe);
        else select_row<32>(row, lane, hist, cur, mk, probe);
#pragma unroll
        for (int i = 0; i < 32; ++i) cur[i] = nxt[i];
    }
#undef ROW_OF
#undef LOAD_ROW
}

#ifndef MK_ONE_LAUNCH
#define MK_ONE_LAUNCH 1
#endif
constexpr int NPHASE = 13;
__global__ void __launch_bounds__(NWAVES * 64, 2) fwd(Args args) {
    extern __shared__ __attribute__((aligned(16))) unsigned char lds[];
    Frame F;
    F.lds = (LAS unsigned char*)lds; F.ws = (GAS unsigned char*)args.ws;
    F.tid = threadIdx.x; F.lane = F.tid & 63; F.wave = __builtin_amdgcn_readfirstlane(F.tid >> 6); F.wave0 = F.wave;
    F.G = gridDim.x; F.bid = blockIdx.x;
    volatile LAS unsigned* MISC = (volatile LAS unsigned*)(F.lds + MISC_OFF);
    for (int u = F.tid; u < (LDS_BYTES - LDSCTL_OFF) / 4; u += NWAVES * 64) ((LAS unsigned*)(F.lds + LDSCTL_OFF))[u] = 0u;
    __syncthreads();
    const bool multi = MK_ONE_LAUNCH ? true : !(args.it_hi - args.it_lo == 1 && args.ph_hi - args.ph_lo == 1);
    XcdBarrier bar; bar.bar = (unsigned*)(F.ws + WS_CTL) + CW_BAR; bar.x = 0; bar.st = nullptr;
    if (multi) bar = xcd_barrier_post((unsigned*)(F.ws + WS_CTL) + CW_BAR, MISC + 8);
#define GRID_BAR() do { if (multi) { xcd_barrier(bar); if ((REPMASK >> 15) & 1) xcd_barrier(bar); } } while (0)
    const int lo = args.ph_lo, hi = args.ph_hi; (void)lo; (void)hi;
#ifndef PHMASK
#define PHMASK 0xFFFF
#endif
#if MK_ONE_LAUNCH
#define IN(k) ((PHMASK >> (k)) & 1)
#else
#define IN(k) (((PHMASK >> (k)) & 1) && lo <= (k) && (k) < hi)
#endif
#define REPS(k) (1 + ((REPMASK >> (k)) & 1))
    const bool wsplit = (F.G == 256) && IN(0) && IN(11) && args.it_lo == 0 && args.it_hi > 1;
    const bool gate_early = (F.G == 256) && IN(2) && IN(7);
    if (IN(0) && args.it_lo == 0) for (int rp = 0; rp < REPS(0); ++rp) { phase_prologue(F, args, 0, wsplit ? 1 : DEPTH, true, F.bid * NWAVES + F.wave, F.G * NWAVES); if (rp + 1 < REPS(0) || !IN(1)) GRID_BAR(); }
    for (int it = args.it_lo; it < args.it_hi; ++it) {
        const int chunk = it >> 1, l = it & 1;
        unsigned char* wl = (unsigned char*)(F.ws + WS_W + (size_t)l * W_LAYER);
        const size_t xoff = (size_t)chunk * MC * DM;
        const float* xin = args.in[I_X] + xoff;
        float* Xout = args.out + xoff;
        bf16_t* X16 = (bf16_t*)(F.ws + WS_X16);
        bf16_t* XN = (bf16_t*)(F.ws + WS_XN);
        const bool xn_early = wsplit && args.it_hi > 2;
        if (IN(1) && !(xn_early && it == 2)) for (int rp = 0; rp < REPS(1); ++rp) { phase_rmsnorm(F, l == 0 ? (const void*)xin : (const void*)X16, l != 0, args.in[I_NMG] + (size_t)l * DM, XN, F.bid * NWAVES + F.wave, F.G * NWAVES); GRID_BAR(); }
        if (IN(2)) for (int rp = 0; rp < REPS(2); ++rp) {
            pg8::Gemm g{XN, (const bf16_t*)(wl + WO_IN), MC, NT_IN * 256, DM}; F.refresh(); pg8::StaticOrder S; S.init(MC, NT_IN * 256, F.G, F.bid);
            EpiInProj E{(unsigned char*)F.ws, args.in[I_GB] + l * 8, l};
            pg8::gemm_phase<EpiInProj, true>(F.lds, g, S, E, F.tid);
            if (gate_early && F.bid >= 192) {
                pg8::Gemm g2{XN, (const bf16_t*)(wl + WO_G), MC, 256, DM}; F.refresh(); pg8::StaticOrder S2; S2.init(MC, 256, 64, F.bid - 192);
                EpiGate E2{(unsigned char*)(F.ws + WS_HREG), args.in[I_BG] + (size_t)l * 3072, 0, (unsigned char*)(F.ws + WS_G0)};
                pg8::gemm_phase<EpiGate, true>(F.lds, g2, S2, E2, F.tid);
            }
            GRID_BAR();
        }
        if (IN(3)) for (int rp = 0; rp < REPS(3); ++rp) { phase_token(F, args, l, rp == 0 ? 0 : PROBE_NOLOAD); GRID_BAR(); }
        if (IN(4)) for (int rp = 0; rp < REPS(4); ++rp) {
            pg8::Gemm g{(const bf16_t*)(F.ws + WS_CKV), (const bf16_t*)(wl + WO_KV), MC, 1024, 256}; F.refresh(); pg8::StaticOrder S; S.init(MC, 1024, F.G, F.bid);
            EpiKV E{(unsigned char*)F.ws, l};
            pg8::gemm_phase<EpiKV, true>(F.lds, g, S, E, F.tid);
            if (rp + 1 < REPS(4)) GRID_BAR();
        }
#ifdef NAIVE_SEL
        if (IN(5)) { naive_select(F); GRID_BAR(); }
#else
        if (IN(5)) { for (int rp = 0; rp < REPS(5); ++rp) { phase_scores(F, it + 8 * rp); GRID_BAR(); } for (int rp = 0; rp < REPS(13); ++rp) { phase_select(F, rp == 0 ? 0 : PROBE_NOLOAD); GRID_BAR(); } }
#endif
                if (IN(7)) for (int rp = 0; rp < REPS(7); ++rp) {
            const int gsk = gate_early ? 1 : 0;
            pg8::Gemm g{XN, (const bf16_t*)(wl + WO_G) + (size_t)gsk * 256 * DM, MC, 3072 - 256 * gsk, DM}; F.refresh(); pg8::StaticOrder S; S.init(MC, 3072 - 256 * gsk, F.G, F.bid);
            EpiGate E{(unsigned char*)(F.ws + WS_HREG), args.in[I_BG] + (size_t)l * 3072, gsk, (unsigned char*)(F.ws + WS_G0)};
            pg8::gemm_phase<EpiGate, true>(F.lds, g, S, E, F.tid);
            if (rp + 1 < REPS(7)) GRID_BAR();
        }
#ifdef NAIVE_MIX
        if (IN(6)) { naive_dsa(F); __syncthreads(); naive_mlstm(F, args, l); __syncthreads(); naive_diff(F, args, l); GRID_BAR(); }
#else
        if (IN(6)) for (int rp = 0; rp < REPS(6); ++rp) { phase_mixers(F, args, l, it + 8 * rp, rp == 0 ? 7 : PROBE_MODES, rp == 0 ? 0 : PROBE_NOLOAD); GRID_BAR(); }
#endif
        if (IN(8)) for (int rp = 0; rp < REPS(8); ++rp) {
            pg8::Gemm g{(const bf16_t*)(F.ws + WS_Y), (const bf16_t*)(wl + WO_BR), MC, 1024, 1536}; F.refresh(); pg8::StaticOrder S; S.init(MC, 1024, F.G, F.bid);
            EpiMerge E{(const unsigned char*)(F.ws + WS_HREG), (bf16_t*)(F.ws + WS_MG), (const unsigned char*)(F.ws + WS_G0)};
            pg8::gemm_phase<EpiMerge, false>(F.lds, g, S, E, F.tid);
            GRID_BAR();
        }
        if (IN(9)) for (int rp = 0; rp < REPS(9); ++rp) {
            pg8::Gemm g{(const bf16_t*)(F.ws + WS_MG), (const bf16_t*)(wl + WO_OUT), MC, 1024, 1024}; F.refresh(); pg8::StaticOrder S; S.init(MC, 1024, F.G, F.bid);
            EpiResid E{l == 0 ? (const void*)xin : (const void*)X16, (void*)X16, l != 0, true, (float*)(F.ws + WS_SS)};
            pg8::gemm_phase<EpiResid, false>(F.lds, g, S, E, F.tid);
            GRID_BAR();
        }
        if (IN(11)) for (int rp = 0; rp < REPS(11); ++rp) {
            pg8::Gemm g{X16, (const bf16_t*)(wl + WO_GU), MC, 5632, DM}; F.refresh(); pg8::StaticOrder S; S.init(MC, 5632, F.G, F.bid);
            EpiSwiGLU E{(bf16_t*)(F.ws + WS_HREG), (const float*)(F.ws + WS_SS)};
            pg8::gemm_phase<EpiSwiGLU, true>(F.lds, g, S, E, F.tid);
            if (wsplit && it == 0 && F.bid >= 128) {
                __syncthreads();
                phase_prologue(F, args, 1, DEPTH, false, (F.bid - 128) * NWAVES + F.wave, 128 * NWAVES);
            }
            if (xn_early && it == 1 && F.bid >= 128)
                phase_rmsnorm(F, (const void*)(args.in[I_X] + (size_t)(chunk + 1) * MC * DM), false, args.in[I_NMG], XN, (F.bid - 128) * NWAVES + F.wave, 128 * NWAVES);
            GRID_BAR();
        }
        if (IN(12)) for (int rp = 0; rp < REPS(12); ++rp) {
            pg8::Gemm g{(const bf16_t*)(F.ws + WS_HREG), (const bf16_t*)(wl + WO_D), MC, 1024, FF}; F.refresh(); pg8::StaticOrder S; S.init(MC, 1024, F.G, F.bid);
            EpiResid E{(const void*)X16, l == DEPTH - 1 ? (void*)Xout : (void*)X16, true, l != DEPTH - 1, (float*)nullptr};
            pg8::gemm_phase<EpiResid, false>(F.lds, g, S, E, F.tid);
            if (l != DEPTH - 1) GRID_BAR();
        }
    }
#undef IN
#undef GRID_BAR
}

extern "C" void kernel_launch(void* const* d_in, const int* in_sizes, int n_in, void* d_out, int out_size, void* d_ws, size_t ws_size, hipStream_t stream) {
    static int grid = 0;
    if (grid == 0) {
        if (n_in != 21 || ws_size < WS_END) { fprintf(stderr, "kernel_launch: unexpected inputs (n_in %d, ws %zu)\n", n_in, ws_size); grid = -1; return; }
        int dev = 0, cus = 0;
        if (hipGetDevice(&dev) != hipSuccess || hipDeviceGetAttribute(&cus, hipDeviceAttributeMultiprocessorCount, dev) != hipSuccess) { grid = -1; return; }
        if (hipFuncSetAttribute((const void*)fwd, hipFuncAttributeMaxDynamicSharedMemorySize, LDS_BYTES) != hipSuccess) { grid = -1; return; }
        int per_cu = 0;
        if (hipOccupancyMaxActiveBlocksPerMultiprocessor(&per_cu, (const void*)fwd, NWAVES * 64, LDS_BYTES) != hipSuccess || per_cu < 1) fprintf(stderr, "kernel_launch: occupancy query says %d\n", per_cu);
        (void)hipGetLastError();
        grid = cus;
    }
    if (grid < 0) return;
    (void)hipMemsetAsync((char*)d_ws + WS_CTL, 0, CTL_ZERO_BYTES, stream);
    Args a{};
    for (int i = 0; i < 21; ++i) a.in[i] = (const float*)d_in[i];
    a.out = (float*)d_out; a.ws = (unsigned char*)d_ws;
#if MK_ONE_LAUNCH
    a.it_lo = 0; a.it_hi = NCHUNK * DEPTH; a.ph_lo = 0; a.ph_hi = NPHASE;
    hipLaunchKernelGGL(fwd, dim3(grid), dim3(NWAVES * 64), LDS_BYTES, stream, a);
#else
    a.it_lo = 0; a.it_hi = 1; a.ph_lo = 0; a.ph_hi = 1;
    hipLaunchKernelGGL(fwd, dim3(grid), dim3(NWAVES * 64), LDS_BYTES, stream, a);
    for (int it = 0; it < NCHUNK * DEPTH; ++it)
        for (int ph = 1; ph < NPHASE; ++ph) { a.it_lo = it; a.it_hi = it + 1; a.ph_lo = ph; a.ph_hi = ph + 1; hipLaunchKernelGGL(fwd, dim3(grid), dim3(NWAVES * 64), LDS_BYTES, stream, a); }
#endif
}
```
